# Optimizing an MI355X kernel written in HIP

```python
import math
import jax, jax.numpy as jnp
from jax import lax
import numpy as np

D_MODEL = 1024
BATCH = 4
SEQ = 8192
DEPTH = 1
DEC_BATCH = 32
DEC_SEQ = 16
PAST_LEN = 4096

CHUNK = 64
DN_HEADS = 4
DN_HEAD_DIM = 128
DN_WIDTH = DN_HEADS * DN_HEAD_DIM
DN_CONV = 4
S5_WIDTH = D_MODEL - DN_WIDTH
S5_GROUP = 16
S5_GROUPS = S5_WIDTH // S5_GROUP
S5_STATE = 64
IN_DIM = 4 * DN_WIDTH + 2 * DN_HEADS + S5_WIDTH
D_FF = 2816
FFN_CONV = 3
EPS = 1e-6

kernel_name = 'hymba_deltanet_s5_streaming_step'


def rmsnorm(x, g):
    xf = x.astype(jnp.float32)
    y = xf * lax.rsqrt(jnp.mean(xf * xf, axis=-1, keepdims=True) + EPS) * g.astype(jnp.float32)
    return y.astype(x.dtype)


def l2norm(x):
    return x * lax.rsqrt(jnp.sum(x * x, axis=-1, keepdims=True) + EPS)


def causal_dwconv(x, buf, w):
    K = w.shape[0]
    L = x.shape[1]
    xx = jnp.concatenate([buf.astype(x.dtype), x], axis=1)
    out = xx[:, 0:L] * w[0]
    for j in range(1, K):
        out = out + xx[:, j:j + L] * w[j]
    return out, xx[:, L:]


def gated_delta_rule(q, k, v, g, beta, s0):
    bsz, L, H, dk = q.shape
    dv = v.shape[-1]
    C = CHUNK if L % CHUNK == 0 else L
    N = L // C

    def blocks(t):
        t = t.reshape((bsz, N, C, H) + t.shape[3:])
        perm = (1, 0, 3, 2) + tuple(range(4, t.ndim))
        return t.transpose(perm)

    causal = jnp.tril(jnp.ones((C, C), dtype=bool))
    strict = jnp.tril(jnp.ones((C, C), dtype=bool), -1)
    eye = jnp.eye(C, dtype=q.dtype)

    def step(S, blk):
        qc, kc, vc, gc, bc = blk
        G = jnp.cumsum(gc, axis=-1)
        decay = jnp.exp(jnp.where(causal, G[..., :, None] - G[..., None, :], -jnp.inf))
        kk = jnp.einsum('bhik,bhjk->bhij', kc, kc)
        A = eye + jnp.where(strict, bc[..., :, None] * kk * decay, 0.0)
        rhs = jnp.concatenate([vc * bc[..., None], kc * (bc * jnp.exp(G))[..., None]], axis=-1)
        sol = lax.linalg.triangular_solve(A, rhs, left_side=True, lower=True, unit_diagonal=True)
        u = sol[..., :dv] - jnp.einsum('bhck,bhkv->bhcv', sol[..., dv:], S)
        qk = jnp.einsum('bhik,bhjk->bhij', qc, kc) * decay
        o = (jnp.einsum('bhck,bhkv->bhcv', qc * jnp.exp(G)[..., None], S)
             + jnp.einsum('bhij,bhjv->bhiv', qk, u))
        g_last = G[..., -1:]
        S = (S * jnp.exp(g_last)[..., None]
             + jnp.einsum('bhck,bhcv->bhkv', kc * jnp.exp(g_last - G)[..., None], u))
        return S, o

    S, o = lax.scan(step, s0, (blocks(q), blocks(k), blocks(v), blocks(g), blocks(beta)))
    o = o.transpose(1, 0, 3, 2, 4).reshape(bsz, L, H, dv)
    return o, S


def complex_affine_combine(e1, e2):
    a1r, a1i, b1r, b1i = e1
    a2r, a2i, b2r, b2i = e2
    return (a2r * a1r - a2i * a1i,
            a2r * a1i + a2i * a1r,
            a2r * b1r - a2i * b1i + b2r,
            a2r * b1i + a2i * b1r + b2i)


def s5_ssm(u, x0_re, x0_im, A_re, A_im, log_dt, B_re, B_im, C_re, C_im, Dv):
    bsz, L, _ = u.shape
    dt = jnp.exp(log_dt)[:, None]
    mag = jnp.exp(A_re * dt)
    ang = A_im * dt
    lam_re = mag * jnp.cos(ang)
    lam_im = mag * jnp.sin(ang)
    den = A_re * A_re + A_im * A_im
    f_re = ((lam_re - 1.0) * A_re + lam_im * A_im) / den
    f_im = (lam_im * A_re - (lam_re - 1.0) * A_im) / den
    Bb_re = f_re[..., None] * B_re - f_im[..., None] * B_im
    Bb_im = f_re[..., None] * B_im + f_im[..., None] * B_re
    ug = u.reshape(bsz, L, S5_GROUPS, S5_GROUP)
    b_re = jnp.einsum('blgh,gph->blgp', ug, Bb_re)
    b_im = jnp.einsum('blgh,gph->blgp', ug, Bb_im)
    b_re = b_re.at[:, 0].add(lam_re * x0_re - lam_im * x0_im)
    b_im = b_im.at[:, 0].add(lam_re * x0_im + lam_im * x0_re)
    a_re = jnp.broadcast_to(lam_re, (1, L) + lam_re.shape)
    a_im = jnp.broadcast_to(lam_im, (1, L) + lam_im.shape)
    _, _, xr, xi = lax.associative_scan(complex_affine_combine, (a_re, a_im, b_re, b_im), axis=1)
    y = jnp.einsum('blgp,ghp->blgh', xr, C_re) - jnp.einsum('blgp,ghp->blgh', xi, C_im)
    y = y.reshape(bsz, L, S5_WIDTH) + Dv * u
    return y, xr[:, -1], xi[:, -1]


def layer(x, conv_dn, s_dn, s5_re, s5_im, conv_ffn, lw):
    (n1, w_in, dn_cw, A_log, dt_bias, dn_g, A_re, A_im, log_dt, B_re, B_im, C_re, C_im, Dv,
     glu_w, glu_b, s5_g, w_out, n2, w_up, fcw, fcb, w_down) = lw
    f32 = jnp.float32
    bsz, L, _ = x.shape
    h = rmsnorm(x, n1)
    p = h @ w_in
    o1, o2 = 3 * DN_WIDTH, 4 * DN_WIDTH
    o3, o4 = o2 + DN_HEADS, o2 + 2 * DN_HEADS
    qkv_raw, z, b_raw, a_raw, u = p[..., :o1], p[..., o1:o2], p[..., o2:o3], p[..., o3:o4], p[..., o4:]

    qkv, conv_dn_new = causal_dwconv(qkv_raw, conv_dn, dn_cw)
    qkv = jax.nn.silu(qkv).astype(f32)
    q = l2norm(qkv[..., :DN_WIDTH].reshape(bsz, L, DN_HEADS, DN_HEAD_DIM)) * (DN_HEAD_DIM ** -0.5)
    k = l2norm(qkv[..., DN_WIDTH:2 * DN_WIDTH].reshape(bsz, L, DN_HEADS, DN_HEAD_DIM))
    v = qkv[..., 2 * DN_WIDTH:].reshape(bsz, L, DN_HEADS, DN_HEAD_DIM)
    beta = jax.nn.sigmoid(b_raw.astype(f32))
    g = -jnp.exp(A_log.astype(f32)) * jax.nn.softplus(a_raw.astype(f32) + dt_bias.astype(f32))
    o_dn, s_dn_new = gated_delta_rule(q, k, v, g, beta, s_dn.astype(f32))
    zg = jax.nn.silu(z.astype(f32)).reshape(bsz, L, DN_HEADS, DN_HEAD_DIM)
    o_dn = (rmsnorm(o_dn, dn_g) * zg).reshape(bsz, L, DN_WIDTH).astype(x.dtype)

    uf = u.astype(f32)
    y5, xr, xi = s5_ssm(uf, s5_re.astype(f32), s5_im.astype(f32), A_re.astype(f32), A_im.astype(f32),
                        log_dt.astype(f32), B_re.astype(f32), B_im.astype(f32), C_re.astype(f32),
                        C_im.astype(f32), Dv.astype(f32))
    y5 = jax.nn.gelu(y5).astype(x.dtype)
    gl = y5 @ glu_w + glu_b
    o_s5 = gl[..., :S5_WIDTH] * jax.nn.sigmoid(gl[..., S5_WIDTH:])
    o_s5 = rmsnorm(o_s5, s5_g)

    x = x + jnp.concatenate([o_dn, o_s5], axis=-1) @ w_out

    h2 = rmsnorm(x, n2)
    up = h2 @ w_up
    gate, val = up[..., :D_FF], up[..., D_FF:]
    gate_c, conv_ffn_new = causal_dwconv(gate, conv_ffn, fcw)
    x = x + (jax.nn.silu(gate_c + fcb) * val) @ w_down
    new = (conv_dn_new, s_dn_new.astype(x.dtype), xr.astype(x.dtype), xi.astype(x.dtype), conv_ffn_new)
    return x, new


def run_trunk(x, conv_dn, s_dn, s5_re, s5_im, conv_ffn, weights, final_norm_g):
    outs = ([], [], [], [], [])
    for l in range(DEPTH):
        lw = tuple(w[l] for w in weights)
        x, new = layer(x, conv_dn[l], s_dn[l], s5_re[l], s5_im[l], conv_ffn[l], lw)
        for lst, s in zip(outs, new):
            lst.append(s)
    y = rmsnorm(x, final_norm_g)
    return y, tuple(jnp.stack(lst) for lst in outs)


def setup_inputs(seed: int = 0) -> dict:
    key = jax.random.key(seed)
    ks = jax.random.split(key, 40)
    ctr = [0]

    def nk():
        ctr[0] += 1
        return ks[ctr[0] - 1]

    f32 = jnp.float32

    def nrm(shape, s):
        return jax.random.normal(nk(), shape, f32) * s

    def unif(shape, lo, hi):
        return jax.random.uniform(nk(), shape, f32, lo, hi)

    x_prompt = nrm((BATCH, SEQ, D_MODEL), 1.0)
    x_sample = nrm((DEC_BATCH, DEC_SEQ, D_MODEL), 1.0)
    cache_dn_conv = nrm((DEPTH, DEC_BATCH, DN_CONV - 1, 3 * DN_WIDTH), 1.0)
    state_dn = nrm((DEPTH, DEC_BATCH, DN_HEADS, DN_HEAD_DIM, DN_HEAD_DIM), 0.05)
    state_s5_re = nrm((DEPTH, DEC_BATCH, S5_GROUPS, S5_STATE), 0.1)
    state_s5_im = nrm((DEPTH, DEC_BATCH, S5_GROUPS, S5_STATE), 0.1)
    cache_ffn_conv = nrm((DEPTH, DEC_BATCH, FFN_CONV - 1, D_FF), 1.0)

    norm1_g = 1.0 + nrm((DEPTH, D_MODEL), 0.02)
    w_in = nrm((DEPTH, D_MODEL, IN_DIM), D_MODEL ** -0.5)
    dn_conv_w = nrm((DEPTH, DN_CONV, 3 * DN_WIDTH), DN_CONV ** -0.5)
    dn_A_log = jnp.log(unif((DEPTH, DN_HEADS), 1.0, 16.0))
    dt = jnp.exp(unif((DEPTH, DN_HEADS), math.log(1e-3), math.log(1e-1)))
    dn_dt_bias = dt + jnp.log(-jnp.expm1(-dt))
    dn_norm_g = 1.0 + nrm((DEPTH, DN_HEAD_DIM), 0.02)
    n_idx = jnp.arange(S5_STATE, dtype=f32)
    s5_A_re = -0.5 + nrm((DEPTH, S5_GROUPS, S5_STATE), 0.01)
    s5_A_im = math.pi * n_idx + nrm((DEPTH, S5_GROUPS, S5_STATE), 0.01)
    s5_log_dt = unif((DEPTH, S5_GROUPS), math.log(1e-3), math.log(1e-1))
    s5_B_re = nrm((DEPTH, S5_GROUPS, S5_STATE, S5_GROUP), (2 * S5_GROUP) ** -0.5)
    s5_B_im = nrm((DEPTH, S5_GROUPS, S5_STATE, S5_GROUP), (2 * S5_GROUP) ** -0.5)
    s5_C_re = nrm((DEPTH, S5_GROUPS, S5_GROUP, S5_STATE), (2 * S5_STATE) ** -0.5)
    s5_C_im = nrm((DEPTH, S5_GROUPS, S5_GROUP, S5_STATE), (2 * S5_STATE) ** -0.5)
    s5_D = nrm((DEPTH, S5_WIDTH), 1.0)
    s5_glu_w = nrm((DEPTH, S5_WIDTH, 2 * S5_WIDTH), S5_WIDTH ** -0.5)
    s5_glu_b = nrm((DEPTH, 2 * S5_WIDTH), 0.01)
    s5_norm_g = 1.0 + nrm((DEPTH, S5_WIDTH), 0.02)
    w_out = nrm((DEPTH, DN_WIDTH + S5_WIDTH, D_MODEL), (DN_WIDTH + S5_WIDTH) ** -0.5)
    norm2_g = 1.0 + nrm((DEPTH, D_MODEL), 0.02)
    w_up = nrm((DEPTH, D_MODEL, 2 * D_FF), D_MODEL ** -0.5)
    ffn_conv_w = nrm((DEPTH, FFN_CONV, D_FF), FFN_CONV ** -0.5)
    ffn_conv_b = nrm((DEPTH, D_FF), 0.01)
    w_down = nrm((DEPTH, D_FF, D_MODEL), D_FF ** -0.5)
    final_norm_g = 1.0 + nrm((D_MODEL,), 0.02)
    return {'x_prompt': x_prompt, 'x_sample': x_sample,
            'cache_dn_conv': cache_dn_conv, 'state_dn': state_dn,
            'state_s5_re': state_s5_re, 'state_s5_im': state_s5_im, 'cache_ffn_conv': cache_ffn_conv,
            'norm1_g': norm1_g, 'w_in': w_in, 'dn_conv_w': dn_conv_w, 'dn_A_log': dn_A_log,
            'dn_dt_bias': dn_dt_bias, 'dn_norm_g': dn_norm_g, 's5_A_re': s5_A_re, 's5_A_im': s5_A_im,
            's5_log_dt': s5_log_dt, 's5_B_re': s5_B_re, 's5_B_im': s5_B_im, 's5_C_re': s5_C_re,
            's5_C_im': s5_C_im, 's5_D': s5_D, 's5_glu_w': s5_glu_w, 's5_glu_b': s5_glu_b,
            's5_norm_g': s5_norm_g, 'w_out': w_out, 'norm2_g': norm2_g, 'w_up': w_up,
            'ffn_conv_w': ffn_conv_w, 'ffn_conv_b': ffn_conv_b, 'w_down': w_down,
            'final_norm_g': final_norm_g}


def reference(x_prompt, x_sample, cache_dn_conv, state_dn, state_s5_re, state_s5_im, cache_ffn_conv,
              norm1_g, w_in, dn_conv_w, dn_A_log, dn_dt_bias, dn_norm_g, s5_A_re, s5_A_im, s5_log_dt,
              s5_B_re, s5_B_im, s5_C_re, s5_C_im, s5_D, s5_glu_w, s5_glu_b, s5_norm_g, w_out,
              norm2_g, w_up, ffn_conv_w, ffn_conv_b, w_down, final_norm_g):
    weights = (norm1_g, w_in, dn_conv_w, dn_A_log, dn_dt_bias, dn_norm_g, s5_A_re, s5_A_im, s5_log_dt,
               s5_B_re, s5_B_im, s5_C_re, s5_C_im, s5_D, s5_glu_w, s5_glu_b, s5_norm_g, w_out,
               norm2_g, w_up, ffn_conv_w, ffn_conv_b, w_down)
    bp = x_prompt.shape[0]
    dt_p = x_prompt.dtype
    z_conv = jnp.zeros((DEPTH, bp, DN_CONV - 1, 3 * DN_WIDTH), dt_p)
    z_dn = jnp.zeros((DEPTH, bp, DN_HEADS, DN_HEAD_DIM, DN_HEAD_DIM), dt_p)
    z_s5 = jnp.zeros((DEPTH, bp, S5_GROUPS, S5_STATE), dt_p)
    z_ffn = jnp.zeros((DEPTH, bp, FFN_CONV - 1, D_FF), dt_p)
    y_prompt, pst = run_trunk(x_prompt, z_conv, z_dn, z_s5, z_s5, z_ffn, weights, final_norm_g)
    p_dn_conv, p_dn_state, p_s5_re, p_s5_im, p_ffn_conv = pst
    y_sample, sst = run_trunk(x_sample, cache_dn_conv, state_dn, state_s5_re, state_s5_im, cache_ffn_conv,
                              weights, final_norm_g)
    s_dn_conv, s_dn_state, s_s5_re, s_s5_im, s_ffn_conv = sst
    return (y_prompt, y_sample, p_dn_conv, p_dn_state, p_s5_re, p_s5_im, p_ffn_conv,
            s_dn_conv, s_dn_state, s_s5_re, s_s5_im, s_ffn_conv)
```

```cpp
#include <hip/hip_runtime.h>
#include <hip/hip_cooperative_groups.h>
#include <cstdio>
#include <cstdint>
namespace cg = cooperative_groups;
namespace pg8 {
#define PG8_LAS __attribute__((address_space(3)))
typedef unsigned short bf16_t;
typedef short bf16x8 __attribute__((ext_vector_type(8)));
typedef float f32x4 __attribute__((ext_vector_type(4)));
typedef unsigned u32x4 __attribute__((ext_vector_type(4)));
constexpr int BM = 256, BK = 64, HALF = 128, HTB = HALF * BK * 2  , STAGE_BYTES = 8 * HTB, NXCD = 8, WGM = 8;

__host__ __device__ __forceinline__ int lds_byte(int r, int c) { const int st = (r >> 4) * 2 + (c >> 5), rr = r & 15, cc = c & 31, ob = rr * 64 + cc * 2; return st * 1024 + (ob ^ (((ob >> 9) & 1) << 5)); }
__host__ __device__ __forceinline__ void stage_rc(int b, int& R, int& C) { const int st = b / 1024, sb = b % 1024, swz = sb ^ (((sb >> 9) & 1) << 5); R = (st >> 1) * 16 + swz / 64; C = (st & 1) * 32 + (swz % 64) / 2; }
__host__ __device__ __forceinline__ int perm32(int rho) { const int n = rho >> 4, i = rho & 15; return 8 * (i >> 2) + 4 * n + (i & 3); }

struct Unit { int pm, pn; };
struct Gemm { const bf16_t* A; const bf16_t* Bt; int M, N, K, lda; };

struct StaticOrder {
    int nM, nN, nwg, G, c;
    __host__ __device__ void init(int M, int N, int G_, int c_) { nM = M / BM; nN = N / BM; nwg = nM * nN; G = G_; c = c_; }
    __host__ __device__ bool next(int i, Unit& u) const {
        const long L = (long)i * G + c; if (L >= nwg) return false;
        int wgid = (int)L; { const int q = nwg / NXCD, r = nwg % NXCD, xcd = wgid % NXCD, off = wgid / NXCD; wgid = (xcd < r ? xcd * (q + 1) : r * (q + 1) + (xcd - r) * q) + off; }
        const int nig = WGM * nN, gid = wgid / nig, fm = gid * WGM, gsz = (nM - fm) < WGM ? (nM - fm) : WGM;
        u.pm = fm + ((wgid % nig) % gsz); u.pn = (wgid % nig) / gsz; return true;
    }
    __device__ __forceinline__ void a_ready(const Unit&) const {}
    __device__ __forceinline__ void done(const Unit&) const {}
};
__device__ __forceinline__ unsigned cvt_pk_bf16(float lo, float hi) { unsigned r; asm volatile("v_cvt_pk_bf16_f32 %0, %1, %2" : "=v"(r) : "v"(lo), "v"(hi)); return r; }
typedef float f32x2 __attribute__((ext_vector_type(2)));
template <class Epi, class Sched, bool ALIGN_EPI = false, bool SP2 = false>
__device__ __forceinline__ void gemm_phase(PG8_LAS unsigned char* lds, const Gemm g, const Sched& S, const Epi& E) {
    const int tid = threadIdx.x, wid = __builtin_amdgcn_readfirstlane(tid >> 6), lane = tid & 63, wr = wid >> 2, wc = wid & 3, fr = lane & 15, fq = lane >> 4;
    const int K = g.K, nt = K / BK;
    unsigned voffA[2], voffB[2];
#pragma unroll
    for (int i = 0; i < 2; ++i) { int R, C; stage_rc(tid * 16 + i * 8192, R, C); const int Rb = Epi::PERM ? ((R & ~31) + perm32(R & 31)) : R;
        voffA[i] = (unsigned)(R * g.lda + C) * 2u; voffB[i] = (unsigned)(Rb * K + C) * 2u; }
    const size_t kstep = (size_t)(BK * 2);
    const size_t hstep = (size_t)HALF * K * 2;
    const size_t tstep = 2 * hstep; const size_t hstepA = (size_t)HALF * g.lda * 2, tstepA = 2 * hstepA;
    const unsigned ldsw = (unsigned)wid * 1024u;
    const int aoff = lds_byte(wr * 64 + fr, fq * 8), boff = lds_byte(wc * 32 + fr, fq * 8);
#define PG8_SA(b, h) (((b) * 2 + (h)) * HTB)
#define PG8_SB(b, h) ((4 + (b) * 2 + (h)) * HTB)
#define PG8_STAGE(bufoff, gbase, voff) do { _Pragma("unroll") for (int _i = 0; _i < 2; ++_i) \
        __builtin_amdgcn_global_load_lds((const unsigned*)((const char*)(gbase) + (voff)[_i]), (PG8_LAS unsigned*)(lds + (bufoff) + ldsw + _i * 8192), 16, 0, 0); } while (0)
#define PG8_LDA(dst, b, h) do { _Pragma("unroll") for (int m = 0; m < 4; ++m) _Pragma("unroll") for (int k = 0; k < 2; ++k) dst[m][k] = *(const PG8_LAS bf16x8*)(lds + PG8_SA(b, h) + aoff + m * 2048 + k * 1024); } while (0)
#define PG8_LDB(dst, b, h) do { _Pragma("unroll") for (int n = 0; n < 2; ++n) _Pragma("unroll") for (int k = 0; k < 2; ++k) dst[n][k] = *(const PG8_LAS bf16x8*)(lds + PG8_SB(b, h) + boff + n * 2048 + k * 1024); } while (0)
#define PG8_MMA(ai, bj, At, Bt) do { __builtin_amdgcn_s_setprio(1); _Pragma("unroll") for (int m = 0; m < 4; ++m) _Pragma("unroll") for (int n = 0; n < 2; ++n) _Pragma("unroll") for (int k = 0; k < 2; ++k) \
        acc[ai][bj][m][n] = __builtin_amdgcn_mfma_f32_16x16x32_bf16(Bt[n][k], At[m][k], acc[ai][bj][m][n], 0, 0, 0); __builtin_amdgcn_s_setprio(0); } while (0)
#define PG8_WAIT_V(n) asm volatile("s_waitcnt vmcnt(" #n ")" ::: "memory")
#define PG8_WAIT_L(n) asm volatile("s_waitcnt lgkmcnt(" #n ")" ::: "memory")
#define PG8_BAR __builtin_amdgcn_s_barrier()
#define PG8_SCHED __builtin_amdgcn_sched_barrier(0)
    Unit cur, nxt; int ui = 0;
    if (!S.next(0, cur)) return;
    f32x4 acc[2][2][4][2];
#pragma unroll
    for (int a = 0; a < 2; ++a)
#pragma unroll
        for (int b = 0; b < 2; ++b)
#pragma unroll
            for (int m = 0; m < 4; ++m)
#pragma unroll
                for (int n = 0; n < 2; ++n) acc[a][b][m][n] = (f32x4){0.f, 0.f, 0.f, 0.f};
    bf16x8 At[4][2], B0[2][2], B1[2][2];
    const char* cA = (const char*)g.A + (size_t)cur.pm * tstepA; const char* cB = (const char*)g.Bt + (size_t)cur.pn * tstep;
    S.a_ready(cur);
    if constexpr (SP2) {
        PG8_STAGE(PG8_SB(0, 0), cB, voffB); PG8_STAGE(PG8_SB(0, 1), cB + hstep, voffB); PG8_STAGE(PG8_SA(0, 0), cA, voffA); PG8_STAGE(PG8_SA(0, 1), cA + hstepA, voffA);
        if (wr == 1) PG8_BAR;
        PG8_WAIT_V(2); PG8_BAR;
        PG8_STAGE(PG8_SB(1, 0), cB + kstep, voffB); PG8_STAGE(PG8_SA(1, 0), cA + kstep, voffA); PG8_STAGE(PG8_SB(1, 1), cB + hstep + kstep, voffB);
        PG8_WAIT_V(6); PG8_BAR;
    } else {
        PG8_STAGE(PG8_SB(0, 0), cB, voffB); PG8_STAGE(PG8_SA(0, 0), cA, voffA); PG8_STAGE(PG8_SB(0, 1), cB + hstep, voffB); PG8_STAGE(PG8_SA(0, 1), cA + hstepA, voffA);
        if (wr == 1) PG8_BAR;
        PG8_WAIT_V(4); PG8_BAR;
        PG8_STAGE(PG8_SB(1, 0), cB + kstep, voffB); PG8_STAGE(PG8_SA(1, 0), cA + kstep, voffA); PG8_STAGE(PG8_SB(1, 1), cB + hstep + kstep, voffB);
        PG8_WAIT_V(6); PG8_BAR;
    }
    for (;;) {
        const bool has_next = S.next(ui + 1, nxt);
        const char* nA = has_next ? (const char*)g.A + (size_t)nxt.pm * tstepA : cA; const char* nB = has_next ? (const char*)g.Bt + (size_t)nxt.pn * tstep : cB;
        for (int t = 0; t < nt; t += 2) {
            const bool last = (t == nt - 2);
            const char* a1 = cA + (size_t)(t + 1) * kstep;
            const char* a2 = last ? nA : cA + (size_t)(t + 2) * kstep; const char* b2 = last ? nB : cB + (size_t)(t + 2) * kstep;
            const char* a3 = a2 + kstep; const char* b3 = b2 + kstep;
            if (last && has_next) S.a_ready(nxt);
            if constexpr (SP2) {
            PG8_LDB(B0, 0, 0); PG8_LDB(B1, 0, 1); PG8_SCHED; PG8_LDA(At, 0, 0); PG8_STAGE(PG8_SA(1, 1), a1 + hstepA, voffA);
            PG8_WAIT_V(8); PG8_WAIT_L(0); PG8_BAR; PG8_MMA(0, 0, At, B0); PG8_MMA(0, 1, At, B1); PG8_BAR; PG8_SCHED;
            PG8_LDA(At, 0, 1); PG8_STAGE(PG8_SB(0, 0), b2, voffB); PG8_STAGE(PG8_SB(0, 1), b2 + hstep, voffB); PG8_STAGE(PG8_SA(0, 0), a2, voffA);
            PG8_WAIT_V(8); PG8_WAIT_L(0); PG8_BAR; PG8_MMA(1, 0, At, B0); PG8_MMA(1, 1, At, B1); PG8_BAR; PG8_SCHED;
            PG8_LDB(B0, 1, 0); PG8_LDB(B1, 1, 1); PG8_SCHED; PG8_LDA(At, 1, 0); PG8_STAGE(PG8_SA(0, 1), a2 + hstepA, voffA);
            PG8_WAIT_V(8); PG8_WAIT_L(0); PG8_BAR; PG8_MMA(0, 0, At, B0); PG8_MMA(0, 1, At, B1); PG8_BAR; PG8_SCHED;
            PG8_LDA(At, 1, 1); PG8_STAGE(PG8_SB(1, 0), b3, voffB); PG8_STAGE(PG8_SB(1, 1), b3 + hstep, voffB); PG8_STAGE(PG8_SA(1, 0), a3, voffA);
            PG8_WAIT_V(8); PG8_WAIT_L(0); PG8_BAR; PG8_MMA(1, 0, At, B0); PG8_MMA(1, 1, At, B1); PG8_BAR; PG8_SCHED;
            } else {
            PG8_LDB(B0, 0, 0); PG8_SCHED; PG8_LDA(At, 0, 0); PG8_STAGE(PG8_SA(1, 1), a1 + hstepA, voffA);
            PG8_WAIT_L(8); PG8_BAR; PG8_WAIT_L(0); PG8_MMA(0, 0, At, B0); PG8_BAR; PG8_SCHED;
            PG8_LDB(B1, 0, 1); PG8_STAGE(PG8_SB(0, 0), b2, voffB);
            PG8_BAR; PG8_WAIT_L(0); PG8_MMA(0, 1, At, B1); PG8_BAR;
            PG8_LDA(At, 0, 1); PG8_STAGE(PG8_SA(0, 0), a2, voffA);
            PG8_BAR; PG8_WAIT_L(0); PG8_MMA(1, 0, At, B0); PG8_BAR; PG8_SCHED;
            PG8_STAGE(PG8_SB(0, 1), b2 + hstep, voffB);
            PG8_WAIT_V(6); PG8_BAR; PG8_MMA(1, 1, At, B1); PG8_BAR;
            PG8_LDB(B0, 1, 0); PG8_SCHED; PG8_LDA(At, 1, 0); PG8_STAGE(PG8_SA(0, 1), a2 + hstepA, voffA);
            PG8_WAIT_L(8); PG8_BAR; PG8_WAIT_L(0); PG8_MMA(0, 0, At, B0); PG8_BAR; PG8_SCHED;
            PG8_LDB(B1, 1, 1); PG8_STAGE(PG8_SB(1, 0), b3, voffB);
            PG8_BAR; PG8_WAIT_L(0); PG8_MMA(0, 1, At, B1); PG8_BAR;
            PG8_LDA(At, 1, 1); PG8_STAGE(PG8_SA(1, 0), a3, voffA);
            PG8_BAR; PG8_WAIT_L(0); PG8_MMA(1, 0, At, B0); PG8_BAR; PG8_SCHED;
            PG8_STAGE(PG8_SB(1, 1), b3 + hstep, voffB);
            PG8_WAIT_V(6); PG8_BAR; PG8_MMA(1, 1, At, B1); PG8_BAR;
            }
        }
        if constexpr (ALIGN_EPI) { if (wr == 0) PG8_BAR; }
        if constexpr (!Epi::AFTER_DRAIN) { E(acc, cur, wr, wc, fr, fq); S.done(cur); }
        if (!has_next) break;
#pragma unroll
        for (int a = 0; a < 2; ++a)
#pragma unroll
            for (int b = 0; b < 2; ++b)
#pragma unroll
                for (int m = 0; m < 4; ++m)
#pragma unroll
                    for (int n = 0; n < 2; ++n) acc[a][b][m][n] = (f32x4){0.f, 0.f, 0.f, 0.f};
        cur = nxt; cA = nA; cB = nB; ++ui;
        if constexpr (ALIGN_EPI) { if (wr == 1) PG8_BAR; }
    }
    PG8_WAIT_V(0);
    if constexpr (!ALIGN_EPI) { if (wr == 0) PG8_BAR; }
    PG8_BAR;
    if constexpr (Epi::AFTER_DRAIN) { E.fused(acc, cur, wr, wc, fr, fq, lds, wid, lane); S.done(cur); }
#undef PG8_SA
#undef PG8_SB
#undef PG8_STAGE
#undef PG8_LDA
#undef PG8_LDB
#undef PG8_MMA
#undef PG8_WAIT_V
#undef PG8_WAIT_L
#undef PG8_BAR
#undef PG8_SCHED
}
}

#define DI __device__ __forceinline__
typedef unsigned short bf16;
typedef float f32x4 __attribute__((ext_vector_type(4)));
typedef float f32x2 __attribute__((ext_vector_type(2)));
typedef short bf16x8 __attribute__((ext_vector_type(8)));
typedef unsigned u32x4 __attribute__((ext_vector_type(4)));
typedef unsigned u32x2 __attribute__((ext_vector_type(2)));
typedef __bf16 bf16x2_t __attribute__((ext_vector_type(2)));

DI unsigned pk2(float lo, float hi) { f32x2 v = {lo, hi}; bf16x2_t b = __builtin_convertvector(v, bf16x2_t); return __builtin_bit_cast(unsigned, b); }
DI bf16 f2b(float x) { return (bf16)(pk2(x, 0.f) & 0xffffu); }
DI float b2f(unsigned b) { return __uint_as_float(b << 16); }
DI float blo(unsigned w) { return __uint_as_float(w << 16); }
DI float bhi(unsigned w) { return __uint_as_float(w & 0xffff0000u); }
DI float wave_sum(float v) {
#pragma unroll
    for (int o = 1; o < 64; o <<= 1) v += __shfl_xor(v, o);
    return v;
}
DI float sigm(float x) { return 1.f / (1.f + __expf(-x)); }
DI float silu(float x) { return x / (1.f + __expf(-x)); }
DI float gelu_tanh(float x) { const float z = 1.5957691216057308f * (x + 0.044715f * x * x * x); return x / (1.f + __expf(-z)); }
#define MFMA16(a, b, c) __builtin_amdgcn_mfma_f32_16x16x32_bf16((a), (b), (c), 0, 0, 0)

constexpr int TP = 32768, TS = 512, T = TP + TS;
constexpr int DM = 1024, PW = 2560, NIN = 2816, DFF = 2816, UPW = 5632;
constexpr float EPS = 1e-6f;
constexpr int NCH = 2048 + 128;
constexpr int REC = 73728;
constexpr int R_WN = 0, R_QG = 16384, R_KDT = 32768, R_QK = 49152, R_U0 = 57344;
constexpr size_t O_Y = 0, O_PDC = (size_t)T * DM, O_PDS = O_PDC + 4 * 3 * 1536, O_PSR = O_PDS + 4 * 4 * 128 * 128, O_PSI = O_PSR + 4 * 32 * 64,
                 O_PFC = O_PSI + 4 * 32 * 64, O_SDC = O_PFC + 4 * 2 * 2816, O_SDS = O_SDC + 32 * 3 * 1536, O_SSR = O_SDS + (size_t)32 * 4 * 128 * 128,
                 O_SSI = O_SSR + 32 * 32 * 64, O_SFC = O_SSI + 32 * 32 * 64, O_END = O_SFC + 32 * 2 * 2816;
constexpr size_t MiB = 1u << 20;
constexpr size_t WS_SS2 = 0;
constexpr size_t WS_EG = 3 * MiB;
constexpr size_t WS_BA = 4 * MiB;
constexpr size_t WS_WIN = 6 * MiB, WS_WGLU = 12 * MiB, WS_WOUT = 13 * MiB, WS_WUP = 15 * MiB, WS_WDOWN = 26 * MiB;
constexpr size_t WS_H = 32 * MiB;
constexpr size_t WS_P = 98 * MiB;
constexpr size_t WS_DNC = 262 * MiB;
constexpr size_t WS_Y5 = 416 * MiB, WS_GLU = 449 * MiB, WS_S5E = 482 * MiB, WS_END = 487 * MiB;
constexpr size_t WS_UP = 98 * MiB;
static_assert(WS_UP + (size_t)T * UPW * 2 <= WS_END && WS_P + (size_t)T * PW * 2 <= WS_DNC && WS_DNC + (size_t)NCH * REC <= WS_Y5, "ws map");
constexpr int LDS_BYTES = 147456;

struct Args { const float* in[31]; float* out; unsigned char* ws; };

DI int colmap(int mode, int n) {
    if (mode == 0) return n;
    if (mode == 1) return n < 2048 ? n : (n < 2560 ? n + 8 : (n < 2568 ? n - 512 : -1));
    const int pn = n >> 8, bj = (n >> 7) & 1, j = n & 127;
    return bj * (mode == 2 ? 512 : 2816) + 128 * pn + j;
}
DI void transpose_item(const float* W, int K, int N, bf16* WT, float* scr, int kb, int nb, int lane, int mode, const float* rs) {
    const int k0 = 64 * kb, n0 = 32 * nb;
    const int sc = colmap(mode, n0 + (lane & 31));
#pragma unroll 8
    for (int i = 0; i < 32; ++i) { const int kk = 2 * i + (lane >> 5); float v = 0.f; if (sc >= 0) v = W[(size_t)(k0 + kk) * N + sc]; if (rs) v *= rs[k0 + kk]; scr[kk * 33 + (lane & 31)] = v; }
    asm volatile("s_waitcnt lgkmcnt(0)" ::: "memory");
    const int c = lane & 7;
#pragma unroll
    for (int j = 0; j < 4; ++j) { const int n = (lane >> 3) + 8 * j; const float* s = scr + (8 * c) * 33 + n;
        u32x4 o; o.x = pk2(s[0 * 33], s[1 * 33]); o.y = pk2(s[2 * 33], s[3 * 33]); o.z = pk2(s[4 * 33], s[5 * 33]); o.w = pk2(s[6 * 33], s[7 * 33]);
        *(u32x4*)(WT + (size_t)(n0 + n) * K + k0 + 8 * c) = o; }
    asm volatile("s_waitcnt lgkmcnt(0)" ::: "memory");
}
DI void phase0(const Args& a, unsigned char* lds, int gw, int NGW, int wave, int lane) {
    unsigned char* ws = a.ws;
    float* scr = (float*)(lds + wave * 16384);
    constexpr int I_IN = 16 * (NIN / 32), I_GLU = 8 * 32, I_OUT = 16 * 32, I_UP = 16 * (UPW / 32), I_DN = 44 * 32;
    constexpr int NIT = I_IN + I_GLU + I_OUT + I_UP + I_DN;
    for (int it = gw; it < NIT; it += NGW) {
        int r = it;
        if (r < I_IN) { transpose_item(a.in[8], 1024, 2568, (bf16*)(ws + WS_WIN), scr, r / (NIN / 32), r % (NIN / 32), lane, 1, nullptr); continue; } r -= I_IN;
        if (r < I_GLU) { transpose_item(a.in[21], 512, 1024, (bf16*)(ws + WS_WGLU), scr, r / 32, r % 32, lane, 2, nullptr); continue; } r -= I_GLU;
        if (r < I_OUT) { transpose_item(a.in[24], 1024, 1024, (bf16*)(ws + WS_WOUT), scr, r / 32, r % 32, lane, 0, nullptr); continue; } r -= I_OUT;
        if (r < I_UP) { transpose_item(a.in[26], 1024, 5632, (bf16*)(ws + WS_WUP), scr, r / (UPW / 32), r % (UPW / 32), lane, 3, a.in[25]); continue; } r -= I_UP;
        transpose_item(a.in[29], 2816, 1024, (bf16*)(ws + WS_WDOWN), scr, r / 32, r % 32, lane, 0, nullptr);
    }
    const float* g1 = a.in[7];
    f32x4 gv[4];
#pragma unroll
    for (int j = 0; j < 4; ++j) gv[j] = ((const f32x4*)g1)[lane + 64 * j];
    bf16* H = (bf16*)(ws + WS_H);
    for (int m = gw; m < T; m += NGW) {
        const float* xrow = m < TP ? a.in[0] + (size_t)m * DM : a.in[1] + (size_t)(m - TP) * DM;
        const f32x4* xr = (const f32x4*)xrow + lane;
        f32x4 v[4]; float s = 0.f;
#pragma unroll
        for (int j = 0; j < 4; ++j) { v[j] = xr[64 * j]; s += (v[j].x * v[j].x + v[j].y * v[j].y) + (v[j].z * v[j].z + v[j].w * v[j].w); }
        const float rstd = rsqrtf(wave_sum(s) * (1.f / DM) + EPS);
        u32x2* o8 = (u32x2*)(H + (size_t)m * DM) + lane;
#pragma unroll
        for (int j = 0; j < 4; ++j) { u32x2 o; o.x = pk2(v[j].x * rstd * gv[j].x, v[j].y * rstd * gv[j].y); o.y = pk2(v[j].z * rstd * gv[j].z, v[j].w * rstd * gv[j].w); o8[64 * j] = o; }
    }
}

struct EpiP {
    static constexpr bool PERM = true, AFTER_DRAIN = false;
    bf16* P; float* BA;
    DI void operator()(const pg8::f32x4 (&acc)[2][2][4][2], const pg8::Unit& u, int wr, int wc, int fr, int fq) const {
        const int row0 = u.pm * 256 + wr * 64 + fr;
        if (u.pn < 10) {
            const int col0 = u.pn * 256 + wc * 32 + 8 * fq;
#pragma unroll
            for (int ai = 0; ai < 2; ++ai)
#pragma unroll
                for (int m = 0; m < 4; ++m) { bf16* rowp = P + (size_t)(row0 + ai * 128 + m * 16) * PW + col0;
#pragma unroll
                    for (int bj = 0; bj < 2; ++bj) { const pg8::f32x4 v0 = acc[ai][bj][m][0], v1 = acc[ai][bj][m][1];
                        u32x4 w; w.x = pk2(v0[0], v0[1]); w.y = pk2(v0[2], v0[3]); w.z = pk2(v1[0], v1[1]); w.w = pk2(v1[2], v1[3]);
                        *(u32x4*)(rowp + bj * 128) = w; } }
        } else if (wc == 0 && fq == 0) {
#pragma unroll
            for (int ai = 0; ai < 2; ++ai)
#pragma unroll
                for (int m = 0; m < 4; ++m) { float* bp = BA + (size_t)(row0 + ai * 128 + m * 16) * 8;
                    *(pg8::f32x4*)bp = acc[ai][0][m][0]; *(pg8::f32x4*)(bp + 4) = acc[ai][0][m][1]; }
        }
    }
};
struct EpiGlu {
    static constexpr bool PERM = true, AFTER_DRAIN = false;
    bf16* O; const float* gb;
    DI void operator()(const pg8::f32x4 (&acc)[2][2][4][2], const pg8::Unit& u, int wr, int wc, int fr, int fq) const {
        const int row0 = u.pm * 256 + wr * 64 + fr, col0 = u.pn * 128 + wc * 32 + 8 * fq;
        const pg8::f32x4 ba0 = *(const pg8::f32x4*)(gb + col0), ba1 = *(const pg8::f32x4*)(gb + col0 + 4), bg0 = *(const pg8::f32x4*)(gb + 512 + col0), bg1 = *(const pg8::f32x4*)(gb + 512 + col0 + 4);
#pragma unroll
        for (int ai = 0; ai < 2; ++ai)
#pragma unroll
            for (int m = 0; m < 4; ++m) {
                const pg8::f32x4 a0 = acc[ai][0][m][0] + ba0, a1 = acc[ai][0][m][1] + ba1, g0 = acc[ai][1][m][0] + bg0, g1 = acc[ai][1][m][1] + bg1;
                float o[8];
#pragma unroll
                for (int e = 0; e < 4; ++e) { o[e] = a0[e] * sigm(g0[e]); o[4 + e] = a1[e] * sigm(g1[e]); }
                u32x4 w; w.x = pk2(o[0], o[1]); w.y = pk2(o[2], o[3]); w.z = pk2(o[4], o[5]); w.w = pk2(o[6], o[7]);
                *(u32x4*)(O + (size_t)(row0 + ai * 128 + m * 16) * 512 + col0) = w;
            }
    }
};
struct EpiX1 {
    static constexpr bool PERM = false, AFTER_DRAIN = false;
    const float* xp; const float* xs; float* out; bf16* xb; float* ss2;
    DI void operator()(const pg8::f32x4 (&acc)[2][2][4][2], const pg8::Unit& u, int wr, int wc, int fr, int fq) const {
        const int row0 = u.pm * 256 + wr * 64 + fr, col0 = u.pn * 256 + wc * 32 + 4 * fq;
#pragma unroll
        for (int ai = 0; ai < 2; ++ai)
#pragma unroll
            for (int m = 0; m < 4; ++m) {
                const int row = row0 + ai * 128 + m * 16;
                const float* xr = (row < TP ? xp + (size_t)row * DM : xs + (size_t)(row - TP) * DM) + col0;
                float ss = 0.f;
#pragma unroll
                for (int bj = 0; bj < 2; ++bj)
#pragma unroll
                    for (int n = 0; n < 2; ++n) {
                        const pg8::f32x4 v = *(const pg8::f32x4*)(xr + bj * 128 + n * 16) + acc[ai][bj][m][n];
                        *(pg8::f32x4*)(out + (size_t)row * DM + col0 + bj * 128 + n * 16) = v;
                        u32x2 w; w.x = pk2(v[0], v[1]); w.y = pk2(v[2], v[3]);
                        *(u32x2*)(xb + (size_t)row * DM + col0 + bj * 128 + n * 16) = w;
                        ss += (v[0] * v[0] + v[1] * v[1]) + (v[2] * v[2] + v[3] * v[3]);
                    }
                ss += __shfl_xor(ss, 16); ss += __shfl_xor(ss, 32);
                if (fq == 0) ss2[(size_t)row * 16 + u.pn * 4 + wc] = ss;
            }
    }
};
struct EpiUp {
    static constexpr bool PERM = true, AFTER_DRAIN = false;
    bf16* UP; const float* ss2;
    DI void operator()(const pg8::f32x4 (&acc)[2][2][4][2], const pg8::Unit& u, int wr, int wc, int fr, int fq) const {
        const int row0 = u.pm * 256 + wr * 64 + fr, col0 = u.pn * 128 + wc * 32 + 8 * fq;
#pragma unroll
        for (int ai = 0; ai < 2; ++ai)
#pragma unroll
            for (int m = 0; m < 4; ++m) {
                const int row = row0 + ai * 128 + m * 16;
                const pg8::f32x4* sp = (const pg8::f32x4*)(ss2 + (size_t)row * 16);
                const pg8::f32x4 s0 = sp[0], s1 = sp[1], s2 = sp[2], s3 = sp[3];
                const float tot = ((s0[0] + s0[1]) + (s0[2] + s0[3])) + ((s1[0] + s1[1]) + (s1[2] + s1[3])) + ((s2[0] + s2[1]) + (s2[2] + s2[3])) + ((s3[0] + s3[1]) + (s3[2] + s3[3]));
                const float r = rsqrtf(tot * (1.f / DM) + EPS);
                bf16* rowp = UP + (size_t)row * UPW + col0;
#pragma unroll
                for (int bj = 0; bj < 2; ++bj) { const pg8::f32x4 v0 = acc[ai][bj][m][0] * r, v1 = acc[ai][bj][m][1] * r;
                    u32x4 w; w.x = pk2(v0[0], v0[1]); w.y = pk2(v0[2], v0[3]); w.z = pk2(v1[0], v1[1]); w.w = pk2(v1[2], v1[3]);
                    *(u32x4*)(rowp + bj * DFF) = w; }
            }
    }
};
struct EpiX2 {
    static constexpr bool PERM = false, AFTER_DRAIN = false;
    float* out;
    DI void operator()(const pg8::f32x4 (&acc)[2][2][4][2], const pg8::Unit& u, int wr, int wc, int fr, int fq) const {
        const int row0 = u.pm * 256 + wr * 64 + fr, col0 = u.pn * 256 + wc * 32 + 4 * fq;
#pragma unroll
        for (int ai = 0; ai < 2; ++ai)
#pragma unroll
            for (int m = 0; m < 4; ++m) {
                float* orow = out + (size_t)(row0 + ai * 128 + m * 16) * DM + col0;
#pragma unroll
                for (int bj = 0; bj < 2; ++bj)
#pragma unroll
                    for (int n = 0; n < 2; ++n) { pg8::f32x4* p = (pg8::f32x4*)(orow + bj * 128 + n * 16); *p = *p + acc[ai][bj][m][n]; }
            }
    }
};

DI int kperm(int k) { return (k & ~31) | (((k >> 2) & 3) << 3) | (((k >> 4) & 1) << 2) | (k & 3); }
DI void conv_col(const bf16* pcol, float h0, float h1, float h2, const float* cw, int nrows, float* outp, float (&val)[64]) {
    const float w0 = cw[0], w1 = cw[1536], w2 = cw[2 * 1536], w3 = cw[3 * 1536];
    float x3 = h0, x2 = h1, x1 = h2;
#pragma unroll
    for (int r = 0; r < 64; ++r) {
        float x0 = 0.f;
        if (r < nrows) x0 = b2f(pcol[(size_t)r * PW]);
        const float c = x3 * w0 + x2 * w1 + x1 * w2 + x0 * w3;
        val[r] = r < nrows ? silu(c) : 0.f;
        if (outp && r >= nrows - 3 && r < nrows) outp[(r - (nrows - 3)) * 1536] = x0;
        x3 = x2; x2 = x1; x1 = x0;
    }
}
DI void dn_chunk_phase(const Args& a, unsigned char* lds, int tid) {
    unsigned char* ws = a.ws;
    const int half = tid >> 8, t8 = tid & 255, hw = (tid >> 6) & 3, lane = tid & 63, fr = lane & 15, fq = lane >> 4;
    unsigned char* L = lds + half * 53248;
    unsigned char* qb = L; unsigned char* kb = L + 17408;
    float* Am = (float*)(L + 34816);
    float* Gs = (float*)(L + 51200); float* Bs = Gs + 64; float* RQ = Gs + 128; float* RK = Gs + 192; float* EG = Gs + 256;
    const bf16* P = (const bf16*)(ws + WS_P);
    const float* BA = (const float*)(ws + WS_BA);
    const float* cwt = a.in[9];
    constexpr float QSCALE = 0.08838834764831845f;
    for (int it = blockIdx.x; it < NCH / 2; it += gridDim.x) {
        const int unit = it * 2 + half;
        int row0, nrows, h, bidx; bool sample, first, lastc;
        if (unit < 2048) { const int b = unit >> 9, n = unit & 127; h = (unit >> 7) & 3; row0 = b * 8192 + n * 64; nrows = 64; sample = false; first = (n == 0); lastc = (n == 127); bidx = b; }
        else { const int su = unit - 2048; bidx = su >> 2; h = su & 3; row0 = TP + bidx * 16; nrows = 16; sample = true; first = false; lastc = true; }
        unsigned char* rec = ws + WS_DNC + (size_t)unit * REC;
        if (hw == 0) {
            float g = 0.f, be = 0.f;
            if (lane < nrows) {
                const float* bp = BA + (size_t)(row0 + lane) * 8;
                be = sigm(bp[h]);
                const float xx = bp[4 + h] + a.in[11][h];
                const float sp = xx > 20.f ? xx : log1pf(__expf(xx));
                g = -__expf(a.in[10][h]) * sp;
            }
#pragma unroll
            for (int o = 1; o < 64; o <<= 1) { const float v = __shfl_up(g, o); if (lane >= o) g += v; }
            Gs[lane] = g; Bs[lane] = be; EG[lane] = __expf(g);
            if (lane == 63) ((float*)(ws + WS_EG))[unit] = __expf(g);
        }
        float va[64];
        {
            const int c = t8 & 127;
            const int col = (t8 < 128 ? 0 : 512) + h * 128 + c;
            float h0 = 0.f, h1 = 0.f, h2 = 0.f;
            if (sample) { const float* cc = a.in[2] + (size_t)bidx * 3 * 1536 + col; h0 = cc[0]; h1 = cc[1536]; h2 = cc[2 * 1536]; }
            else if (!first) { const bf16* pp = P + (size_t)(row0 - 3) * PW + col; h0 = b2f(pp[0]); h1 = b2f(pp[PW]); h2 = b2f(pp[2 * PW]); }
            float* outp = lastc ? a.out + (sample ? O_SDC : O_PDC) + (size_t)bidx * 3 * 1536 + col : nullptr;
            conv_col(P + (size_t)row0 * PW + col, h0, h1, h2, cwt + col, nrows, outp, va);
            unsigned char* dst = (t8 < 128 ? qb : kb) + c * 2;
#pragma unroll
            for (int r = 0; r < 64; ++r) *(bf16*)(dst + r * 272) = f2b(va[r]);
        }
        __syncthreads();
        f32x4 kk[4], qk[4], qq;
        {
            bf16x8 ak[4], aq[4];
#pragma unroll
            for (int ks = 0; ks < 4; ++ks) { ak[ks] = *(const bf16x8*)(kb + (16 * hw + fr) * 272 + ks * 64 + fq * 16); aq[ks] = *(const bf16x8*)(qb + (16 * hw + fr) * 272 + ks * 64 + fq * 16); }
            qq = (f32x4){0.f, 0.f, 0.f, 0.f};
#pragma unroll
            for (int ks = 0; ks < 4; ++ks) qq = MFMA16(aq[ks], aq[ks], qq);
#pragma unroll
            for (int nt = 0; nt < 4; ++nt) {
                kk[nt] = (f32x4){0.f, 0.f, 0.f, 0.f}; qk[nt] = (f32x4){0.f, 0.f, 0.f, 0.f};
#pragma unroll
                for (int ks = 0; ks < 4; ++ks) { const bf16x8 bk = *(const bf16x8*)(kb + (16 * nt + fr) * 272 + ks * 64 + fq * 16);
                    kk[nt] = MFMA16(ak[ks], bk, kk[nt]); qk[nt] = MFMA16(aq[ks], bk, qk[nt]); }
            }
#pragma unroll
            for (int i = 0; i < 4; ++i) if (fr == 4 * fq + i) {
                float dk = 0.f;
#pragma unroll
                for (int nt = 0; nt < 4; ++nt) if (nt == hw) dk = kk[nt][i];
                RK[16 * hw + fr] = rsqrtf(dk + EPS); RQ[16 * hw + fr] = rsqrtf(qq[i] + EPS);
            }
        }
        __syncthreads();
        {
            bf16* QKr = (bf16*)(rec + R_QK);
#pragma unroll
            for (int i = 0; i < 4; ++i) {
                const int row = 16 * hw + 4 * fq + i;
                const float gr = Gs[row], br = Bs[row], rk = RK[row], rq = RQ[row];
#pragma unroll
                for (int nt = 0; nt < 4; ++nt) {
                    const int col = 16 * nt + fr;
                    const float d = col <= row ? gr - Gs[col] : 0.f;
                    const float e = __expf(d), rkc = RK[col];
                    Am[row * 64 + col] = col < row ? br * kk[nt][i] * rk * rkc * e : 0.f;
                    QKr[row * 64 + kperm(col)] = f2b(col <= row ? qk[nt][i] * rq * rkc * QSCALE * e : 0.f);
                }
            }
        }
        __syncthreads();
        if (t8 < 128) {
            bf16* Qg = (bf16*)(rec + R_QG) + kperm(t8);
#pragma unroll
            for (int r = 0; r < 64; ++r) Qg[r * 128] = f2b(va[r] * RQ[r] * QSCALE * EG[r]);
            {
                const int col = 1024 + h * 128 + t8;
                float h0 = 0.f, h1 = 0.f, h2 = 0.f;
                if (sample) { const float* cc = a.in[2] + (size_t)bidx * 3 * 1536 + col; h0 = cc[0]; h1 = cc[1536]; h2 = cc[2 * 1536]; }
                else if (!first) { const bf16* pp = P + (size_t)(row0 - 3) * PW + col; h0 = b2f(pp[0]); h1 = b2f(pp[PW]); h2 = b2f(pp[2 * PW]); }
                float* outp = lastc ? a.out + (sample ? O_SDC : O_PDC) + (size_t)bidx * 3 * 1536 + col : nullptr;
                conv_col(P + (size_t)row0 * PW + col, h0, h1, h2, cwt + col, nrows, outp, va);
            }
#pragma unroll
            for (int r = 0; r < 64; ++r) va[r] = va[r] * Bs[r];
        } else {
            const int c = t8 - 128;
            const float gl = Gs[63];
            unsigned w[32];
#pragma unroll
            for (int r = 0; r < 64; r += 2) w[kperm(r) >> 1] = pk2(va[r] * RK[r] * __expf(gl - Gs[r]), va[r + 1] * RK[r + 1] * __expf(gl - Gs[r + 1]));
            u32x4* dst = (u32x4*)(rec + R_KDT + c * 128);
#pragma unroll
            for (int j = 0; j < 8; ++j) dst[j] = (u32x4){w[4 * j], w[4 * j + 1], w[4 * j + 2], w[4 * j + 3]};
#pragma unroll
            for (int r = 0; r < 64; ++r) va[r] = va[r] * RK[r] * Bs[r] * EG[r];
        }
#pragma unroll
        for (int i = 1; i < 64; ++i) {
            float acc = va[i];
            const f32x4* Ar = (const f32x4*)(Am + i * 64);
#pragma unroll
            for (int j4 = 0; j4 < (i + 3) / 4; ++j4) {
                const f32x4 av = Ar[j4];
#pragma unroll
                for (int e = 0; e < 4; ++e) if (4 * j4 + e < i) acc -= av[e] * va[4 * j4 + e];
            }
            va[i] = acc;
        }
        if (t8 < 128) { bf16* U0 = (bf16*)(rec + R_U0) + t8;
#pragma unroll
            for (int r = 0; r < 64; ++r) U0[r * 128] = f2b(va[r]);
        } else { bf16* Wn = (bf16*)(rec + R_WN) + kperm(t8 - 128);
#pragma unroll
            for (int r = 0; r < 64; ++r) Wn[r * 128] = f2b(-va[r]);
        }
        __syncthreads();
    }
}

struct S5Par { float lr, li; float bbr[16], bbi[16]; };
DI void s5_setup(const Args& a, int g, int p, S5Par& q) {
    const float are = a.in[13][g * 64 + p], aim = a.in[14][g * 64 + p], dt = __expf(a.in[15][g]);
    const float mag = __expf(are * dt), ang = aim * dt;
    float sn, cs; sincosf(ang, &sn, &cs);
    q.lr = mag * cs; q.li = mag * sn;
    const float den = are * are + aim * aim;
    const float fre = ((q.lr - 1.f) * are + q.li * aim) / den, fim = (q.li * are - (q.lr - 1.f) * aim) / den;
    const f32x4* br = (const f32x4*)(a.in[16] + (size_t)(g * 64 + p) * 16); const f32x4* bi = (const f32x4*)(a.in[17] + (size_t)(g * 64 + p) * 16);
#pragma unroll
    for (int j = 0; j < 4; ++j) { const f32x4 r = br[j], i = bi[j];
#pragma unroll
        for (int e = 0; e < 4; ++e) { q.bbr[4 * j + e] = fre * r[e] - fim * i[e]; q.bbi[4 * j + e] = fre * i[e] + fim * r[e]; } }
}
DI void s5_step4(const S5Par& q, float uv, float& xr, float& xi, unsigned (&xo)[4]) {
#pragma unroll
    for (int j = 0; j < 4; ++j) {
        float br = 0.f, bi = 0.f;
#pragma unroll
        for (int h = 0; h < 16; ++h) { const float uh = __int_as_float(__builtin_amdgcn_readlane(__float_as_int(uv), 16 * j + h)); br += q.bbr[h] * uh; bi += q.bbi[h] * uh; }
        const float nr = q.lr * xr - q.li * xi + br, ni = q.lr * xi + q.li * xr + bi;
        xr = nr; xi = ni; xo[j] = pk2(xr, xi);
    }
}
DI void s5_pass1(const Args& a, int gw, int NGW, int lane) {
    const bf16* P = (const bf16*)(a.ws + WS_P);
    float* E = (float*)(a.ws + WS_S5E);
    for (int unit = gw; unit < 4 * 32 * 63; unit += NGW) {
        const int seg = unit % 63, bg = unit / 63, g = bg & 31, b = bg >> 5;
        S5Par q; s5_setup(a, g, lane, q);
        float xr = 0.f, xi = 0.f; unsigned xo[4];
        const bf16* up = P + (size_t)(b * 8192 + seg * 128 + (lane >> 4)) * PW + 2048 + g * 16 + (lane & 15);
#pragma unroll 2
        for (int t = 0; t < 128; t += 4) { const float uv = b2f(up[(size_t)t * PW]); s5_step4(q, uv, xr, xi, xo); }
        float* e = E + ((size_t)bg * 64 + seg) * 128;
        e[lane] = xr; e[64 + lane] = xi;
    }
}
DI void s5_pass2(const Args& a, unsigned char* xs  , int gw, int NGW, int lane) {
    const bf16* P = (const bf16*)(a.ws + WS_P);
    const float* E = (const float*)(a.ws + WS_S5E);
    bf16* Y5 = (bf16*)(a.ws + WS_Y5);
    const int fr = lane & 15, fq = lane >> 4;
    for (int unit = gw; unit < 4 * 32 * 64 + 32 * 32; unit += NGW) {
        int g, row0, ntok, seg = 0, bg; bool sample;
        if (unit < 8192) { seg = unit & 63; bg = unit >> 6; g = bg & 31; row0 = (bg >> 5) * 8192 + seg * 128; ntok = 128; sample = false; }
        else { bg = unit - 8192; g = bg & 31; row0 = TP + (bg >> 5) * 16; ntok = 16; sample = true; }
        S5Par q; s5_setup(a, g, lane, q);
        float xr = 0.f, xi = 0.f;
        if (sample) { xr = a.in[4][(size_t)bg * 64 + lane]; xi = a.in[5][(size_t)bg * 64 + lane]; }
        else {
            float pr = q.lr, pi = q.li;
#pragma unroll
            for (int s = 0; s < 7; ++s) { const float nr = pr * pr - pi * pi, ni = 2.f * pr * pi; pr = nr; pi = ni; }
            const float* e = E + (size_t)bg * 64 * 128;
            for (int s = 0; s < seg; ++s) { const float er = e[s * 128 + lane], ei = e[s * 128 + 64 + lane]; const float nr = pr * xr - pi * xi + er, ni = pr * xi + pi * xr + ei; xr = nr; xi = ni; }
        }
        bf16x8 cf[4];
#pragma unroll
        for (int ks = 0; ks < 4; ++ks) {
            const f32x4 cr = *(const f32x4*)(a.in[18] + (size_t)(g * 16 + fr) * 64 + 16 * ks + 4 * fq), ci = *(const f32x4*)(a.in[19] + (size_t)(g * 16 + fr) * 64 + 16 * ks + 4 * fq);
            u32x4 w; w.x = pk2(cr[0], -ci[0]); w.y = pk2(cr[1], -ci[1]); w.z = pk2(cr[2], -ci[2]); w.w = pk2(cr[3], -ci[3]);
            cf[ks] = __builtin_bit_cast(bf16x8, w);
        }
        const float Dg = a.in[20][g * 16 + fr];
        const bf16* up = P + (size_t)(row0 + (lane >> 4)) * PW + 2048 + g * 16 + (lane & 15);
        for (int tb = 0; tb < ntok; tb += 16) {
#pragma unroll
            for (int j4 = 0; j4 < 4; ++j4) {
                const float uv = b2f(up[(size_t)(tb + 4 * j4) * PW]);
                unsigned xo[4]; s5_step4(q, uv, xr, xi, xo);
#pragma unroll
                for (int j = 0; j < 4; ++j) *(unsigned*)(xs + (4 * j4 + j) * 272 + lane * 4) = xo[j];
            }
            f32x4 y = (f32x4){0.f, 0.f, 0.f, 0.f};
#pragma unroll
            for (int ks = 0; ks < 4; ++ks) { const bf16x8 af = *(const bf16x8*)(xs + fr * 272 + ks * 64 + fq * 16); y = MFMA16(af, cf[ks], y); }
#pragma unroll
            for (int i = 0; i < 4; ++i) {
                const size_t row = (size_t)row0 + tb + 4 * fq + i;
                const float uu = b2f(P[row * PW + 2048 + g * 16 + fr]);
                Y5[row * 512 + g * 16 + fr] = f2b(gelu_tanh(y[i] + Dg * uu));
            }
        }
        if (sample) { a.out[O_SSR + (size_t)bg * 64 + lane] = xr; a.out[O_SSI + (size_t)bg * 64 + lane] = xi; }
        else if (seg == 63) { a.out[O_PSR + (size_t)bg * 64 + lane] = xr; a.out[O_PSI + (size_t)bg * 64 + lane] = xi; }
    }
}

constexpr int DB_WN = 0, DB_QG = 17408, DB_KDT = 34816, DB_QK = 53248, DB_SIZE = 62464;
struct DnRegs { u32x4 r[7]; };
DI void dn_load(const unsigned char* rec, int tid, DnRegs& R) {
    const u32x4* g = (const u32x4*)rec;
    R.r[0] = g[tid]; R.r[1] = g[tid + 512]; R.r[2] = g[1024 + tid]; R.r[3] = g[1024 + tid + 512]; R.r[4] = g[2048 + tid]; R.r[5] = g[2048 + tid + 512]; R.r[6] = g[3072 + tid];
}
DI void dn_store(unsigned char* buf, int tid, const DnRegs& R) {
#pragma unroll
    for (int j = 0; j < 2; ++j) { const int q = tid + 512 * j;
        *(u32x4*)(buf + DB_WN + (q >> 4) * 272 + (q & 15) * 16) = R.r[j];
        *(u32x4*)(buf + DB_QG + (q >> 4) * 272 + (q & 15) * 16) = R.r[2 + j];
        *(u32x4*)(buf + DB_KDT + (q >> 3) * 144 + (q & 7) * 16) = R.r[4 + j]; }
    *(u32x4*)(buf + DB_QK + (tid >> 3) * 144 + (tid & 7) * 16) = R.r[6];
}
DI bf16x8 pack8(const f32x4& lo, const f32x4& hi) { u32x4 w; w.x = pk2(lo[0], lo[1]); w.y = pk2(lo[2], lo[3]); w.z = pk2(hi[0], hi[1]); w.w = pk2(hi[2], hi[3]); return __builtin_bit_cast(bf16x8, w); }
DI void dn_step(const unsigned char* buf, f32x4 (&S)[8], const bf16* U0c  , float eg, int fr, int fq, f32x4 (&o)[4]) {
    bf16x8 Sb[4];
#pragma unroll
    for (int ks = 0; ks < 4; ++ks) Sb[ks] = pack8(S[2 * ks], S[2 * ks + 1]);
    f32x4 u[4];
#pragma unroll
    for (int mt = 0; mt < 4; ++mt) {
#pragma unroll
        for (int i = 0; i < 4; ++i) u[mt][i] = b2f(U0c[(16 * mt + 4 * fq + i) * 128]);
#pragma unroll
        for (int ks = 0; ks < 4; ++ks) u[mt] = MFMA16(*(const bf16x8*)(buf + DB_WN + (16 * mt + fr) * 272 + ks * 64 + fq * 16), Sb[ks], u[mt]);
    }
    bf16x8 ub[2];
#pragma unroll
    for (int k2 = 0; k2 < 2; ++k2) ub[k2] = pack8(u[2 * k2], u[2 * k2 + 1]);
#pragma unroll
    for (int mt = 0; mt < 4; ++mt) {
        o[mt] = (f32x4){0.f, 0.f, 0.f, 0.f};
#pragma unroll
        for (int ks = 0; ks < 4; ++ks) o[mt] = MFMA16(*(const bf16x8*)(buf + DB_QG + (16 * mt + fr) * 272 + ks * 64 + fq * 16), Sb[ks], o[mt]);
#pragma unroll
        for (int k2 = 0; k2 < 2; ++k2) o[mt] = MFMA16(*(const bf16x8*)(buf + DB_QK + (16 * mt + fr) * 144 + k2 * 64 + fq * 16), ub[k2], o[mt]);
    }
#pragma unroll
    for (int m8 = 0; m8 < 8; ++m8) {
        S[m8] = S[m8] * eg;
#pragma unroll
        for (int k2 = 0; k2 < 2; ++k2) S[m8] = MFMA16(*(const bf16x8*)(buf + DB_KDT + (16 * m8 + fr) * 144 + k2 * 64 + fq * 16), ub[k2], S[m8]);
    }
}
DI void dn_scan_prompt(const Args& a, unsigned char* lds, int tid) {
    const int wave = tid >> 6, lane = tid & 63, fr = lane & 15, fq = lane >> 4;
    const int bh = blockIdx.x >> 1, hf = blockIdx.x & 1, b = bh >> 2, h = bh & 3;
    const int v0 = hf * 64 + (wave & 3) * 16;
    const unsigned char* recs = a.ws + WS_DNC + (size_t)bh * 128 * REC;
    const float* egs = (const float*)(a.ws + WS_EG) + bh * 128;
    float* ORAW = (float*)(a.ws + WS_H);
    f32x4 S[8];
#pragma unroll
    for (int m8 = 0; m8 < 8; ++m8) S[m8] = (f32x4){0.f, 0.f, 0.f, 0.f};
    DnRegs R;
    dn_load(recs, tid, R); dn_store(lds, tid, R);
    __syncthreads();
    for (int n = 0; n < 128; ++n) {
        if (n + 1 < 128) dn_load(recs + (size_t)(n + 1) * REC, tid, R);
        if (wave < 4) {
            f32x4 o[4];
            dn_step(lds + (n & 1) * DB_SIZE, S, (const bf16*)(recs + (size_t)n * REC + R_U0) + v0 + fr, egs[n], fr, fq, o);
            float* op = ORAW + (size_t)(b * 8192 + n * 64) * 512 + h * 128 + v0 + fr;
#pragma unroll
            for (int mt = 0; mt < 4; ++mt)
#pragma unroll
                for (int i = 0; i < 4; ++i) op[(size_t)(16 * mt + 4 * fq + i) * 512] = o[mt][i];
        }
        if (n + 1 < 128) dn_store(lds + ((n + 1) & 1) * DB_SIZE, tid, R);
        __syncthreads();
    }
    if (wave < 4) {
        float* so = a.out + O_PDS + (size_t)bh * 128 * 128 + v0 + fr;
#pragma unroll
        for (int m8 = 0; m8 < 8; ++m8)
#pragma unroll
            for (int i = 0; i < 4; ++i) so[(16 * m8 + 4 * fq + i) * 128] = S[m8][i];
    }
}
DI void dn_scan_sample(const Args& a, unsigned char* lds, int tid, int wg, int nwg) {
    const int wave = tid >> 6, lane = tid & 63, fr = lane & 15, fq = lane >> 4;
    const int v0 = wave * 16;
    float* ORAW = (float*)(a.ws + WS_H);
    for (int su = wg; su < 128; su += nwg) {
        const int sb = su >> 2, h = su & 3;
        const unsigned char* rec = a.ws + WS_DNC + (size_t)(2048 + su) * REC;
        DnRegs R; dn_load(rec, tid, R); dn_store(lds, tid, R);
        __syncthreads();
        f32x4 S[8];
        const float* s0 = a.in[3] + (size_t)su * 128 * 128 + v0 + fr;
#pragma unroll
        for (int m8 = 0; m8 < 8; ++m8)
#pragma unroll
            for (int i = 0; i < 4; ++i) S[m8][i] = s0[(16 * m8 + 4 * fq + i) * 128];
        f32x4 o[4];
        dn_step(lds, S, (const bf16*)(rec + R_U0) + v0 + fr, ((const float*)(a.ws + WS_EG))[2048 + su], fr, fq, o);
        float* op = ORAW + (size_t)(TP + sb * 16) * 512 + h * 128 + v0 + fr;
#pragma unroll
        for (int i = 0; i < 4; ++i) op[(size_t)(4 * fq + i) * 512] = o[0][i];
        float* so = a.out + O_SDS + (size_t)su * 128 * 128 + v0 + fr;
#pragma unroll
        for (int m8 = 0; m8 < 8; ++m8)
#pragma unroll
            for (int i = 0; i < 4; ++i) so[(16 * m8 + 4 * fq + i) * 128] = S[m8][i];
        __syncthreads();
    }
}

DI void mix_phase(const Args& a, int gw, int NGW, int lane) {
    const float* ORAW = (const float*)(a.ws + WS_H);
    const bf16* P = (const bf16*)(a.ws + WS_P);
    const bf16* GLU = (const bf16*)(a.ws + WS_GLU);
    bf16* MIX = (bf16*)(a.ws + WS_DNC);
    const f32x2 dg = *(const f32x2*)(a.in[12] + 2 * lane);
    const f32x4 sg0 = *(const f32x4*)(a.in[23] + 8 * lane), sg1 = *(const f32x4*)(a.in[23] + 8 * lane + 4);
    for (int row = gw; row < T; row += NGW) {
#pragma unroll
        for (int h = 0; h < 4; ++h) {
            const f32x2 ov = *(const f32x2*)(ORAW + (size_t)row * 512 + h * 128 + 2 * lane);
            const float r = rsqrtf(wave_sum(ov.x * ov.x + ov.y * ov.y) * (1.f / 128.f) + EPS);
            const unsigned zz = *(const unsigned*)(P + (size_t)row * PW + 1536 + h * 128 + 2 * lane);
            *(unsigned*)(MIX + (size_t)row * DM + h * 128 + 2 * lane) = pk2(ov.x * r * dg.x * silu(blo(zz)), ov.y * r * dg.y * silu(bhi(zz)));
        }
        const u32x4 gv = *(const u32x4*)(GLU + (size_t)row * 512 + 8 * lane);
        float v[8] = {blo(gv.x), bhi(gv.x), blo(gv.y), bhi(gv.y), blo(gv.z), bhi(gv.z), blo(gv.w), bhi(gv.w)};
        float ss = 0.f;
#pragma unroll
        for (int e = 0; e < 8; ++e) ss += v[e] * v[e];
        const float r5 = rsqrtf(wave_sum(ss) * (1.f / 512.f) + EPS);
        u32x4 w; w.x = pk2(v[0] * r5 * sg0[0], v[1] * r5 * sg0[1]); w.y = pk2(v[2] * r5 * sg0[2], v[3] * r5 * sg0[3]);
        w.z = pk2(v[4] * r5 * sg1[0], v[5] * r5 * sg1[1]); w.w = pk2(v[6] * r5 * sg1[2], v[7] * r5 * sg1[3]);
        *(u32x4*)(MIX + (size_t)row * DM + 512 + 8 * lane) = w;
    }
}

DI void act_phase(const Args& a, int gtid, int NT) {
    bf16* UP = (bf16*)(a.ws + WS_UP);
    const float* fw = a.in[27]; const float* fb = a.in[28];
    constexpr int NCG = DFF / 8;
    for (int item = gtid; item < (T / 16) * NCG; item += NT) {
        const int cg8 = item % NCG, rb = item / NCG, col = cg8 * 8, row0 = rb * 16;
        float w0[8], w1[8], w2[8], bb[8], g2[8], g1[8];
#pragma unroll
        for (int e = 0; e < 8; ++e) { w0[e] = fw[col + e]; w1[e] = fw[DFF + col + e]; w2[e] = fw[2 * DFF + col + e]; bb[e] = fb[col + e]; g2[e] = 0.f; g1[e] = 0.f; }
        const bool sample = row0 >= TP;
        float* outp = nullptr;
        if (sample) { const int sb = (row0 - TP) >> 4; const float* cc = a.in[6] + (size_t)sb * 2 * DFF + col;
#pragma unroll
            for (int e = 0; e < 8; ++e) { g2[e] = cc[e]; g1[e] = cc[DFF + e]; }
            outp = a.out + O_SFC + (size_t)sb * 2 * DFF + col;
        } else {
            if ((rb & 511) != 0) {
                const u32x4 x2 = *(const u32x4*)(UP + (size_t)(row0 - 2) * UPW + col), x1 = *(const u32x4*)(UP + (size_t)(row0 - 1) * UPW + col);
                g2[0] = blo(x2.x); g2[1] = bhi(x2.x); g2[2] = blo(x2.y); g2[3] = bhi(x2.y); g2[4] = blo(x2.z); g2[5] = bhi(x2.z); g2[6] = blo(x2.w); g2[7] = bhi(x2.w);
                g1[0] = blo(x1.x); g1[1] = bhi(x1.x); g1[2] = blo(x1.y); g1[3] = bhi(x1.y); g1[4] = blo(x1.z); g1[5] = bhi(x1.z); g1[6] = blo(x1.w); g1[7] = bhi(x1.w);
            }
            if ((rb & 511) == 511) outp = a.out + O_PFC + (size_t)(rb >> 9) * 2 * DFF + col;
        }
#pragma unroll 4
        for (int r = 0; r < 16; ++r) {
            bf16* gp = UP + (size_t)(row0 + r) * UPW + col;
            const u32x4 xg = *(const u32x4*)gp, xv = *(const u32x4*)(gp + DFF);
            float g0[8] = {blo(xg.x), bhi(xg.x), blo(xg.y), bhi(xg.y), blo(xg.z), bhi(xg.z), blo(xg.w), bhi(xg.w)};
            float vv[8] = {blo(xv.x), bhi(xv.x), blo(xv.y), bhi(xv.y), blo(xv.z), bhi(xv.z), blo(xv.w), bhi(xv.w)};
            float o[8];
#pragma unroll
            for (int e = 0; e < 8; ++e) { o[e] = silu(g2[e] * w0[e] + g1[e] * w1[e] + g0[e] * w2[e] + bb[e]) * vv[e]; g2[e] = g1[e]; g1[e] = g0[e]; }
            u32x4 w; w.x = pk2(o[0], o[1]); w.y = pk2(o[2], o[3]); w.z = pk2(o[4], o[5]); w.w = pk2(o[6], o[7]);
            *(u32x4*)(gp + DFF) = w;
            if (outp && r >= 14) {
#pragma unroll
                for (int e = 0; e < 8; ++e) outp[(r - 14) * DFF + e] = g0[e];
            }
        }
    }
}

DI void final_phase(const Args& a, int gw, int NGW, int lane) {
    f32x4 gv[4];
#pragma unroll
    for (int j = 0; j < 4; ++j) gv[j] = ((const f32x4*)a.in[30])[lane + 64 * j];
    for (int m = gw; m < T; m += NGW) {
        f32x4* xr = (f32x4*)(a.out + (size_t)m * DM) + lane;
        f32x4 v[4]; float s = 0.f;
#pragma unroll
        for (int j = 0; j < 4; ++j) { v[j] = xr[64 * j]; s += (v[j].x * v[j].x + v[j].y * v[j].y) + (v[j].z * v[j].z + v[j].w * v[j].w); }
        const float rstd = rsqrtf(wave_sum(s) * (1.f / DM) + EPS);
#pragma unroll
        for (int j = 0; j < 4; ++j) xr[64 * j] = v[j] * rstd * gv[j];
    }
}

#ifndef PH_MASK
#define PH_MASK 0xffff
#endif
#ifndef PH_LO
#define PH_LO 0
#endif
#ifndef PH_HI
#define PH_HI 99
#endif
__global__ void __launch_bounds__(512, 2) fwd_kernel(Args a) {
    extern __shared__ __attribute__((aligned(16))) unsigned char lds[];
    cg::grid_group grid = cg::this_grid();
    const int tid = threadIdx.x, lane = tid & 63, wave = __builtin_amdgcn_readfirstlane(tid >> 6);
    const int G = gridDim.x, gw = blockIdx.x * 8 + wave, NGW = G * 8;
    unsigned char* ws = a.ws;
    PG8_LAS unsigned char* ldsg = (PG8_LAS unsigned char*)lds;

#if PH_MASK & 1
    phase0(a, lds, gw, NGW, wave, lane);
#endif
    grid.sync();
#if PH_MASK & 256
    { pg8::Gemm g{(const bf16*)(ws + WS_H), (const bf16*)(ws + WS_WIN), T, NIN, DM, DM}; pg8::StaticOrder S; S.init(T, NIN, G, (int)blockIdx.x);
      EpiP E{(bf16*)(ws + WS_P), (float*)(ws + WS_BA)};
      pg8::gemm_phase<EpiP, pg8::StaticOrder, true, true>(ldsg, g, S, E); }
#endif
    grid.sync();
#if PH_MASK & 2
    dn_chunk_phase(a, lds, tid);
#endif
#if PH_MASK & 4
    s5_pass1(a, gw, NGW, lane);
#endif
    grid.sync();
#if PH_MASK & 8
    if (blockIdx.x < 32) dn_scan_prompt(a, lds, tid);
    else { dn_scan_sample(a, lds, tid, (int)blockIdx.x - 32, G - 32);
#if PH_MASK & 16
    s5_pass2(a, lds + 65536 + wave * 4352, gw - 256, NGW - 256, lane);
#endif
    }
#endif
    grid.sync();
#if PH_MASK & 512
    { pg8::Gemm g{(const bf16*)(ws + WS_Y5), (const bf16*)(ws + WS_WGLU), T, 1024, 512, 512}; pg8::StaticOrder S; S.init(T, 1024, G, (int)blockIdx.x);
      EpiGlu E{(bf16*)(ws + WS_GLU), a.in[22]};
      pg8::gemm_phase<EpiGlu, pg8::StaticOrder, true, true>(ldsg, g, S, E); }
#endif
    grid.sync();
#if PH_MASK & 32
    mix_phase(a, gw, NGW, lane);
#endif
    grid.sync();
#if PH_MASK & 1024
    { pg8::Gemm g{(const bf16*)(ws + WS_DNC), (const bf16*)(ws + WS_WOUT), T, DM, DM, DM}; pg8::StaticOrder S; S.init(T, DM, G, (int)blockIdx.x);
      EpiX1 E{a.in[0], a.in[1], a.out, (bf16*)(ws + WS_H), (float*)(ws + WS_SS2)};
      pg8::gemm_phase<EpiX1, pg8::StaticOrder, true, true>(ldsg, g, S, E); }
#endif
    grid.sync();
#if PH_MASK & 2048
    { pg8::Gemm g{(const bf16*)(ws + WS_H), (const bf16*)(ws + WS_WUP), T, UPW, DM, DM}; pg8::StaticOrder S; S.init(T, UPW, G, (int)blockIdx.x);
      EpiUp E{(bf16*)(ws + WS_UP), (const float*)(ws + WS_SS2)};
      pg8::gemm_phase<EpiUp, pg8::StaticOrder, true, true>(ldsg, g, S, E); }
#endif
    grid.sync();
#if PH_MASK & 64
    act_phase(a, (int)blockIdx.x * 512 + tid, G * 512);
#endif
    grid.sync();
#if PH_MASK & 4096
    { pg8::Gemm g{(const bf16*)(ws + WS_UP) + DFF, (const bf16*)(ws + WS_WDOWN), T, DM, DFF, UPW}; pg8::StaticOrder S; S.init(T, DM, G, (int)blockIdx.x);
      EpiX2 E{a.out};
      pg8::gemm_phase<EpiX2, pg8::StaticOrder, true, true>(ldsg, g, S, E); }
#endif
    grid.sync();
#if PH_MASK & 128
    final_phase(a, gw, NGW, lane);
#endif
}

extern "C" void kernel_launch(void* const* d_in, const int* in_sizes, int n_in, void* d_out, int out_size, void* d_ws, size_t ws_size, hipStream_t stream) {
    static int grid = 0;
    if (grid == 0) {
        if (n_in != 31 || (size_t)out_size != O_END || ws_size < WS_END) { fprintf(stderr, "kernel_launch: unexpected shapes n_in %d out %d ws %zu\n", n_in, out_size, ws_size); grid = -1; return; }
        int dev = 0, cus = 0, per_cu = 0;
        hipGetDevice(&dev);
        hipDeviceGetAttribute(&cus, hipDeviceAttributeMultiprocessorCount, dev);
        hipFuncSetAttribute((const void*)fwd_kernel, hipFuncAttributeMaxDynamicSharedMemorySize, LDS_BYTES);
        hipOccupancyMaxActiveBlocksPerMultiprocessor(&per_cu, (const void*)fwd_kernel, 512, LDS_BYTES);
        if (per_cu < 1) { fprintf(stderr, "kernel_launch: occupancy query says %d blocks per CU\n", per_cu); per_cu = 1; }
        grid = cus * 1;
        (void)hipGetLastError();
    }
    if (grid < 0) return;
    Args a{};
    for (int i = 0; i < 31; ++i) a.in[i] = (const float*)d_in[i];
    a.out = (float*)d_out; a.ws = (unsigned char*)d_ws;
    void* args[] = {&a};
    hipError_t e = hipLaunchCooperativeKernel((const void*)fwd_kernel, dim3(grid), dim3(512), args, LDS_BYTES, stream);
    if (e != hipSuccess) fprintf(stderr, "cooperative launch failed: %s (grid %d)\n", hipGetErrorString(e), grid);
}
```

```cpp
#include <hip/hip_runtime.h>
#include <hip/hip_cooperative_groups.h>
#include <cstdio>
#include <cstdint>
namespace cg = cooperative_groups;
#define OLD_S5 5
namespace pg8 {
#define PG8_LAS __attribute__((address_space(3)))
typedef unsigned short bf16_t;
typedef short bf16x8 __attribute__((ext_vector_type(8)));
typedef float f32x4 __attribute__((ext_vector_type(4)));
typedef unsigned u32x4 __attribute__((ext_vector_type(4)));
constexpr int BM = 256, BK = 64, HALF = 128, HTB = HALF * BK * 2  , STAGE_BYTES = 8 * HTB, NXCD = 8, WGM = 8;

__host__ __device__ __forceinline__ int lds_byte(int r, int c) { const int st = (r >> 4) * 2 + (c >> 5), rr = r & 15, cc = c & 31, ob = rr * 64 + cc * 2; return st * 1024 + (ob ^ (((ob >> 9) & 1) << 5)); }
__host__ __device__ __forceinline__ void stage_rc(int b, int& R, int& C) { const int st = b / 1024, sb = b % 1024, swz = sb ^ (((sb >> 9) & 1) << 5); R = (st >> 1) * 16 + swz / 64; C = (st & 1) * 32 + (swz % 64) / 2; }
__host__ __device__ __forceinline__ int perm32(int rho) { const int n = rho >> 4, i = rho & 15; return 8 * (i >> 2) + 4 * n + (i & 3); }

struct Unit { int pm, pn; };
struct Gemm { const bf16_t* A; const bf16_t* Bt; int M, N, K, lda; };

struct StaticOrder {
    int nM, nN, nwg, G, c;
    __host__ __device__ void init(int M, int N, int G_, int c_) { nM = M / BM; nN = N / BM; nwg = nM * nN; G = G_; c = c_; }
    __host__ __device__ bool next(int i, Unit& u) const {
        const long L = (long)i * G + c; if (L >= nwg) return false;
        int wgid = (int)L; { const int q = nwg / NXCD, r = nwg % NXCD, xcd = wgid % NXCD, off = wgid / NXCD; wgid = (xcd < r ? xcd * (q + 1) : r * (q + 1) + (xcd - r) * q) + off; }
        const int nig = WGM * nN, gid = wgid / nig, fm = gid * WGM, gsz = (nM - fm) < WGM ? (nM - fm) : WGM;
        u.pm = fm + ((wgid % nig) % gsz); u.pn = (wgid % nig) / gsz; return true;
    }
    __device__ __forceinline__ void a_ready(const Unit&) const {}
    __device__ __forceinline__ void done(const Unit&) const {}
};
__device__ __forceinline__ unsigned cvt_pk_bf16(float lo, float hi) { unsigned r; asm volatile("v_cvt_pk_bf16_f32 %0, %1, %2" : "=v"(r) : "v"(lo), "v"(hi)); return r; }
typedef float f32x2 __attribute__((ext_vector_type(2)));
template <class Epi, class Sched, bool ALIGN_EPI = false, bool SP2 = false>
__device__ __forceinline__ void gemm_phase(PG8_LAS unsigned char* lds, const Gemm g, const Sched& S, const Epi& E) {
    int tid_ = threadIdx.x; asm volatile("" : "+v"(tid_));
    const int tid = tid_, wid = __builtin_amdgcn_readfirstlane(tid >> 6), lane = tid & 63, wr = wid >> 2, wc = wid & 3, fr = lane & 15, fq = lane >> 4;
    const int K = g.K, nt = K / BK;
    unsigned voffA[2], voffB[2];
#pragma unroll
    for (int i = 0; i < 2; ++i) { int R, C; stage_rc(tid * 16 + i * 8192, R, C); const int Rb = Epi::PERM ? ((R & ~31) + perm32(R & 31)) : R;
        voffA[i] = (unsigned)(R * g.lda + C) * 2u; voffB[i] = (unsigned)(Rb * K + C) * 2u; }
    const size_t kstep = (size_t)(BK * 2);
    const size_t hstep = (size_t)HALF * K * 2;
    const size_t tstep = 2 * hstep; const size_t hstepA = (size_t)HALF * g.lda * 2, tstepA = 2 * hstepA;
    const unsigned ldsw = (unsigned)wid * 1024u;
    const int aoff = lds_byte(wr * 64 + fr, fq * 8), boff = lds_byte(wc * 32 + fr, fq * 8);
#define PG8_SA(b, h) (((b) * 2 + (h)) * HTB)
#define PG8_SB(b, h) ((4 + (b) * 2 + (h)) * HTB)
#define PG8_STAGE(bufoff, gbase, voff) do { _Pragma("unroll") for (int _i = 0; _i < 2; ++_i) \
        __builtin_amdgcn_global_load_lds((const unsigned*)((const char*)(gbase) + (voff)[_i]), (PG8_LAS unsigned*)(lds + (bufoff) + ldsw + _i * 8192), 16, 0, 0); } while (0)
#define PG8_LDA(dst, b, h) do { _Pragma("unroll") for (int m = 0; m < 4; ++m) _Pragma("unroll") for (int k = 0; k < 2; ++k) dst[m][k] = *(const PG8_LAS bf16x8*)(lds + PG8_SA(b, h) + aoff + m * 2048 + k * 1024); } while (0)
#define PG8_LDB(dst, b, h) do { _Pragma("unroll") for (int n = 0; n < 2; ++n) _Pragma("unroll") for (int k = 0; k < 2; ++k) dst[n][k] = *(const PG8_LAS bf16x8*)(lds + PG8_SB(b, h) + boff + n * 2048 + k * 1024); } while (0)
#define PG8_MMA(ai, bj, At, Bt) do { __builtin_amdgcn_s_setprio(1); _Pragma("unroll") for (int m = 0; m < 4; ++m) _Pragma("unroll") for (int n = 0; n < 2; ++n) _Pragma("unroll") for (int k = 0; k < 2; ++k) \
        acc[ai][bj][m][n] = __builtin_amdgcn_mfma_f32_16x16x32_bf16(Bt[n][k], At[m][k], acc[ai][bj][m][n], 0, 0, 0); __builtin_amdgcn_s_setprio(0); } while (0)
#define PG8_WAIT_V(n) asm volatile("s_waitcnt vmcnt(" #n ")" ::: "memory")
#define PG8_WAIT_L(n) asm volatile("s_waitcnt lgkmcnt(" #n ")" ::: "memory")
#define PG8_BAR __builtin_amdgcn_s_barrier()
#define PG8_SCHED __builtin_amdgcn_sched_barrier(0)
    Unit cur, nxt; int ui = 0;
    if (!S.next(0, cur)) return;
    f32x4 acc[2][2][4][2];
#pragma unroll
    for (int a = 0; a < 2; ++a)
#pragma unroll
        for (int b = 0; b < 2; ++b)
#pragma unroll
            for (int m = 0; m < 4; ++m)
#pragma unroll
                for (int n = 0; n < 2; ++n) acc[a][b][m][n] = (f32x4){0.f, 0.f, 0.f, 0.f};
    bf16x8 At[4][2], B0[2][2], B1[2][2];
    const char* cA = (const char*)g.A + (size_t)cur.pm * tstepA; const char* cB = (const char*)g.Bt + (size_t)cur.pn * tstep;
    S.a_ready(cur);
    if constexpr (SP2) {
        PG8_STAGE(PG8_SB(0, 0), cB, voffB); PG8_STAGE(PG8_SB(0, 1), cB + hstep, voffB); PG8_STAGE(PG8_SA(0, 0), cA, voffA); PG8_STAGE(PG8_SA(0, 1), cA + hstepA, voffA);
        if (wr == 1) PG8_BAR;
        PG8_WAIT_V(2); PG8_BAR;
        PG8_STAGE(PG8_SB(1, 0), cB + kstep, voffB); PG8_STAGE(PG8_SA(1, 0), cA + kstep, voffA); PG8_STAGE(PG8_SB(1, 1), cB + hstep + kstep, voffB);
        PG8_WAIT_V(6); PG8_BAR;
    } else {
        PG8_STAGE(PG8_SB(0, 0), cB, voffB); PG8_STAGE(PG8_SA(0, 0), cA, voffA); PG8_STAGE(PG8_SB(0, 1), cB + hstep, voffB); PG8_STAGE(PG8_SA(0, 1), cA + hstepA, voffA);
        if (wr == 1) PG8_BAR;
        PG8_WAIT_V(4); PG8_BAR;
        PG8_STAGE(PG8_SB(1, 0), cB + kstep, voffB); PG8_STAGE(PG8_SA(1, 0), cA + kstep, voffA); PG8_STAGE(PG8_SB(1, 1), cB + hstep + kstep, voffB);
        PG8_WAIT_V(6); PG8_BAR;
    }
    for (;;) {
        const bool has_next = S.next(ui + 1, nxt);
        const char* nA = has_next ? (const char*)g.A + (size_t)nxt.pm * tstepA : cA; const char* nB = has_next ? (const char*)g.Bt + (size_t)nxt.pn * tstep : cB;
        for (int t = 0; t < nt; t += 2) {
            const bool last = (t == nt - 2);
            const char* a1 = cA + (size_t)(t + 1) * kstep;
            const char* a2 = last ? nA : cA + (size_t)(t + 2) * kstep; const char* b2 = last ? nB : cB + (size_t)(t + 2) * kstep;
            const char* a3 = a2 + kstep; const char* b3 = b2 + kstep;
            if (last && has_next) S.a_ready(nxt);
            if constexpr (SP2) {
            PG8_LDB(B0, 0, 0); PG8_LDB(B1, 0, 1); PG8_SCHED; PG8_LDA(At, 0, 0); PG8_STAGE(PG8_SA(1, 1), a1 + hstepA, voffA);
            PG8_WAIT_V(8); PG8_WAIT_L(0); PG8_BAR; PG8_MMA(0, 0, At, B0); PG8_MMA(0, 1, At, B1); PG8_BAR; PG8_SCHED;
            PG8_LDA(At, 0, 1); PG8_STAGE(PG8_SB(0, 0), b2, voffB); PG8_STAGE(PG8_SB(0, 1), b2 + hstep, voffB); PG8_STAGE(PG8_SA(0, 0), a2, voffA);
            PG8_WAIT_V(8); PG8_WAIT_L(0); PG8_BAR; PG8_MMA(1, 0, At, B0); PG8_MMA(1, 1, At, B1); PG8_BAR; PG8_SCHED;
            PG8_LDB(B0, 1, 0); PG8_LDB(B1, 1, 1); PG8_SCHED; PG8_LDA(At, 1, 0); PG8_STAGE(PG8_SA(0, 1), a2 + hstepA, voffA);
            PG8_WAIT_V(8); PG8_WAIT_L(0); PG8_BAR; PG8_MMA(0, 0, At, B0); PG8_MMA(0, 1, At, B1); PG8_BAR; PG8_SCHED;
            PG8_LDA(At, 1, 1); PG8_STAGE(PG8_SB(1, 0), b3, voffB); PG8_STAGE(PG8_SB(1, 1), b3 + hstep, voffB); PG8_STAGE(PG8_SA(1, 0), a3, voffA);
            PG8_WAIT_V(8); PG8_WAIT_L(0); PG8_BAR; PG8_MMA(1, 0, At, B0); PG8_MMA(1, 1, At, B1); PG8_BAR; PG8_SCHED;
            } else {
            PG8_LDB(B0, 0, 0); PG8_SCHED; PG8_LDA(At, 0, 0); PG8_STAGE(PG8_SA(1, 1), a1 + hstepA, voffA);
            PG8_WAIT_L(8); PG8_BAR; PG8_WAIT_L(0); PG8_MMA(0, 0, At, B0); PG8_BAR; PG8_SCHED;
            PG8_LDB(B1, 0, 1); PG8_STAGE(PG8_SB(0, 0), b2, voffB);
            PG8_BAR; PG8_WAIT_L(0); PG8_MMA(0, 1, At, B1); PG8_BAR;
            PG8_LDA(At, 0, 1); PG8_STAGE(PG8_SA(0, 0), a2, voffA);
            PG8_BAR; PG8_WAIT_L(0); PG8_MMA(1, 0, At, B0); PG8_BAR; PG8_SCHED;
            PG8_STAGE(PG8_SB(0, 1), b2 + hstep, voffB);
            PG8_WAIT_V(6); PG8_BAR; PG8_MMA(1, 1, At, B1); PG8_BAR;
            PG8_LDB(B0, 1, 0); PG8_SCHED; PG8_LDA(At, 1, 0); PG8_STAGE(PG8_SA(0, 1), a2 + hstepA, voffA);
            PG8_WAIT_L(8); PG8_BAR; PG8_WAIT_L(0); PG8_MMA(0, 0, At, B0); PG8_BAR; PG8_SCHED;
            PG8_LDB(B1, 1, 1); PG8_STAGE(PG8_SB(1, 0), b3, voffB);
            PG8_BAR; PG8_WAIT_L(0); PG8_MMA(0, 1, At, B1); PG8_BAR;
            PG8_LDA(At, 1, 1); PG8_STAGE(PG8_SA(1, 0), a3, voffA);
            PG8_BAR; PG8_WAIT_L(0); PG8_MMA(1, 0, At, B0); PG8_BAR; PG8_SCHED;
            PG8_STAGE(PG8_SB(1, 1), b3 + hstep, voffB);
            PG8_WAIT_V(6); PG8_BAR; PG8_MMA(1, 1, At, B1); PG8_BAR;
            }
        }
        if constexpr (ALIGN_EPI) { if (wr == 0) PG8_BAR; }
        if constexpr (!Epi::AFTER_DRAIN) { E(acc, cur, wr, wc, fr, fq); S.done(cur); }
        if (!has_next) break;
#pragma unroll
        for (int a = 0; a < 2; ++a)
#pragma unroll
            for (int b = 0; b < 2; ++b)
#pragma unroll
                for (int m = 0; m < 4; ++m)
#pragma unroll
                    for (int n = 0; n < 2; ++n) acc[a][b][m][n] = (f32x4){0.f, 0.f, 0.f, 0.f};
        cur = nxt; cA = nA; cB = nB; ++ui;
        if constexpr (ALIGN_EPI) { if (wr == 1) PG8_BAR; }
    }
    PG8_WAIT_V(0);
    if constexpr (!ALIGN_EPI) { if (wr == 0) PG8_BAR; }
    PG8_BAR;
    if constexpr (Epi::AFTER_DRAIN) { E.fused(acc, cur, wr, wc, fr, fq, lds, wid, lane); S.done(cur); }
#undef PG8_SA
#undef PG8_SB
#undef PG8_STAGE
#undef PG8_LDA
#undef PG8_LDB
#undef PG8_MMA
#undef PG8_WAIT_V
#undef PG8_WAIT_L
#undef PG8_BAR
#undef PG8_SCHED
}
}

#ifndef DIAG_Y
#define DIAG_Y 0
#endif
#ifndef OLD_S5
#define OLD_S5 0
#endif
#if OLD_S5 == 3
#define OLD_S5_ULIM 8192
#else
#define OLD_S5_ULIM (4 * 32 * 64 + 32 * 32)
#endif
#define DI __device__ __forceinline__
typedef unsigned short bf16;
typedef float f32x4 __attribute__((ext_vector_type(4)));
typedef float f32x2 __attribute__((ext_vector_type(2)));
typedef short bf16x8 __attribute__((ext_vector_type(8)));
typedef unsigned u32x4 __attribute__((ext_vector_type(4)));
typedef unsigned u32x2 __attribute__((ext_vector_type(2)));
typedef __bf16 bf16x2_t __attribute__((ext_vector_type(2)));

DI unsigned pk2(float lo, float hi) { f32x2 v = {lo, hi}; bf16x2_t b = __builtin_convertvector(v, bf16x2_t); return __builtin_bit_cast(unsigned, b); }
DI bf16 f2b(float x) { return (bf16)(pk2(x, 0.f) & 0xffffu); }
DI float b2f(unsigned b) { return __uint_as_float(b << 16); }
DI float blo(unsigned w) { return __uint_as_float(w << 16); }
DI float bhi(unsigned w) { return __uint_as_float(w & 0xffff0000u); }
DI float wave_sum(float v) {
#pragma unroll
    for (int o = 1; o < 64; o <<= 1) v += __shfl_xor(v, o);
    return v;
}
DI float sigm(float x) { return 1.f / (1.f + __expf(-x)); }
DI float silu(float x) { return x / (1.f + __expf(-x)); }
DI float gelu_tanh(float x) { const float z = 1.5957691216057308f * (x + 0.044715f * x * x * x); return x / (1.f + __expf(-z)); }
#define MFMA16(a, b, c) __builtin_amdgcn_mfma_f32_16x16x32_bf16((a), (b), (c), 0, 0, 0)

constexpr int TP = 32768, TS = 512, T = TP + TS;
constexpr int DM = 1024, PW = 2560, NIN = 2816, DFF = 2816, UPW = 5632;
constexpr float EPS = 1e-6f;
constexpr int NCH = 2048 + 128;
constexpr int REC = 73728;
constexpr int R_WN = 0, R_QG = 16384, R_KDT = 32768, R_QK = 49152, R_U0 = 57344;
constexpr size_t O_Y = 0, O_PDC = (size_t)T * DM, O_PDS = O_PDC + 4 * 3 * 1536, O_PSR = O_PDS + 4 * 4 * 128 * 128, O_PSI = O_PSR + 4 * 32 * 64,
                 O_PFC = O_PSI + 4 * 32 * 64, O_SDC = O_PFC + 4 * 2 * 2816, O_SDS = O_SDC + 32 * 3 * 1536, O_SSR = O_SDS + (size_t)32 * 4 * 128 * 128,
                 O_SSI = O_SSR + 32 * 32 * 64, O_SFC = O_SSI + 32 * 32 * 64, O_END = O_SFC + 32 * 2 * 2816;
constexpr size_t MiB = 1u << 20;
constexpr size_t WS_SS2 = 0;
constexpr size_t WS_EG = 3 * MiB;
constexpr size_t WS_BA = 4 * MiB;
constexpr size_t WS_WIN = 6 * MiB, WS_WGLU = 12 * MiB, WS_WOUT = 13 * MiB, WS_WUP = 15 * MiB, WS_WDOWN = 26 * MiB;
constexpr size_t WS_H = 32 * MiB;
constexpr size_t WS_P = 98 * MiB;
constexpr size_t WS_DNC = 262 * MiB;
constexpr size_t WS_Y5 = 416 * MiB, WS_GLU = 449 * MiB, WS_S5E = 482 * MiB, WS_END = 487 * MiB;
constexpr size_t WS_UP = 98 * MiB;
static_assert(WS_UP + (size_t)T * UPW * 2 <= WS_END && WS_P + (size_t)T * PW * 2 <= WS_DNC && WS_DNC + (size_t)NCH * REC <= WS_Y5, "ws map");
constexpr int LDS_BYTES = 147456;

struct Args { const float* in[31]; float* out; unsigned char* ws; };

DI int colmap(int mode, int n) {
    if (mode == 0) return n;
    if (mode == 1) return n < 2048 ? n : (n < 2560 ? n + 8 : (n < 2568 ? n - 512 : -1));
    const int pn = n >> 8, bj = (n >> 7) & 1, j = n & 127;
    return bj * (mode == 2 ? 512 : 2816) + 128 * pn + j;
}
DI void transpose_item(const float* W, int K, int N, bf16* WT, float* scr, int kb, int nb, int lane, int mode, const float* rs) {
    const int k0 = 64 * kb, n0 = 32 * nb;
    const int sc = colmap(mode, n0 + (lane & 31));
#pragma unroll 8
    for (int i = 0; i < 32; ++i) { const int kk = 2 * i + (lane >> 5); float v = 0.f; if (sc >= 0) v = W[(size_t)(k0 + kk) * N + sc]; if (rs) v *= rs[k0 + kk]; scr[kk * 33 + (lane & 31)] = v; }
    asm volatile("s_waitcnt lgkmcnt(0)" ::: "memory");
    const int c = lane & 7;
#pragma unroll
    for (int j = 0; j < 4; ++j) { const int n = (lane >> 3) + 8 * j; const float* s = scr + (8 * c) * 33 + n;
        u32x4 o; o.x = pk2(s[0 * 33], s[1 * 33]); o.y = pk2(s[2 * 33], s[3 * 33]); o.z = pk2(s[4 * 33], s[5 * 33]); o.w = pk2(s[6 * 33], s[7 * 33]);
        *(u32x4*)(WT + (size_t)(n0 + n) * K + k0 + 8 * c) = o; }
    asm volatile("s_waitcnt lgkmcnt(0)" ::: "memory");
}
DI void phase0(const Args& a, unsigned char* lds, int gw, int NGW, int wave, int lane) {
    asm volatile("" : "+v"(lane));
    unsigned char* ws = a.ws;
    float* scr = (float*)(lds + wave * 16384);
    constexpr int I_IN = 16 * (NIN / 32), I_GLU = 8 * 32, I_OUT = 16 * 32, I_UP = 16 * (UPW / 32), I_DN = 44 * 32;
    constexpr int NIT = I_IN + I_GLU + I_OUT + I_UP + I_DN;
    for (int it = gw; it < NIT; it += NGW) {
        int r = it;
        if (r < I_IN) { transpose_item(a.in[8], 1024, 2568, (bf16*)(ws + WS_WIN), scr, r / (NIN / 32), r % (NIN / 32), lane, 1, nullptr); continue; } r -= I_IN;
        if (r < I_GLU) { transpose_item(a.in[21], 512, 1024, (bf16*)(ws + WS_WGLU), scr, r / 32, r % 32, lane, 2, nullptr); continue; } r -= I_GLU;
        if (r < I_OUT) { transpose_item(a.in[24], 1024, 1024, (bf16*)(ws + WS_WOUT), scr, r / 32, r % 32, lane, 0, nullptr); continue; } r -= I_OUT;
        if (r < I_UP) { transpose_item(a.in[26], 1024, 5632, (bf16*)(ws + WS_WUP), scr, r / (UPW / 32), r % (UPW / 32), lane, 3, a.in[25]); continue; } r -= I_UP;
        transpose_item(a.in[29], 2816, 1024, (bf16*)(ws + WS_WDOWN), scr, r / 32, r % 32, lane, 0, nullptr);
    }
    const float* g1 = a.in[7];
    f32x4 gv[4];
#pragma unroll
    for (int j = 0; j < 4; ++j) gv[j] = ((const f32x4*)g1)[lane + 64 * j];
    bf16* H = (bf16*)(ws + WS_H);
    for (int m = gw; m < T; m += NGW) {
        const float* xrow = m < TP ? a.in[0] + (size_t)m * DM : a.in[1] + (size_t)(m - TP) * DM;
        const f32x4* xr = (const f32x4*)xrow + lane;
        f32x4 v[4]; float s = 0.f;
#pragma unroll
        for (int j = 0; j < 4; ++j) { v[j] = xr[64 * j]; s += (v[j].x * v[j].x + v[j].y * v[j].y) + (v[j].z * v[j].z + v[j].w * v[j].w); }
        const float rstd = rsqrtf(wave_sum(s) * (1.f / DM) + EPS);
        u32x2* o8 = (u32x2*)(H + (size_t)m * DM) + lane;
#pragma unroll
        for (int j = 0; j < 4; ++j) { u32x2 o; o.x = pk2(v[j].x * rstd * gv[j].x, v[j].y * rstd * gv[j].y); o.y = pk2(v[j].z * rstd * gv[j].z, v[j].w * rstd * gv[j].w); o8[64 * j] = o; }
    }
}

struct EpiP {
    static constexpr bool PERM = true, AFTER_DRAIN = false;
    bf16* P; float* BA;
    DI void operator()(const pg8::f32x4 (&acc)[2][2][4][2], const pg8::Unit& u, int wr, int wc, int fr, int fq) const {
        const int row0 = u.pm * 256 + wr * 64 + fr;
        if (u.pn < 10) {
            const int col0 = u.pn * 256 + wc * 32 + 8 * fq;
#pragma unroll
            for (int ai = 0; ai < 2; ++ai)
#pragma unroll
                for (int m = 0; m < 4; ++m) { bf16* rowp = P + (size_t)(row0 + ai * 128 + m * 16) * PW + col0;
#pragma unroll
                    for (int bj = 0; bj < 2; ++bj) { const pg8::f32x4 v0 = acc[ai][bj][m][0], v1 = acc[ai][bj][m][1];
                        u32x4 w; w.x = pk2(v0[0], v0[1]); w.y = pk2(v0[2], v0[3]); w.z = pk2(v1[0], v1[1]); w.w = pk2(v1[2], v1[3]);
                        *(u32x4*)(rowp + bj * 128) = w; } }
        } else if (wc == 0 && fq == 0) {
#pragma unroll
            for (int ai = 0; ai < 2; ++ai)
#pragma unroll
                for (int m = 0; m < 4; ++m) { float* bp = BA + (size_t)(row0 + ai * 128 + m * 16) * 8;
                    *(pg8::f32x4*)bp = acc[ai][0][m][0]; *(pg8::f32x4*)(bp + 4) = acc[ai][0][m][1]; }
        }
    }
};
struct EpiGlu {
    static constexpr bool PERM = true, AFTER_DRAIN = false;
    bf16* O; const float* gb;
    DI void operator()(const pg8::f32x4 (&acc)[2][2][4][2], const pg8::Unit& u, int wr, int wc, int fr, int fq) const {
        const int row0 = u.pm * 256 + wr * 64 + fr, col0 = u.pn * 128 + wc * 32 + 8 * fq;
        const pg8::f32x4 ba0 = *(const pg8::f32x4*)(gb + col0), ba1 = *(const pg8::f32x4*)(gb + col0 + 4), bg0 = *(const pg8::f32x4*)(gb + 512 + col0), bg1 = *(const pg8::f32x4*)(gb + 512 + col0 + 4);
#pragma unroll
        for (int ai = 0; ai < 2; ++ai)
#pragma unroll
            for (int m = 0; m < 4; ++m) {
                const pg8::f32x4 a0 = acc[ai][0][m][0] + ba0, a1 = acc[ai][0][m][1] + ba1, g0 = acc[ai][1][m][0] + bg0, g1 = acc[ai][1][m][1] + bg1;
                float o[8];
#pragma unroll
                for (int e = 0; e < 4; ++e) { o[e] = a0[e] * sigm(g0[e]); o[4 + e] = a1[e] * sigm(g1[e]); }
                u32x4 w; w.x = pk2(o[0], o[1]); w.y = pk2(o[2], o[3]); w.z = pk2(o[4], o[5]); w.w = pk2(o[6], o[7]);
                *(u32x4*)(O + (size_t)(row0 + ai * 128 + m * 16) * 512 + col0) = w;
            }
    }
};
struct EpiX1 {
    static constexpr bool PERM = false, AFTER_DRAIN = false;
    const float* xp; const float* xs; float* out; bf16* xb; float* ss2;
    DI void operator()(const pg8::f32x4 (&acc)[2][2][4][2], const pg8::Unit& u, int wr, int wc, int fr, int fq) const {
        const int row0 = u.pm * 256 + wr * 64 + fr, col0 = u.pn * 256 + wc * 32 + 4 * fq;
#pragma unroll
        for (int ai = 0; ai < 2; ++ai)
#pragma unroll
            for (int m = 0; m < 4; ++m) {
                const int row = row0 + ai * 128 + m * 16;
                const float* xr = (row < TP ? xp + (size_t)row * DM : xs + (size_t)(row - TP) * DM) + col0;
                float ss = 0.f;
#pragma unroll
                for (int bj = 0; bj < 2; ++bj)
#pragma unroll
                    for (int n = 0; n < 2; ++n) {
                        const pg8::f32x4 v = *(const pg8::f32x4*)(xr + bj * 128 + n * 16) + acc[ai][bj][m][n];
                        *(pg8::f32x4*)(out + (size_t)row * DM + col0 + bj * 128 + n * 16) = v;
                        u32x2 w; w.x = pk2(v[0], v[1]); w.y = pk2(v[2], v[3]);
                        *(u32x2*)(xb + (size_t)row * DM + col0 + bj * 128 + n * 16) = w;
                        ss += (v[0] * v[0] + v[1] * v[1]) + (v[2] * v[2] + v[3] * v[3]);
                    }
                ss += __shfl_xor(ss, 16); ss += __shfl_xor(ss, 32);
                if (fq == 0) ss2[(size_t)row * 16 + u.pn * 4 + wc] = ss;
            }
    }
};
struct EpiUp {
    static constexpr bool PERM = true, AFTER_DRAIN = false;
    bf16* UP; const float* ss2;
    DI void operator()(const pg8::f32x4 (&acc)[2][2][4][2], const pg8::Unit& u, int wr, int wc, int fr, int fq) const {
        const int row0 = u.pm * 256 + wr * 64 + fr, col0 = u.pn * 128 + wc * 32 + 8 * fq;
#pragma unroll
        for (int ai = 0; ai < 2; ++ai)
#pragma unroll
            for (int m = 0; m < 4; ++m) {
                const int row = row0 + ai * 128 + m * 16;
                const pg8::f32x4* sp = (const pg8::f32x4*)(ss2 + (size_t)row * 16);
                const pg8::f32x4 s0 = sp[0], s1 = sp[1], s2 = sp[2], s3 = sp[3];
                const float tot = ((s0[0] + s0[1]) + (s0[2] + s0[3])) + ((s1[0] + s1[1]) + (s1[2] + s1[3])) + ((s2[0] + s2[1]) + (s2[2] + s2[3])) + ((s3[0] + s3[1]) + (s3[2] + s3[3]));
                const float r = rsqrtf(tot * (1.f / DM) + EPS);
                bf16* rowp = UP + (size_t)row * UPW + col0;
#pragma unroll
                for (int bj = 0; bj < 2; ++bj) { const pg8::f32x4 v0 = acc[ai][bj][m][0] * r, v1 = acc[ai][bj][m][1] * r;
                    u32x4 w; w.x = pk2(v0[0], v0[1]); w.y = pk2(v0[2], v0[3]); w.z = pk2(v1[0], v1[1]); w.w = pk2(v1[2], v1[3]);
                    *(u32x4*)(rowp + bj * DFF) = w; }
            }
    }
};
struct EpiX2 {
    static constexpr bool PERM = false, AFTER_DRAIN = false;
    float* out;
    DI void operator()(const pg8::f32x4 (&acc)[2][2][4][2], const pg8::Unit& u, int wr, int wc, int fr, int fq) const {
        const int row0 = u.pm * 256 + wr * 64 + fr, col0 = u.pn * 256 + wc * 32 + 4 * fq;
#pragma unroll
        for (int ai = 0; ai < 2; ++ai)
#pragma unroll
            for (int m = 0; m < 4; ++m) {
                float* orow = out + (size_t)(row0 + ai * 128 + m * 16) * DM + col0;
#pragma unroll
                for (int bj = 0; bj < 2; ++bj)
#pragma unroll
                    for (int n = 0; n < 2; ++n) { pg8::f32x4* p = (pg8::f32x4*)(orow + bj * 128 + n * 16); *p = *p + acc[ai][bj][m][n]; }
            }
    }
};

DI int kperm(int k) { return (k & ~31) | (((k >> 2) & 3) << 3) | (((k >> 4) & 1) << 2) | (k & 3); }
DI void conv_col(const bf16* pcol, float h0, float h1, float h2, const float* cw, int nrows, float* outp, float (&val)[64]) {
    const float w0 = cw[0], w1 = cw[1536], w2 = cw[2 * 1536], w3 = cw[3 * 1536];
    float x3 = h0, x2 = h1, x1 = h2;
#pragma unroll
    for (int r = 0; r < 64; ++r) {
        float x0 = 0.f;
        if (r < nrows) x0 = b2f(pcol[(size_t)r * PW]);
        const float c = x3 * w0 + x2 * w1 + x1 * w2 + x0 * w3;
        val[r] = r < nrows ? silu(c) : 0.f;
        if (outp && r >= nrows - 3 && r < nrows) outp[(r - (nrows - 3)) * 1536] = x0;
        x3 = x2; x2 = x1; x1 = x0;
    }
}
DI void dn_chunk_phase(const Args& a, unsigned char* lds, int tid) {
    unsigned char* ws = a.ws;
    const bf16* P = (const bf16*)(ws + WS_P);
    const float* BA = (const float*)(ws + WS_BA);
    const float* cwt = a.in[9];
    constexpr float QSCALE = 0.08838834764831845f;
    for (int it = blockIdx.x; it < NCH / 2; it += gridDim.x) {
        int tl = tid; asm volatile("" : "+v"(tl));
        const int half = __builtin_amdgcn_readfirstlane(tl >> 8), t8 = tl & 255, hw = __builtin_amdgcn_readfirstlane((tl >> 6) & 3), lane = tl & 63, fr = lane & 15, fq = lane >> 4;
        unsigned char* L = lds + half * 53248;
        unsigned char* qb = L; unsigned char* kb = L + 17408;
        float* Am = (float*)(L + 34816);
        float* Gs = (float*)(L + 51200); float* Bs = Gs + 64; float* RQ = Gs + 128; float* RK = Gs + 192; float* EG = Gs + 256;
        const int unit = it * 2 + half;
        int row0, nrows, h, bidx; bool sample, first, lastc;
        if (unit < 2048) { const int b = unit >> 9, n = unit & 127; h = (unit >> 7) & 3; row0 = b * 8192 + n * 64; nrows = 64; sample = false; first = (n == 0); lastc = (n == 127); bidx = b; }
        else { const int su = unit - 2048; bidx = su >> 2; h = su & 3; row0 = TP + bidx * 16; nrows = 16; sample = true; first = false; lastc = true; }
        unsigned char* rec = ws + WS_DNC + (size_t)unit * REC;
        if (hw == 0) {
            float g = 0.f, be = 0.f;
            if (lane < nrows) {
                const float* bp = BA + (size_t)(row0 + lane) * 8;
                be = sigm(bp[h]);
                const float xx = bp[4 + h] + a.in[11][h];
                const float sp = xx > 20.f ? xx : log1pf(__expf(xx));
                g = -__expf(a.in[10][h]) * sp;
            }
#pragma unroll
            for (int o = 1; o < 64; o <<= 1) { const float v = __shfl_up(g, o); if (lane >= o) g += v; }
            Gs[lane] = g; Bs[lane] = be; EG[lane] = __expf(g);
            if (lane == 63) ((float*)(ws + WS_EG))[unit] = __expf(g);
        }
        float va[64];
        {
            const int c = t8 & 127;
            const int col = (t8 < 128 ? 0 : 512) + h * 128 + c;
            float h0 = 0.f, h1 = 0.f, h2 = 0.f;
            if (sample) { const float* cc = a.in[2] + (size_t)bidx * 3 * 1536 + col; h0 = cc[0]; h1 = cc[1536]; h2 = cc[2 * 1536]; }
            else if (!first) { const bf16* pp = P + (size_t)(row0 - 3) * PW + col; h0 = b2f(pp[0]); h1 = b2f(pp[PW]); h2 = b2f(pp[2 * PW]); }
            float* outp = lastc ? a.out + (sample ? O_SDC : O_PDC) + (size_t)bidx * 3 * 1536 + col : nullptr;
            conv_col(P + (size_t)row0 * PW + col, h0, h1, h2, cwt + col, nrows, outp, va);
            unsigned char* dst = (t8 < 128 ? qb : kb) + c * 2;
#pragma unroll
            for (int r = 0; r < 64; ++r) *(bf16*)(dst + r * 272) = f2b(va[r]);
        }
        __syncthreads();
        f32x4 kk[4], qk[4], qq;
        {
            bf16x8 ak[4], aq[4];
#pragma unroll
            for (int ks = 0; ks < 4; ++ks) { ak[ks] = *(const bf16x8*)(kb + (16 * hw + fr) * 272 + ks * 64 + fq * 16); aq[ks] = *(const bf16x8*)(qb + (16 * hw + fr) * 272 + ks * 64 + fq * 16); }
            qq = (f32x4){0.f, 0.f, 0.f, 0.f};
#pragma unroll
            for (int ks = 0; ks < 4; ++ks) qq = MFMA16(aq[ks], aq[ks], qq);
#pragma unroll
            for (int nt = 0; nt < 4; ++nt) {
                kk[nt] = (f32x4){0.f, 0.f, 0.f, 0.f}; qk[nt] = (f32x4){0.f, 0.f, 0.f, 0.f};
#pragma unroll
                for (int ks = 0; ks < 4; ++ks) { const bf16x8 bk = *(const bf16x8*)(kb + (16 * nt + fr) * 272 + ks * 64 + fq * 16);
                    kk[nt] = MFMA16(ak[ks], bk, kk[nt]); qk[nt] = MFMA16(aq[ks], bk, qk[nt]); }
            }
#pragma unroll
            for (int i = 0; i < 4; ++i) if (fr == 4 * fq + i) {
                float dk = 0.f;
#pragma unroll
                for (int nt = 0; nt < 4; ++nt) if (nt == hw) dk = kk[nt][i];
                RK[16 * hw + fr] = rsqrtf(dk + EPS); RQ[16 * hw + fr] = rsqrtf(qq[i] + EPS);
            }
        }
        __syncthreads();
        {
            bf16* QKr = (bf16*)(rec + R_QK);
#pragma unroll
            for (int i = 0; i < 4; ++i) {
                const int row = 16 * hw + 4 * fq + i;
                const float gr = Gs[row], br = Bs[row], rk = RK[row], rq = RQ[row];
#pragma unroll
                for (int nt = 0; nt < 4; ++nt) {
                    const int col = 16 * nt + fr;
                    const float d = col <= row ? gr - Gs[col] : 0.f;
                    const float e = __expf(d), rkc = RK[col];
                    Am[row * 64 + col] = col < row ? br * kk[nt][i] * rk * rkc * e : 0.f;
                    QKr[row * 64 + kperm(col)] = f2b(col <= row ? qk[nt][i] * rq * rkc * QSCALE * e : 0.f);
                }
            }
        }
        __syncthreads();
        if (t8 < 128) {
            bf16* Qg = (bf16*)(rec + R_QG) + kperm(t8);
#pragma unroll
            for (int r = 0; r < 64; ++r) Qg[r * 128] = f2b(va[r] * RQ[r] * QSCALE * EG[r]);
            {
                const int col = 1024 + h * 128 + t8;
                float h0 = 0.f, h1 = 0.f, h2 = 0.f;
                if (sample) { const float* cc = a.in[2] + (size_t)bidx * 3 * 1536 + col; h0 = cc[0]; h1 = cc[1536]; h2 = cc[2 * 1536]; }
                else if (!first) { const bf16* pp = P + (size_t)(row0 - 3) * PW + col; h0 = b2f(pp[0]); h1 = b2f(pp[PW]); h2 = b2f(pp[2 * PW]); }
                float* outp = lastc ? a.out + (sample ? O_SDC : O_PDC) + (size_t)bidx * 3 * 1536 + col : nullptr;
                conv_col(P + (size_t)row0 * PW + col, h0, h1, h2, cwt + col, nrows, outp, va);
            }
#pragma unroll
            for (int r = 0; r < 64; ++r) va[r] = va[r] * Bs[r];
        } else {
            const int c = t8 - 128;
            const float gl = Gs[63];
            unsigned w[32];
#pragma unroll
            for (int r = 0; r < 64; r += 2) w[kperm(r) >> 1] = pk2(va[r] * RK[r] * __expf(gl - Gs[r]), va[r + 1] * RK[r + 1] * __expf(gl - Gs[r + 1]));
            u32x4* dst = (u32x4*)(rec + R_KDT + c * 128);
#pragma unroll
            for (int j = 0; j < 8; ++j) dst[j] = (u32x4){w[4 * j], w[4 * j + 1], w[4 * j + 2], w[4 * j + 3]};
#pragma unroll
            for (int r = 0; r < 64; ++r) va[r] = va[r] * RK[r] * Bs[r] * EG[r];
        }
#if SOLVE_RL
        {
            float arow[64];
#pragma unroll
            for (int i = 1; i < 64; ++i) arow[i] = Am[i * 64 + lane];
#pragma unroll
            for (int i = 1; i < 64; ++i) {
                if (i < nrows) {
                    float acc0 = va[i], acc1 = 0.f;
#pragma unroll
                    for (int j = 0; j < i; ++j) { const float aij = __int_as_float(__builtin_amdgcn_readlane(__float_as_int(arow[i]), j)); if (j & 1) acc1 -= aij * va[j]; else acc0 -= aij * va[j]; }
                    va[i] = acc0 + acc1;
                }
            }
        }
#else
#pragma unroll
        for (int i = 1; i < 64; ++i) {
            float acc = va[i];
            const f32x4* Ar = (const f32x4*)(Am + i * 64);
#pragma unroll
            for (int j4 = 0; j4 < (i + 3) / 4; ++j4) {
                const f32x4 av = Ar[j4];
#pragma unroll
                for (int e = 0; e < 4; ++e) if (4 * j4 + e < i) acc -= av[e] * va[4 * j4 + e];
            }
            va[i] = acc;
        }
#endif
        if (t8 < 128) { bf16* U0 = (bf16*)(rec + R_U0) + t8;
#pragma unroll
            for (int r = 0; r < 64; ++r) U0[r * 128] = f2b(va[r]);
        } else { bf16* Wn = (bf16*)(rec + R_WN) + kperm(t8 - 128);
#pragma unroll
            for (int r = 0; r < 64; ++r) Wn[r * 128] = f2b(-va[r]);
        }
        __syncthreads();
    }
}

struct S5W { float lr[4], li[4]; bf16x8 bf[8]; };
DI void s5w_setup(const Args& a, int g, int fr, int fq, S5W& w) {
    const float dt = __expf(a.in[15][g]);
#pragma unroll
    for (int j = 0; j < 4; ++j) {
        const int p = 16 * j + fr;
        const float are = a.in[13][g * 64 + p], aim = a.in[14][g * 64 + p];
        const float mag = __expf(are * dt), ang = aim * dt;
        float sn, cs; sincosf(ang, &sn, &cs);
        const float lr = mag * cs, li = mag * sn;
        w.lr[j] = lr; w.li[j] = li;
        const float den = are * are + aim * aim;
        const float fre = ((lr - 1.f) * are + li * aim) / den, fim = (li * are - (lr - 1.f) * aim) / den;
        u32x4 wr = (u32x4){0u, 0u, 0u, 0u}, wi = (u32x4){0u, 0u, 0u, 0u};
        if (fq < 2) {
            const f32x4* br = (const f32x4*)(a.in[16] + (size_t)(g * 64 + p) * 16 + 8 * fq); const f32x4* bi = (const f32x4*)(a.in[17] + (size_t)(g * 64 + p) * 16 + 8 * fq);
            const f32x4 r0 = br[0], r1 = br[1], i0 = bi[0], i1 = bi[1];
            wr.x = pk2(fre * r0[0] - fim * i0[0], fre * r0[1] - fim * i0[1]); wr.y = pk2(fre * r0[2] - fim * i0[2], fre * r0[3] - fim * i0[3]);
            wr.z = pk2(fre * r1[0] - fim * i1[0], fre * r1[1] - fim * i1[1]); wr.w = pk2(fre * r1[2] - fim * i1[2], fre * r1[3] - fim * i1[3]);
            wi.x = pk2(fre * i0[0] + fim * r0[0], fre * i0[1] + fim * r0[1]); wi.y = pk2(fre * i0[2] + fim * r0[2], fre * i0[3] + fim * r0[3]);
            wi.z = pk2(fre * i1[0] + fim * r1[0], fre * i1[1] + fim * r1[1]); wi.w = pk2(fre * i1[2] + fim * r1[2], fre * i1[3] + fim * r1[3]);
        }
        w.bf[j] = __builtin_bit_cast(bf16x8, wr); w.bf[4 + j] = __builtin_bit_cast(bf16x8, wi);
    }
}
DI bf16x8 s5w_uload(const bf16* P, size_t row0, int SS, int ms, int g, int fr, int fq) {
    u32x4 v = (u32x4){0u, 0u, 0u, 0u};
    if (fq < 2) v = *(const u32x4*)(P + (row0 + (size_t)(fr >> 2) * SS + 4 * ms + (fr & 3)) * PW + 2048 + g * 16 + 8 * fq);
    return __builtin_bit_cast(bf16x8, v);
}
DI void s5w_step(const S5W& w, bf16x8 ua, float (&xr)[4], float (&xi)[4], unsigned (&xo)[4][4]) {
    f32x4 br[4], bi[4];
    const f32x4 z = (f32x4){0.f, 0.f, 0.f, 0.f};
#pragma unroll
    for (int j = 0; j < 4; ++j) { br[j] = MFMA16(ua, w.bf[j], z); bi[j] = MFMA16(ua, w.bf[4 + j], z); }
#pragma unroll
    for (int i = 0; i < 4; ++i)
#pragma unroll
        for (int j = 0; j < 4; ++j) {
            const float nr = w.lr[j] * xr[j] - w.li[j] * xi[j] + br[j][i], ni = w.lr[j] * xi[j] + w.li[j] * xr[j] + bi[j][i];
            xr[j] = nr; xi[j] = ni; xo[i][j] = pk2(nr, ni);
        }
#pragma unroll
    for (int j = 0; j < 8; ++j) asm volatile("" :: "v"(w.bf[j]));
    asm volatile("" :: "v"(ua));
}
DI void s5_pass1(const Args& a, int gw, int NGW, int lane) {
    asm volatile("" : "+v"(lane));
    const bf16* P = (const bf16*)(a.ws + WS_P);
    float* E = (float*)(a.ws + WS_S5E);
    const int fr = lane & 15, fq = lane >> 4;
    for (int unit = gw; unit < 4 * 32 * 16; unit += NGW) {
        const int sg = unit & 15, bg = unit >> 4, g = bg & 31, b = bg >> 5;
        S5W w; s5w_setup(a, g, fr, fq, w);
        float xr[4] = {0.f, 0.f, 0.f, 0.f}, xi[4] = {0.f, 0.f, 0.f, 0.f}; unsigned xo[4][4];
        const size_t row0 = (size_t)b * 8192 + sg * 512;
        bf16x8 ua = s5w_uload(P, row0, 128, 0, g, fr, fq);
        for (int ms = 0; ms < 32; ++ms) {
            const bf16x8 un = s5w_uload(P, row0, 128, ms + 1 < 32 ? ms + 1 : ms, g, fr, fq);
            s5w_step(w, ua, xr, xi, xo); ua = un;
        }
        float* e = E + ((size_t)bg * 64 + 4 * sg + fq) * 128;
#pragma unroll
        for (int j = 0; j < 4; ++j) { e[16 * j + fr] = xr[j]; e[64 + 16 * j + fr] = xi[j]; }
    }
}
DI void s5w_run(const Args& a, const S5W& w, const bf16x8 (&cf)[4], float Dg, unsigned char* xs, size_t row0, int SS, int nms, int g, int fr, int fq, float (&xr)[4], float (&xi)[4]) {
    const bf16* P = (const bf16*)(a.ws + WS_P);
    bf16* Y5 = (bf16*)(a.ws + WS_Y5);
    bf16x8 ua = s5w_uload(P, row0, SS, 0, g, fr, fq);
    for (int ms = 0; ms < nms; ++ms) {
        const bf16x8 un = s5w_uload(P, row0, SS, ms + 1 < nms ? ms + 1 : ms, g, fr, fq);
        float uu[4];
#pragma unroll
        for (int i = 0; i < 4; ++i) uu[i] = b2f(P[(row0 + (size_t)fq * SS + 4 * ms + i) * PW + 2048 + g * 16 + fr]);
        unsigned xo[4][4];
        s5w_step(w, ua, xr, xi, xo); ua = un;
#pragma unroll
        for (int i = 0; i < 4; ++i)
#pragma unroll
            for (int j = 0; j < 4; ++j) *(unsigned*)(xs + (4 * fq + i) * 272 + (16 * j + fr) * 4) = xo[i][j];
        asm volatile("s_waitcnt lgkmcnt(0)" ::: "memory");
        f32x4 y = (f32x4){0.f, 0.f, 0.f, 0.f};
        bf16x8 af[4];
#pragma unroll
        for (int ks = 0; ks < 4; ++ks) af[ks] = *(const bf16x8*)(xs + fr * 272 + ks * 64 + fq * 16);
        asm volatile("" ::: "memory");
#pragma unroll
        for (int ks = 0; ks < 4; ++ks) y = MFMA16(af[ks], cf[ks], y);
#if DIAG_Y
        {
            const float* cre = a.in[18] + (size_t)(g * 16 + fr) * 64; const float* cim = a.in[19] + (size_t)(g * 16 + fr) * 64;
#pragma unroll
            for (int i = 0; i < 4; ++i) { float acc = 0.f;
                for (int p = 0; p < 64; ++p) { const unsigned wv = *(const unsigned*)(xs + (4 * fq + i) * 272 + p * 4); acc += cre[p] * blo(wv) - cim[p] * bhi(wv); }
                y[i] = acc; }
        }
#endif
        asm volatile("" :: "v"(y));
#pragma unroll
        for (int ks = 0; ks < 4; ++ks) asm volatile("" :: "v"(af[ks]), "v"(cf[ks]));
#pragma unroll
        for (int i = 0; i < 4; ++i) {
            const size_t row = row0 + (size_t)fq * SS + 4 * ms + i;
            Y5[row * 512 + g * 16 + fr] = f2b(gelu_tanh(y[i] + Dg * uu[i]));
        }
    }
}
DI void s5_cfrag(const Args& a, int g, int fr, int fq, bf16x8 (&cf)[4]) {
#pragma unroll
    for (int ks = 0; ks < 4; ++ks) {
        const f32x4 cr = *(const f32x4*)(a.in[18] + (size_t)(g * 16 + fr) * 64 + 16 * ks + 4 * fq), ci = *(const f32x4*)(a.in[19] + (size_t)(g * 16 + fr) * 64 + 16 * ks + 4 * fq);
        u32x4 w; w.x = pk2(cr[0], -ci[0]); w.y = pk2(cr[1], -ci[1]); w.z = pk2(cr[2], -ci[2]); w.w = pk2(cr[3], -ci[3]);
        cf[ks] = __builtin_bit_cast(bf16x8, w);
    }
}
DI void s5_pass2_prompt(const Args& a, unsigned char* lds, int bg, int tid) {
    asm volatile("" : "+v"(tid));
    const int wave = __builtin_amdgcn_readfirstlane(tid >> 6), lane = tid & 63, fr = lane & 15, fq = lane >> 4;
    const int b = bg >> 5, g4 = (bg >> 2) & 7, part = bg & 3, g = 4 * g4 + (wave & 3);
    bg = b * 32 + g;
    unsigned char* xs = lds + wave * 4352;
    S5W w; s5w_setup(a, g, fr, fq, w);
    bf16x8 cf[4]; s5_cfrag(a, g, fr, fq, cf);
    const float Dg = a.in[20][g * 16 + fr];
    float pr[4], pi[4];
#pragma unroll
    for (int j = 0; j < 4; ++j) { pr[j] = w.lr[j]; pi[j] = w.li[j];
#pragma unroll
        for (int s = 0; s < 7; ++s) { const float nr = pr[j] * pr[j] - pi[j] * pi[j], ni = 2.f * pr[j] * pi[j]; pr[j] = nr; pi[j] = ni; } }
    const float* e = (const float*)(a.ws + WS_S5E) + (size_t)bg * 64 * 128;
    for (int uu = 0; uu < 2; ++uu) {
        const int sg = 4 * part + 2 * (wave >> 2) + uu, seg = 4 * sg + fq;
        float xr[4] = {0.f, 0.f, 0.f, 0.f}, xi[4] = {0.f, 0.f, 0.f, 0.f};
        for (int s = 0; s < 4 * sg + 3; ++s) {
            if (s < seg) {
#pragma unroll
                for (int j = 0; j < 4; ++j) { const float er = e[s * 128 + 16 * j + fr], ei = e[s * 128 + 64 + 16 * j + fr];
                    const float nr = pr[j] * xr[j] - pi[j] * xi[j] + er, ni = pr[j] * xi[j] + pi[j] * xr[j] + ei; xr[j] = nr; xi[j] = ni; }
            }
        }
        s5w_run(a, w, cf, Dg, xs, (size_t)b * 8192 + sg * 512, 128, 32, g, fr, fq, xr, xi);
        if (seg == 63) {
#pragma unroll
            for (int j = 0; j < 4; ++j) { a.out[O_PSR + (size_t)bg * 64 + 16 * j + fr] = xr[j]; a.out[O_PSI + (size_t)bg * 64 + 16 * j + fr] = xi[j]; }
        }
    }
}
DI void s5_pass2_sample(const Args& a, unsigned char* xs, int gw, int NGW, int lane) {
    asm volatile("" : "+v"(lane));
    const int fr = lane & 15, fq = lane >> 4;
    for (int unit = gw; unit < 256; unit += NGW) {
        const int g = unit & 31, q = unit >> 5, sb = 4 * q + fq;
        S5W w; s5w_setup(a, g, fr, fq, w);
        bf16x8 cf[4]; s5_cfrag(a, g, fr, fq, cf);
        const float Dg = a.in[20][g * 16 + fr];
        float xr[4], xi[4];
#pragma unroll
        for (int j = 0; j < 4; ++j) { xr[j] = a.in[4][(size_t)(sb * 32 + g) * 64 + 16 * j + fr]; xi[j] = a.in[5][(size_t)(sb * 32 + g) * 64 + 16 * j + fr]; }
        s5w_run(a, w, cf, Dg, xs, (size_t)TP + (size_t)q * 64, 16, 4, g, fr, fq, xr, xi);
#pragma unroll
        for (int j = 0; j < 4; ++j) { a.out[O_SSR + (size_t)(sb * 32 + g) * 64 + 16 * j + fr] = xr[j]; a.out[O_SSI + (size_t)(sb * 32 + g) * 64 + 16 * j + fr] = xi[j]; }
    }
}

struct S5Par { float lr, li; float bbr[16], bbi[16]; };
DI void s5_setup(const Args& a, int g, int p, S5Par& q) {
    const float are = a.in[13][g * 64 + p], aim = a.in[14][g * 64 + p], dt = __expf(a.in[15][g]);
    const float mag = __expf(are * dt), ang = aim * dt;
    float sn, cs; sincosf(ang, &sn, &cs);
    q.lr = mag * cs; q.li = mag * sn;
    const float den = are * are + aim * aim;
    const float fre = ((q.lr - 1.f) * are + q.li * aim) / den, fim = (q.li * are - (q.lr - 1.f) * aim) / den;
    const f32x4* br = (const f32x4*)(a.in[16] + (size_t)(g * 64 + p) * 16); const f32x4* bi = (const f32x4*)(a.in[17] + (size_t)(g * 64 + p) * 16);
#pragma unroll
    for (int j = 0; j < 4; ++j) { const f32x4 r = br[j], i = bi[j];
#pragma unroll
        for (int e = 0; e < 4; ++e) { q.bbr[4 * j + e] = fre * r[e] - fim * i[e]; q.bbi[4 * j + e] = fre * i[e] + fim * r[e]; } }
}
DI void s5_step4(const S5Par& q, float uv, float& xr, float& xi, unsigned (&xo)[4]) {
#pragma unroll
    for (int j = 0; j < 4; ++j) {
        float br = 0.f, bi = 0.f;
#pragma unroll
        for (int h = 0; h < 16; ++h) { const float uh = __int_as_float(__builtin_amdgcn_readlane(__float_as_int(uv), 16 * j + h)); br += q.bbr[h] * uh; bi += q.bbi[h] * uh; }
        const float nr = q.lr * xr - q.li * xi + br, ni = q.lr * xi + q.li * xr + bi;
        xr = nr; xi = ni; xo[j] = pk2(xr, xi);
    }
}
DI void old_s5_pass1(const Args& a, int gw, int NGW, int lane) {
    asm volatile("" : "+v"(lane));
    const bf16* P = (const bf16*)(a.ws + WS_P);
    float* E = (float*)(a.ws + WS_S5E);
    for (int unit = gw; unit < 4 * 32 * 64; unit += NGW) {
        const int seg = unit & 63, bg = unit >> 6, g = bg & 31, b = bg >> 5;
        S5Par q; s5_setup(a, g, lane, q);
        float xr = 0.f, xi = 0.f; unsigned xo[4];
        const bf16* up = P + (size_t)(b * 8192 + seg * 128 + (lane >> 4)) * PW + 2048 + g * 16 + (lane & 15);
#pragma unroll 2
        for (int t = 0; t < 128; t += 4) { const float uv = b2f(up[(size_t)t * PW]); s5_step4(q, uv, xr, xi, xo); }
        float* e = E + ((size_t)bg * 64 + seg) * 128;
        e[lane] = xr; e[64 + lane] = xi;
    }
}
DI void old_s5_pass2(const Args& a, unsigned char* xs  , int gw, int NGW, int lane) {
    asm volatile("" : "+v"(lane));
    const bf16* P = (const bf16*)(a.ws + WS_P);
    const float* E = (const float*)(a.ws + WS_S5E);
    bf16* Y5 = (bf16*)(a.ws + WS_Y5);
    const int fr = lane & 15, fq = lane >> 4;
    for (int unit = gw; unit < OLD_S5_ULIM; unit += NGW) {
        int g, row0, ntok, seg = 0, bg; bool sample;
        if (unit < 8192) { seg = unit & 63; bg = unit >> 6; g = bg & 31; row0 = (bg >> 5) * 8192 + seg * 128; ntok = 128; sample = false; }
        else { bg = unit - 8192; g = bg & 31; row0 = TP + (bg >> 5) * 16; ntok = 16; sample = true; }
        S5Par q; s5_setup(a, g, lane, q);
        float xr = 0.f, xi = 0.f;
        if (sample) { xr = a.in[4][(size_t)bg * 64 + lane]; xi = a.in[5][(size_t)bg * 64 + lane]; }
        else {
            float pr = q.lr, pi = q.li;
#pragma unroll
            for (int s = 0; s < 7; ++s) { const float nr = pr * pr - pi * pi, ni = 2.f * pr * pi; pr = nr; pi = ni; }
            const float* e = E + (size_t)bg * 64 * 128;
            for (int s = 0; s < seg; ++s) { const float er = e[s * 128 + lane], ei = e[s * 128 + 64 + lane]; const float nr = pr * xr - pi * xi + er, ni = pr * xi + pi * xr + ei; xr = nr; xi = ni; }
        }
        bf16x8 cf[4];
#pragma unroll
        for (int ks = 0; ks < 4; ++ks) {
            const f32x4 cr = *(const f32x4*)(a.in[18] + (size_t)(g * 16 + fr) * 64 + 16 * ks + 4 * fq), ci = *(const f32x4*)(a.in[19] + (size_t)(g * 16 + fr) * 64 + 16 * ks + 4 * fq);
            u32x4 w; w.x = pk2(cr[0], -ci[0]); w.y = pk2(cr[1], -ci[1]); w.z = pk2(cr[2], -ci[2]); w.w = pk2(cr[3], -ci[3]);
            cf[ks] = __builtin_bit_cast(bf16x8, w);
        }
        const float Dg = a.in[20][g * 16 + fr];
        const bf16* up = P + (size_t)(row0 + (lane >> 4)) * PW + 2048 + g * 16 + (lane & 15);
        for (int tb = 0; tb < ntok; tb += 16) {
#pragma unroll
            for (int j4 = 0; j4 < 4; ++j4) {
                const float uv = b2f(up[(size_t)(tb + 4 * j4) * PW]);
                unsigned xo[4]; s5_step4(q, uv, xr, xi, xo);
#pragma unroll
                for (int j = 0; j < 4; ++j) *(unsigned*)(xs + (4 * j4 + j) * 272 + lane * 4) = xo[j];
            }
            f32x4 y = (f32x4){0.f, 0.f, 0.f, 0.f};
#pragma unroll
            for (int ks = 0; ks < 4; ++ks) { const bf16x8 af = *(const bf16x8*)(xs + fr * 272 + ks * 64 + fq * 16); y = MFMA16(af, cf[ks], y); }
#pragma unroll
            for (int i = 0; i < 4; ++i) {
                const size_t row = (size_t)row0 + tb + 4 * fq + i;
                const float uu = b2f(P[row * PW + 2048 + g * 16 + fr]);
                Y5[row * 512 + g * 16 + fr] = f2b(gelu_tanh(y[i] + Dg * uu));
            }
        }
        if (sample) { a.out[O_SSR + (size_t)bg * 64 + lane] = xr; a.out[O_SSI + (size_t)bg * 64 + lane] = xi; }
        else if (seg == 63) { a.out[O_PSR + (size_t)bg * 64 + lane] = xr; a.out[O_PSI + (size_t)bg * 64 + lane] = xi; }
    }
}

DI void s5_pass2b(const Args& a, unsigned char* xs, int gw, int NGW, int lane) {
    asm volatile("" : "+v"(lane));
    const bf16* P = (const bf16*)(a.ws + WS_P);
    const float* E = (const float*)(a.ws + WS_S5E);
    bf16* Y5 = (bf16*)(a.ws + WS_Y5);
    const int fr = lane & 15, fq = lane >> 4;
    for (int unit = gw; unit < 4 * 32 * 64 + 32 * 32; unit += NGW) {
        int g, row0, ntok, seg = 0, bg; bool sample;
        if (unit < 8192) { seg = unit & 63; bg = unit >> 6; g = bg & 31; row0 = (bg >> 5) * 8192 + seg * 128; ntok = 128; sample = false; }
        else { bg = unit - 8192; g = bg & 31; row0 = TP + (bg >> 5) * 16; ntok = 16; sample = true; }
        S5Par q; s5_setup(a, g, lane, q);
        float xr = 0.f, xi = 0.f;
        if (sample) { xr = a.in[4][(size_t)bg * 64 + lane]; xi = a.in[5][(size_t)bg * 64 + lane]; }
        else {
            float pr = q.lr, pi = q.li;
#pragma unroll
            for (int s = 0; s < 7; ++s) { const float nr = pr * pr - pi * pi, ni = 2.f * pr * pi; pr = nr; pi = ni; }
            const float* e = E + (size_t)bg * 64 * 128;
            for (int s = 0; s < seg; ++s) { const float er = e[s * 128 + lane], ei = e[s * 128 + 64 + lane]; const float nr = pr * xr - pi * xi + er, ni = pr * xi + pi * xr + ei; xr = nr; xi = ni; }
        }
        bf16x8 cf[4];
#pragma unroll
        for (int ks = 0; ks < 4; ++ks) {
            const f32x4 cr = *(const f32x4*)(a.in[18] + (size_t)(g * 16 + fr) * 64 + 16 * ks + 4 * fq), ci = *(const f32x4*)(a.in[19] + (size_t)(g * 16 + fr) * 64 + 16 * ks + 4 * fq);
            u32x4 w; w.x = pk2(cr[0], -ci[0]); w.y = pk2(cr[1], -ci[1]); w.z = pk2(cr[2], -ci[2]); w.w = pk2(cr[3], -ci[3]);
            cf[ks] = __builtin_bit_cast(bf16x8, w);
        }
        const float Dg = a.in[20][g * 16 + fr];
        S5W w; s5w_setup(a, g, fr, fq, w);
        unsigned char* bt = xs + 4352;
        for (int tb = 0; tb < ntok; tb += 16) {
            {
                u32x4 uv = (u32x4){0u, 0u, 0u, 0u};
                if (fq < 2) uv = *(const u32x4*)(P + (size_t)(row0 + tb + fr) * PW + 2048 + g * 16 + 8 * fq);
                const bf16x8 ua = __builtin_bit_cast(bf16x8, uv);
                const f32x4 z = (f32x4){0.f, 0.f, 0.f, 0.f};
#pragma unroll
                for (int j = 0; j < 4; ++j) {
                    const f32x4 br = MFMA16(ua, w.bf[j], z), bi = MFMA16(ua, w.bf[4 + j], z);
                    *(f32x4*)(bt + (16 * j + fr) * 80 + fq * 16) = br; *(f32x4*)(bt + (64 + 16 * j + fr) * 80 + fq * 16) = bi;
                }
            }
            asm volatile("s_waitcnt lgkmcnt(0)" ::: "memory");
            f32x4 bre[4], bim[4];
#pragma unroll
            for (int k = 0; k < 4; ++k) { bre[k] = *(const f32x4*)(bt + lane * 80 + k * 16); bim[k] = *(const f32x4*)(bt + (64 + lane) * 80 + k * 16); }
            asm volatile("s_waitcnt lgkmcnt(0)" ::: "memory");
#pragma unroll
            for (int t = 0; t < 16; ++t) {
                const float nr = q.lr * xr - q.li * xi + bre[t >> 2][t & 3], ni = q.lr * xi + q.li * xr + bim[t >> 2][t & 3];
                xr = nr; xi = ni;
                *(unsigned*)(xs + t * 272 + lane * 4) = pk2(nr, ni);
            }
            asm volatile("s_waitcnt lgkmcnt(0)" ::: "memory");
            f32x4 y = (f32x4){0.f, 0.f, 0.f, 0.f};
#pragma unroll
            for (int ks = 0; ks < 4; ++ks) { const bf16x8 af = *(const bf16x8*)(xs + fr * 272 + ks * 64 + fq * 16); y = MFMA16(af, cf[ks], y); }
#pragma unroll
            for (int i = 0; i < 4; ++i) {
                const size_t row = (size_t)row0 + tb + 4 * fq + i;
                const float uu = b2f(P[row * PW + 2048 + g * 16 + fr]);
                Y5[row * 512 + g * 16 + fr] = f2b(gelu_tanh(y[i] + Dg * uu));
            }
        }
        if (sample) { a.out[O_SSR + (size_t)bg * 64 + lane] = xr; a.out[O_SSI + (size_t)bg * 64 + lane] = xi; }
        else if (seg == 63) { a.out[O_PSR + (size_t)bg * 64 + lane] = xr; a.out[O_PSI + (size_t)bg * 64 + lane] = xi; }
    }
}

constexpr int DB_WN = 0, DB_QG = 17408, DB_KDT = 34816, DB_QK = 53248, DB_U0 = 62464;
constexpr int DBP_SIZE = DB_U0 + 64 * 80;
constexpr int DBS_SIZE = DB_U0 + 64 * 272;
template <int NC> struct DnRegs { u32x4 r[7]; u32x4 u[NC == 32 ? 1 : 2]; };
template <int NC> DI void dn_load(const unsigned char* rec, int tid, int c0, DnRegs<NC>& R) {
    const u32x4* g = (const u32x4*)rec;
    R.r[0] = g[tid]; R.r[1] = g[tid + 512]; R.r[2] = g[1024 + tid]; R.r[3] = g[1024 + tid + 512]; R.r[4] = g[2048 + tid]; R.r[5] = g[2048 + tid + 512]; R.r[6] = g[3072 + tid];
    if (NC == 32) { if (tid < 256) R.u[0] = *(const u32x4*)(rec + R_U0 + (tid >> 2) * 256 + c0 * 2 + (tid & 3) * 16); }
    else { R.u[0] = *(const u32x4*)(rec + R_U0 + tid * 16); R.u[1] = *(const u32x4*)(rec + R_U0 + (tid + 512) * 16); }
}
template <int NC> DI void dn_store(unsigned char* buf, int tid, const DnRegs<NC>& R) {
#pragma unroll
    for (int j = 0; j < 2; ++j) { const int q = tid + 512 * j;
        *(u32x4*)(buf + DB_WN + (q >> 4) * 272 + (q & 15) * 16) = R.r[j];
        *(u32x4*)(buf + DB_QG + (q >> 4) * 272 + (q & 15) * 16) = R.r[2 + j];
        *(u32x4*)(buf + DB_KDT + (q >> 3) * 144 + (q & 7) * 16) = R.r[4 + j]; }
    *(u32x4*)(buf + DB_QK + (tid >> 3) * 144 + (tid & 7) * 16) = R.r[6];
    if (NC == 32) { if (tid < 256) *(u32x4*)(buf + DB_U0 + (tid >> 2) * 80 + (tid & 3) * 16) = R.u[0]; }
    else {
#pragma unroll
        for (int j = 0; j < 2; ++j) { const int q = tid + 512 * j; *(u32x4*)(buf + DB_U0 + (q >> 4) * 272 + (q & 15) * 16) = R.u[j]; }
    }
}
DI bf16x8 pack8(const f32x4& lo, const f32x4& hi) { u32x4 w; w.x = pk2(lo[0], lo[1]); w.y = pk2(lo[2], lo[3]); w.z = pk2(hi[0], hi[1]); w.w = pk2(hi[2], hi[3]); return __builtin_bit_cast(bf16x8, w); }
template <int UPI> DI void dn_step(const unsigned char* buf, f32x4 (&S)[8], const unsigned char* u0, float eg, int fr, int fq, f32x4 (&o)[4]) {
    bf16x8 Sb[4];
#pragma unroll
    for (int ks = 0; ks < 4; ++ks) Sb[ks] = pack8(S[2 * ks], S[2 * ks + 1]);
    f32x4 u[4];
#pragma unroll
    for (int mt = 0; mt < 4; ++mt) {
#pragma unroll
        for (int i = 0; i < 4; ++i) u[mt][i] = b2f(*(const bf16*)(u0 + (16 * mt + 4 * fq + i) * UPI));
#pragma unroll
        for (int ks = 0; ks < 4; ++ks) u[mt] = MFMA16(*(const bf16x8*)(buf + DB_WN + (16 * mt + fr) * 272 + ks * 64 + fq * 16), Sb[ks], u[mt]);
    }
    bf16x8 ub[2];
#pragma unroll
    for (int k2 = 0; k2 < 2; ++k2) ub[k2] = pack8(u[2 * k2], u[2 * k2 + 1]);
#pragma unroll
    for (int mt = 0; mt < 4; ++mt) {
        o[mt] = (f32x4){0.f, 0.f, 0.f, 0.f};
#pragma unroll
        for (int ks = 0; ks < 4; ++ks) o[mt] = MFMA16(*(const bf16x8*)(buf + DB_QG + (16 * mt + fr) * 272 + ks * 64 + fq * 16), Sb[ks], o[mt]);
#pragma unroll
        for (int k2 = 0; k2 < 2; ++k2) o[mt] = MFMA16(*(const bf16x8*)(buf + DB_QK + (16 * mt + fr) * 144 + k2 * 64 + fq * 16), ub[k2], o[mt]);
    }
#pragma unroll
    for (int m8 = 0; m8 < 8; ++m8) {
        S[m8] = S[m8] * eg;
#pragma unroll
        for (int k2 = 0; k2 < 2; ++k2) S[m8] = MFMA16(*(const bf16x8*)(buf + DB_KDT + (16 * m8 + fr) * 144 + k2 * 64 + fq * 16), ub[k2], S[m8]);
    }
}
DI void dn_scan_prompt(const Args& a, unsigned char* lds, int tid) {
    asm volatile("" : "+v"(tid));
    const int wave = __builtin_amdgcn_readfirstlane(tid >> 6), lane = tid & 63, fr = lane & 15, fq = lane >> 4;
    const int bh = blockIdx.x >> 2, qt = blockIdx.x & 3, b = bh >> 2, h = bh & 3;
    const int c0 = qt * 32, v0 = c0 + (wave & 1) * 16;
    const unsigned char* recs = a.ws + WS_DNC + (size_t)bh * 128 * REC;
    const float* egs = (const float*)(a.ws + WS_EG) + bh * 128;
    float* ORAW = (float*)(a.ws + WS_H);
    f32x4 S[8];
#pragma unroll
    for (int m8 = 0; m8 < 8; ++m8) S[m8] = (f32x4){0.f, 0.f, 0.f, 0.f};
    DnRegs<32> RA, RB;
    dn_load<32>(recs, tid, c0, RA); dn_store<32>(lds, tid, RA);
    dn_load<32>(recs + REC, tid, c0, RB);
    float eg0 = egs[0], eg1 = egs[1];
    __syncthreads();
#define DN_BODY(n, RL, RS) do { \
        const int n_ = (n); \
        if (n_ + 2 < 128) dn_load<32>(recs + (size_t)(n_ + 2) * REC, tid, c0, RL); \
        const float egn = n_ + 2 < 128 ? egs[n_ + 2] : 0.f; \
        if (wave < 2) { \
            f32x4 o[4]; \
            dn_step<80>(lds + (n_ & 1) * DBP_SIZE, S, lds + (n_ & 1) * DBP_SIZE + DB_U0 + ((wave & 1) * 16 + fr) * 2, eg0, fr, fq, o); \
            float* op = ORAW + (size_t)(b * 8192 + n_ * 64) * 512 + h * 128 + v0 + fr; \
            _Pragma("unroll") for (int mt = 0; mt < 4; ++mt) _Pragma("unroll") for (int i = 0; i < 4; ++i) op[(size_t)(16 * mt + 4 * fq + i) * 512] = o[mt][i]; \
        } \
        if (n_ + 1 < 128) dn_store<32>(lds + ((n_ + 1) & 1) * DBP_SIZE, tid, RS); \
        eg0 = eg1; eg1 = egn; \
        __syncthreads(); } while (0)
    for (int n = 0; n < 128; n += 2) { DN_BODY(n, RA, RB); DN_BODY(n + 1, RB, RA); }
#undef DN_BODY
    if (wave < 2) {
        float* so = a.out + O_PDS + (size_t)bh * 128 * 128 + v0 + fr;
#pragma unroll
        for (int m8 = 0; m8 < 8; ++m8)
#pragma unroll
            for (int i = 0; i < 4; ++i) so[(16 * m8 + 4 * fq + i) * 128] = S[m8][i];
    }
}
DI void dn_scan_sample(const Args& a, unsigned char* lds, int tid, int wg, int nwg) {
    asm volatile("" : "+v"(tid));
    const int wave = __builtin_amdgcn_readfirstlane(tid >> 6), lane = tid & 63, fr = lane & 15, fq = lane >> 4;
    const int v0 = wave * 16;
    float* ORAW = (float*)(a.ws + WS_H);
    for (int su = wg; su < 128; su += nwg) {
        const int sb = su >> 2, h = su & 3;
        const unsigned char* rec = a.ws + WS_DNC + (size_t)(2048 + su) * REC;
        DnRegs<128> R; dn_load<128>(rec, tid, 0, R); dn_store<128>(lds, tid, R);
        __syncthreads();
        f32x4 S[8];
        const float* s0 = a.in[3] + (size_t)su * 128 * 128 + v0 + fr;
#pragma unroll
        for (int m8 = 0; m8 < 8; ++m8)
#pragma unroll
            for (int i = 0; i < 4; ++i) S[m8][i] = s0[(16 * m8 + 4 * fq + i) * 128];
        f32x4 o[4];
        dn_step<272>(lds, S, lds + DB_U0 + (v0 + fr) * 2, ((const float*)(a.ws + WS_EG))[2048 + su], fr, fq, o);
        float* op = ORAW + (size_t)(TP + sb * 16) * 512 + h * 128 + v0 + fr;
#pragma unroll
        for (int i = 0; i < 4; ++i) op[(size_t)(4 * fq + i) * 512] = o[0][i];
        float* so = a.out + O_SDS + (size_t)su * 128 * 128 + v0 + fr;
#pragma unroll
        for (int m8 = 0; m8 < 8; ++m8)
#pragma unroll
            for (int i = 0; i < 4; ++i) so[(16 * m8 + 4 * fq + i) * 128] = S[m8][i];
        __syncthreads();
    }
}

DI void mix_phase(const Args& a, int gw, int NGW, int lane) {
    asm volatile("" : "+v"(lane));
    const float* ORAW = (const float*)(a.ws + WS_H);
    const bf16* P = (const bf16*)(a.ws + WS_P);
    const bf16* GLU = (const bf16*)(a.ws + WS_GLU);
    bf16* MIX = (bf16*)(a.ws + WS_DNC);
    const f32x2 dg = *(const f32x2*)(a.in[12] + 2 * lane);
    const f32x4 sg0 = *(const f32x4*)(a.in[23] + 8 * lane), sg1 = *(const f32x4*)(a.in[23] + 8 * lane + 4);
    for (int row = gw; row < T; row += NGW) {
#pragma unroll
        for (int h = 0; h < 4; ++h) {
            const f32x2 ov = *(const f32x2*)(ORAW + (size_t)row * 512 + h * 128 + 2 * lane);
            const float r = rsqrtf(wave_sum(ov.x * ov.x + ov.y * ov.y) * (1.f / 128.f) + EPS);
            const unsigned zz = *(const unsigned*)(P + (size_t)row * PW + 1536 + h * 128 + 2 * lane);
            *(unsigned*)(MIX + (size_t)row * DM + h * 128 + 2 * lane) = pk2(ov.x * r * dg.x * silu(blo(zz)), ov.y * r * dg.y * silu(bhi(zz)));
        }
        const u32x4 gv = *(const u32x4*)(GLU + (size_t)row * 512 + 8 * lane);
        float v[8] = {blo(gv.x), bhi(gv.x), blo(gv.y), bhi(gv.y), blo(gv.z), bhi(gv.z), blo(gv.w), bhi(gv.w)};
        float ss = 0.f;
#pragma unroll
        for (int e = 0; e < 8; ++e) ss += v[e] * v[e];
        const float r5 = rsqrtf(wave_sum(ss) * (1.f / 512.f) + EPS);
        u32x4 w; w.x = pk2(v[0] * r5 * sg0[0], v[1] * r5 * sg0[1]); w.y = pk2(v[2] * r5 * sg0[2], v[3] * r5 * sg0[3]);
        w.z = pk2(v[4] * r5 * sg1[0], v[5] * r5 * sg1[1]); w.w = pk2(v[6] * r5 * sg1[2], v[7] * r5 * sg1[3]);
        *(u32x4*)(MIX + (size_t)row * DM + 512 + 8 * lane) = w;
    }
}

DI void act_phase(const Args& a, int gtid, int NT) {
    asm volatile("" : "+v"(gtid));
    bf16* UP = (bf16*)(a.ws + WS_UP);
    const float* fw = a.in[27]; const float* fb = a.in[28];
    constexpr int NCG = DFF / 8;
    for (int item = gtid; item < (T / 16) * NCG; item += NT) {
        const int cg8 = item % NCG, rb = item / NCG, col = cg8 * 8, row0 = rb * 16;
        float w0[8], w1[8], w2[8], bb[8], g2[8], g1[8];
#pragma unroll
        for (int e = 0; e < 8; ++e) { w0[e] = fw[col + e]; w1[e] = fw[DFF + col + e]; w2[e] = fw[2 * DFF + col + e]; bb[e] = fb[col + e]; g2[e] = 0.f; g1[e] = 0.f; }
        const bool sample = row0 >= TP;
        float* outp = nullptr;
        if (sample) { const int sb = (row0 - TP) >> 4; const float* cc = a.in[6] + (size_t)sb * 2 * DFF + col;
#pragma unroll
            for (int e = 0; e < 8; ++e) { g2[e] = cc[e]; g1[e] = cc[DFF + e]; }
            outp = a.out + O_SFC + (size_t)sb * 2 * DFF + col;
        } else {
            if ((rb & 511) != 0) {
                const u32x4 x2 = *(const u32x4*)(UP + (size_t)(row0 - 2) * UPW + col), x1 = *(const u32x4*)(UP + (size_t)(row0 - 1) * UPW + col);
                g2[0] = blo(x2.x); g2[1] = bhi(x2.x); g2[2] = blo(x2.y); g2[3] = bhi(x2.y); g2[4] = blo(x2.z); g2[5] = bhi(x2.z); g2[6] = blo(x2.w); g2[7] = bhi(x2.w);
                g1[0] = blo(x1.x); g1[1] = bhi(x1.x); g1[2] = blo(x1.y); g1[3] = bhi(x1.y); g1[4] = blo(x1.z); g1[5] = bhi(x1.z); g1[6] = blo(x1.w); g1[7] = bhi(x1.w);
            }
            if ((rb & 511) == 511) outp = a.out + O_PFC + (size_t)(rb >> 9) * 2 * DFF + col;
        }
#pragma unroll 4
        for (int r = 0; r < 16; ++r) {
            bf16* gp = UP + (size_t)(row0 + r) * UPW + col;
            const u32x4 xg = *(const u32x4*)gp, xv = *(const u32x4*)(gp + DFF);
            float g0[8] = {blo(xg.x), bhi(xg.x), blo(xg.y), bhi(xg.y), blo(xg.z), bhi(xg.z), blo(xg.w), bhi(xg.w)};
            float vv[8] = {blo(xv.x), bhi(xv.x), blo(xv.y), bhi(xv.y), blo(xv.z), bhi(xv.z), blo(xv.w), bhi(xv.w)};
            float o[8];
#pragma unroll
            for (int e = 0; e < 8; ++e) { o[e] = silu(g2[e] * w0[e] + g1[e] * w1[e] + g0[e] * w2[e] + bb[e]) * vv[e]; g2[e] = g1[e]; g1[e] = g0[e]; }
            u32x4 w; w.x = pk2(o[0], o[1]); w.y = pk2(o[2], o[3]); w.z = pk2(o[4], o[5]); w.w = pk2(o[6], o[7]);
            *(u32x4*)(gp + DFF) = w;
            if (outp && r >= 14) {
#pragma unroll
                for (int e = 0; e < 8; ++e) outp[(r - 14) * DFF + e] = g0[e];
            }
        }
    }
}

DI void final_phase(const Args& a, int gw, int NGW, int lane) {
    asm volatile("" : "+v"(lane));
    f32x4 gv[4];
#pragma unroll
    for (int j = 0; j < 4; ++j) gv[j] = ((const f32x4*)a.in[30])[lane + 64 * j];
    for (int m = gw; m < T; m += NGW) {
        f32x4* xr = (f32x4*)(a.out + (size_t)m * DM) + lane;
        f32x4 v[4]; float s = 0.f;
#pragma unroll
        for (int j = 0; j < 4; ++j) { v[j] = xr[64 * j]; s += (v[j].x * v[j].x + v[j].y * v[j].y) + (v[j].z * v[j].z + v[j].w * v[j].w); }
        const float rstd = rsqrtf(wave_sum(s) * (1.f / DM) + EPS);
#pragma unroll
        for (int j = 0; j < 4; ++j) xr[64 * j] = v[j] * rstd * gv[j];
    }
}

#ifndef PH_MASK
#define PH_MASK 0xffff
#endif
#ifndef SOLVE_RL
#define SOLVE_RL 1
#endif
#ifndef REP0
#define REP0 1
#endif
#ifndef REP1
#define REP1 1
#endif
#ifndef REP2A
#define REP2A 1
#endif
#ifndef REP2B
#define REP2B 1
#endif
#ifndef REP3A
#define REP3A 1
#endif
#ifndef REP3B
#define REP3B 1
#endif
#ifndef REP3C
#define REP3C 1
#endif
#ifndef PH_LO
#define PH_LO 0
#endif
#ifndef PH_HI
#define PH_HI 99
#endif
__global__ void __launch_bounds__(512, 2) fwd_kernel(Args a) {
    extern __shared__ __attribute__((aligned(16))) unsigned char lds[];
    cg::grid_group grid = cg::this_grid();
    const int tid = threadIdx.x, lane = tid & 63, wave = __builtin_amdgcn_readfirstlane(tid >> 6);
    const int G = gridDim.x, gw = blockIdx.x * 8 + wave, NGW = G * 8;
    unsigned char* ws = a.ws;
    PG8_LAS unsigned char* ldsg = (PG8_LAS unsigned char*)lds;

    _Pragma("nounroll") for (int rep = 0; rep < REP0; ++rep) { phase0(a, lds, gw, NGW, wave, lane); __syncthreads(); }
    grid.sync();
    _Pragma("nounroll") for (int rep = 0; rep < REP1; ++rep)
    { pg8::Gemm g{(const bf16*)(ws + WS_H), (const bf16*)(ws + WS_WIN), T, NIN, DM, DM}; pg8::StaticOrder S; S.init(T, NIN, G, (int)blockIdx.x);
      EpiP E{(bf16*)(ws + WS_P), (float*)(ws + WS_BA)};
      pg8::gemm_phase<EpiP, pg8::StaticOrder, true, true>(ldsg, g, S, E); }
    grid.sync();
    _Pragma("nounroll") for (int rep = 0; rep < REP2A; ++rep) dn_chunk_phase(a, lds, tid);
#if OLD_S5 && OLD_S5 != 4 && OLD_S5 != 5
    old_s5_pass1(a, gw, NGW, lane);
#elif 0
#else
    _Pragma("nounroll") for (int rep = 0; rep < REP2B; ++rep) s5_pass1(a, gw, NGW, lane);
#endif
    grid.sync();
#if OLD_S5 == 3
    if (blockIdx.x < 64) dn_scan_prompt(a, lds, tid);
    else { if (blockIdx.x >= 192) { dn_scan_sample(a, lds, tid, (int)blockIdx.x - 192, 64); s5_pass2_sample(a, lds + 81920 + wave * 4352, ((int)blockIdx.x - 192) * 8 + wave, 512, lane); __syncthreads(); }
           old_s5_pass2(a, lds + 81920 + wave * 4352, gw - 512, NGW - 512, lane); }
#elif OLD_S5 == 5
    if (blockIdx.x < 64) dn_scan_prompt(a, lds, tid);
    else { if (blockIdx.x >= 192) dn_scan_sample(a, lds, tid, (int)blockIdx.x - 192, 64); s5_pass2b(a, lds + wave * 14592, gw - 512, NGW - 512, lane); }
#elif OLD_S5 == 1 || OLD_S5 == 4
    if (blockIdx.x < 64) dn_scan_prompt(a, lds, tid);
    else { if (blockIdx.x >= 192) dn_scan_sample(a, lds, tid, (int)blockIdx.x - 192, 64); old_s5_pass2(a, lds + 81920 + wave * 4352, gw - 512, NGW - 512, lane); }
#else
    if (blockIdx.x < 64) { _Pragma("nounroll") for (int rep = 0; rep < REP3A; ++rep) dn_scan_prompt(a, lds, tid); }
    else if (blockIdx.x < 192) { _Pragma("nounroll") for (int rep = 0; rep < REP3B; ++rep) s5_pass2_prompt(a, lds, (int)blockIdx.x - 64, tid); }
    else { _Pragma("nounroll") for (int rep = 0; rep < REP3C; ++rep) { dn_scan_sample(a, lds, tid, (int)blockIdx.x - 192, 64); s5_pass2_sample(a, lds + 81920 + wave * 4352, ((int)blockIdx.x - 192) * 8 + wave, 512, lane); } }
#endif
    grid.sync();
#if PH_MASK & 512
    { pg8::Gemm g{(const bf16*)(ws + WS_Y5), (const bf16*)(ws + WS_WGLU), T, 1024, 512, 512}; pg8::StaticOrder S; S.init(T, 1024, G, (int)blockIdx.x);
      EpiGlu E{(bf16*)(ws + WS_GLU), a.in[22]};
      pg8::gemm_phase<EpiGlu, pg8::StaticOrder, true, true>(ldsg, g, S, E); }
#endif
    grid.sync();
#if PH_MASK & 32
    mix_phase(a, gw, NGW, lane);
#endif
    grid.sync();
#if PH_MASK & 1024
    { pg8::Gemm g{(const bf16*)(ws + WS_DNC), (const bf16*)(ws + WS_WOUT), T, DM, DM, DM}; pg8::StaticOrder S; S.init(T, DM, G, (int)blockIdx.x);
      EpiX1 E{a.in[0], a.in[1], a.out, (bf16*)(ws + WS_H), (float*)(ws + WS_SS2)};
      pg8::gemm_phase<EpiX1, pg8::StaticOrder, true, true>(ldsg, g, S, E); }
#endif
    grid.sync();
#if PH_MASK & 2048
    { pg8::Gemm g{(const bf16*)(ws + WS_H), (const bf16*)(ws + WS_WUP), T, UPW, DM, DM}; pg8::StaticOrder S; S.init(T, UPW, G, (int)blockIdx.x);
      EpiUp E{(bf16*)(ws + WS_UP), (const float*)(ws + WS_SS2)};
      pg8::gemm_phase<EpiUp, pg8::StaticOrder, true, true>(ldsg, g, S, E); }
#endif
    grid.sync();
#if PH_MASK & 64
    act_phase(a, (int)blockIdx.x * 512 + tid, G * 512);
#endif
    grid.sync();
#if PH_MASK & 4096
    { pg8::Gemm g{(const bf16*)(ws + WS_UP) + DFF, (const bf16*)(ws + WS_WDOWN), T, DM, DFF, UPW}; pg8::StaticOrder S; S.init(T, DM, G, (int)blockIdx.x);
      EpiX2 E{a.out};
      pg8::gemm_phase<EpiX2, pg8::StaticOrder, true, true>(ldsg, g, S, E); }
#endif
    grid.sync();
#if PH_MASK & 128
    final_phase(a, gw, NGW, lane);
#endif
}

extern "C" void kernel_launch(void* const* d_in, const int* in_sizes, int n_in, void* d_out, int out_size, void* d_ws, size_t ws_size, hipStream_t stream) {
    static int grid = 0;
    if (grid == 0) {
        if (n_in != 31 || (size_t)out_size != O_END || ws_size < WS_END) { fprintf(stderr, "kernel_launch: unexpected shapes n_in %d out %d ws %zu\n", n_in, out_size, ws_size); grid = -1; return; }
        int dev = 0, cus = 0, per_cu = 0;
        hipGetDevice(&dev);
        hipDeviceGetAttribute(&cus, hipDeviceAttributeMultiprocessorCount, dev);
        hipFuncSetAttribute((const void*)fwd_kernel, hipFuncAttributeMaxDynamicSharedMemorySize, LDS_BYTES);
        hipOccupancyMaxActiveBlocksPerMultiprocessor(&per_cu, (const void*)fwd_kernel, 512, LDS_BYTES);
        if (per_cu < 1) { fprintf(stderr, "kernel_launch: occupancy query says %d blocks per CU\n", per_cu); per_cu = 1; }
        grid = cus * 1;
        if (grid != 256) { fprintf(stderr, "kernel_launch: built for a 256-CU device, got %d\n", cus); grid = -1; return; }
        (void)hipGetLastError();
    }
    if (grid < 0) return;
    Args a{};
    for (int i = 0; i < 31; ++i) a.in[i] = (const float*)d_in[i];
    a.out = (float*)d_out; a.ws = (unsigned char*)d_ws;
    void* args[] = {&a};
    hipError_t e = hipLaunchCooperativeKernel((const void*)fwd_kernel, dim3(grid), dim3(512), args, LDS_BYTES, stream);
    if (e != hipSuccess) fprintf(stderr, "cooperative launch failed: %s (grid %d)\n", hipGetErrorString(e), grid);
}
```

```cpp
#include <hip/hip_runtime.h>
#include <hip/hip_cooperative_groups.h>
#include <cstdio>
#include <cstdint>
namespace cg = cooperative_groups;
#define OLD_S5 5
#define DN_STAGED 0
namespace pg8 {
#define PG8_LAS __attribute__((address_space(3)))
typedef unsigned short bf16_t;
typedef short bf16x8 __attribute__((ext_vector_type(8)));
typedef float f32x4 __attribute__((ext_vector_type(4)));
typedef unsigned u32x4 __attribute__((ext_vector_type(4)));
constexpr int BM = 256, BK = 64, HALF = 128, HTB = HALF * BK * 2  , STAGE_BYTES = 8 * HTB, NXCD = 8, WGM = 8;

__host__ __device__ __forceinline__ int lds_byte(int r, int c) { const int st = (r >> 4) * 2 + (c >> 5), rr = r & 15, cc = c & 31, ob = rr * 64 + cc * 2; return st * 1024 + (ob ^ (((ob >> 9) & 1) << 5)); }
__host__ __device__ __forceinline__ void stage_rc(int b, int& R, int& C) { const int st = b / 1024, sb = b % 1024, swz = sb ^ (((sb >> 9) & 1) << 5); R = (st >> 1) * 16 + swz / 64; C = (st & 1) * 32 + (swz % 64) / 2; }
__host__ __device__ __forceinline__ int perm32(int rho) { const int n = rho >> 4, i = rho & 15; return 8 * (i >> 2) + 4 * n + (i & 3); }

struct Unit { int pm, pn; };
struct Gemm { const bf16_t* A; const bf16_t* Bt; int M, N, K, lda; };

struct StaticOrder {
    int nM, nN, nwg, G, c;
    __host__ __device__ void init(int M, int N, int G_, int c_) { nM = M / BM; nN = N / BM; nwg = nM * nN; G = G_; c = c_; }
    __host__ __device__ bool next(int i, Unit& u) const {
        const long L = (long)i * G + c; if (L >= nwg) return false;
        int wgid = (int)L; { const int q = nwg / NXCD, r = nwg % NXCD, xcd = wgid % NXCD, off = wgid / NXCD; wgid = (xcd < r ? xcd * (q + 1) : r * (q + 1) + (xcd - r) * q) + off; }
        const int nig = WGM * nN, gid = wgid / nig, fm = gid * WGM, gsz = (nM - fm) < WGM ? (nM - fm) : WGM;
        u.pm = fm + ((wgid % nig) % gsz); u.pn = (wgid % nig) / gsz; return true;
    }
    __device__ __forceinline__ void a_ready(const Unit&) const {}
    __device__ __forceinline__ void done(const Unit&) const {}
};
__device__ __forceinline__ unsigned cvt_pk_bf16(float lo, float hi) { unsigned r; asm volatile("v_cvt_pk_bf16_f32 %0, %1, %2" : "=v"(r) : "v"(lo), "v"(hi)); return r; }
typedef float f32x2 __attribute__((ext_vector_type(2)));
template <class Epi, class Sched, bool ALIGN_EPI = false, bool SP2 = false>
__device__ __forceinline__ void gemm_phase(PG8_LAS unsigned char* lds, const Gemm g, const Sched& S, const Epi& E) {
    int tid_ = threadIdx.x; asm volatile("" : "+v"(tid_));
    const int tid = tid_, wid = __builtin_amdgcn_readfirstlane(tid >> 6), lane = tid & 63, wr = wid >> 2, wc = wid & 3, fr = lane & 15, fq = lane >> 4;
    const int K = g.K, nt = K / BK;
    unsigned voffA[2], voffB[2];
#pragma unroll
    for (int i = 0; i < 2; ++i) { int R, C; stage_rc(tid * 16 + i * 8192, R, C); const int Rb = Epi::PERM ? ((R & ~31) + perm32(R & 31)) : R;
        voffA[i] = (unsigned)(R * g.lda + C) * 2u; voffB[i] = (unsigned)(Rb * K + C) * 2u; }
    const size_t kstep = (size_t)(BK * 2);
    const size_t hstep = (size_t)HALF * K * 2;
    const size_t tstep = 2 * hstep; const size_t hstepA = (size_t)HALF * g.lda * 2, tstepA = 2 * hstepA;
    const unsigned ldsw = (unsigned)wid * 1024u;
    const int aoff = lds_byte(wr * 64 + fr, fq * 8), boff = lds_byte(wc * 32 + fr, fq * 8);
#define PG8_SA(b, h) (((b) * 2 + (h)) * HTB)
#define PG8_SB(b, h) ((4 + (b) * 2 + (h)) * HTB)
#define PG8_STAGE(bufoff, gbase, voff) do { _Pragma("unroll") for (int _i = 0; _i < 2; ++_i) \
        __builtin_amdgcn_global_load_lds((const unsigned*)((const char*)(gbase) + (voff)[_i]), (PG8_LAS unsigned*)(lds + (bufoff) + ldsw + _i * 8192), 16, 0, 0); } while (0)
#define PG8_LDA(dst, b, h) do { _Pragma("unroll") for (int m = 0; m < 4; ++m) _Pragma("unroll") for (int k = 0; k < 2; ++k) dst[m][k] = *(const PG8_LAS bf16x8*)(lds + PG8_SA(b, h) + aoff + m * 2048 + k * 1024); } while (0)
#define PG8_LDB(dst, b, h) do { _Pragma("unroll") for (int n = 0; n < 2; ++n) _Pragma("unroll") for (int k = 0; k < 2; ++k) dst[n][k] = *(const PG8_LAS bf16x8*)(lds + PG8_SB(b, h) + boff + n * 2048 + k * 1024); } while (0)
#define PG8_MMA(ai, bj, At, Bt) do { __builtin_amdgcn_s_setprio(1); _Pragma("unroll") for (int m = 0; m < 4; ++m) _Pragma("unroll") for (int n = 0; n < 2; ++n) _Pragma("unroll") for (int k = 0; k < 2; ++k) \
        acc[ai][bj][m][n] = __builtin_amdgcn_mfma_f32_16x16x32_bf16(Bt[n][k], At[m][k], acc[ai][bj][m][n], 0, 0, 0); __builtin_amdgcn_s_setprio(0); } while (0)
#define PG8_WAIT_V(n) asm volatile("s_waitcnt vmcnt(" #n ")" ::: "memory")
#define PG8_WAIT_L(n) asm volatile("s_waitcnt lgkmcnt(" #n ")" ::: "memory")
#define PG8_BAR __builtin_amdgcn_s_barrier()
#define PG8_SCHED __builtin_amdgcn_sched_barrier(0)
    Unit cur, nxt; int ui = 0;
    if (!S.next(0, cur)) return;
    f32x4 acc[2][2][4][2];
#pragma unroll
    for (int a = 0; a < 2; ++a)
#pragma unroll
        for (int b = 0; b < 2; ++b)
#pragma unroll
            for (int m = 0; m < 4; ++m)
#pragma unroll
                for (int n = 0; n < 2; ++n) acc[a][b][m][n] = (f32x4){0.f, 0.f, 0.f, 0.f};
    bf16x8 At[4][2], B0[2][2], B1[2][2];
    const char* cA = (const char*)g.A + (size_t)cur.pm * tstepA; const char* cB = (const char*)g.Bt + (size_t)cur.pn * tstep;
    S.a_ready(cur);
    if constexpr (SP2) {
        PG8_STAGE(PG8_SB(0, 0), cB, voffB); PG8_STAGE(PG8_SB(0, 1), cB + hstep, voffB); PG8_STAGE(PG8_SA(0, 0), cA, voffA); PG8_STAGE(PG8_SA(0, 1), cA + hstepA, voffA);
        if (wr == 1) PG8_BAR;
        PG8_WAIT_V(2); PG8_BAR;
        PG8_STAGE(PG8_SB(1, 0), cB + kstep, voffB); PG8_STAGE(PG8_SA(1, 0), cA + kstep, voffA); PG8_STAGE(PG8_SB(1, 1), cB + hstep + kstep, voffB);
        PG8_WAIT_V(6); PG8_BAR;
    } else {
        PG8_STAGE(PG8_SB(0, 0), cB, voffB); PG8_STAGE(PG8_SA(0, 0), cA, voffA); PG8_STAGE(PG8_SB(0, 1), cB + hstep, voffB); PG8_STAGE(PG8_SA(0, 1), cA + hstepA, voffA);
        if (wr == 1) PG8_BAR;
        PG8_WAIT_V(4); PG8_BAR;
        PG8_STAGE(PG8_SB(1, 0), cB + kstep, voffB); PG8_STAGE(PG8_SA(1, 0), cA + kstep, voffA); PG8_STAGE(PG8_SB(1, 1), cB + hstep + kstep, voffB);
        PG8_WAIT_V(6); PG8_BAR;
    }
    for (;;) {
        const bool has_next = S.next(ui + 1, nxt);
        const char* nA = has_next ? (const char*)g.A + (size_t)nxt.pm * tstepA : cA; const char* nB = has_next ? (const char*)g.Bt + (size_t)nxt.pn * tstep : cB;
        for (int t = 0; t < nt; t += 2) {
            const bool last = (t == nt - 2);
            const char* a1 = cA + (size_t)(t + 1) * kstep;
            const char* a2 = last ? nA : cA + (size_t)(t + 2) * kstep; const char* b2 = last ? nB : cB + (size_t)(t + 2) * kstep;
            const char* a3 = a2 + kstep; const char* b3 = b2 + kstep;
            if (last && has_next) S.a_ready(nxt);
            if constexpr (SP2) {
            PG8_LDB(B0, 0, 0); PG8_LDB(B1, 0, 1); PG8_SCHED; PG8_LDA(At, 0, 0); PG8_STAGE(PG8_SA(1, 1), a1 + hstepA, voffA);
            PG8_WAIT_V(8); PG8_WAIT_L(0); PG8_BAR; PG8_MMA(0, 0, At, B0); PG8_MMA(0, 1, At, B1); PG8_BAR; PG8_SCHED;
            PG8_LDA(At, 0, 1); PG8_STAGE(PG8_SB(0, 0), b2, voffB); PG8_STAGE(PG8_SB(0, 1), b2 + hstep, voffB); PG8_STAGE(PG8_SA(0, 0), a2, voffA);
            PG8_WAIT_V(8); PG8_WAIT_L(0); PG8_BAR; PG8_MMA(1, 0, At, B0); PG8_MMA(1, 1, At, B1); PG8_BAR; PG8_SCHED;
            PG8_LDB(B0, 1, 0); PG8_LDB(B1, 1, 1); PG8_SCHED; PG8_LDA(At, 1, 0); PG8_STAGE(PG8_SA(0, 1), a2 + hstepA, voffA);
            PG8_WAIT_V(8); PG8_WAIT_L(0); PG8_BAR; PG8_MMA(0, 0, At, B0); PG8_MMA(0, 1, At, B1); PG8_BAR; PG8_SCHED;
            PG8_LDA(At, 1, 1); PG8_STAGE(PG8_SB(1, 0), b3, voffB); PG8_STAGE(PG8_SB(1, 1), b3 + hstep, voffB); PG8_STAGE(PG8_SA(1, 0), a3, voffA);
            PG8_WAIT_V(8); PG8_WAIT_L(0); PG8_BAR; PG8_MMA(1, 0, At, B0); PG8_MMA(1, 1, At, B1); PG8_BAR; PG8_SCHED;
            } else {
            PG8_LDB(B0, 0, 0); PG8_SCHED; PG8_LDA(At, 0, 0); PG8_STAGE(PG8_SA(1, 1), a1 + hstepA, voffA);
            PG8_WAIT_L(8); PG8_BAR; PG8_WAIT_L(0); PG8_MMA(0, 0, At, B0); PG8_BAR; PG8_SCHED;
            PG8_LDB(B1, 0, 1); PG8_STAGE(PG8_SB(0, 0), b2, voffB);
            PG8_BAR; PG8_WAIT_L(0); PG8_MMA(0, 1, At, B1); PG8_BAR;
            PG8_LDA(At, 0, 1); PG8_STAGE(PG8_SA(0, 0), a2, voffA);
            PG8_BAR; PG8_WAIT_L(0); PG8_MMA(1, 0, At, B0); PG8_BAR; PG8_SCHED;
            PG8_STAGE(PG8_SB(0, 1), b2 + hstep, voffB);
            PG8_WAIT_V(6); PG8_BAR; PG8_MMA(1, 1, At, B1); PG8_BAR;
            PG8_LDB(B0, 1, 0); PG8_SCHED; PG8_LDA(At, 1, 0); PG8_STAGE(PG8_SA(0, 1), a2 + hstepA, voffA);
            PG8_WAIT_L(8); PG8_BAR; PG8_WAIT_L(0); PG8_MMA(0, 0, At, B0); PG8_BAR; PG8_SCHED;
            PG8_LDB(B1, 1, 1); PG8_STAGE(PG8_SB(1, 0), b3, voffB);
            PG8_BAR; PG8_WAIT_L(0); PG8_MMA(0, 1, At, B1); PG8_BAR;
            PG8_LDA(At, 1, 1); PG8_STAGE(PG8_SA(1, 0), a3, voffA);
            PG8_BAR; PG8_WAIT_L(0); PG8_MMA(1, 0, At, B0); PG8_BAR; PG8_SCHED;
            PG8_STAGE(PG8_SB(1, 1), b3 + hstep, voffB);
            PG8_WAIT_V(6); PG8_BAR; PG8_MMA(1, 1, At, B1); PG8_BAR;
            }
        }
        if constexpr (ALIGN_EPI) { if (wr == 0) PG8_BAR; }
        if constexpr (!Epi::AFTER_DRAIN) { E(acc, cur, wr, wc, fr, fq); S.done(cur); }
        if (!has_next) break;
#pragma unroll
        for (int a = 0; a < 2; ++a)
#pragma unroll
            for (int b = 0; b < 2; ++b)
#pragma unroll
                for (int m = 0; m < 4; ++m)
#pragma unroll
                    for (int n = 0; n < 2; ++n) acc[a][b][m][n] = (f32x4){0.f, 0.f, 0.f, 0.f};
        cur = nxt; cA = nA; cB = nB; ++ui;
        if constexpr (ALIGN_EPI) { if (wr == 1) PG8_BAR; }
    }
    PG8_WAIT_V(0);
    if constexpr (!ALIGN_EPI) { if (wr == 0) PG8_BAR; }
    PG8_BAR;
    if constexpr (Epi::AFTER_DRAIN) { E.fused(acc, cur, wr, wc, fr, fq, lds, wid, lane); S.done(cur); }
#undef PG8_SA
#undef PG8_SB
#undef PG8_STAGE
#undef PG8_LDA
#undef PG8_LDB
#undef PG8_MMA
#undef PG8_WAIT_V
#undef PG8_WAIT_L
#undef PG8_BAR
#undef PG8_SCHED
}
}

#ifndef DN_STAGED
#define DN_STAGED 1
#endif
#ifndef DIAG_Y
#define DIAG_Y 0
#endif
#ifndef OLD_S5
#define OLD_S5 0
#endif
#if OLD_S5 == 3
#define OLD_S5_ULIM 8192
#else
#define OLD_S5_ULIM (4 * 32 * 64 + 32 * 32)
#endif
#define DI __device__ __forceinline__
typedef unsigned short bf16;
typedef float f32x4 __attribute__((ext_vector_type(4)));
typedef float f32x2 __attribute__((ext_vector_type(2)));
typedef short bf16x8 __attribute__((ext_vector_type(8)));
typedef unsigned u32x4 __attribute__((ext_vector_type(4)));
typedef unsigned u32x2 __attribute__((ext_vector_type(2)));
typedef __bf16 bf16x2_t __attribute__((ext_vector_type(2)));

DI unsigned pk2(float lo, float hi) { f32x2 v = {lo, hi}; bf16x2_t b = __builtin_convertvector(v, bf16x2_t); return __builtin_bit_cast(unsigned, b); }
DI bf16 f2b(float x) { return (bf16)(pk2(x, 0.f) & 0xffffu); }
DI float b2f(unsigned b) { return __uint_as_float(b << 16); }
DI float blo(unsigned w) { return __uint_as_float(w << 16); }
DI float bhi(unsigned w) { return __uint_as_float(w & 0xffff0000u); }
DI float wave_sum(float v) {
#pragma unroll
    for (int o = 1; o < 64; o <<= 1) v += __shfl_xor(v, o);
    return v;
}
DI float sigm(float x) { return 1.f / (1.f + __expf(-x)); }
DI float silu(float x) { return x / (1.f + __expf(-x)); }
DI float gelu_tanh(float x) { const float z = 1.5957691216057308f * (x + 0.044715f * x * x * x); return x / (1.f + __expf(-z)); }
#define MFMA16(a, b, c) __builtin_amdgcn_mfma_f32_16x16x32_bf16((a), (b), (c), 0, 0, 0)

constexpr int TP = 32768, TS = 512, T = TP + TS;
constexpr int DM = 1024, PW = 2560, NIN = 2816, DFF = 2816, UPW = 5632;
constexpr float EPS = 1e-6f;
constexpr int NCH = 2048 + 128;
constexpr int REC = 73728;
constexpr int R_WN = 0, R_QG = 16384, R_KDT = 32768, R_QK = 49152, R_U0 = 57344;
constexpr size_t O_Y = 0, O_PDC = (size_t)T * DM, O_PDS = O_PDC + 4 * 3 * 1536, O_PSR = O_PDS + 4 * 4 * 128 * 128, O_PSI = O_PSR + 4 * 32 * 64,
                 O_PFC = O_PSI + 4 * 32 * 64, O_SDC = O_PFC + 4 * 2 * 2816, O_SDS = O_SDC + 32 * 3 * 1536, O_SSR = O_SDS + (size_t)32 * 4 * 128 * 128,
                 O_SSI = O_SSR + 32 * 32 * 64, O_SFC = O_SSI + 32 * 32 * 64, O_END = O_SFC + 32 * 2 * 2816;
constexpr size_t MiB = 1u << 20;
constexpr size_t WS_SS2 = 0;
constexpr size_t WS_EG = 3 * MiB;
constexpr size_t WS_BA = 4 * MiB;
constexpr size_t WS_WIN = 6 * MiB, WS_WGLU = 12 * MiB, WS_WOUT = 13 * MiB, WS_WUP = 15 * MiB, WS_WDOWN = 26 * MiB;
constexpr size_t WS_H = 32 * MiB;
constexpr size_t WS_P = 98 * MiB;
constexpr size_t WS_DNC = 262 * MiB;
constexpr size_t WS_Y5 = 416 * MiB, WS_GLU = 449 * MiB, WS_S5E = 482 * MiB, WS_END = 487 * MiB;
constexpr size_t WS_UP = 98 * MiB;
static_assert(WS_UP + (size_t)T * UPW * 2 <= WS_END && WS_P + (size_t)T * PW * 2 <= WS_DNC && WS_DNC + (size_t)NCH * REC <= WS_Y5, "ws map");
constexpr int LDS_BYTES = 147456;

struct Args { const float* in[31]; float* out; unsigned char* ws; };

DI int colmap(int mode, int n) {
    if (mode == 0) return n;
    if (mode == 1) return n < 2048 ? n : (n < 2560 ? n + 8 : (n < 2568 ? n - 512 : -1));
    const int pn = n >> 8, bj = (n >> 7) & 1, j = n & 127;
    return bj * (mode == 2 ? 512 : 2816) + 128 * pn + j;
}
DI void transpose_item(const float* W, int K, int N, bf16* WT, float* scr, int kb, int nb, int lane, int mode, const float* rs) {
    const int k0 = 64 * kb, n0 = 32 * nb;
    const int sc = colmap(mode, n0 + (lane & 31));
#pragma unroll 8
    for (int i = 0; i < 32; ++i) { const int kk = 2 * i + (lane >> 5); float v = 0.f; if (sc >= 0) v = W[(size_t)(k0 + kk) * N + sc]; if (rs) v *= rs[k0 + kk]; scr[kk * 33 + (lane & 31)] = v; }
    asm volatile("s_waitcnt lgkmcnt(0)" ::: "memory");
    const int c = lane & 7;
#pragma unroll
    for (int j = 0; j < 4; ++j) { const int n = (lane >> 3) + 8 * j; const float* s = scr + (8 * c) * 33 + n;
        u32x4 o; o.x = pk2(s[0 * 33], s[1 * 33]); o.y = pk2(s[2 * 33], s[3 * 33]); o.z = pk2(s[4 * 33], s[5 * 33]); o.w = pk2(s[6 * 33], s[7 * 33]);
        *(u32x4*)(WT + (size_t)(n0 + n) * K + k0 + 8 * c) = o; }
    asm volatile("s_waitcnt lgkmcnt(0)" ::: "memory");
}
DI void phase0(const Args& a, unsigned char* lds, int gw, int NGW, int wave, int lane) {
    asm volatile("" : "+v"(lane));
    unsigned char* ws = a.ws;
    float* scr = (float*)(lds + wave * 16384);
    constexpr int I_IN = 16 * (NIN / 32), I_GLU = 8 * 32, I_OUT = 16 * 32, I_UP = 16 * (UPW / 32), I_DN = 44 * 32;
    constexpr int NIT = I_IN + I_GLU + I_OUT + I_UP + I_DN;
    for (int it = gw; it < NIT; it += NGW) {
        int r = it;
        if (r < I_IN) { transpose_item(a.in[8], 1024, 2568, (bf16*)(ws + WS_WIN), scr, r / (NIN / 32), r % (NIN / 32), lane, 1, nullptr); continue; } r -= I_IN;
        if (r < I_GLU) { transpose_item(a.in[21], 512, 1024, (bf16*)(ws + WS_WGLU), scr, r / 32, r % 32, lane, 2, nullptr); continue; } r -= I_GLU;
        if (r < I_OUT) { transpose_item(a.in[24], 1024, 1024, (bf16*)(ws + WS_WOUT), scr, r / 32, r % 32, lane, 0, nullptr); continue; } r -= I_OUT;
        if (r < I_UP) { transpose_item(a.in[26], 1024, 5632, (bf16*)(ws + WS_WUP), scr, r / (UPW / 32), r % (UPW / 32), lane, 3, a.in[25]); continue; } r -= I_UP;
        transpose_item(a.in[29], 2816, 1024, (bf16*)(ws + WS_WDOWN), scr, r / 32, r % 32, lane, 0, nullptr);
    }
    const float* g1 = a.in[7];
    f32x4 gv[4];
#pragma unroll
    for (int j = 0; j < 4; ++j) gv[j] = ((const f32x4*)g1)[lane + 64 * j];
    bf16* H = (bf16*)(ws + WS_H);
    for (int m = gw; m < T; m += NGW) {
        const float* xrow = m < TP ? a.in[0] + (size_t)m * DM : a.in[1] + (size_t)(m - TP) * DM;
        const f32x4* xr = (const f32x4*)xrow + lane;
        f32x4 v[4]; float s = 0.f;
#pragma unroll
        for (int j = 0; j < 4; ++j) { v[j] = xr[64 * j]; s += (v[j].x * v[j].x + v[j].y * v[j].y) + (v[j].z * v[j].z + v[j].w * v[j].w); }
        const float rstd = rsqrtf(wave_sum(s) * (1.f / DM) + EPS);
        u32x2* o8 = (u32x2*)(H + (size_t)m * DM) + lane;
#pragma unroll
        for (int j = 0; j < 4; ++j) { u32x2 o; o.x = pk2(v[j].x * rstd * gv[j].x, v[j].y * rstd * gv[j].y); o.y = pk2(v[j].z * rstd * gv[j].z, v[j].w * rstd * gv[j].w); o8[64 * j] = o; }
    }
}

struct EpiP {
    static constexpr bool PERM = true, AFTER_DRAIN = false;
    bf16* P; float* BA;
    DI void operator()(const pg8::f32x4 (&acc)[2][2][4][2], const pg8::Unit& u, int wr, int wc, int fr, int fq) const {
        const int row0 = u.pm * 256 + wr * 64 + fr;
        if (u.pn < 10) {
            const int col0 = u.pn * 256 + wc * 32 + 8 * fq;
#pragma unroll
            for (int ai = 0; ai < 2; ++ai)
#pragma unroll
                for (int m = 0; m < 4; ++m) { bf16* rowp = P + (size_t)(row0 + ai * 128 + m * 16) * PW + col0;
#pragma unroll
                    for (int bj = 0; bj < 2; ++bj) { const pg8::f32x4 v0 = acc[ai][bj][m][0], v1 = acc[ai][bj][m][1];
                        u32x4 w; w.x = pk2(v0[0], v0[1]); w.y = pk2(v0[2], v0[3]); w.z = pk2(v1[0], v1[1]); w.w = pk2(v1[2], v1[3]);
                        *(u32x4*)(rowp + bj * 128) = w; } }
        } else if (wc == 0 && fq == 0) {
#pragma unroll
            for (int ai = 0; ai < 2; ++ai)
#pragma unroll
                for (int m = 0; m < 4; ++m) { float* bp = BA + (size_t)(row0 + ai * 128 + m * 16) * 8;
                    *(pg8::f32x4*)bp = acc[ai][0][m][0]; *(pg8::f32x4*)(bp + 4) = acc[ai][0][m][1]; }
        }
    }
};
struct EpiGlu {
    static constexpr bool PERM = true, AFTER_DRAIN = false;
    bf16* O; const float* gb;
    DI void operator()(const pg8::f32x4 (&acc)[2][2][4][2], const pg8::Unit& u, int wr, int wc, int fr, int fq) const {
        const int row0 = u.pm * 256 + wr * 64 + fr, col0 = u.pn * 128 + wc * 32 + 8 * fq;
        const pg8::f32x4 ba0 = *(const pg8::f32x4*)(gb + col0), ba1 = *(const pg8::f32x4*)(gb + col0 + 4), bg0 = *(const pg8::f32x4*)(gb + 512 + col0), bg1 = *(const pg8::f32x4*)(gb + 512 + col0 + 4);
#pragma unroll
        for (int ai = 0; ai < 2; ++ai)
#pragma unroll
            for (int m = 0; m < 4; ++m) {
                const pg8::f32x4 a0 = acc[ai][0][m][0] + ba0, a1 = acc[ai][0][m][1] + ba1, g0 = acc[ai][1][m][0] + bg0, g1 = acc[ai][1][m][1] + bg1;
                float o[8];
#pragma unroll
                for (int e = 0; e < 4; ++e) { o[e] = a0[e] * sigm(g0[e]); o[4 + e] = a1[e] * sigm(g1[e]); }
                u32x4 w; w.x = pk2(o[0], o[1]); w.y = pk2(o[2], o[3]); w.z = pk2(o[4], o[5]); w.w = pk2(o[6], o[7]);
                *(u32x4*)(O + (size_t)(row0 + ai * 128 + m * 16) * 512 + col0) = w;
            }
    }
};
struct EpiX1 {
    static constexpr bool PERM = false, AFTER_DRAIN = false;
    const float* xp; const float* xs; float* out; bf16* xb; float* ss2;
    DI void operator()(const pg8::f32x4 (&acc)[2][2][4][2], const pg8::Unit& u, int wr, int wc, int fr, int fq) const {
        const int row0 = u.pm * 256 + wr * 64 + fr, col0 = u.pn * 256 + wc * 32 + 4 * fq;
#pragma unroll
        for (int ai = 0; ai < 2; ++ai)
#pragma unroll
            for (int m = 0; m < 4; ++m) {
                const int row = row0 + ai * 128 + m * 16;
                const float* xr = (row < TP ? xp + (size_t)row * DM : xs + (size_t)(row - TP) * DM) + col0;
                float ss = 0.f;
#pragma unroll
                for (int bj = 0; bj < 2; ++bj)
#pragma unroll
                    for (int n = 0; n < 2; ++n) {
                        const pg8::f32x4 v = *(const pg8::f32x4*)(xr + bj * 128 + n * 16) + acc[ai][bj][m][n];
                        *(pg8::f32x4*)(out + (size_t)row * DM + col0 + bj * 128 + n * 16) = v;
                        u32x2 w; w.x = pk2(v[0], v[1]); w.y = pk2(v[2], v[3]);
                        *(u32x2*)(xb + (size_t)row * DM + col0 + bj * 128 + n * 16) = w;
                        ss += (v[0] * v[0] + v[1] * v[1]) + (v[2] * v[2] + v[3] * v[3]);
                    }
                ss += __shfl_xor(ss, 16); ss += __shfl_xor(ss, 32);
                if (fq == 0) ss2[(size_t)row * 16 + u.pn * 4 + wc] = ss;
            }
    }
};
struct EpiUp {
    static constexpr bool PERM = true, AFTER_DRAIN = false;
    bf16* UP; const float* ss2;
    DI void operator()(const pg8::f32x4 (&acc)[2][2][4][2], const pg8::Unit& u, int wr, int wc, int fr, int fq) const {
        const int row0 = u.pm * 256 + wr * 64 + fr, col0 = u.pn * 128 + wc * 32 + 8 * fq;
#pragma unroll
        for (int ai = 0; ai < 2; ++ai)
#pragma unroll
            for (int m = 0; m < 4; ++m) {
                const int row = row0 + ai * 128 + m * 16;
                const pg8::f32x4* sp = (const pg8::f32x4*)(ss2 + (size_t)row * 16);
                const pg8::f32x4 s0 = sp[0], s1 = sp[1], s2 = sp[2], s3 = sp[3];
                const float tot = ((s0[0] + s0[1]) + (s0[2] + s0[3])) + ((s1[0] + s1[1]) + (s1[2] + s1[3])) + ((s2[0] + s2[1]) + (s2[2] + s2[3])) + ((s3[0] + s3[1]) + (s3[2] + s3[3]));
                const float r = rsqrtf(tot * (1.f / DM) + EPS);
                bf16* rowp = UP + (size_t)row * UPW + col0;
#pragma unroll
                for (int bj = 0; bj < 2; ++bj) { const pg8::f32x4 v0 = acc[ai][bj][m][0] * r, v1 = acc[ai][bj][m][1] * r;
                    u32x4 w; w.x = pk2(v0[0], v0[1]); w.y = pk2(v0[2], v0[3]); w.z = pk2(v1[0], v1[1]); w.w = pk2(v1[2], v1[3]);
                    *(u32x4*)(rowp + bj * DFF) = w; }
            }
    }
};
struct EpiX2 {
    static constexpr bool PERM = false, AFTER_DRAIN = false;
    float* out;
    DI void operator()(const pg8::f32x4 (&acc)[2][2][4][2], const pg8::Unit& u, int wr, int wc, int fr, int fq) const {
        const int row0 = u.pm * 256 + wr * 64 + fr, col0 = u.pn * 256 + wc * 32 + 4 * fq;
#pragma unroll
        for (int ai = 0; ai < 2; ++ai)
#pragma unroll
            for (int m = 0; m < 4; ++m) {
                float* orow = out + (size_t)(row0 + ai * 128 + m * 16) * DM + col0;
#pragma unroll
                for (int bj = 0; bj < 2; ++bj)
#pragma unroll
                    for (int n = 0; n < 2; ++n) { pg8::f32x4* p = (pg8::f32x4*)(orow + bj * 128 + n * 16); *p = *p + acc[ai][bj][m][n]; }
            }
    }
};

DI int kperm(int k) { return (k & ~31) | (((k >> 2) & 3) << 3) | (((k >> 4) & 1) << 2) | (k & 3); }
DI void conv_col(const bf16* pcol, float h0, float h1, float h2, const float* cw, int nrows, float* outp, float (&val)[64]) {
    const float w0 = cw[0], w1 = cw[1536], w2 = cw[2 * 1536], w3 = cw[3 * 1536];
    float x3 = h0, x2 = h1, x1 = h2;
#pragma unroll
    for (int r = 0; r < 64; ++r) {
        float x0 = 0.f;
        if (r < nrows) x0 = b2f(pcol[(size_t)r * PW]);
        const float c = x3 * w0 + x2 * w1 + x1 * w2 + x0 * w3;
        val[r] = r < nrows ? silu(c) : 0.f;
        if (outp && r >= nrows - 3 && r < nrows) outp[(r - (nrows - 3)) * 1536] = x0;
        x3 = x2; x2 = x1; x1 = x0;
    }
}
DI void dn_chunk_phase(const Args& a, unsigned char* lds, int tid) {
    unsigned char* ws = a.ws;
    const bf16* P = (const bf16*)(ws + WS_P);
    const float* BA = (const float*)(ws + WS_BA);
    const float* cwt = a.in[9];
    constexpr float QSCALE = 0.08838834764831845f;
    for (int it = blockIdx.x; it < NCH / 2; it += gridDim.x) {
        int tl = tid; asm volatile("" : "+v"(tl));
        const int half = __builtin_amdgcn_readfirstlane(tl >> 8), t8 = tl & 255, hw = __builtin_amdgcn_readfirstlane((tl >> 6) & 3), lane = tl & 63, fr = lane & 15, fq = lane >> 4;
        unsigned char* L = lds + half * 53248;
        unsigned char* qb = L; unsigned char* kb = L + 17408;
        float* Am = (float*)(L + 34816);
        float* Gs = (float*)(L + 51200); float* Bs = Gs + 64; float* RQ = Gs + 128; float* RK = Gs + 192; float* EG = Gs + 256;
        const int unit = it * 2 + half;
        int row0, nrows, h, bidx; bool sample, first, lastc;
        if (unit < 2048) { const int b = unit >> 9, n = unit & 127; h = (unit >> 7) & 3; row0 = b * 8192 + n * 64; nrows = 64; sample = false; first = (n == 0); lastc = (n == 127); bidx = b; }
        else { const int su = unit - 2048; bidx = su >> 2; h = su & 3; row0 = TP + bidx * 16; nrows = 16; sample = true; first = false; lastc = true; }
        unsigned char* rec = ws + WS_DNC + (size_t)unit * REC;
        if (hw == 0) {
            float g = 0.f, be = 0.f;
            if (lane < nrows) {
                const float* bp = BA + (size_t)(row0 + lane) * 8;
                be = sigm(bp[h]);
                const float xx = bp[4 + h] + a.in[11][h];
                const float sp = xx > 20.f ? xx : log1pf(__expf(xx));
                g = -__expf(a.in[10][h]) * sp;
            }
#pragma unroll
            for (int o = 1; o < 64; o <<= 1) { const float v = __shfl_up(g, o); if (lane >= o) g += v; }
            Gs[lane] = g; Bs[lane] = be; EG[lane] = __expf(g);
            if (lane == 63) ((float*)(ws + WS_EG))[unit] = __expf(g);
        }
        float va[64];
        {
            const int c = t8 & 127;
            const int col = (t8 < 128 ? 0 : 512) + h * 128 + c;
            float h0 = 0.f, h1 = 0.f, h2 = 0.f;
            if (sample) { const float* cc = a.in[2] + (size_t)bidx * 3 * 1536 + col; h0 = cc[0]; h1 = cc[1536]; h2 = cc[2 * 1536]; }
            else if (!first) { const bf16* pp = P + (size_t)(row0 - 3) * PW + col; h0 = b2f(pp[0]); h1 = b2f(pp[PW]); h2 = b2f(pp[2 * PW]); }
            float* outp = lastc ? a.out + (sample ? O_SDC : O_PDC) + (size_t)bidx * 3 * 1536 + col : nullptr;
            conv_col(P + (size_t)row0 * PW + col, h0, h1, h2, cwt + col, nrows, outp, va);
            unsigned char* dst = (t8 < 128 ? qb : kb) + c * 2;
#pragma unroll
            for (int r = 0; r < 64; ++r) *(bf16*)(dst + r * 272) = f2b(va[r]);
        }
        __syncthreads();
        f32x4 kk[4], qk[4], qq;
        {
            bf16x8 ak[4], aq[4];
#pragma unroll
            for (int ks = 0; ks < 4; ++ks) { ak[ks] = *(const bf16x8*)(kb + (16 * hw + fr) * 272 + ks * 64 + fq * 16); aq[ks] = *(const bf16x8*)(qb + (16 * hw + fr) * 272 + ks * 64 + fq * 16); }
            qq = (f32x4){0.f, 0.f, 0.f, 0.f};
#pragma unroll
            for (int ks = 0; ks < 4; ++ks) qq = MFMA16(aq[ks], aq[ks], qq);
#pragma unroll
            for (int nt = 0; nt < 4; ++nt) {
                kk[nt] = (f32x4){0.f, 0.f, 0.f, 0.f}; qk[nt] = (f32x4){0.f, 0.f, 0.f, 0.f};
#pragma unroll
                for (int ks = 0; ks < 4; ++ks) { const bf16x8 bk = *(const bf16x8*)(kb + (16 * nt + fr) * 272 + ks * 64 + fq * 16);
                    kk[nt] = MFMA16(ak[ks], bk, kk[nt]); qk[nt] = MFMA16(aq[ks], bk, qk[nt]); }
            }
#pragma unroll
            for (int i = 0; i < 4; ++i) if (fr == 4 * fq + i) {
                float dk = 0.f;
#pragma unroll
                for (int nt = 0; nt < 4; ++nt) if (nt == hw) dk = kk[nt][i];
                RK[16 * hw + fr] = rsqrtf(dk + EPS); RQ[16 * hw + fr] = rsqrtf(qq[i] + EPS);
            }
        }
        __syncthreads();
        {
            bf16* QKr = (bf16*)(rec + R_QK);
#pragma unroll
            for (int i = 0; i < 4; ++i) {
                const int row = 16 * hw + 4 * fq + i;
                const float gr = Gs[row], br = Bs[row], rk = RK[row], rq = RQ[row];
#pragma unroll
                for (int nt = 0; nt < 4; ++nt) {
                    const int col = 16 * nt + fr;
                    const float d = col <= row ? gr - Gs[col] : 0.f;
                    const float e = __expf(d), rkc = RK[col];
                    Am[row * 64 + col] = col < row ? br * kk[nt][i] * rk * rkc * e : 0.f;
                    QKr[row * 64 + kperm(col)] = f2b(col <= row ? qk[nt][i] * rq * rkc * QSCALE * e : 0.f);
                }
            }
        }
        __syncthreads();
        if (t8 < 128) {
            bf16* Qg = (bf16*)(rec + R_QG) + kperm(t8);
#pragma unroll
            for (int r = 0; r < 64; ++r) Qg[r * 128] = f2b(va[r] * RQ[r] * QSCALE * EG[r]);
            {
                const int col = 1024 + h * 128 + t8;
                float h0 = 0.f, h1 = 0.f, h2 = 0.f;
                if (sample) { const float* cc = a.in[2] + (size_t)bidx * 3 * 1536 + col; h0 = cc[0]; h1 = cc[1536]; h2 = cc[2 * 1536]; }
                else if (!first) { const bf16* pp = P + (size_t)(row0 - 3) * PW + col; h0 = b2f(pp[0]); h1 = b2f(pp[PW]); h2 = b2f(pp[2 * PW]); }
                float* outp = lastc ? a.out + (sample ? O_SDC : O_PDC) + (size_t)bidx * 3 * 1536 + col : nullptr;
                conv_col(P + (size_t)row0 * PW + col, h0, h1, h2, cwt + col, nrows, outp, va);
            }
#pragma unroll
            for (int r = 0; r < 64; ++r) va[r] = va[r] * Bs[r];
        } else {
            const int c = t8 - 128;
            const float gl = Gs[63];
            unsigned w[32];
#pragma unroll
            for (int r = 0; r < 64; r += 2) w[kperm(r) >> 1] = pk2(va[r] * RK[r] * __expf(gl - Gs[r]), va[r + 1] * RK[r + 1] * __expf(gl - Gs[r + 1]));
            u32x4* dst = (u32x4*)(rec + R_KDT + c * 128);
#pragma unroll
            for (int j = 0; j < 8; ++j) dst[j] = (u32x4){w[4 * j], w[4 * j + 1], w[4 * j + 2], w[4 * j + 3]};
#pragma unroll
            for (int r = 0; r < 64; ++r) va[r] = va[r] * RK[r] * Bs[r] * EG[r];
        }
#if SOLVE_RL
        {
            float arow[64];
#pragma unroll
            for (int i = 1; i < 64; ++i) arow[i] = Am[i * 64 + lane];
#pragma unroll
            for (int i = 1; i < 64; ++i) {
                if (i < nrows) {
                    float acc0 = va[i], acc1 = 0.f;
#pragma unroll
                    for (int j = 0; j < i; ++j) { const float aij = __int_as_float(__builtin_amdgcn_readlane(__float_as_int(arow[i]), j)); if (j & 1) acc1 -= aij * va[j]; else acc0 -= aij * va[j]; }
                    va[i] = acc0 + acc1;
                }
            }
        }
#else
#pragma unroll
        for (int i = 1; i < 64; ++i) {
            float acc = va[i];
            const f32x4* Ar = (const f32x4*)(Am + i * 64);
#pragma unroll
            for (int j4 = 0; j4 < (i + 3) / 4; ++j4) {
                const f32x4 av = Ar[j4];
#pragma unroll
                for (int e = 0; e < 4; ++e) if (4 * j4 + e < i) acc -= av[e] * va[4 * j4 + e];
            }
            va[i] = acc;
        }
#endif
        if (t8 < 128) { bf16* U0 = (bf16*)(rec + R_U0) + t8;
#pragma unroll
            for (int r = 0; r < 64; ++r) U0[r * 128] = f2b(va[r]);
        } else { bf16* Wn = (bf16*)(rec + R_WN) + kperm(t8 - 128);
#pragma unroll
            for (int r = 0; r < 64; ++r) Wn[r * 128] = f2b(-va[r]);
        }
        __syncthreads();
    }
}

struct S5W { float lr[4], li[4]; bf16x8 bf[8]; };
DI void s5w_setup(const Args& a, int g, int fr, int fq, S5W& w) {
    const float dt = __expf(a.in[15][g]);
#pragma unroll
    for (int j = 0; j < 4; ++j) {
        const int p = 16 * j + fr;
        const float are = a.in[13][g * 64 + p], aim = a.in[14][g * 64 + p];
        const float mag = __expf(are * dt), ang = aim * dt;
        float sn, cs; sincosf(ang, &sn, &cs);
        const float lr = mag * cs, li = mag * sn;
        w.lr[j] = lr; w.li[j] = li;
        const float den = are * are + aim * aim;
        const float fre = ((lr - 1.f) * are + li * aim) / den, fim = (li * are - (lr - 1.f) * aim) / den;
        u32x4 wr = (u32x4){0u, 0u, 0u, 0u}, wi = (u32x4){0u, 0u, 0u, 0u};
        if (fq < 2) {
            const f32x4* br = (const f32x4*)(a.in[16] + (size_t)(g * 64 + p) * 16 + 8 * fq); const f32x4* bi = (const f32x4*)(a.in[17] + (size_t)(g * 64 + p) * 16 + 8 * fq);
            const f32x4 r0 = br[0], r1 = br[1], i0 = bi[0], i1 = bi[1];
            wr.x = pk2(fre * r0[0] - fim * i0[0], fre * r0[1] - fim * i0[1]); wr.y = pk2(fre * r0[2] - fim * i0[2], fre * r0[3] - fim * i0[3]);
            wr.z = pk2(fre * r1[0] - fim * i1[0], fre * r1[1] - fim * i1[1]); wr.w = pk2(fre * r1[2] - fim * i1[2], fre * r1[3] - fim * i1[3]);
            wi.x = pk2(fre * i0[0] + fim * r0[0], fre * i0[1] + fim * r0[1]); wi.y = pk2(fre * i0[2] + fim * r0[2], fre * i0[3] + fim * r0[3]);
            wi.z = pk2(fre * i1[0] + fim * r1[0], fre * i1[1] + fim * r1[1]); wi.w = pk2(fre * i1[2] + fim * r1[2], fre * i1[3] + fim * r1[3]);
        }
        w.bf[j] = __builtin_bit_cast(bf16x8, wr); w.bf[4 + j] = __builtin_bit_cast(bf16x8, wi);
    }
}
DI bf16x8 s5w_uload(const bf16* P, size_t row0, int SS, int ms, int g, int fr, int fq) {
    u32x4 v = (u32x4){0u, 0u, 0u, 0u};
    if (fq < 2) v = *(const u32x4*)(P + (row0 + (size_t)(fr >> 2) * SS + 4 * ms + (fr & 3)) * PW + 2048 + g * 16 + 8 * fq);
    return __builtin_bit_cast(bf16x8, v);
}
DI void s5w_step(const S5W& w, bf16x8 ua, float (&xr)[4], float (&xi)[4], unsigned (&xo)[4][4]) {
    f32x4 br[4], bi[4];
    const f32x4 z = (f32x4){0.f, 0.f, 0.f, 0.f};
#pragma unroll
    for (int j = 0; j < 4; ++j) { br[j] = MFMA16(ua, w.bf[j], z); bi[j] = MFMA16(ua, w.bf[4 + j], z); }
#pragma unroll
    for (int i = 0; i < 4; ++i)
#pragma unroll
        for (int j = 0; j < 4; ++j) {
            const float nr = w.lr[j] * xr[j] - w.li[j] * xi[j] + br[j][i], ni = w.lr[j] * xi[j] + w.li[j] * xr[j] + bi[j][i];
            xr[j] = nr; xi[j] = ni; xo[i][j] = pk2(nr, ni);
        }
#pragma unroll
    for (int j = 0; j < 8; ++j) asm volatile("" :: "v"(w.bf[j]));
    asm volatile("" :: "v"(ua));
}
DI void s5_pass1(const Args& a, int gw, int NGW, int lane) {
    asm volatile("" : "+v"(lane));
    const bf16* P = (const bf16*)(a.ws + WS_P);
    float* E = (float*)(a.ws + WS_S5E);
    const int fr = lane & 15, fq = lane >> 4;
    for (int unit = gw; unit < 4 * 32 * 16; unit += NGW) {
        const int sg = unit & 15, bg = unit >> 4, g = bg & 31, b = bg >> 5;
        S5W w; s5w_setup(a, g, fr, fq, w);
        float xr[4] = {0.f, 0.f, 0.f, 0.f}, xi[4] = {0.f, 0.f, 0.f, 0.f}; unsigned xo[4][4];
        const size_t row0 = (size_t)b * 8192 + sg * 512;
        bf16x8 ua = s5w_uload(P, row0, 128, 0, g, fr, fq);
        for (int ms = 0; ms < 32; ++ms) {
            const bf16x8 un = s5w_uload(P, row0, 128, ms + 1 < 32 ? ms + 1 : ms, g, fr, fq);
            s5w_step(w, ua, xr, xi, xo); ua = un;
        }
        float* e = E + ((size_t)bg * 64 + 4 * sg + fq) * 128;
#pragma unroll
        for (int j = 0; j < 4; ++j) { e[16 * j + fr] = xr[j]; e[64 + 16 * j + fr] = xi[j]; }
    }
}
DI void s5w_run(const Args& a, const S5W& w, const bf16x8 (&cf)[4], float Dg, unsigned char* xs, size_t row0, int SS, int nms, int g, int fr, int fq, float (&xr)[4], float (&xi)[4]) {
    const bf16* P = (const bf16*)(a.ws + WS_P);
    bf16* Y5 = (bf16*)(a.ws + WS_Y5);
    bf16x8 ua = s5w_uload(P, row0, SS, 0, g, fr, fq);
    for (int ms = 0; ms < nms; ++ms) {
        const bf16x8 un = s5w_uload(P, row0, SS, ms + 1 < nms ? ms + 1 : ms, g, fr, fq);
        float uu[4];
#pragma unroll
        for (int i = 0; i < 4; ++i) uu[i] = b2f(P[(row0 + (size_t)fq * SS + 4 * ms + i) * PW + 2048 + g * 16 + fr]);
        unsigned xo[4][4];
        s5w_step(w, ua, xr, xi, xo); ua = un;
#pragma unroll
        for (int i = 0; i < 4; ++i)
#pragma unroll
            for (int j = 0; j < 4; ++j) *(unsigned*)(xs + (4 * fq + i) * 272 + (16 * j + fr) * 4) = xo[i][j];
        asm volatile("s_waitcnt lgkmcnt(0)" ::: "memory");
        f32x4 y = (f32x4){0.f, 0.f, 0.f, 0.f};
        bf16x8 af[4];
#pragma unroll
        for (int ks = 0; ks < 4; ++ks) af[ks] = *(const bf16x8*)(xs + fr * 272 + ks * 64 + fq * 16);
        asm volatile("" ::: "memory");
#pragma unroll
        for (int ks = 0; ks < 4; ++ks) y = MFMA16(af[ks], cf[ks], y);
#if DIAG_Y
        {
            const float* cre = a.in[18] + (size_t)(g * 16 + fr) * 64; const float* cim = a.in[19] + (size_t)(g * 16 + fr) * 64;
#pragma unroll
            for (int i = 0; i < 4; ++i) { float acc = 0.f;
                for (int p = 0; p < 64; ++p) { const unsigned wv = *(const unsigned*)(xs + (4 * fq + i) * 272 + p * 4); acc += cre[p] * blo(wv) - cim[p] * bhi(wv); }
                y[i] = acc; }
        }
#endif
        asm volatile("" :: "v"(y));
#pragma unroll
        for (int ks = 0; ks < 4; ++ks) asm volatile("" :: "v"(af[ks]), "v"(cf[ks]));
#pragma unroll
        for (int i = 0; i < 4; ++i) {
            const size_t row = row0 + (size_t)fq * SS + 4 * ms + i;
            Y5[row * 512 + g * 16 + fr] = f2b(gelu_tanh(y[i] + Dg * uu[i]));
        }
    }
}
DI void s5_cfrag(const Args& a, int g, int fr, int fq, bf16x8 (&cf)[4]) {
#pragma unroll
    for (int ks = 0; ks < 4; ++ks) {
        const f32x4 cr = *(const f32x4*)(a.in[18] + (size_t)(g * 16 + fr) * 64 + 16 * ks + 4 * fq), ci = *(const f32x4*)(a.in[19] + (size_t)(g * 16 + fr) * 64 + 16 * ks + 4 * fq);
        u32x4 w; w.x = pk2(cr[0], -ci[0]); w.y = pk2(cr[1], -ci[1]); w.z = pk2(cr[2], -ci[2]); w.w = pk2(cr[3], -ci[3]);
        cf[ks] = __builtin_bit_cast(bf16x8, w);
    }
}
DI void s5_pass2_prompt(const Args& a, unsigned char* lds, int bg, int tid) {
    asm volatile("" : "+v"(tid));
    const int wave = __builtin_amdgcn_readfirstlane(tid >> 6), lane = tid & 63, fr = lane & 15, fq = lane >> 4;
    const int b = bg >> 5, g4 = (bg >> 2) & 7, part = bg & 3, g = 4 * g4 + (wave & 3);
    bg = b * 32 + g;
    unsigned char* xs = lds + wave * 4352;
    S5W w; s5w_setup(a, g, fr, fq, w);
    bf16x8 cf[4]; s5_cfrag(a, g, fr, fq, cf);
    const float Dg = a.in[20][g * 16 + fr];
    float pr[4], pi[4];
#pragma unroll
    for (int j = 0; j < 4; ++j) { pr[j] = w.lr[j]; pi[j] = w.li[j];
#pragma unroll
        for (int s = 0; s < 7; ++s) { const float nr = pr[j] * pr[j] - pi[j] * pi[j], ni = 2.f * pr[j] * pi[j]; pr[j] = nr; pi[j] = ni; } }
    const float* e = (const float*)(a.ws + WS_S5E) + (size_t)bg * 64 * 128;
    for (int uu = 0; uu < 2; ++uu) {
        const int sg = 4 * part + 2 * (wave >> 2) + uu, seg = 4 * sg + fq;
        float xr[4] = {0.f, 0.f, 0.f, 0.f}, xi[4] = {0.f, 0.f, 0.f, 0.f};
        for (int s = 0; s < 4 * sg + 3; ++s) {
            if (s < seg) {
#pragma unroll
                for (int j = 0; j < 4; ++j) { const float er = e[s * 128 + 16 * j + fr], ei = e[s * 128 + 64 + 16 * j + fr];
                    const float nr = pr[j] * xr[j] - pi[j] * xi[j] + er, ni = pr[j] * xi[j] + pi[j] * xr[j] + ei; xr[j] = nr; xi[j] = ni; }
            }
        }
        s5w_run(a, w, cf, Dg, xs, (size_t)b * 8192 + sg * 512, 128, 32, g, fr, fq, xr, xi);
        if (seg == 63) {
#pragma unroll
            for (int j = 0; j < 4; ++j) { a.out[O_PSR + (size_t)bg * 64 + 16 * j + fr] = xr[j]; a.out[O_PSI + (size_t)bg * 64 + 16 * j + fr] = xi[j]; }
        }
    }
}
DI void s5_pass2_sample(const Args& a, unsigned char* xs, int gw, int NGW, int lane) {
    asm volatile("" : "+v"(lane));
    const int fr = lane & 15, fq = lane >> 4;
    for (int unit = gw; unit < 256; unit += NGW) {
        const int g = unit & 31, q = unit >> 5, sb = 4 * q + fq;
        S5W w; s5w_setup(a, g, fr, fq, w);
        bf16x8 cf[4]; s5_cfrag(a, g, fr, fq, cf);
        const float Dg = a.in[20][g * 16 + fr];
        float xr[4], xi[4];
#pragma unroll
        for (int j = 0; j < 4; ++j) { xr[j] = a.in[4][(size_t)(sb * 32 + g) * 64 + 16 * j + fr]; xi[j] = a.in[5][(size_t)(sb * 32 + g) * 64 + 16 * j + fr]; }
        s5w_run(a, w, cf, Dg, xs, (size_t)TP + (size_t)q * 64, 16, 4, g, fr, fq, xr, xi);
#pragma unroll
        for (int j = 0; j < 4; ++j) { a.out[O_SSR + (size_t)(sb * 32 + g) * 64 + 16 * j + fr] = xr[j]; a.out[O_SSI + (size_t)(sb * 32 + g) * 64 + 16 * j + fr] = xi[j]; }
    }
}

struct S5Par { float lr, li; float bbr[16], bbi[16]; };
DI void s5_setup(const Args& a, int g, int p, S5Par& q) {
    const float are = a.in[13][g * 64 + p], aim = a.in[14][g * 64 + p], dt = __expf(a.in[15][g]);
    const float mag = __expf(are * dt), ang = aim * dt;
    float sn, cs; sincosf(ang, &sn, &cs);
    q.lr = mag * cs; q.li = mag * sn;
    const float den = are * are + aim * aim;
    const float fre = ((q.lr - 1.f) * are + q.li * aim) / den, fim = (q.li * are - (q.lr - 1.f) * aim) / den;
    const f32x4* br = (const f32x4*)(a.in[16] + (size_t)(g * 64 + p) * 16); const f32x4* bi = (const f32x4*)(a.in[17] + (size_t)(g * 64 + p) * 16);
#pragma unroll
    for (int j = 0; j < 4; ++j) { const f32x4 r = br[j], i = bi[j];
#pragma unroll
        for (int e = 0; e < 4; ++e) { q.bbr[4 * j + e] = fre * r[e] - fim * i[e]; q.bbi[4 * j + e] = fre * i[e] + fim * r[e]; } }
}
DI void s5_step4(const S5Par& q, float uv, float& xr, float& xi, unsigned (&xo)[4]) {
#pragma unroll
    for (int j = 0; j < 4; ++j) {
        float br = 0.f, bi = 0.f;
#pragma unroll
        for (int h = 0; h < 16; ++h) { const float uh = __int_as_float(__builtin_amdgcn_readlane(__float_as_int(uv), 16 * j + h)); br += q.bbr[h] * uh; bi += q.bbi[h] * uh; }
        const float nr = q.lr * xr - q.li * xi + br, ni = q.lr * xi + q.li * xr + bi;
        xr = nr; xi = ni; xo[j] = pk2(xr, xi);
    }
}
DI void old_s5_pass1(const Args& a, int gw, int NGW, int lane) {
    asm volatile("" : "+v"(lane));
    const bf16* P = (const bf16*)(a.ws + WS_P);
    float* E = (float*)(a.ws + WS_S5E);
    for (int unit = gw; unit < 4 * 32 * 64; unit += NGW) {
        const int seg = unit & 63, bg = unit >> 6, g = bg & 31, b = bg >> 5;
        S5Par q; s5_setup(a, g, lane, q);
        float xr = 0.f, xi = 0.f; unsigned xo[4];
        const bf16* up = P + (size_t)(b * 8192 + seg * 128 + (lane >> 4)) * PW + 2048 + g * 16 + (lane & 15);
#pragma unroll 2
        for (int t = 0; t < 128; t += 4) { const float uv = b2f(up[(size_t)t * PW]); s5_step4(q, uv, xr, xi, xo); }
        float* e = E + ((size_t)bg * 64 + seg) * 128;
        e[lane] = xr; e[64 + lane] = xi;
    }
}
DI void old_s5_pass2(const Args& a, unsigned char* xs  , int gw, int NGW, int lane) {
    asm volatile("" : "+v"(lane));
    const bf16* P = (const bf16*)(a.ws + WS_P);
    const float* E = (const float*)(a.ws + WS_S5E);
    bf16* Y5 = (bf16*)(a.ws + WS_Y5);
    const int fr = lane & 15, fq = lane >> 4;
    for (int unit = gw; unit < OLD_S5_ULIM; unit += NGW) {
        int g, row0, ntok, seg = 0, bg; bool sample;
        if (unit < 8192) { seg = unit & 63; bg = unit >> 6; g = bg & 31; row0 = (bg >> 5) * 8192 + seg * 128; ntok = 128; sample = false; }
        else { bg = unit - 8192; g = bg & 31; row0 = TP + (bg >> 5) * 16; ntok = 16; sample = true; }
        S5Par q; s5_setup(a, g, lane, q);
        float xr = 0.f, xi = 0.f;
        if (sample) { xr = a.in[4][(size_t)bg * 64 + lane]; xi = a.in[5][(size_t)bg * 64 + lane]; }
        else {
            float pr = q.lr, pi = q.li;
#pragma unroll
            for (int s = 0; s < 7; ++s) { const float nr = pr * pr - pi * pi, ni = 2.f * pr * pi; pr = nr; pi = ni; }
            const float* e = E + (size_t)bg * 64 * 128;
            for (int s = 0; s < seg; ++s) { const float er = e[s * 128 + lane], ei = e[s * 128 + 64 + lane]; const float nr = pr * xr - pi * xi + er, ni = pr * xi + pi * xr + ei; xr = nr; xi = ni; }
        }
        bf16x8 cf[4];
#pragma unroll
        for (int ks = 0; ks < 4; ++ks) {
            const f32x4 cr = *(const f32x4*)(a.in[18] + (size_t)(g * 16 + fr) * 64 + 16 * ks + 4 * fq), ci = *(const f32x4*)(a.in[19] + (size_t)(g * 16 + fr) * 64 + 16 * ks + 4 * fq);
            u32x4 w; w.x = pk2(cr[0], -ci[0]); w.y = pk2(cr[1], -ci[1]); w.z = pk2(cr[2], -ci[2]); w.w = pk2(cr[3], -ci[3]);
            cf[ks] = __builtin_bit_cast(bf16x8, w);
        }
        const float Dg = a.in[20][g * 16 + fr];
        const bf16* up = P + (size_t)(row0 + (lane >> 4)) * PW + 2048 + g * 16 + (lane & 15);
        for (int tb = 0; tb < ntok; tb += 16) {
#pragma unroll
            for (int j4 = 0; j4 < 4; ++j4) {
                const float uv = b2f(up[(size_t)(tb + 4 * j4) * PW]);
                unsigned xo[4]; s5_step4(q, uv, xr, xi, xo);
#pragma unroll
                for (int j = 0; j < 4; ++j) *(unsigned*)(xs + (4 * j4 + j) * 272 + lane * 4) = xo[j];
            }
            f32x4 y = (f32x4){0.f, 0.f, 0.f, 0.f};
#pragma unroll
            for (int ks = 0; ks < 4; ++ks) { const bf16x8 af = *(const bf16x8*)(xs + fr * 272 + ks * 64 + fq * 16); y = MFMA16(af, cf[ks], y); }
#pragma unroll
            for (int i = 0; i < 4; ++i) {
                const size_t row = (size_t)row0 + tb + 4 * fq + i;
                const float uu = b2f(P[row * PW + 2048 + g * 16 + fr]);
                Y5[row * 512 + g * 16 + fr] = f2b(gelu_tanh(y[i] + Dg * uu));
            }
        }
        if (sample) { a.out[O_SSR + (size_t)bg * 64 + lane] = xr; a.out[O_SSI + (size_t)bg * 64 + lane] = xi; }
        else if (seg == 63) { a.out[O_PSR + (size_t)bg * 64 + lane] = xr; a.out[O_PSI + (size_t)bg * 64 + lane] = xi; }
    }
}

DI void s5_pass2b(const Args& a, unsigned char* xs, int gw, int NGW, int lane) {
    asm volatile("" : "+v"(lane));
    const bf16* P = (const bf16*)(a.ws + WS_P);
    const float* E = (const float*)(a.ws + WS_S5E);
    bf16* Y5 = (bf16*)(a.ws + WS_Y5);
    const int fr = lane & 15, fq = lane >> 4;
    for (int unit = gw; unit < 4 * 32 * 64 + 32 * 32; unit += NGW) {
        int g, row0, ntok, seg = 0, bg; bool sample;
        if (unit < 8192) { seg = unit & 63; bg = unit >> 6; g = bg & 31; row0 = (bg >> 5) * 8192 + seg * 128; ntok = 128; sample = false; }
        else { bg = unit - 8192; g = bg & 31; row0 = TP + (bg >> 5) * 16; ntok = 16; sample = true; }
        S5Par q; s5_setup(a, g, lane, q);
        float xr = 0.f, xi = 0.f;
        if (sample) { xr = a.in[4][(size_t)bg * 64 + lane]; xi = a.in[5][(size_t)bg * 64 + lane]; }
        else {
            float pr = q.lr, pi = q.li;
#pragma unroll
            for (int s = 0; s < 7; ++s) { const float nr = pr * pr - pi * pi, ni = 2.f * pr * pi; pr = nr; pi = ni; }
            const float* e = E + (size_t)bg * 64 * 128;
            for (int s = 0; s < seg; ++s) { const float er = e[s * 128 + lane], ei = e[s * 128 + 64 + lane]; const float nr = pr * xr - pi * xi + er, ni = pr * xi + pi * xr + ei; xr = nr; xi = ni; }
        }
        bf16x8 cf[4];
#pragma unroll
        for (int ks = 0; ks < 4; ++ks) {
            const f32x4 cr = *(const f32x4*)(a.in[18] + (size_t)(g * 16 + fr) * 64 + 16 * ks + 4 * fq), ci = *(const f32x4*)(a.in[19] + (size_t)(g * 16 + fr) * 64 + 16 * ks + 4 * fq);
            u32x4 w; w.x = pk2(cr[0], -ci[0]); w.y = pk2(cr[1], -ci[1]); w.z = pk2(cr[2], -ci[2]); w.w = pk2(cr[3], -ci[3]);
            cf[ks] = __builtin_bit_cast(bf16x8, w);
        }
        const float Dg = a.in[20][g * 16 + fr];
        S5W w; s5w_setup(a, g, fr, fq, w);
        unsigned char* bt = xs + 4352;
        for (int tb = 0; tb < ntok; tb += 16) {
            {
                u32x4 uv = (u32x4){0u, 0u, 0u, 0u};
                if (fq < 2) uv = *(const u32x4*)(P + (size_t)(row0 + tb + fr) * PW + 2048 + g * 16 + 8 * fq);
                const bf16x8 ua = __builtin_bit_cast(bf16x8, uv);
                const f32x4 z = (f32x4){0.f, 0.f, 0.f, 0.f};
#pragma unroll
                for (int j = 0; j < 4; ++j) {
                    const f32x4 br = MFMA16(ua, w.bf[j], z), bi = MFMA16(ua, w.bf[4 + j], z);
                    *(f32x4*)(bt + (16 * j + fr) * 80 + fq * 16) = br; *(f32x4*)(bt + (64 + 16 * j + fr) * 80 + fq * 16) = bi;
                }
            }
            asm volatile("s_waitcnt lgkmcnt(0)" ::: "memory");
            f32x4 bre[4], bim[4];
#pragma unroll
            for (int k = 0; k < 4; ++k) { bre[k] = *(const f32x4*)(bt + lane * 80 + k * 16); bim[k] = *(const f32x4*)(bt + (64 + lane) * 80 + k * 16); }
            asm volatile("s_waitcnt lgkmcnt(0)" ::: "memory");
#pragma unroll
            for (int t = 0; t < 16; ++t) {
                const float nr = q.lr * xr - q.li * xi + bre[t >> 2][t & 3], ni = q.lr * xi + q.li * xr + bim[t >> 2][t & 3];
                xr = nr; xi = ni;
                *(unsigned*)(xs + t * 272 + lane * 4) = pk2(nr, ni);
            }
            asm volatile("s_waitcnt lgkmcnt(0)" ::: "memory");
            f32x4 y = (f32x4){0.f, 0.f, 0.f, 0.f};
#pragma unroll
            for (int ks = 0; ks < 4; ++ks) { const bf16x8 af = *(const bf16x8*)(xs + fr * 272 + ks * 64 + fq * 16); y = MFMA16(af, cf[ks], y); }
#pragma unroll
            for (int i = 0; i < 4; ++i) {
                const size_t row = (size_t)row0 + tb + 4 * fq + i;
                const float uu = b2f(P[row * PW + 2048 + g * 16 + fr]);
                Y5[row * 512 + g * 16 + fr] = f2b(gelu_tanh(y[i] + Dg * uu));
            }
        }
        if (sample) { a.out[O_SSR + (size_t)bg * 64 + lane] = xr; a.out[O_SSI + (size_t)bg * 64 + lane] = xi; }
        else if (seg == 63) { a.out[O_PSR + (size_t)bg * 64 + lane] = xr; a.out[O_PSI + (size_t)bg * 64 + lane] = xi; }
    }
}

constexpr int DB_WN = 0, DB_QG = 17408, DB_KDT = 34816, DB_QK = 53248, DB_U0 = 62464;
constexpr int DBP_SIZE = DB_U0 + 64 * 80;
constexpr int DBS_SIZE = DB_U0 + 64 * 272;
template <int NC> struct DnRegs { u32x4 r[7]; u32x4 u[NC == 32 ? 1 : 2]; };
template <int NC> DI void dn_load(const unsigned char* rec, int tid, int c0, DnRegs<NC>& R) {
    const u32x4* g = (const u32x4*)rec;
    R.r[0] = g[tid]; R.r[1] = g[tid + 512]; R.r[2] = g[1024 + tid]; R.r[3] = g[1024 + tid + 512]; R.r[4] = g[2048 + tid]; R.r[5] = g[2048 + tid + 512]; R.r[6] = g[3072 + tid];
    if (NC == 32) { if (tid < 256) R.u[0] = *(const u32x4*)(rec + R_U0 + (tid >> 2) * 256 + c0 * 2 + (tid & 3) * 16); }
    else { R.u[0] = *(const u32x4*)(rec + R_U0 + tid * 16); R.u[1] = *(const u32x4*)(rec + R_U0 + (tid + 512) * 16); }
}
template <int NC> DI void dn_store(unsigned char* buf, int tid, const DnRegs<NC>& R) {
#pragma unroll
    for (int j = 0; j < 2; ++j) { const int q = tid + 512 * j;
        *(u32x4*)(buf + DB_WN + (q >> 4) * 272 + (q & 15) * 16) = R.r[j];
        *(u32x4*)(buf + DB_QG + (q >> 4) * 272 + (q & 15) * 16) = R.r[2 + j];
        *(u32x4*)(buf + DB_KDT + (q >> 3) * 144 + (q & 7) * 16) = R.r[4 + j]; }
    *(u32x4*)(buf + DB_QK + (tid >> 3) * 144 + (tid & 7) * 16) = R.r[6];
    if (NC == 32) { if (tid < 256) *(u32x4*)(buf + DB_U0 + (tid >> 2) * 80 + (tid & 3) * 16) = R.u[0]; }
    else {
#pragma unroll
        for (int j = 0; j < 2; ++j) { const int q = tid + 512 * j; *(u32x4*)(buf + DB_U0 + (q >> 4) * 272 + (q & 15) * 16) = R.u[j]; }
    }
}
DI bf16x8 pack8(const f32x4& lo, const f32x4& hi) { u32x4 w; w.x = pk2(lo[0], lo[1]); w.y = pk2(lo[2], lo[3]); w.z = pk2(hi[0], hi[1]); w.w = pk2(hi[2], hi[3]); return __builtin_bit_cast(bf16x8, w); }
template <int UPI> DI void dn_step(const unsigned char* buf, f32x4 (&S)[8], const unsigned char* u0, float eg, int fr, int fq, f32x4 (&o)[4]) {
    bf16x8 Sb[4];
#pragma unroll
    for (int ks = 0; ks < 4; ++ks) Sb[ks] = pack8(S[2 * ks], S[2 * ks + 1]);
    f32x4 u[4];
#pragma unroll
    for (int mt = 0; mt < 4; ++mt) {
#pragma unroll
        for (int i = 0; i < 4; ++i) u[mt][i] = b2f(*(const bf16*)(u0 + (16 * mt + 4 * fq + i) * UPI));
#pragma unroll
        for (int ks = 0; ks < 4; ++ks) u[mt] = MFMA16(*(const bf16x8*)(buf + DB_WN + (16 * mt + fr) * 272 + ks * 64 + fq * 16), Sb[ks], u[mt]);
    }
    bf16x8 ub[2];
#pragma unroll
    for (int k2 = 0; k2 < 2; ++k2) ub[k2] = pack8(u[2 * k2], u[2 * k2 + 1]);
#pragma unroll
    for (int mt = 0; mt < 4; ++mt) {
        o[mt] = (f32x4){0.f, 0.f, 0.f, 0.f};
#pragma unroll
        for (int ks = 0; ks < 4; ++ks) o[mt] = MFMA16(*(const bf16x8*)(buf + DB_QG + (16 * mt + fr) * 272 + ks * 64 + fq * 16), Sb[ks], o[mt]);
#pragma unroll
        for (int k2 = 0; k2 < 2; ++k2) o[mt] = MFMA16(*(const bf16x8*)(buf + DB_QK + (16 * mt + fr) * 144 + k2 * 64 + fq * 16), ub[k2], o[mt]);
    }
#pragma unroll
    for (int m8 = 0; m8 < 8; ++m8) {
        S[m8] = S[m8] * eg;
#pragma unroll
        for (int k2 = 0; k2 < 2; ++k2) S[m8] = MFMA16(*(const bf16x8*)(buf + DB_KDT + (16 * m8 + fr) * 144 + k2 * 64 + fq * 16), ub[k2], S[m8]);
    }
}
DI void dn_step_p(const unsigned char* buf, f32x4 (&S)[8], const unsigned char* u0, float eg, int fr, int fq, f32x4 (&o)[4]) {
    const unsigned char* aw = buf + DB_WN + fr * 272 + fq * 16;
    const unsigned char* aq = buf + DB_QG + fr * 272 + fq * 16;
    const unsigned char* ak = buf + DB_KDT + fr * 144 + fq * 16;
    const unsigned char* ac = buf + DB_QK + fr * 144 + fq * 16;
    bf16x8 f1[16], f2[16], Sb[4], ub[2];
    f32x4 u[4];
#pragma unroll
    for (int mt = 0; mt < 4; ++mt)
#pragma unroll
        for (int ks = 0; ks < 4; ++ks) f1[4 * mt + ks] = *(const bf16x8*)(aw + mt * 4352 + ks * 64);
#pragma unroll
    for (int mt = 0; mt < 4; ++mt)
#pragma unroll
        for (int i = 0; i < 4; ++i) u[mt][i] = b2f(*(const bf16*)(u0 + (16 * mt + 4 * fq + i) * 80));
#pragma unroll
    for (int ks = 0; ks < 4; ++ks) Sb[ks] = pack8(S[2 * ks], S[2 * ks + 1]);
    __builtin_amdgcn_sched_barrier(0);
#pragma unroll
    for (int mt = 0; mt < 4; ++mt)
#pragma unroll
        for (int ks = 0; ks < 4; ++ks) f2[4 * mt + ks] = *(const bf16x8*)(aq + mt * 4352 + ks * 64);
#pragma unroll
    for (int ks = 0; ks < 4; ++ks)
#pragma unroll
        for (int mt = 0; mt < 4; ++mt) u[mt] = MFMA16(f1[4 * mt + ks], Sb[ks], u[mt]);
    __builtin_amdgcn_sched_barrier(0);
#pragma unroll
    for (int k2 = 0; k2 < 2; ++k2) ub[k2] = pack8(u[2 * k2], u[2 * k2 + 1]);
#pragma unroll
    for (int m8 = 0; m8 < 8; ++m8)
#pragma unroll
        for (int k2 = 0; k2 < 2; ++k2) f1[2 * m8 + k2] = *(const bf16x8*)(ak + m8 * 2304 + k2 * 64);
#pragma unroll
    for (int mt = 0; mt < 4; ++mt) o[mt] = (f32x4){0.f, 0.f, 0.f, 0.f};
#pragma unroll
    for (int ks = 0; ks < 4; ++ks)
#pragma unroll
        for (int mt = 0; mt < 4; ++mt) o[mt] = MFMA16(f2[4 * mt + ks], Sb[ks], o[mt]);
    __builtin_amdgcn_sched_barrier(0);
#pragma unroll
    for (int mt = 0; mt < 4; ++mt)
#pragma unroll
        for (int k2 = 0; k2 < 2; ++k2) f2[2 * mt + k2] = *(const bf16x8*)(ac + mt * 2304 + k2 * 64);
#pragma unroll
    for (int m8 = 0; m8 < 8; ++m8) S[m8] = S[m8] * eg;
#pragma unroll
    for (int k2 = 0; k2 < 2; ++k2)
#pragma unroll
        for (int m8 = 0; m8 < 8; ++m8) S[m8] = MFMA16(f1[2 * m8 + k2], ub[k2], S[m8]);
    __builtin_amdgcn_sched_barrier(0);
#pragma unroll
    for (int k2 = 0; k2 < 2; ++k2)
#pragma unroll
        for (int mt = 0; mt < 4; ++mt) o[mt] = MFMA16(f2[2 * mt + k2], ub[k2], o[mt]);
}
DI void dn_piece(int q, int c0, unsigned& src, unsigned& dst) {
    if (q < 1024) { src = R_WN + q * 16; dst = DB_WN + (q >> 4) * 272 + (q & 15) * 16; }
    else if (q < 2048) { const int p = q - 1024; src = R_QG + p * 16; dst = DB_QG + (p >> 4) * 272 + (p & 15) * 16; }
    else if (q < 3072) { const int p = q - 2048; src = R_KDT + p * 16; dst = DB_KDT + (p >> 3) * 144 + (p & 7) * 16; }
    else if (q < 3584) { const int p = q - 3072; src = R_QK + p * 16; dst = DB_QK + (p >> 3) * 144 + (p & 7) * 16; }
    else { const int p = q - 3584; src = R_U0 + (p >> 2) * 256 + c0 * 2 + (p & 3) * 16; dst = DB_U0 + (p >> 2) * 80 + (p & 3) * 16; }
}
#define DN_LD(R, base) do { _Pragma("unroll") for (int k = 0; k < 10; ++k) { unsigned s_, d_; dn_piece(lt + 384 * k, c0, s_, d_); R[k] = *(const u32x4*)((base) + s_); } } while (0)
#define DN_WAIT(R, cnt) do { } while (0)
#define DN_ST(R, buf) do { _Pragma("unroll") for (int k = 0; k < 10; ++k) { unsigned s_, d_; dn_piece(lt + 384 * k, c0, s_, d_); *(u32x4*)((buf) + d_) = R[k]; } } while (0)
#define DN_BAR() do { asm volatile("s_waitcnt lgkmcnt(0)" ::: "memory"); __builtin_amdgcn_s_barrier(); asm volatile("" ::: "memory"); } while (0)
DI void dn_scan_prompt(const Args& a, unsigned char* lds, int tid) {
    asm volatile("" : "+v"(tid));
    const int wave = __builtin_amdgcn_readfirstlane(tid >> 6), lane = tid & 63, fr = lane & 15, fq = lane >> 4;
    const int bh = blockIdx.x >> 2, qt = blockIdx.x & 3, b = bh >> 2, h = bh & 3;
    const int c0 = qt * 32, v0 = c0 + (wave & 1) * 16;
    const unsigned char* recs = a.ws + WS_DNC + (size_t)bh * 128 * REC;
    const float* egs = (const float*)(a.ws + WS_EG) + bh * 128;
    float* ORAW = (float*)(a.ws + WS_H);
    const bool loader = wave >= 2;
    const int lt = tid - 128;
    f32x4 S[8];
#pragma unroll
    for (int m8 = 0; m8 < 8; ++m8) S[m8] = (f32x4){0.f, 0.f, 0.f, 0.f};
    float egA = egs[lane], egB = egs[64 + lane];
    asm volatile("s_waitcnt vmcnt(0)" : "+v"(egA), "+v"(egB) :: "memory");
    if (loader) {
        const int grp = wave >= 5 ? 1 : 0, lt2 = tid - 128 - grp * 192;
        u32x4 R[20];
#define DN_LD20(base) do { _Pragma("unroll") for (int k = 0; k < 20; ++k) { unsigned s_, d_; dn_piece(lt2 + 192 * k, c0, s_, d_); R[k] = *(const u32x4*)((base) + s_); } } while (0)
#define DN_ST20(buf) do { _Pragma("unroll") for (int k = 0; k < 20; ++k) { unsigned s_, d_; dn_piece(lt2 + 192 * k, c0, s_, d_); *(u32x4*)((buf) + d_) = R[k]; } } while (0)
        if (grp == 0) { DN_LD20(recs); DN_ST20(lds); DN_LD20(recs + 2 * (size_t)REC); }
        else { DN_LD20(recs + REC); }
        DN_BAR();
        for (int n = 0; n < 128; n += 2) {
            if (grp == 1) { DN_ST20(lds + DBP_SIZE); if (n + 3 < 128) DN_LD20(recs + (size_t)(n + 3) * REC); }
            DN_BAR();
            if (grp == 0 && n + 2 < 128) { DN_ST20(lds); if (n + 4 < 128) DN_LD20(recs + (size_t)(n + 4) * REC); }
            DN_BAR();
        }
#undef DN_LD20
#undef DN_ST20
    } else {
        DN_BAR();
        for (int n = 0; n < 128; ++n) {
            const float eg0 = __int_as_float(__builtin_amdgcn_readlane(__float_as_int(n < 64 ? egA : egB), n & 63));
            f32x4 o[4];
#if DN_STAGED
            dn_step_p(lds + (n & 1) * DBP_SIZE, S, lds + (n & 1) * DBP_SIZE + DB_U0 + ((wave & 1) * 16 + fr) * 2, eg0, fr, fq, o);
#else
            dn_step<80>(lds + (n & 1) * DBP_SIZE, S, lds + (n & 1) * DBP_SIZE + DB_U0 + ((wave & 1) * 16 + fr) * 2, eg0, fr, fq, o);
#endif
            float* op = ORAW + (size_t)(b * 8192 + n * 64) * 512 + h * 128 + v0 + fr;
#pragma unroll
            for (int mt = 0; mt < 4; ++mt)
#pragma unroll
                for (int i = 0; i < 4; ++i) op[(size_t)(16 * mt + 4 * fq + i) * 512] = o[mt][i];
            DN_BAR();
        }
    }
    if (!loader) {
        float* so = a.out + O_PDS + (size_t)bh * 128 * 128 + v0 + fr;
#pragma unroll
        for (int m8 = 0; m8 < 8; ++m8)
#pragma unroll
            for (int i = 0; i < 4; ++i) so[(16 * m8 + 4 * fq + i) * 128] = S[m8][i];
    }
    __syncthreads();
}
DI void dn_scan_sample(const Args& a, unsigned char* lds, int tid, int wg, int nwg) {
    asm volatile("" : "+v"(tid));
    const int wave = __builtin_amdgcn_readfirstlane(tid >> 6), lane = tid & 63, fr = lane & 15, fq = lane >> 4;
    const int v0 = wave * 16;
    float* ORAW = (float*)(a.ws + WS_H);
    for (int su = wg; su < 128; su += nwg) {
        const int sb = su >> 2, h = su & 3;
        const unsigned char* rec = a.ws + WS_DNC + (size_t)(2048 + su) * REC;
        DnRegs<128> R; dn_load<128>(rec, tid, 0, R); dn_store<128>(lds, tid, R);
        __syncthreads();
        f32x4 S[8];
        const float* s0 = a.in[3] + (size_t)su * 128 * 128 + v0 + fr;
#pragma unroll
        for (int m8 = 0; m8 < 8; ++m8)
#pragma unroll
            for (int i = 0; i < 4; ++i) S[m8][i] = s0[(16 * m8 + 4 * fq + i) * 128];
        f32x4 o[4];
        dn_step<272>(lds, S, lds + DB_U0 + (v0 + fr) * 2, ((const float*)(a.ws + WS_EG))[2048 + su], fr, fq, o);
        float* op = ORAW + (size_t)(TP + sb * 16) * 512 + h * 128 + v0 + fr;
#pragma unroll
        for (int i = 0; i < 4; ++i) op[(size_t)(4 * fq + i) * 512] = o[0][i];
        float* so = a.out + O_SDS + (size_t)su * 128 * 128 + v0 + fr;
#pragma unroll
        for (int m8 = 0; m8 < 8; ++m8)
#pragma unroll
            for (int i = 0; i < 4; ++i) so[(16 * m8 + 4 * fq + i) * 128] = S[m8][i];
        __syncthreads();
    }
}

DI void mix_phase(const Args& a, int gw, int NGW, int lane) {
    asm volatile("" : "+v"(lane));
    const float* ORAW = (const float*)(a.ws + WS_H);
    const bf16* P = (const bf16*)(a.ws + WS_P);
    const bf16* GLU = (const bf16*)(a.ws + WS_GLU);
    bf16* MIX = (bf16*)(a.ws + WS_DNC);
    const f32x2 dg = *(const f32x2*)(a.in[12] + 2 * lane);
    const f32x4 sg0 = *(const f32x4*)(a.in[23] + 8 * lane), sg1 = *(const f32x4*)(a.in[23] + 8 * lane + 4);
    for (int row = gw; row < T; row += NGW) {
#pragma unroll
        for (int h = 0; h < 4; ++h) {
            const f32x2 ov = *(const f32x2*)(ORAW + (size_t)row * 512 + h * 128 + 2 * lane);
            const float r = rsqrtf(wave_sum(ov.x * ov.x + ov.y * ov.y) * (1.f / 128.f) + EPS);
            const unsigned zz = *(const unsigned*)(P + (size_t)row * PW + 1536 + h * 128 + 2 * lane);
            *(unsigned*)(MIX + (size_t)row * DM + h * 128 + 2 * lane) = pk2(ov.x * r * dg.x * silu(blo(zz)), ov.y * r * dg.y * silu(bhi(zz)));
        }
        const u32x4 gv = *(const u32x4*)(GLU + (size_t)row * 512 + 8 * lane);
        float v[8] = {blo(gv.x), bhi(gv.x), blo(gv.y), bhi(gv.y), blo(gv.z), bhi(gv.z), blo(gv.w), bhi(gv.w)};
        float ss = 0.f;
#pragma unroll
        for (int e = 0; e < 8; ++e) ss += v[e] * v[e];
        const float r5 = rsqrtf(wave_sum(ss) * (1.f / 512.f) + EPS);
        u32x4 w; w.x = pk2(v[0] * r5 * sg0[0], v[1] * r5 * sg0[1]); w.y = pk2(v[2] * r5 * sg0[2], v[3] * r5 * sg0[3]);
        w.z = pk2(v[4] * r5 * sg1[0], v[5] * r5 * sg1[1]); w.w = pk2(v[6] * r5 * sg1[2], v[7] * r5 * sg1[3]);
        *(u32x4*)(MIX + (size_t)row * DM + 512 + 8 * lane) = w;
    }
}

DI void act_phase(const Args& a, int gtid, int NT) {
    asm volatile("" : "+v"(gtid));
    bf16* UP = (bf16*)(a.ws + WS_UP);
    const float* fw = a.in[27]; const float* fb = a.in[28];
    constexpr int NCG = DFF / 8;
    for (int item = gtid; item < (T / 16) * NCG; item += NT) {
        const int cg8 = item % NCG, rb = item / NCG, col = cg8 * 8, row0 = rb * 16;
        float w0[8], w1[8], w2[8], bb[8], g2[8], g1[8];
#pragma unroll
        for (int e = 0; e < 8; ++e) { w0[e] = fw[col + e]; w1[e] = fw[DFF + col + e]; w2[e] = fw[2 * DFF + col + e]; bb[e] = fb[col + e]; g2[e] = 0.f; g1[e] = 0.f; }
        const bool sample = row0 >= TP;
        float* outp = nullptr;
        if (sample) { const int sb = (row0 - TP) >> 4; const float* cc = a.in[6] + (size_t)sb * 2 * DFF + col;
#pragma unroll
            for (int e = 0; e < 8; ++e) { g2[e] = cc[e]; g1[e] = cc[DFF + e]; }
            outp = a.out + O_SFC + (size_t)sb * 2 * DFF + col;
        } else {
            if ((rb & 511) != 0) {
                const u32x4 x2 = *(const u32x4*)(UP + (size_t)(row0 - 2) * UPW + col), x1 = *(const u32x4*)(UP + (size_t)(row0 - 1) * UPW + col);
                g2[0] = blo(x2.x); g2[1] = bhi(x2.x); g2[2] = blo(x2.y); g2[3] = bhi(x2.y); g2[4] = blo(x2.z); g2[5] = bhi(x2.z); g2[6] = blo(x2.w); g2[7] = bhi(x2.w);
                g1[0] = blo(x1.x); g1[1] = bhi(x1.x); g1[2] = blo(x1.y); g1[3] = bhi(x1.y); g1[4] = blo(x1.z); g1[5] = bhi(x1.z); g1[6] = blo(x1.w); g1[7] = bhi(x1.w);
            }
            if ((rb & 511) == 511) outp = a.out + O_PFC + (size_t)(rb >> 9) * 2 * DFF + col;
        }
#pragma unroll 4
        for (int r = 0; r < 16; ++r) {
            bf16* gp = UP + (size_t)(row0 + r) * UPW + col;
            const u32x4 xg = *(const u32x4*)gp, xv = *(const u32x4*)(gp + DFF);
            float g0[8] = {blo(xg.x), bhi(xg.x), blo(xg.y), bhi(xg.y), blo(xg.z), bhi(xg.z), blo(xg.w), bhi(xg.w)};
            float vv[8] = {blo(xv.x), bhi(xv.x), blo(xv.y), bhi(xv.y), blo(xv.z), bhi(xv.z), blo(xv.w), bhi(xv.w)};
            float o[8];
#pragma unroll
            for (int e = 0; e < 8; ++e) { o[e] = silu(g2[e] * w0[e] + g1[e] * w1[e] + g0[e] * w2[e] + bb[e]) * vv[e]; g2[e] = g1[e]; g1[e] = g0[e]; }
            u32x4 w; w.x = pk2(o[0], o[1]); w.y = pk2(o[2], o[3]); w.z = pk2(o[4], o[5]); w.w = pk2(o[6], o[7]);
            *(u32x4*)(gp + DFF) = w;
            if (outp && r >= 14) {
#pragma unroll
                for (int e = 0; e < 8; ++e) outp[(r - 14) * DFF + e] = g0[e];
            }
        }
    }
}

DI void final_phase(const Args& a, int gw, int NGW, int lane) {
    asm volatile("" : "+v"(lane));
    f32x4 gv[4];
#pragma unroll
    for (int j = 0; j < 4; ++j) gv[j] = ((const f32x4*)a.in[30])[lane + 64 * j];
    for (int m = gw; m < T; m += NGW) {
        f32x4* xr = (f32x4*)(a.out + (size_t)m * DM) + lane;
        f32x4 v[4]; float s = 0.f;
#pragma unroll
        for (int j = 0; j < 4; ++j) { v[j] = xr[64 * j]; s += (v[j].x * v[j].x + v[j].y * v[j].y) + (v[j].z * v[j].z + v[j].w * v[j].w); }
        const float rstd = rsqrtf(wave_sum(s) * (1.f / DM) + EPS);
#pragma unroll
        for (int j = 0; j < 4; ++j) xr[64 * j] = v[j] * rstd * gv[j];
    }
}

#ifndef PH_MASK
#define PH_MASK 0xffff
#endif
#ifndef SOLVE_RL
#define SOLVE_RL 1
#endif
#ifndef REP0
#define REP0 1
#endif
#ifndef REP1
#define REP1 1
#endif
#ifndef REP2A
#define REP2A 1
#endif
#ifndef REP2B
#define REP2B 1
#endif
#ifndef REP3A
#define REP3A 1
#endif
#ifndef REP3B
#define REP3B 1
#endif
#ifndef REP3C
#define REP3C 1
#endif
#ifndef PH_LO
#define PH_LO 0
#endif
#ifndef PH_HI
#define PH_HI 99
#endif
__global__ void __launch_bounds__(512, 2) fwd_kernel(Args a) {
    extern __shared__ __attribute__((aligned(16))) unsigned char lds[];
    cg::grid_group grid = cg::this_grid();
    const int tid = threadIdx.x, lane = tid & 63, wave = __builtin_amdgcn_readfirstlane(tid >> 6);
    const int G = gridDim.x, gw = blockIdx.x * 8 + wave, NGW = G * 8;
    unsigned char* ws = a.ws;
    PG8_LAS unsigned char* ldsg = (PG8_LAS unsigned char*)lds;

    _Pragma("nounroll") for (int rep = 0; rep < REP0; ++rep) { phase0(a, lds, gw, NGW, wave, lane); __syncthreads(); }
    grid.sync();
    _Pragma("nounroll") for (int rep = 0; rep < REP1; ++rep)
    { pg8::Gemm g{(const bf16*)(ws + WS_H), (const bf16*)(ws + WS_WIN), T, NIN, DM, DM}; pg8::StaticOrder S; S.init(T, NIN, G, (int)blockIdx.x);
      EpiP E{(bf16*)(ws + WS_P), (float*)(ws + WS_BA)};
      pg8::gemm_phase<EpiP, pg8::StaticOrder, true, true>(ldsg, g, S, E); }
    grid.sync();
    _Pragma("nounroll") for (int rep = 0; rep < REP2A; ++rep) dn_chunk_phase(a, lds, tid);
#if OLD_S5 && OLD_S5 != 4 && OLD_S5 != 5
    old_s5_pass1(a, gw, NGW, lane);
#elif 0
#else
    _Pragma("nounroll") for (int rep = 0; rep < REP2B; ++rep) s5_pass1(a, gw, NGW, lane);
#endif
    grid.sync();
#if OLD_S5 == 3
    if (blockIdx.x < 64) dn_scan_prompt(a, lds, tid);
    else { if (blockIdx.x >= 192) { dn_scan_sample(a, lds, tid, (int)blockIdx.x - 192, 64); s5_pass2_sample(a, lds + 81920 + wave * 4352, ((int)blockIdx.x - 192) * 8 + wave, 512, lane); __syncthreads(); }
           old_s5_pass2(a, lds + 81920 + wave * 4352, gw - 512, NGW - 512, lane); }
#elif OLD_S5 == 5
    if (blockIdx.x < 64) { _Pragma("nounroll") for (int rep = 0; rep < REP3A; ++rep) dn_scan_prompt(a, lds, tid); }
    else { if (blockIdx.x >= 192) dn_scan_sample(a, lds, tid, (int)blockIdx.x - 192, 64); _Pragma("nounroll") for (int rep = 0; rep < REP3B; ++rep) s5_pass2b(a, lds + wave * 14592, gw - 512, NGW - 512, lane); }
#elif OLD_S5 == 1 || OLD_S5 == 4
    if (blockIdx.x < 64) dn_scan_prompt(a, lds, tid);
    else { if (blockIdx.x >= 192) dn_scan_sample(a, lds, tid, (int)blockIdx.x - 192, 64); old_s5_pass2(a, lds + 81920 + wave * 4352, gw - 512, NGW - 512, lane); }
#else
    if (blockIdx.x < 64) { _Pragma("nounroll") for (int rep = 0; rep < REP3A; ++rep) dn_scan_prompt(a, lds, tid); }
    else if (blockIdx.x < 192) { _Pragma("nounroll") for (int rep = 0; rep < REP3B; ++rep) s5_pass2_prompt(a, lds, (int)blockIdx.x - 64, tid); }
    else { _Pragma("nounroll") for (int rep = 0; rep < REP3C; ++rep) { dn_scan_sample(a, lds, tid, (int)blockIdx.x - 192, 64); s5_pass2_sample(a, lds + 81920 + wave * 4352, ((int)blockIdx.x - 192) * 8 + wave, 512, lane); } }
#endif
    grid.sync();
#if PH_MASK & 512
    { pg8::Gemm g{(const bf16*)(ws + WS_Y5), (const bf16*)(ws + WS_WGLU), T, 1024, 512, 512}; pg8::StaticOrder S; S.init(T, 1024, G, (int)blockIdx.x);
      EpiGlu E{(bf16*)(ws + WS_GLU), a.in[22]};
      pg8::gemm_phase<EpiGlu, pg8::StaticOrder, true, true>(ldsg, g, S, E); }
#endif
    grid.sync();
#if PH_MASK & 32
    mix_phase(a, gw, NGW, lane);
#endif
    grid.sync();
#if PH_MASK & 1024
    { pg8::Gemm g{(const bf16*)(ws + WS_DNC), (const bf16*)(ws + WS_WOUT), T, DM, DM, DM}; pg8::StaticOrder S; S.init(T, DM, G, (int)blockIdx.x);
      EpiX1 E{a.in[0], a.in[1], a.out, (bf16*)(ws + WS_H), (float*)(ws + WS_SS2)};
      pg8::gemm_phase<EpiX1, pg8::StaticOrder, true, true>(ldsg, g, S, E); }
#endif
    grid.sync();
#if PH_MASK & 2048
    { pg8::Gemm g{(const bf16*)(ws + WS_H), (const bf16*)(ws + WS_WUP), T, UPW, DM, DM}; pg8::StaticOrder S; S.init(T, UPW, G, (int)blockIdx.x);
      EpiUp E{(bf16*)(ws + WS_UP), (const float*)(ws + WS_SS2)};
      pg8::gemm_phase<EpiUp, pg8::StaticOrder, true, true>(ldsg, g, S, E); }
#endif
    grid.sync();
#if PH_MASK & 64
    act_phase(a, (int)blockIdx.x * 512 + tid, G * 512);
#endif
    grid.sync();
#if PH_MASK & 4096
    { pg8::Gemm g{(const bf16*)(ws + WS_UP) + DFF, (const bf16*)(ws + WS_WDOWN), T, DM, DFF, UPW}; pg8::StaticOrder S; S.init(T, DM, G, (int)blockIdx.x);
      EpiX2 E{a.out};
      pg8::gemm_phase<EpiX2, pg8::StaticOrder, true, true>(ldsg, g, S, E); }
#endif
    grid.sync();
#if PH_MASK & 128
    final_phase(a, gw, NGW, lane);
#endif
}

extern "C" void kernel_launch(void* const* d_in, const int* in_sizes, int n_in, void* d_out, int out_size, void* d_ws, size_t ws_size, hipStream_t stream) {
    static int grid = 0;
    if (grid == 0) {
        if (n_in != 31 || (size_t)out_size != O_END || ws_size < WS_END) { fprintf(stderr, "kernel_launch: unexpected shapes n_in %d out %d ws %zu\n", n_in, out_size, ws_size); grid = -1; return; }
        int dev = 0, cus = 0, per_cu = 0;
        hipGetDevice(&dev);
        hipDeviceGetAttribute(&cus, hipDeviceAttributeMultiprocessorCount, dev);
        hipFuncSetAttribute((const void*)fwd_kernel, hipFuncAttributeMaxDynamicSharedMemorySize, LDS_BYTES);
        hipOccupancyMaxActiveBlocksPerMultiprocessor(&per_cu, (const void*)fwd_kernel, 512, LDS_BYTES);
        if (per_cu < 1) { fprintf(stderr, "kernel_launch: occupancy query says %d blocks per CU\n", per_cu); per_cu = 1; }
        grid = cus * 1;
        if (grid != 256) { fprintf(stderr, "kernel_launch: built for a 256-CU device, got %d\n", cus); grid = -1; return; }
        (void)hipGetLastError();
    }
    if (grid < 0) return;
    Args a{};
    for (int i = 0; i < 31; ++i) a.in[i] = (const float*)d_in[i];
    a.out = (float*)d_out; a.ws = (unsigned char*)d_ws;
    void* args[] = {&a};
    hipError_t e = hipLaunchCooperativeKernel((const void*)fwd_kernel, dim3(grid), dim3(512), args, LDS_BYTES, stream);
    if (e != hipSuccess) fprintf(stderr, "cooperative launch failed: %s (grid %d)\n", hipGetErrorString(e), grid);
}
```

```cpp
#include <hip/hip_runtime.h>
#include <hip/hip_cooperative_groups.h>
#include <cstdio>
#include <cstdint>
namespace cg = cooperative_groups;
#define OLD_S5 5
#define DN_STAGED 2
namespace pg8 {
#define PG8_LAS __attribute__((address_space(3)))
typedef unsigned short bf16_t;
typedef short bf16x8 __attribute__((ext_vector_type(8)));
typedef float f32x4 __attribute__((ext_vector_type(4)));
typedef unsigned u32x4 __attribute__((ext_vector_type(4)));
constexpr int BM = 256, BK = 64, HALF = 128, HTB = HALF * BK * 2  , STAGE_BYTES = 8 * HTB, NXCD = 8, WGM = 8;

__host__ __device__ __forceinline__ int lds_byte(int r, int c) { const int st = (r >> 4) * 2 + (c >> 5), rr = r & 15, cc = c & 31, ob = rr * 64 + cc * 2; return st * 1024 + (ob ^ (((ob >> 9) & 1) << 5)); }
__host__ __device__ __forceinline__ void stage_rc(int b, int& R, int& C) { const int st = b / 1024, sb = b % 1024, swz = sb ^ (((sb >> 9) & 1) << 5); R = (st >> 1) * 16 + swz / 64; C = (st & 1) * 32 + (swz % 64) / 2; }
__host__ __device__ __forceinline__ int perm32(int rho) { const int n = rho >> 4, i = rho & 15; return 8 * (i >> 2) + 4 * n + (i & 3); }

struct Unit { int pm, pn; };
struct Gemm { const bf16_t* A; const bf16_t* Bt; int M, N, K, lda; };

struct StaticOrder {
    int nM, nN, nwg, G, c;
    __host__ __device__ void init(int M, int N, int G_, int c_) { nM = M / BM; nN = N / BM; nwg = nM * nN; G = G_; c = c_; }
    __host__ __device__ bool next(int i, Unit& u) const {
        const long L = (long)i * G + c; if (L >= nwg) return false;
        int wgid = (int)L; { const int q = nwg / NXCD, r = nwg % NXCD, xcd = wgid % NXCD, off = wgid / NXCD; wgid = (xcd < r ? xcd * (q + 1) : r * (q + 1) + (xcd - r) * q) + off; }
        const int nig = WGM * nN, gid = wgid / nig, fm = gid * WGM, gsz = (nM - fm) < WGM ? (nM - fm) : WGM;
        u.pm = fm + ((wgid % nig) % gsz); u.pn = (wgid % nig) / gsz; return true;
    }
    __device__ __forceinline__ void a_ready(const Unit&) const {}
    __device__ __forceinline__ void done(const Unit&) const {}
};
__device__ __forceinline__ unsigned cvt_pk_bf16(float lo, float hi) { unsigned r; asm volatile("v_cvt_pk_bf16_f32 %0, %1, %2" : "=v"(r) : "v"(lo), "v"(hi)); return r; }
typedef float f32x2 __attribute__((ext_vector_type(2)));
template <class Epi, class Sched, bool ALIGN_EPI = false, bool SP2 = false>
__device__ __forceinline__ void gemm_phase(PG8_LAS unsigned char* lds, const Gemm g, const Sched& S, const Epi& E) {
    int tid_ = threadIdx.x; asm volatile("" : "+v"(tid_));
    const int tid = tid_, wid = __builtin_amdgcn_readfirstlane(tid >> 6), lane = tid & 63, wr = wid >> 2, wc = wid & 3, fr = lane & 15, fq = lane >> 4;
    const int K = g.K, nt = K / BK;
    unsigned voffA[2], voffB[2];
#pragma unroll
    for (int i = 0; i < 2; ++i) { int R, C; stage_rc(tid * 16 + i * 8192, R, C); const int Rb = Epi::PERM ? ((R & ~31) + perm32(R & 31)) : R;
        voffA[i] = (unsigned)(R * g.lda + C) * 2u; voffB[i] = (unsigned)(Rb * K + C) * 2u; }
    const size_t kstep = (size_t)(BK * 2);
    const size_t hstep = (size_t)HALF * K * 2;
    const size_t tstep = 2 * hstep; const size_t hstepA = (size_t)HALF * g.lda * 2, tstepA = 2 * hstepA;
    const unsigned ldsw = (unsigned)wid * 1024u;
    const int aoff = lds_byte(wr * 64 + fr, fq * 8), boff = lds_byte(wc * 32 + fr, fq * 8);
#define PG8_SA(b, h) (((b) * 2 + (h)) * HTB)
#define PG8_SB(b, h) ((4 + (b) * 2 + (h)) * HTB)
#define PG8_STAGE(bufoff, gbase, voff) do { _Pragma("unroll") for (int _i = 0; _i < 2; ++_i) \
        __builtin_amdgcn_global_load_lds((const unsigned*)((const char*)(gbase) + (voff)[_i]), (PG8_LAS unsigned*)(lds + (bufoff) + ldsw + _i * 8192), 16, 0, 0); } while (0)
#define PG8_LDA(dst, b, h) do { _Pragma("unroll") for (int m = 0; m < 4; ++m) _Pragma("unroll") for (int k = 0; k < 2; ++k) dst[m][k] = *(const PG8_LAS bf16x8*)(lds + PG8_SA(b, h) + aoff + m * 2048 + k * 1024); } while (0)
#define PG8_LDB(dst, b, h) do { _Pragma("unroll") for (int n = 0; n < 2; ++n) _Pragma("unroll") for (int k = 0; k < 2; ++k) dst[n][k] = *(const PG8_LAS bf16x8*)(lds + PG8_SB(b, h) + boff + n * 2048 + k * 1024); } while (0)
#define PG8_MMA(ai, bj, At, Bt) do { __builtin_amdgcn_s_setprio(1); _Pragma("unroll") for (int m = 0; m < 4; ++m) _Pragma("unroll") for (int n = 0; n < 2; ++n) _Pragma("unroll") for (int k = 0; k < 2; ++k) \
        acc[ai][bj][m][n] = __builtin_amdgcn_mfma_f32_16x16x32_bf16(Bt[n][k], At[m][k], acc[ai][bj][m][n], 0, 0, 0); __builtin_amdgcn_s_setprio(0); } while (0)
#define PG8_WAIT_V(n) asm volatile("s_waitcnt vmcnt(" #n ")" ::: "memory")
#define PG8_WAIT_L(n) asm volatile("s_waitcnt lgkmcnt(" #n ")" ::: "memory")
#define PG8_BAR __builtin_amdgcn_s_barrier()
#define PG8_SCHED __builtin_amdgcn_sched_barrier(0)
    Unit cur, nxt; int ui = 0;
    if (!S.next(0, cur)) return;
    f32x4 acc[2][2][4][2];
#pragma unroll
    for (int a = 0; a < 2; ++a)
#pragma unroll
        for (int b = 0; b < 2; ++b)
#pragma unroll
            for (int m = 0; m < 4; ++m)
#pragma unroll
                for (int n = 0; n < 2; ++n) acc[a][b][m][n] = (f32x4){0.f, 0.f, 0.f, 0.f};
    bf16x8 At[4][2], B0[2][2], B1[2][2];
    const char* cA = (const char*)g.A + (size_t)cur.pm * tstepA; const char* cB = (const char*)g.Bt + (size_t)cur.pn * tstep;
    S.a_ready(cur);
    if constexpr (SP2) {
        PG8_STAGE(PG8_SB(0, 0), cB, voffB); PG8_STAGE(PG8_SB(0, 1), cB + hstep, voffB); PG8_STAGE(PG8_SA(0, 0), cA, voffA); PG8_STAGE(PG8_SA(0, 1), cA + hstepA, voffA);
        if (wr == 1) PG8_BAR;
        PG8_WAIT_V(2); PG8_BAR;
        PG8_STAGE(PG8_SB(1, 0), cB + kstep, voffB); PG8_STAGE(PG8_SA(1, 0), cA + kstep, voffA); PG8_STAGE(PG8_SB(1, 1), cB + hstep + kstep, voffB);
        PG8_WAIT_V(6); PG8_BAR;
    } else {
        PG8_STAGE(PG8_SB(0, 0), cB, voffB); PG8_STAGE(PG8_SA(0, 0), cA, voffA); PG8_STAGE(PG8_SB(0, 1), cB + hstep, voffB); PG8_STAGE(PG8_SA(0, 1), cA + hstepA, voffA);
        if (wr == 1) PG8_BAR;
        PG8_WAIT_V(4); PG8_BAR;
        PG8_STAGE(PG8_SB(1, 0), cB + kstep, voffB); PG8_STAGE(PG8_SA(1, 0), cA + kstep, voffA); PG8_STAGE(PG8_SB(1, 1), cB + hstep + kstep, voffB);
        PG8_WAIT_V(6); PG8_BAR;
    }
    for (;;) {
        const bool has_next = S.next(ui + 1, nxt);
        const char* nA = has_next ? (const char*)g.A + (size_t)nxt.pm * tstepA : cA; const char* nB = has_next ? (const char*)g.Bt + (size_t)nxt.pn * tstep : cB;
        for (int t = 0; t < nt; t += 2) {
            const bool last = (t == nt - 2);
            const char* a1 = cA + (size_t)(t + 1) * kstep;
            const char* a2 = last ? nA : cA + (size_t)(t + 2) * kstep; const char* b2 = last ? nB : cB + (size_t)(t + 2) * kstep;
            const char* a3 = a2 + kstep; const char* b3 = b2 + kstep;
            if (last && has_next) S.a_ready(nxt);
            if constexpr (SP2) {
            PG8_LDB(B0, 0, 0); PG8_LDB(B1, 0, 1); PG8_SCHED; PG8_LDA(At, 0, 0); PG8_STAGE(PG8_SA(1, 1), a1 + hstepA, voffA);
            PG8_WAIT_V(8); PG8_WAIT_L(0); PG8_BAR; PG8_MMA(0, 0, At, B0); PG8_MMA(0, 1, At, B1); PG8_BAR; PG8_SCHED;
            PG8_LDA(At, 0, 1); PG8_STAGE(PG8_SB(0, 0), b2, voffB); PG8_STAGE(PG8_SB(0, 1), b2 + hstep, voffB); PG8_STAGE(PG8_SA(0, 0), a2, voffA);
            PG8_WAIT_V(8); PG8_WAIT_L(0); PG8_BAR; PG8_MMA(1, 0, At, B0); PG8_MMA(1, 1, At, B1); PG8_BAR; PG8_SCHED;
            PG8_LDB(B0, 1, 0); PG8_LDB(B1, 1, 1); PG8_SCHED; PG8_LDA(At, 1, 0); PG8_STAGE(PG8_SA(0, 1), a2 + hstepA, voffA);
            PG8_WAIT_V(8); PG8_WAIT_L(0); PG8_BAR; PG8_MMA(0, 0, At, B0); PG8_MMA(0, 1, At, B1); PG8_BAR; PG8_SCHED;
            PG8_LDA(At, 1, 1); PG8_STAGE(PG8_SB(1, 0), b3, voffB); PG8_STAGE(PG8_SB(1, 1), b3 + hstep, voffB); PG8_STAGE(PG8_SA(1, 0), a3, voffA);
            PG8_WAIT_V(8); PG8_WAIT_L(0); PG8_BAR; PG8_MMA(1, 0, At, B0); PG8_MMA(1, 1, At, B1); PG8_BAR; PG8_SCHED;
            } else {
            PG8_LDB(B0, 0, 0); PG8_SCHED; PG8_LDA(At, 0, 0); PG8_STAGE(PG8_SA(1, 1), a1 + hstepA, voffA);
            PG8_WAIT_L(8); PG8_BAR; PG8_WAIT_L(0); PG8_MMA(0, 0, At, B0); PG8_BAR; PG8_SCHED;
            PG8_LDB(B1, 0, 1); PG8_STAGE(PG8_SB(0, 0), b2, voffB);
            PG8_BAR; PG8_WAIT_L(0); PG8_MMA(0, 1, At, B1); PG8_BAR;
            PG8_LDA(At, 0, 1); PG8_STAGE(PG8_SA(0, 0), a2, voffA);
            PG8_BAR; PG8_WAIT_L(0); PG8_MMA(1, 0, At, B0); PG8_BAR; PG8_SCHED;
            PG8_STAGE(PG8_SB(0, 1), b2 + hstep, voffB);
            PG8_WAIT_V(6); PG8_BAR; PG8_MMA(1, 1, At, B1); PG8_BAR;
            PG8_LDB(B0, 1, 0); PG8_SCHED; PG8_LDA(At, 1, 0); PG8_STAGE(PG8_SA(0, 1), a2 + hstepA, voffA);
            PG8_WAIT_L(8); PG8_BAR; PG8_WAIT_L(0); PG8_MMA(0, 0, At, B0); PG8_BAR; PG8_SCHED;
            PG8_LDB(B1, 1, 1); PG8_STAGE(PG8_SB(1, 0), b3, voffB);
            PG8_BAR; PG8_WAIT_L(0); PG8_MMA(0, 1, At, B1); PG8_BAR;
            PG8_LDA(At, 1, 1); PG8_STAGE(PG8_SA(1, 0), a3, voffA);
            PG8_BAR; PG8_WAIT_L(0); PG8_MMA(1, 0, At, B0); PG8_BAR; PG8_SCHED;
            PG8_STAGE(PG8_SB(1, 1), b3 + hstep, voffB);
            PG8_WAIT_V(6); PG8_BAR; PG8_MMA(1, 1, At, B1); PG8_BAR;
            }
        }
        if constexpr (ALIGN_EPI) { if (wr == 0) PG8_BAR; }
        if constexpr (!Epi::AFTER_DRAIN) { E(acc, cur, wr, wc, fr, fq); S.done(cur); }
        if (!has_next) break;
#pragma unroll
        for (int a = 0; a < 2; ++a)
#pragma unroll
            for (int b = 0; b < 2; ++b)
#pragma unroll
                for (int m = 0; m < 4; ++m)
#pragma unroll
                    for (int n = 0; n < 2; ++n) acc[a][b][m][n] = (f32x4){0.f, 0.f, 0.f, 0.f};
        cur = nxt; cA = nA; cB = nB; ++ui;
        if constexpr (ALIGN_EPI) { if (wr == 1) PG8_BAR; }
    }
    PG8_WAIT_V(0);
    if constexpr (!ALIGN_EPI) { if (wr == 0) PG8_BAR; }
    PG8_BAR;
    if constexpr (Epi::AFTER_DRAIN) { E.fused(acc, cur, wr, wc, fr, fq, lds, wid, lane); S.done(cur); }
#undef PG8_SA
#undef PG8_SB
#undef PG8_STAGE
#undef PG8_LDA
#undef PG8_LDB
#undef PG8_MMA
#undef PG8_WAIT_V
#undef PG8_WAIT_L
#undef PG8_BAR
#undef PG8_SCHED
}
}

#ifndef DN_STAGED
#define DN_STAGED 1
#endif
#ifndef DIAG_Y
#define DIAG_Y 0
#endif
#ifndef OLD_S5
#define OLD_S5 0
#endif
#if OLD_S5 == 3
#define OLD_S5_ULIM 8192
#else
#define OLD_S5_ULIM (4 * 32 * 64 + 32 * 32)
#endif
#define DI __device__ __forceinline__
typedef unsigned short bf16;
typedef float f32x4 __attribute__((ext_vector_type(4)));
typedef float f32x2 __attribute__((ext_vector_type(2)));
typedef short bf16x8 __attribute__((ext_vector_type(8)));
typedef unsigned u32x4 __attribute__((ext_vector_type(4)));
typedef unsigned u32x2 __attribute__((ext_vector_type(2)));
typedef __bf16 bf16x2_t __attribute__((ext_vector_type(2)));

DI unsigned pk2(float lo, float hi) { f32x2 v = {lo, hi}; bf16x2_t b = __builtin_convertvector(v, bf16x2_t); return __builtin_bit_cast(unsigned, b); }
DI bf16 f2b(float x) { return (bf16)(pk2(x, 0.f) & 0xffffu); }
DI float b2f(unsigned b) { return __uint_as_float(b << 16); }
DI float blo(unsigned w) { return __uint_as_float(w << 16); }
DI float bhi(unsigned w) { return __uint_as_float(w & 0xffff0000u); }
DI float wave_sum(float v) {
#pragma unroll
    for (int o = 1; o < 64; o <<= 1) v += __shfl_xor(v, o);
    return v;
}
DI float sigm(float x) { return 1.f / (1.f + __expf(-x)); }
DI float silu(float x) { return x / (1.f + __expf(-x)); }
DI float gelu_tanh(float x) { const float z = 1.5957691216057308f * (x + 0.044715f * x * x * x); return x / (1.f + __expf(-z)); }
#define MFMA16(a, b, c) __builtin_amdgcn_mfma_f32_16x16x32_bf16((a), (b), (c), 0, 0, 0)

constexpr int TP = 32768, TS = 512, T = TP + TS;
constexpr int DM = 1024, PW = 2560, NIN = 2816, DFF = 2816, UPW = 5632;
constexpr float EPS = 1e-6f;
constexpr int NCH = 2048 + 128;
constexpr int REC = 73728;
constexpr int R_WN = 0, R_QG = 16384, R_KDT = 32768, R_QK = 49152, R_U0 = 57344;
constexpr size_t O_Y = 0, O_PDC = (size_t)T * DM, O_PDS = O_PDC + 4 * 3 * 1536, O_PSR = O_PDS + 4 * 4 * 128 * 128, O_PSI = O_PSR + 4 * 32 * 64,
                 O_PFC = O_PSI + 4 * 32 * 64, O_SDC = O_PFC + 4 * 2 * 2816, O_SDS = O_SDC + 32 * 3 * 1536, O_SSR = O_SDS + (size_t)32 * 4 * 128 * 128,
                 O_SSI = O_SSR + 32 * 32 * 64, O_SFC = O_SSI + 32 * 32 * 64, O_END = O_SFC + 32 * 2 * 2816;
constexpr size_t MiB = 1u << 20;
constexpr size_t WS_SS2 = 0;
constexpr size_t WS_EG = 3 * MiB;
constexpr size_t WS_BA = 4 * MiB;
constexpr size_t WS_WIN = 6 * MiB, WS_WGLU = 12 * MiB, WS_WOUT = 13 * MiB, WS_WUP = 15 * MiB, WS_WDOWN = 26 * MiB;
constexpr size_t WS_H = 32 * MiB;
constexpr size_t WS_P = 98 * MiB;
constexpr size_t WS_DNC = 262 * MiB;
constexpr size_t WS_Y5 = 416 * MiB, WS_GLU = 449 * MiB, WS_S5E = 482 * MiB, WS_END = 487 * MiB;
constexpr size_t WS_UP = 98 * MiB;
static_assert(WS_UP + (size_t)T * UPW * 2 <= WS_END && WS_P + (size_t)T * PW * 2 <= WS_DNC && WS_DNC + (size_t)NCH * REC <= WS_Y5, "ws map");
constexpr int LDS_BYTES = 147456;

struct Args { const float* in[31]; float* out; unsigned char* ws; };

DI int colmap(int mode, int n) {
    if (mode == 0) return n;
    if (mode == 1) return n < 2048 ? n : (n < 2560 ? n + 8 : (n < 2568 ? n - 512 : -1));
    const int pn = n >> 8, bj = (n >> 7) & 1, j = n & 127;
    return bj * (mode == 2 ? 512 : 2816) + 128 * pn + j;
}
DI void transpose_item(const float* W, int K, int N, bf16* WT, float* scr, int kb, int nb, int lane, int mode, const float* rs) {
    const int k0 = 64 * kb, n0 = 32 * nb;
    const int sc = colmap(mode, n0 + (lane & 31));
#pragma unroll 8
    for (int i = 0; i < 32; ++i) { const int kk = 2 * i + (lane >> 5); float v = 0.f; if (sc >= 0) v = W[(size_t)(k0 + kk) * N + sc]; if (rs) v *= rs[k0 + kk]; scr[kk * 33 + (lane & 31)] = v; }
    asm volatile("s_waitcnt lgkmcnt(0)" ::: "memory");
    const int c = lane & 7;
#pragma unroll
    for (int j = 0; j < 4; ++j) { const int n = (lane >> 3) + 8 * j; const float* s = scr + (8 * c) * 33 + n;
        u32x4 o; o.x = pk2(s[0 * 33], s[1 * 33]); o.y = pk2(s[2 * 33], s[3 * 33]); o.z = pk2(s[4 * 33], s[5 * 33]); o.w = pk2(s[6 * 33], s[7 * 33]);
        *(u32x4*)(WT + (size_t)(n0 + n) * K + k0 + 8 * c) = o; }
    asm volatile("s_waitcnt lgkmcnt(0)" ::: "memory");
}
DI void phase0(const Args& a, unsigned char* lds, int gw, int NGW, int wave, int lane) {
    asm volatile("" : "+v"(lane));
    unsigned char* ws = a.ws;
    float* scr = (float*)(lds + wave * 16384);
    constexpr int I_IN = 16 * (NIN / 32), I_GLU = 8 * 32, I_OUT = 16 * 32, I_UP = 16 * (UPW / 32), I_DN = 44 * 32;
    constexpr int NIT = I_IN + I_GLU + I_OUT + I_UP + I_DN;
    for (int it = gw; it < NIT; it += NGW) {
        int r = it;
        if (r < I_IN) { transpose_item(a.in[8], 1024, 2568, (bf16*)(ws + WS_WIN), scr, r / (NIN / 32), r % (NIN / 32), lane, 1, nullptr); continue; } r -= I_IN;
        if (r < I_GLU) { transpose_item(a.in[21], 512, 1024, (bf16*)(ws + WS_WGLU), scr, r / 32, r % 32, lane, 2, nullptr); continue; } r -= I_GLU;
        if (r < I_OUT) { transpose_item(a.in[24], 1024, 1024, (bf16*)(ws + WS_WOUT), scr, r / 32, r % 32, lane, 0, nullptr); continue; } r -= I_OUT;
        if (r < I_UP) { transpose_item(a.in[26], 1024, 5632, (bf16*)(ws + WS_WUP), scr, r / (UPW / 32), r % (UPW / 32), lane, 3, a.in[25]); continue; } r -= I_UP;
        transpose_item(a.in[29], 2816, 1024, (bf16*)(ws + WS_WDOWN), scr, r / 32, r % 32, lane, 0, nullptr);
    }
    const float* g1 = a.in[7];
    f32x4 gv[4];
#pragma unroll
    for (int j = 0; j < 4; ++j) gv[j] = ((const f32x4*)g1)[lane + 64 * j];
    bf16* H = (bf16*)(ws + WS_H);
    for (int m = gw; m < T; m += NGW) {
        const float* xrow = m < TP ? a.in[0] + (size_t)m * DM : a.in[1] + (size_t)(m - TP) * DM;
        const f32x4* xr = (const f32x4*)xrow + lane;
        f32x4 v[4]; float s = 0.f;
#pragma unroll
        for (int j = 0; j < 4; ++j) { v[j] = xr[64 * j]; s += (v[j].x * v[j].x + v[j].y * v[j].y) + (v[j].z * v[j].z + v[j].w * v[j].w); }
        const float rstd = rsqrtf(wave_sum(s) * (1.f / DM) + EPS);
        u32x2* o8 = (u32x2*)(H + (size_t)m * DM) + lane;
#pragma unroll
        for (int j = 0; j < 4; ++j) { u32x2 o; o.x = pk2(v[j].x * rstd * gv[j].x, v[j].y * rstd * gv[j].y); o.y = pk2(v[j].z * rstd * gv[j].z, v[j].w * rstd * gv[j].w); o8[64 * j] = o; }
    }
}

struct EpiP {
    static constexpr bool PERM = true, AFTER_DRAIN = false;
    bf16* P; float* BA;
    DI void operator()(const pg8::f32x4 (&acc)[2][2][4][2], const pg8::Unit& u, int wr, int wc, int fr, int fq) const {
        const int row0 = u.pm * 256 + wr * 64 + fr;
        if (u.pn < 10) {
            const int col0 = u.pn * 256 + wc * 32 + 8 * fq;
#pragma unroll
            for (int ai = 0; ai < 2; ++ai)
#pragma unroll
                for (int m = 0; m < 4; ++m) { bf16* rowp = P + (size_t)(row0 + ai * 128 + m * 16) * PW + col0;
#pragma unroll
                    for (int bj = 0; bj < 2; ++bj) { const pg8::f32x4 v0 = acc[ai][bj][m][0], v1 = acc[ai][bj][m][1];
                        u32x4 w; w.x = pk2(v0[0], v0[1]); w.y = pk2(v0[2], v0[3]); w.z = pk2(v1[0], v1[1]); w.w = pk2(v1[2], v1[3]);
                        *(u32x4*)(rowp + bj * 128) = w; } }
        } else if (wc == 0 && fq == 0) {
#pragma unroll
            for (int ai = 0; ai < 2; ++ai)
#pragma unroll
                for (int m = 0; m < 4; ++m) { float* bp = BA + (size_t)(row0 + ai * 128 + m * 16) * 8;
                    *(pg8::f32x4*)bp = acc[ai][0][m][0]; *(pg8::f32x4*)(bp + 4) = acc[ai][0][m][1]; }
        }
    }
};
struct EpiGlu {
    static constexpr bool PERM = true, AFTER_DRAIN = false;
    bf16* O; const float* gb;
    DI void operator()(const pg8::f32x4 (&acc)[2][2][4][2], const pg8::Unit& u, int wr, int wc, int fr, int fq) const {
        const int row0 = u.pm * 256 + wr * 64 + fr, col0 = u.pn * 128 + wc * 32 + 8 * fq;
        const pg8::f32x4 ba0 = *(const pg8::f32x4*)(gb + col0), ba1 = *(const pg8::f32x4*)(gb + col0 + 4), bg0 = *(const pg8::f32x4*)(gb + 512 + col0), bg1 = *(const pg8::f32x4*)(gb + 512 + col0 + 4);
#pragma unroll
        for (int ai = 0; ai < 2; ++ai)
#pragma unroll
            for (int m = 0; m < 4; ++m) {
                const pg8::f32x4 a0 = acc[ai][0][m][0] + ba0, a1 = acc[ai][0][m][1] + ba1, g0 = acc[ai][1][m][0] + bg0, g1 = acc[ai][1][m][1] + bg1;
                float o[8];
#pragma unroll
                for (int e = 0; e < 4; ++e) { o[e] = a0[e] * sigm(g0[e]); o[4 + e] = a1[e] * sigm(g1[e]); }
                u32x4 w; w.x = pk2(o[0], o[1]); w.y = pk2(o[2], o[3]); w.z = pk2(o[4], o[5]); w.w = pk2(o[6], o[7]);
                *(u32x4*)(O + (size_t)(row0 + ai * 128 + m * 16) * 512 + col0) = w;
            }
    }
};
struct EpiX1 {
    static constexpr bool PERM = false, AFTER_DRAIN = false;
    const float* xp; const float* xs; float* out; bf16* xb; float* ss2;
    DI void operator()(const pg8::f32x4 (&acc)[2][2][4][2], const pg8::Unit& u, int wr, int wc, int fr, int fq) const {
        const int row0 = u.pm * 256 + wr * 64 + fr, col0 = u.pn * 256 + wc * 32 + 4 * fq;
#pragma unroll
        for (int ai = 0; ai < 2; ++ai)
#pragma unroll
            for (int m = 0; m < 4; ++m) {
                const int row = row0 + ai * 128 + m * 16;
                const float* xr = (row < TP ? xp + (size_t)row * DM : xs + (size_t)(row - TP) * DM) + col0;
                float ss = 0.f;
#pragma unroll
                for (int bj = 0; bj < 2; ++bj)
#pragma unroll
                    for (int n = 0; n < 2; ++n) {
                        const pg8::f32x4 v = *(const pg8::f32x4*)(xr + bj * 128 + n * 16) + acc[ai][bj][m][n];
                        *(pg8::f32x4*)(out + (size_t)row * DM + col0 + bj * 128 + n * 16) = v;
                        u32x2 w; w.x = pk2(v[0], v[1]); w.y = pk2(v[2], v[3]);
                        *(u32x2*)(xb + (size_t)row * DM + col0 + bj * 128 + n * 16) = w;
                        ss += (v[0] * v[0] + v[1] * v[1]) + (v[2] * v[2] + v[3] * v[3]);
                    }
                ss += __shfl_xor(ss, 16); ss += __shfl_xor(ss, 32);
                if (fq == 0) ss2[(size_t)row * 16 + u.pn * 4 + wc] = ss;
            }
    }
};
struct EpiUp {
    static constexpr bool PERM = true, AFTER_DRAIN = false;
    bf16* UP; const float* ss2;
    DI void operator()(const pg8::f32x4 (&acc)[2][2][4][2], const pg8::Unit& u, int wr, int wc, int fr, int fq) const {
        const int row0 = u.pm * 256 + wr * 64 + fr, col0 = u.pn * 128 + wc * 32 + 8 * fq;
#pragma unroll
        for (int ai = 0; ai < 2; ++ai)
#pragma unroll
            for (int m = 0; m < 4; ++m) {
                const int row = row0 + ai * 128 + m * 16;
                const pg8::f32x4* sp = (const pg8::f32x4*)(ss2 + (size_t)row * 16);
                const pg8::f32x4 s0 = sp[0], s1 = sp[1], s2 = sp[2], s3 = sp[3];
                const float tot = ((s0[0] + s0[1]) + (s0[2] + s0[3])) + ((s1[0] + s1[1]) + (s1[2] + s1[3])) + ((s2[0] + s2[1]) + (s2[2] + s2[3])) + ((s3[0] + s3[1]) + (s3[2] + s3[3]));
                const float r = rsqrtf(tot * (1.f / DM) + EPS);
                bf16* rowp = UP + (size_t)row * UPW + col0;
#pragma unroll
                for (int bj = 0; bj < 2; ++bj) { const pg8::f32x4 v0 = acc[ai][bj][m][0] * r, v1 = acc[ai][bj][m][1] * r;
                    u32x4 w; w.x = pk2(v0[0], v0[1]); w.y = pk2(v0[2], v0[3]); w.z = pk2(v1[0], v1[1]); w.w = pk2(v1[2], v1[3]);
                    *(u32x4*)(rowp + bj * DFF) = w; }
            }
    }
};
struct EpiX2 {
    static constexpr bool PERM = false, AFTER_DRAIN = false;
    float* out;
    DI void operator()(const pg8::f32x4 (&acc)[2][2][4][2], const pg8::Unit& u, int wr, int wc, int fr, int fq) const {
        const int row0 = u.pm * 256 + wr * 64 + fr, col0 = u.pn * 256 + wc * 32 + 4 * fq;
#pragma unroll
        for (int ai = 0; ai < 2; ++ai)
#pragma unroll
            for (int m = 0; m < 4; ++m) {
                float* orow = out + (size_t)(row0 + ai * 128 + m * 16) * DM + col0;
#pragma unroll
                for (int bj = 0; bj < 2; ++bj)
#pragma unroll
                    for (int n = 0; n < 2; ++n) { pg8::f32x4* p = (pg8::f32x4*)(orow + bj * 128 + n * 16); *p = *p + acc[ai][bj][m][n]; }
            }
    }
};

DI int kperm(int k) { return (k & ~31) | (((k >> 2) & 3) << 3) | (((k >> 4) & 1) << 2) | (k & 3); }
DI void conv_col(const bf16* pcol, float h0, float h1, float h2, const float* cw, int nrows, float* outp, float (&val)[64]) {
    const float w0 = cw[0], w1 = cw[1536], w2 = cw[2 * 1536], w3 = cw[3 * 1536];
    float x3 = h0, x2 = h1, x1 = h2;
#pragma unroll
    for (int r = 0; r < 64; ++r) {
        float x0 = 0.f;
        if (r < nrows) x0 = b2f(pcol[(size_t)r * PW]);
        const float c = x3 * w0 + x2 * w1 + x1 * w2 + x0 * w3;
        val[r] = r < nrows ? silu(c) : 0.f;
        if (outp && r >= nrows - 3 && r < nrows) outp[(r - (nrows - 3)) * 1536] = x0;
        x3 = x2; x2 = x1; x1 = x0;
    }
}
DI void dn_chunk_phase(const Args& a, unsigned char* lds, int tid) {
    unsigned char* ws = a.ws;
    const bf16* P = (const bf16*)(ws + WS_P);
    const float* BA = (const float*)(ws + WS_BA);
    const float* cwt = a.in[9];
    constexpr float QSCALE = 0.08838834764831845f;
    for (int it = blockIdx.x; it < NCH / 2; it += gridDim.x) {
        int tl = tid; asm volatile("" : "+v"(tl));
        const int half = __builtin_amdgcn_readfirstlane(tl >> 8), t8 = tl & 255, hw = __builtin_amdgcn_readfirstlane((tl >> 6) & 3), lane = tl & 63, fr = lane & 15, fq = lane >> 4;
        unsigned char* L = lds + half * 53248;
        unsigned char* qb = L; unsigned char* kb = L + 17408;
        float* Am = (float*)(L + 34816);
        float* Gs = (float*)(L + 51200); float* Bs = Gs + 64; float* RQ = Gs + 128; float* RK = Gs + 192; float* EG = Gs + 256;
        const int unit = it * 2 + half;
        int row0, nrows, h, bidx; bool sample, first, lastc;
        if (unit < 2048) { const int b = unit >> 9, n = unit & 127; h = (unit >> 7) & 3; row0 = b * 8192 + n * 64; nrows = 64; sample = false; first = (n == 0); lastc = (n == 127); bidx = b; }
        else { const int su = unit - 2048; bidx = su >> 2; h = su & 3; row0 = TP + bidx * 16; nrows = 16; sample = true; first = false; lastc = true; }
        unsigned char* rec = ws + WS_DNC + (size_t)unit * REC;
        if (hw == 0) {
            float g = 0.f, be = 0.f;
            if (lane < nrows) {
                const float* bp = BA + (size_t)(row0 + lane) * 8;
                be = sigm(bp[h]);
                const float xx = bp[4 + h] + a.in[11][h];
                const float sp = xx > 20.f ? xx : log1pf(__expf(xx));
                g = -__expf(a.in[10][h]) * sp;
            }
#pragma unroll
            for (int o = 1; o < 64; o <<= 1) { const float v = __shfl_up(g, o); if (lane >= o) g += v; }
            Gs[lane] = g; Bs[lane] = be; EG[lane] = __expf(g);
            if (lane == 63) ((float*)(ws + WS_EG))[unit] = __expf(g);
        }
        float va[64];
        {
            const int c = t8 & 127;
            const int col = (t8 < 128 ? 0 : 512) + h * 128 + c;
            float h0 = 0.f, h1 = 0.f, h2 = 0.f;
            if (sample) { const float* cc = a.in[2] + (size_t)bidx * 3 * 1536 + col; h0 = cc[0]; h1 = cc[1536]; h2 = cc[2 * 1536]; }
            else if (!first) { const bf16* pp = P + (size_t)(row0 - 3) * PW + col; h0 = b2f(pp[0]); h1 = b2f(pp[PW]); h2 = b2f(pp[2 * PW]); }
            float* outp = lastc ? a.out + (sample ? O_SDC : O_PDC) + (size_t)bidx * 3 * 1536 + col : nullptr;
            conv_col(P + (size_t)row0 * PW + col, h0, h1, h2, cwt + col, nrows, outp, va);
            unsigned char* dst = (t8 < 128 ? qb : kb) + c * 2;
#pragma unroll
            for (int r = 0; r < 64; ++r) *(bf16*)(dst + r * 272) = f2b(va[r]);
        }
        __syncthreads();
        f32x4 kk[4], qk[4], qq;
        {
            bf16x8 ak[4], aq[4];
#pragma unroll
            for (int ks = 0; ks < 4; ++ks) { ak[ks] = *(const bf16x8*)(kb + (16 * hw + fr) * 272 + ks * 64 + fq * 16); aq[ks] = *(const bf16x8*)(qb + (16 * hw + fr) * 272 + ks * 64 + fq * 16); }
            qq = (f32x4){0.f, 0.f, 0.f, 0.f};
#pragma unroll
            for (int ks = 0; ks < 4; ++ks) qq = MFMA16(aq[ks], aq[ks], qq);
#pragma unroll
            for (int nt = 0; nt < 4; ++nt) {
                kk[nt] = (f32x4){0.f, 0.f, 0.f, 0.f}; qk[nt] = (f32x4){0.f, 0.f, 0.f, 0.f};
#pragma unroll
                for (int ks = 0; ks < 4; ++ks) { const bf16x8 bk = *(const bf16x8*)(kb + (16 * nt + fr) * 272 + ks * 64 + fq * 16);
                    kk[nt] = MFMA16(ak[ks], bk, kk[nt]); qk[nt] = MFMA16(aq[ks], bk, qk[nt]); }
            }
#pragma unroll
            for (int i = 0; i < 4; ++i) if (fr == 4 * fq + i) {
                float dk = 0.f;
#pragma unroll
                for (int nt = 0; nt < 4; ++nt) if (nt == hw) dk = kk[nt][i];
                RK[16 * hw + fr] = rsqrtf(dk + EPS); RQ[16 * hw + fr] = rsqrtf(qq[i] + EPS);
            }
        }
        __syncthreads();
        {
            bf16* QKr = (bf16*)(rec + R_QK);
#pragma unroll
            for (int i = 0; i < 4; ++i) {
                const int row = 16 * hw + 4 * fq + i;
                const float gr = Gs[row], br = Bs[row], rk = RK[row], rq = RQ[row];
#pragma unroll
                for (int nt = 0; nt < 4; ++nt) {
                    const int col = 16 * nt + fr;
                    const float d = col <= row ? gr - Gs[col] : 0.f;
                    const float e = __expf(d), rkc = RK[col];
                    Am[row * 64 + col] = col < row ? br * kk[nt][i] * rk * rkc * e : 0.f;
                    QKr[row * 64 + kperm(col)] = f2b(col <= row ? qk[nt][i] * rq * rkc * QSCALE * e : 0.f);
                }
            }
        }
        __syncthreads();
        if (t8 < 128) {
            bf16* Qg = (bf16*)(rec + R_QG) + kperm(t8);
#pragma unroll
            for (int r = 0; r < 64; ++r) Qg[r * 128] = f2b(va[r] * RQ[r] * QSCALE * EG[r]);
            {
                const int col = 1024 + h * 128 + t8;
                float h0 = 0.f, h1 = 0.f, h2 = 0.f;
                if (sample) { const float* cc = a.in[2] + (size_t)bidx * 3 * 1536 + col; h0 = cc[0]; h1 = cc[1536]; h2 = cc[2 * 1536]; }
                else if (!first) { const bf16* pp = P + (size_t)(row0 - 3) * PW + col; h0 = b2f(pp[0]); h1 = b2f(pp[PW]); h2 = b2f(pp[2 * PW]); }
                float* outp = lastc ? a.out + (sample ? O_SDC : O_PDC) + (size_t)bidx * 3 * 1536 + col : nullptr;
                conv_col(P + (size_t)row0 * PW + col, h0, h1, h2, cwt + col, nrows, outp, va);
            }
#pragma unroll
            for (int r = 0; r < 64; ++r) va[r] = va[r] * Bs[r];
        } else {
            const int c = t8 - 128;
            const float gl = Gs[63];
            unsigned w[32];
#pragma unroll
            for (int r = 0; r < 64; r += 2) w[kperm(r) >> 1] = pk2(va[r] * RK[r] * __expf(gl - Gs[r]), va[r + 1] * RK[r + 1] * __expf(gl - Gs[r + 1]));
            u32x4* dst = (u32x4*)(rec + R_KDT + c * 128);
#pragma unroll
            for (int j = 0; j < 8; ++j) dst[j] = (u32x4){w[4 * j], w[4 * j + 1], w[4 * j + 2], w[4 * j + 3]};
#pragma unroll
            for (int r = 0; r < 64; ++r) va[r] = va[r] * RK[r] * Bs[r] * EG[r];
        }
#if SOLVE_RL
        {
            float arow[64];
#pragma unroll
            for (int i = 1; i < 64; ++i) arow[i] = Am[i * 64 + lane];
#pragma unroll
            for (int i = 1; i < 64; ++i) {
                if (i < nrows) {
                    float acc0 = va[i], acc1 = 0.f;
#pragma unroll
                    for (int j = 0; j < i; ++j) { const float aij = __int_as_float(__builtin_amdgcn_readlane(__float_as_int(arow[i]), j)); if (j & 1) acc1 -= aij * va[j]; else acc0 -= aij * va[j]; }
                    va[i] = acc0 + acc1;
                }
            }
        }
#else
#pragma unroll
        for (int i = 1; i < 64; ++i) {
            float acc = va[i];
            const f32x4* Ar = (const f32x4*)(Am + i * 64);
#pragma unroll
            for (int j4 = 0; j4 < (i + 3) / 4; ++j4) {
                const f32x4 av = Ar[j4];
#pragma unroll
                for (int e = 0; e < 4; ++e) if (4 * j4 + e < i) acc -= av[e] * va[4 * j4 + e];
            }
            va[i] = acc;
        }
#endif
        if (t8 < 128) { bf16* U0 = (bf16*)(rec + R_U0) + t8;
#pragma unroll
            for (int r = 0; r < 64; ++r) U0[r * 128] = f2b(va[r]);
        } else { bf16* Wn = (bf16*)(rec + R_WN) + kperm(t8 - 128);
#pragma unroll
            for (int r = 0; r < 64; ++r) Wn[r * 128] = f2b(-va[r]);
        }
        __syncthreads();
    }
}

struct S5W { float lr[4], li[4]; bf16x8 bf[8]; };
DI void s5w_setup(const Args& a, int g, int fr, int fq, S5W& w) {
    const float dt = __expf(a.in[15][g]);
#pragma unroll
    for (int j = 0; j < 4; ++j) {
        const int p = 16 * j + fr;
        const float are = a.in[13][g * 64 + p], aim = a.in[14][g * 64 + p];
        const float mag = __expf(are * dt), ang = aim * dt;
        float sn, cs; sincosf(ang, &sn, &cs);
        const float lr = mag * cs, li = mag * sn;
        w.lr[j] = lr; w.li[j] = li;
        const float den = are * are + aim * aim;
        const float fre = ((lr - 1.f) * are + li * aim) / den, fim = (li * are - (lr - 1.f) * aim) / den;
        u32x4 wr = (u32x4){0u, 0u, 0u, 0u}, wi = (u32x4){0u, 0u, 0u, 0u};
        if (fq < 2) {
            const f32x4* br = (const f32x4*)(a.in[16] + (size_t)(g * 64 + p) * 16 + 8 * fq); const f32x4* bi = (const f32x4*)(a.in[17] + (size_t)(g * 64 + p) * 16 + 8 * fq);
            const f32x4 r0 = br[0], r1 = br[1], i0 = bi[0], i1 = bi[1];
            wr.x = pk2(fre * r0[0] - fim * i0[0], fre * r0[1] - fim * i0[1]); wr.y = pk2(fre * r0[2] - fim * i0[2], fre * r0[3] - fim * i0[3]);
            wr.z = pk2(fre * r1[0] - fim * i1[0], fre * r1[1] - fim * i1[1]); wr.w = pk2(fre * r1[2] - fim * i1[2], fre * r1[3] - fim * i1[3]);
            wi.x = pk2(fre * i0[0] + fim * r0[0], fre * i0[1] + fim * r0[1]); wi.y = pk2(fre * i0[2] + fim * r0[2], fre * i0[3] + fim * r0[3]);
            wi.z = pk2(fre * i1[0] + fim * r1[0], fre * i1[1] + fim * r1[1]); wi.w = pk2(fre * i1[2] + fim * r1[2], fre * i1[3] + fim * r1[3]);
        }
        w.bf[j] = __builtin_bit_cast(bf16x8, wr); w.bf[4 + j] = __builtin_bit_cast(bf16x8, wi);
    }
}
DI bf16x8 s5w_uload(const bf16* P, size_t row0, int SS, int ms, int g, int fr, int fq) {
    u32x4 v = (u32x4){0u, 0u, 0u, 0u};
    if (fq < 2) v = *(const u32x4*)(P + (row0 + (size_t)(fr >> 2) * SS + 4 * ms + (fr & 3)) * PW + 2048 + g * 16 + 8 * fq);
    return __builtin_bit_cast(bf16x8, v);
}
DI void s5w_step(const S5W& w, bf16x8 ua, float (&xr)[4], float (&xi)[4], unsigned (&xo)[4][4]) {
    f32x4 br[4], bi[4];
    const f32x4 z = (f32x4){0.f, 0.f, 0.f, 0.f};
#pragma unroll
    for (int j = 0; j < 4; ++j) { br[j] = MFMA16(ua, w.bf[j], z); bi[j] = MFMA16(ua, w.bf[4 + j], z); }
#pragma unroll
    for (int i = 0; i < 4; ++i)
#pragma unroll
        for (int j = 0; j < 4; ++j) {
            const float nr = w.lr[j] * xr[j] - w.li[j] * xi[j] + br[j][i], ni = w.lr[j] * xi[j] + w.li[j] * xr[j] + bi[j][i];
            xr[j] = nr; xi[j] = ni; xo[i][j] = pk2(nr, ni);
        }
#pragma unroll
    for (int j = 0; j < 8; ++j) asm volatile("" :: "v"(w.bf[j]));
    asm volatile("" :: "v"(ua));
}
DI void s5_pass1(const Args& a, int gw, int NGW, int lane) {
    asm volatile("" : "+v"(lane));
    const bf16* P = (const bf16*)(a.ws + WS_P);
    float* E = (float*)(a.ws + WS_S5E);
    const int fr = lane & 15, fq = lane >> 4;
    for (int unit = gw; unit < 4 * 32 * 16; unit += NGW) {
        const int sg = unit & 15, bg = unit >> 4, g = bg & 31, b = bg >> 5;
        S5W w; s5w_setup(a, g, fr, fq, w);
        float xr[4] = {0.f, 0.f, 0.f, 0.f}, xi[4] = {0.f, 0.f, 0.f, 0.f}; unsigned xo[4][4];
        const size_t row0 = (size_t)b * 8192 + sg * 512;
        bf16x8 ua = s5w_uload(P, row0, 128, 0, g, fr, fq);
        for (int ms = 0; ms < 32; ++ms) {
            const bf16x8 un = s5w_uload(P, row0, 128, ms + 1 < 32 ? ms + 1 : ms, g, fr, fq);
            s5w_step(w, ua, xr, xi, xo); ua = un;
        }
        float* e = E + ((size_t)bg * 64 + 4 * sg + fq) * 128;
#pragma unroll
        for (int j = 0; j < 4; ++j) { e[16 * j + fr] = xr[j]; e[64 + 16 * j + fr] = xi[j]; }
    }
}
DI void s5w_run(const Args& a, const S5W& w, const bf16x8 (&cf)[4], float Dg, unsigned char* xs, size_t row0, int SS, int nms, int g, int fr, int fq, float (&xr)[4], float (&xi)[4]) {
    const bf16* P = (const bf16*)(a.ws + WS_P);
    bf16* Y5 = (bf16*)(a.ws + WS_Y5);
    bf16x8 ua = s5w_uload(P, row0, SS, 0, g, fr, fq);
    for (int ms = 0; ms < nms; ++ms) {
        const bf16x8 un = s5w_uload(P, row0, SS, ms + 1 < nms ? ms + 1 : ms, g, fr, fq);
        float uu[4];
#pragma unroll
        for (int i = 0; i < 4; ++i) uu[i] = b2f(P[(row0 + (size_t)fq * SS + 4 * ms + i) * PW + 2048 + g * 16 + fr]);
        unsigned xo[4][4];
        s5w_step(w, ua, xr, xi, xo); ua = un;
#pragma unroll
        for (int i = 0; i < 4; ++i)
#pragma unroll
            for (int j = 0; j < 4; ++j) *(unsigned*)(xs + (4 * fq + i) * 272 + (16 * j + fr) * 4) = xo[i][j];
        asm volatile("s_waitcnt lgkmcnt(0)" ::: "memory");
        f32x4 y = (f32x4){0.f, 0.f, 0.f, 0.f};
        bf16x8 af[4];
#pragma unroll
        for (int ks = 0; ks < 4; ++ks) af[ks] = *(const bf16x8*)(xs + fr * 272 + ks * 64 + fq * 16);
        asm volatile("" ::: "memory");
#pragma unroll
        for (int ks = 0; ks < 4; ++ks) y = MFMA16(af[ks], cf[ks], y);
#if DIAG_Y
        {
            const float* cre = a.in[18] + (size_t)(g * 16 + fr) * 64; const float* cim = a.in[19] + (size_t)(g * 16 + fr) * 64;
#pragma unroll
            for (int i = 0; i < 4; ++i) { float acc = 0.f;
                for (int p = 0; p < 64; ++p) { const unsigned wv = *(const unsigned*)(xs + (4 * fq + i) * 272 + p * 4); acc += cre[p] * blo(wv) - cim[p] * bhi(wv); }
                y[i] = acc; }
        }
#endif
        asm volatile("" :: "v"(y));
#pragma unroll
        for (int ks = 0; ks < 4; ++ks) asm volatile("" :: "v"(af[ks]), "v"(cf[ks]));
#pragma unroll
        for (int i = 0; i < 4; ++i) {
            const size_t row = row0 + (size_t)fq * SS + 4 * ms + i;
            Y5[row * 512 + g * 16 + fr] = f2b(gelu_tanh(y[i] + Dg * uu[i]));
        }
    }
}
DI void s5_cfrag(const Args& a, int g, int fr, int fq, bf16x8 (&cf)[4]) {
#pragma unroll
    for (int ks = 0; ks < 4; ++ks) {
        const f32x4 cr = *(const f32x4*)(a.in[18] + (size_t)(g * 16 + fr) * 64 + 16 * ks + 4 * fq), ci = *(const f32x4*)(a.in[19] + (size_t)(g * 16 + fr) * 64 + 16 * ks + 4 * fq);
        u32x4 w; w.x = pk2(cr[0], -ci[0]); w.y = pk2(cr[1], -ci[1]); w.z = pk2(cr[2], -ci[2]); w.w = pk2(cr[3], -ci[3]);
        cf[ks] = __builtin_bit_cast(bf16x8, w);
    }
}
DI void s5_pass2_prompt(const Args& a, unsigned char* lds, int bg, int tid) {
    asm volatile("" : "+v"(tid));
    const int wave = __builtin_amdgcn_readfirstlane(tid >> 6), lane = tid & 63, fr = lane & 15, fq = lane >> 4;
    const int b = bg >> 5, g4 = (bg >> 2) & 7, part = bg & 3, g = 4 * g4 + (wave & 3);
    bg = b * 32 + g;
    unsigned char* xs = lds + wave * 4352;
    S5W w; s5w_setup(a, g, fr, fq, w);
    bf16x8 cf[4]; s5_cfrag(a, g, fr, fq, cf);
    const float Dg = a.in[20][g * 16 + fr];
    float pr[4], pi[4];
#pragma unroll
    for (int j = 0; j < 4; ++j) { pr[j] = w.lr[j]; pi[j] = w.li[j];
#pragma unroll
        for (int s = 0; s < 7; ++s) { const float nr = pr[j] * pr[j] - pi[j] * pi[j], ni = 2.f * pr[j] * pi[j]; pr[j] = nr; pi[j] = ni; } }
    const float* e = (const float*)(a.ws + WS_S5E) + (size_t)bg * 64 * 128;
    for (int uu = 0; uu < 2; ++uu) {
        const int sg = 4 * part + 2 * (wave >> 2) + uu, seg = 4 * sg + fq;
        float xr[4] = {0.f, 0.f, 0.f, 0.f}, xi[4] = {0.f, 0.f, 0.f, 0.f};
        for (int s = 0; s < 4 * sg + 3; ++s) {
            if (s < seg) {
#pragma unroll
                for (int j = 0; j < 4; ++j) { const float er = e[s * 128 + 16 * j + fr], ei = e[s * 128 + 64 + 16 * j + fr];
                    const float nr = pr[j] * xr[j] - pi[j] * xi[j] + er, ni = pr[j] * xi[j] + pi[j] * xr[j] + ei; xr[j] = nr; xi[j] = ni; }
            }
        }
        s5w_run(a, w, cf, Dg, xs, (size_t)b * 8192 + sg * 512, 128, 32, g, fr, fq, xr, xi);
        if (seg == 63) {
#pragma unroll
            for (int j = 0; j < 4; ++j) { a.out[O_PSR + (size_t)bg * 64 + 16 * j + fr] = xr[j]; a.out[O_PSI + (size_t)bg * 64 + 16 * j + fr] = xi[j]; }
        }
    }
}
DI void s5_pass2_sample(const Args& a, unsigned char* xs, int gw, int NGW, int lane) {
    asm volatile("" : "+v"(lane));
    const int fr = lane & 15, fq = lane >> 4;
    for (int unit = gw; unit < 256; unit += NGW) {
        const int g = unit & 31, q = unit >> 5, sb = 4 * q + fq;
        S5W w; s5w_setup(a, g, fr, fq, w);
        bf16x8 cf[4]; s5_cfrag(a, g, fr, fq, cf);
        const float Dg = a.in[20][g * 16 + fr];
        float xr[4], xi[4];
#pragma unroll
        for (int j = 0; j < 4; ++j) { xr[j] = a.in[4][(size_t)(sb * 32 + g) * 64 + 16 * j + fr]; xi[j] = a.in[5][(size_t)(sb * 32 + g) * 64 + 16 * j + fr]; }
        s5w_run(a, w, cf, Dg, xs, (size_t)TP + (size_t)q * 64, 16, 4, g, fr, fq, xr, xi);
#pragma unroll
        for (int j = 0; j < 4; ++j) { a.out[O_SSR + (size_t)(sb * 32 + g) * 64 + 16 * j + fr] = xr[j]; a.out[O_SSI + (size_t)(sb * 32 + g) * 64 + 16 * j + fr] = xi[j]; }
    }
}

struct S5Par { float lr, li; float bbr[16], bbi[16]; };
DI void s5_setup(const Args& a, int g, int p, S5Par& q) {
    const float are = a.in[13][g * 64 + p], aim = a.in[14][g * 64 + p], dt = __expf(a.in[15][g]);
    const float mag = __expf(are * dt), ang = aim * dt;
    float sn, cs; sincosf(ang, &sn, &cs);
    q.lr = mag * cs; q.li = mag * sn;
    const float den = are * are + aim * aim;
    const float fre = ((q.lr - 1.f) * are + q.li * aim) / den, fim = (q.li * are - (q.lr - 1.f) * aim) / den;
    const f32x4* br = (const f32x4*)(a.in[16] + (size_t)(g * 64 + p) * 16); const f32x4* bi = (const f32x4*)(a.in[17] + (size_t)(g * 64 + p) * 16);
#pragma unroll
    for (int j = 0; j < 4; ++j) { const f32x4 r = br[j], i = bi[j];
#pragma unroll
        for (int e = 0; e < 4; ++e) { q.bbr[4 * j + e] = fre * r[e] - fim * i[e]; q.bbi[4 * j + e] = fre * i[e] + fim * r[e]; } }
}
DI void s5_step4(const S5Par& q, float uv, float& xr, float& xi, unsigned (&xo)[4]) {
#pragma unroll
    for (int j = 0; j < 4; ++j) {
        float br = 0.f, bi = 0.f;
#pragma unroll
        for (int h = 0; h < 16; ++h) { const float uh = __int_as_float(__builtin_amdgcn_readlane(__float_as_int(uv), 16 * j + h)); br += q.bbr[h] * uh; bi += q.bbi[h] * uh; }
        const float nr = q.lr * xr - q.li * xi + br, ni = q.lr * xi + q.li * xr + bi;
        xr = nr; xi = ni; xo[j] = pk2(xr, xi);
    }
}
DI void old_s5_pass1(const Args& a, int gw, int NGW, int lane) {
    asm volatile("" : "+v"(lane));
    const bf16* P = (const bf16*)(a.ws + WS_P);
    float* E = (float*)(a.ws + WS_S5E);
    for (int unit = gw; unit < 4 * 32 * 64; unit += NGW) {
        const int seg = unit & 63, bg = unit >> 6, g = bg & 31, b = bg >> 5;
        S5Par q; s5_setup(a, g, lane, q);
        float xr = 0.f, xi = 0.f; unsigned xo[4];
        const bf16* up = P + (size_t)(b * 8192 + seg * 128 + (lane >> 4)) * PW + 2048 + g * 16 + (lane & 15);
#pragma unroll 2
        for (int t = 0; t < 128; t += 4) { const float uv = b2f(up[(size_t)t * PW]); s5_step4(q, uv, xr, xi, xo); }
        float* e = E + ((size_t)bg * 64 + seg) * 128;
        e[lane] = xr; e[64 + lane] = xi;
    }
}
DI void old_s5_pass2(const Args& a, unsigned char* xs  , int gw, int NGW, int lane) {
    asm volatile("" : "+v"(lane));
    const bf16* P = (const bf16*)(a.ws + WS_P);
    const float* E = (const float*)(a.ws + WS_S5E);
    bf16* Y5 = (bf16*)(a.ws + WS_Y5);
    const int fr = lane & 15, fq = lane >> 4;
    for (int unit = gw; unit < OLD_S5_ULIM; unit += NGW) {
        int g, row0, ntok, seg = 0, bg; bool sample;
        if (unit < 8192) { seg = unit & 63; bg = unit >> 6; g = bg & 31; row0 = (bg >> 5) * 8192 + seg * 128; ntok = 128; sample = false; }
        else { bg = unit - 8192; g = bg & 31; row0 = TP + (bg >> 5) * 16; ntok = 16; sample = true; }
        S5Par q; s5_setup(a, g, lane, q);
        float xr = 0.f, xi = 0.f;
        if (sample) { xr = a.in[4][(size_t)bg * 64 + lane]; xi = a.in[5][(size_t)bg * 64 + lane]; }
        else {
            float pr = q.lr, pi = q.li;
#pragma unroll
            for (int s = 0; s < 7; ++s) { const float nr = pr * pr - pi * pi, ni = 2.f * pr * pi; pr = nr; pi = ni; }
            const float* e = E + (size_t)bg * 64 * 128;
            for (int s = 0; s < seg; ++s) { const float er = e[s * 128 + lane], ei = e[s * 128 + 64 + lane]; const float nr = pr * xr - pi * xi + er, ni = pr * xi + pi * xr + ei; xr = nr; xi = ni; }
        }
        bf16x8 cf[4];
#pragma unroll
        for (int ks = 0; ks < 4; ++ks) {
            const f32x4 cr = *(const f32x4*)(a.in[18] + (size_t)(g * 16 + fr) * 64 + 16 * ks + 4 * fq), ci = *(const f32x4*)(a.in[19] + (size_t)(g * 16 + fr) * 64 + 16 * ks + 4 * fq);
            u32x4 w; w.x = pk2(cr[0], -ci[0]); w.y = pk2(cr[1], -ci[1]); w.z = pk2(cr[2], -ci[2]); w.w = pk2(cr[3], -ci[3]);
            cf[ks] = __builtin_bit_cast(bf16x8, w);
        }
        const float Dg = a.in[20][g * 16 + fr];
        const bf16* up = P + (size_t)(row0 + (lane >> 4)) * PW + 2048 + g * 16 + (lane & 15);
        for (int tb = 0; tb < ntok; tb += 16) {
#pragma unroll
            for (int j4 = 0; j4 < 4; ++j4) {
                const float uv = b2f(up[(size_t)(tb + 4 * j4) * PW]);
                unsigned xo[4]; s5_step4(q, uv, xr, xi, xo);
#pragma unroll
                for (int j = 0; j < 4; ++j) *(unsigned*)(xs + (4 * j4 + j) * 272 + lane * 4) = xo[j];
            }
            f32x4 y = (f32x4){0.f, 0.f, 0.f, 0.f};
#pragma unroll
            for (int ks = 0; ks < 4; ++ks) { const bf16x8 af = *(const bf16x8*)(xs + fr * 272 + ks * 64 + fq * 16); y = MFMA16(af, cf[ks], y); }
#pragma unroll
            for (int i = 0; i < 4; ++i) {
                const size_t row = (size_t)row0 + tb + 4 * fq + i;
                const float uu = b2f(P[row * PW + 2048 + g * 16 + fr]);
                Y5[row * 512 + g * 16 + fr] = f2b(gelu_tanh(y[i] + Dg * uu));
            }
        }
        if (sample) { a.out[O_SSR + (size_t)bg * 64 + lane] = xr; a.out[O_SSI + (size_t)bg * 64 + lane] = xi; }
        else if (seg == 63) { a.out[O_PSR + (size_t)bg * 64 + lane] = xr; a.out[O_PSI + (size_t)bg * 64 + lane] = xi; }
    }
}

DI void s5_pass2b(const Args& a, unsigned char* xs, int gw, int NGW, int lane) {
    asm volatile("" : "+v"(lane));
    const bf16* P = (const bf16*)(a.ws + WS_P);
    const float* E = (const float*)(a.ws + WS_S5E);
    bf16* Y5 = (bf16*)(a.ws + WS_Y5);
    const int fr = lane & 15, fq = lane >> 4;
    for (int unit = gw; unit < 4 * 32 * 64 + 32 * 32; unit += NGW) {
        int g, row0, ntok, seg = 0, bg; bool sample;
        if (unit < 8192) { seg = unit & 63; bg = unit >> 6; g = bg & 31; row0 = (bg >> 5) * 8192 + seg * 128; ntok = 128; sample = false; }
        else { bg = unit - 8192; g = bg & 31; row0 = TP + (bg >> 5) * 16; ntok = 16; sample = true; }
        S5Par q; s5_setup(a, g, lane, q);
        float xr = 0.f, xi = 0.f;
        if (sample) { xr = a.in[4][(size_t)bg * 64 + lane]; xi = a.in[5][(size_t)bg * 64 + lane]; }
        else {
            float pr = q.lr, pi = q.li;
#pragma unroll
            for (int s = 0; s < 7; ++s) { const float nr = pr * pr - pi * pi, ni = 2.f * pr * pi; pr = nr; pi = ni; }
            const float* e = E + (size_t)bg * 64 * 128;
            for (int s = 0; s < seg; ++s) { const float er = e[s * 128 + lane], ei = e[s * 128 + 64 + lane]; const float nr = pr * xr - pi * xi + er, ni = pr * xi + pi * xr + ei; xr = nr; xi = ni; }
        }
        bf16x8 cf[4];
#pragma unroll
        for (int ks = 0; ks < 4; ++ks) {
            const f32x4 cr = *(const f32x4*)(a.in[18] + (size_t)(g * 16 + fr) * 64 + 16 * ks + 4 * fq), ci = *(const f32x4*)(a.in[19] + (size_t)(g * 16 + fr) * 64 + 16 * ks + 4 * fq);
            u32x4 w; w.x = pk2(cr[0], -ci[0]); w.y = pk2(cr[1], -ci[1]); w.z = pk2(cr[2], -ci[2]); w.w = pk2(cr[3], -ci[3]);
            cf[ks] = __builtin_bit_cast(bf16x8, w);
        }
        const float Dg = a.in[20][g * 16 + fr];
        S5W w; s5w_setup(a, g, fr, fq, w);
        unsigned char* bt = xs + 4352;
        for (int tb = 0; tb < ntok; tb += 16) {
            {
                u32x4 uv = (u32x4){0u, 0u, 0u, 0u};
                if (fq < 2) uv = *(const u32x4*)(P + (size_t)(row0 + tb + fr) * PW + 2048 + g * 16 + 8 * fq);
                const bf16x8 ua = __builtin_bit_cast(bf16x8, uv);
                const f32x4 z = (f32x4){0.f, 0.f, 0.f, 0.f};
#pragma unroll
                for (int j = 0; j < 4; ++j) {
                    const f32x4 br = MFMA16(ua, w.bf[j], z), bi = MFMA16(ua, w.bf[4 + j], z);
                    *(f32x4*)(bt + (16 * j + fr) * 80 + fq * 16) = br; *(f32x4*)(bt + (64 + 16 * j + fr) * 80 + fq * 16) = bi;
                }
            }
            asm volatile("s_waitcnt lgkmcnt(0)" ::: "memory");
            f32x4 bre[4], bim[4];
#pragma unroll
            for (int k = 0; k < 4; ++k) { bre[k] = *(const f32x4*)(bt + lane * 80 + k * 16); bim[k] = *(const f32x4*)(bt + (64 + lane) * 80 + k * 16); }
            asm volatile("s_waitcnt lgkmcnt(0)" ::: "memory");
#pragma unroll
            for (int t = 0; t < 16; ++t) {
                const float nr = q.lr * xr - q.li * xi + bre[t >> 2][t & 3], ni = q.lr * xi + q.li * xr + bim[t >> 2][t & 3];
                xr = nr; xi = ni;
                *(unsigned*)(xs + t * 272 + lane * 4) = pk2(nr, ni);
            }
            asm volatile("s_waitcnt lgkmcnt(0)" ::: "memory");
            f32x4 y = (f32x4){0.f, 0.f, 0.f, 0.f};
#pragma unroll
            for (int ks = 0; ks < 4; ++ks) { const bf16x8 af = *(const bf16x8*)(xs + fr * 272 + ks * 64 + fq * 16); y = MFMA16(af, cf[ks], y); }
#pragma unroll
            for (int i = 0; i < 4; ++i) {
                const size_t row = (size_t)row0 + tb + 4 * fq + i;
                const float uu = b2f(P[row * PW + 2048 + g * 16 + fr]);
                Y5[row * 512 + g * 16 + fr] = f2b(gelu_tanh(y[i] + Dg * uu));
            }
        }
        if (sample) { a.out[O_SSR + (size_t)bg * 64 + lane] = xr; a.out[O_SSI + (size_t)bg * 64 + lane] = xi; }
        else if (seg == 63) { a.out[O_PSR + (size_t)bg * 64 + lane] = xr; a.out[O_PSI + (size_t)bg * 64 + lane] = xi; }
    }
}

constexpr int DB_WN = 0, DB_QG = 17408, DB_KDT = 34816, DB_QK = 53248, DB_U0 = 62464;
constexpr int DBP_SIZE = DB_U0 + 64 * 80;
constexpr int DBS_SIZE = DB_U0 + 64 * 272;
template <int NC> struct DnRegs { u32x4 r[7]; u32x4 u[NC == 32 ? 1 : 2]; };
template <int NC> DI void dn_load(const unsigned char* rec, int tid, int c0, DnRegs<NC>& R) {
    const u32x4* g = (const u32x4*)rec;
    R.r[0] = g[tid]; R.r[1] = g[tid + 512]; R.r[2] = g[1024 + tid]; R.r[3] = g[1024 + tid + 512]; R.r[4] = g[2048 + tid]; R.r[5] = g[2048 + tid + 512]; R.r[6] = g[3072 + tid];
    if (NC == 32) { if (tid < 256) R.u[0] = *(const u32x4*)(rec + R_U0 + (tid >> 2) * 256 + c0 * 2 + (tid & 3) * 16); }
    else { R.u[0] = *(const u32x4*)(rec + R_U0 + tid * 16); R.u[1] = *(const u32x4*)(rec + R_U0 + (tid + 512) * 16); }
}
template <int NC> DI void dn_store(unsigned char* buf, int tid, const DnRegs<NC>& R) {
#pragma unroll
    for (int j = 0; j < 2; ++j) { const int q = tid + 512 * j;
        *(u32x4*)(buf + DB_WN + (q >> 4) * 272 + (q & 15) * 16) = R.r[j];
        *(u32x4*)(buf + DB_QG + (q >> 4) * 272 + (q & 15) * 16) = R.r[2 + j];
        *(u32x4*)(buf + DB_KDT + (q >> 3) * 144 + (q & 7) * 16) = R.r[4 + j]; }
    *(u32x4*)(buf + DB_QK + (tid >> 3) * 144 + (tid & 7) * 16) = R.r[6];
    if (NC == 32) { if (tid < 256) *(u32x4*)(buf + DB_U0 + (tid >> 2) * 80 + (tid & 3) * 16) = R.u[0]; }
    else {
#pragma unroll
        for (int j = 0; j < 2; ++j) { const int q = tid + 512 * j; *(u32x4*)(buf + DB_U0 + (q >> 4) * 272 + (q & 15) * 16) = R.u[j]; }
    }
}
DI bf16x8 pack8(const f32x4& lo, const f32x4& hi) { u32x4 w; w.x = pk2(lo[0], lo[1]); w.y = pk2(lo[2], lo[3]); w.z = pk2(hi[0], hi[1]); w.w = pk2(hi[2], hi[3]); return __builtin_bit_cast(bf16x8, w); }
template <int UPI> DI void dn_step(const unsigned char* buf, f32x4 (&S)[8], const unsigned char* u0, float eg, int fr, int fq, f32x4 (&o)[4]) {
    bf16x8 Sb[4];
#pragma unroll
    for (int ks = 0; ks < 4; ++ks) Sb[ks] = pack8(S[2 * ks], S[2 * ks + 1]);
    f32x4 u[4];
#pragma unroll
    for (int mt = 0; mt < 4; ++mt) {
#pragma unroll
        for (int i = 0; i < 4; ++i) u[mt][i] = b2f(*(const bf16*)(u0 + (16 * mt + 4 * fq + i) * UPI));
#pragma unroll
        for (int ks = 0; ks < 4; ++ks) u[mt] = MFMA16(*(const bf16x8*)(buf + DB_WN + (16 * mt + fr) * 272 + ks * 64 + fq * 16), Sb[ks], u[mt]);
    }
    bf16x8 ub[2];
#pragma unroll
    for (int k2 = 0; k2 < 2; ++k2) ub[k2] = pack8(u[2 * k2], u[2 * k2 + 1]);
#pragma unroll
    for (int mt = 0; mt < 4; ++mt) {
        o[mt] = (f32x4){0.f, 0.f, 0.f, 0.f};
#pragma unroll
        for (int ks = 0; ks < 4; ++ks) o[mt] = MFMA16(*(const bf16x8*)(buf + DB_QG + (16 * mt + fr) * 272 + ks * 64 + fq * 16), Sb[ks], o[mt]);
#pragma unroll
        for (int k2 = 0; k2 < 2; ++k2) o[mt] = MFMA16(*(const bf16x8*)(buf + DB_QK + (16 * mt + fr) * 144 + k2 * 64 + fq * 16), ub[k2], o[mt]);
    }
#pragma unroll
    for (int m8 = 0; m8 < 8; ++m8) {
        S[m8] = S[m8] * eg;
#pragma unroll
        for (int k2 = 0; k2 < 2; ++k2) S[m8] = MFMA16(*(const bf16x8*)(buf + DB_KDT + (16 * m8 + fr) * 144 + k2 * 64 + fq * 16), ub[k2], S[m8]);
    }
}
#if DN_STAGED == 2
#define DNP_SYNC() do { asm volatile("s_waitcnt lgkmcnt(0)" ::: "memory"); __builtin_amdgcn_sched_barrier(0); } while (0)
#else
#define DNP_SYNC() do { } while (0)
#endif
DI void dn_step_p(const unsigned char* buf, f32x4 (&S)[8], const unsigned char* u0, float eg, int fr, int fq, f32x4 (&o)[4]) {
    const unsigned char* aw = buf + DB_WN + fr * 272 + fq * 16;
    const unsigned char* aq = buf + DB_QG + fr * 272 + fq * 16;
    const unsigned char* ak = buf + DB_KDT + fr * 144 + fq * 16;
    const unsigned char* ac = buf + DB_QK + fr * 144 + fq * 16;
    bf16x8 f1[16], f2[16], Sb[4], ub[2];
    f32x4 u[4];
#pragma unroll
    for (int mt = 0; mt < 4; ++mt)
#pragma unroll
        for (int ks = 0; ks < 4; ++ks) f1[4 * mt + ks] = *(const bf16x8*)(aw + mt * 4352 + ks * 64);
#pragma unroll
    for (int mt = 0; mt < 4; ++mt)
#pragma unroll
        for (int i = 0; i < 4; ++i) u[mt][i] = b2f(*(const bf16*)(u0 + (16 * mt + 4 * fq + i) * 80));
#pragma unroll
    for (int ks = 0; ks < 4; ++ks) Sb[ks] = pack8(S[2 * ks], S[2 * ks + 1]);
    __builtin_amdgcn_sched_barrier(0);
#pragma unroll
    for (int mt = 0; mt < 4; ++mt)
#pragma unroll
        for (int ks = 0; ks < 4; ++ks) f2[4 * mt + ks] = *(const bf16x8*)(aq + mt * 4352 + ks * 64);
    DNP_SYNC();
#pragma unroll
    for (int ks = 0; ks < 4; ++ks)
#pragma unroll
        for (int mt = 0; mt < 4; ++mt) u[mt] = MFMA16(f1[4 * mt + ks], Sb[ks], u[mt]);
    __builtin_amdgcn_sched_barrier(0);
#pragma unroll
    for (int k2 = 0; k2 < 2; ++k2) ub[k2] = pack8(u[2 * k2], u[2 * k2 + 1]);
#pragma unroll
    for (int m8 = 0; m8 < 8; ++m8)
#pragma unroll
        for (int k2 = 0; k2 < 2; ++k2) f1[2 * m8 + k2] = *(const bf16x8*)(ak + m8 * 2304 + k2 * 64);
    DNP_SYNC();
#pragma unroll
    for (int mt = 0; mt < 4; ++mt) o[mt] = (f32x4){0.f, 0.f, 0.f, 0.f};
#pragma unroll
    for (int ks = 0; ks < 4; ++ks)
#pragma unroll
        for (int mt = 0; mt < 4; ++mt) o[mt] = MFMA16(f2[4 * mt + ks], Sb[ks], o[mt]);
    __builtin_amdgcn_sched_barrier(0);
#pragma unroll
    for (int mt = 0; mt < 4; ++mt)
#pragma unroll
        for (int k2 = 0; k2 < 2; ++k2) f2[2 * mt + k2] = *(const bf16x8*)(ac + mt * 2304 + k2 * 64);
    DNP_SYNC();
#pragma unroll
    for (int m8 = 0; m8 < 8; ++m8) S[m8] = S[m8] * eg;
#pragma unroll
    for (int k2 = 0; k2 < 2; ++k2)
#pragma unroll
        for (int m8 = 0; m8 < 8; ++m8) S[m8] = MFMA16(f1[2 * m8 + k2], ub[k2], S[m8]);
    __builtin_amdgcn_sched_barrier(0);
#pragma unroll
    for (int k2 = 0; k2 < 2; ++k2)
#pragma unroll
        for (int mt = 0; mt < 4; ++mt) o[mt] = MFMA16(f2[2 * mt + k2], ub[k2], o[mt]);
}
DI void dn_piece(int q, int c0, unsigned& src, unsigned& dst) {
    if (q < 1024) { src = R_WN + q * 16; dst = DB_WN + (q >> 4) * 272 + (q & 15) * 16; }
    else if (q < 2048) { const int p = q - 1024; src = R_QG + p * 16; dst = DB_QG + (p >> 4) * 272 + (p & 15) * 16; }
    else if (q < 3072) { const int p = q - 2048; src = R_KDT + p * 16; dst = DB_KDT + (p >> 3) * 144 + (p & 7) * 16; }
    else if (q < 3584) { const int p = q - 3072; src = R_QK + p * 16; dst = DB_QK + (p >> 3) * 144 + (p & 7) * 16; }
    else { const int p = q - 3584; src = R_U0 + (p >> 2) * 256 + c0 * 2 + (p & 3) * 16; dst = DB_U0 + (p >> 2) * 80 + (p & 3) * 16; }
}
#define DN_LD(R, base) do { _Pragma("unroll") for (int k = 0; k < 10; ++k) { unsigned s_, d_; dn_piece(lt + 384 * k, c0, s_, d_); R[k] = *(const u32x4*)((base) + s_); } } while (0)
#define DN_WAIT(R, cnt) do { } while (0)
#define DN_ST(R, buf) do { _Pragma("unroll") for (int k = 0; k < 10; ++k) { unsigned s_, d_; dn_piece(lt + 384 * k, c0, s_, d_); *(u32x4*)((buf) + d_) = R[k]; } } while (0)
#define DN_BAR() do { asm volatile("s_waitcnt lgkmcnt(0)" ::: "memory"); __builtin_amdgcn_s_barrier(); asm volatile("" ::: "memory"); } while (0)
DI void dn_scan_prompt(const Args& a, unsigned char* lds, int tid) {
    asm volatile("" : "+v"(tid));
    const int wave = __builtin_amdgcn_readfirstlane(tid >> 6), lane = tid & 63, fr = lane & 15, fq = lane >> 4;
    const int bh = blockIdx.x >> 2, qt = blockIdx.x & 3, b = bh >> 2, h = bh & 3;
    const int c0 = qt * 32, v0 = c0 + (wave & 1) * 16;
    const unsigned char* recs = a.ws + WS_DNC + (size_t)bh * 128 * REC;
    const float* egs = (const float*)(a.ws + WS_EG) + bh * 128;
    float* ORAW = (float*)(a.ws + WS_H);
    const bool loader = wave >= 2;
    const int lt = tid - 128;
    f32x4 S[8];
#pragma unroll
    for (int m8 = 0; m8 < 8; ++m8) S[m8] = (f32x4){0.f, 0.f, 0.f, 0.f};
    float egA = egs[lane], egB = egs[64 + lane];
    asm volatile("s_waitcnt vmcnt(0)" : "+v"(egA), "+v"(egB) :: "memory");
    if (loader) {
        const int grp = wave >= 5 ? 1 : 0, lt2 = tid - 128 - grp * 192;
        u32x4 R[20];
#define DN_LD20(base) do { _Pragma("unroll") for (int k = 0; k < 20; ++k) { unsigned s_, d_; dn_piece(lt2 + 192 * k, c0, s_, d_); R[k] = *(const u32x4*)((base) + s_); } } while (0)
#define DN_ST20(buf) do { _Pragma("unroll") for (int k = 0; k < 20; ++k) { unsigned s_, d_; dn_piece(lt2 + 192 * k, c0, s_, d_); *(u32x4*)((buf) + d_) = R[k]; } } while (0)
        if (grp == 0) { DN_LD20(recs); DN_ST20(lds); DN_LD20(recs + 2 * (size_t)REC); }
        else { DN_LD20(recs + REC); }
        DN_BAR();
        for (int n = 0; n < 128; n += 2) {
            if (grp == 1) { DN_ST20(lds + DBP_SIZE); if (n + 3 < 128) DN_LD20(recs + (size_t)(n + 3) * REC); }
            DN_BAR();
            if (grp == 0 && n + 2 < 128) { DN_ST20(lds); if (n + 4 < 128) DN_LD20(recs + (size_t)(n + 4) * REC); }
            DN_BAR();
        }
#undef DN_LD20
#undef DN_ST20
    } else {
        DN_BAR();
        for (int n = 0; n < 128; ++n) {
            const float eg0 = __int_as_float(__builtin_amdgcn_readlane(__float_as_int(n < 64 ? egA : egB), n & 63));
            f32x4 o[4];
#if DN_STAGED
            dn_step_p(lds + (n & 1) * DBP_SIZE, S, lds + (n & 1) * DBP_SIZE + DB_U0 + ((wave & 1) * 16 + fr) * 2, eg0, fr, fq, o);
#else
            dn_step<80>(lds + (n & 1) * DBP_SIZE, S, lds + (n & 1) * DBP_SIZE + DB_U0 + ((wave & 1) * 16 + fr) * 2, eg0, fr, fq, o);
#endif
            float* op = ORAW + (size_t)(b * 8192 + n * 64) * 512 + h * 128 + v0 + fr;
#pragma unroll
            for (int mt = 0; mt < 4; ++mt)
#pragma unroll
                for (int i = 0; i < 4; ++i) op[(size_t)(16 * mt + 4 * fq + i) * 512] = o[mt][i];
            DN_BAR();
        }
    }
    if (!loader) {
        float* so = a.out + O_PDS + (size_t)bh * 128 * 128 + v0 + fr;
#pragma unroll
        for (int m8 = 0; m8 < 8; ++m8)
#pragma unroll
            for (int i = 0; i < 4; ++i) so[(16 * m8 + 4 * fq + i) * 128] = S[m8][i];
    }
    __syncthreads();
}
DI void dn_scan_sample(const Args& a, unsigned char* lds, int tid, int wg, int nwg) {
    asm volatile("" : "+v"(tid));
    const int wave = __builtin_amdgcn_readfirstlane(tid >> 6), lane = tid & 63, fr = lane & 15, fq = lane >> 4;
    const int v0 = wave * 16;
    float* ORAW = (float*)(a.ws + WS_H);
    for (int su = wg; su < 128; su += nwg) {
        const int sb = su >> 2, h = su & 3;
        const unsigned char* rec = a.ws + WS_DNC + (size_t)(2048 + su) * REC;
        DnRegs<128> R; dn_load<128>(rec, tid, 0, R); dn_store<128>(lds, tid, R);
        __syncthreads();
        f32x4 S[8];
        const float* s0 = a.in[3] + (size_t)su * 128 * 128 + v0 + fr;
#pragma unroll
        for (int m8 = 0; m8 < 8; ++m8)
#pragma unroll
            for (int i = 0; i < 4; ++i) S[m8][i] = s0[(16 * m8 + 4 * fq + i) * 128];
        f32x4 o[4];
        dn_step<272>(lds, S, lds + DB_U0 + (v0 + fr) * 2, ((const float*)(a.ws + WS_EG))[2048 + su], fr, fq, o);
        float* op = ORAW + (size_t)(TP + sb * 16) * 512 + h * 128 + v0 + fr;
#pragma unroll
        for (int i = 0; i < 4; ++i) op[(size_t)(4 * fq + i) * 512] = o[0][i];
        float* so = a.out + O_SDS + (size_t)su * 128 * 128 + v0 + fr;
#pragma unroll
        for (int m8 = 0; m8 < 8; ++m8)
#pragma unroll
            for (int i = 0; i < 4; ++i) so[(16 * m8 + 4 * fq + i) * 128] = S[m8][i];
        __syncthreads();
    }
}

DI void mix_phase(const Args& a, int gw, int NGW, int lane) {
    asm volatile("" : "+v"(lane));
    const float* ORAW = (const float*)(a.ws + WS_H);
    const bf16* P = (const bf16*)(a.ws + WS_P);
    const bf16* GLU = (const bf16*)(a.ws + WS_GLU);
    bf16* MIX = (bf16*)(a.ws + WS_DNC);
    const f32x2 dg = *(const f32x2*)(a.in[12] + 2 * lane);
    const f32x4 sg0 = *(const f32x4*)(a.in[23] + 8 * lane), sg1 = *(const f32x4*)(a.in[23] + 8 * lane + 4);
    for (int row = gw; row < T; row += NGW) {
#pragma unroll
        for (int h = 0; h < 4; ++h) {
            const f32x2 ov = *(const f32x2*)(ORAW + (size_t)row * 512 + h * 128 + 2 * lane);
            const float r = rsqrtf(wave_sum(ov.x * ov.x + ov.y * ov.y) * (1.f / 128.f) + EPS);
            const unsigned zz = *(const unsigned*)(P + (size_t)row * PW + 1536 + h * 128 + 2 * lane);
            *(unsigned*)(MIX + (size_t)row * DM + h * 128 + 2 * lane) = pk2(ov.x * r * dg.x * silu(blo(zz)), ov.y * r * dg.y * silu(bhi(zz)));
        }
        const u32x4 gv = *(const u32x4*)(GLU + (size_t)row * 512 + 8 * lane);
        float v[8] = {blo(gv.x), bhi(gv.x), blo(gv.y), bhi(gv.y), blo(gv.z), bhi(gv.z), blo(gv.w), bhi(gv.w)};
        float ss = 0.f;
#pragma unroll
        for (int e = 0; e < 8; ++e) ss += v[e] * v[e];
        const float r5 = rsqrtf(wave_sum(ss) * (1.f / 512.f) + EPS);
        u32x4 w; w.x = pk2(v[0] * r5 * sg0[0], v[1] * r5 * sg0[1]); w.y = pk2(v[2] * r5 * sg0[2], v[3] * r5 * sg0[3]);
        w.z = pk2(v[4] * r5 * sg1[0], v[5] * r5 * sg1[1]); w.w = pk2(v[6] * r5 * sg1[2], v[7] * r5 * sg1[3]);
        *(u32x4*)(MIX + (size_t)row * DM + 512 + 8 * lane) = w;
    }
}

DI void act_phase(const Args& a, int gtid, int NT) {
    asm volatile("" : "+v"(gtid));
    bf16* UP = (bf16*)(a.ws + WS_UP);
    const float* fw = a.in[27]; const float* fb = a.in[28];
    constexpr int NCG = DFF / 8;
    for (int item = gtid; item < (T / 16) * NCG; item += NT) {
        const int cg8 = item % NCG, rb = item / NCG, col = cg8 * 8, row0 = rb * 16;
        float w0[8], w1[8], w2[8], bb[8], g2[8], g1[8];
#pragma unroll
        for (int e = 0; e < 8; ++e) { w0[e] = fw[col + e]; w1[e] = fw[DFF + col + e]; w2[e] = fw[2 * DFF + col + e]; bb[e] = fb[col + e]; g2[e] = 0.f; g1[e] = 0.f; }
        const bool sample = row0 >= TP;
        float* outp = nullptr;
        if (sample) { const int sb = (row0 - TP) >> 4; const float* cc = a.in[6] + (size_t)sb * 2 * DFF + col;
#pragma unroll
            for (int e = 0; e < 8; ++e) { g2[e] = cc[e]; g1[e] = cc[DFF + e]; }
            outp = a.out + O_SFC + (size_t)sb * 2 * DFF + col;
        } else {
            if ((rb & 511) != 0) {
                const u32x4 x2 = *(const u32x4*)(UP + (size_t)(row0 - 2) * UPW + col), x1 = *(const u32x4*)(UP + (size_t)(row0 - 1) * UPW + col);
                g2[0] = blo(x2.x); g2[1] = bhi(x2.x); g2[2] = blo(x2.y); g2[3] = bhi(x2.y); g2[4] = blo(x2.z); g2[5] = bhi(x2.z); g2[6] = blo(x2.w); g2[7] = bhi(x2.w);
                g1[0] = blo(x1.x); g1[1] = bhi(x1.x); g1[2] = blo(x1.y); g1[3] = bhi(x1.y); g1[4] = blo(x1.z); g1[5] = bhi(x1.z); g1[6] = blo(x1.w); g1[7] = bhi(x1.w);
            }
            if ((rb & 511) == 511) outp = a.out + O_PFC + (size_t)(rb >> 9) * 2 * DFF + col;
        }
#pragma unroll 4
        for (int r = 0; r < 16; ++r) {
            bf16* gp = UP + (size_t)(row0 + r) * UPW + col;
            const u32x4 xg = *(const u32x4*)gp, xv = *(const u32x4*)(gp + DFF);
            float g0[8] = {blo(xg.x), bhi(xg.x), blo(xg.y), bhi(xg.y), blo(xg.z), bhi(xg.z), blo(xg.w), bhi(xg.w)};
            float vv[8] = {blo(xv.x), bhi(xv.x), blo(xv.y), bhi(xv.y), blo(xv.z), bhi(xv.z), blo(xv.w), bhi(xv.w)};
            float o[8];
#pragma unroll
            for (int e = 0; e < 8; ++e) { o[e] = silu(g2[e] * w0[e] + g1[e] * w1[e] + g0[e] * w2[e] + bb[e]) * vv[e]; g2[e] = g1[e]; g1[e] = g0[e]; }
            u32x4 w; w.x = pk2(o[0], o[1]); w.y = pk2(o[2], o[3]); w.z = pk2(o[4], o[5]); w.w = pk2(o[6], o[7]);
            *(u32x4*)(gp + DFF) = w;
            if (outp && r >= 14) {
#pragma unroll
                for (int e = 0; e < 8; ++e) outp[(r - 14) * DFF + e] = g0[e];
            }
        }
    }
}

DI void final_phase(const Args& a, int gw, int NGW, int lane) {
    asm volatile("" : "+v"(lane));
    f32x4 gv[4];
#pragma unroll
    for (int j = 0; j < 4; ++j) gv[j] = ((const f32x4*)a.in[30])[lane + 64 * j];
    for (int m = gw; m < T; m += NGW) {
        f32x4* xr = (f32x4*)(a.out + (size_t)m * DM) + lane;
        f32x4 v[4]; float s = 0.f;
#pragma unroll
        for (int j = 0; j < 4; ++j) { v[j] = xr[64 * j]; s += (v[j].x * v[j].x + v[j].y * v[j].y) + (v[j].z * v[j].z + v[j].w * v[j].w); }
        const float rstd = rsqrtf(wave_sum(s) * (1.f / DM) + EPS);
#pragma unroll
        for (int j = 0; j < 4; ++j) xr[64 * j] = v[j] * rstd * gv[j];
    }
}

#ifndef PH_MASK
#define PH_MASK 0xffff
#endif
#ifndef SOLVE_RL
#define SOLVE_RL 1
#endif
#ifndef REP0
#define REP0 1
#endif
#ifndef REP1
#define REP1 1
#endif
#ifndef REP2A
#define REP2A 1
#endif
#ifndef REP2B
#define REP2B 1
#endif
#ifndef REP3A
#define REP3A 1
#endif
#ifndef REP3B
#define REP3B 1
#endif
#ifndef REP3C
#define REP3C 1
#endif
#ifndef PH_LO
#define PH_LO 0
#endif
#ifndef PH_HI
#define PH_HI 99
#endif
__global__ void __launch_bounds__(512, 2) fwd_kernel(Args a) {
    extern __shared__ __attribute__((aligned(16))) unsigned char lds[];
    cg::grid_group grid = cg::this_grid();
    const int tid = threadIdx.x, lane = tid & 63, wave = __builtin_amdgcn_readfirstlane(tid >> 6);
    const int G = gridDim.x, gw = blockIdx.x * 8 + wave, NGW = G * 8;
    unsigned char* ws = a.ws;
    PG8_LAS unsigned char* ldsg = (PG8_LAS unsigned char*)lds;

    _Pragma("nounroll") for (int rep = 0; rep < REP0; ++rep) { phase0(a, lds, gw, NGW, wave, lane); __syncthreads(); }
    grid.sync();
    _Pragma("nounroll") for (int rep = 0; rep < REP1; ++rep)
    { pg8::Gemm g{(const bf16*)(ws + WS_H), (const bf16*)(ws + WS_WIN), T, NIN, DM, DM}; pg8::StaticOrder S; S.init(T, NIN, G, (int)blockIdx.x);
      EpiP E{(bf16*)(ws + WS_P), (float*)(ws + WS_BA)};
      pg8::gemm_phase<EpiP, pg8::StaticOrder, true, true>(ldsg, g, S, E); }
    grid.sync();
    _Pragma("nounroll") for (int rep = 0; rep < REP2A; ++rep) dn_chunk_phase(a, lds, tid);
#if OLD_S5 && OLD_S5 != 4 && OLD_S5 != 5
    old_s5_pass1(a, gw, NGW, lane);
#elif 0
#else
    _Pragma("nounroll") for (int rep = 0; rep < REP2B; ++rep) s5_pass1(a, gw, NGW, lane);
#endif
    grid.sync();
#if OLD_S5 == 3
    if (blockIdx.x < 64) dn_scan_prompt(a, lds, tid);
    else { if (blockIdx.x >= 192) { dn_scan_sample(a, lds, tid, (int)blockIdx.x - 192, 64); s5_pass2_sample(a, lds + 81920 + wave * 4352, ((int)blockIdx.x - 192) * 8 + wave, 512, lane); __syncthreads(); }
           old_s5_pass2(a, lds + 81920 + wave * 4352, gw - 512, NGW - 512, lane); }
#elif OLD_S5 == 5
    if (blockIdx.x < 64) { _Pragma("nounroll") for (int rep = 0; rep < REP3A; ++rep) dn_scan_prompt(a, lds, tid); }
    else { if (blockIdx.x >= 192) dn_scan_sample(a, lds, tid, (int)blockIdx.x - 192, 64); _Pragma("nounroll") for (int rep = 0; rep < REP3B; ++rep) s5_pass2b(a, lds + wave * 14592, gw - 512, NGW - 512, lane); }
#elif OLD_S5 == 1 || OLD_S5 == 4
    if (blockIdx.x < 64) dn_scan_prompt(a, lds, tid);
    else { if (blockIdx.x >= 192) dn_scan_sample(a, lds, tid, (int)blockIdx.x - 192, 64); old_s5_pass2(a, lds + 81920 + wave * 4352, gw - 512, NGW - 512, lane); }
#else
    if (blockIdx.x < 64) { _Pragma("nounroll") for (int rep = 0; rep < REP3A; ++rep) dn_scan_prompt(a, lds, tid); }
    else if (blockIdx.x < 192) { _Pragma("nounroll") for (int rep = 0; rep < REP3B; ++rep) s5_pass2_prompt(a, lds, (int)blockIdx.x - 64, tid); }
    else { _Pragma("nounroll") for (int rep = 0; rep < REP3C; ++rep) { dn_scan_sample(a, lds, tid, (int)blockIdx.x - 192, 64); s5_pass2_sample(a, lds + 81920 + wave * 4352, ((int)blockIdx.x - 192) * 8 + wave, 512, lane); } }
#endif
    grid.sync();
#if PH_MASK & 512
    { pg8::Gemm g{(const bf16*)(ws + WS_Y5), (const bf16*)(ws + WS_WGLU), T, 1024, 512, 512}; pg8::StaticOrder S; S.init(T, 1024, G, (int)blockIdx.x);
      EpiGlu E{(bf16*)(ws + WS_GLU), a.in[22]};
      pg8::gemm_phase<EpiGlu, pg8::StaticOrder, true, true>(ldsg, g, S, E); }
#endif
    grid.sync();
#if PH_MASK & 32
    mix_phase(a, gw, NGW, lane);
#endif
    grid.sync();
#if PH_MASK & 1024
    { pg8::Gemm g{(const bf16*)(ws + WS_DNC), (const bf16*)(ws + WS_WOUT), T, DM, DM, DM}; pg8::StaticOrder S; S.init(T, DM, G, (int)blockIdx.x);
      EpiX1 E{a.in[0], a.in[1], a.out, (bf16*)(ws + WS_H), (float*)(ws + WS_SS2)};
      pg8::gemm_phase<EpiX1, pg8::StaticOrder, true, true>(ldsg, g, S, E); }
#endif
    grid.sync();
#if PH_MASK & 2048
    { pg8::Gemm g{(const bf16*)(ws + WS_H), (const bf16*)(ws + WS_WUP), T, UPW, DM, DM}; pg8::StaticOrder S; S.init(T, UPW, G, (int)blockIdx.x);
      EpiUp E{(bf16*)(ws + WS_UP), (const float*)(ws + WS_SS2)};
      pg8::gemm_phase<EpiUp, pg8::StaticOrder, true, true>(ldsg, g, S, E); }
#endif
    grid.sync();
#if PH_MASK & 64
    act_phase(a, (int)blockIdx.x * 512 + tid, G * 512);
#endif
    grid.sync();
#if PH_MASK & 4096
    { pg8::Gemm g{(const bf16*)(ws + WS_UP) + DFF, (const bf16*)(ws + WS_WDOWN), T, DM, DFF, UPW}; pg8::StaticOrder S; S.init(T, DM, G, (int)blockIdx.x);
      EpiX2 E{a.out};
      pg8::gemm_phase<EpiX2, pg8::StaticOrder, true, true>(ldsg, g, S, E); }
#endif
    grid.sync();
#if PH_MASK & 128
    final_phase(a, gw, NGW, lane);
#endif
}

extern "C" void kernel_launch(void* const* d_in, const int* in_sizes, int n_in, void* d_out, int out_size, void* d_ws, size_t ws_size, hipStream_t stream) {
    static int grid = 0;
    if (grid == 0) {
        if (n_in != 31 || (size_t)out_size != O_END || ws_size < WS_END) { fprintf(stderr, "kernel_launch: unexpected shapes n_in %d out %d ws %zu\n", n_in, out_size, ws_size); grid = -1; return; }
        int dev = 0, cus = 0, per_cu = 0;
        hipGetDevice(&dev);
        hipDeviceGetAttribute(&cus, hipDeviceAttributeMultiprocessorCount, dev);
        hipFuncSetAttribute((const void*)fwd_kernel, hipFuncAttributeMaxDynamicSharedMemorySize, LDS_BYTES);
        hipOccupancyMaxActiveBlocksPerMultiprocessor(&per_cu, (const void*)fwd_kernel, 512, LDS_BYTES);
        if (per_cu < 1) { fprintf(stderr, "kernel_launch: occupancy query says %d blocks per CU\n", per_cu); per_cu = 1; }
        grid = cus * 1;
        if (grid != 256) { fprintf(stderr, "kernel_launch: built for a 256-CU device, got %d\n", cus); grid = -1; return; }
        (void)hipGetLastError();
    }
    if (grid < 0) return;
    Args a{};
    for (int i = 0; i < 31; ++i) a.in[i] = (const float*)d_in[i];
    a.out = (float*)d_out; a.ws = (unsigned char*)d_ws;
    void* args[] = {&a};
    hipError_t e = hipLaunchCooperativeKernel((const void*)fwd_kernel, dim3(grid), dim3(512), args, LDS_BYTES, stream);
    if (e != hipSuccess) fprintf(stderr, "cooperative launch failed: %s (grid %d)\n", hipGetErrorString(e), grid);
}
```

```cpp
#include <hip/hip_runtime.h>
#include <hip/hip_cooperative_groups.h>
#include <cstdio>
#include <cstdint>
namespace cg = cooperative_groups;
#define OLD_S5 5
#define DN_STAGED 2
namespace pg8 {
#define PG8_LAS __attribute__((address_space(3)))
typedef unsigned short bf16_t;
typedef short bf16x8 __attribute__((ext_vector_type(8)));
typedef float f32x4 __attribute__((ext_vector_type(4)));
typedef unsigned u32x4 __attribute__((ext_vector_type(4)));
constexpr int BM = 256, BK = 64, HALF = 128, HTB = HALF * BK * 2  , STAGE_BYTES = 8 * HTB, NXCD = 8, WGM = 8;

__host__ __device__ __forceinline__ int lds_byte(int r, int c) { const int st = (r >> 4) * 2 + (c >> 5), rr = r & 15, cc = c & 31, ob = rr * 64 + cc * 2; return st * 1024 + (ob ^ (((ob >> 9) & 1) << 5)); }
__host__ __device__ __forceinline__ void stage_rc(int b, int& R, int& C) { const int st = b / 1024, sb = b % 1024, swz = sb ^ (((sb >> 9) & 1) << 5); R = (st >> 1) * 16 + swz / 64; C = (st & 1) * 32 + (swz % 64) / 2; }
__host__ __device__ __forceinline__ int perm32(int rho) { const int n = rho >> 4, i = rho & 15; return 8 * (i >> 2) + 4 * n + (i & 3); }

struct Unit { int pm, pn; };
struct Gemm { const bf16_t* A; const bf16_t* Bt; int M, N, K, lda; };

struct StaticOrder {
    int nM, nN, nwg, G, c;
    __host__ __device__ void init(int M, int N, int G_, int c_) { nM = M / BM; nN = N / BM; nwg = nM * nN; G = G_; c = c_; }
    __host__ __device__ bool next(int i, Unit& u) const {
        const long L = (long)i * G + c; if (L >= nwg) return false;
        int wgid = (int)L; { const int q = nwg / NXCD, r = nwg % NXCD, xcd = wgid % NXCD, off = wgid / NXCD; wgid = (xcd < r ? xcd * (q + 1) : r * (q + 1) + (xcd - r) * q) + off; }
        const int nig = WGM * nN, gid = wgid / nig, fm = gid * WGM, gsz = (nM - fm) < WGM ? (nM - fm) : WGM;
        u.pm = fm + ((wgid % nig) % gsz); u.pn = (wgid % nig) / gsz; return true;
    }
    __device__ __forceinline__ void a_ready(const Unit&) const {}
    __device__ __forceinline__ void done(const Unit&) const {}
};
__device__ __forceinline__ unsigned cvt_pk_bf16(float lo, float hi) { unsigned r; asm volatile("v_cvt_pk_bf16_f32 %0, %1, %2" : "=v"(r) : "v"(lo), "v"(hi)); return r; }
typedef float f32x2 __attribute__((ext_vector_type(2)));
template <class Epi, class Sched, bool ALIGN_EPI = false, bool SP2 = false>
__device__ __forceinline__ void gemm_phase(PG8_LAS unsigned char* lds, const Gemm g, const Sched& S, const Epi& E) {
    int tid_ = threadIdx.x; asm volatile("" : "+v"(tid_));
    const int tid = tid_, wid = __builtin_amdgcn_readfirstlane(tid >> 6), lane = tid & 63, wr = wid >> 2, wc = wid & 3, fr = lane & 15, fq = lane >> 4;
    const int K = g.K, nt = K / BK;
    unsigned voffA[2], voffB[2];
#pragma unroll
    for (int i = 0; i < 2; ++i) { int R, C; stage_rc(tid * 16 + i * 8192, R, C); const int Rb = Epi::PERM ? ((R & ~31) + perm32(R & 31)) : R;
        voffA[i] = (unsigned)(R * g.lda + C) * 2u; voffB[i] = (unsigned)(Rb * K + C) * 2u; }
    const size_t kstep = (size_t)(BK * 2);
    const size_t hstep = (size_t)HALF * K * 2;
    const size_t tstep = 2 * hstep; const size_t hstepA = (size_t)HALF * g.lda * 2, tstepA = 2 * hstepA;
    const unsigned ldsw = (unsigned)wid * 1024u;
    const int aoff = lds_byte(wr * 64 + fr, fq * 8), boff = lds_byte(wc * 32 + fr, fq * 8);
#define PG8_SA(b, h) (((b) * 2 + (h)) * HTB)
#define PG8_SB(b, h) ((4 + (b) * 2 + (h)) * HTB)
#define PG8_STAGE(bufoff, gbase, voff) do { _Pragma("unroll") for (int _i = 0; _i < 2; ++_i) \
        __builtin_amdgcn_global_load_lds((const unsigned*)((const char*)(gbase) + (voff)[_i]), (PG8_LAS unsigned*)(lds + (bufoff) + ldsw + _i * 8192), 16, 0, 0); } while (0)
#define PG8_LDA(dst, b, h) do { _Pragma("unroll") for (int m = 0; m < 4; ++m) _Pragma("unroll") for (int k = 0; k < 2; ++k) dst[m][k] = *(const PG8_LAS bf16x8*)(lds + PG8_SA(b, h) + aoff + m * 2048 + k * 1024); } while (0)
#define PG8_LDB(dst, b, h) do { _Pragma("unroll") for (int n = 0; n < 2; ++n) _Pragma("unroll") for (int k = 0; k < 2; ++k) dst[n][k] = *(const PG8_LAS bf16x8*)(lds + PG8_SB(b, h) + boff + n * 2048 + k * 1024); } while (0)
#define PG8_MMA(ai, bj, At, Bt) do { __builtin_amdgcn_s_setprio(1); _Pragma("unroll") for (int m = 0; m < 4; ++m) _Pragma("unroll") for (int n = 0; n < 2; ++n) _Pragma("unroll") for (int k = 0; k < 2; ++k) \
        acc[ai][bj][m][n] = __builtin_amdgcn_mfma_f32_16x16x32_bf16(Bt[n][k], At[m][k], acc[ai][bj][m][n], 0, 0, 0); __builtin_amdgcn_s_setprio(0); } while (0)
#define PG8_WAIT_V(n) asm volatile("s_waitcnt vmcnt(" #n ")" ::: "memory")
#define PG8_WAIT_L(n) asm volatile("s_waitcnt lgkmcnt(" #n ")" ::: "memory")
#define PG8_BAR __builtin_amdgcn_s_barrier()
#define PG8_SCHED __builtin_amdgcn_sched_barrier(0)
    Unit cur, nxt; int ui = 0;
    if (!S.next(0, cur)) return;
    f32x4 acc[2][2][4][2];
#pragma unroll
    for (int a = 0; a < 2; ++a)
#pragma unroll
        for (int b = 0; b < 2; ++b)
#pragma unroll
            for (int m = 0; m < 4; ++m)
#pragma unroll
                for (int n = 0; n < 2; ++n) acc[a][b][m][n] = (f32x4){0.f, 0.f, 0.f, 0.f};
    bf16x8 At[4][2], B0[2][2], B1[2][2];
    const char* cA = (const char*)g.A + (size_t)cur.pm * tstepA; const char* cB = (const char*)g.Bt + (size_t)cur.pn * tstep;
    S.a_ready(cur);
    if constexpr (SP2) {
        PG8_STAGE(PG8_SB(0, 0), cB, voffB); PG8_STAGE(PG8_SB(0, 1), cB + hstep, voffB); PG8_STAGE(PG8_SA(0, 0), cA, voffA); PG8_STAGE(PG8_SA(0, 1), cA + hstepA, voffA);
        if (wr == 1) PG8_BAR;
        PG8_WAIT_V(2); PG8_BAR;
        PG8_STAGE(PG8_SB(1, 0), cB + kstep, voffB); PG8_STAGE(PG8_SA(1, 0), cA + kstep, voffA); PG8_STAGE(PG8_SB(1, 1), cB + hstep + kstep, voffB);
        PG8_WAIT_V(6); PG8_BAR;
    } else {
        PG8_STAGE(PG8_SB(0, 0), cB, voffB); PG8_STAGE(PG8_SA(0, 0), cA, voffA); PG8_STAGE(PG8_SB(0, 1), cB + hstep, voffB); PG8_STAGE(PG8_SA(0, 1), cA + hstepA, voffA);
        if (wr == 1) PG8_BAR;
        PG8_WAIT_V(4); PG8_BAR;
        PG8_STAGE(PG8_SB(1, 0), cB + kstep, voffB); PG8_STAGE(PG8_SA(1, 0), cA + kstep, voffA); PG8_STAGE(PG8_SB(1, 1), cB + hstep + kstep, voffB);
        PG8_WAIT_V(6); PG8_BAR;
    }
    for (;;) {
        const bool has_next = S.next(ui + 1, nxt);
        const char* nA = has_next ? (const char*)g.A + (size_t)nxt.pm * tstepA : cA; const char* nB = has_next ? (const char*)g.Bt + (size_t)nxt.pn * tstep : cB;
        for (int t = 0; t < nt; t += 2) {
            const bool last = (t == nt - 2);
            const char* a1 = cA + (size_t)(t + 1) * kstep;
            const char* a2 = last ? nA : cA + (size_t)(t + 2) * kstep; const char* b2 = last ? nB : cB + (size_t)(t + 2) * kstep;
            const char* a3 = a2 + kstep; const char* b3 = b2 + kstep;
            if (last && has_next) S.a_ready(nxt);
            if constexpr (SP2) {
            PG8_LDB(B0, 0, 0); PG8_LDB(B1, 0, 1); PG8_SCHED; PG8_LDA(At, 0, 0); PG8_STAGE(PG8_SA(1, 1), a1 + hstepA, voffA);
            PG8_WAIT_V(8); PG8_WAIT_L(0); PG8_BAR; PG8_MMA(0, 0, At, B0); PG8_MMA(0, 1, At, B1); PG8_BAR; PG8_SCHED;
            PG8_LDA(At, 0, 1); PG8_STAGE(PG8_SB(0, 0), b2, voffB); PG8_STAGE(PG8_SB(0, 1), b2 + hstep, voffB); PG8_STAGE(PG8_SA(0, 0), a2, voffA);
            PG8_WAIT_V(8); PG8_WAIT_L(0); PG8_BAR; PG8_MMA(1, 0, At, B0); PG8_MMA(1, 1, At, B1); PG8_BAR; PG8_SCHED;
            PG8_LDB(B0, 1, 0); PG8_LDB(B1, 1, 1); PG8_SCHED; PG8_LDA(At, 1, 0); PG8_STAGE(PG8_SA(0, 1), a2 + hstepA, voffA);
            PG8_WAIT_V(8); PG8_WAIT_L(0); PG8_BAR; PG8_MMA(0, 0, At, B0); PG8_MMA(0, 1, At, B1); PG8_BAR; PG8_SCHED;
            PG8_LDA(At, 1, 1); PG8_STAGE(PG8_SB(1, 0), b3, voffB); PG8_STAGE(PG8_SB(1, 1), b3 + hstep, voffB); PG8_STAGE(PG8_SA(1, 0), a3, voffA);
            PG8_WAIT_V(8); PG8_WAIT_L(0); PG8_BAR; PG8_MMA(1, 0, At, B0); PG8_MMA(1, 1, At, B1); PG8_BAR; PG8_SCHED;
            } else {
            PG8_LDB(B0, 0, 0); PG8_SCHED; PG8_LDA(At, 0, 0); PG8_STAGE(PG8_SA(1, 1), a1 + hstepA, voffA);
            PG8_WAIT_L(8); PG8_BAR; PG8_WAIT_L(0); PG8_MMA(0, 0, At, B0); PG8_BAR; PG8_SCHED;
            PG8_LDB(B1, 0, 1); PG8_STAGE(PG8_SB(0, 0), b2, voffB);
            PG8_BAR; PG8_WAIT_L(0); PG8_MMA(0, 1, At, B1); PG8_BAR;
            PG8_LDA(At, 0, 1); PG8_STAGE(PG8_SA(0, 0), a2, voffA);
            PG8_BAR; PG8_WAIT_L(0); PG8_MMA(1, 0, At, B0); PG8_BAR; PG8_SCHED;
            PG8_STAGE(PG8_SB(0, 1), b2 + hstep, voffB);
            PG8_WAIT_V(6); PG8_BAR; PG8_MMA(1, 1, At, B1); PG8_BAR;
            PG8_LDB(B0, 1, 0); PG8_SCHED; PG8_LDA(At, 1, 0); PG8_STAGE(PG8_SA(0, 1), a2 + hstepA, voffA);
            PG8_WAIT_L(8); PG8_BAR; PG8_WAIT_L(0); PG8_MMA(0, 0, At, B0); PG8_BAR; PG8_SCHED;
            PG8_LDB(B1, 1, 1); PG8_STAGE(PG8_SB(1, 0), b3, voffB);
            PG8_BAR; PG8_WAIT_L(0); PG8_MMA(0, 1, At, B1); PG8_BAR;
            PG8_LDA(At, 1, 1); PG8_STAGE(PG8_SA(1, 0), a3, voffA);
            PG8_BAR; PG8_WAIT_L(0); PG8_MMA(1, 0, At, B0); PG8_BAR; PG8_SCHED;
            PG8_STAGE(PG8_SB(1, 1), b3 + hstep, voffB);
            PG8_WAIT_V(6); PG8_BAR; PG8_MMA(1, 1, At, B1); PG8_BAR;
            }
        }
        if constexpr (ALIGN_EPI) { if (wr == 0) PG8_BAR; }
        if constexpr (!Epi::AFTER_DRAIN) { E(acc, cur, wr, wc, fr, fq); S.done(cur); }
        if (!has_next) break;
#pragma unroll
        for (int a = 0; a < 2; ++a)
#pragma unroll
            for (int b = 0; b < 2; ++b)
#pragma unroll
                for (int m = 0; m < 4; ++m)
#pragma unroll
                    for (int n = 0; n < 2; ++n) acc[a][b][m][n] = (f32x4){0.f, 0.f, 0.f, 0.f};
        cur = nxt; cA = nA; cB = nB; ++ui;
        if constexpr (ALIGN_EPI) { if (wr == 1) PG8_BAR; }
    }
    PG8_WAIT_V(0);
    if constexpr (!ALIGN_EPI) { if (wr == 0) PG8_BAR; }
    PG8_BAR;
    if constexpr (Epi::AFTER_DRAIN) { E.fused(acc, cur, wr, wc, fr, fq, lds, wid, lane); S.done(cur); }
#undef PG8_SA
#undef PG8_SB
#undef PG8_STAGE
#undef PG8_LDA
#undef PG8_LDB
#undef PG8_MMA
#undef PG8_WAIT_V
#undef PG8_WAIT_L
#undef PG8_BAR
#undef PG8_SCHED
}
}

#ifndef FUSE_ACT
#define FUSE_ACT 1
#endif
#ifndef DN_STAGED
#define DN_STAGED 1
#endif
#ifndef DIAG_Y
#define DIAG_Y 0
#endif
#ifndef OLD_S5
#define OLD_S5 0
#endif
#if OLD_S5 == 3
#define OLD_S5_ULIM 8192
#else
#define OLD_S5_ULIM (4 * 32 * 64 + 32 * 32)
#endif
#define DI __device__ __forceinline__
typedef unsigned short bf16;
typedef float f32x4 __attribute__((ext_vector_type(4)));
typedef float f32x2 __attribute__((ext_vector_type(2)));
typedef short bf16x8 __attribute__((ext_vector_type(8)));
typedef unsigned u32x4 __attribute__((ext_vector_type(4)));
typedef unsigned u32x2 __attribute__((ext_vector_type(2)));
typedef __bf16 bf16x2_t __attribute__((ext_vector_type(2)));

DI unsigned pk2(float lo, float hi) { f32x2 v = {lo, hi}; bf16x2_t b = __builtin_convertvector(v, bf16x2_t); return __builtin_bit_cast(unsigned, b); }
DI bf16 f2b(float x) { return (bf16)(pk2(x, 0.f) & 0xffffu); }
DI float b2f(unsigned b) { return __uint_as_float(b << 16); }
DI float blo(unsigned w) { return __uint_as_float(w << 16); }
DI float bhi(unsigned w) { return __uint_as_float(w & 0xffff0000u); }
DI float wave_sum(float v) {
#pragma unroll
    for (int o = 1; o < 64; o <<= 1) v += __shfl_xor(v, o);
    return v;
}
DI float sigm(float x) { return 1.f / (1.f + __expf(-x)); }
DI float silu(float x) { return x / (1.f + __expf(-x)); }
DI float gelu_tanh(float x) { const float z = 1.5957691216057308f * (x + 0.044715f * x * x * x); return x / (1.f + __expf(-z)); }
#define MFMA16(a, b, c) __builtin_amdgcn_mfma_f32_16x16x32_bf16((a), (b), (c), 0, 0, 0)

constexpr int TP = 32768, TS = 512, T = TP + TS;
constexpr int DM = 1024, PW = 2560, NIN = 2816, DFF = 2816, UPW = 5632;
constexpr float EPS = 1e-6f;
constexpr int NCH = 2048 + 128;
constexpr int REC = 73728;
constexpr int R_WN = 0, R_QG = 16384, R_KDT = 32768, R_QK = 49152, R_U0 = 57344;
constexpr size_t O_Y = 0, O_PDC = (size_t)T * DM, O_PDS = O_PDC + 4 * 3 * 1536, O_PSR = O_PDS + 4 * 4 * 128 * 128, O_PSI = O_PSR + 4 * 32 * 64,
                 O_PFC = O_PSI + 4 * 32 * 64, O_SDC = O_PFC + 4 * 2 * 2816, O_SDS = O_SDC + 32 * 3 * 1536, O_SSR = O_SDS + (size_t)32 * 4 * 128 * 128,
                 O_SSI = O_SSR + 32 * 32 * 64, O_SFC = O_SSI + 32 * 32 * 64, O_END = O_SFC + 32 * 2 * 2816;
constexpr size_t MiB = 1u << 20;
constexpr size_t WS_SS2 = 0;
constexpr size_t WS_EG = 3 * MiB;
constexpr size_t WS_BA = 4 * MiB;
constexpr size_t WS_WIN = 6 * MiB, WS_WGLU = 12 * MiB, WS_WOUT = 13 * MiB, WS_WUP = 15 * MiB, WS_WDOWN = 26 * MiB;
constexpr size_t WS_H = 32 * MiB;
constexpr size_t WS_P = 98 * MiB;
constexpr size_t WS_DNC = 262 * MiB;
constexpr size_t WS_Y5 = 416 * MiB, WS_GLU = 449 * MiB, WS_S5E = 482 * MiB, WS_END = 487 * MiB;
constexpr size_t WS_GH = 300 * MiB, WS_GT = 324 * MiB, WS_VH = 348 * MiB;
constexpr size_t WS_UP = 98 * MiB;
static_assert(WS_UP + (size_t)T * UPW * 2 <= WS_END && WS_P + (size_t)T * PW * 2 <= WS_DNC && WS_DNC + (size_t)NCH * REC <= WS_Y5, "ws map");
constexpr int LDS_BYTES = 147456;

struct Args { const float* in[31]; float* out; unsigned char* ws; };

DI int colmap(int mode, int n) {
    if (mode == 0) return n;
    if (mode == 1) return n < 2048 ? n : (n < 2560 ? n + 8 : (n < 2568 ? n - 512 : -1));
    const int pn = n >> 8, bj = (n >> 7) & 1, j = n & 127;
    return bj * (mode == 2 ? 512 : 2816) + 128 * pn + j;
}
DI void transpose_item(const float* W, int K, int N, bf16* WT, float* scr, int kb, int nb, int lane, int mode, const float* rs) {
    const int k0 = 64 * kb, n0 = 32 * nb;
    const int sc = colmap(mode, n0 + (lane & 31));
#pragma unroll 8
    for (int i = 0; i < 32; ++i) { const int kk = 2 * i + (lane >> 5); float v = 0.f; if (sc >= 0) v = W[(size_t)(k0 + kk) * N + sc]; if (rs) v *= rs[k0 + kk]; scr[kk * 33 + (lane & 31)] = v; }
    asm volatile("s_waitcnt lgkmcnt(0)" ::: "memory");
    const int c = lane & 7;
#pragma unroll
    for (int j = 0; j < 4; ++j) { const int n = (lane >> 3) + 8 * j; const float* s = scr + (8 * c) * 33 + n;
        u32x4 o; o.x = pk2(s[0 * 33], s[1 * 33]); o.y = pk2(s[2 * 33], s[3 * 33]); o.z = pk2(s[4 * 33], s[5 * 33]); o.w = pk2(s[6 * 33], s[7 * 33]);
        *(u32x4*)(WT + (size_t)(n0 + n) * K + k0 + 8 * c) = o; }
    asm volatile("s_waitcnt lgkmcnt(0)" ::: "memory");
}
DI void phase0(const Args& a, unsigned char* lds, int gw, int NGW, int wave, int lane) {
    asm volatile("" : "+v"(lane));
    unsigned char* ws = a.ws;
    float* scr = (float*)(lds + wave * 16384);
    constexpr int I_IN = 16 * (NIN / 32), I_GLU = 8 * 32, I_OUT = 16 * 32, I_UP = 16 * (UPW / 32), I_DN = 44 * 32;
    constexpr int NIT = I_IN + I_GLU + I_OUT + I_UP + I_DN;
    for (int it = gw; it < NIT; it += NGW) {
        int r = it;
        if (r < I_IN) { transpose_item(a.in[8], 1024, 2568, (bf16*)(ws + WS_WIN), scr, r / (NIN / 32), r % (NIN / 32), lane, 1, nullptr); continue; } r -= I_IN;
        if (r < I_GLU) { transpose_item(a.in[21], 512, 1024, (bf16*)(ws + WS_WGLU), scr, r / 32, r % 32, lane, 2, nullptr); continue; } r -= I_GLU;
        if (r < I_OUT) { transpose_item(a.in[24], 1024, 1024, (bf16*)(ws + WS_WOUT), scr, r / 32, r % 32, lane, 0, nullptr); continue; } r -= I_OUT;
        if (r < I_UP) { transpose_item(a.in[26], 1024, 5632, (bf16*)(ws + WS_WUP), scr, r / (UPW / 32), r % (UPW / 32), lane, 3, a.in[25]); continue; } r -= I_UP;
        transpose_item(a.in[29], 2816, 1024, (bf16*)(ws + WS_WDOWN), scr, r / 32, r % 32, lane, 0, nullptr);
    }
    const float* g1 = a.in[7];
    f32x4 gv[4];
#pragma unroll
    for (int j = 0; j < 4; ++j) gv[j] = ((const f32x4*)g1)[lane + 64 * j];
    bf16* H = (bf16*)(ws + WS_H);
    for (int m = gw; m < T; m += NGW) {
        const float* xrow = m < TP ? a.in[0] + (size_t)m * DM : a.in[1] + (size_t)(m - TP) * DM;
        const f32x4* xr = (const f32x4*)xrow + lane;
        f32x4 v[4]; float s = 0.f;
#pragma unroll
        for (int j = 0; j < 4; ++j) { v[j] = xr[64 * j]; s += (v[j].x * v[j].x + v[j].y * v[j].y) + (v[j].z * v[j].z + v[j].w * v[j].w); }
        const float rstd = rsqrtf(wave_sum(s) * (1.f / DM) + EPS);
        u32x2* o8 = (u32x2*)(H + (size_t)m * DM) + lane;
#pragma unroll
        for (int j = 0; j < 4; ++j) { u32x2 o; o.x = pk2(v[j].x * rstd * gv[j].x, v[j].y * rstd * gv[j].y); o.y = pk2(v[j].z * rstd * gv[j].z, v[j].w * rstd * gv[j].w); o8[64 * j] = o; }
    }
}

struct EpiP {
    static constexpr bool PERM = true, AFTER_DRAIN = false;
    bf16* P; float* BA;
    DI void operator()(const pg8::f32x4 (&acc)[2][2][4][2], const pg8::Unit& u, int wr, int wc, int fr, int fq) const {
        const int row0 = u.pm * 256 + wr * 64 + fr;
        if (u.pn < 10) {
            const int col0 = u.pn * 256 + wc * 32 + 8 * fq;
#pragma unroll
            for (int ai = 0; ai < 2; ++ai)
#pragma unroll
                for (int m = 0; m < 4; ++m) { bf16* rowp = P + (size_t)(row0 + ai * 128 + m * 16) * PW + col0;
#pragma unroll
                    for (int bj = 0; bj < 2; ++bj) { const pg8::f32x4 v0 = acc[ai][bj][m][0], v1 = acc[ai][bj][m][1];
                        u32x4 w; w.x = pk2(v0[0], v0[1]); w.y = pk2(v0[2], v0[3]); w.z = pk2(v1[0], v1[1]); w.w = pk2(v1[2], v1[3]);
                        *(u32x4*)(rowp + bj * 128) = w; } }
        } else if (wc == 0 && fq == 0) {
#pragma unroll
            for (int ai = 0; ai < 2; ++ai)
#pragma unroll
                for (int m = 0; m < 4; ++m) { float* bp = BA + (size_t)(row0 + ai * 128 + m * 16) * 8;
                    *(pg8::f32x4*)bp = acc[ai][0][m][0]; *(pg8::f32x4*)(bp + 4) = acc[ai][0][m][1]; }
        }
    }
};
struct EpiGlu {
    static constexpr bool PERM = true, AFTER_DRAIN = false;
    bf16* O; const float* gb;
    DI void operator()(const pg8::f32x4 (&acc)[2][2][4][2], const pg8::Unit& u, int wr, int wc, int fr, int fq) const {
        const int row0 = u.pm * 256 + wr * 64 + fr, col0 = u.pn * 128 + wc * 32 + 8 * fq;
        const pg8::f32x4 ba0 = *(const pg8::f32x4*)(gb + col0), ba1 = *(const pg8::f32x4*)(gb + col0 + 4), bg0 = *(const pg8::f32x4*)(gb + 512 + col0), bg1 = *(const pg8::f32x4*)(gb + 512 + col0 + 4);
#pragma unroll
        for (int ai = 0; ai < 2; ++ai)
#pragma unroll
            for (int m = 0; m < 4; ++m) {
                const pg8::f32x4 a0 = acc[ai][0][m][0] + ba0, a1 = acc[ai][0][m][1] + ba1, g0 = acc[ai][1][m][0] + bg0, g1 = acc[ai][1][m][1] + bg1;
                float o[8];
#pragma unroll
                for (int e = 0; e < 4; ++e) { o[e] = a0[e] * sigm(g0[e]); o[4 + e] = a1[e] * sigm(g1[e]); }
                u32x4 w; w.x = pk2(o[0], o[1]); w.y = pk2(o[2], o[3]); w.z = pk2(o[4], o[5]); w.w = pk2(o[6], o[7]);
                *(u32x4*)(O + (size_t)(row0 + ai * 128 + m * 16) * 512 + col0) = w;
            }
    }
};
struct EpiX1 {
    static constexpr bool PERM = false, AFTER_DRAIN = false;
    const float* xp; const float* xs; float* out; bf16* xb; float* ss2;
    DI void operator()(const pg8::f32x4 (&acc)[2][2][4][2], const pg8::Unit& u, int wr, int wc, int fr, int fq) const {
        const int row0 = u.pm * 256 + wr * 64 + fr, col0 = u.pn * 256 + wc * 32 + 4 * fq;
#pragma unroll
        for (int ai = 0; ai < 2; ++ai)
#pragma unroll
            for (int m = 0; m < 4; ++m) {
                const int row = row0 + ai * 128 + m * 16;
                const float* xr = (row < TP ? xp + (size_t)row * DM : xs + (size_t)(row - TP) * DM) + col0;
                float ss = 0.f;
#pragma unroll
                for (int bj = 0; bj < 2; ++bj)
#pragma unroll
                    for (int n = 0; n < 2; ++n) {
                        const pg8::f32x4 v = *(const pg8::f32x4*)(xr + bj * 128 + n * 16) + acc[ai][bj][m][n];
                        *(pg8::f32x4*)(out + (size_t)row * DM + col0 + bj * 128 + n * 16) = v;
                        u32x2 w; w.x = pk2(v[0], v[1]); w.y = pk2(v[2], v[3]);
                        *(u32x2*)(xb + (size_t)row * DM + col0 + bj * 128 + n * 16) = w;
                        ss += (v[0] * v[0] + v[1] * v[1]) + (v[2] * v[2] + v[3] * v[3]);
                    }
                ss += __shfl_xor(ss, 16); ss += __shfl_xor(ss, 32);
                if (fq == 0) ss2[(size_t)row * 16 + u.pn * 4 + wc] = ss;
            }
    }
};
struct EpiUp {
    static constexpr bool PERM = true, AFTER_DRAIN = false;
    bf16* UP; const float* ss2;
    DI void operator()(const pg8::f32x4 (&acc)[2][2][4][2], const pg8::Unit& u, int wr, int wc, int fr, int fq) const {
        const int row0 = u.pm * 256 + wr * 64 + fr, col0 = u.pn * 128 + wc * 32 + 8 * fq;
#pragma unroll
        for (int ai = 0; ai < 2; ++ai)
#pragma unroll
            for (int m = 0; m < 4; ++m) {
                const int row = row0 + ai * 128 + m * 16;
                const pg8::f32x4* sp = (const pg8::f32x4*)(ss2 + (size_t)row * 16);
                const pg8::f32x4 s0 = sp[0], s1 = sp[1], s2 = sp[2], s3 = sp[3];
                const float tot = ((s0[0] + s0[1]) + (s0[2] + s0[3])) + ((s1[0] + s1[1]) + (s1[2] + s1[3])) + ((s2[0] + s2[1]) + (s2[2] + s2[3])) + ((s3[0] + s3[1]) + (s3[2] + s3[3]));
                const float r = rsqrtf(tot * (1.f / DM) + EPS);
                bf16* rowp = UP + (size_t)row * UPW + col0;
#pragma unroll
                for (int bj = 0; bj < 2; ++bj) { const pg8::f32x4 v0 = acc[ai][bj][m][0] * r, v1 = acc[ai][bj][m][1] * r;
                    u32x4 w; w.x = pk2(v0[0], v0[1]); w.y = pk2(v0[2], v0[3]); w.z = pk2(v1[0], v1[1]); w.w = pk2(v1[2], v1[3]);
                    *(u32x4*)(rowp + bj * DFF) = w; }
            }
    }
};
DI float dpp_shr1(float v) { return __int_as_float(__builtin_amdgcn_update_dpp(0, __float_as_int(v), 0x111, 0xf, 0xf, false)); }
DI float dpp_shr2(float v) { return __int_as_float(__builtin_amdgcn_update_dpp(0, __float_as_int(v), 0x112, 0xf, 0xf, false)); }
struct EpiUpAct {
    static constexpr bool PERM = true, AFTER_DRAIN = false;
    bf16* ACT; bf16* GH; bf16* GT; bf16* VH; const float* ss2; const float* fw; const float* fb;
    DI void operator()(const pg8::f32x4 (&acc)[2][2][4][2], const pg8::Unit& u, int wr, int wc, int fr, int fq) const {
        const int row0 = u.pm * 256 + wr * 64 + fr, col0 = u.pn * 128 + wc * 32 + 8 * fq;
        float w0[8], w1[8], w2[8], bb[8];
#pragma unroll
        for (int n = 0; n < 2; ++n) { const pg8::f32x4 a0 = *(const pg8::f32x4*)(fw + col0 + 4 * n), a1 = *(const pg8::f32x4*)(fw + DFF + col0 + 4 * n), a2 = *(const pg8::f32x4*)(fw + 2 * DFF + col0 + 4 * n), a3 = *(const pg8::f32x4*)(fb + col0 + 4 * n);
#pragma unroll
            for (int e = 0; e < 4; ++e) { w0[4 * n + e] = a0[e]; w1[4 * n + e] = a1[e]; w2[4 * n + e] = a2[e]; bb[4 * n + e] = a3[e]; } }
#pragma unroll
        for (int ai = 0; ai < 2; ++ai)
#pragma unroll
            for (int m = 0; m < 4; ++m) {
                const int row = row0 + ai * 128 + m * 16, grp = row >> 4;
                const pg8::f32x4* sp = (const pg8::f32x4*)(ss2 + (size_t)row * 16);
                const pg8::f32x4 s0 = sp[0], s1 = sp[1], s2 = sp[2], s3 = sp[3];
                const float tot = ((s0[0] + s0[1]) + (s0[2] + s0[3])) + ((s1[0] + s1[1]) + (s1[2] + s1[3])) + ((s2[0] + s2[1]) + (s2[2] + s2[3])) + ((s3[0] + s3[1]) + (s3[2] + s3[3]));
                const float r = rsqrtf(tot * (1.f / DM) + EPS);
                float gs[8], vv[8], o[8];
#pragma unroll
                for (int n = 0; n < 2; ++n)
#pragma unroll
                    for (int e = 0; e < 4; ++e) { gs[4 * n + e] = acc[ai][0][m][n][e] * r; vv[4 * n + e] = acc[ai][1][m][n][e] * r; }
#pragma unroll
                for (int e = 0; e < 8; ++e) { const float g1 = dpp_shr1(gs[e]), g2 = dpp_shr2(gs[e]); o[e] = silu(g2 * w0[e] + g1 * w1[e] + gs[e] * w2[e] + bb[e]) * vv[e]; }
                u32x4 wg; wg.x = pk2(gs[0], gs[1]); wg.y = pk2(gs[2], gs[3]); wg.z = pk2(gs[4], gs[5]); wg.w = pk2(gs[6], gs[7]);
                if (fr >= 2) { u32x4 w; w.x = pk2(o[0], o[1]); w.y = pk2(o[2], o[3]); w.z = pk2(o[4], o[5]); w.w = pk2(o[6], o[7]);
                    *(u32x4*)(ACT + (size_t)row * DFF + col0) = w; }
                else { u32x4 wv; wv.x = pk2(vv[0], vv[1]); wv.y = pk2(vv[2], vv[3]); wv.z = pk2(vv[4], vv[5]); wv.w = pk2(vv[6], vv[7]);
                    *(u32x4*)(GH + ((size_t)grp * 2 + fr) * DFF + col0) = wg; *(u32x4*)(VH + ((size_t)grp * 2 + fr) * DFF + col0) = wv; }
                if (fr >= 14) *(u32x4*)(GT + ((size_t)grp * 2 + (fr - 14)) * DFF + col0) = wg;
            }
    }
};
struct EpiX2 {
    static constexpr bool PERM = false, AFTER_DRAIN = false;
    float* out;
    DI void operator()(const pg8::f32x4 (&acc)[2][2][4][2], const pg8::Unit& u, int wr, int wc, int fr, int fq) const {
        const int row0 = u.pm * 256 + wr * 64 + fr, col0 = u.pn * 256 + wc * 32 + 4 * fq;
#pragma unroll
        for (int ai = 0; ai < 2; ++ai)
#pragma unroll
            for (int m = 0; m < 4; ++m) {
                float* orow = out + (size_t)(row0 + ai * 128 + m * 16) * DM + col0;
#pragma unroll
                for (int bj = 0; bj < 2; ++bj)
#pragma unroll
                    for (int n = 0; n < 2; ++n) { pg8::f32x4* p = (pg8::f32x4*)(orow + bj * 128 + n * 16); *p = *p + acc[ai][bj][m][n]; }
            }
    }
};

DI int kperm(int k) { return (k & ~31) | (((k >> 2) & 3) << 3) | (((k >> 4) & 1) << 2) | (k & 3); }
DI void conv_col(const bf16* pcol, float h0, float h1, float h2, const float* cw, int nrows, float* outp, float (&val)[64]) {
    const float w0 = cw[0], w1 = cw[1536], w2 = cw[2 * 1536], w3 = cw[3 * 1536];
    float x3 = h0, x2 = h1, x1 = h2;
#pragma unroll
    for (int r = 0; r < 64; ++r) {
        float x0 = 0.f;
        if (r < nrows) x0 = b2f(pcol[(size_t)r * PW]);
        const float c = x3 * w0 + x2 * w1 + x1 * w2 + x0 * w3;
        val[r] = r < nrows ? silu(c) : 0.f;
        if (outp && r >= nrows - 3 && r < nrows) outp[(r - (nrows - 3)) * 1536] = x0;
        x3 = x2; x2 = x1; x1 = x0;
    }
}
DI void dn_chunk_phase(const Args& a, unsigned char* lds, int tid) {
    unsigned char* ws = a.ws;
    const bf16* P = (const bf16*)(ws + WS_P);
    const float* BA = (const float*)(ws + WS_BA);
    const float* cwt = a.in[9];
    constexpr float QSCALE = 0.08838834764831845f;
    for (int it = blockIdx.x; it < NCH / 2; it += gridDim.x) {
        int tl = tid; asm volatile("" : "+v"(tl));
        const int half = __builtin_amdgcn_readfirstlane(tl >> 8), t8 = tl & 255, hw = __builtin_amdgcn_readfirstlane((tl >> 6) & 3), lane = tl & 63, fr = lane & 15, fq = lane >> 4;
        unsigned char* L = lds + half * 53248;
        unsigned char* qb = L; unsigned char* kb = L + 17408;
        float* Am = (float*)(L + 34816);
        float* Gs = (float*)(L + 51200); float* Bs = Gs + 64; float* RQ = Gs + 128; float* RK = Gs + 192; float* EG = Gs + 256;
        const int unit = it * 2 + half;
        int row0, nrows, h, bidx; bool sample, first, lastc;
        if (unit < 2048) { const int b = unit >> 9, n = unit & 127; h = (unit >> 7) & 3; row0 = b * 8192 + n * 64; nrows = 64; sample = false; first = (n == 0); lastc = (n == 127); bidx = b; }
        else { const int su = unit - 2048; bidx = su >> 2; h = su & 3; row0 = TP + bidx * 16; nrows = 16; sample = true; first = false; lastc = true; }
        unsigned char* rec = ws + WS_DNC + (size_t)unit * REC;
        if (hw == 0) {
            float g = 0.f, be = 0.f;
            if (lane < nrows) {
                const float* bp = BA + (size_t)(row0 + lane) * 8;
                be = sigm(bp[h]);
                const float xx = bp[4 + h] + a.in[11][h];
                const float sp = xx > 20.f ? xx : log1pf(__expf(xx));
                g = -__expf(a.in[10][h]) * sp;
            }
#pragma unroll
            for (int o = 1; o < 64; o <<= 1) { const float v = __shfl_up(g, o); if (lane >= o) g += v; }
            Gs[lane] = g; Bs[lane] = be; EG[lane] = __expf(g);
            if (lane == 63) ((float*)(ws + WS_EG))[unit] = __expf(g);
        }
        float va[64];
        {
            const int c = t8 & 127;
            const int col = (t8 < 128 ? 0 : 512) + h * 128 + c;
            float h0 = 0.f, h1 = 0.f, h2 = 0.f;
            if (sample) { const float* cc = a.in[2] + (size_t)bidx * 3 * 1536 + col; h0 = cc[0]; h1 = cc[1536]; h2 = cc[2 * 1536]; }
            else if (!first) { const bf16* pp = P + (size_t)(row0 - 3) * PW + col; h0 = b2f(pp[0]); h1 = b2f(pp[PW]); h2 = b2f(pp[2 * PW]); }
            float* outp = lastc ? a.out + (sample ? O_SDC : O_PDC) + (size_t)bidx * 3 * 1536 + col : nullptr;
            conv_col(P + (size_t)row0 * PW + col, h0, h1, h2, cwt + col, nrows, outp, va);
            unsigned char* dst = (t8 < 128 ? qb : kb) + c * 2;
#pragma unroll
            for (int r = 0; r < 64; ++r) *(bf16*)(dst + r * 272) = f2b(va[r]);
        }
        __syncthreads();
        f32x4 kk[4], qk[4], qq;
        {
            bf16x8 ak[4], aq[4];
#pragma unroll
            for (int ks = 0; ks < 4; ++ks) { ak[ks] = *(const bf16x8*)(kb + (16 * hw + fr) * 272 + ks * 64 + fq * 16); aq[ks] = *(const bf16x8*)(qb + (16 * hw + fr) * 272 + ks * 64 + fq * 16); }
            qq = (f32x4){0.f, 0.f, 0.f, 0.f};
#pragma unroll
            for (int ks = 0; ks < 4; ++ks) qq = MFMA16(aq[ks], aq[ks], qq);
#pragma unroll
            for (int nt = 0; nt < 4; ++nt) {
                kk[nt] = (f32x4){0.f, 0.f, 0.f, 0.f}; qk[nt] = (f32x4){0.f, 0.f, 0.f, 0.f};
#pragma unroll
                for (int ks = 0; ks < 4; ++ks) { const bf16x8 bk = *(const bf16x8*)(kb + (16 * nt + fr) * 272 + ks * 64 + fq * 16);
                    kk[nt] = MFMA16(ak[ks], bk, kk[nt]); qk[nt] = MFMA16(aq[ks], bk, qk[nt]); }
            }
#pragma unroll
            for (int i = 0; i < 4; ++i) if (fr == 4 * fq + i) {
                float dk = 0.f;
#pragma unroll
                for (int nt = 0; nt < 4; ++nt) if (nt == hw) dk = kk[nt][i];
                RK[16 * hw + fr] = rsqrtf(dk + EPS); RQ[16 * hw + fr] = rsqrtf(qq[i] + EPS);
            }
        }
        __syncthreads();
        {
            bf16* QKr = (bf16*)(rec + R_QK);
#pragma unroll
            for (int i = 0; i < 4; ++i) {
                const int row = 16 * hw + 4 * fq + i;
                const float gr = Gs[row], br = Bs[row], rk = RK[row], rq = RQ[row];
#pragma unroll
                for (int nt = 0; nt < 4; ++nt) {
                    const int col = 16 * nt + fr;
                    const float d = col <= row ? gr - Gs[col] : 0.f;
                    const float e = __expf(d), rkc = RK[col];
                    Am[row * 64 + col] = col < row ? br * kk[nt][i] * rk * rkc * e : 0.f;
                    QKr[row * 64 + kperm(col)] = f2b(col <= row ? qk[nt][i] * rq * rkc * QSCALE * e : 0.f);
                }
            }
        }
        __syncthreads();
        if (t8 < 128) {
            bf16* Qg = (bf16*)(rec + R_QG) + kperm(t8);
#pragma unroll
            for (int r = 0; r < 64; ++r) Qg[r * 128] = f2b(va[r] * RQ[r] * QSCALE * EG[r]);
            {
                const int col = 1024 + h * 128 + t8;
                float h0 = 0.f, h1 = 0.f, h2 = 0.f;
                if (sample) { const float* cc = a.in[2] + (size_t)bidx * 3 * 1536 + col; h0 = cc[0]; h1 = cc[1536]; h2 = cc[2 * 1536]; }
                else if (!first) { const bf16* pp = P + (size_t)(row0 - 3) * PW + col; h0 = b2f(pp[0]); h1 = b2f(pp[PW]); h2 = b2f(pp[2 * PW]); }
                float* outp = lastc ? a.out + (sample ? O_SDC : O_PDC) + (size_t)bidx * 3 * 1536 + col : nullptr;
                conv_col(P + (size_t)row0 * PW + col, h0, h1, h2, cwt + col, nrows, outp, va);
            }
#pragma unroll
            for (int r = 0; r < 64; ++r) va[r] = va[r] * Bs[r];
        } else {
            const int c = t8 - 128;
            const float gl = Gs[63];
            unsigned w[32];
#pragma unroll
            for (int r = 0; r < 64; r += 2) w[kperm(r) >> 1] = pk2(va[r] * RK[r] * __expf(gl - Gs[r]), va[r + 1] * RK[r + 1] * __expf(gl - Gs[r + 1]));
            u32x4* dst = (u32x4*)(rec + R_KDT + c * 128);
#pragma unroll
            for (int j = 0; j < 8; ++j) dst[j] = (u32x4){w[4 * j], w[4 * j + 1], w[4 * j + 2], w[4 * j + 3]};
#pragma unroll
            for (int r = 0; r < 64; ++r) va[r] = va[r] * RK[r] * Bs[r] * EG[r];
        }
#if SOLVE_RL
        {
            float arow[64];
#pragma unroll
            for (int i = 1; i < 64; ++i) arow[i] = Am[i * 64 + lane];
#pragma unroll
            for (int i = 1; i < 64; ++i) {
                if (i < nrows) {
                    float acc0 = va[i], acc1 = 0.f;
#pragma unroll
                    for (int j = 0; j < i; ++j) { const float aij = __int_as_float(__builtin_amdgcn_readlane(__float_as_int(arow[i]), j)); if (j & 1) acc1 -= aij * va[j]; else acc0 -= aij * va[j]; }
                    va[i] = acc0 + acc1;
                }
            }
        }
#else
#pragma unroll
        for (int i = 1; i < 64; ++i) {
            float acc = va[i];
            const f32x4* Ar = (const f32x4*)(Am + i * 64);
#pragma unroll
            for (int j4 = 0; j4 < (i + 3) / 4; ++j4) {
                const f32x4 av = Ar[j4];
#pragma unroll
                for (int e = 0; e < 4; ++e) if (4 * j4 + e < i) acc -= av[e] * va[4 * j4 + e];
            }
            va[i] = acc;
        }
#endif
        if (t8 < 128) { bf16* U0 = (bf16*)(rec + R_U0) + t8;
#pragma unroll
            for (int r = 0; r < 64; ++r) U0[r * 128] = f2b(va[r]);
        } else { bf16* Wn = (bf16*)(rec + R_WN) + kperm(t8 - 128);
#pragma unroll
            for (int r = 0; r < 64; ++r) Wn[r * 128] = f2b(-va[r]);
        }
        __syncthreads();
    }
}

struct S5W { float lr[4], li[4]; bf16x8 bf[8]; };
DI void s5w_setup(const Args& a, int g, int fr, int fq, S5W& w) {
    const float dt = __expf(a.in[15][g]);
#pragma unroll
    for (int j = 0; j < 4; ++j) {
        const int p = 16 * j + fr;
        const float are = a.in[13][g * 64 + p], aim = a.in[14][g * 64 + p];
        const float mag = __expf(are * dt), ang = aim * dt;
        float sn, cs; sincosf(ang, &sn, &cs);
        const float lr = mag * cs, li = mag * sn;
        w.lr[j] = lr; w.li[j] = li;
        const float den = are * are + aim * aim;
        const float fre = ((lr - 1.f) * are + li * aim) / den, fim = (li * are - (lr - 1.f) * aim) / den;
        u32x4 wr = (u32x4){0u, 0u, 0u, 0u}, wi = (u32x4){0u, 0u, 0u, 0u};
        if (fq < 2) {
            const f32x4* br = (const f32x4*)(a.in[16] + (size_t)(g * 64 + p) * 16 + 8 * fq); const f32x4* bi = (const f32x4*)(a.in[17] + (size_t)(g * 64 + p) * 16 + 8 * fq);
            const f32x4 r0 = br[0], r1 = br[1], i0 = bi[0], i1 = bi[1];
            wr.x = pk2(fre * r0[0] - fim * i0[0], fre * r0[1] - fim * i0[1]); wr.y = pk2(fre * r0[2] - fim * i0[2], fre * r0[3] - fim * i0[3]);
            wr.z = pk2(fre * r1[0] - fim * i1[0], fre * r1[1] - fim * i1[1]); wr.w = pk2(fre * r1[2] - fim * i1[2], fre * r1[3] - fim * i1[3]);
            wi.x = pk2(fre * i0[0] + fim * r0[0], fre * i0[1] + fim * r0[1]); wi.y = pk2(fre * i0[2] + fim * r0[2], fre * i0[3] + fim * r0[3]);
            wi.z = pk2(fre * i1[0] + fim * r1[0], fre * i1[1] + fim * r1[1]); wi.w = pk2(fre * i1[2] + fim * r1[2], fre * i1[3] + fim * r1[3]);
        }
        w.bf[j] = __builtin_bit_cast(bf16x8, wr); w.bf[4 + j] = __builtin_bit_cast(bf16x8, wi);
    }
}
DI bf16x8 s5w_uload(const bf16* P, size_t row0, int SS, int ms, int g, int fr, int fq) {
    u32x4 v = (u32x4){0u, 0u, 0u, 0u};
    if (fq < 2) v = *(const u32x4*)(P + (row0 + (size_t)(fr >> 2) * SS + 4 * ms + (fr & 3)) * PW + 2048 + g * 16 + 8 * fq);
    return __builtin_bit_cast(bf16x8, v);
}
DI void s5w_step(const S5W& w, bf16x8 ua, float (&xr)[4], float (&xi)[4], unsigned (&xo)[4][4]) {
    f32x4 br[4], bi[4];
    const f32x4 z = (f32x4){0.f, 0.f, 0.f, 0.f};
#pragma unroll
    for (int j = 0; j < 4; ++j) { br[j] = MFMA16(ua, w.bf[j], z); bi[j] = MFMA16(ua, w.bf[4 + j], z); }
#pragma unroll
    for (int i = 0; i < 4; ++i)
#pragma unroll
        for (int j = 0; j < 4; ++j) {
            const float nr = w.lr[j] * xr[j] - w.li[j] * xi[j] + br[j][i], ni = w.lr[j] * xi[j] + w.li[j] * xr[j] + bi[j][i];
            xr[j] = nr; xi[j] = ni; xo[i][j] = pk2(nr, ni);
        }
#pragma unroll
    for (int j = 0; j < 8; ++j) asm volatile("" :: "v"(w.bf[j]));
    asm volatile("" :: "v"(ua));
}
DI void s5_pass1(const Args& a, int gw, int NGW, int lane) {
    asm volatile("" : "+v"(lane));
    const bf16* P = (const bf16*)(a.ws + WS_P);
    float* E = (float*)(a.ws + WS_S5E);
    const int fr = lane & 15, fq = lane >> 4;
    for (int unit = gw; unit < 4 * 32 * 16; unit += NGW) {
        const int sg = unit & 15, bg = unit >> 4, g = bg & 31, b = bg >> 5;
        S5W w; s5w_setup(a, g, fr, fq, w);
        float xr[4] = {0.f, 0.f, 0.f, 0.f}, xi[4] = {0.f, 0.f, 0.f, 0.f}; unsigned xo[4][4];
        const size_t row0 = (size_t)b * 8192 + sg * 512;
        bf16x8 ua = s5w_uload(P, row0, 128, 0, g, fr, fq);
        for (int ms = 0; ms < 32; ++ms) {
            const bf16x8 un = s5w_uload(P, row0, 128, ms + 1 < 32 ? ms + 1 : ms, g, fr, fq);
            s5w_step(w, ua, xr, xi, xo); ua = un;
        }
        float* e = E + ((size_t)bg * 64 + 4 * sg + fq) * 128;
#pragma unroll
        for (int j = 0; j < 4; ++j) { e[16 * j + fr] = xr[j]; e[64 + 16 * j + fr] = xi[j]; }
    }
}
DI void s5w_run(const Args& a, const S5W& w, const bf16x8 (&cf)[4], float Dg, unsigned char* xs, size_t row0, int SS, int nms, int g, int fr, int fq, float (&xr)[4], float (&xi)[4]) {
    const bf16* P = (const bf16*)(a.ws + WS_P);
    bf16* Y5 = (bf16*)(a.ws + WS_Y5);
    bf16x8 ua = s5w_uload(P, row0, SS, 0, g, fr, fq);
    for (int ms = 0; ms < nms; ++ms) {
        const bf16x8 un = s5w_uload(P, row0, SS, ms + 1 < nms ? ms + 1 : ms, g, fr, fq);
        float uu[4];
#pragma unroll
        for (int i = 0; i < 4; ++i) uu[i] = b2f(P[(row0 + (size_t)fq * SS + 4 * ms + i) * PW + 2048 + g * 16 + fr]);
        unsigned xo[4][4];
        s5w_step(w, ua, xr, xi, xo); ua = un;
#pragma unroll
        for (int i = 0; i < 4; ++i)
#pragma unroll
            for (int j = 0; j < 4; ++j) *(unsigned*)(xs + (4 * fq + i) * 272 + (16 * j + fr) * 4) = xo[i][j];
        asm volatile("s_waitcnt lgkmcnt(0)" ::: "memory");
        f32x4 y = (f32x4){0.f, 0.f, 0.f, 0.f};
        bf16x8 af[4];
#pragma unroll
        for (int ks = 0; ks < 4; ++ks) af[ks] = *(const bf16x8*)(xs + fr * 272 + ks * 64 + fq * 16);
        asm volatile("" ::: "memory");
#pragma unroll
        for (int ks = 0; ks < 4; ++ks) y = MFMA16(af[ks], cf[ks], y);
#if DIAG_Y
        {
            const float* cre = a.in[18] + (size_t)(g * 16 + fr) * 64; const float* cim = a.in[19] + (size_t)(g * 16 + fr) * 64;
#pragma unroll
            for (int i = 0; i < 4; ++i) { float acc = 0.f;
                for (int p = 0; p < 64; ++p) { const unsigned wv = *(const unsigned*)(xs + (4 * fq + i) * 272 + p * 4); acc += cre[p] * blo(wv) - cim[p] * bhi(wv); }
                y[i] = acc; }
        }
#endif
        asm volatile("" :: "v"(y));
#pragma unroll
        for (int ks = 0; ks < 4; ++ks) asm volatile("" :: "v"(af[ks]), "v"(cf[ks]));
#pragma unroll
        for (int i = 0; i < 4; ++i) {
            const size_t row = row0 + (size_t)fq * SS + 4 * ms + i;
            Y5[row * 512 + g * 16 + fr] = f2b(gelu_tanh(y[i] + Dg * uu[i]));
        }
    }
}
DI void s5_cfrag(const Args& a, int g, int fr, int fq, bf16x8 (&cf)[4]) {
#pragma unroll
    for (int ks = 0; ks < 4; ++ks) {
        const f32x4 cr = *(const f32x4*)(a.in[18] + (size_t)(g * 16 + fr) * 64 + 16 * ks + 4 * fq), ci = *(const f32x4*)(a.in[19] + (size_t)(g * 16 + fr) * 64 + 16 * ks + 4 * fq);
        u32x4 w; w.x = pk2(cr[0], -ci[0]); w.y = pk2(cr[1], -ci[1]); w.z = pk2(cr[2], -ci[2]); w.w = pk2(cr[3], -ci[3]);
        cf[ks] = __builtin_bit_cast(bf16x8, w);
    }
}
DI void s5_pass2_prompt(const Args& a, unsigned char* lds, int bg, int tid) {
    asm volatile("" : "+v"(tid));
    const int wave = __builtin_amdgcn_readfirstlane(tid >> 6), lane = tid & 63, fr = lane & 15, fq = lane >> 4;
    const int b = bg >> 5, g4 = (bg >> 2) & 7, part = bg & 3, g = 4 * g4 + (wave & 3);
    bg = b * 32 + g;
    unsigned char* xs = lds + wave * 4352;
    S5W w; s5w_setup(a, g, fr, fq, w);
    bf16x8 cf[4]; s5_cfrag(a, g, fr, fq, cf);
    const float Dg = a.in[20][g * 16 + fr];
    float pr[4], pi[4];
#pragma unroll
    for (int j = 0; j < 4; ++j) { pr[j] = w.lr[j]; pi[j] = w.li[j];
#pragma unroll
        for (int s = 0; s < 7; ++s) { const float nr = pr[j] * pr[j] - pi[j] * pi[j], ni = 2.f * pr[j] * pi[j]; pr[j] = nr; pi[j] = ni; } }
    const float* e = (const float*)(a.ws + WS_S5E) + (size_t)bg * 64 * 128;
    for (int uu = 0; uu < 2; ++uu) {
        const int sg = 4 * part + 2 * (wave >> 2) + uu, seg = 4 * sg + fq;
        float xr[4] = {0.f, 0.f, 0.f, 0.f}, xi[4] = {0.f, 0.f, 0.f, 0.f};
        for (int s = 0; s < 4 * sg + 3; ++s) {
            if (s < seg) {
#pragma unroll
                for (int j = 0; j < 4; ++j) { const float er = e[s * 128 + 16 * j + fr], ei = e[s * 128 + 64 + 16 * j + fr];
                    const float nr = pr[j] * xr[j] - pi[j] * xi[j] + er, ni = pr[j] * xi[j] + pi[j] * xr[j] + ei; xr[j] = nr; xi[j] = ni; }
            }
        }
        s5w_run(a, w, cf, Dg, xs, (size_t)b * 8192 + sg * 512, 128, 32, g, fr, fq, xr, xi);
        if (seg == 63) {
#pragma unroll
            for (int j = 0; j < 4; ++j) { a.out[O_PSR + (size_t)bg * 64 + 16 * j + fr] = xr[j]; a.out[O_PSI + (size_t)bg * 64 + 16 * j + fr] = xi[j]; }
        }
    }
}
DI void s5_pass2_sample(const Args& a, unsigned char* xs, int gw, int NGW, int lane) {
    asm volatile("" : "+v"(lane));
    const int fr = lane & 15, fq = lane >> 4;
    for (int unit = gw; unit < 256; unit += NGW) {
        const int g = unit & 31, q = unit >> 5, sb = 4 * q + fq;
        S5W w; s5w_setup(a, g, fr, fq, w);
        bf16x8 cf[4]; s5_cfrag(a, g, fr, fq, cf);
        const float Dg = a.in[20][g * 16 + fr];
        float xr[4], xi[4];
#pragma unroll
        for (int j = 0; j < 4; ++j) { xr[j] = a.in[4][(size_t)(sb * 32 + g) * 64 + 16 * j + fr]; xi[j] = a.in[5][(size_t)(sb * 32 + g) * 64 + 16 * j + fr]; }
        s5w_run(a, w, cf, Dg, xs, (size_t)TP + (size_t)q * 64, 16, 4, g, fr, fq, xr, xi);
#pragma unroll
        for (int j = 0; j < 4; ++j) { a.out[O_SSR + (size_t)(sb * 32 + g) * 64 + 16 * j + fr] = xr[j]; a.out[O_SSI + (size_t)(sb * 32 + g) * 64 + 16 * j + fr] = xi[j]; }
    }
}

struct S5Par { float lr, li; float bbr[16], bbi[16]; };
DI void s5_setup(const Args& a, int g, int p, S5Par& q) {
    const float are = a.in[13][g * 64 + p], aim = a.in[14][g * 64 + p], dt = __expf(a.in[15][g]);
    const float mag = __expf(are * dt), ang = aim * dt;
    float sn, cs; sincosf(ang, &sn, &cs);
    q.lr = mag * cs; q.li = mag * sn;
    const float den = are * are + aim * aim;
    const float fre = ((q.lr - 1.f) * are + q.li * aim) / den, fim = (q.li * are - (q.lr - 1.f) * aim) / den;
    const f32x4* br = (const f32x4*)(a.in[16] + (size_t)(g * 64 + p) * 16); const f32x4* bi = (const f32x4*)(a.in[17] + (size_t)(g * 64 + p) * 16);
#pragma unroll
    for (int j = 0; j < 4; ++j) { const f32x4 r = br[j], i = bi[j];
#pragma unroll
        for (int e = 0; e < 4; ++e) { q.bbr[4 * j + e] = fre * r[e] - fim * i[e]; q.bbi[4 * j + e] = fre * i[e] + fim * r[e]; } }
}
DI void s5_step4(const S5Par& q, float uv, float& xr, float& xi, unsigned (&xo)[4]) {
#pragma unroll
    for (int j = 0; j < 4; ++j) {
        float br = 0.f, bi = 0.f;
#pragma unroll
        for (int h = 0; h < 16; ++h) { const float uh = __int_as_float(__builtin_amdgcn_readlane(__float_as_int(uv), 16 * j + h)); br += q.bbr[h] * uh; bi += q.bbi[h] * uh; }
        const float nr = q.lr * xr - q.li * xi + br, ni = q.lr * xi + q.li * xr + bi;
        xr = nr; xi = ni; xo[j] = pk2(xr, xi);
    }
}
DI void old_s5_pass1(const Args& a, int gw, int NGW, int lane) {
    asm volatile("" : "+v"(lane));
    const bf16* P = (const bf16*)(a.ws + WS_P);
    float* E = (float*)(a.ws + WS_S5E);
    for (int unit = gw; unit < 4 * 32 * 64; unit += NGW) {
        const int seg = unit & 63, bg = unit >> 6, g = bg & 31, b = bg >> 5;
        S5Par q; s5_setup(a, g, lane, q);
        float xr = 0.f, xi = 0.f; unsigned xo[4];
        const bf16* up = P + (size_t)(b * 8192 + seg * 128 + (lane >> 4)) * PW + 2048 + g * 16 + (lane & 15);
#pragma unroll 2
        for (int t = 0; t < 128; t += 4) { const float uv = b2f(up[(size_t)t * PW]); s5_step4(q, uv, xr, xi, xo); }
        float* e = E + ((size_t)bg * 64 + seg) * 128;
        e[lane] = xr; e[64 + lane] = xi;
    }
}
DI void old_s5_pass2(const Args& a, unsigned char* xs  , int gw, int NGW, int lane) {
    asm volatile("" : "+v"(lane));
    const bf16* P = (const bf16*)(a.ws + WS_P);
    const float* E = (const float*)(a.ws + WS_S5E);
    bf16* Y5 = (bf16*)(a.ws + WS_Y5);
    const int fr = lane & 15, fq = lane >> 4;
    for (int unit = gw; unit < OLD_S5_ULIM; unit += NGW) {
        int g, row0, ntok, seg = 0, bg; bool sample;
        if (unit < 8192) { seg = unit & 63; bg = unit >> 6; g = bg & 31; row0 = (bg >> 5) * 8192 + seg * 128; ntok = 128; sample = false; }
        else { bg = unit - 8192; g = bg & 31; row0 = TP + (bg >> 5) * 16; ntok = 16; sample = true; }
        S5Par q; s5_setup(a, g, lane, q);
        float xr = 0.f, xi = 0.f;
        if (sample) { xr = a.in[4][(size_t)bg * 64 + lane]; xi = a.in[5][(size_t)bg * 64 + lane]; }
        else {
            float pr = q.lr, pi = q.li;
#pragma unroll
            for (int s = 0; s < 7; ++s) { const float nr = pr * pr - pi * pi, ni = 2.f * pr * pi; pr = nr; pi = ni; }
            const float* e = E + (size_t)bg * 64 * 128;
            for (int s = 0; s < seg; ++s) { const float er = e[s * 128 + lane], ei = e[s * 128 + 64 + lane]; const float nr = pr * xr - pi * xi + er, ni = pr * xi + pi * xr + ei; xr = nr; xi = ni; }
        }
        bf16x8 cf[4];
#pragma unroll
        for (int ks = 0; ks < 4; ++ks) {
            const f32x4 cr = *(const f32x4*)(a.in[18] + (size_t)(g * 16 + fr) * 64 + 16 * ks + 4 * fq), ci = *(const f32x4*)(a.in[19] + (size_t)(g * 16 + fr) * 64 + 16 * ks + 4 * fq);
            u32x4 w; w.x = pk2(cr[0], -ci[0]); w.y = pk2(cr[1], -ci[1]); w.z = pk2(cr[2], -ci[2]); w.w = pk2(cr[3], -ci[3]);
            cf[ks] = __builtin_bit_cast(bf16x8, w);
        }
        const float Dg = a.in[20][g * 16 + fr];
        const bf16* up = P + (size_t)(row0 + (lane >> 4)) * PW + 2048 + g * 16 + (lane & 15);
        for (int tb = 0; tb < ntok; tb += 16) {
#pragma unroll
            for (int j4 = 0; j4 < 4; ++j4) {
                const float uv = b2f(up[(size_t)(tb + 4 * j4) * PW]);
                unsigned xo[4]; s5_step4(q, uv, xr, xi, xo);
#pragma unroll
                for (int j = 0; j < 4; ++j) *(unsigned*)(xs + (4 * j4 + j) * 272 + lane * 4) = xo[j];
            }
            f32x4 y = (f32x4){0.f, 0.f, 0.f, 0.f};
#pragma unroll
            for (int ks = 0; ks < 4; ++ks) { const bf16x8 af = *(const bf16x8*)(xs + fr * 272 + ks * 64 + fq * 16); y = MFMA16(af, cf[ks], y); }
#pragma unroll
            for (int i = 0; i < 4; ++i) {
                const size_t row = (size_t)row0 + tb + 4 * fq + i;
                const float uu = b2f(P[row * PW + 2048 + g * 16 + fr]);
                Y5[row * 512 + g * 16 + fr] = f2b(gelu_tanh(y[i] + Dg * uu));
            }
        }
        if (sample) { a.out[O_SSR + (size_t)bg * 64 + lane] = xr; a.out[O_SSI + (size_t)bg * 64 + lane] = xi; }
        else if (seg == 63) { a.out[O_PSR + (size_t)bg * 64 + lane] = xr; a.out[O_PSI + (size_t)bg * 64 + lane] = xi; }
    }
}

DI void s5_pass2b(const Args& a, unsigned char* xs, int gw, int NGW, int lane) {
    asm volatile("" : "+v"(lane));
    const bf16* P = (const bf16*)(a.ws + WS_P);
    const float* E = (const float*)(a.ws + WS_S5E);
    bf16* Y5 = (bf16*)(a.ws + WS_Y5);
    const int fr = lane & 15, fq = lane >> 4;
    for (int unit = gw; unit < 4 * 32 * 64 + 32 * 32; unit += NGW) {
        int g, row0, ntok, seg = 0, bg; bool sample;
        if (unit < 8192) { seg = unit & 63; bg = unit >> 6; g = bg & 31; row0 = (bg >> 5) * 8192 + seg * 128; ntok = 128; sample = false; }
        else { bg = unit - 8192; g = bg & 31; row0 = TP + (bg >> 5) * 16; ntok = 16; sample = true; }
        S5Par q; s5_setup(a, g, lane, q);
        float xr = 0.f, xi = 0.f;
        if (sample) { xr = a.in[4][(size_t)bg * 64 + lane]; xi = a.in[5][(size_t)bg * 64 + lane]; }
        else {
            float pr = q.lr, pi = q.li;
#pragma unroll
            for (int s = 0; s < 7; ++s) { const float nr = pr * pr - pi * pi, ni = 2.f * pr * pi; pr = nr; pi = ni; }
            const float* e = E + (size_t)bg * 64 * 128;
            for (int s = 0; s < seg; ++s) { const float er = e[s * 128 + lane], ei = e[s * 128 + 64 + lane]; const float nr = pr * xr - pi * xi + er, ni = pr * xi + pi * xr + ei; xr = nr; xi = ni; }
        }
        bf16x8 cf[4];
#pragma unroll
        for (int ks = 0; ks < 4; ++ks) {
            const f32x4 cr = *(const f32x4*)(a.in[18] + (size_t)(g * 16 + fr) * 64 + 16 * ks + 4 * fq), ci = *(const f32x4*)(a.in[19] + (size_t)(g * 16 + fr) * 64 + 16 * ks + 4 * fq);
            u32x4 w; w.x = pk2(cr[0], -ci[0]); w.y = pk2(cr[1], -ci[1]); w.z = pk2(cr[2], -ci[2]); w.w = pk2(cr[3], -ci[3]);
            cf[ks] = __builtin_bit_cast(bf16x8, w);
        }
        const float Dg = a.in[20][g * 16 + fr];
        S5W w; s5w_setup(a, g, fr, fq, w);
        unsigned char* bt = xs + 4352;
        for (int tb = 0; tb < ntok; tb += 16) {
            {
                u32x4 uv = (u32x4){0u, 0u, 0u, 0u};
                if (fq < 2) uv = *(const u32x4*)(P + (size_t)(row0 + tb + fr) * PW + 2048 + g * 16 + 8 * fq);
                const bf16x8 ua = __builtin_bit_cast(bf16x8, uv);
                const f32x4 z = (f32x4){0.f, 0.f, 0.f, 0.f};
#pragma unroll
                for (int j = 0; j < 4; ++j) {
                    const f32x4 br = MFMA16(ua, w.bf[j], z), bi = MFMA16(ua, w.bf[4 + j], z);
                    *(f32x4*)(bt + (16 * j + fr) * 80 + fq * 16) = br; *(f32x4*)(bt + (64 + 16 * j + fr) * 80 + fq * 16) = bi;
                }
            }
            asm volatile("s_waitcnt lgkmcnt(0)" ::: "memory");
            f32x4 bre[4], bim[4];
#pragma unroll
            for (int k = 0; k < 4; ++k) { bre[k] = *(const f32x4*)(bt + lane * 80 + k * 16); bim[k] = *(const f32x4*)(bt + (64 + lane) * 80 + k * 16); }
            asm volatile("s_waitcnt lgkmcnt(0)" ::: "memory");
#pragma unroll
            for (int t = 0; t < 16; ++t) {
                const float nr = q.lr * xr - q.li * xi + bre[t >> 2][t & 3], ni = q.lr * xi + q.li * xr + bim[t >> 2][t & 3];
                xr = nr; xi = ni;
                *(unsigned*)(xs + t * 272 + lane * 4) = pk2(nr, ni);
            }
            asm volatile("s_waitcnt lgkmcnt(0)" ::: "memory");
            f32x4 y = (f32x4){0.f, 0.f, 0.f, 0.f};
#pragma unroll
            for (int ks = 0; ks < 4; ++ks) { const bf16x8 af = *(const bf16x8*)(xs + fr * 272 + ks * 64 + fq * 16); y = MFMA16(af, cf[ks], y); }
#pragma unroll
            for (int i = 0; i < 4; ++i) {
                const size_t row = (size_t)row0 + tb + 4 * fq + i;
                const float uu = b2f(P[row * PW + 2048 + g * 16 + fr]);
                Y5[row * 512 + g * 16 + fr] = f2b(gelu_tanh(y[i] + Dg * uu));
            }
        }
        if (sample) { a.out[O_SSR + (size_t)bg * 64 + lane] = xr; a.out[O_SSI + (size_t)bg * 64 + lane] = xi; }
        else if (seg == 63) { a.out[O_PSR + (size_t)bg * 64 + lane] = xr; a.out[O_PSI + (size_t)bg * 64 + lane] = xi; }
    }
}

constexpr int DB_WN = 0, DB_QG = 17408, DB_KDT = 34816, DB_QK = 53248, DB_U0 = 62464;
constexpr int DBP_SIZE = DB_U0 + 64 * 80;
constexpr int DBS_SIZE = DB_U0 + 64 * 272;
template <int NC> struct DnRegs { u32x4 r[7]; u32x4 u[NC == 32 ? 1 : 2]; };
template <int NC> DI void dn_load(const unsigned char* rec, int tid, int c0, DnRegs<NC>& R) {
    const u32x4* g = (const u32x4*)rec;
    R.r[0] = g[tid]; R.r[1] = g[tid + 512]; R.r[2] = g[1024 + tid]; R.r[3] = g[1024 + tid + 512]; R.r[4] = g[2048 + tid]; R.r[5] = g[2048 + tid + 512]; R.r[6] = g[3072 + tid];
    if (NC == 32) { if (tid < 256) R.u[0] = *(const u32x4*)(rec + R_U0 + (tid >> 2) * 256 + c0 * 2 + (tid & 3) * 16); }
    else { R.u[0] = *(const u32x4*)(rec + R_U0 + tid * 16); R.u[1] = *(const u32x4*)(rec + R_U0 + (tid + 512) * 16); }
}
template <int NC> DI void dn_store(unsigned char* buf, int tid, const DnRegs<NC>& R) {
#pragma unroll
    for (int j = 0; j < 2; ++j) { const int q = tid + 512 * j;
        *(u32x4*)(buf + DB_WN + (q >> 4) * 272 + (q & 15) * 16) = R.r[j];
        *(u32x4*)(buf + DB_QG + (q >> 4) * 272 + (q & 15) * 16) = R.r[2 + j];
        *(u32x4*)(buf + DB_KDT + (q >> 3) * 144 + (q & 7) * 16) = R.r[4 + j]; }
    *(u32x4*)(buf + DB_QK + (tid >> 3) * 144 + (tid & 7) * 16) = R.r[6];
    if (NC == 32) { if (tid < 256) *(u32x4*)(buf + DB_U0 + (tid >> 2) * 80 + (tid & 3) * 16) = R.u[0]; }
    else {
#pragma unroll
        for (int j = 0; j < 2; ++j) { const int q = tid + 512 * j; *(u32x4*)(buf + DB_U0 + (q >> 4) * 272 + (q & 15) * 16) = R.u[j]; }
    }
}
DI bf16x8 pack8(const f32x4& lo, const f32x4& hi) { u32x4 w; w.x = pk2(lo[0], lo[1]); w.y = pk2(lo[2], lo[3]); w.z = pk2(hi[0], hi[1]); w.w = pk2(hi[2], hi[3]); return __builtin_bit_cast(bf16x8, w); }
template <int UPI> DI void dn_step(const unsigned char* buf, f32x4 (&S)[8], const unsigned char* u0, float eg, int fr, int fq, f32x4 (&o)[4]) {
    bf16x8 Sb[4];
#pragma unroll
    for (int ks = 0; ks < 4; ++ks) Sb[ks] = pack8(S[2 * ks], S[2 * ks + 1]);
    f32x4 u[4];
#pragma unroll
    for (int mt = 0; mt < 4; ++mt) {
#pragma unroll
        for (int i = 0; i < 4; ++i) u[mt][i] = b2f(*(const bf16*)(u0 + (16 * mt + 4 * fq + i) * UPI));
#pragma unroll
        for (int ks = 0; ks < 4; ++ks) u[mt] = MFMA16(*(const bf16x8*)(buf + DB_WN + (16 * mt + fr) * 272 + ks * 64 + fq * 16), Sb[ks], u[mt]);
    }
    bf16x8 ub[2];
#pragma unroll
    for (int k2 = 0; k2 < 2; ++k2) ub[k2] = pack8(u[2 * k2], u[2 * k2 + 1]);
#pragma unroll
    for (int mt = 0; mt < 4; ++mt) {
        o[mt] = (f32x4){0.f, 0.f, 0.f, 0.f};
#pragma unroll
        for (int ks = 0; ks < 4; ++ks) o[mt] = MFMA16(*(const bf16x8*)(buf + DB_QG + (16 * mt + fr) * 272 + ks * 64 + fq * 16), Sb[ks], o[mt]);
#pragma unroll
        for (int k2 = 0; k2 < 2; ++k2) o[mt] = MFMA16(*(const bf16x8*)(buf + DB_QK + (16 * mt + fr) * 144 + k2 * 64 + fq * 16), ub[k2], o[mt]);
    }
#pragma unroll
    for (int m8 = 0; m8 < 8; ++m8) {
        S[m8] = S[m8] * eg;
#pragma unroll
        for (int k2 = 0; k2 < 2; ++k2) S[m8] = MFMA16(*(const bf16x8*)(buf + DB_KDT + (16 * m8 + fr) * 144 + k2 * 64 + fq * 16), ub[k2], S[m8]);
    }
}
#if DN_STAGED == 2
#define DNP_SYNC() do { asm volatile("s_waitcnt lgkmcnt(0)" ::: "memory"); __builtin_amdgcn_sched_barrier(0); } while (0)
#else
#define DNP_SYNC() do { } while (0)
#endif
DI void dn_step_p(const unsigned char* buf, f32x4 (&S)[8], const unsigned char* u0, float eg, int fr, int fq, f32x4 (&o)[4]) {
    const unsigned char* aw = buf + DB_WN + fr * 272 + fq * 16;
    const unsigned char* aq = buf + DB_QG + fr * 272 + fq * 16;
    const unsigned char* ak = buf + DB_KDT + fr * 144 + fq * 16;
    const unsigned char* ac = buf + DB_QK + fr * 144 + fq * 16;
    bf16x8 f1[16], f2[16], Sb[4], ub[2];
    f32x4 u[4];
#pragma unroll
    for (int mt = 0; mt < 4; ++mt)
#pragma unroll
        for (int ks = 0; ks < 4; ++ks) f1[4 * mt + ks] = *(const bf16x8*)(aw + mt * 4352 + ks * 64);
#pragma unroll
    for (int mt = 0; mt < 4; ++mt)
#pragma unroll
        for (int i = 0; i < 4; ++i) u[mt][i] = b2f(*(const bf16*)(u0 + (16 * mt + 4 * fq + i) * 80));
#pragma unroll
    for (int ks = 0; ks < 4; ++ks) Sb[ks] = pack8(S[2 * ks], S[2 * ks + 1]);
    __builtin_amdgcn_sched_barrier(0);
#pragma unroll
    for (int mt = 0; mt < 4; ++mt)
#pragma unroll
        for (int ks = 0; ks < 4; ++ks) f2[4 * mt + ks] = *(const bf16x8*)(aq + mt * 4352 + ks * 64);
    DNP_SYNC();
#pragma unroll
    for (int ks = 0; ks < 4; ++ks)
#pragma unroll
        for (int mt = 0; mt < 4; ++mt) u[mt] = MFMA16(f1[4 * mt + ks], Sb[ks], u[mt]);
    __builtin_amdgcn_sched_barrier(0);
#pragma unroll
    for (int k2 = 0; k2 < 2; ++k2) ub[k2] = pack8(u[2 * k2], u[2 * k2 + 1]);
#pragma unroll
    for (int m8 = 0; m8 < 8; ++m8)
#pragma unroll
        for (int k2 = 0; k2 < 2; ++k2) f1[2 * m8 + k2] = *(const bf16x8*)(ak + m8 * 2304 + k2 * 64);
    DNP_SYNC();
#pragma unroll
    for (int mt = 0; mt < 4; ++mt) o[mt] = (f32x4){0.f, 0.f, 0.f, 0.f};
#pragma unroll
    for (int ks = 0; ks < 4; ++ks)
#pragma unroll
        for (int mt = 0; mt < 4; ++mt) o[mt] = MFMA16(f2[4 * mt + ks], Sb[ks], o[mt]);
    __builtin_amdgcn_sched_barrier(0);
#pragma unroll
    for (int mt = 0; mt < 4; ++mt)
#pragma unroll
        for (int k2 = 0; k2 < 2; ++k2) f2[2 * mt + k2] = *(const bf16x8*)(ac + mt * 2304 + k2 * 64);
    DNP_SYNC();
#pragma unroll
    for (int m8 = 0; m8 < 8; ++m8) S[m8] = S[m8] * eg;
#pragma unroll
    for (int k2 = 0; k2 < 2; ++k2)
#pragma unroll
        for (int m8 = 0; m8 < 8; ++m8) S[m8] = MFMA16(f1[2 * m8 + k2], ub[k2], S[m8]);
    __builtin_amdgcn_sched_barrier(0);
#pragma unroll
    for (int k2 = 0; k2 < 2; ++k2)
#pragma unroll
        for (int mt = 0; mt < 4; ++mt) o[mt] = MFMA16(f2[2 * mt + k2], ub[k2], o[mt]);
}
DI void dn_piece(int q, int c0, unsigned& src, unsigned& dst) {
    if (q < 1024) { src = R_WN + q * 16; dst = DB_WN + (q >> 4) * 272 + (q & 15) * 16; }
    else if (q < 2048) { const int p = q - 1024; src = R_QG + p * 16; dst = DB_QG + (p >> 4) * 272 + (p & 15) * 16; }
    else if (q < 3072) { const int p = q - 2048; src = R_KDT + p * 16; dst = DB_KDT + (p >> 3) * 144 + (p & 7) * 16; }
    else if (q < 3584) { const int p = q - 3072; src = R_QK + p * 16; dst = DB_QK + (p >> 3) * 144 + (p & 7) * 16; }
    else { const int p = q - 3584; src = R_U0 + (p >> 2) * 256 + c0 * 2 + (p & 3) * 16; dst = DB_U0 + (p >> 2) * 80 + (p & 3) * 16; }
}
#define DN_LD(R, base) do { _Pragma("unroll") for (int k = 0; k < 10; ++k) { unsigned s_, d_; dn_piece(lt + 384 * k, c0, s_, d_); R[k] = *(const u32x4*)((base) + s_); } } while (0)
#define DN_WAIT(R, cnt) do { } while (0)
#define DN_ST(R, buf) do { _Pragma("unroll") for (int k = 0; k < 10; ++k) { unsigned s_, d_; dn_piece(lt + 384 * k, c0, s_, d_); *(u32x4*)((buf) + d_) = R[k]; } } while (0)
#define DN_BAR() do { asm volatile("s_waitcnt lgkmcnt(0)" ::: "memory"); __builtin_amdgcn_s_barrier(); asm volatile("" ::: "memory"); } while (0)
DI void dn_scan_prompt(const Args& a, unsigned char* lds, int tid) {
    asm volatile("" : "+v"(tid));
    const int wave = __builtin_amdgcn_readfirstlane(tid >> 6), lane = tid & 63, fr = lane & 15, fq = lane >> 4;
    const int bh = blockIdx.x >> 2, qt = blockIdx.x & 3, b = bh >> 2, h = bh & 3;
    const int c0 = qt * 32, v0 = c0 + (wave & 1) * 16;
    const unsigned char* recs = a.ws + WS_DNC + (size_t)bh * 128 * REC;
    const float* egs = (const float*)(a.ws + WS_EG) + bh * 128;
    float* ORAW = (float*)(a.ws + WS_H);
    const bool loader = wave >= 2;
    const int lt = tid - 128;
    f32x4 S[8];
#pragma unroll
    for (int m8 = 0; m8 < 8; ++m8) S[m8] = (f32x4){0.f, 0.f, 0.f, 0.f};
    float egA = egs[lane], egB = egs[64 + lane];
    asm volatile("s_waitcnt vmcnt(0)" : "+v"(egA), "+v"(egB) :: "memory");
    if (loader) {
        const int grp = wave >= 5 ? 1 : 0, lt2 = tid - 128 - grp * 192;
        u32x4 R[20];
#define DN_LD20(base) do { _Pragma("unroll") for (int k = 0; k < 20; ++k) { unsigned s_, d_; dn_piece(lt2 + 192 * k, c0, s_, d_); R[k] = *(const u32x4*)((base) + s_); } } while (0)
#define DN_ST20(buf) do { _Pragma("unroll") for (int k = 0; k < 20; ++k) { unsigned s_, d_; dn_piece(lt2 + 192 * k, c0, s_, d_); *(u32x4*)((buf) + d_) = R[k]; } } while (0)
        if (grp == 0) { DN_LD20(recs); DN_ST20(lds); DN_LD20(recs + 2 * (size_t)REC); }
        else { DN_LD20(recs + REC); }
        DN_BAR();
        for (int n = 0; n < 128; n += 2) {
            if (grp == 1) { DN_ST20(lds + DBP_SIZE); if (n + 3 < 128) DN_LD20(recs + (size_t)(n + 3) * REC); }
            DN_BAR();
            if (grp == 0 && n + 2 < 128) { DN_ST20(lds); if (n + 4 < 128) DN_LD20(recs + (size_t)(n + 4) * REC); }
            DN_BAR();
        }
#undef DN_LD20
#undef DN_ST20
    } else {
        DN_BAR();
        for (int n = 0; n < 128; ++n) {
            const float eg0 = __int_as_float(__builtin_amdgcn_readlane(__float_as_int(n < 64 ? egA : egB), n & 63));
            f32x4 o[4];
#if DN_STAGED
            dn_step_p(lds + (n & 1) * DBP_SIZE, S, lds + (n & 1) * DBP_SIZE + DB_U0 + ((wave & 1) * 16 + fr) * 2, eg0, fr, fq, o);
#else
            dn_step<80>(lds + (n & 1) * DBP_SIZE, S, lds + (n & 1) * DBP_SIZE + DB_U0 + ((wave & 1) * 16 + fr) * 2, eg0, fr, fq, o);
#endif
            float* op = ORAW + (size_t)(b * 8192 + n * 64) * 512 + h * 128 + v0 + fr;
#pragma unroll
            for (int mt = 0; mt < 4; ++mt)
#pragma unroll
                for (int i = 0; i < 4; ++i) op[(size_t)(16 * mt + 4 * fq + i) * 512] = o[mt][i];
            DN_BAR();
        }
    }
    if (!loader) {
        float* so = a.out + O_PDS + (size_t)bh * 128 * 128 + v0 + fr;
#pragma unroll
        for (int m8 = 0; m8 < 8; ++m8)
#pragma unroll
            for (int i = 0; i < 4; ++i) so[(16 * m8 + 4 * fq + i) * 128] = S[m8][i];
    }
    __syncthreads();
}
DI void dn_scan_sample(const Args& a, unsigned char* lds, int tid, int wg, int nwg) {
    asm volatile("" : "+v"(tid));
    const int wave = __builtin_amdgcn_readfirstlane(tid >> 6), lane = tid & 63, fr = lane & 15, fq = lane >> 4;
    const int v0 = wave * 16;
    float* ORAW = (float*)(a.ws + WS_H);
    for (int su = wg; su < 128; su += nwg) {
        const int sb = su >> 2, h = su & 3;
        const unsigned char* rec = a.ws + WS_DNC + (size_t)(2048 + su) * REC;
        DnRegs<128> R; dn_load<128>(rec, tid, 0, R); dn_store<128>(lds, tid, R);
        __syncthreads();
        f32x4 S[8];
        const float* s0 = a.in[3] + (size_t)su * 128 * 128 + v0 + fr;
#pragma unroll
        for (int m8 = 0; m8 < 8; ++m8)
#pragma unroll
            for (int i = 0; i < 4; ++i) S[m8][i] = s0[(16 * m8 + 4 * fq + i) * 128];
        f32x4 o[4];
        dn_step<272>(lds, S, lds + DB_U0 + (v0 + fr) * 2, ((const float*)(a.ws + WS_EG))[2048 + su], fr, fq, o);
        float* op = ORAW + (size_t)(TP + sb * 16) * 512 + h * 128 + v0 + fr;
#pragma unroll
        for (int i = 0; i < 4; ++i) op[(size_t)(4 * fq + i) * 512] = o[0][i];
        float* so = a.out + O_SDS + (size_t)su * 128 * 128 + v0 + fr;
#pragma unroll
        for (int m8 = 0; m8 < 8; ++m8)
#pragma unroll
            for (int i = 0; i < 4; ++i) so[(16 * m8 + 4 * fq + i) * 128] = S[m8][i];
        __syncthreads();
    }
}

DI void mix_phase(const Args& a, int gw, int NGW, int lane) {
    asm volatile("" : "+v"(lane));
    const float* ORAW = (const float*)(a.ws + WS_H);
    const bf16* P = (const bf16*)(a.ws + WS_P);
    const bf16* GLU = (const bf16*)(a.ws + WS_GLU);
    bf16* MIX = (bf16*)(a.ws + WS_DNC);
    const f32x2 dg = *(const f32x2*)(a.in[12] + 2 * lane);
    const f32x4 sg0 = *(const f32x4*)(a.in[23] + 8 * lane), sg1 = *(const f32x4*)(a.in[23] + 8 * lane + 4);
    for (int row = gw; row < T; row += NGW) {
#pragma unroll
        for (int h = 0; h < 4; ++h) {
            const f32x2 ov = *(const f32x2*)(ORAW + (size_t)row * 512 + h * 128 + 2 * lane);
            const float r = rsqrtf(wave_sum(ov.x * ov.x + ov.y * ov.y) * (1.f / 128.f) + EPS);
            const unsigned zz = *(const unsigned*)(P + (size_t)row * PW + 1536 + h * 128 + 2 * lane);
            *(unsigned*)(MIX + (size_t)row * DM + h * 128 + 2 * lane) = pk2(ov.x * r * dg.x * silu(blo(zz)), ov.y * r * dg.y * silu(bhi(zz)));
        }
        const u32x4 gv = *(const u32x4*)(GLU + (size_t)row * 512 + 8 * lane);
        float v[8] = {blo(gv.x), bhi(gv.x), blo(gv.y), bhi(gv.y), blo(gv.z), bhi(gv.z), blo(gv.w), bhi(gv.w)};
        float ss = 0.f;
#pragma unroll
        for (int e = 0; e < 8; ++e) ss += v[e] * v[e];
        const float r5 = rsqrtf(wave_sum(ss) * (1.f / 512.f) + EPS);
        u32x4 w; w.x = pk2(v[0] * r5 * sg0[0], v[1] * r5 * sg0[1]); w.y = pk2(v[2] * r5 * sg0[2], v[3] * r5 * sg0[3]);
        w.z = pk2(v[4] * r5 * sg1[0], v[5] * r5 * sg1[1]); w.w = pk2(v[6] * r5 * sg1[2], v[7] * r5 * sg1[3]);
        *(u32x4*)(MIX + (size_t)row * DM + 512 + 8 * lane) = w;
    }
}

DI void act_phase(const Args& a, int gtid, int NT) {
    asm volatile("" : "+v"(gtid));
    bf16* UP = (bf16*)(a.ws + WS_UP);
    const float* fw = a.in[27]; const float* fb = a.in[28];
    constexpr int NCG = DFF / 8;
    for (int item = gtid; item < (T / 16) * NCG; item += NT) {
        const int cg8 = item % NCG, rb = item / NCG, col = cg8 * 8, row0 = rb * 16;
        float w0[8], w1[8], w2[8], bb[8], g2[8], g1[8];
#pragma unroll
        for (int e = 0; e < 8; ++e) { w0[e] = fw[col + e]; w1[e] = fw[DFF + col + e]; w2[e] = fw[2 * DFF + col + e]; bb[e] = fb[col + e]; g2[e] = 0.f; g1[e] = 0.f; }
        const bool sample = row0 >= TP;
        float* outp = nullptr;
        if (sample) { const int sb = (row0 - TP) >> 4; const float* cc = a.in[6] + (size_t)sb * 2 * DFF + col;
#pragma unroll
            for (int e = 0; e < 8; ++e) { g2[e] = cc[e]; g1[e] = cc[DFF + e]; }
            outp = a.out + O_SFC + (size_t)sb * 2 * DFF + col;
        } else {
            if ((rb & 511) != 0) {
                const u32x4 x2 = *(const u32x4*)(UP + (size_t)(row0 - 2) * UPW + col), x1 = *(const u32x4*)(UP + (size_t)(row0 - 1) * UPW + col);
                g2[0] = blo(x2.x); g2[1] = bhi(x2.x); g2[2] = blo(x2.y); g2[3] = bhi(x2.y); g2[4] = blo(x2.z); g2[5] = bhi(x2.z); g2[6] = blo(x2.w); g2[7] = bhi(x2.w);
                g1[0] = blo(x1.x); g1[1] = bhi(x1.x); g1[2] = blo(x1.y); g1[3] = bhi(x1.y); g1[4] = blo(x1.z); g1[5] = bhi(x1.z); g1[6] = blo(x1.w); g1[7] = bhi(x1.w);
            }
            if ((rb & 511) == 511) outp = a.out + O_PFC + (size_t)(rb >> 9) * 2 * DFF + col;
        }
#pragma unroll 4
        for (int r = 0; r < 16; ++r) {
            bf16* gp = UP + (size_t)(row0 + r) * UPW + col;
            const u32x4 xg = *(const u32x4*)gp, xv = *(const u32x4*)(gp + DFF);
            float g0[8] = {blo(xg.x), bhi(xg.x), blo(xg.y), bhi(xg.y), blo(xg.z), bhi(xg.z), blo(xg.w), bhi(xg.w)};
            float vv[8] = {blo(xv.x), bhi(xv.x), blo(xv.y), bhi(xv.y), blo(xv.z), bhi(xv.z), blo(xv.w), bhi(xv.w)};
            float o[8];
#pragma unroll
            for (int e = 0; e < 8; ++e) { o[e] = silu(g2[e] * w0[e] + g1[e] * w1[e] + g0[e] * w2[e] + bb[e]) * vv[e]; g2[e] = g1[e]; g1[e] = g0[e]; }
            u32x4 w; w.x = pk2(o[0], o[1]); w.y = pk2(o[2], o[3]); w.z = pk2(o[4], o[5]); w.w = pk2(o[6], o[7]);
            *(u32x4*)(gp + DFF) = w;
            if (outp && r >= 14) {
#pragma unroll
                for (int e = 0; e < 8; ++e) outp[(r - 14) * DFF + e] = g0[e];
            }
        }
    }
}

DI void act_fix_phase(const Args& a, int gtid, int NT) {
    asm volatile("" : "+v"(gtid));
    bf16* ACT = (bf16*)(a.ws + WS_UP);
    const bf16* GH = (const bf16*)(a.ws + WS_GH); const bf16* GT = (const bf16*)(a.ws + WS_GT); const bf16* VH = (const bf16*)(a.ws + WS_VH);
    const float* fw = a.in[27]; const float* fb = a.in[28];
    constexpr int NCG = DFF / 8;
    for (int item = gtid; item < (T / 16) * NCG; item += NT) {
        const int cg8 = item % NCG, grp = item / NCG, col = cg8 * 8;
        float w0[8], w1[8], w2[8], bb[8], g2[8], g1[8], h0[8], h1[8], v0[8], v1[8];
#pragma unroll
        for (int e = 0; e < 8; ++e) { w0[e] = fw[col + e]; w1[e] = fw[DFF + col + e]; w2[e] = fw[2 * DFF + col + e]; bb[e] = fb[col + e]; g2[e] = 0.f; g1[e] = 0.f; }
        const bool sample = grp >= TP / 16;
        if (sample) { const float* cc = a.in[6] + (size_t)(grp - TP / 16) * 2 * DFF + col;
#pragma unroll
            for (int e = 0; e < 8; ++e) { g2[e] = cc[e]; g1[e] = cc[DFF + e]; }
        } else if ((grp & 511) != 0) {
            const u32x4 x2 = *(const u32x4*)(GT + ((size_t)(grp - 1) * 2) * DFF + col), x1 = *(const u32x4*)(GT + ((size_t)(grp - 1) * 2 + 1) * DFF + col);
            g2[0] = blo(x2.x); g2[1] = bhi(x2.x); g2[2] = blo(x2.y); g2[3] = bhi(x2.y); g2[4] = blo(x2.z); g2[5] = bhi(x2.z); g2[6] = blo(x2.w); g2[7] = bhi(x2.w);
            g1[0] = blo(x1.x); g1[1] = bhi(x1.x); g1[2] = blo(x1.y); g1[3] = bhi(x1.y); g1[4] = blo(x1.z); g1[5] = bhi(x1.z); g1[6] = blo(x1.w); g1[7] = bhi(x1.w);
        }
        {
            const u32x4 xa = *(const u32x4*)(GH + ((size_t)grp * 2) * DFF + col), xb = *(const u32x4*)(GH + ((size_t)grp * 2 + 1) * DFF + col);
            const u32x4 ya = *(const u32x4*)(VH + ((size_t)grp * 2) * DFF + col), yb = *(const u32x4*)(VH + ((size_t)grp * 2 + 1) * DFF + col);
            h0[0] = blo(xa.x); h0[1] = bhi(xa.x); h0[2] = blo(xa.y); h0[3] = bhi(xa.y); h0[4] = blo(xa.z); h0[5] = bhi(xa.z); h0[6] = blo(xa.w); h0[7] = bhi(xa.w);
            h1[0] = blo(xb.x); h1[1] = bhi(xb.x); h1[2] = blo(xb.y); h1[3] = bhi(xb.y); h1[4] = blo(xb.z); h1[5] = bhi(xb.z); h1[6] = blo(xb.w); h1[7] = bhi(xb.w);
            v0[0] = blo(ya.x); v0[1] = bhi(ya.x); v0[2] = blo(ya.y); v0[3] = bhi(ya.y); v0[4] = blo(ya.z); v0[5] = bhi(ya.z); v0[6] = blo(ya.w); v0[7] = bhi(ya.w);
            v1[0] = blo(yb.x); v1[1] = bhi(yb.x); v1[2] = blo(yb.y); v1[3] = bhi(yb.y); v1[4] = blo(yb.z); v1[5] = bhi(yb.z); v1[6] = blo(yb.w); v1[7] = bhi(yb.w);
        }
        float o0[8], o1[8];
#pragma unroll
        for (int e = 0; e < 8; ++e) { o0[e] = silu(g2[e] * w0[e] + g1[e] * w1[e] + h0[e] * w2[e] + bb[e]) * v0[e]; o1[e] = silu(g1[e] * w0[e] + h0[e] * w1[e] + h1[e] * w2[e] + bb[e]) * v1[e]; }
        u32x4 wa, wb; wa.x = pk2(o0[0], o0[1]); wa.y = pk2(o0[2], o0[3]); wa.z = pk2(o0[4], o0[5]); wa.w = pk2(o0[6], o0[7]);
        wb.x = pk2(o1[0], o1[1]); wb.y = pk2(o1[2], o1[3]); wb.z = pk2(o1[4], o1[5]); wb.w = pk2(o1[6], o1[7]);
        *(u32x4*)(ACT + ((size_t)grp * 16) * DFF + col) = wa; *(u32x4*)(ACT + ((size_t)grp * 16 + 1) * DFF + col) = wb;
        float* outp = nullptr;
        if (sample) outp = a.out + O_SFC + (size_t)(grp - TP / 16) * 2 * DFF + col;
        else if ((grp & 511) == 511) outp = a.out + O_PFC + (size_t)(grp >> 9) * 2 * DFF + col;
        if (outp) {
            const u32x4 t0 = *(const u32x4*)(GT + ((size_t)grp * 2) * DFF + col), t1 = *(const u32x4*)(GT + ((size_t)grp * 2 + 1) * DFF + col);
            outp[0] = blo(t0.x); outp[1] = bhi(t0.x); outp[2] = blo(t0.y); outp[3] = bhi(t0.y); outp[4] = blo(t0.z); outp[5] = bhi(t0.z); outp[6] = blo(t0.w); outp[7] = bhi(t0.w);
            outp[DFF + 0] = blo(t1.x); outp[DFF + 1] = bhi(t1.x); outp[DFF + 2] = blo(t1.y); outp[DFF + 3] = bhi(t1.y); outp[DFF + 4] = blo(t1.z); outp[DFF + 5] = bhi(t1.z); outp[DFF + 6] = blo(t1.w); outp[DFF + 7] = bhi(t1.w);
        }
    }
}

DI void final_phase(const Args& a, int gw, int NGW, int lane) {
    asm volatile("" : "+v"(lane));
    f32x4 gv[4];
#pragma unroll
    for (int j = 0; j < 4; ++j) gv[j] = ((const f32x4*)a.in[30])[lane + 64 * j];
    for (int m = gw; m < T; m += NGW) {
        f32x4* xr = (f32x4*)(a.out + (size_t)m * DM) + lane;
        f32x4 v[4]; float s = 0.f;
#pragma unroll
        for (int j = 0; j < 4; ++j) { v[j] = xr[64 * j]; s += (v[j].x * v[j].x + v[j].y * v[j].y) + (v[j].z * v[j].z + v[j].w * v[j].w); }
        const float rstd = rsqrtf(wave_sum(s) * (1.f / DM) + EPS);
#pragma unroll
        for (int j = 0; j < 4; ++j) xr[64 * j] = v[j] * rstd * gv[j];
    }
}

#ifndef PH_MASK
#define PH_MASK 0xffff
#endif
#ifndef SOLVE_RL
#define SOLVE_RL 1
#endif
#ifndef REP0
#define REP0 1
#endif
#ifndef REP1
#define REP1 1
#endif
#ifndef REP2A
#define REP2A 1
#endif
#ifndef REP2B
#define REP2B 1
#endif
#ifndef REP3A
#define REP3A 1
#endif
#ifndef REP3B
#define REP3B 1
#endif
#ifndef REP3C
#define REP3C 1
#endif
#ifndef PH_LO
#define PH_LO 0
#endif
#ifndef PH_HI
#define PH_HI 99
#endif
__global__ void __launch_bounds__(512, 2) fwd_kernel(Args a) {
    extern __shared__ __attribute__((aligned(16))) unsigned char lds[];
    cg::grid_group grid = cg::this_grid();
    const int tid = threadIdx.x, lane = tid & 63, wave = __builtin_amdgcn_readfirstlane(tid >> 6);
    const int G = gridDim.x, gw = blockIdx.x * 8 + wave, NGW = G * 8;
    unsigned char* ws = a.ws;
    PG8_LAS unsigned char* ldsg = (PG8_LAS unsigned char*)lds;

    _Pragma("nounroll") for (int rep = 0; rep < REP0; ++rep) { phase0(a, lds, gw, NGW, wave, lane); __syncthreads(); }
    grid.sync();
    _Pragma("nounroll") for (int rep = 0; rep < REP1; ++rep)
    { pg8::Gemm g{(const bf16*)(ws + WS_H), (const bf16*)(ws + WS_WIN), T, NIN, DM, DM}; pg8::StaticOrder S; S.init(T, NIN, G, (int)blockIdx.x);
      EpiP E{(bf16*)(ws + WS_P), (float*)(ws + WS_BA)};
      pg8::gemm_phase<EpiP, pg8::StaticOrder, true, true>(ldsg, g, S, E); }
    grid.sync();
    _Pragma("nounroll") for (int rep = 0; rep < REP2A; ++rep) dn_chunk_phase(a, lds, tid);
#if OLD_S5 && OLD_S5 != 4 && OLD_S5 != 5
    old_s5_pass1(a, gw, NGW, lane);
#elif 0
#else
    _Pragma("nounroll") for (int rep = 0; rep < REP2B; ++rep) s5_pass1(a, gw, NGW, lane);
#endif
    grid.sync();
#if OLD_S5 == 3
    if (blockIdx.x < 64) dn_scan_prompt(a, lds, tid);
    else { if (blockIdx.x >= 192) { dn_scan_sample(a, lds, tid, (int)blockIdx.x - 192, 64); s5_pass2_sample(a, lds + 81920 + wave * 4352, ((int)blockIdx.x - 192) * 8 + wave, 512, lane); __syncthreads(); }
           old_s5_pass2(a, lds + 81920 + wave * 4352, gw - 512, NGW - 512, lane); }
#elif OLD_S5 == 5
    if (blockIdx.x < 64) { _Pragma("nounroll") for (int rep = 0; rep < REP3A; ++rep) dn_scan_prompt(a, lds, tid); }
    else { if (blockIdx.x >= 192) dn_scan_sample(a, lds, tid, (int)blockIdx.x - 192, 64); _Pragma("nounroll") for (int rep = 0; rep < REP3B; ++rep) s5_pass2b(a, lds + wave * 14592, gw - 512, NGW - 512, lane); }
#elif OLD_S5 == 1 || OLD_S5 == 4
    if (blockIdx.x < 64) dn_scan_prompt(a, lds, tid);
    else { if (blockIdx.x >= 192) dn_scan_sample(a, lds, tid, (int)blockIdx.x - 192, 64); old_s5_pass2(a, lds + 81920 + wave * 4352, gw - 512, NGW - 512, lane); }
#else
    if (blockIdx.x < 64) { _Pragma("nounroll") for (int rep = 0; rep < REP3A; ++rep) dn_scan_prompt(a, lds, tid); }
    else if (blockIdx.x < 192) { _Pragma("nounroll") for (int rep = 0; rep < REP3B; ++rep) s5_pass2_prompt(a, lds, (int)blockIdx.x - 64, tid); }
    else { _Pragma("nounroll") for (int rep = 0; rep < REP3C; ++rep) { dn_scan_sample(a, lds, tid, (int)blockIdx.x - 192, 64); s5_pass2_sample(a, lds + 81920 + wave * 4352, ((int)blockIdx.x - 192) * 8 + wave, 512, lane); } }
#endif
    grid.sync();
#if PH_MASK & 512
    { pg8::Gemm g{(const bf16*)(ws + WS_Y5), (const bf16*)(ws + WS_WGLU), T, 1024, 512, 512}; pg8::StaticOrder S; S.init(T, 1024, G, (int)blockIdx.x);
      EpiGlu E{(bf16*)(ws + WS_GLU), a.in[22]};
      pg8::gemm_phase<EpiGlu, pg8::StaticOrder, true, true>(ldsg, g, S, E); }
#endif
    grid.sync();
#if PH_MASK & 32
    mix_phase(a, gw, NGW, lane);
#endif
    grid.sync();
#if PH_MASK & 1024
    { pg8::Gemm g{(const bf16*)(ws + WS_DNC), (const bf16*)(ws + WS_WOUT), T, DM, DM, DM}; pg8::StaticOrder S; S.init(T, DM, G, (int)blockIdx.x);
      EpiX1 E{a.in[0], a.in[1], a.out, (bf16*)(ws + WS_H), (float*)(ws + WS_SS2)};
      pg8::gemm_phase<EpiX1, pg8::StaticOrder, true, true>(ldsg, g, S, E); }
#endif
    grid.sync();
#if FUSE_ACT
    { pg8::Gemm g{(const bf16*)(ws + WS_H), (const bf16*)(ws + WS_WUP), T, UPW, DM, DM}; pg8::StaticOrder S; S.init(T, UPW, G, (int)blockIdx.x);
      EpiUpAct E{(bf16*)(ws + WS_UP), (bf16*)(ws + WS_GH), (bf16*)(ws + WS_GT), (bf16*)(ws + WS_VH), (const float*)(ws + WS_SS2), a.in[27], a.in[28]};
      pg8::gemm_phase<EpiUpAct, pg8::StaticOrder, true, true>(ldsg, g, S, E); }
    grid.sync();
    act_fix_phase(a, (int)blockIdx.x * 512 + tid, G * 512);
    grid.sync();
    { pg8::Gemm g{(const bf16*)(ws + WS_UP), (const bf16*)(ws + WS_WDOWN), T, DM, DFF, DFF}; pg8::StaticOrder S; S.init(T, DM, G, (int)blockIdx.x);
      EpiX2 E{a.out};
      pg8::gemm_phase<EpiX2, pg8::StaticOrder, true, true>(ldsg, g, S, E); }
    grid.sync();
#else
#if PH_MASK & 2048
    { pg8::Gemm g{(const bf16*)(ws + WS_H), (const bf16*)(ws + WS_WUP), T, UPW, DM, DM}; pg8::StaticOrder S; S.init(T, UPW, G, (int)blockIdx.x);
      EpiUp E{(bf16*)(ws + WS_UP), (const float*)(ws + WS_SS2)};
      pg8::gemm_phase<EpiUp, pg8::StaticOrder, true, true>(ldsg, g, S, E); }
#endif
    grid.sync();
#if PH_MASK & 64
    act_phase(a, (int)blockIdx.x * 512 + tid, G * 512);
#endif
    grid.sync();
#if PH_MASK & 4096
    { pg8::Gemm g{(const bf16*)(ws + WS_UP) + DFF, (const bf16*)(ws + WS_WDOWN), T, DM, DFF, UPW}; pg8::StaticOrder S; S.init(T, DM, G, (int)blockIdx.x);
      EpiX2 E{a.out};
      pg8::gemm_phase<EpiX2, pg8::StaticOrder, true, true>(ldsg, g, S, E); }
#endif
    grid.sync();
#endif
#if PH_MASK & 128
    final_phase(a, gw, NGW, lane);
#endif
}

extern "C" void kernel_launch(void* const* d_in, const int* in_sizes, int n_in, void* d_out, int out_size, void* d_ws, size_t ws_size, hipStream_t stream) {
    static int grid = 0;
    if (grid == 0) {
        if (n_in != 31 || (size_t)out_size != O_END || ws_size < WS_END) { fprintf(stderr, "kernel_launch: unexpected shapes n_in %d out %d ws %zu\n", n_in, out_size, ws_size); grid = -1; return; }
        int dev = 0, cus = 0, per_cu = 0;
        hipGetDevice(&dev);
        hipDeviceGetAttribute(&cus, hipDeviceAttributeMultiprocessorCount, dev);
        hipFuncSetAttribute((const void*)fwd_kernel, hipFuncAttributeMaxDynamicSharedMemorySize, LDS_BYTES);
        hipOccupancyMaxActiveBlocksPerMultiprocessor(&per_cu, (const void*)fwd_kernel, 512, LDS_BYTES);
        if (per_cu < 1) { fprintf(stderr, "kernel_launch: occupancy query says %d blocks per CU\n", per_cu); per_cu = 1; }
        grid = cus * 1;
        if (grid != 256) { fprintf(stderr, "kernel_launch: built for a 256-CU device, got %d\n", cus); grid = -1; return; }
        (void)hipGetLastError();
    }
    if (grid < 0) return;
    Args a{};
    for (int i = 0; i < 31; ++i) a.in[i] = (const float*)d_in[i];
    a.out = (float*)d_out; a.ws = (unsigned char*)d_ws;
    void* args[] = {&a};
    hipError_t e = hipLaunchCooperativeKernel((const void*)fwd_kernel, dim3(grid), dim3(512), args, LDS_BYTES, stream);
    if (e != hipSuccess) fprintf(stderr, "cooperative launch failed: %s (grid %d)\n", hipGetErrorString(e), grid);
}
```

```cpp
#include <hip/hip_runtime.h>
#include <hip/hip_cooperative_groups.h>
#include <cstdio>
#include <cstdint>
namespace cg = cooperative_groups;
#define OLD_S5 5
#define DN_STAGED 2
namespace pg8 {
#define PG8_LAS __attribute__((address_space(3)))
typedef unsigned short bf16_t;
typedef short bf16x8 __attribute__((ext_vector_type(8)));
typedef float f32x4 __attribute__((ext_vector_type(4)));
typedef unsigned u32x4 __attribute__((ext_vector_type(4)));
constexpr int BM = 256, BK = 64, HALF = 128, HTB = HALF * BK * 2  , STAGE_BYTES = 8 * HTB, NXCD = 8, WGM = 8;

__host__ __device__ __forceinline__ int lds_byte(int r, int c) { const int st = (r >> 4) * 2 + (c >> 5), rr = r & 15, cc = c & 31, ob = rr * 64 + cc * 2; return st * 1024 + (ob ^ (((ob >> 9) & 1) << 5)); }
__host__ __device__ __forceinline__ void stage_rc(int b, int& R, int& C) { const int st = b / 1024, sb = b % 1024, swz = sb ^ (((sb >> 9) & 1) << 5); R = (st >> 1) * 16 + swz / 64; C = (st & 1) * 32 + (swz % 64) / 2; }
__host__ __device__ __forceinline__ int perm32(int rho) { const int n = rho >> 4, i = rho & 15; return 8 * (i >> 2) + 4 * n + (i & 3); }

struct Unit { int pm, pn; };
struct Gemm { const bf16_t* A; const bf16_t* Bt; int M, N, K, lda; };

struct StaticOrder {
    int nM, nN, nwg, G, c;
    __host__ __device__ void init(int M, int N, int G_, int c_) { nM = M / BM; nN = N / BM; nwg = nM * nN; G = G_; c = c_; }
    __host__ __device__ bool next(int i, Unit& u) const {
        const long L = (long)i * G + c; if (L >= nwg) return false;
        int wgid = (int)L; { const int q = nwg / NXCD, r = nwg % NXCD, xcd = wgid % NXCD, off = wgid / NXCD; wgid = (xcd < r ? xcd * (q + 1) : r * (q + 1) + (xcd - r) * q) + off; }
        const int nig = WGM * nN, gid = wgid / nig, fm = gid * WGM, gsz = (nM - fm) < WGM ? (nM - fm) : WGM;
        u.pm = fm + ((wgid % nig) % gsz); u.pn = (wgid % nig) / gsz; return true;
    }
    __device__ __forceinline__ void a_ready(const Unit&) const {}
    __device__ __forceinline__ void done(const Unit&) const {}
};
__device__ __forceinline__ unsigned cvt_pk_bf16(float lo, float hi) { unsigned r; asm volatile("v_cvt_pk_bf16_f32 %0, %1, %2" : "=v"(r) : "v"(lo), "v"(hi)); return r; }
typedef float f32x2 __attribute__((ext_vector_type(2)));
template <class Epi, class Sched, bool ALIGN_EPI = false, bool SP2 = false>
__device__ __forceinline__ void gemm_phase(PG8_LAS unsigned char* lds, const Gemm g, const Sched& S, const Epi& E) {
    int tid_ = threadIdx.x; asm volatile("" : "+v"(tid_));
    const int tid = tid_, wid = __builtin_amdgcn_readfirstlane(tid >> 6), lane = tid & 63, wr = wid >> 2, wc = wid & 3, fr = lane & 15, fq = lane >> 4;
    const int K = g.K, nt = K / BK;
    unsigned voffA[2], voffB[2];
#pragma unroll
    for (int i = 0; i < 2; ++i) { int R, C; stage_rc(tid * 16 + i * 8192, R, C); const int Rb = Epi::PERM ? ((R & ~31) + perm32(R & 31)) : R;
        voffA[i] = (unsigned)(R * g.lda + C) * 2u; voffB[i] = (unsigned)(Rb * K + C) * 2u; }
    const size_t kstep = (size_t)(BK * 2);
    const size_t hstep = (size_t)HALF * K * 2;
    const size_t tstep = 2 * hstep; const size_t hstepA = (size_t)HALF * g.lda * 2, tstepA = 2 * hstepA;
    const unsigned ldsw = (unsigned)wid * 1024u;
    const int aoff = lds_byte(wr * 64 + fr, fq * 8), boff = lds_byte(wc * 32 + fr, fq * 8);
#define PG8_SA(b, h) (((b) * 2 + (h)) * HTB)
#define PG8_SB(b, h) ((4 + (b) * 2 + (h)) * HTB)
#define PG8_STAGE(bufoff, gbase, voff) do { _Pragma("unroll") for (int _i = 0; _i < 2; ++_i) \
        __builtin_amdgcn_global_load_lds((const unsigned*)((const char*)(gbase) + (voff)[_i]), (PG8_LAS unsigned*)(lds + (bufoff) + ldsw + _i * 8192), 16, 0, 0); } while (0)
#define PG8_LDA(dst, b, h) do { _Pragma("unroll") for (int m = 0; m < 4; ++m) _Pragma("unroll") for (int k = 0; k < 2; ++k) dst[m][k] = *(const PG8_LAS bf16x8*)(lds + PG8_SA(b, h) + aoff + m * 2048 + k * 1024); } while (0)
#define PG8_LDB(dst, b, h) do { _Pragma("unroll") for (int n = 0; n < 2; ++n) _Pragma("unroll") for (int k = 0; k < 2; ++k) dst[n][k] = *(const PG8_LAS bf16x8*)(lds + PG8_SB(b, h) + boff + n * 2048 + k * 1024); } while (0)
#define PG8_MMA(ai, bj, At, Bt) do { __builtin_amdgcn_s_setprio(1); _Pragma("unroll") for (int m = 0; m < 4; ++m) _Pragma("unroll") for (int n = 0; n < 2; ++n) _Pragma("unroll") for (int k = 0; k < 2; ++k) \
        acc[ai][bj][m][n] = __builtin_amdgcn_mfma_f32_16x16x32_bf16(Bt[n][k], At[m][k], acc[ai][bj][m][n], 0, 0, 0); __builtin_amdgcn_s_setprio(0); } while (0)
#define PG8_WAIT_V(n) asm volatile("s_waitcnt vmcnt(" #n ")" ::: "memory")
#define PG8_WAIT_L(n) asm volatile("s_waitcnt lgkmcnt(" #n ")" ::: "memory")
#define PG8_BAR __builtin_amdgcn_s_barrier()
#define PG8_SCHED __builtin_amdgcn_sched_barrier(0)
    Unit cur, nxt; int ui = 0;
    if (!S.next(0, cur)) return;
    f32x4 acc[2][2][4][2];
#pragma unroll
    for (int a = 0; a < 2; ++a)
#pragma unroll
        for (int b = 0; b < 2; ++b)
#pragma unroll
            for (int m = 0; m < 4; ++m)
#pragma unroll
                for (int n = 0; n < 2; ++n) acc[a][b][m][n] = (f32x4){0.f, 0.f, 0.f, 0.f};
    bf16x8 At[4][2], B0[2][2], B1[2][2];
    const char* cA = (const char*)g.A + (size_t)cur.pm * tstepA; const char* cB = (const char*)g.Bt + (size_t)cur.pn * tstep;
    S.a_ready(cur);
    if constexpr (SP2) {
        PG8_STAGE(PG8_SB(0, 0), cB, voffB); PG8_STAGE(PG8_SB(0, 1), cB + hstep, voffB); PG8_STAGE(PG8_SA(0, 0), cA, voffA); PG8_STAGE(PG8_SA(0, 1), cA + hstepA, voffA);
        if (wr == 1) PG8_BAR;
        PG8_WAIT_V(2); PG8_BAR;
        PG8_STAGE(PG8_SB(1, 0), cB + kstep, voffB); PG8_STAGE(PG8_SA(1, 0), cA + kstep, voffA); PG8_STAGE(PG8_SB(1, 1), cB + hstep + kstep, voffB);
        PG8_WAIT_V(6); PG8_BAR;
    } else {
        PG8_STAGE(PG8_SB(0, 0), cB, voffB); PG8_STAGE(PG8_SA(0, 0), cA, voffA); PG8_STAGE(PG8_SB(0, 1), cB + hstep, voffB); PG8_STAGE(PG8_SA(0, 1), cA + hstepA, voffA);
        if (wr == 1) PG8_BAR;
        PG8_WAIT_V(4); PG8_BAR;
        PG8_STAGE(PG8_SB(1, 0), cB + kstep, voffB); PG8_STAGE(PG8_SA(1, 0), cA + kstep, voffA); PG8_STAGE(PG8_SB(1, 1), cB + hstep + kstep, voffB);
        PG8_WAIT_V(6); PG8_BAR;
    }
    for (;;) {
        const bool has_next = S.next(ui + 1, nxt);
        const char* nA = has_next ? (const char*)g.A + (size_t)nxt.pm * tstepA : cA; const char* nB = has_next ? (const char*)g.Bt + (size_t)nxt.pn * tstep : cB;
        for (int t = 0; t < nt; t += 2) {
            const bool last = (t == nt - 2);
            const char* a1 = cA + (size_t)(t + 1) * kstep;
            const char* a2 = last ? nA : cA + (size_t)(t + 2) * kstep; const char* b2 = last ? nB : cB + (size_t)(t + 2) * kstep;
            const char* a3 = a2 + kstep; const char* b3 = b2 + kstep;
            if (last && has_next) S.a_ready(nxt);
            if constexpr (SP2) {
            PG8_LDB(B0, 0, 0); PG8_LDB(B1, 0, 1); PG8_SCHED; PG8_LDA(At, 0, 0); PG8_STAGE(PG8_SA(1, 1), a1 + hstepA, voffA);
            PG8_WAIT_V(8); PG8_WAIT_L(0); PG8_BAR; PG8_MMA(0, 0, At, B0); PG8_MMA(0, 1, At, B1); PG8_BAR; PG8_SCHED;
            PG8_LDA(At, 0, 1); PG8_STAGE(PG8_SB(0, 0), b2, voffB); PG8_STAGE(PG8_SB(0, 1), b2 + hstep, voffB); PG8_STAGE(PG8_SA(0, 0), a2, voffA);
            PG8_WAIT_V(8); PG8_WAIT_L(0); PG8_BAR; PG8_MMA(1, 0, At, B0); PG8_MMA(1, 1, At, B1); PG8_BAR; PG8_SCHED;
            PG8_LDB(B0, 1, 0); PG8_LDB(B1, 1, 1); PG8_SCHED; PG8_LDA(At, 1, 0); PG8_STAGE(PG8_SA(0, 1), a2 + hstepA, voffA);
            PG8_WAIT_V(8); PG8_WAIT_L(0); PG8_BAR; PG8_MMA(0, 0, At, B0); PG8_MMA(0, 1, At, B1); PG8_BAR; PG8_SCHED;
            PG8_LDA(At, 1, 1); PG8_STAGE(PG8_SB(1, 0), b3, voffB); PG8_STAGE(PG8_SB(1, 1), b3 + hstep, voffB); PG8_STAGE(PG8_SA(1, 0), a3, voffA);
            PG8_WAIT_V(8); PG8_WAIT_L(0); PG8_BAR; PG8_MMA(1, 0, At, B0); PG8_MMA(1, 1, At, B1); PG8_BAR; PG8_SCHED;
            } else {
            PG8_LDB(B0, 0, 0); PG8_SCHED; PG8_LDA(At, 0, 0); PG8_STAGE(PG8_SA(1, 1), a1 + hstepA, voffA);
            PG8_WAIT_L(8); PG8_BAR; PG8_WAIT_L(0); PG8_MMA(0, 0, At, B0); PG8_BAR; PG8_SCHED;
            PG8_LDB(B1, 0, 1); PG8_STAGE(PG8_SB(0, 0), b2, voffB);
            PG8_BAR; PG8_WAIT_L(0); PG8_MMA(0, 1, At, B1); PG8_BAR;
            PG8_LDA(At, 0, 1); PG8_STAGE(PG8_SA(0, 0), a2, voffA);
            PG8_BAR; PG8_WAIT_L(0); PG8_MMA(1, 0, At, B0); PG8_BAR; PG8_SCHED;
            PG8_STAGE(PG8_SB(0, 1), b2 + hstep, voffB);
            PG8_WAIT_V(6); PG8_BAR; PG8_MMA(1, 1, At, B1); PG8_BAR;
            PG8_LDB(B0, 1, 0); PG8_SCHED; PG8_LDA(At, 1, 0); PG8_STAGE(PG8_SA(0, 1), a2 + hstepA, voffA);
            PG8_WAIT_L(8); PG8_BAR; PG8_WAIT_L(0); PG8_MMA(0, 0, At, B0); PG8_BAR; PG8_SCHED;
            PG8_LDB(B1, 1, 1); PG8_STAGE(PG8_SB(1, 0), b3, voffB);
            PG8_BAR; PG8_WAIT_L(0); PG8_MMA(0, 1, At, B1); PG8_BAR;
            PG8_LDA(At, 1, 1); PG8_STAGE(PG8_SA(1, 0), a3, voffA);
            PG8_BAR; PG8_WAIT_L(0); PG8_MMA(1, 0, At, B0); PG8_BAR; PG8_SCHED;
            PG8_STAGE(PG8_SB(1, 1), b3 + hstep, voffB);
            PG8_WAIT_V(6); PG8_BAR; PG8_MMA(1, 1, At, B1); PG8_BAR;
            }
        }
        if constexpr (ALIGN_EPI) { if (wr == 0) PG8_BAR; }
        if constexpr (!Epi::AFTER_DRAIN) { E(acc, cur, wr, wc, fr, fq); S.done(cur); }
        if (!has_next) break;
#pragma unroll
        for (int a = 0; a < 2; ++a)
#pragma unroll
            for (int b = 0; b < 2; ++b)
#pragma unroll
                for (int m = 0; m < 4; ++m)
#pragma unroll
                    for (int n = 0; n < 2; ++n) acc[a][b][m][n] = (f32x4){0.f, 0.f, 0.f, 0.f};
        cur = nxt; cA = nA; cB = nB; ++ui;
        if constexpr (ALIGN_EPI) { if (wr == 1) PG8_BAR; }
    }
    PG8_WAIT_V(0);
    if constexpr (!ALIGN_EPI) { if (wr == 0) PG8_BAR; }
    PG8_BAR;
    if constexpr (Epi::AFTER_DRAIN) { E.fused(acc, cur, wr, wc, fr, fq, lds, wid, lane); S.done(cur); }
#undef PG8_SA
#undef PG8_SB
#undef PG8_STAGE
#undef PG8_LDA
#undef PG8_LDB
#undef PG8_MMA
#undef PG8_WAIT_V
#undef PG8_WAIT_L
#undef PG8_BAR
#undef PG8_SCHED
}
}

#ifndef FUSE_ACT
#define FUSE_ACT 1
#endif
#ifndef DN_STAGED
#define DN_STAGED 1
#endif
#ifndef DIAG_Y
#define DIAG_Y 0
#endif
#ifndef OLD_S5
#define OLD_S5 0
#endif
#if OLD_S5 == 3
#define OLD_S5_ULIM 8192
#else
#define OLD_S5_ULIM (4 * 32 * 64 + 32 * 32)
#endif
#define DI __device__ __forceinline__
typedef unsigned short bf16;
typedef float f32x4 __attribute__((ext_vector_type(4)));
typedef float f32x2 __attribute__((ext_vector_type(2)));
typedef short bf16x8 __attribute__((ext_vector_type(8)));
typedef unsigned u32x4 __attribute__((ext_vector_type(4)));
typedef unsigned u32x2 __attribute__((ext_vector_type(2)));
typedef __bf16 bf16x2_t __attribute__((ext_vector_type(2)));

DI unsigned pk2(float lo, float hi) { f32x2 v = {lo, hi}; bf16x2_t b = __builtin_convertvector(v, bf16x2_t); return __builtin_bit_cast(unsigned, b); }
DI bf16 f2b(float x) { return (bf16)(pk2(x, 0.f) & 0xffffu); }
DI float b2f(unsigned b) { return __uint_as_float(b << 16); }
DI float blo(unsigned w) { return __uint_as_float(w << 16); }
DI float bhi(unsigned w) { return __uint_as_float(w & 0xffff0000u); }
DI float wave_sum(float v) {
#pragma unroll
    for (int o = 1; o < 64; o <<= 1) v += __shfl_xor(v, o);
    return v;
}
DI float sigm(float x) { return 1.f / (1.f + __expf(-x)); }
DI float silu(float x) { return x / (1.f + __expf(-x)); }
DI float gelu_tanh(float x) { const float z = 1.5957691216057308f * (x + 0.044715f * x * x * x); return x / (1.f + __expf(-z)); }
#define MFMA16(a, b, c) __builtin_amdgcn_mfma_f32_16x16x32_bf16((a), (b), (c), 0, 0, 0)

constexpr int TP = 32768, TS = 512, T = TP + TS;
constexpr int DM = 1024, PW = 2560, NIN = 2816, DFF = 2816, UPW = 5632;
constexpr float EPS = 1e-6f;
constexpr int NCH = 2048 + 128;
constexpr int REC = 73728;
constexpr int R_WN = 0, R_QG = 16384, R_KDT = 32768, R_QK = 49152, R_U0 = 57344;
constexpr size_t O_Y = 0, O_PDC = (size_t)T * DM, O_PDS = O_PDC + 4 * 3 * 1536, O_PSR = O_PDS + 4 * 4 * 128 * 128, O_PSI = O_PSR + 4 * 32 * 64,
                 O_PFC = O_PSI + 4 * 32 * 64, O_SDC = O_PFC + 4 * 2 * 2816, O_SDS = O_SDC + 32 * 3 * 1536, O_SSR = O_SDS + (size_t)32 * 4 * 128 * 128,
                 O_SSI = O_SSR + 32 * 32 * 64, O_SFC = O_SSI + 32 * 32 * 64, O_END = O_SFC + 32 * 2 * 2816;
constexpr size_t MiB = 1u << 20;
constexpr size_t WS_SS2 = 0;
constexpr size_t WS_EG = 3 * MiB;
constexpr size_t WS_BA = 4 * MiB;
constexpr size_t WS_WIN = 6 * MiB, WS_WGLU = 12 * MiB, WS_WOUT = 13 * MiB, WS_WUP = 15 * MiB, WS_WDOWN = 26 * MiB;
constexpr size_t WS_H = 32 * MiB;
constexpr size_t WS_P = 98 * MiB;
constexpr size_t WS_DNC = 262 * MiB;
constexpr size_t WS_Y5 = 416 * MiB, WS_GLU = 449 * MiB, WS_S5E = 482 * MiB, WS_END = 487 * MiB;
constexpr size_t WS_GH = 300 * MiB, WS_GT = 324 * MiB, WS_VH = 348 * MiB;
constexpr size_t WS_UP = 98 * MiB;
static_assert(WS_UP + (size_t)T * UPW * 2 <= WS_END && WS_P + (size_t)T * PW * 2 <= WS_DNC && WS_DNC + (size_t)NCH * REC <= WS_Y5, "ws map");
constexpr int LDS_BYTES = 147456;

struct Args { const float* in[31]; float* out; unsigned char* ws; };

DI int colmap(int mode, int n) {
    if (mode == 0) return n;
    if (mode == 1) return n < 2048 ? n : (n < 2560 ? n + 8 : (n < 2568 ? n - 512 : -1));
    const int pn = n >> 8, bj = (n >> 7) & 1, j = n & 127;
    return bj * (mode == 2 ? 512 : 2816) + 128 * pn + j;
}
DI void transpose_item(const float* W, int K, int N, bf16* WT, float* scr, int kb, int nb, int lane, int mode, const float* rs) {
    const int k0 = 64 * kb, n0 = 32 * nb;
    const int sc = colmap(mode, n0 + (lane & 31));
    float tv[32];
#pragma unroll
    for (int i = 0; i < 32; ++i) { const int kk = 2 * i + (lane >> 5); tv[i] = 0.f; if (sc >= 0) tv[i] = W[(size_t)(k0 + kk) * N + sc]; }
#pragma unroll
    for (int i = 0; i < 32; ++i) { const int kk = 2 * i + (lane >> 5); float v = tv[i]; if (rs) v *= rs[k0 + kk]; scr[kk * 33 + (lane & 31)] = v; }
    asm volatile("s_waitcnt lgkmcnt(0)" ::: "memory");
    const int c = lane & 7;
#pragma unroll
    for (int j = 0; j < 4; ++j) { const int n = (lane >> 3) + 8 * j; const float* s = scr + (8 * c) * 33 + n;
        u32x4 o; o.x = pk2(s[0 * 33], s[1 * 33]); o.y = pk2(s[2 * 33], s[3 * 33]); o.z = pk2(s[4 * 33], s[5 * 33]); o.w = pk2(s[6 * 33], s[7 * 33]);
        *(u32x4*)(WT + (size_t)(n0 + n) * K + k0 + 8 * c) = o; }
    asm volatile("s_waitcnt lgkmcnt(0)" ::: "memory");
}
DI void phase0(const Args& a, unsigned char* lds, int gw, int NGW, int wave, int lane) {
    asm volatile("" : "+v"(lane));
    unsigned char* ws = a.ws;
    float* scr = (float*)(lds + wave * 16384);
    constexpr int I_IN = 16 * (NIN / 32), I_GLU = 8 * 32, I_OUT = 16 * 32, I_UP = 16 * (UPW / 32), I_DN = 44 * 32;
    constexpr int NIT = I_IN + I_GLU + I_OUT + I_UP + I_DN;
    for (int it = gw; it < NIT; it += NGW) {
        int r = it;
        if (r < I_IN) { transpose_item(a.in[8], 1024, 2568, (bf16*)(ws + WS_WIN), scr, r / (NIN / 32), r % (NIN / 32), lane, 1, nullptr); continue; } r -= I_IN;
        if (r < I_GLU) { transpose_item(a.in[21], 512, 1024, (bf16*)(ws + WS_WGLU), scr, r / 32, r % 32, lane, 2, nullptr); continue; } r -= I_GLU;
        if (r < I_OUT) { transpose_item(a.in[24], 1024, 1024, (bf16*)(ws + WS_WOUT), scr, r / 32, r % 32, lane, 0, nullptr); continue; } r -= I_OUT;
        if (r < I_UP) { transpose_item(a.in[26], 1024, 5632, (bf16*)(ws + WS_WUP), scr, r / (UPW / 32), r % (UPW / 32), lane, 3, a.in[25]); continue; } r -= I_UP;
        transpose_item(a.in[29], 2816, 1024, (bf16*)(ws + WS_WDOWN), scr, r / 32, r % 32, lane, 0, nullptr);
    }
    const float* g1 = a.in[7];
    f32x4 gv[4];
#pragma unroll
    for (int j = 0; j < 4; ++j) gv[j] = ((const f32x4*)g1)[lane + 64 * j];
    bf16* H = (bf16*)(ws + WS_H);
    for (int m0 = gw; m0 < T; m0 += 2 * NGW) {
        const int m1 = m0 + NGW < T ? m0 + NGW : m0;
        const f32x4* xr0 = (const f32x4*)(m0 < TP ? a.in[0] + (size_t)m0 * DM : a.in[1] + (size_t)(m0 - TP) * DM) + lane;
        const f32x4* xr1 = (const f32x4*)(m1 < TP ? a.in[0] + (size_t)m1 * DM : a.in[1] + (size_t)(m1 - TP) * DM) + lane;
        f32x4 v0[4], v1[4]; float s0 = 0.f, s1 = 0.f;
#pragma unroll
        for (int j = 0; j < 4; ++j) { v0[j] = xr0[64 * j]; v1[j] = xr1[64 * j]; }
#pragma unroll
        for (int j = 0; j < 4; ++j) { s0 += (v0[j].x * v0[j].x + v0[j].y * v0[j].y) + (v0[j].z * v0[j].z + v0[j].w * v0[j].w); s1 += (v1[j].x * v1[j].x + v1[j].y * v1[j].y) + (v1[j].z * v1[j].z + v1[j].w * v1[j].w); }
        const float r0 = rsqrtf(wave_sum(s0) * (1.f / DM) + EPS), r1 = rsqrtf(wave_sum(s1) * (1.f / DM) + EPS);
        u32x2* o0 = (u32x2*)(H + (size_t)m0 * DM) + lane; u32x2* o1 = (u32x2*)(H + (size_t)m1 * DM) + lane;
#pragma unroll
        for (int j = 0; j < 4; ++j) { u32x2 o; o.x = pk2(v0[j].x * r0 * gv[j].x, v0[j].y * r0 * gv[j].y); o.y = pk2(v0[j].z * r0 * gv[j].z, v0[j].w * r0 * gv[j].w); o0[64 * j] = o; }
        if (m1 != m0) {
#pragma unroll
            for (int j = 0; j < 4; ++j) { u32x2 o; o.x = pk2(v1[j].x * r1 * gv[j].x, v1[j].y * r1 * gv[j].y); o.y = pk2(v1[j].z * r1 * gv[j].z, v1[j].w * r1 * gv[j].w); o1[64 * j] = o; }
        }
    }
}

struct EpiP {
    static constexpr bool PERM = true, AFTER_DRAIN = false;
    bf16* P; float* BA;
    DI void operator()(const pg8::f32x4 (&acc)[2][2][4][2], const pg8::Unit& u, int wr, int wc, int fr, int fq) const {
        const int row0 = u.pm * 256 + wr * 64 + fr;
        if (u.pn < 10) {
            const int col0 = u.pn * 256 + wc * 32 + 8 * fq;
#pragma unroll
            for (int ai = 0; ai < 2; ++ai)
#pragma unroll
                for (int m = 0; m < 4; ++m) { bf16* rowp = P + (size_t)(row0 + ai * 128 + m * 16) * PW + col0;
#pragma unroll
                    for (int bj = 0; bj < 2; ++bj) { const pg8::f32x4 v0 = acc[ai][bj][m][0], v1 = acc[ai][bj][m][1];
                        u32x4 w; w.x = pk2(v0[0], v0[1]); w.y = pk2(v0[2], v0[3]); w.z = pk2(v1[0], v1[1]); w.w = pk2(v1[2], v1[3]);
                        *(u32x4*)(rowp + bj * 128) = w; } }
        } else if (wc == 0 && fq == 0) {
#pragma unroll
            for (int ai = 0; ai < 2; ++ai)
#pragma unroll
                for (int m = 0; m < 4; ++m) { float* bp = BA + (size_t)(row0 + ai * 128 + m * 16) * 8;
                    *(pg8::f32x4*)bp = acc[ai][0][m][0]; *(pg8::f32x4*)(bp + 4) = acc[ai][0][m][1]; }
        }
    }
};
struct EpiGlu {
    static constexpr bool PERM = true, AFTER_DRAIN = false;
    bf16* O; const float* gb;
    DI void operator()(const pg8::f32x4 (&acc)[2][2][4][2], const pg8::Unit& u, int wr, int wc, int fr, int fq) const {
        const int row0 = u.pm * 256 + wr * 64 + fr, col0 = u.pn * 128 + wc * 32 + 8 * fq;
        const pg8::f32x4 ba0 = *(const pg8::f32x4*)(gb + col0), ba1 = *(const pg8::f32x4*)(gb + col0 + 4), bg0 = *(const pg8::f32x4*)(gb + 512 + col0), bg1 = *(const pg8::f32x4*)(gb + 512 + col0 + 4);
#pragma unroll
        for (int ai = 0; ai < 2; ++ai)
#pragma unroll
            for (int m = 0; m < 4; ++m) {
                const pg8::f32x4 a0 = acc[ai][0][m][0] + ba0, a1 = acc[ai][0][m][1] + ba1, g0 = acc[ai][1][m][0] + bg0, g1 = acc[ai][1][m][1] + bg1;
                float o[8];
#pragma unroll
                for (int e = 0; e < 4; ++e) { o[e] = a0[e] * sigm(g0[e]); o[4 + e] = a1[e] * sigm(g1[e]); }
                u32x4 w; w.x = pk2(o[0], o[1]); w.y = pk2(o[2], o[3]); w.z = pk2(o[4], o[5]); w.w = pk2(o[6], o[7]);
                *(u32x4*)(O + (size_t)(row0 + ai * 128 + m * 16) * 512 + col0) = w;
            }
    }
};
struct EpiX1 {
    static constexpr bool PERM = false, AFTER_DRAIN = false;
    const float* xp; const float* xs; float* out; bf16* xb; float* ss2;
    DI void operator()(const pg8::f32x4 (&acc)[2][2][4][2], const pg8::Unit& u, int wr, int wc, int fr, int fq) const {
        const int row0 = u.pm * 256 + wr * 64 + fr, col0 = u.pn * 256 + wc * 32 + 4 * fq;
#pragma unroll
        for (int ai = 0; ai < 2; ++ai)
#pragma unroll
            for (int m = 0; m < 4; ++m) {
                const int row = row0 + ai * 128 + m * 16;
                const float* xr = (row < TP ? xp + (size_t)row * DM : xs + (size_t)(row - TP) * DM) + col0;
                float ss = 0.f;
#pragma unroll
                for (int bj = 0; bj < 2; ++bj)
#pragma unroll
                    for (int n = 0; n < 2; ++n) {
                        const pg8::f32x4 v = *(const pg8::f32x4*)(xr + bj * 128 + n * 16) + acc[ai][bj][m][n];
                        *(pg8::f32x4*)(out + (size_t)row * DM + col0 + bj * 128 + n * 16) = v;
                        u32x2 w; w.x = pk2(v[0], v[1]); w.y = pk2(v[2], v[3]);
                        *(u32x2*)(xb + (size_t)row * DM + col0 + bj * 128 + n * 16) = w;
                        ss += (v[0] * v[0] + v[1] * v[1]) + (v[2] * v[2] + v[3] * v[3]);
                    }
                ss += __shfl_xor(ss, 16); ss += __shfl_xor(ss, 32);
                if (fq == 0) ss2[(size_t)row * 16 + u.pn * 4 + wc] = ss;
            }
    }
};
struct EpiUp {
    static constexpr bool PERM = true, AFTER_DRAIN = false;
    bf16* UP; const float* ss2;
    DI void operator()(const pg8::f32x4 (&acc)[2][2][4][2], const pg8::Unit& u, int wr, int wc, int fr, int fq) const {
        const int row0 = u.pm * 256 + wr * 64 + fr, col0 = u.pn * 128 + wc * 32 + 8 * fq;
#pragma unroll
        for (int ai = 0; ai < 2; ++ai)
#pragma unroll
            for (int m = 0; m < 4; ++m) {
                const int row = row0 + ai * 128 + m * 16;
                const pg8::f32x4* sp = (const pg8::f32x4*)(ss2 + (size_t)row * 16);
                const pg8::f32x4 s0 = sp[0], s1 = sp[1], s2 = sp[2], s3 = sp[3];
                const float tot = ((s0[0] + s0[1]) + (s0[2] + s0[3])) + ((s1[0] + s1[1]) + (s1[2] + s1[3])) + ((s2[0] + s2[1]) + (s2[2] + s2[3])) + ((s3[0] + s3[1]) + (s3[2] + s3[3]));
                const float r = rsqrtf(tot * (1.f / DM) + EPS);
                bf16* rowp = UP + (size_t)row * UPW + col0;
#pragma unroll
                for (int bj = 0; bj < 2; ++bj) { const pg8::f32x4 v0 = acc[ai][bj][m][0] * r, v1 = acc[ai][bj][m][1] * r;
                    u32x4 w; w.x = pk2(v0[0], v0[1]); w.y = pk2(v0[2], v0[3]); w.z = pk2(v1[0], v1[1]); w.w = pk2(v1[2], v1[3]);
                    *(u32x4*)(rowp + bj * DFF) = w; }
            }
    }
};
DI float dpp_shr1(float v) { return __int_as_float(__builtin_amdgcn_update_dpp(0, __float_as_int(v), 0x111, 0xf, 0xf, false)); }
DI float dpp_shr2(float v) { return __int_as_float(__builtin_amdgcn_update_dpp(0, __float_as_int(v), 0x112, 0xf, 0xf, false)); }
struct EpiUpAct {
    static constexpr bool PERM = true, AFTER_DRAIN = false;
    bf16* ACT; bf16* GH; bf16* GT; bf16* VH; const float* ss2; const float* fw; const float* fb;
    DI void operator()(const pg8::f32x4 (&acc)[2][2][4][2], const pg8::Unit& u, int wr, int wc, int fr, int fq) const {
        const int row0 = u.pm * 256 + wr * 64 + fr, col0 = u.pn * 128 + wc * 32 + 8 * fq;
        float w0[8], w1[8], w2[8], bb[8];
#pragma unroll
        for (int n = 0; n < 2; ++n) { const pg8::f32x4 a0 = *(const pg8::f32x4*)(fw + col0 + 4 * n), a1 = *(const pg8::f32x4*)(fw + DFF + col0 + 4 * n), a2 = *(const pg8::f32x4*)(fw + 2 * DFF + col0 + 4 * n), a3 = *(const pg8::f32x4*)(fb + col0 + 4 * n);
#pragma unroll
            for (int e = 0; e < 4; ++e) { w0[4 * n + e] = a0[e]; w1[4 * n + e] = a1[e]; w2[4 * n + e] = a2[e]; bb[4 * n + e] = a3[e]; } }
#pragma unroll
        for (int ai = 0; ai < 2; ++ai)
#pragma unroll
            for (int m = 0; m < 4; ++m) {
                const int row = row0 + ai * 128 + m * 16, grp = row >> 4;
                const pg8::f32x4* sp = (const pg8::f32x4*)(ss2 + (size_t)row * 16);
                const pg8::f32x4 s0 = sp[0], s1 = sp[1], s2 = sp[2], s3 = sp[3];
                const float tot = ((s0[0] + s0[1]) + (s0[2] + s0[3])) + ((s1[0] + s1[1]) + (s1[2] + s1[3])) + ((s2[0] + s2[1]) + (s2[2] + s2[3])) + ((s3[0] + s3[1]) + (s3[2] + s3[3]));
                const float r = rsqrtf(tot * (1.f / DM) + EPS);
                float gs[8], vv[8], o[8];
#pragma unroll
                for (int n = 0; n < 2; ++n)
#pragma unroll
                    for (int e = 0; e < 4; ++e) { gs[4 * n + e] = acc[ai][0][m][n][e] * r; vv[4 * n + e] = acc[ai][1][m][n][e] * r; }
#pragma unroll
                for (int e = 0; e < 8; ++e) { const float g1 = dpp_shr1(gs[e]), g2 = dpp_shr2(gs[e]); o[e] = silu(g2 * w0[e] + g1 * w1[e] + gs[e] * w2[e] + bb[e]) * vv[e]; }
                u32x4 wg; wg.x = pk2(gs[0], gs[1]); wg.y = pk2(gs[2], gs[3]); wg.z = pk2(gs[4], gs[5]); wg.w = pk2(gs[6], gs[7]);
                if (fr >= 2) { u32x4 w; w.x = pk2(o[0], o[1]); w.y = pk2(o[2], o[3]); w.z = pk2(o[4], o[5]); w.w = pk2(o[6], o[7]);
                    *(u32x4*)(ACT + (size_t)row * DFF + col0) = w; }
                else { u32x4 wv; wv.x = pk2(vv[0], vv[1]); wv.y = pk2(vv[2], vv[3]); wv.z = pk2(vv[4], vv[5]); wv.w = pk2(vv[6], vv[7]);
                    *(u32x4*)(GH + ((size_t)grp * 2 + fr) * DFF + col0) = wg; *(u32x4*)(VH + ((size_t)grp * 2 + fr) * DFF + col0) = wv; }
                if (fr >= 14) *(u32x4*)(GT + ((size_t)grp * 2 + (fr - 14)) * DFF + col0) = wg;
            }
    }
};
struct EpiX2 {
    static constexpr bool PERM = false, AFTER_DRAIN = false;
    float* out;
    DI void operator()(const pg8::f32x4 (&acc)[2][2][4][2], const pg8::Unit& u, int wr, int wc, int fr, int fq) const {
        const int row0 = u.pm * 256 + wr * 64 + fr, col0 = u.pn * 256 + wc * 32 + 4 * fq;
#pragma unroll
        for (int ai = 0; ai < 2; ++ai)
#pragma unroll
            for (int m = 0; m < 4; ++m) {
                float* orow = out + (size_t)(row0 + ai * 128 + m * 16) * DM + col0;
#pragma unroll
                for (int bj = 0; bj < 2; ++bj)
#pragma unroll
                    for (int n = 0; n < 2; ++n) { pg8::f32x4* p = (pg8::f32x4*)(orow + bj * 128 + n * 16); *p = *p + acc[ai][bj][m][n]; }
            }
    }
};

DI int kperm(int k) { return (k & ~31) | (((k >> 2) & 3) << 3) | (((k >> 4) & 1) << 2) | (k & 3); }
DI void conv_col(const bf16* pcol, float h0, float h1, float h2, const float* cw, int nrows, float* outp, float (&val)[64]) {
    const float w0 = cw[0], w1 = cw[1536], w2 = cw[2 * 1536], w3 = cw[3 * 1536];
    float x3 = h0, x2 = h1, x1 = h2;
#pragma unroll
    for (int r = 0; r < 64; ++r) {
        float x0 = 0.f;
        if (r < nrows) x0 = b2f(pcol[(size_t)r * PW]);
        const float c = x3 * w0 + x2 * w1 + x1 * w2 + x0 * w3;
        val[r] = r < nrows ? silu(c) : 0.f;
        if (outp && r >= nrows - 3 && r < nrows) outp[(r - (nrows - 3)) * 1536] = x0;
        x3 = x2; x2 = x1; x1 = x0;
    }
}
DI void dn_chunk_phase(const Args& a, unsigned char* lds, int tid) {
    unsigned char* ws = a.ws;
    const bf16* P = (const bf16*)(ws + WS_P);
    const float* BA = (const float*)(ws + WS_BA);
    const float* cwt = a.in[9];
    constexpr float QSCALE = 0.08838834764831845f;
    for (int it = blockIdx.x; it < NCH / 2; it += gridDim.x) {
        int tl = tid; asm volatile("" : "+v"(tl));
        const int half = __builtin_amdgcn_readfirstlane(tl >> 8), t8 = tl & 255, hw = __builtin_amdgcn_readfirstlane((tl >> 6) & 3), lane = tl & 63, fr = lane & 15, fq = lane >> 4;
        unsigned char* L = lds + half * 53248;
        unsigned char* qb = L; unsigned char* kb = L + 17408;
        float* Am = (float*)(L + 34816);
        float* Gs = (float*)(L + 51200); float* Bs = Gs + 64; float* RQ = Gs + 128; float* RK = Gs + 192; float* EG = Gs + 256;
        const int unit = it * 2 + half;
        int row0, nrows, h, bidx; bool sample, first, lastc;
        if (unit < 2048) { const int b = unit >> 9, n = unit & 127; h = (unit >> 7) & 3; row0 = b * 8192 + n * 64; nrows = 64; sample = false; first = (n == 0); lastc = (n == 127); bidx = b; }
        else { const int su = unit - 2048; bidx = su >> 2; h = su & 3; row0 = TP + bidx * 16; nrows = 16; sample = true; first = false; lastc = true; }
        unsigned char* rec = ws + WS_DNC + (size_t)unit * REC;
        if (hw == 0) {
            float g = 0.f, be = 0.f;
            if (lane < nrows) {
                const float* bp = BA + (size_t)(row0 + lane) * 8;
                be = sigm(bp[h]);
                const float xx = bp[4 + h] + a.in[11][h];
                const float sp = xx > 20.f ? xx : log1pf(__expf(xx));
                g = -__expf(a.in[10][h]) * sp;
            }
#pragma unroll
            for (int o = 1; o < 64; o <<= 1) { const float v = __shfl_up(g, o); if (lane >= o) g += v; }
            Gs[lane] = g; Bs[lane] = be; EG[lane] = __expf(g);
            if (lane == 63) ((float*)(ws + WS_EG))[unit] = __expf(g);
        }
        float va[64];
        {
            const int c = t8 & 127;
            const int col = (t8 < 128 ? 0 : 512) + h * 128 + c;
            float h0 = 0.f, h1 = 0.f, h2 = 0.f;
            if (sample) { const float* cc = a.in[2] + (size_t)bidx * 3 * 1536 + col; h0 = cc[0]; h1 = cc[1536]; h2 = cc[2 * 1536]; }
            else if (!first) { const bf16* pp = P + (size_t)(row0 - 3) * PW + col; h0 = b2f(pp[0]); h1 = b2f(pp[PW]); h2 = b2f(pp[2 * PW]); }
            float* outp = lastc ? a.out + (sample ? O_SDC : O_PDC) + (size_t)bidx * 3 * 1536 + col : nullptr;
            conv_col(P + (size_t)row0 * PW + col, h0, h1, h2, cwt + col, nrows, outp, va);
            unsigned char* dst = (t8 < 128 ? qb : kb) + c * 2;
#pragma unroll
            for (int r = 0; r < 64; ++r) *(bf16*)(dst + r * 272) = f2b(va[r]);
        }
        __syncthreads();
        f32x4 kk[4], qk[4], qq;
        {
            bf16x8 ak[4], aq[4];
#pragma unroll
            for (int ks = 0; ks < 4; ++ks) { ak[ks] = *(const bf16x8*)(kb + (16 * hw + fr) * 272 + ks * 64 + fq * 16); aq[ks] = *(const bf16x8*)(qb + (16 * hw + fr) * 272 + ks * 64 + fq * 16); }
            qq = (f32x4){0.f, 0.f, 0.f, 0.f};
#pragma unroll
            for (int ks = 0; ks < 4; ++ks) qq = MFMA16(aq[ks], aq[ks], qq);
#pragma unroll
            for (int nt = 0; nt < 4; ++nt) {
                kk[nt] = (f32x4){0.f, 0.f, 0.f, 0.f}; qk[nt] = (f32x4){0.f, 0.f, 0.f, 0.f};
#pragma unroll
                for (int ks = 0; ks < 4; ++ks) { const bf16x8 bk = *(const bf16x8*)(kb + (16 * nt + fr) * 272 + ks * 64 + fq * 16);
                    kk[nt] = MFMA16(ak[ks], bk, kk[nt]); qk[nt] = MFMA16(aq[ks], bk, qk[nt]); }
            }
#pragma unroll
            for (int i = 0; i < 4; ++i) if (fr == 4 * fq + i) {
                float dk = 0.f;
#pragma unroll
                for (int nt = 0; nt < 4; ++nt) if (nt == hw) dk = kk[nt][i];
                RK[16 * hw + fr] = rsqrtf(dk + EPS); RQ[16 * hw + fr] = rsqrtf(qq[i] + EPS);
            }
        }
        __syncthreads();
        {
            bf16* QKr = (bf16*)(rec + R_QK);
#pragma unroll
            for (int i = 0; i < 4; ++i) {
                const int row = 16 * hw + 4 * fq + i;
                const float gr = Gs[row], br = Bs[row], rk = RK[row], rq = RQ[row];
#pragma unroll
                for (int nt = 0; nt < 4; ++nt) {
                    const int col = 16 * nt + fr;
                    const float d = col <= row ? gr - Gs[col] : 0.f;
                    const float e = __expf(d), rkc = RK[col];
                    Am[row * 64 + col] = col < row ? br * kk[nt][i] * rk * rkc * e : 0.f;
                    QKr[row * 64 + kperm(col)] = f2b(col <= row ? qk[nt][i] * rq * rkc * QSCALE * e : 0.f);
                }
            }
        }
        __syncthreads();
        if (t8 < 128) {
            bf16* Qg = (bf16*)(rec + R_QG) + kperm(t8);
#pragma unroll
            for (int r = 0; r < 64; ++r) Qg[r * 128] = f2b(va[r] * RQ[r] * QSCALE * EG[r]);
            {
                const int col = 1024 + h * 128 + t8;
                float h0 = 0.f, h1 = 0.f, h2 = 0.f;
                if (sample) { const float* cc = a.in[2] + (size_t)bidx * 3 * 1536 + col; h0 = cc[0]; h1 = cc[1536]; h2 = cc[2 * 1536]; }
                else if (!first) { const bf16* pp = P + (size_t)(row0 - 3) * PW + col; h0 = b2f(pp[0]); h1 = b2f(pp[PW]); h2 = b2f(pp[2 * PW]); }
                float* outp = lastc ? a.out + (sample ? O_SDC : O_PDC) + (size_t)bidx * 3 * 1536 + col : nullptr;
                conv_col(P + (size_t)row0 * PW + col, h0, h1, h2, cwt + col, nrows, outp, va);
            }
#pragma unroll
            for (int r = 0; r < 64; ++r) va[r] = va[r] * Bs[r];
        } else {
            const int c = t8 - 128;
            const float gl = Gs[63];
            unsigned w[32];
#pragma unroll
            for (int r = 0; r < 64; r += 2) w[kperm(r) >> 1] = pk2(va[r] * RK[r] * __expf(gl - Gs[r]), va[r + 1] * RK[r + 1] * __expf(gl - Gs[r + 1]));
            u32x4* dst = (u32x4*)(rec + R_KDT + c * 128);
#pragma unroll
            for (int j = 0; j < 8; ++j) dst[j] = (u32x4){w[4 * j], w[4 * j + 1], w[4 * j + 2], w[4 * j + 3]};
#pragma unroll
            for (int r = 0; r < 64; ++r) va[r] = va[r] * RK[r] * Bs[r] * EG[r];
        }
#if SOLVE_RL
        {
            float arow[64];
#pragma unroll
            for (int i = 1; i < 64; ++i) arow[i] = Am[i * 64 + lane];
#pragma unroll
            for (int i = 1; i < 64; ++i) {
                if (i < nrows) {
                    float acc0 = va[i], acc1 = 0.f;
#pragma unroll
                    for (int j = 0; j < i; ++j) { const float aij = __int_as_float(__builtin_amdgcn_readlane(__float_as_int(arow[i]), j)); if (j & 1) acc1 -= aij * va[j]; else acc0 -= aij * va[j]; }
                    va[i] = acc0 + acc1;
                }
            }
        }
#else
#pragma unroll
        for (int i = 1; i < 64; ++i) {
            float acc = va[i];
            const f32x4* Ar = (const f32x4*)(Am + i * 64);
#pragma unroll
            for (int j4 = 0; j4 < (i + 3) / 4; ++j4) {
                const f32x4 av = Ar[j4];
#pragma unroll
                for (int e = 0; e < 4; ++e) if (4 * j4 + e < i) acc -= av[e] * va[4 * j4 + e];
            }
            va[i] = acc;
        }
#endif
        if (t8 < 128) { bf16* U0 = (bf16*)(rec + R_U0) + t8;
#pragma unroll
            for (int r = 0; r < 64; ++r) U0[r * 128] = f2b(va[r]);
        } else { bf16* Wn = (bf16*)(rec + R_WN) + kperm(t8 - 128);
#pragma unroll
            for (int r = 0; r < 64; ++r) Wn[r * 128] = f2b(-va[r]);
        }
        __syncthreads();
    }
}

struct S5W { float lr[4], li[4]; bf16x8 bf[8]; };
DI void s5w_setup(const Args& a, int g, int fr, int fq, S5W& w) {
    const float dt = __expf(a.in[15][g]);
#pragma unroll
    for (int j = 0; j < 4; ++j) {
        const int p = 16 * j + fr;
        const float are = a.in[13][g * 64 + p], aim = a.in[14][g * 64 + p];
        const float mag = __expf(are * dt), ang = aim * dt;
        float sn, cs; sincosf(ang, &sn, &cs);
        const float lr = mag * cs, li = mag * sn;
        w.lr[j] = lr; w.li[j] = li;
        const float den = are * are + aim * aim;
        const float fre = ((lr - 1.f) * are + li * aim) / den, fim = (li * are - (lr - 1.f) * aim) / den;
        u32x4 wr = (u32x4){0u, 0u, 0u, 0u}, wi = (u32x4){0u, 0u, 0u, 0u};
        if (fq < 2) {
            const f32x4* br = (const f32x4*)(a.in[16] + (size_t)(g * 64 + p) * 16 + 8 * fq); const f32x4* bi = (const f32x4*)(a.in[17] + (size_t)(g * 64 + p) * 16 + 8 * fq);
            const f32x4 r0 = br[0], r1 = br[1], i0 = bi[0], i1 = bi[1];
            wr.x = pk2(fre * r0[0] - fim * i0[0], fre * r0[1] - fim * i0[1]); wr.y = pk2(fre * r0[2] - fim * i0[2], fre * r0[3] - fim * i0[3]);
            wr.z = pk2(fre * r1[0] - fim * i1[0], fre * r1[1] - fim * i1[1]); wr.w = pk2(fre * r1[2] - fim * i1[2], fre * r1[3] - fim * i1[3]);
            wi.x = pk2(fre * i0[0] + fim * r0[0], fre * i0[1] + fim * r0[1]); wi.y = pk2(fre * i0[2] + fim * r0[2], fre * i0[3] + fim * r0[3]);
            wi.z = pk2(fre * i1[0] + fim * r1[0], fre * i1[1] + fim * r1[1]); wi.w = pk2(fre * i1[2] + fim * r1[2], fre * i1[3] + fim * r1[3]);
        }
        w.bf[j] = __builtin_bit_cast(bf16x8, wr); w.bf[4 + j] = __builtin_bit_cast(bf16x8, wi);
    }
}
DI bf16x8 s5w_uload(const bf16* P, size_t row0, int SS, int ms, int g, int fr, int fq) {
    u32x4 v = (u32x4){0u, 0u, 0u, 0u};
    if (fq < 2) v = *(const u32x4*)(P + (row0 + (size_t)(fr >> 2) * SS + 4 * ms + (fr & 3)) * PW + 2048 + g * 16 + 8 * fq);
    return __builtin_bit_cast(bf16x8, v);
}
DI void s5w_step(const S5W& w, bf16x8 ua, float (&xr)[4], float (&xi)[4], unsigned (&xo)[4][4]) {
    f32x4 br[4], bi[4];
    const f32x4 z = (f32x4){0.f, 0.f, 0.f, 0.f};
#pragma unroll
    for (int j = 0; j < 4; ++j) { br[j] = MFMA16(ua, w.bf[j], z); bi[j] = MFMA16(ua, w.bf[4 + j], z); }
#pragma unroll
    for (int i = 0; i < 4; ++i)
#pragma unroll
        for (int j = 0; j < 4; ++j) {
            const float nr = w.lr[j] * xr[j] - w.li[j] * xi[j] + br[j][i], ni = w.lr[j] * xi[j] + w.li[j] * xr[j] + bi[j][i];
            xr[j] = nr; xi[j] = ni; xo[i][j] = pk2(nr, ni);
        }
#pragma unroll
    for (int j = 0; j < 8; ++j) asm volatile("" :: "v"(w.bf[j]));
    asm volatile("" :: "v"(ua));
}
DI void s5_pass1(const Args& a, int gw, int NGW, int lane) {
    asm volatile("" : "+v"(lane));
    const bf16* P = (const bf16*)(a.ws + WS_P);
    float* E = (float*)(a.ws + WS_S5E);
    const int fr = lane & 15, fq = lane >> 4;
    for (int unit = gw; unit < 4 * 32 * 16; unit += NGW) {
        const int sg = unit & 15, bg = unit >> 4, g = bg & 31, b = bg >> 5;
        S5W w; s5w_setup(a, g, fr, fq, w);
        float xr[4] = {0.f, 0.f, 0.f, 0.f}, xi[4] = {0.f, 0.f, 0.f, 0.f}; unsigned xo[4][4];
        const size_t row0 = (size_t)b * 8192 + sg * 512;
        bf16x8 ua = s5w_uload(P, row0, 128, 0, g, fr, fq);
        for (int ms = 0; ms < 32; ++ms) {
            const bf16x8 un = s5w_uload(P, row0, 128, ms + 1 < 32 ? ms + 1 : ms, g, fr, fq);
            s5w_step(w, ua, xr, xi, xo); ua = un;
        }
        float* e = E + ((size_t)bg * 64 + 4 * sg + fq) * 128;
#pragma unroll
        for (int j = 0; j < 4; ++j) { e[16 * j + fr] = xr[j]; e[64 + 16 * j + fr] = xi[j]; }
    }
}
DI void s5w_run(const Args& a, const S5W& w, const bf16x8 (&cf)[4], float Dg, unsigned char* xs, size_t row0, int SS, int nms, int g, int fr, int fq, float (&xr)[4], float (&xi)[4]) {
    const bf16* P = (const bf16*)(a.ws + WS_P);
    bf16* Y5 = (bf16*)(a.ws + WS_Y5);
    bf16x8 ua = s5w_uload(P, row0, SS, 0, g, fr, fq);
    for (int ms = 0; ms < nms; ++ms) {
        const bf16x8 un = s5w_uload(P, row0, SS, ms + 1 < nms ? ms + 1 : ms, g, fr, fq);
        float uu[4];
#pragma unroll
        for (int i = 0; i < 4; ++i) uu[i] = b2f(P[(row0 + (size_t)fq * SS + 4 * ms + i) * PW + 2048 + g * 16 + fr]);
        unsigned xo[4][4];
        s5w_step(w, ua, xr, xi, xo); ua = un;
#pragma unroll
        for (int i = 0; i < 4; ++i)
#pragma unroll
            for (int j = 0; j < 4; ++j) *(unsigned*)(xs + (4 * fq + i) * 272 + (16 * j + fr) * 4) = xo[i][j];
        asm volatile("s_waitcnt lgkmcnt(0)" ::: "memory");
        f32x4 y = (f32x4){0.f, 0.f, 0.f, 0.f};
        bf16x8 af[4];
#pragma unroll
        for (int ks = 0; ks < 4; ++ks) af[ks] = *(const bf16x8*)(xs + fr * 272 + ks * 64 + fq * 16);
        asm volatile("" ::: "memory");
#pragma unroll
        for (int ks = 0; ks < 4; ++ks) y = MFMA16(af[ks], cf[ks], y);
#if DIAG_Y
        {
            const float* cre = a.in[18] + (size_t)(g * 16 + fr) * 64; const float* cim = a.in[19] + (size_t)(g * 16 + fr) * 64;
#pragma unroll
            for (int i = 0; i < 4; ++i) { float acc = 0.f;
                for (int p = 0; p < 64; ++p) { const unsigned wv = *(const unsigned*)(xs + (4 * fq + i) * 272 + p * 4); acc += cre[p] * blo(wv) - cim[p] * bhi(wv); }
                y[i] = acc; }
        }
#endif
        asm volatile("" :: "v"(y));
#pragma unroll
        for (int ks = 0; ks < 4; ++ks) asm volatile("" :: "v"(af[ks]), "v"(cf[ks]));
#pragma unroll
        for (int i = 0; i < 4; ++i) {
            const size_t row = row0 + (size_t)fq * SS + 4 * ms + i;
            Y5[row * 512 + g * 16 + fr] = f2b(gelu_tanh(y[i] + Dg * uu[i]));
        }
    }
}
DI void s5_cfrag(const Args& a, int g, int fr, int fq, bf16x8 (&cf)[4]) {
#pragma unroll
    for (int ks = 0; ks < 4; ++ks) {
        const f32x4 cr = *(const f32x4*)(a.in[18] + (size_t)(g * 16 + fr) * 64 + 16 * ks + 4 * fq), ci = *(const f32x4*)(a.in[19] + (size_t)(g * 16 + fr) * 64 + 16 * ks + 4 * fq);
        u32x4 w; w.x = pk2(cr[0], -ci[0]); w.y = pk2(cr[1], -ci[1]); w.z = pk2(cr[2], -ci[2]); w.w = pk2(cr[3], -ci[3]);
        cf[ks] = __builtin_bit_cast(bf16x8, w);
    }
}
DI void s5_pass2_prompt(const Args& a, unsigned char* lds, int bg, int tid) {
    asm volatile("" : "+v"(tid));
    const int wave = __builtin_amdgcn_readfirstlane(tid >> 6), lane = tid & 63, fr = lane & 15, fq = lane >> 4;
    const int b = bg >> 5, g4 = (bg >> 2) & 7, part = bg & 3, g = 4 * g4 + (wave & 3);
    bg = b * 32 + g;
    unsigned char* xs = lds + wave * 4352;
    S5W w; s5w_setup(a, g, fr, fq, w);
    bf16x8 cf[4]; s5_cfrag(a, g, fr, fq, cf);
    const float Dg = a.in[20][g * 16 + fr];
    float pr[4], pi[4];
#pragma unroll
    for (int j = 0; j < 4; ++j) { pr[j] = w.lr[j]; pi[j] = w.li[j];
#pragma unroll
        for (int s = 0; s < 7; ++s) { const float nr = pr[j] * pr[j] - pi[j] * pi[j], ni = 2.f * pr[j] * pi[j]; pr[j] = nr; pi[j] = ni; } }
    const float* e = (const float*)(a.ws + WS_S5E) + (size_t)bg * 64 * 128;
    for (int uu = 0; uu < 2; ++uu) {
        const int sg = 4 * part + 2 * (wave >> 2) + uu, seg = 4 * sg + fq;
        float xr[4] = {0.f, 0.f, 0.f, 0.f}, xi[4] = {0.f, 0.f, 0.f, 0.f};
        for (int s = 0; s < 4 * sg + 3; ++s) {
            if (s < seg) {
#pragma unroll
                for (int j = 0; j < 4; ++j) { const float er = e[s * 128 + 16 * j + fr], ei = e[s * 128 + 64 + 16 * j + fr];
                    const float nr = pr[j] * xr[j] - pi[j] * xi[j] + er, ni = pr[j] * xi[j] + pi[j] * xr[j] + ei; xr[j] = nr; xi[j] = ni; }
            }
        }
        s5w_run(a, w, cf, Dg, xs, (size_t)b * 8192 + sg * 512, 128, 32, g, fr, fq, xr, xi);
        if (seg == 63) {
#pragma unroll
            for (int j = 0; j < 4; ++j) { a.out[O_PSR + (size_t)bg * 64 + 16 * j + fr] = xr[j]; a.out[O_PSI + (size_t)bg * 64 + 16 * j + fr] = xi[j]; }
        }
    }
}
DI void s5_pass2_sample(const Args& a, unsigned char* xs, int gw, int NGW, int lane) {
    asm volatile("" : "+v"(lane));
    const int fr = lane & 15, fq = lane >> 4;
    for (int unit = gw; unit < 256; unit += NGW) {
        const int g = unit & 31, q = unit >> 5, sb = 4 * q + fq;
        S5W w; s5w_setup(a, g, fr, fq, w);
        bf16x8 cf[4]; s5_cfrag(a, g, fr, fq, cf);
        const float Dg = a.in[20][g * 16 + fr];
        float xr[4], xi[4];
#pragma unroll
        for (int j = 0; j < 4; ++j) { xr[j] = a.in[4][(size_t)(sb * 32 + g) * 64 + 16 * j + fr]; xi[j] = a.in[5][(size_t)(sb * 32 + g) * 64 + 16 * j + fr]; }
        s5w_run(a, w, cf, Dg, xs, (size_t)TP + (size_t)q * 64, 16, 4, g, fr, fq, xr, xi);
#pragma unroll
        for (int j = 0; j < 4; ++j) { a.out[O_SSR + (size_t)(sb * 32 + g) * 64 + 16 * j + fr] = xr[j]; a.out[O_SSI + (size_t)(sb * 32 + g) * 64 + 16 * j + fr] = xi[j]; }
    }
}

struct S5Par { float lr, li; float bbr[16], bbi[16]; };
DI void s5_setup(const Args& a, int g, int p, S5Par& q) {
    const float are = a.in[13][g * 64 + p], aim = a.in[14][g * 64 + p], dt = __expf(a.in[15][g]);
    const float mag = __expf(are * dt), ang = aim * dt;
    float sn, cs; sincosf(ang, &sn, &cs);
    q.lr = mag * cs; q.li = mag * sn;
    const float den = are * are + aim * aim;
    const float fre = ((q.lr - 1.f) * are + q.li * aim) / den, fim = (q.li * are - (q.lr - 1.f) * aim) / den;
    const f32x4* br = (const f32x4*)(a.in[16] + (size_t)(g * 64 + p) * 16); const f32x4* bi = (const f32x4*)(a.in[17] + (size_t)(g * 64 + p) * 16);
#pragma unroll
    for (int j = 0; j < 4; ++j) { const f32x4 r = br[j], i = bi[j];
#pragma unroll
        for (int e = 0; e < 4; ++e) { q.bbr[4 * j + e] = fre * r[e] - fim * i[e]; q.bbi[4 * j + e] = fre * i[e] + fim * r[e]; } }
}
DI void s5_step4(const S5Par& q, float uv, float& xr, float& xi, unsigned (&xo)[4]) {
#pragma unroll
    for (int j = 0; j < 4; ++j) {
        float br = 0.f, bi = 0.f;
#pragma unroll
        for (int h = 0; h < 16; ++h) { const float uh = __int_as_float(__builtin_amdgcn_readlane(__float_as_int(uv), 16 * j + h)); br += q.bbr[h] * uh; bi += q.bbi[h] * uh; }
        const float nr = q.lr * xr - q.li * xi + br, ni = q.lr * xi + q.li * xr + bi;
        xr = nr; xi = ni; xo[j] = pk2(xr, xi);
    }
}
DI void old_s5_pass1(const Args& a, int gw, int NGW, int lane) {
    asm volatile("" : "+v"(lane));
    const bf16* P = (const bf16*)(a.ws + WS_P);
    float* E = (float*)(a.ws + WS_S5E);
    for (int unit = gw; unit < 4 * 32 * 64; unit += NGW) {
        const int seg = unit & 63, bg = unit >> 6, g = bg & 31, b = bg >> 5;
        S5Par q; s5_setup(a, g, lane, q);
        float xr = 0.f, xi = 0.f; unsigned xo[4];
        const bf16* up = P + (size_t)(b * 8192 + seg * 128 + (lane >> 4)) * PW + 2048 + g * 16 + (lane & 15);
#pragma unroll 2
        for (int t = 0; t < 128; t += 4) { const float uv = b2f(up[(size_t)t * PW]); s5_step4(q, uv, xr, xi, xo); }
        float* e = E + ((size_t)bg * 64 + seg) * 128;
        e[lane] = xr; e[64 + lane] = xi;
    }
}
DI void old_s5_pass2(const Args& a, unsigned char* xs  , int gw, int NGW, int lane) {
    asm volatile("" : "+v"(lane));
    const bf16* P = (const bf16*)(a.ws + WS_P);
    const float* E = (const float*)(a.ws + WS_S5E);
    bf16* Y5 = (bf16*)(a.ws + WS_Y5);
    const int fr = lane & 15, fq = lane >> 4;
    for (int unit = gw; unit < OLD_S5_ULIM; unit += NGW) {
        int g, row0, ntok, seg = 0, bg; bool sample;
        if (unit < 8192) { seg = unit & 63; bg = unit >> 6; g = bg & 31; row0 = (bg >> 5) * 8192 + seg * 128; ntok = 128; sample = false; }
        else { bg = unit - 8192; g = bg & 31; row0 = TP + (bg >> 5) * 16; ntok = 16; sample = true; }
        S5Par q; s5_setup(a, g, lane, q);
        float xr = 0.f, xi = 0.f;
        if (sample) { xr = a.in[4][(size_t)bg * 64 + lane]; xi = a.in[5][(size_t)bg * 64 + lane]; }
        else {
            float pr = q.lr, pi = q.li;
#pragma unroll
            for (int s = 0; s < 7; ++s) { const float nr = pr * pr - pi * pi, ni = 2.f * pr * pi; pr = nr; pi = ni; }
            const float* e = E + (size_t)bg * 64 * 128;
            for (int s = 0; s < seg; ++s) { const float er = e[s * 128 + lane], ei = e[s * 128 + 64 + lane]; const float nr = pr * xr - pi * xi + er, ni = pr * xi + pi * xr + ei; xr = nr; xi = ni; }
        }
        bf16x8 cf[4];
#pragma unroll
        for (int ks = 0; ks < 4; ++ks) {
            const f32x4 cr = *(const f32x4*)(a.in[18] + (size_t)(g * 16 + fr) * 64 + 16 * ks + 4 * fq), ci = *(const f32x4*)(a.in[19] + (size_t)(g * 16 + fr) * 64 + 16 * ks + 4 * fq);
            u32x4 w; w.x = pk2(cr[0], -ci[0]); w.y = pk2(cr[1], -ci[1]); w.z = pk2(cr[2], -ci[2]); w.w = pk2(cr[3], -ci[3]);
            cf[ks] = __builtin_bit_cast(bf16x8, w);
        }
        const float Dg = a.in[20][g * 16 + fr];
        const bf16* up = P + (size_t)(row0 + (lane >> 4)) * PW + 2048 + g * 16 + (lane & 15);
        for (int tb = 0; tb < ntok; tb += 16) {
#pragma unroll
            for (int j4 = 0; j4 < 4; ++j4) {
                const float uv = b2f(up[(size_t)(tb + 4 * j4) * PW]);
                unsigned xo[4]; s5_step4(q, uv, xr, xi, xo);
#pragma unroll
                for (int j = 0; j < 4; ++j) *(unsigned*)(xs + (4 * j4 + j) * 272 + lane * 4) = xo[j];
            }
            f32x4 y = (f32x4){0.f, 0.f, 0.f, 0.f};
#pragma unroll
            for (int ks = 0; ks < 4; ++ks) { const bf16x8 af = *(const bf16x8*)(xs + fr * 272 + ks * 64 + fq * 16); y = MFMA16(af, cf[ks], y); }
#pragma unroll
            for (int i = 0; i < 4; ++i) {
                const size_t row = (size_t)row0 + tb + 4 * fq + i;
                const float uu = b2f(P[row * PW + 2048 + g * 16 + fr]);
                Y5[row * 512 + g * 16 + fr] = f2b(gelu_tanh(y[i] + Dg * uu));
            }
        }
        if (sample) { a.out[O_SSR + (size_t)bg * 64 + lane] = xr; a.out[O_SSI + (size_t)bg * 64 + lane] = xi; }
        else if (seg == 63) { a.out[O_PSR + (size_t)bg * 64 + lane] = xr; a.out[O_PSI + (size_t)bg * 64 + lane] = xi; }
    }
}

DI void s5_pass2b(const Args& a, unsigned char* xs, int gw, int NGW, int lane) {
    asm volatile("" : "+v"(lane));
    const bf16* P = (const bf16*)(a.ws + WS_P);
    const float* E = (const float*)(a.ws + WS_S5E);
    bf16* Y5 = (bf16*)(a.ws + WS_Y5);
    const int fr = lane & 15, fq = lane >> 4;
    for (int unit = gw; unit < 4 * 32 * 64 + 32 * 32; unit += NGW) {
        int g, row0, ntok, seg = 0, bg; bool sample;
        if (unit < 8192) { seg = unit & 63; bg = unit >> 6; g = bg & 31; row0 = (bg >> 5) * 8192 + seg * 128; ntok = 128; sample = false; }
        else { bg = unit - 8192; g = bg & 31; row0 = TP + (bg >> 5) * 16; ntok = 16; sample = true; }
        S5Par q; s5_setup(a, g, lane, q);
        float xr = 0.f, xi = 0.f;
        if (sample) { xr = a.in[4][(size_t)bg * 64 + lane]; xi = a.in[5][(size_t)bg * 64 + lane]; }
        else {
            float pr = q.lr, pi = q.li;
#pragma unroll
            for (int s = 0; s < 7; ++s) { const float nr = pr * pr - pi * pi, ni = 2.f * pr * pi; pr = nr; pi = ni; }
            const float* e = E + (size_t)bg * 64 * 128;
            for (int s = 0; s < seg; ++s) { const float er = e[s * 128 + lane], ei = e[s * 128 + 64 + lane]; const float nr = pr * xr - pi * xi + er, ni = pr * xi + pi * xr + ei; xr = nr; xi = ni; }
        }
        bf16x8 cf[4];
#pragma unroll
        for (int ks = 0; ks < 4; ++ks) {
            const f32x4 cr = *(const f32x4*)(a.in[18] + (size_t)(g * 16 + fr) * 64 + 16 * ks + 4 * fq), ci = *(const f32x4*)(a.in[19] + (size_t)(g * 16 + fr) * 64 + 16 * ks + 4 * fq);
            u32x4 w; w.x = pk2(cr[0], -ci[0]); w.y = pk2(cr[1], -ci[1]); w.z = pk2(cr[2], -ci[2]); w.w = pk2(cr[3], -ci[3]);
            cf[ks] = __builtin_bit_cast(bf16x8, w);
        }
        const float Dg = a.in[20][g * 16 + fr];
        S5W w; s5w_setup(a, g, fr, fq, w);
        unsigned char* bt = xs + 4352;
        for (int tb = 0; tb < ntok; tb += 16) {
            {
                u32x4 uv = (u32x4){0u, 0u, 0u, 0u};
                if (fq < 2) uv = *(const u32x4*)(P + (size_t)(row0 + tb + fr) * PW + 2048 + g * 16 + 8 * fq);
                const bf16x8 ua = __builtin_bit_cast(bf16x8, uv);
                const f32x4 z = (f32x4){0.f, 0.f, 0.f, 0.f};
#pragma unroll
                for (int j = 0; j < 4; ++j) {
                    const f32x4 br = MFMA16(ua, w.bf[j], z), bi = MFMA16(ua, w.bf[4 + j], z);
                    *(f32x4*)(bt + (16 * j + fr) * 80 + fq * 16) = br; *(f32x4*)(bt + (64 + 16 * j + fr) * 80 + fq * 16) = bi;
                }
            }
            asm volatile("s_waitcnt lgkmcnt(0)" ::: "memory");
            f32x4 bre[4], bim[4];
#pragma unroll
            for (int k = 0; k < 4; ++k) { bre[k] = *(const f32x4*)(bt + lane * 80 + k * 16); bim[k] = *(const f32x4*)(bt + (64 + lane) * 80 + k * 16); }
            asm volatile("s_waitcnt lgkmcnt(0)" ::: "memory");
#pragma unroll
            for (int t = 0; t < 16; ++t) {
                const float nr = q.lr * xr - q.li * xi + bre[t >> 2][t & 3], ni = q.lr * xi + q.li * xr + bim[t >> 2][t & 3];
                xr = nr; xi = ni;
                *(unsigned*)(xs + t * 272 + lane * 4) = pk2(nr, ni);
            }
            asm volatile("s_waitcnt lgkmcnt(0)" ::: "memory");
            f32x4 y = (f32x4){0.f, 0.f, 0.f, 0.f};
#pragma unroll
            for (int ks = 0; ks < 4; ++ks) { const bf16x8 af = *(const bf16x8*)(xs + fr * 272 + ks * 64 + fq * 16); y = MFMA16(af, cf[ks], y); }
#pragma unroll
            for (int i = 0; i < 4; ++i) {
                const size_t row = (size_t)row0 + tb + 4 * fq + i;
                const float uu = b2f(P[row * PW + 2048 + g * 16 + fr]);
                Y5[row * 512 + g * 16 + fr] = f2b(gelu_tanh(y[i] + Dg * uu));
            }
        }
        if (sample) { a.out[O_SSR + (size_t)bg * 64 + lane] = xr; a.out[O_SSI + (size_t)bg * 64 + lane] = xi; }
        else if (seg == 63) { a.out[O_PSR + (size_t)bg * 64 + lane] = xr; a.out[O_PSI + (size_t)bg * 64 + lane] = xi; }
    }
}

constexpr int DB_WN = 0, DB_QG = 17408, DB_KDT = 34816, DB_QK = 53248, DB_U0 = 62464;
constexpr int DBP_SIZE = DB_U0 + 64 * 80;
constexpr int DBS_SIZE = DB_U0 + 64 * 272;
template <int NC> struct DnRegs { u32x4 r[7]; u32x4 u[NC == 32 ? 1 : 2]; };
template <int NC> DI void dn_load(const unsigned char* rec, int tid, int c0, DnRegs<NC>& R) {
    const u32x4* g = (const u32x4*)rec;
    R.r[0] = g[tid]; R.r[1] = g[tid + 512]; R.r[2] = g[1024 + tid]; R.r[3] = g[1024 + tid + 512]; R.r[4] = g[2048 + tid]; R.r[5] = g[2048 + tid + 512]; R.r[6] = g[3072 + tid];
    if (NC == 32) { if (tid < 256) R.u[0] = *(const u32x4*)(rec + R_U0 + (tid >> 2) * 256 + c0 * 2 + (tid & 3) * 16); }
    else { R.u[0] = *(const u32x4*)(rec + R_U0 + tid * 16); R.u[1] = *(const u32x4*)(rec + R_U0 + (tid + 512) * 16); }
}
template <int NC> DI void dn_store(unsigned char* buf, int tid, const DnRegs<NC>& R) {
#pragma unroll
    for (int j = 0; j < 2; ++j) { const int q = tid + 512 * j;
        *(u32x4*)(buf + DB_WN + (q >> 4) * 272 + (q & 15) * 16) = R.r[j];
        *(u32x4*)(buf + DB_QG + (q >> 4) * 272 + (q & 15) * 16) = R.r[2 + j];
        *(u32x4*)(buf + DB_KDT + (q >> 3) * 144 + (q & 7) * 16) = R.r[4 + j]; }
    *(u32x4*)(buf + DB_QK + (tid >> 3) * 144 + (tid & 7) * 16) = R.r[6];
    if (NC == 32) { if (tid < 256) *(u32x4*)(buf + DB_U0 + (tid >> 2) * 80 + (tid & 3) * 16) = R.u[0]; }
    else {
#pragma unroll
        for (int j = 0; j < 2; ++j) { const int q = tid + 512 * j; *(u32x4*)(buf + DB_U0 + (q >> 4) * 272 + (q & 15) * 16) = R.u[j]; }
    }
}
DI bf16x8 pack8(const f32x4& lo, const f32x4& hi) { u32x4 w; w.x = pk2(lo[0], lo[1]); w.y = pk2(lo[2], lo[3]); w.z = pk2(hi[0], hi[1]); w.w = pk2(hi[2], hi[3]); return __builtin_bit_cast(bf16x8, w); }
template <int UPI> DI void dn_step(const unsigned char* buf, f32x4 (&S)[8], const unsigned char* u0, float eg, int fr, int fq, f32x4 (&o)[4]) {
    bf16x8 Sb[4];
#pragma unroll
    for (int ks = 0; ks < 4; ++ks) Sb[ks] = pack8(S[2 * ks], S[2 * ks + 1]);
    f32x4 u[4];
#pragma unroll
    for (int mt = 0; mt < 4; ++mt) {
#pragma unroll
        for (int i = 0; i < 4; ++i) u[mt][i] = b2f(*(const bf16*)(u0 + (16 * mt + 4 * fq + i) * UPI));
#pragma unroll
        for (int ks = 0; ks < 4; ++ks) u[mt] = MFMA16(*(const bf16x8*)(buf + DB_WN + (16 * mt + fr) * 272 + ks * 64 + fq * 16), Sb[ks], u[mt]);
    }
    bf16x8 ub[2];
#pragma unroll
    for (int k2 = 0; k2 < 2; ++k2) ub[k2] = pack8(u[2 * k2], u[2 * k2 + 1]);
#pragma unroll
    for (int mt = 0; mt < 4; ++mt) {
        o[mt] = (f32x4){0.f, 0.f, 0.f, 0.f};
#pragma unroll
        for (int ks = 0; ks < 4; ++ks) o[mt] = MFMA16(*(const bf16x8*)(buf + DB_QG + (16 * mt + fr) * 272 + ks * 64 + fq * 16), Sb[ks], o[mt]);
#pragma unroll
        for (int k2 = 0; k2 < 2; ++k2) o[mt] = MFMA16(*(const bf16x8*)(buf + DB_QK + (16 * mt + fr) * 144 + k2 * 64 + fq * 16), ub[k2], o[mt]);
    }
#pragma unroll
    for (int m8 = 0; m8 < 8; ++m8) {
        S[m8] = S[m8] * eg;
#pragma unroll
        for (int k2 = 0; k2 < 2; ++k2) S[m8] = MFMA16(*(const bf16x8*)(buf + DB_KDT + (16 * m8 + fr) * 144 + k2 * 64 + fq * 16), ub[k2], S[m8]);
    }
}
#if DN_STAGED == 2
#define DNP_SYNC() do { asm volatile("s_waitcnt lgkmcnt(0)" ::: "memory"); __builtin_amdgcn_sched_barrier(0); } while (0)
#else
#define DNP_SYNC() do { } while (0)
#endif
DI void dn_step_p(const unsigned char* buf, f32x4 (&S)[8], const unsigned char* u0, float eg, int fr, int fq, f32x4 (&o)[4]) {
    const unsigned char* aw = buf + DB_WN + fr * 272 + fq * 16;
    const unsigned char* aq = buf + DB_QG + fr * 272 + fq * 16;
    const unsigned char* ak = buf + DB_KDT + fr * 144 + fq * 16;
    const unsigned char* ac = buf + DB_QK + fr * 144 + fq * 16;
    bf16x8 f1[16], f2[16], Sb[4], ub[2];
    f32x4 u[4];
#pragma unroll
    for (int mt = 0; mt < 4; ++mt)
#pragma unroll
        for (int ks = 0; ks < 4; ++ks) f1[4 * mt + ks] = *(const bf16x8*)(aw + mt * 4352 + ks * 64);
#pragma unroll
    for (int mt = 0; mt < 4; ++mt)
#pragma unroll
        for (int i = 0; i < 4; ++i) u[mt][i] = b2f(*(const bf16*)(u0 + (16 * mt + 4 * fq + i) * 80));
#pragma unroll
    for (int ks = 0; ks < 4; ++ks) Sb[ks] = pack8(S[2 * ks], S[2 * ks + 1]);
    __builtin_amdgcn_sched_barrier(0);
#pragma unroll
    for (int mt = 0; mt < 4; ++mt)
#pragma unroll
        for (int ks = 0; ks < 4; ++ks) f2[4 * mt + ks] = *(const bf16x8*)(aq + mt * 4352 + ks * 64);
    DNP_SYNC();
#pragma unroll
    for (int ks = 0; ks < 4; ++ks)
#pragma unroll
        for (int mt = 0; mt < 4; ++mt) u[mt] = MFMA16(f1[4 * mt + ks], Sb[ks], u[mt]);
    __builtin_amdgcn_sched_barrier(0);
#pragma unroll
    for (int k2 = 0; k2 < 2; ++k2) ub[k2] = pack8(u[2 * k2], u[2 * k2 + 1]);
#pragma unroll
    for (int m8 = 0; m8 < 8; ++m8)
#pragma unroll
        for (int k2 = 0; k2 < 2; ++k2) f1[2 * m8 + k2] = *(const bf16x8*)(ak + m8 * 2304 + k2 * 64);
    DNP_SYNC();
#pragma unroll
    for (int mt = 0; mt < 4; ++mt) o[mt] = (f32x4){0.f, 0.f, 0.f, 0.f};
#pragma unroll
    for (int ks = 0; ks < 4; ++ks)
#pragma unroll
        for (int mt = 0; mt < 4; ++mt) o[mt] = MFMA16(f2[4 * mt + ks], Sb[ks], o[mt]);
    __builtin_amdgcn_sched_barrier(0);
#pragma unroll
    for (int mt = 0; mt < 4; ++mt)
#pragma unroll
        for (int k2 = 0; k2 < 2; ++k2) f2[2 * mt + k2] = *(const bf16x8*)(ac + mt * 2304 + k2 * 64);
    DNP_SYNC();
#pragma unroll
    for (int m8 = 0; m8 < 8; ++m8) S[m8] = S[m8] * eg;
#pragma unroll
    for (int k2 = 0; k2 < 2; ++k2)
#pragma unroll
        for (int m8 = 0; m8 < 8; ++m8) S[m8] = MFMA16(f1[2 * m8 + k2], ub[k2], S[m8]);
    __builtin_amdgcn_sched_barrier(0);
#pragma unroll
    for (int k2 = 0; k2 < 2; ++k2)
#pragma unroll
        for (int mt = 0; mt < 4; ++mt) o[mt] = MFMA16(f2[2 * mt + k2], ub[k2], o[mt]);
}
DI void dn_piece(int q, int c0, unsigned& src, unsigned& dst) {
    if (q < 1024) { src = R_WN + q * 16; dst = DB_WN + (q >> 4) * 272 + (q & 15) * 16; }
    else if (q < 2048) { const int p = q - 1024; src = R_QG + p * 16; dst = DB_QG + (p >> 4) * 272 + (p & 15) * 16; }
    else if (q < 3072) { const int p = q - 2048; src = R_KDT + p * 16; dst = DB_KDT + (p >> 3) * 144 + (p & 7) * 16; }
    else if (q < 3584) { const int p = q - 3072; src = R_QK + p * 16; dst = DB_QK + (p >> 3) * 144 + (p & 7) * 16; }
    else { const int p = q - 3584; src = R_U0 + (p >> 2) * 256 + c0 * 2 + (p & 3) * 16; dst = DB_U0 + (p >> 2) * 80 + (p & 3) * 16; }
}
#define DN_LD(R, base) do { _Pragma("unroll") for (int k = 0; k < 10; ++k) { unsigned s_, d_; dn_piece(lt + 384 * k, c0, s_, d_); R[k] = *(const u32x4*)((base) + s_); } } while (0)
#define DN_WAIT(R, cnt) do { } while (0)
#define DN_ST(R, buf) do { _Pragma("unroll") for (int k = 0; k < 10; ++k) { unsigned s_, d_; dn_piece(lt + 384 * k, c0, s_, d_); *(u32x4*)((buf) + d_) = R[k]; } } while (0)
#define DN_BAR() do { asm volatile("s_waitcnt lgkmcnt(0)" ::: "memory"); __builtin_amdgcn_s_barrier(); asm volatile("" ::: "memory"); } while (0)
DI void dn_scan_prompt(const Args& a, unsigned char* lds, int tid) {
    asm volatile("" : "+v"(tid));
    const int wave = __builtin_amdgcn_readfirstlane(tid >> 6), lane = tid & 63, fr = lane & 15, fq = lane >> 4;
    const int bh = blockIdx.x >> 2, qt = blockIdx.x & 3, b = bh >> 2, h = bh & 3;
    const int c0 = qt * 32, v0 = c0 + (wave & 1) * 16;
    const unsigned char* recs = a.ws + WS_DNC + (size_t)bh * 128 * REC;
    const float* egs = (const float*)(a.ws + WS_EG) + bh * 128;
    float* ORAW = (float*)(a.ws + WS_H);
    const bool loader = wave >= 2;
    const int lt = tid - 128;
    f32x4 S[8];
#pragma unroll
    for (int m8 = 0; m8 < 8; ++m8) S[m8] = (f32x4){0.f, 0.f, 0.f, 0.f};
    float egA = egs[lane], egB = egs[64 + lane];
    asm volatile("s_waitcnt vmcnt(0)" : "+v"(egA), "+v"(egB) :: "memory");
    if (loader) {
        const int grp = wave >= 5 ? 1 : 0, lt2 = tid - 128 - grp * 192;
        u32x4 R[20];
#define DN_LD20(base) do { _Pragma("unroll") for (int k = 0; k < 20; ++k) { unsigned s_, d_; dn_piece(lt2 + 192 * k, c0, s_, d_); R[k] = *(const u32x4*)((base) + s_); } } while (0)
#define DN_ST20(buf) do { _Pragma("unroll") for (int k = 0; k < 20; ++k) { unsigned s_, d_; dn_piece(lt2 + 192 * k, c0, s_, d_); *(u32x4*)((buf) + d_) = R[k]; } } while (0)
        if (grp == 0) { DN_LD20(recs); DN_ST20(lds); DN_LD20(recs + 2 * (size_t)REC); }
        else { DN_LD20(recs + REC); }
        DN_BAR();
        for (int n = 0; n < 128; n += 2) {
            if (grp == 1) { DN_ST20(lds + DBP_SIZE); if (n + 3 < 128) DN_LD20(recs + (size_t)(n + 3) * REC); }
            DN_BAR();
            if (grp == 0 && n + 2 < 128) { DN_ST20(lds); if (n + 4 < 128) DN_LD20(recs + (size_t)(n + 4) * REC); }
            DN_BAR();
        }
#undef DN_LD20
#undef DN_ST20
    } else {
        DN_BAR();
        for (int n = 0; n < 128; ++n) {
            const float eg0 = __int_as_float(__builtin_amdgcn_readlane(__float_as_int(n < 64 ? egA : egB), n & 63));
            f32x4 o[4];
#if DN_STAGED
            dn_step_p(lds + (n & 1) * DBP_SIZE, S, lds + (n & 1) * DBP_SIZE + DB_U0 + ((wave & 1) * 16 + fr) * 2, eg0, fr, fq, o);
#else
            dn_step<80>(lds + (n & 1) * DBP_SIZE, S, lds + (n & 1) * DBP_SIZE + DB_U0 + ((wave & 1) * 16 + fr) * 2, eg0, fr, fq, o);
#endif
            float* op = ORAW + (size_t)(b * 8192 + n * 64) * 512 + h * 128 + v0 + fr;
#pragma unroll
            for (int mt = 0; mt < 4; ++mt)
#pragma unroll
                for (int i = 0; i < 4; ++i) op[(size_t)(16 * mt + 4 * fq + i) * 512] = o[mt][i];
            DN_BAR();
        }
    }
    if (!loader) {
        float* so = a.out + O_PDS + (size_t)bh * 128 * 128 + v0 + fr;
#pragma unroll
        for (int m8 = 0; m8 < 8; ++m8)
#pragma unroll
            for (int i = 0; i < 4; ++i) so[(16 * m8 + 4 * fq + i) * 128] = S[m8][i];
    }
    __syncthreads();
}
DI void dn_scan_sample(const Args& a, unsigned char* lds, int tid, int wg, int nwg) {
    asm volatile("" : "+v"(tid));
    const int wave = __builtin_amdgcn_readfirstlane(tid >> 6), lane = tid & 63, fr = lane & 15, fq = lane >> 4;
    const int v0 = wave * 16;
    float* ORAW = (float*)(a.ws + WS_H);
    for (int su = wg; su < 128; su += nwg) {
        const int sb = su >> 2, h = su & 3;
        const unsigned char* rec = a.ws + WS_DNC + (size_t)(2048 + su) * REC;
        DnRegs<128> R; dn_load<128>(rec, tid, 0, R); dn_store<128>(lds, tid, R);
        __syncthreads();
        f32x4 S[8];
        const float* s0 = a.in[3] + (size_t)su * 128 * 128 + v0 + fr;
#pragma unroll
        for (int m8 = 0; m8 < 8; ++m8)
#pragma unroll
            for (int i = 0; i < 4; ++i) S[m8][i] = s0[(16 * m8 + 4 * fq + i) * 128];
        f32x4 o[4];
        dn_step<272>(lds, S, lds + DB_U0 + (v0 + fr) * 2, ((const float*)(a.ws + WS_EG))[2048 + su], fr, fq, o);
        float* op = ORAW + (size_t)(TP + sb * 16) * 512 + h * 128 + v0 + fr;
#pragma unroll
        for (int i = 0; i < 4; ++i) op[(size_t)(4 * fq + i) * 512] = o[0][i];
        float* so = a.out + O_SDS + (size_t)su * 128 * 128 + v0 + fr;
#pragma unroll
        for (int m8 = 0; m8 < 8; ++m8)
#pragma unroll
            for (int i = 0; i < 4; ++i) so[(16 * m8 + 4 * fq + i) * 128] = S[m8][i];
        __syncthreads();
    }
}

DI void mix_phase(const Args& a, int gw, int NGW, int lane) {
    asm volatile("" : "+v"(lane));
    const float* ORAW = (const float*)(a.ws + WS_H);
    const bf16* P = (const bf16*)(a.ws + WS_P);
    const bf16* GLU = (const bf16*)(a.ws + WS_GLU);
    bf16* MIX = (bf16*)(a.ws + WS_DNC);
    const f32x2 dg = *(const f32x2*)(a.in[12] + 2 * lane);
    const f32x4 sg0 = *(const f32x4*)(a.in[23] + 8 * lane), sg1 = *(const f32x4*)(a.in[23] + 8 * lane + 4);
    for (int row = gw; row < T; row += NGW) {
#pragma unroll
        for (int h = 0; h < 4; ++h) {
            const f32x2 ov = *(const f32x2*)(ORAW + (size_t)row * 512 + h * 128 + 2 * lane);
            const float r = rsqrtf(wave_sum(ov.x * ov.x + ov.y * ov.y) * (1.f / 128.f) + EPS);
            const unsigned zz = *(const unsigned*)(P + (size_t)row * PW + 1536 + h * 128 + 2 * lane);
            *(unsigned*)(MIX + (size_t)row * DM + h * 128 + 2 * lane) = pk2(ov.x * r * dg.x * silu(blo(zz)), ov.y * r * dg.y * silu(bhi(zz)));
        }
        const u32x4 gv = *(const u32x4*)(GLU + (size_t)row * 512 + 8 * lane);
        float v[8] = {blo(gv.x), bhi(gv.x), blo(gv.y), bhi(gv.y), blo(gv.z), bhi(gv.z), blo(gv.w), bhi(gv.w)};
        float ss = 0.f;
#pragma unroll
        for (int e = 0; e < 8; ++e) ss += v[e] * v[e];
        const float r5 = rsqrtf(wave_sum(ss) * (1.f / 512.f) + EPS);
        u32x4 w; w.x = pk2(v[0] * r5 * sg0[0], v[1] * r5 * sg0[1]); w.y = pk2(v[2] * r5 * sg0[2], v[3] * r5 * sg0[3]);
        w.z = pk2(v[4] * r5 * sg1[0], v[5] * r5 * sg1[1]); w.w = pk2(v[6] * r5 * sg1[2], v[7] * r5 * sg1[3]);
        *(u32x4*)(MIX + (size_t)row * DM + 512 + 8 * lane) = w;
    }
}

DI void act_phase(const Args& a, int gtid, int NT) {
    asm volatile("" : "+v"(gtid));
    bf16* UP = (bf16*)(a.ws + WS_UP);
    const float* fw = a.in[27]; const float* fb = a.in[28];
    constexpr int NCG = DFF / 8;
    for (int item = gtid; item < (T / 16) * NCG; item += NT) {
        const int cg8 = item % NCG, rb = item / NCG, col = cg8 * 8, row0 = rb * 16;
        float w0[8], w1[8], w2[8], bb[8], g2[8], g1[8];
#pragma unroll
        for (int e = 0; e < 8; ++e) { w0[e] = fw[col + e]; w1[e] = fw[DFF + col + e]; w2[e] = fw[2 * DFF + col + e]; bb[e] = fb[col + e]; g2[e] = 0.f; g1[e] = 0.f; }
        const bool sample = row0 >= TP;
        float* outp = nullptr;
        if (sample) { const int sb = (row0 - TP) >> 4; const float* cc = a.in[6] + (size_t)sb * 2 * DFF + col;
#pragma unroll
            for (int e = 0; e < 8; ++e) { g2[e] = cc[e]; g1[e] = cc[DFF + e]; }
            outp = a.out + O_SFC + (size_t)sb * 2 * DFF + col;
        } else {
            if ((rb & 511) != 0) {
                const u32x4 x2 = *(const u32x4*)(UP + (size_t)(row0 - 2) * UPW + col), x1 = *(const u32x4*)(UP + (size_t)(row0 - 1) * UPW + col);
                g2[0] = blo(x2.x); g2[1] = bhi(x2.x); g2[2] = blo(x2.y); g2[3] = bhi(x2.y); g2[4] = blo(x2.z); g2[5] = bhi(x2.z); g2[6] = blo(x2.w); g2[7] = bhi(x2.w);
                g1[0] = blo(x1.x); g1[1] = bhi(x1.x); g1[2] = blo(x1.y); g1[3] = bhi(x1.y); g1[4] = blo(x1.z); g1[5] = bhi(x1.z); g1[6] = blo(x1.w); g1[7] = bhi(x1.w);
            }
            if ((rb & 511) == 511) outp = a.out + O_PFC + (size_t)(rb >> 9) * 2 * DFF + col;
        }
#pragma unroll 4
        for (int r = 0; r < 16; ++r) {
            bf16* gp = UP + (size_t)(row0 + r) * UPW + col;
            const u32x4 xg = *(const u32x4*)gp, xv = *(const u32x4*)(gp + DFF);
            float g0[8] = {blo(xg.x), bhi(xg.x), blo(xg.y), bhi(xg.y), blo(xg.z), bhi(xg.z), blo(xg.w), bhi(xg.w)};
            float vv[8] = {blo(xv.x), bhi(xv.x), blo(xv.y), bhi(xv.y), blo(xv.z), bhi(xv.z), blo(xv.w), bhi(xv.w)};
            float o[8];
#pragma unroll
            for (int e = 0; e < 8; ++e) { o[e] = silu(g2[e] * w0[e] + g1[e] * w1[e] + g0[e] * w2[e] + bb[e]) * vv[e]; g2[e] = g1[e]; g1[e] = g0[e]; }
            u32x4 w; w.x = pk2(o[0], o[1]); w.y = pk2(o[2], o[3]); w.z = pk2(o[4], o[5]); w.w = pk2(o[6], o[7]);
            *(u32x4*)(gp + DFF) = w;
            if (outp && r >= 14) {
#pragma unroll
                for (int e = 0; e < 8; ++e) outp[(r - 14) * DFF + e] = g0[e];
            }
        }
    }
}

DI void act_fix_phase(const Args& a, int gtid, int NT) {
    asm volatile("" : "+v"(gtid));
    bf16* ACT = (bf16*)(a.ws + WS_UP);
    const bf16* GH = (const bf16*)(a.ws + WS_GH); const bf16* GT = (const bf16*)(a.ws + WS_GT); const bf16* VH = (const bf16*)(a.ws + WS_VH);
    const float* fw = a.in[27]; const float* fb = a.in[28];
    constexpr int NCG = DFF / 8;
    for (int item = gtid; item < (T / 16) * NCG; item += NT) {
        const int cg8 = item % NCG, grp = item / NCG, col = cg8 * 8;
        float w0[8], w1[8], w2[8], bb[8], g2[8], g1[8], h0[8], h1[8], v0[8], v1[8];
#pragma unroll
        for (int e = 0; e < 8; ++e) { w0[e] = fw[col + e]; w1[e] = fw[DFF + col + e]; w2[e] = fw[2 * DFF + col + e]; bb[e] = fb[col + e]; g2[e] = 0.f; g1[e] = 0.f; }
        const bool sample = grp >= TP / 16;
        if (sample) { const float* cc = a.in[6] + (size_t)(grp - TP / 16) * 2 * DFF + col;
#pragma unroll
            for (int e = 0; e < 8; ++e) { g2[e] = cc[e]; g1[e] = cc[DFF + e]; }
        } else if ((grp & 511) != 0) {
            const u32x4 x2 = *(const u32x4*)(GT + ((size_t)(grp - 1) * 2) * DFF + col), x1 = *(const u32x4*)(GT + ((size_t)(grp - 1) * 2 + 1) * DFF + col);
            g2[0] = blo(x2.x); g2[1] = bhi(x2.x); g2[2] = blo(x2.y); g2[3] = bhi(x2.y); g2[4] = blo(x2.z); g2[5] = bhi(x2.z); g2[6] = blo(x2.w); g2[7] = bhi(x2.w);
            g1[0] = blo(x1.x); g1[1] = bhi(x1.x); g1[2] = blo(x1.y); g1[3] = bhi(x1.y); g1[4] = blo(x1.z); g1[5] = bhi(x1.z); g1[6] = blo(x1.w); g1[7] = bhi(x1.w);
        }
        {
            const u32x4 xa = *(const u32x4*)(GH + ((size_t)grp * 2) * DFF + col), xb = *(const u32x4*)(GH + ((size_t)grp * 2 + 1) * DFF + col);
            const u32x4 ya = *(const u32x4*)(VH + ((size_t)grp * 2) * DFF + col), yb = *(const u32x4*)(VH + ((size_t)grp * 2 + 1) * DFF + col);
            h0[0] = blo(xa.x); h0[1] = bhi(xa.x); h0[2] = blo(xa.y); h0[3] = bhi(xa.y); h0[4] = blo(xa.z); h0[5] = bhi(xa.z); h0[6] = blo(xa.w); h0[7] = bhi(xa.w);
            h1[0] = blo(xb.x); h1[1] = bhi(xb.x); h1[2] = blo(xb.y); h1[3] = bhi(xb.y); h1[4] = blo(xb.z); h1[5] = bhi(xb.z); h1[6] = blo(xb.w); h1[7] = bhi(xb.w);
            v0[0] = blo(ya.x); v0[1] = bhi(ya.x); v0[2] = blo(ya.y); v0[3] = bhi(ya.y); v0[4] = blo(ya.z); v0[5] = bhi(ya.z); v0[6] = blo(ya.w); v0[7] = bhi(ya.w);
            v1[0] = blo(yb.x); v1[1] = bhi(yb.x); v1[2] = blo(yb.y); v1[3] = bhi(yb.y); v1[4] = blo(yb.z); v1[5] = bhi(yb.z); v1[6] = blo(yb.w); v1[7] = bhi(yb.w);
        }
        float o0[8], o1[8];
#pragma unroll
        for (int e = 0; e < 8; ++e) { o0[e] = silu(g2[e] * w0[e] + g1[e] * w1[e] + h0[e] * w2[e] + bb[e]) * v0[e]; o1[e] = silu(g1[e] * w0[e] + h0[e] * w1[e] + h1[e] * w2[e] + bb[e]) * v1[e]; }
        u32x4 wa, wb; wa.x = pk2(o0[0], o0[1]); wa.y = pk2(o0[2], o0[3]); wa.z = pk2(o0[4], o0[5]); wa.w = pk2(o0[6], o0[7]);
        wb.x = pk2(o1[0], o1[1]); wb.y = pk2(o1[2], o1[3]); wb.z = pk2(o1[4], o1[5]); wb.w = pk2(o1[6], o1[7]);
        *(u32x4*)(ACT + ((size_t)grp * 16) * DFF + col) = wa; *(u32x4*)(ACT + ((size_t)grp * 16 + 1) * DFF + col) = wb;
        float* outp = nullptr;
        if (sample) outp = a.out + O_SFC + (size_t)(grp - TP / 16) * 2 * DFF + col;
        else if ((grp & 511) == 511) outp = a.out + O_PFC + (size_t)(grp >> 9) * 2 * DFF + col;
        if (outp) {
            const u32x4 t0 = *(const u32x4*)(GT + ((size_t)grp * 2) * DFF + col), t1 = *(const u32x4*)(GT + ((size_t)grp * 2 + 1) * DFF + col);
            outp[0] = blo(t0.x); outp[1] = bhi(t0.x); outp[2] = blo(t0.y); outp[3] = bhi(t0.y); outp[4] = blo(t0.z); outp[5] = bhi(t0.z); outp[6] = blo(t0.w); outp[7] = bhi(t0.w);
            outp[DFF + 0] = blo(t1.x); outp[DFF + 1] = bhi(t1.x); outp[DFF + 2] = blo(t1.y); outp[DFF + 3] = bhi(t1.y); outp[DFF + 4] = blo(t1.z); outp[DFF + 5] = bhi(t1.z); outp[DFF + 6] = blo(t1.w); outp[DFF + 7] = bhi(t1.w);
        }
    }
}

DI void final_phase(const Args& a, int gw, int NGW, int lane) {
    asm volatile("" : "+v"(lane));
    f32x4 gv[4];
#pragma unroll
    for (int j = 0; j < 4; ++j) gv[j] = ((const f32x4*)a.in[30])[lane + 64 * j];
    for (int m0 = gw; m0 < T; m0 += 2 * NGW) {
        const int m1 = m0 + NGW < T ? m0 + NGW : m0;
        f32x4* xr0 = (f32x4*)(a.out + (size_t)m0 * DM) + lane; f32x4* xr1 = (f32x4*)(a.out + (size_t)m1 * DM) + lane;
        f32x4 v0[4], v1[4]; float s0 = 0.f, s1 = 0.f;
#pragma unroll
        for (int j = 0; j < 4; ++j) { v0[j] = xr0[64 * j]; v1[j] = xr1[64 * j]; }
#pragma unroll
        for (int j = 0; j < 4; ++j) { s0 += (v0[j].x * v0[j].x + v0[j].y * v0[j].y) + (v0[j].z * v0[j].z + v0[j].w * v0[j].w); s1 += (v1[j].x * v1[j].x + v1[j].y * v1[j].y) + (v1[j].z * v1[j].z + v1[j].w * v1[j].w); }
        const float r0 = rsqrtf(wave_sum(s0) * (1.f / DM) + EPS), r1 = rsqrtf(wave_sum(s1) * (1.f / DM) + EPS);
#pragma unroll
        for (int j = 0; j < 4; ++j) xr0[64 * j] = v0[j] * r0 * gv[j];
        if (m1 != m0) {
#pragma unroll
            for (int j = 0; j < 4; ++j) xr1[64 * j] = v1[j] * r1 * gv[j];
        }
    }
}

#ifndef PH_MASK
#define PH_MASK 0xffff
#endif
#ifndef SOLVE_RL
#define SOLVE_RL 1
#endif
#ifndef REP0
#define REP0 1
#endif
#ifndef REP1
#define REP1 1
#endif
#ifndef REP2A
#define REP2A 1
#endif
#ifndef REP2B
#define REP2B 1
#endif
#ifndef REP3A
#define REP3A 1
#endif
#ifndef REP3B
#define REP3B 1
#endif
#ifndef REP3C
#define REP3C 1
#endif
#ifndef PH_LO
#define PH_LO 0
#endif
#ifndef PH_HI
#define PH_HI 99
#endif
__global__ void __launch_bounds__(512, 2) fwd_kernel(Args a) {
    extern __shared__ __attribute__((aligned(16))) unsigned char lds[];
    cg::grid_group grid = cg::this_grid();
    const int tid = threadIdx.x, lane = tid & 63, wave = __builtin_amdgcn_readfirstlane(tid >> 6);
    const int G = gridDim.x, gw = blockIdx.x * 8 + wave, NGW = G * 8;
    unsigned char* ws = a.ws;
    PG8_LAS unsigned char* ldsg = (PG8_LAS unsigned char*)lds;

    _Pragma("nounroll") for (int rep = 0; rep < REP0; ++rep) { phase0(a, lds, gw, NGW, wave, lane); __syncthreads(); }
    grid.sync();
    _Pragma("nounroll") for (int rep = 0; rep < REP1; ++rep)
    { pg8::Gemm g{(const bf16*)(ws + WS_H), (const bf16*)(ws + WS_WIN), T, NIN, DM, DM}; pg8::StaticOrder S; S.init(T, NIN, G, (int)blockIdx.x);
      EpiP E{(bf16*)(ws + WS_P), (float*)(ws + WS_BA)};
      pg8::gemm_phase<EpiP, pg8::StaticOrder, true, true>(ldsg, g, S, E); }
    grid.sync();
    _Pragma("nounroll") for (int rep = 0; rep < REP2A; ++rep) dn_chunk_phase(a, lds, tid);
#if OLD_S5 && OLD_S5 != 4 && OLD_S5 != 5
    old_s5_pass1(a, gw, NGW, lane);
#elif 0
#else
    _Pragma("nounroll") for (int rep = 0; rep < REP2B; ++rep) s5_pass1(a, gw, NGW, lane);
#endif
    grid.sync();
#if OLD_S5 == 3
    if (blockIdx.x < 64) dn_scan_prompt(a, lds, tid);
    else { if (blockIdx.x >= 192) { dn_scan_sample(a, lds, tid, (int)blockIdx.x - 192, 64); s5_pass2_sample(a, lds + 81920 + wave * 4352, ((int)blockIdx.x - 192) * 8 + wave, 512, lane); __syncthreads(); }
           old_s5_pass2(a, lds + 81920 + wave * 4352, gw - 512, NGW - 512, lane); }
#elif OLD_S5 == 5
    if (blockIdx.x < 64) { _Pragma("nounroll") for (int rep = 0; rep < REP3A; ++rep) dn_scan_prompt(a, lds, tid); }
    else { if (blockIdx.x >= 192) dn_scan_sample(a, lds, tid, (int)blockIdx.x - 192, 64); _Pragma("nounroll") for (int rep = 0; rep < REP3B; ++rep) s5_pass2b(a, lds + wave * 14592, gw - 512, NGW - 512, lane); }
#elif OLD_S5 == 1 || OLD_S5 == 4
    if (blockIdx.x < 64) dn_scan_prompt(a, lds, tid);
    else { if (blockIdx.x >= 192) dn_scan_sample(a, lds, tid, (int)blockIdx.x - 192, 64); old_s5_pass2(a, lds + 81920 + wave * 4352, gw - 512, NGW - 512, lane); }
#else
    if (blockIdx.x < 64) { _Pragma("nounroll") for (int rep = 0; rep < REP3A; ++rep) dn_scan_prompt(a, lds, tid); }
    else if (blockIdx.x < 192) { _Pragma("nounroll") for (int rep = 0; rep < REP3B; ++rep) s5_pass2_prompt(a, lds, (int)blockIdx.x - 64, tid); }
    else { _Pragma("nounroll") for (int rep = 0; rep < REP3C; ++rep) { dn_scan_sample(a, lds, tid, (int)blockIdx.x - 192, 64); s5_pass2_sample(a, lds + 81920 + wave * 4352, ((int)blockIdx.x - 192) * 8 + wave, 512, lane); } }
#endif
    grid.sync();
#if PH_MASK & 512
    { pg8::Gemm g{(const bf16*)(ws + WS_Y5), (const bf16*)(ws + WS_WGLU), T, 1024, 512, 512}; pg8::StaticOrder S; S.init(T, 1024, G, (int)blockIdx.x);
      EpiGlu E{(bf16*)(ws + WS_GLU), a.in[22]};
      pg8::gemm_phase<EpiGlu, pg8::StaticOrder, true, true>(ldsg, g, S, E); }
#endif
    grid.sync();
#if PH_MASK & 32
    mix_phase(a, gw, NGW, lane);
#endif
    grid.sync();
#if PH_MASK & 1024
    { pg8::Gemm g{(const bf16*)(ws + WS_DNC), (const bf16*)(ws + WS_WOUT), T, DM, DM, DM}; pg8::StaticOrder S; S.init(T, DM, G, (int)blockIdx.x);
      EpiX1 E{a.in[0], a.in[1], a.out, (bf16*)(ws + WS_H), (float*)(ws + WS_SS2)};
      pg8::gemm_phase<EpiX1, pg8::StaticOrder, true, true>(ldsg, g, S, E); }
#endif
    grid.sync();
#if FUSE_ACT
    { pg8::Gemm g{(const bf16*)(ws + WS_H), (const bf16*)(ws + WS_WUP), T, UPW, DM, DM}; pg8::StaticOrder S; S.init(T, UPW, G, (int)blockIdx.x);
      EpiUpAct E{(bf16*)(ws + WS_UP), (bf16*)(ws + WS_GH), (bf16*)(ws + WS_GT), (bf16*)(ws + WS_VH), (const float*)(ws + WS_SS2), a.in[27], a.in[28]};
      pg8::gemm_phase<EpiUpAct, pg8::StaticOrder, true, true>(ldsg, g, S, E); }
    grid.sync();
    act_fix_phase(a, (int)blockIdx.x * 512 + tid, G * 512);
    grid.sync();
    { pg8::Gemm g{(const bf16*)(ws + WS_UP), (const bf16*)(ws + WS_WDOWN), T, DM, DFF, DFF}; pg8::StaticOrder S; S.init(T, DM, G, (int)blockIdx.x);
      EpiX2 E{a.out};
      pg8::gemm_phase<EpiX2, pg8::StaticOrder, true, true>(ldsg, g, S, E); }
    grid.sync();
#else
#if PH_MASK & 2048
    { pg8::Gemm g{(const bf16*)(ws + WS_H), (const bf16*)(ws + WS_WUP), T, UPW, DM, DM}; pg8::StaticOrder S; S.init(T, UPW, G, (int)blockIdx.x);
      EpiUp E{(bf16*)(ws + WS_UP), (const float*)(ws + WS_SS2)};
      pg8::gemm_phase<EpiUp, pg8::StaticOrder, true, true>(ldsg, g, S, E); }
#endif
    grid.sync();
#if PH_MASK & 64
    act_phase(a, (int)blockIdx.x * 512 + tid, G * 512);
#endif
    grid.sync();
#if PH_MASK & 4096
    { pg8::Gemm g{(const bf16*)(ws + WS_UP) + DFF, (const bf16*)(ws + WS_WDOWN), T, DM, DFF, UPW}; pg8::StaticOrder S; S.init(T, DM, G, (int)blockIdx.x);
      EpiX2 E{a.out};
      pg8::gemm_phase<EpiX2, pg8::StaticOrder, true, true>(ldsg, g, S, E); }
#endif
    grid.sync();
#endif
#if PH_MASK & 128
    final_phase(a, gw, NGW, lane);
#endif
}

extern "C" void kernel_launch(void* const* d_in, const int* in_sizes, int n_in, void* d_out, int out_size, void* d_ws, size_t ws_size, hipStream_t stream) {
    static int grid = 0;
    if (grid == 0) {
        if (n_in != 31 || (size_t)out_size != O_END || ws_size < WS_END) { fprintf(stderr, "kernel_launch: unexpected shapes n_in %d out %d ws %zu\n", n_in, out_size, ws_size); grid = -1; return; }
        int dev = 0, cus = 0, per_cu = 0;
        hipGetDevice(&dev);
        hipDeviceGetAttribute(&cus, hipDeviceAttributeMultiprocessorCount, dev);
        hipFuncSetAttribute((const void*)fwd_kernel, hipFuncAttributeMaxDynamicSharedMemorySize, LDS_BYTES);
        hipOccupancyMaxActiveBlocksPerMultiprocessor(&per_cu, (const void*)fwd_kernel, 512, LDS_BYTES);
        if (per_cu < 1) { fprintf(stderr, "kernel_launch: occupancy query says %d blocks per CU\n", per_cu); per_cu = 1; }
        grid = cus * 1;
        if (grid != 256) { fprintf(stderr, "kernel_launch: built for a 256-CU device, got %d\n", cus); grid = -1; return; }
        (void)hipGetLastError();
    }
    if (grid < 0) return;
    Args a{};
    for (int i = 0; i < 31; ++i) a.in[i] = (const float*)d_in[i];
    a.out = (float*)d_out; a.ws = (unsigned char*)d_ws;
    void* args[] = {&a};
    hipError_t e = hipLaunchCooperativeKernel((const void*)fwd_kernel, dim3(grid), dim3(512), args, LDS_BYTES, stream);
    if (e != hipSuccess) fprintf(stderr, "cooperative launch failed: %s (grid %d)\n", hipGetErrorString(e), grid);
}
```

```cpp
#include <hip/hip_runtime.h>
#include <hip/hip_cooperative_groups.h>
#include <cstdio>
#include <cstdint>
namespace cg = cooperative_groups;
#define OLD_S5 5
#define DN_STAGED 2
namespace pg8 {
#define PG8_LAS __attribute__((address_space(3)))
typedef unsigned short bf16_t;
typedef short bf16x8 __attribute__((ext_vector_type(8)));
typedef float f32x4 __attribute__((ext_vector_type(4)));
typedef unsigned u32x4 __attribute__((ext_vector_type(4)));
constexpr int BM = 256, BK = 64, HALF = 128, HTB = HALF * BK * 2  , STAGE_BYTES = 8 * HTB, NXCD = 8, WGM = 8;

__host__ __device__ __forceinline__ int lds_byte(int r, int c) { const int st = (r >> 4) * 2 + (c >> 5), rr = r & 15, cc = c & 31, ob = rr * 64 + cc * 2; return st * 1024 + (ob ^ (((ob >> 9) & 1) << 5)); }
__host__ __device__ __forceinline__ void stage_rc(int b, int& R, int& C) { const int st = b / 1024, sb = b % 1024, swz = sb ^ (((sb >> 9) & 1) << 5); R = (st >> 1) * 16 + swz / 64; C = (st & 1) * 32 + (swz % 64) / 2; }
__host__ __device__ __forceinline__ int perm32(int rho) { const int n = rho >> 4, i = rho & 15; return 8 * (i >> 2) + 4 * n + (i & 3); }

struct Unit { int pm, pn; };
struct Gemm { const bf16_t* A; const bf16_t* Bt; int M, N, K, lda; };

struct StaticOrder {
    int nM, nN, nwg, G, c;
    __host__ __device__ void init(int M, int N, int G_, int c_) { nM = M / BM; nN = N / BM; nwg = nM * nN; G = G_; c = c_; }
    __host__ __device__ bool next(int i, Unit& u) const {
        const long L = (long)i * G + c; if (L >= nwg) return false;
        int wgid = (int)L; { const int q = nwg / NXCD, r = nwg % NXCD, xcd = wgid % NXCD, off = wgid / NXCD; wgid = (xcd < r ? xcd * (q + 1) : r * (q + 1) + (xcd - r) * q) + off; }
        const int nig = WGM * nN, gid = wgid / nig, fm = gid * WGM, gsz = (nM - fm) < WGM ? (nM - fm) : WGM;
        u.pm = fm + ((wgid % nig) % gsz); u.pn = (wgid % nig) / gsz; return true;
    }
    __device__ __forceinline__ void a_ready(const Unit&) const {}
    __device__ __forceinline__ void done(const Unit&) const {}
};
__device__ __forceinline__ unsigned cvt_pk_bf16(float lo, float hi) { unsigned r; asm volatile("v_cvt_pk_bf16_f32 %0, %1, %2" : "=v"(r) : "v"(lo), "v"(hi)); return r; }
typedef float f32x2 __attribute__((ext_vector_type(2)));
template <class Epi, class Sched, bool ALIGN_EPI = false, bool SP2 = false>
__device__ __forceinline__ void gemm_phase(PG8_LAS unsigned char* lds, const Gemm g, const Sched& S, const Epi& E) {
    int tid_ = threadIdx.x; asm volatile("" : "+v"(tid_));
    const int tid = tid_, wid = __builtin_amdgcn_readfirstlane(tid >> 6), lane = tid & 63, wr = wid >> 2, wc = wid & 3, fr = lane & 15, fq = lane >> 4;
    const int K = g.K, nt = K / BK;
    unsigned voffA[2], voffB[2];
#pragma unroll
    for (int i = 0; i < 2; ++i) { int R, C; stage_rc(tid * 16 + i * 8192, R, C); const int Rb = Epi::PERM ? ((R & ~31) + perm32(R & 31)) : R;
        voffA[i] = (unsigned)(R * g.lda + C) * 2u; voffB[i] = (unsigned)(Rb * K + C) * 2u; }
    const size_t kstep = (size_t)(BK * 2);
    const size_t hstep = (size_t)HALF * K * 2;
    const size_t tstep = 2 * hstep; const size_t hstepA = (size_t)HALF * g.lda * 2, tstepA = 2 * hstepA;
    const unsigned ldsw = (unsigned)wid * 1024u;
    const int aoff = lds_byte(wr * 64 + fr, fq * 8), boff = lds_byte(wc * 32 + fr, fq * 8);
#define PG8_SA(b, h) (((b) * 2 + (h)) * HTB)
#define PG8_SB(b, h) ((4 + (b) * 2 + (h)) * HTB)
#define PG8_STAGE(bufoff, gbase, voff) do { _Pragma("unroll") for (int _i = 0; _i < 2; ++_i) \
        __builtin_amdgcn_global_load_lds((const unsigned*)((const char*)(gbase) + (voff)[_i]), (PG8_LAS unsigned*)(lds + (bufoff) + ldsw + _i * 8192), 16, 0, 0); } while (0)
#define PG8_LDA(dst, b, h) do { _Pragma("unroll") for (int m = 0; m < 4; ++m) _Pragma("unroll") for (int k = 0; k < 2; ++k) dst[m][k] = *(const PG8_LAS bf16x8*)(lds + PG8_SA(b, h) + aoff + m * 2048 + k * 1024); } while (0)
#define PG8_LDB(dst, b, h) do { _Pragma("unroll") for (int n = 0; n < 2; ++n) _Pragma("unroll") for (int k = 0; k < 2; ++k) dst[n][k] = *(const PG8_LAS bf16x8*)(lds + PG8_SB(b, h) + boff + n * 2048 + k * 1024); } while (0)
#define PG8_MMA(ai, bj, At, Bt) do { __builtin_amdgcn_s_setprio(1); _Pragma("unroll") for (int m = 0; m < 4; ++m) _Pragma("unroll") for (int n = 0; n < 2; ++n) _Pragma("unroll") for (int k = 0; k < 2; ++k) \
        acc[ai][bj][m][n] = __builtin_amdgcn_mfma_f32_16x16x32_bf16(Bt[n][k], At[m][k], acc[ai][bj][m][n], 0, 0, 0); __builtin_amdgcn_s_setprio(0); } while (0)
#define PG8_WAIT_V(n) asm volatile("s_waitcnt vmcnt(" #n ")" ::: "memory")
#define PG8_WAIT_L(n) asm volatile("s_waitcnt lgkmcnt(" #n ")" ::: "memory")
#define PG8_BAR __builtin_amdgcn_s_barrier()
#define PG8_SCHED __builtin_amdgcn_sched_barrier(0)
    Unit cur, nxt; int ui = 0;
    if (!S.next(0, cur)) return;
    f32x4 acc[2][2][4][2];
#pragma unroll
    for (int a = 0; a < 2; ++a)
#pragma unroll
        for (int b = 0; b < 2; ++b)
#pragma unroll
            for (int m = 0; m < 4; ++m)
#pragma unroll
                for (int n = 0; n < 2; ++n) acc[a][b][m][n] = (f32x4){0.f, 0.f, 0.f, 0.f};
    bf16x8 At[4][2], B0[2][2], B1[2][2];
    const char* cA = (const char*)g.A + (size_t)cur.pm * tstepA; const char* cB = (const char*)g.Bt + (size_t)cur.pn * tstep;
    S.a_ready(cur);
    if constexpr (SP2) {
        PG8_STAGE(PG8_SB(0, 0), cB, voffB); PG8_STAGE(PG8_SB(0, 1), cB + hstep, voffB); PG8_STAGE(PG8_SA(0, 0), cA, voffA); PG8_STAGE(PG8_SA(0, 1), cA + hstepA, voffA);
        if (wr == 1) PG8_BAR;
        PG8_WAIT_V(2); PG8_BAR;
        PG8_STAGE(PG8_SB(1, 0), cB + kstep, voffB); PG8_STAGE(PG8_SA(1, 0), cA + kstep, voffA); PG8_STAGE(PG8_SB(1, 1), cB + hstep + kstep, voffB);
        PG8_WAIT_V(6); PG8_BAR;
    } else {
        PG8_STAGE(PG8_SB(0, 0), cB, voffB); PG8_STAGE(PG8_SA(0, 0), cA, voffA); PG8_STAGE(PG8_SB(0, 1), cB + hstep, voffB); PG8_STAGE(PG8_SA(0, 1), cA + hstepA, voffA);
        if (wr == 1) PG8_BAR;
        PG8_WAIT_V(4); PG8_BAR;
        PG8_STAGE(PG8_SB(1, 0), cB + kstep, voffB); PG8_STAGE(PG8_SA(1, 0), cA + kstep, voffA); PG8_STAGE(PG8_SB(1, 1), cB + hstep + kstep, voffB);
        PG8_WAIT_V(6); PG8_BAR;
    }
    for (;;) {
        const bool has_next = S.next(ui + 1, nxt);
        const char* nA = has_next ? (const char*)g.A + (size_t)nxt.pm * tstepA : cA; const char* nB = has_next ? (const char*)g.Bt + (size_t)nxt.pn * tstep : cB;
        for (int t = 0; t < nt; t += 2) {
            const bool last = (t == nt - 2);
            const char* a1 = cA + (size_t)(t + 1) * kstep;
            const char* a2 = last ? nA : cA + (size_t)(t + 2) * kstep; const char* b2 = last ? nB : cB + (size_t)(t + 2) * kstep;
            const char* a3 = a2 + kstep; const char* b3 = b2 + kstep;
            if (last && has_next) S.a_ready(nxt);
            if constexpr (SP2) {
            PG8_LDB(B0, 0, 0); PG8_LDB(B1, 0, 1); PG8_SCHED; PG8_LDA(At, 0, 0); PG8_STAGE(PG8_SA(1, 1), a1 + hstepA, voffA);
            PG8_WAIT_V(8); PG8_WAIT_L(0); PG8_BAR; PG8_MMA(0, 0, At, B0); PG8_MMA(0, 1, At, B1); PG8_BAR; PG8_SCHED;
            PG8_LDA(At, 0, 1); PG8_STAGE(PG8_SB(0, 0), b2, voffB); PG8_STAGE(PG8_SB(0, 1), b2 + hstep, voffB); PG8_STAGE(PG8_SA(0, 0), a2, voffA);
            PG8_WAIT_V(8); PG8_WAIT_L(0); PG8_BAR; PG8_MMA(1, 0, At, B0); PG8_MMA(1, 1, At, B1); PG8_BAR; PG8_SCHED;
            PG8_LDB(B0, 1, 0); PG8_LDB(B1, 1, 1); PG8_SCHED; PG8_LDA(At, 1, 0); PG8_STAGE(PG8_SA(0, 1), a2 + hstepA, voffA);
            PG8_WAIT_V(8); PG8_WAIT_L(0); PG8_BAR; PG8_MMA(0, 0, At, B0); PG8_MMA(0, 1, At, B1); PG8_BAR; PG8_SCHED;
            PG8_LDA(At, 1, 1); PG8_STAGE(PG8_SB(1, 0), b3, voffB); PG8_STAGE(PG8_SB(1, 1), b3 + hstep, voffB); PG8_STAGE(PG8_SA(1, 0), a3, voffA);
            PG8_WAIT_V(8); PG8_WAIT_L(0); PG8_BAR; PG8_MMA(1, 0, At, B0); PG8_MMA(1, 1, At, B1); PG8_BAR; PG8_SCHED;
            } else {
            PG8_LDB(B0, 0, 0); PG8_SCHED; PG8_LDA(At, 0, 0); PG8_STAGE(PG8_SA(1, 1), a1 + hstepA, voffA);
            PG8_WAIT_L(8); PG8_BAR; PG8_WAIT_L(0); PG8_MMA(0, 0, At, B0); PG8_BAR; PG8_SCHED;
            PG8_LDB(B1, 0, 1); PG8_STAGE(PG8_SB(0, 0), b2, voffB);
            PG8_BAR; PG8_WAIT_L(0); PG8_MMA(0, 1, At, B1); PG8_BAR;
            PG8_LDA(At, 0, 1); PG8_STAGE(PG8_SA(0, 0), a2, voffA);
            PG8_BAR; PG8_WAIT_L(0); PG8_MMA(1, 0, At, B0); PG8_BAR; PG8_SCHED;
            PG8_STAGE(PG8_SB(0, 1), b2 + hstep, voffB);
            PG8_WAIT_V(6); PG8_BAR; PG8_MMA(1, 1, At, B1); PG8_BAR;
            PG8_LDB(B0, 1, 0); PG8_SCHED; PG8_LDA(At, 1, 0); PG8_STAGE(PG8_SA(0, 1), a2 + hstepA, voffA);
            PG8_WAIT_L(8); PG8_BAR; PG8_WAIT_L(0); PG8_MMA(0, 0, At, B0); PG8_BAR; PG8_SCHED;
            PG8_LDB(B1, 1, 1); PG8_STAGE(PG8_SB(1, 0), b3, voffB);
            PG8_BAR; PG8_WAIT_L(0); PG8_MMA(0, 1, At, B1); PG8_BAR;
            PG8_LDA(At, 1, 1); PG8_STAGE(PG8_SA(1, 0), a3, voffA);
            PG8_BAR; PG8_WAIT_L(0); PG8_MMA(1, 0, At, B0); PG8_BAR; PG8_SCHED;
            PG8_STAGE(PG8_SB(1, 1), b3 + hstep, voffB);
            PG8_WAIT_V(6); PG8_BAR; PG8_MMA(1, 1, At, B1); PG8_BAR;
            }
        }
        if constexpr (ALIGN_EPI) { if (wr == 0) PG8_BAR; }
        if constexpr (!Epi::AFTER_DRAIN) { E(acc, cur, wr, wc, fr, fq); S.done(cur); }
        if (!has_next) break;
#pragma unroll
        for (int a = 0; a < 2; ++a)
#pragma unroll
            for (int b = 0; b < 2; ++b)
#pragma unroll
                for (int m = 0; m < 4; ++m)
#pragma unroll
                    for (int n = 0; n < 2; ++n) acc[a][b][m][n] = (f32x4){0.f, 0.f, 0.f, 0.f};
        cur = nxt; cA = nA; cB = nB; ++ui;
        if constexpr (ALIGN_EPI) { if (wr == 1) PG8_BAR; }
    }
    PG8_WAIT_V(0);
    if constexpr (!ALIGN_EPI) { if (wr == 0) PG8_BAR; }
    PG8_BAR;
    if constexpr (Epi::AFTER_DRAIN) { E.fused(acc, cur, wr, wc, fr, fq, lds, wid, lane); S.done(cur); }
#undef PG8_SA
#undef PG8_SB
#undef PG8_STAGE
#undef PG8_LDA
#undef PG8_LDB
#undef PG8_MMA
#undef PG8_WAIT_V
#undef PG8_WAIT_L
#undef PG8_BAR
#undef PG8_SCHED
}
}
#define LAS __attribute__((address_space(3)))
#define XB_TMO      128
#define XB_XCNT(j)  (256  + 64 * (j))
#define XB_XSUB(j)  (1280 + 64 * (j))
#define XB_XGEN(j)  (2304 + 64 * (j))
#define XB_TOP      3328
#define XB_TOPGEN   3392
#define XCD_BAR_WORDS 3456
#define XB_SPIN_CAP (1u << 18)

__device__ __forceinline__ unsigned xb_ld(unsigned* p)              { return __hip_atomic_load(p, __ATOMIC_RELAXED, __HIP_MEMORY_SCOPE_AGENT); }
__device__ __forceinline__ unsigned xb_add(unsigned* p, unsigned v) { return __hip_atomic_fetch_add(p, v, __ATOMIC_RELAXED, __HIP_MEMORY_SCOPE_AGENT); }
__device__ __forceinline__ unsigned xb_xcc_id() { return (unsigned)__builtin_amdgcn_s_getreg((3 << 11) | 20) & 0xFu; }
#define XB_SPIN(cond, bar) do { unsigned _sp = 0; while (cond) { __builtin_amdgcn_s_sleep(1); \
    if ((++_sp & 255u) == 0u) { if (xb_ld(&(bar)[XB_TMO])) break; if (_sp > XB_SPIN_CAP) { atomicAdd(&(bar)[XB_TMO], 1u); break; } } } } while (0)

struct XcdBarrier {
    unsigned* bar; unsigned x;
    volatile LAS unsigned* st;
};

__device__ __forceinline__ XcdBarrier xcd_barrier_post(unsigned* bar, volatile LAS unsigned* st) {
    XcdBarrier b; b.bar = bar; b.x = xb_xcc_id(); b.st = st;
    if (threadIdx.x == 0) (void)xb_add(&bar[XB_XCNT(b.x)], 1u);
    return b;
}
__device__ __forceinline__ void xcd_barrier_complete(unsigned* bar, unsigned x, unsigned& nloc, unsigned& nx) {
    const unsigned G = gridDim.x * gridDim.y * gridDim.z;
    unsigned sum, cnt, mine, sp = 0u;
    for (;;) {
        sum = 0u; cnt = 0u; mine = 0u;
#pragma unroll
        for (unsigned j = 0; j < 16; ++j) { const unsigned c = xb_ld(&bar[XB_XCNT(j)]); sum += c; cnt += (c > 0u) ? 1u : 0u; mine = (j == x) ? c : mine; }
        if (sum == G) break;
        __builtin_amdgcn_s_sleep(1);
        if ((++sp & 255u) == 0u) { if (xb_ld(&bar[XB_TMO])) break; if (sp > XB_SPIN_CAP) { atomicAdd(&bar[XB_TMO], 1u); break; } }
    }
    nloc = mine > 0u ? mine : 1u; nx = cnt > 0u ? cnt : 1u;
}

__device__ __forceinline__ void xcd_barrier(const XcdBarrier& b) {
    asm volatile("s_waitcnt vmcnt(0)" ::: "memory");
    __syncthreads();
    if (threadIdx.x == 0) {
        unsigned* bar = b.bar;
        __builtin_amdgcn_s_waitcnt(0);
        unsigned nloc = b.st[0], nx = b.st[1];
        if (nloc == 0u) { xcd_barrier_complete(bar, b.x, nloc, nx); b.st[0] = nloc; b.st[1] = nx; }
        const unsigned old = xb_add(&bar[XB_XSUB(b.x)], 1u);
        const unsigned gen = old / nloc;
        if (old + 1u == (gen + 1u) * nloc) {
            __builtin_amdgcn_fence(__ATOMIC_RELEASE, "agent");
            asm volatile("s_waitcnt vmcnt(0)" ::: "memory");
            const unsigned og = xb_add(&bar[XB_TOP], 1u);
            const unsigned tg = og / nx;
            if (og + 1u == (tg + 1u) * nx) xb_add(&bar[XB_TOPGEN], 1u);
            else XB_SPIN(xb_ld(&bar[XB_TOPGEN]) == tg, bar);
            __builtin_amdgcn_fence(__ATOMIC_ACQUIRE, "agent");
            xb_add(&bar[XB_XGEN(b.x)], 1u);
            asm volatile("s_waitcnt vmcnt(0)" ::: "memory");
        } else {
            XB_SPIN(xb_ld(&bar[XB_XGEN(b.x)]) == gen, bar);
            __builtin_amdgcn_fence(__ATOMIC_ACQUIRE, "agent");
            asm volatile("s_waitcnt vmcnt(0)" ::: "memory");
        }
    }
    __syncthreads();
}


#ifndef FUSE_ACT
#define FUSE_ACT 1
#endif
#ifndef DN_STAGED
#define DN_STAGED 1
#endif
#ifndef DIAG_Y
#define DIAG_Y 0
#endif
#ifndef OLD_S5
#define OLD_S5 0
#endif
#if OLD_S5 == 3
#define OLD_S5_ULIM 8192
#else
#define OLD_S5_ULIM (4 * 32 * 64 + 32 * 32)
#endif
#define DI __device__ __forceinline__
typedef unsigned short bf16;
typedef float f32x4 __attribute__((ext_vector_type(4)));
typedef float f32x2 __attribute__((ext_vector_type(2)));
typedef short bf16x8 __attribute__((ext_vector_type(8)));
typedef unsigned u32x4 __attribute__((ext_vector_type(4)));
typedef unsigned u32x2 __attribute__((ext_vector_type(2)));
typedef __bf16 bf16x2_t __attribute__((ext_vector_type(2)));

DI unsigned pk2(float lo, float hi) { f32x2 v = {lo, hi}; bf16x2_t b = __builtin_convertvector(v, bf16x2_t); return __builtin_bit_cast(unsigned, b); }
DI bf16 f2b(float x) { return (bf16)(pk2(x, 0.f) & 0xffffu); }
DI float b2f(unsigned b) { return __uint_as_float(b << 16); }
DI float blo(unsigned w) { return __uint_as_float(w << 16); }
DI float bhi(unsigned w) { return __uint_as_float(w & 0xffff0000u); }
DI float wave_sum(float v) {
#pragma unroll
    for (int o = 1; o < 64; o <<= 1) v += __shfl_xor(v, o);
    return v;
}
DI float sigm(float x) { return 1.f / (1.f + __expf(-x)); }
DI float silu(float x) { return x / (1.f + __expf(-x)); }
DI float gelu_tanh(float x) { const float z = 1.5957691216057308f * (x + 0.044715f * x * x * x); return x / (1.f + __expf(-z)); }
#define MFMA16(a, b, c) __builtin_amdgcn_mfma_f32_16x16x32_bf16((a), (b), (c), 0, 0, 0)

constexpr int TP = 32768, TS = 512, T = TP + TS;
constexpr int DM = 1024, PW = 2560, NIN = 2816, DFF = 2816, UPW = 5632;
constexpr float EPS = 1e-6f;
constexpr int NCH = 2048 + 128;
constexpr int REC = 73728;
constexpr int R_WN = 0, R_QG = 16384, R_KDT = 32768, R_QK = 49152, R_U0 = 57344;
constexpr size_t O_Y = 0, O_PDC = (size_t)T * DM, O_PDS = O_PDC + 4 * 3 * 1536, O_PSR = O_PDS + 4 * 4 * 128 * 128, O_PSI = O_PSR + 4 * 32 * 64,
                 O_PFC = O_PSI + 4 * 32 * 64, O_SDC = O_PFC + 4 * 2 * 2816, O_SDS = O_SDC + 32 * 3 * 1536, O_SSR = O_SDS + (size_t)32 * 4 * 128 * 128,
                 O_SSI = O_SSR + 32 * 32 * 64, O_SFC = O_SSI + 32 * 32 * 64, O_END = O_SFC + 32 * 2 * 2816;
constexpr size_t MiB = 1u << 20;
constexpr size_t WS_SS2 = 0;
constexpr size_t WS_EG = 3 * MiB;
constexpr size_t WS_CTL = 5 * MiB + 512 * 1024;
constexpr size_t WS_BA = 4 * MiB;
constexpr size_t WS_WIN = 6 * MiB, WS_WGLU = 12 * MiB, WS_WOUT = 13 * MiB, WS_WUP = 15 * MiB, WS_WDOWN = 26 * MiB;
constexpr size_t WS_H = 32 * MiB;
constexpr size_t WS_P = 98 * MiB;
constexpr size_t WS_DNC = 262 * MiB;
constexpr size_t WS_Y5 = 416 * MiB, WS_GLU = 449 * MiB, WS_S5E = 482 * MiB, WS_END = 487 * MiB;
constexpr size_t WS_GH = 300 * MiB, WS_GT = 324 * MiB, WS_VH = 348 * MiB;
constexpr size_t WS_UP = 98 * MiB;
static_assert(WS_UP + (size_t)T * UPW * 2 <= WS_END && WS_P + (size_t)T * PW * 2 <= WS_DNC && WS_DNC + (size_t)NCH * REC <= WS_Y5, "ws map");
constexpr int LDS_BYTES = 147456;

struct Args { const float* in[31]; float* out; unsigned char* ws; };

DI int colmap(int mode, int n) {
    if (mode == 0) return n;
    if (mode == 1) return n < 2048 ? n : (n < 2560 ? n + 8 : (n < 2568 ? n - 512 : -1));
    const int pn = n >> 8, bj = (n >> 7) & 1, j = n & 127;
    return bj * (mode == 2 ? 512 : 2816) + 128 * pn + j;
}
DI void transpose_item(const float* W, int K, int N, bf16* WT, float* scr, int kb, int nb, int lane, int mode, const float* rs) {
    const int k0 = 64 * kb, n0 = 32 * nb;
    const int sc = colmap(mode, n0 + (lane & 31));
    float tv[32];
#pragma unroll
    for (int i = 0; i < 32; ++i) { const int kk = 2 * i + (lane >> 5); tv[i] = 0.f; if (sc >= 0) tv[i] = W[(size_t)(k0 + kk) * N + sc]; }
#pragma unroll
    for (int i = 0; i < 32; ++i) { const int kk = 2 * i + (lane >> 5); float v = tv[i]; if (rs) v *= rs[k0 + kk]; scr[kk * 33 + (lane & 31)] = v; }
    asm volatile("s_waitcnt lgkmcnt(0)" ::: "memory");
    const int c = lane & 7;
#pragma unroll
    for (int j = 0; j < 4; ++j) { const int n = (lane >> 3) + 8 * j; const float* s = scr + (8 * c) * 33 + n;
        u32x4 o; o.x = pk2(s[0 * 33], s[1 * 33]); o.y = pk2(s[2 * 33], s[3 * 33]); o.z = pk2(s[4 * 33], s[5 * 33]); o.w = pk2(s[6 * 33], s[7 * 33]);
        *(u32x4*)(WT + (size_t)(n0 + n) * K + k0 + 8 * c) = o; }
    asm volatile("s_waitcnt lgkmcnt(0)" ::: "memory");
}
DI void phase0(const Args& a, unsigned char* lds, int gw, int NGW, int wave, int lane) {
    asm volatile("" : "+v"(lane));
    unsigned char* ws = a.ws;
    float* scr = (float*)(lds + wave * 16384);
    constexpr int I_IN = 16 * (NIN / 32), I_GLU = 8 * 32, I_OUT = 16 * 32, I_UP = 16 * (UPW / 32), I_DN = 44 * 32;
    constexpr int NIT = I_IN + I_GLU + I_OUT + I_UP + I_DN;
    for (int it = gw; it < NIT; it += NGW) {
        int r = it;
        if (r < I_IN) { transpose_item(a.in[8], 1024, 2568, (bf16*)(ws + WS_WIN), scr, r / (NIN / 32), r % (NIN / 32), lane, 1, nullptr); continue; } r -= I_IN;
        if (r < I_GLU) { transpose_item(a.in[21], 512, 1024, (bf16*)(ws + WS_WGLU), scr, r / 32, r % 32, lane, 2, nullptr); continue; } r -= I_GLU;
        if (r < I_OUT) { transpose_item(a.in[24], 1024, 1024, (bf16*)(ws + WS_WOUT), scr, r / 32, r % 32, lane, 0, nullptr); continue; } r -= I_OUT;
        if (r < I_UP) { transpose_item(a.in[26], 1024, 5632, (bf16*)(ws + WS_WUP), scr, r / (UPW / 32), r % (UPW / 32), lane, 3, a.in[25]); continue; } r -= I_UP;
        transpose_item(a.in[29], 2816, 1024, (bf16*)(ws + WS_WDOWN), scr, r / 32, r % 32, lane, 0, nullptr);
    }
    const float* g1 = a.in[7];
    f32x4 gv[4];
#pragma unroll
    for (int j = 0; j < 4; ++j) gv[j] = ((const f32x4*)g1)[lane + 64 * j];
    bf16* H = (bf16*)(ws + WS_H);
    for (int m0 = gw; m0 < T; m0 += 2 * NGW) {
        const int m1 = m0 + NGW < T ? m0 + NGW : m0;
        const f32x4* xr0 = (const f32x4*)(m0 < TP ? a.in[0] + (size_t)m0 * DM : a.in[1] + (size_t)(m0 - TP) * DM) + lane;
        const f32x4* xr1 = (const f32x4*)(m1 < TP ? a.in[0] + (size_t)m1 * DM : a.in[1] + (size_t)(m1 - TP) * DM) + lane;
        f32x4 v0[4], v1[4]; float s0 = 0.f, s1 = 0.f;
#pragma unroll
        for (int j = 0; j < 4; ++j) { v0[j] = xr0[64 * j]; v1[j] = xr1[64 * j]; }
#pragma unroll
        for (int j = 0; j < 4; ++j) { s0 += (v0[j].x * v0[j].x + v0[j].y * v0[j].y) + (v0[j].z * v0[j].z + v0[j].w * v0[j].w); s1 += (v1[j].x * v1[j].x + v1[j].y * v1[j].y) + (v1[j].z * v1[j].z + v1[j].w * v1[j].w); }
        const float r0 = rsqrtf(wave_sum(s0) * (1.f / DM) + EPS), r1 = rsqrtf(wave_sum(s1) * (1.f / DM) + EPS);
        u32x2* o0 = (u32x2*)(H + (size_t)m0 * DM) + lane; u32x2* o1 = (u32x2*)(H + (size_t)m1 * DM) + lane;
#pragma unroll
        for (int j = 0; j < 4; ++j) { u32x2 o; o.x = pk2(v0[j].x * r0 * gv[j].x, v0[j].y * r0 * gv[j].y); o.y = pk2(v0[j].z * r0 * gv[j].z, v0[j].w * r0 * gv[j].w); o0[64 * j] = o; }
        if (m1 != m0) {
#pragma unroll
            for (int j = 0; j < 4; ++j) { u32x2 o; o.x = pk2(v1[j].x * r1 * gv[j].x, v1[j].y * r1 * gv[j].y); o.y = pk2(v1[j].z * r1 * gv[j].z, v1[j].w * r1 * gv[j].w); o1[64 * j] = o; }
        }
    }
}

struct EpiP {
    static constexpr bool PERM = true, AFTER_DRAIN = false;
    bf16* P; float* BA;
    DI void operator()(const pg8::f32x4 (&acc)[2][2][4][2], const pg8::Unit& u, int wr, int wc, int fr, int fq) const {
        const int row0 = u.pm * 256 + wr * 64 + fr;
        if (u.pn < 10) {
            const int col0 = u.pn * 256 + wc * 32 + 8 * fq;
#pragma unroll
            for (int ai = 0; ai < 2; ++ai)
#pragma unroll
                for (int m = 0; m < 4; ++m) { bf16* rowp = P + (size_t)(row0 + ai * 128 + m * 16) * PW + col0;
#pragma unroll
                    for (int bj = 0; bj < 2; ++bj) { const pg8::f32x4 v0 = acc[ai][bj][m][0], v1 = acc[ai][bj][m][1];
                        u32x4 w; w.x = pk2(v0[0], v0[1]); w.y = pk2(v0[2], v0[3]); w.z = pk2(v1[0], v1[1]); w.w = pk2(v1[2], v1[3]);
                        *(u32x4*)(rowp + bj * 128) = w; } }
        } else if (wc == 0 && fq == 0) {
#pragma unroll
            for (int ai = 0; ai < 2; ++ai)
#pragma unroll
                for (int m = 0; m < 4; ++m) { float* bp = BA + (size_t)(row0 + ai * 128 + m * 16) * 8;
                    *(pg8::f32x4*)bp = acc[ai][0][m][0]; *(pg8::f32x4*)(bp + 4) = acc[ai][0][m][1]; }
        }
    }
};
struct EpiGlu {
    static constexpr bool PERM = true, AFTER_DRAIN = false;
    bf16* O; const float* gb;
    DI void operator()(const pg8::f32x4 (&acc)[2][2][4][2], const pg8::Unit& u, int wr, int wc, int fr, int fq) const {
        const int row0 = u.pm * 256 + wr * 64 + fr, col0 = u.pn * 128 + wc * 32 + 8 * fq;
        const pg8::f32x4 ba0 = *(const pg8::f32x4*)(gb + col0), ba1 = *(const pg8::f32x4*)(gb + col0 + 4), bg0 = *(const pg8::f32x4*)(gb + 512 + col0), bg1 = *(const pg8::f32x4*)(gb + 512 + col0 + 4);
#pragma unroll
        for (int ai = 0; ai < 2; ++ai)
#pragma unroll
            for (int m = 0; m < 4; ++m) {
                const pg8::f32x4 a0 = acc[ai][0][m][0] + ba0, a1 = acc[ai][0][m][1] + ba1, g0 = acc[ai][1][m][0] + bg0, g1 = acc[ai][1][m][1] + bg1;
                float o[8];
#pragma unroll
                for (int e = 0; e < 4; ++e) { o[e] = a0[e] * sigm(g0[e]); o[4 + e] = a1[e] * sigm(g1[e]); }
                u32x4 w; w.x = pk2(o[0], o[1]); w.y = pk2(o[2], o[3]); w.z = pk2(o[4], o[5]); w.w = pk2(o[6], o[7]);
                *(u32x4*)(O + (size_t)(row0 + ai * 128 + m * 16) * 512 + col0) = w;
            }
    }
};
struct EpiX1 {
    static constexpr bool PERM = false, AFTER_DRAIN = false;
    const float* xp; const float* xs; float* out; bf16* xb; float* ss2;
    DI void operator()(const pg8::f32x4 (&acc)[2][2][4][2], const pg8::Unit& u, int wr, int wc, int fr, int fq) const {
        const int row0 = u.pm * 256 + wr * 64 + fr, col0 = u.pn * 256 + wc * 32 + 4 * fq;
#pragma unroll
        for (int ai = 0; ai < 2; ++ai)
#pragma unroll
            for (int m = 0; m < 4; ++m) {
                const int row = row0 + ai * 128 + m * 16;
                const float* xr = (row < TP ? xp + (size_t)row * DM : xs + (size_t)(row - TP) * DM) + col0;
                float ss = 0.f;
#pragma unroll
                for (int bj = 0; bj < 2; ++bj)
#pragma unroll
                    for (int n = 0; n < 2; ++n) {
                        const pg8::f32x4 v = *(const pg8::f32x4*)(xr + bj * 128 + n * 16) + acc[ai][bj][m][n];
                        *(pg8::f32x4*)(out + (size_t)row * DM + col0 + bj * 128 + n * 16) = v;
                        u32x2 w; w.x = pk2(v[0], v[1]); w.y = pk2(v[2], v[3]);
                        *(u32x2*)(xb + (size_t)row * DM + col0 + bj * 128 + n * 16) = w;
                        ss += (v[0] * v[0] + v[1] * v[1]) + (v[2] * v[2] + v[3] * v[3]);
                    }
                ss += __shfl_xor(ss, 16); ss += __shfl_xor(ss, 32);
                if (fq == 0) ss2[(size_t)row * 16 + u.pn * 4 + wc] = ss;
            }
    }
};
struct EpiUp {
    static constexpr bool PERM = true, AFTER_DRAIN = false;
    bf16* UP; const float* ss2;
    DI void operator()(const pg8::f32x4 (&acc)[2][2][4][2], const pg8::Unit& u, int wr, int wc, int fr, int fq) const {
        const int row0 = u.pm * 256 + wr * 64 + fr, col0 = u.pn * 128 + wc * 32 + 8 * fq;
#pragma unroll
        for (int ai = 0; ai < 2; ++ai)
#pragma unroll
            for (int m = 0; m < 4; ++m) {
                const int row = row0 + ai * 128 + m * 16;
                const pg8::f32x4* sp = (const pg8::f32x4*)(ss2 + (size_t)row * 16);
                const pg8::f32x4 s0 = sp[0], s1 = sp[1], s2 = sp[2], s3 = sp[3];
                const float tot = ((s0[0] + s0[1]) + (s0[2] + s0[3])) + ((s1[0] + s1[1]) + (s1[2] + s1[3])) + ((s2[0] + s2[1]) + (s2[2] + s2[3])) + ((s3[0] + s3[1]) + (s3[2] + s3[3]));
                const float r = rsqrtf(tot * (1.f / DM) + EPS);
                bf16* rowp = UP + (size_t)row * UPW + col0;
#pragma unroll
                for (int bj = 0; bj < 2; ++bj) { const pg8::f32x4 v0 = acc[ai][bj][m][0] * r, v1 = acc[ai][bj][m][1] * r;
                    u32x4 w; w.x = pk2(v0[0], v0[1]); w.y = pk2(v0[2], v0[3]); w.z = pk2(v1[0], v1[1]); w.w = pk2(v1[2], v1[3]);
                    *(u32x4*)(rowp + bj * DFF) = w; }
            }
    }
};
DI float dpp_shr1(float v) { return __int_as_float(__builtin_amdgcn_update_dpp(0, __float_as_int(v), 0x111, 0xf, 0xf, false)); }
DI float dpp_shr2(float v) { return __int_as_float(__builtin_amdgcn_update_dpp(0, __float_as_int(v), 0x112, 0xf, 0xf, false)); }
struct EpiUpAct {
    static constexpr bool PERM = true, AFTER_DRAIN = false;
    bf16* ACT; bf16* GH; bf16* GT; bf16* VH; const float* ss2; const float* fw; const float* fb;
    DI void operator()(const pg8::f32x4 (&acc)[2][2][4][2], const pg8::Unit& u, int wr, int wc, int fr, int fq) const {
        const int row0 = u.pm * 256 + wr * 64 + fr, col0 = u.pn * 128 + wc * 32 + 8 * fq;
        float w0[8], w1[8], w2[8], bb[8];
#pragma unroll
        for (int n = 0; n < 2; ++n) { const pg8::f32x4 a0 = *(const pg8::f32x4*)(fw + col0 + 4 * n), a1 = *(const pg8::f32x4*)(fw + DFF + col0 + 4 * n), a2 = *(const pg8::f32x4*)(fw + 2 * DFF + col0 + 4 * n), a3 = *(const pg8::f32x4*)(fb + col0 + 4 * n);
#pragma unroll
            for (int e = 0; e < 4; ++e) { w0[4 * n + e] = a0[e]; w1[4 * n + e] = a1[e]; w2[4 * n + e] = a2[e]; bb[4 * n + e] = a3[e]; } }
#pragma unroll
        for (int ai = 0; ai < 2; ++ai)
#pragma unroll
            for (int m = 0; m < 4; ++m) {
                const int row = row0 + ai * 128 + m * 16, grp = row >> 4;
                const pg8::f32x4* sp = (const pg8::f32x4*)(ss2 + (size_t)row * 16);
                const pg8::f32x4 s0 = sp[0], s1 = sp[1], s2 = sp[2], s3 = sp[3];
                const float tot = ((s0[0] + s0[1]) + (s0[2] + s0[3])) + ((s1[0] + s1[1]) + (s1[2] + s1[3])) + ((s2[0] + s2[1]) + (s2[2] + s2[3])) + ((s3[0] + s3[1]) + (s3[2] + s3[3]));
                const float r = rsqrtf(tot * (1.f / DM) + EPS);
                float gs[8], vv[8], o[8];
#pragma unroll
                for (int n = 0; n < 2; ++n)
#pragma unroll
                    for (int e = 0; e < 4; ++e) { gs[4 * n + e] = acc[ai][0][m][n][e] * r; vv[4 * n + e] = acc[ai][1][m][n][e] * r; }
#pragma unroll
                for (int e = 0; e < 8; ++e) { const float g1 = dpp_shr1(gs[e]), g2 = dpp_shr2(gs[e]); o[e] = silu(g2 * w0[e] + g1 * w1[e] + gs[e] * w2[e] + bb[e]) * vv[e]; }
                u32x4 wg; wg.x = pk2(gs[0], gs[1]); wg.y = pk2(gs[2], gs[3]); wg.z = pk2(gs[4], gs[5]); wg.w = pk2(gs[6], gs[7]);
                if (fr >= 2) { u32x4 w; w.x = pk2(o[0], o[1]); w.y = pk2(o[2], o[3]); w.z = pk2(o[4], o[5]); w.w = pk2(o[6], o[7]);
                    *(u32x4*)(ACT + (size_t)row * DFF + col0) = w; }
                else { u32x4 wv; wv.x = pk2(vv[0], vv[1]); wv.y = pk2(vv[2], vv[3]); wv.z = pk2(vv[4], vv[5]); wv.w = pk2(vv[6], vv[7]);
                    *(u32x4*)(GH + ((size_t)grp * 2 + fr) * DFF + col0) = wg; *(u32x4*)(VH + ((size_t)grp * 2 + fr) * DFF + col0) = wv; }
                if (fr >= 14) *(u32x4*)(GT + ((size_t)grp * 2 + (fr - 14)) * DFF + col0) = wg;
            }
    }
};
struct EpiX2 {
    static constexpr bool PERM = false, AFTER_DRAIN = false;
    float* out;
    DI void operator()(const pg8::f32x4 (&acc)[2][2][4][2], const pg8::Unit& u, int wr, int wc, int fr, int fq) const {
        const int row0 = u.pm * 256 + wr * 64 + fr, col0 = u.pn * 256 + wc * 32 + 4 * fq;
#pragma unroll
        for (int ai = 0; ai < 2; ++ai)
#pragma unroll
            for (int m = 0; m < 4; ++m) {
                float* orow = out + (size_t)(row0 + ai * 128 + m * 16) * DM + col0;
#pragma unroll
                for (int bj = 0; bj < 2; ++bj)
#pragma unroll
                    for (int n = 0; n < 2; ++n) { pg8::f32x4* p = (pg8::f32x4*)(orow + bj * 128 + n * 16); *p = *p + acc[ai][bj][m][n]; }
            }
    }
};

DI int kperm(int k) { return (k & ~31) | (((k >> 2) & 3) << 3) | (((k >> 4) & 1) << 2) | (k & 3); }
DI void conv_col(const bf16* pcol, float h0, float h1, float h2, const float* cw, int nrows, float* outp, float (&val)[64]) {
    const float w0 = cw[0], w1 = cw[1536], w2 = cw[2 * 1536], w3 = cw[3 * 1536];
    float x3 = h0, x2 = h1, x1 = h2;
#pragma unroll
    for (int r = 0; r < 64; ++r) {
        float x0 = 0.f;
        if (r < nrows) x0 = b2f(pcol[(size_t)r * PW]);
        const float c = x3 * w0 + x2 * w1 + x1 * w2 + x0 * w3;
        val[r] = r < nrows ? silu(c) : 0.f;
        if (outp && r >= nrows - 3 && r < nrows) outp[(r - (nrows - 3)) * 1536] = x0;
        x3 = x2; x2 = x1; x1 = x0;
    }
}
DI void dn_chunk_phase(const Args& a, unsigned char* lds, int tid) {
    unsigned char* ws = a.ws;
    const bf16* P = (const bf16*)(ws + WS_P);
    const float* BA = (const float*)(ws + WS_BA);
    const float* cwt = a.in[9];
    constexpr float QSCALE = 0.08838834764831845f;
    for (int it = blockIdx.x; it < NCH / 2; it += gridDim.x) {
        int tl = tid; asm volatile("" : "+v"(tl));
        const int half = __builtin_amdgcn_readfirstlane(tl >> 8), t8 = tl & 255, hw = __builtin_amdgcn_readfirstlane((tl >> 6) & 3), lane = tl & 63, fr = lane & 15, fq = lane >> 4;
        unsigned char* L = lds + half * 53248;
        unsigned char* qb = L; unsigned char* kb = L + 17408;
        float* Am = (float*)(L + 34816);
        float* Gs = (float*)(L + 51200); float* Bs = Gs + 64; float* RQ = Gs + 128; float* RK = Gs + 192; float* EG = Gs + 256;
        const int unit = it * 2 + half;
        int row0, nrows, h, bidx; bool sample, first, lastc;
        if (unit < 2048) { const int b = unit >> 9, n = unit & 127; h = (unit >> 7) & 3; row0 = b * 8192 + n * 64; nrows = 64; sample = false; first = (n == 0); lastc = (n == 127); bidx = b; }
        else { const int su = unit - 2048; bidx = su >> 2; h = su & 3; row0 = TP + bidx * 16; nrows = 16; sample = true; first = false; lastc = true; }
        unsigned char* rec = ws + WS_DNC + (size_t)unit * REC;
        if (hw == 0) {
            float g = 0.f, be = 0.f;
            if (lane < nrows) {
                const float* bp = BA + (size_t)(row0 + lane) * 8;
                be = sigm(bp[h]);
                const float xx = bp[4 + h] + a.in[11][h];
                const float sp = xx > 20.f ? xx : log1pf(__expf(xx));
                g = -__expf(a.in[10][h]) * sp;
            }
#pragma unroll
            for (int o = 1; o < 64; o <<= 1) { const float v = __shfl_up(g, o); if (lane >= o) g += v; }
            Gs[lane] = g; Bs[lane] = be; EG[lane] = __expf(g);
            if (lane == 63) ((float*)(ws + WS_EG))[unit] = __expf(g);
        }
        float va[64];
        {
            const int c = t8 & 127;
            const int col = (t8 < 128 ? 0 : 512) + h * 128 + c;
            float h0 = 0.f, h1 = 0.f, h2 = 0.f;
            if (sample) { const float* cc = a.in[2] + (size_t)bidx * 3 * 1536 + col; h0 = cc[0]; h1 = cc[1536]; h2 = cc[2 * 1536]; }
            else if (!first) { const bf16* pp = P + (size_t)(row0 - 3) * PW + col; h0 = b2f(pp[0]); h1 = b2f(pp[PW]); h2 = b2f(pp[2 * PW]); }
            float* outp = lastc ? a.out + (sample ? O_SDC : O_PDC) + (size_t)bidx * 3 * 1536 + col : nullptr;
            conv_col(P + (size_t)row0 * PW + col, h0, h1, h2, cwt + col, nrows, outp, va);
            unsigned char* dst = (t8 < 128 ? qb : kb) + c * 2;
#pragma unroll
            for (int r = 0; r < 64; ++r) *(bf16*)(dst + r * 272) = f2b(va[r]);
        }
        __syncthreads();
        f32x4 kk[4], qk[4], qq;
        {
            bf16x8 ak[4], aq[4];
#pragma unroll
            for (int ks = 0; ks < 4; ++ks) { ak[ks] = *(const bf16x8*)(kb + (16 * hw + fr) * 272 + ks * 64 + fq * 16); aq[ks] = *(const bf16x8*)(qb + (16 * hw + fr) * 272 + ks * 64 + fq * 16); }
            qq = (f32x4){0.f, 0.f, 0.f, 0.f};
#pragma unroll
            for (int ks = 0; ks < 4; ++ks) qq = MFMA16(aq[ks], aq[ks], qq);
#pragma unroll
            for (int nt = 0; nt < 4; ++nt) {
                kk[nt] = (f32x4){0.f, 0.f, 0.f, 0.f}; qk[nt] = (f32x4){0.f, 0.f, 0.f, 0.f};
#pragma unroll
                for (int ks = 0; ks < 4; ++ks) { const bf16x8 bk = *(const bf16x8*)(kb + (16 * nt + fr) * 272 + ks * 64 + fq * 16);
                    kk[nt] = MFMA16(ak[ks], bk, kk[nt]); qk[nt] = MFMA16(aq[ks], bk, qk[nt]); }
            }
#pragma unroll
            for (int i = 0; i < 4; ++i) if (fr == 4 * fq + i) {
                float dk = 0.f;
#pragma unroll
                for (int nt = 0; nt < 4; ++nt) if (nt == hw) dk = kk[nt][i];
                RK[16 * hw + fr] = rsqrtf(dk + EPS); RQ[16 * hw + fr] = rsqrtf(qq[i] + EPS);
            }
        }
        __syncthreads();
        {
            bf16* QKr = (bf16*)(rec + R_QK);
#pragma unroll
            for (int i = 0; i < 4; ++i) {
                const int row = 16 * hw + 4 * fq + i;
                const float gr = Gs[row], br = Bs[row], rk = RK[row], rq = RQ[row];
#pragma unroll
                for (int nt = 0; nt < 4; ++nt) {
                    const int col = 16 * nt + fr;
                    const float d = col <= row ? gr - Gs[col] : 0.f;
                    const float e = __expf(d), rkc = RK[col];
                    Am[row * 64 + col] = col < row ? br * kk[nt][i] * rk * rkc * e : 0.f;
                    QKr[row * 64 + kperm(col)] = f2b(col <= row ? qk[nt][i] * rq * rkc * QSCALE * e : 0.f);
                }
            }
        }
        __syncthreads();
        if (t8 < 128) {
            bf16* Qg = (bf16*)(rec + R_QG) + kperm(t8);
#pragma unroll
            for (int r = 0; r < 64; ++r) Qg[r * 128] = f2b(va[r] * RQ[r] * QSCALE * EG[r]);
            {
                const int col = 1024 + h * 128 + t8;
                float h0 = 0.f, h1 = 0.f, h2 = 0.f;
                if (sample) { const float* cc = a.in[2] + (size_t)bidx * 3 * 1536 + col; h0 = cc[0]; h1 = cc[1536]; h2 = cc[2 * 1536]; }
                else if (!first) { const bf16* pp = P + (size_t)(row0 - 3) * PW + col; h0 = b2f(pp[0]); h1 = b2f(pp[PW]); h2 = b2f(pp[2 * PW]); }
                float* outp = lastc ? a.out + (sample ? O_SDC : O_PDC) + (size_t)bidx * 3 * 1536 + col : nullptr;
                conv_col(P + (size_t)row0 * PW + col, h0, h1, h2, cwt + col, nrows, outp, va);
            }
#pragma unroll
            for (int r = 0; r < 64; ++r) va[r] = va[r] * Bs[r];
        } else {
            const int c = t8 - 128;
            const float gl = Gs[63];
            unsigned w[32];
#pragma unroll
            for (int r = 0; r < 64; r += 2) w[kperm(r) >> 1] = pk2(va[r] * RK[r] * __expf(gl - Gs[r]), va[r + 1] * RK[r + 1] * __expf(gl - Gs[r + 1]));
            u32x4* dst = (u32x4*)(rec + R_KDT + c * 128);
#pragma unroll
            for (int j = 0; j < 8; ++j) dst[j] = (u32x4){w[4 * j], w[4 * j + 1], w[4 * j + 2], w[4 * j + 3]};
#pragma unroll
            for (int r = 0; r < 64; ++r) va[r] = va[r] * RK[r] * Bs[r] * EG[r];
        }
#if SOLVE_RL
        {
            float arow[64];
#pragma unroll
            for (int i = 1; i < 64; ++i) arow[i] = Am[i * 64 + lane];
#pragma unroll
            for (int i = 1; i < 64; ++i) {
                if (i < nrows) {
                    float acc0 = va[i], acc1 = 0.f;
#pragma unroll
                    for (int j = 0; j < i; ++j) { const float aij = __int_as_float(__builtin_amdgcn_readlane(__float_as_int(arow[i]), j)); if (j & 1) acc1 -= aij * va[j]; else acc0 -= aij * va[j]; }
                    va[i] = acc0 + acc1;
                }
            }
        }
#else
#pragma unroll
        for (int i = 1; i < 64; ++i) {
            float acc = va[i];
            const f32x4* Ar = (const f32x4*)(Am + i * 64);
#pragma unroll
            for (int j4 = 0; j4 < (i + 3) / 4; ++j4) {
                const f32x4 av = Ar[j4];
#pragma unroll
                for (int e = 0; e < 4; ++e) if (4 * j4 + e < i) acc -= av[e] * va[4 * j4 + e];
            }
            va[i] = acc;
        }
#endif
        if (t8 < 128) { bf16* U0 = (bf16*)(rec + R_U0) + t8;
#pragma unroll
            for (int r = 0; r < 64; ++r) U0[r * 128] = f2b(va[r]);
        } else { bf16* Wn = (bf16*)(rec + R_WN) + kperm(t8 - 128);
#pragma unroll
            for (int r = 0; r < 64; ++r) Wn[r * 128] = f2b(-va[r]);
        }
        __syncthreads();
    }
}

struct S5W { float lr[4], li[4]; bf16x8 bf[8]; };
DI void s5w_setup(const Args& a, int g, int fr, int fq, S5W& w) {
    const float dt = __expf(a.in[15][g]);
#pragma unroll
    for (int j = 0; j < 4; ++j) {
        const int p = 16 * j + fr;
        const float are = a.in[13][g * 64 + p], aim = a.in[14][g * 64 + p];
        const float mag = __expf(are * dt), ang = aim * dt;
        float sn, cs; sincosf(ang, &sn, &cs);
        const float lr = mag * cs, li = mag * sn;
        w.lr[j] = lr; w.li[j] = li;
        const float den = are * are + aim * aim;
        const float fre = ((lr - 1.f) * are + li * aim) / den, fim = (li * are - (lr - 1.f) * aim) / den;
        u32x4 wr = (u32x4){0u, 0u, 0u, 0u}, wi = (u32x4){0u, 0u, 0u, 0u};
        if (fq < 2) {
            const f32x4* br = (const f32x4*)(a.in[16] + (size_t)(g * 64 + p) * 16 + 8 * fq); const f32x4* bi = (const f32x4*)(a.in[17] + (size_t)(g * 64 + p) * 16 + 8 * fq);
            const f32x4 r0 = br[0], r1 = br[1], i0 = bi[0], i1 = bi[1];
            wr.x = pk2(fre * r0[0] - fim * i0[0], fre * r0[1] - fim * i0[1]); wr.y = pk2(fre * r0[2] - fim * i0[2], fre * r0[3] - fim * i0[3]);
            wr.z = pk2(fre * r1[0] - fim * i1[0], fre * r1[1] - fim * i1[1]); wr.w = pk2(fre * r1[2] - fim * i1[2], fre * r1[3] - fim * i1[3]);
            wi.x = pk2(fre * i0[0] + fim * r0[0], fre * i0[1] + fim * r0[1]); wi.y = pk2(fre * i0[2] + fim * r0[2], fre * i0[3] + fim * r0[3]);
            wi.z = pk2(fre * i1[0] + fim * r1[0], fre * i1[1] + fim * r1[1]); wi.w = pk2(fre * i1[2] + fim * r1[2], fre * i1[3] + fim * r1[3]);
        }
        w.bf[j] = __builtin_bit_cast(bf16x8, wr); w.bf[4 + j] = __builtin_bit_cast(bf16x8, wi);
    }
}
DI bf16x8 s5w_uload(const bf16* P, size_t row0, int SS, int ms, int g, int fr, int fq) {
    u32x4 v = (u32x4){0u, 0u, 0u, 0u};
    if (fq < 2) v = *(const u32x4*)(P + (row0 + (size_t)(fr >> 2) * SS + 4 * ms + (fr & 3)) * PW + 2048 + g * 16 + 8 * fq);
    return __builtin_bit_cast(bf16x8, v);
}
DI void s5w_step(const S5W& w, bf16x8 ua, float (&xr)[4], float (&xi)[4], unsigned (&xo)[4][4]) {
    f32x4 br[4], bi[4];
    const f32x4 z = (f32x4){0.f, 0.f, 0.f, 0.f};
#pragma unroll
    for (int j = 0; j < 4; ++j) { br[j] = MFMA16(ua, w.bf[j], z); bi[j] = MFMA16(ua, w.bf[4 + j], z); }
#pragma unroll
    for (int i = 0; i < 4; ++i)
#pragma unroll
        for (int j = 0; j < 4; ++j) {
            const float nr = w.lr[j] * xr[j] - w.li[j] * xi[j] + br[j][i], ni = w.lr[j] * xi[j] + w.li[j] * xr[j] + bi[j][i];
            xr[j] = nr; xi[j] = ni; xo[i][j] = pk2(nr, ni);
        }
#pragma unroll
    for (int j = 0; j < 8; ++j) asm volatile("" :: "v"(w.bf[j]));
    asm volatile("" :: "v"(ua));
}
DI void s5_pass1(const Args& a, int gw, int NGW, int lane) {
    asm volatile("" : "+v"(lane));
    const bf16* P = (const bf16*)(a.ws + WS_P);
    float* E = (float*)(a.ws + WS_S5E);
    const int fr = lane & 15, fq = lane >> 4;
    for (int unit = gw; unit < 4 * 32 * 16; unit += NGW) {
        const int sg = unit & 15, bg = unit >> 4, g = bg & 31, b = bg >> 5;
        S5W w; s5w_setup(a, g, fr, fq, w);
        float xr[4] = {0.f, 0.f, 0.f, 0.f}, xi[4] = {0.f, 0.f, 0.f, 0.f}; unsigned xo[4][4];
        const size_t row0 = (size_t)b * 8192 + sg * 512;
        bf16x8 ua = s5w_uload(P, row0, 128, 0, g, fr, fq);
        for (int ms = 0; ms < 32; ++ms) {
            const bf16x8 un = s5w_uload(P, row0, 128, ms + 1 < 32 ? ms + 1 : ms, g, fr, fq);
            s5w_step(w, ua, xr, xi, xo); ua = un;
        }
        float* e = E + ((size_t)bg * 64 + 4 * sg + fq) * 128;
#pragma unroll
        for (int j = 0; j < 4; ++j) { e[16 * j + fr] = xr[j]; e[64 + 16 * j + fr] = xi[j]; }
    }
}
DI void s5w_run(const Args& a, const S5W& w, const bf16x8 (&cf)[4], float Dg, unsigned char* xs, size_t row0, int SS, int nms, int g, int fr, int fq, float (&xr)[4], float (&xi)[4]) {
    const bf16* P = (const bf16*)(a.ws + WS_P);
    bf16* Y5 = (bf16*)(a.ws + WS_Y5);
    bf16x8 ua = s5w_uload(P, row0, SS, 0, g, fr, fq);
    for (int ms = 0; ms < nms; ++ms) {
        const bf16x8 un = s5w_uload(P, row0, SS, ms + 1 < nms ? ms + 1 : ms, g, fr, fq);
        float uu[4];
#pragma unroll
        for (int i = 0; i < 4; ++i) uu[i] = b2f(P[(row0 + (size_t)fq * SS + 4 * ms + i) * PW + 2048 + g * 16 + fr]);
        unsigned xo[4][4];
        s5w_step(w, ua, xr, xi, xo); ua = un;
#pragma unroll
        for (int i = 0; i < 4; ++i)
#pragma unroll
            for (int j = 0; j < 4; ++j) *(unsigned*)(xs + (4 * fq + i) * 272 + (16 * j + fr) * 4) = xo[i][j];
        asm volatile("s_waitcnt lgkmcnt(0)" ::: "memory");
        f32x4 y = (f32x4){0.f, 0.f, 0.f, 0.f};
        bf16x8 af[4];
#pragma unroll
        for (int ks = 0; ks < 4; ++ks) af[ks] = *(const bf16x8*)(xs + fr * 272 + ks * 64 + fq * 16);
        asm volatile("" ::: "memory");
#pragma unroll
        for (int ks = 0; ks < 4; ++ks) y = MFMA16(af[ks], cf[ks], y);
#if DIAG_Y
        {
            const float* cre = a.in[18] + (size_t)(g * 16 + fr) * 64; const float* cim = a.in[19] + (size_t)(g * 16 + fr) * 64;
#pragma unroll
            for (int i = 0; i < 4; ++i) { float acc = 0.f;
                for (int p = 0; p < 64; ++p) { const unsigned wv = *(const unsigned*)(xs + (4 * fq + i) * 272 + p * 4); acc += cre[p] * blo(wv) - cim[p] * bhi(wv); }
                y[i] = acc; }
        }
#endif
        asm volatile("" :: "v"(y));
#pragma unroll
        for (int ks = 0; ks < 4; ++ks) asm volatile("" :: "v"(af[ks]), "v"(cf[ks]));
#pragma unroll
        for (int i = 0; i < 4; ++i) {
            const size_t row = row0 + (size_t)fq * SS + 4 * ms + i;
            Y5[row * 512 + g * 16 + fr] = f2b(gelu_tanh(y[i] + Dg * uu[i]));
        }
    }
}
DI void s5_cfrag(const Args& a, int g, int fr, int fq, bf16x8 (&cf)[4]) {
#pragma unroll
    for (int ks = 0; ks < 4; ++ks) {
        const f32x4 cr = *(const f32x4*)(a.in[18] + (size_t)(g * 16 + fr) * 64 + 16 * ks + 4 * fq), ci = *(const f32x4*)(a.in[19] + (size_t)(g * 16 + fr) * 64 + 16 * ks + 4 * fq);
        u32x4 w; w.x = pk2(cr[0], -ci[0]); w.y = pk2(cr[1], -ci[1]); w.z = pk2(cr[2], -ci[2]); w.w = pk2(cr[3], -ci[3]);
        cf[ks] = __builtin_bit_cast(bf16x8, w);
    }
}
DI void s5_pass2_prompt(const Args& a, unsigned char* lds, int bg, int tid) {
    asm volatile("" : "+v"(tid));
    const int wave = __builtin_amdgcn_readfirstlane(tid >> 6), lane = tid & 63, fr = lane & 15, fq = lane >> 4;
    const int b = bg >> 5, g4 = (bg >> 2) & 7, part = bg & 3, g = 4 * g4 + (wave & 3);
    bg = b * 32 + g;
    unsigned char* xs = lds + wave * 4352;
    S5W w; s5w_setup(a, g, fr, fq, w);
    bf16x8 cf[4]; s5_cfrag(a, g, fr, fq, cf);
    const float Dg = a.in[20][g * 16 + fr];
    float pr[4], pi[4];
#pragma unroll
    for (int j = 0; j < 4; ++j) { pr[j] = w.lr[j]; pi[j] = w.li[j];
#pragma unroll
        for (int s = 0; s < 7; ++s) { const float nr = pr[j] * pr[j] - pi[j] * pi[j], ni = 2.f * pr[j] * pi[j]; pr[j] = nr; pi[j] = ni; } }
    const float* e = (const float*)(a.ws + WS_S5E) + (size_t)bg * 64 * 128;
    for (int uu = 0; uu < 2; ++uu) {
        const int sg = 4 * part + 2 * (wave >> 2) + uu, seg = 4 * sg + fq;
        float xr[4] = {0.f, 0.f, 0.f, 0.f}, xi[4] = {0.f, 0.f, 0.f, 0.f};
        for (int s = 0; s < 4 * sg + 3; ++s) {
            if (s < seg) {
#pragma unroll
                for (int j = 0; j < 4; ++j) { const float er = e[s * 128 + 16 * j + fr], ei = e[s * 128 + 64 + 16 * j + fr];
                    const float nr = pr[j] * xr[j] - pi[j] * xi[j] + er, ni = pr[j] * xi[j] + pi[j] * xr[j] + ei; xr[j] = nr; xi[j] = ni; }
            }
        }
        s5w_run(a, w, cf, Dg, xs, (size_t)b * 8192 + sg * 512, 128, 32, g, fr, fq, xr, xi);
        if (seg == 63) {
#pragma unroll
            for (int j = 0; j < 4; ++j) { a.out[O_PSR + (size_t)bg * 64 + 16 * j + fr] = xr[j]; a.out[O_PSI + (size_t)bg * 64 + 16 * j + fr] = xi[j]; }
        }
    }
}
DI void s5_pass2_sample(const Args& a, unsigned char* xs, int gw, int NGW, int lane) {
    asm volatile("" : "+v"(lane));
    const int fr = lane & 15, fq = lane >> 4;
    for (int unit = gw; unit < 256; unit += NGW) {
        const int g = unit & 31, q = unit >> 5, sb = 4 * q + fq;
        S5W w; s5w_setup(a, g, fr, fq, w);
        bf16x8 cf[4]; s5_cfrag(a, g, fr, fq, cf);
        const float Dg = a.in[20][g * 16 + fr];
        float xr[4], xi[4];
#pragma unroll
        for (int j = 0; j < 4; ++j) { xr[j] = a.in[4][(size_t)(sb * 32 + g) * 64 + 16 * j + fr]; xi[j] = a.in[5][(size_t)(sb * 32 + g) * 64 + 16 * j + fr]; }
        s5w_run(a, w, cf, Dg, xs, (size_t)TP + (size_t)q * 64, 16, 4, g, fr, fq, xr, xi);
#pragma unroll
        for (int j = 0; j < 4; ++j) { a.out[O_SSR + (size_t)(sb * 32 + g) * 64 + 16 * j + fr] = xr[j]; a.out[O_SSI + (size_t)(sb * 32 + g) * 64 + 16 * j + fr] = xi[j]; }
    }
}

struct S5Par { float lr, li; float bbr[16], bbi[16]; };
DI void s5_setup(const Args& a, int g, int p, S5Par& q) {
    const float are = a.in[13][g * 64 + p], aim = a.in[14][g * 64 + p], dt = __expf(a.in[15][g]);
    const float mag = __expf(are * dt), ang = aim * dt;
    float sn, cs; sincosf(ang, &sn, &cs);
    q.lr = mag * cs; q.li = mag * sn;
    const float den = are * are + aim * aim;
    const float fre = ((q.lr - 1.f) * are + q.li * aim) / den, fim = (q.li * are - (q.lr - 1.f) * aim) / den;
    const f32x4* br = (const f32x4*)(a.in[16] + (size_t)(g * 64 + p) * 16); const f32x4* bi = (const f32x4*)(a.in[17] + (size_t)(g * 64 + p) * 16);
#pragma unroll
    for (int j = 0; j < 4; ++j) { const f32x4 r = br[j], i = bi[j];
#pragma unroll
        for (int e = 0; e < 4; ++e) { q.bbr[4 * j + e] = fre * r[e] - fim * i[e]; q.bbi[4 * j + e] = fre * i[e] + fim * r[e]; } }
}
DI void s5_step4(const S5Par& q, float uv, float& xr, float& xi, unsigned (&xo)[4]) {
#pragma unroll
    for (int j = 0; j < 4; ++j) {
        float br = 0.f, bi = 0.f;
#pragma unroll
        for (int h = 0; h < 16; ++h) { const float uh = __int_as_float(__builtin_amdgcn_readlane(__float_as_int(uv), 16 * j + h)); br += q.bbr[h] * uh; bi += q.bbi[h] * uh; }
        const float nr = q.lr * xr - q.li * xi + br, ni = q.lr * xi + q.li * xr + bi;
        xr = nr; xi = ni; xo[j] = pk2(xr, xi);
    }
}
DI void old_s5_pass1(const Args& a, int gw, int NGW, int lane) {
    asm volatile("" : "+v"(lane));
    const bf16* P = (const bf16*)(a.ws + WS_P);
    float* E = (float*)(a.ws + WS_S5E);
    for (int unit = gw; unit < 4 * 32 * 64; unit += NGW) {
        const int seg = unit & 63, bg = unit >> 6, g = bg & 31, b = bg >> 5;
        S5Par q; s5_setup(a, g, lane, q);
        float xr = 0.f, xi = 0.f; unsigned xo[4];
        const bf16* up = P + (size_t)(b * 8192 + seg * 128 + (lane >> 4)) * PW + 2048 + g * 16 + (lane & 15);
#pragma unroll 2
        for (int t = 0; t < 128; t += 4) { const float uv = b2f(up[(size_t)t * PW]); s5_step4(q, uv, xr, xi, xo); }
        float* e = E + ((size_t)bg * 64 + seg) * 128;
        e[lane] = xr; e[64 + lane] = xi;
    }
}
DI void old_s5_pass2(const Args& a, unsigned char* xs  , int gw, int NGW, int lane) {
    asm volatile("" : "+v"(lane));
    const bf16* P = (const bf16*)(a.ws + WS_P);
    const float* E = (const float*)(a.ws + WS_S5E);
    bf16* Y5 = (bf16*)(a.ws + WS_Y5);
    const int fr = lane & 15, fq = lane >> 4;
    for (int unit = gw; unit < OLD_S5_ULIM; unit += NGW) {
        int g, row0, ntok, seg = 0, bg; bool sample;
        if (unit < 8192) { seg = unit & 63; bg = unit >> 6; g = bg & 31; row0 = (bg >> 5) * 8192 + seg * 128; ntok = 128; sample = false; }
        else { bg = unit - 8192; g = bg & 31; row0 = TP + (bg >> 5) * 16; ntok = 16; sample = true; }
        S5Par q; s5_setup(a, g, lane, q);
        float xr = 0.f, xi = 0.f;
        if (sample) { xr = a.in[4][(size_t)bg * 64 + lane]; xi = a.in[5][(size_t)bg * 64 + lane]; }
        else {
            float pr = q.lr, pi = q.li;
#pragma unroll
            for (int s = 0; s < 7; ++s) { const float nr = pr * pr - pi * pi, ni = 2.f * pr * pi; pr = nr; pi = ni; }
            const float* e = E + (size_t)bg * 64 * 128;
            for (int s = 0; s < seg; ++s) { const float er = e[s * 128 + lane], ei = e[s * 128 + 64 + lane]; const float nr = pr * xr - pi * xi + er, ni = pr * xi + pi * xr + ei; xr = nr; xi = ni; }
        }
        bf16x8 cf[4];
#pragma unroll
        for (int ks = 0; ks < 4; ++ks) {
            const f32x4 cr = *(const f32x4*)(a.in[18] + (size_t)(g * 16 + fr) * 64 + 16 * ks + 4 * fq), ci = *(const f32x4*)(a.in[19] + (size_t)(g * 16 + fr) * 64 + 16 * ks + 4 * fq);
            u32x4 w; w.x = pk2(cr[0], -ci[0]); w.y = pk2(cr[1], -ci[1]); w.z = pk2(cr[2], -ci[2]); w.w = pk2(cr[3], -ci[3]);
            cf[ks] = __builtin_bit_cast(bf16x8, w);
        }
        const float Dg = a.in[20][g * 16 + fr];
        const bf16* up = P + (size_t)(row0 + (lane >> 4)) * PW + 2048 + g * 16 + (lane & 15);
        for (int tb = 0; tb < ntok; tb += 16) {
#pragma unroll
            for (int j4 = 0; j4 < 4; ++j4) {
                const float uv = b2f(up[(size_t)(tb + 4 * j4) * PW]);
                unsigned xo[4]; s5_step4(q, uv, xr, xi, xo);
#pragma unroll
                for (int j = 0; j < 4; ++j) *(unsigned*)(xs + (4 * j4 + j) * 272 + lane * 4) = xo[j];
            }
            f32x4 y = (f32x4){0.f, 0.f, 0.f, 0.f};
#pragma unroll
            for (int ks = 0; ks < 4; ++ks) { const bf16x8 af = *(const bf16x8*)(xs + fr * 272 + ks * 64 + fq * 16); y = MFMA16(af, cf[ks], y); }
#pragma unroll
            for (int i = 0; i < 4; ++i) {
                const size_t row = (size_t)row0 + tb + 4 * fq + i;
                const float uu = b2f(P[row * PW + 2048 + g * 16 + fr]);
                Y5[row * 512 + g * 16 + fr] = f2b(gelu_tanh(y[i] + Dg * uu));
            }
        }
        if (sample) { a.out[O_SSR + (size_t)bg * 64 + lane] = xr; a.out[O_SSI + (size_t)bg * 64 + lane] = xi; }
        else if (seg == 63) { a.out[O_PSR + (size_t)bg * 64 + lane] = xr; a.out[O_PSI + (size_t)bg * 64 + lane] = xi; }
    }
}

DI void s5_pass2b(const Args& a, unsigned char* xs, int gw, int NGW, int lane) {
    asm volatile("" : "+v"(lane));
    const bf16* P = (const bf16*)(a.ws + WS_P);
    const float* E = (const float*)(a.ws + WS_S5E);
    bf16* Y5 = (bf16*)(a.ws + WS_Y5);
    const int fr = lane & 15, fq = lane >> 4;
    for (int unit = gw; unit < 4 * 32 * 64 + 32 * 32; unit += NGW) {
        int g, row0, ntok, seg = 0, bg; bool sample;
        if (unit < 8192) { seg = unit & 63; bg = unit >> 6; g = bg & 31; row0 = (bg >> 5) * 8192 + seg * 128; ntok = 128; sample = false; }
        else { bg = unit - 8192; g = bg & 31; row0 = TP + (bg >> 5) * 16; ntok = 16; sample = true; }
        S5Par q; s5_setup(a, g, lane, q);
        float xr = 0.f, xi = 0.f;
        if (sample) { xr = a.in[4][(size_t)bg * 64 + lane]; xi = a.in[5][(size_t)bg * 64 + lane]; }
        else {
            float pr = q.lr, pi = q.li;
#pragma unroll
            for (int s = 0; s < 7; ++s) { const float nr = pr * pr - pi * pi, ni = 2.f * pr * pi; pr = nr; pi = ni; }
            const float* e = E + (size_t)bg * 64 * 128;
            for (int s = 0; s < seg; ++s) { const float er = e[s * 128 + lane], ei = e[s * 128 + 64 + lane]; const float nr = pr * xr - pi * xi + er, ni = pr * xi + pi * xr + ei; xr = nr; xi = ni; }
        }
        bf16x8 cf[4];
#pragma unroll
        for (int ks = 0; ks < 4; ++ks) {
            const f32x4 cr = *(const f32x4*)(a.in[18] + (size_t)(g * 16 + fr) * 64 + 16 * ks + 4 * fq), ci = *(const f32x4*)(a.in[19] + (size_t)(g * 16 + fr) * 64 + 16 * ks + 4 * fq);
            u32x4 w; w.x = pk2(cr[0], -ci[0]); w.y = pk2(cr[1], -ci[1]); w.z = pk2(cr[2], -ci[2]); w.w = pk2(cr[3], -ci[3]);
            cf[ks] = __builtin_bit_cast(bf16x8, w);
        }
        const float Dg = a.in[20][g * 16 + fr];
        S5W w; s5w_setup(a, g, fr, fq, w);
        unsigned char* bt = xs + 4352;
        for (int tb = 0; tb < ntok; tb += 16) {
            {
                u32x4 uv = (u32x4){0u, 0u, 0u, 0u};
                if (fq < 2) uv = *(const u32x4*)(P + (size_t)(row0 + tb + fr) * PW + 2048 + g * 16 + 8 * fq);
                const bf16x8 ua = __builtin_bit_cast(bf16x8, uv);
                const f32x4 z = (f32x4){0.f, 0.f, 0.f, 0.f};
#pragma unroll
                for (int j = 0; j < 4; ++j) {
                    const f32x4 br = MFMA16(ua, w.bf[j], z), bi = MFMA16(ua, w.bf[4 + j], z);
                    *(f32x4*)(bt + (16 * j + fr) * 80 + fq * 16) = br; *(f32x4*)(bt + (64 + 16 * j + fr) * 80 + fq * 16) = bi;
                }
            }
            asm volatile("s_waitcnt lgkmcnt(0)" ::: "memory");
            f32x4 bre[4], bim[4];
#pragma unroll
            for (int k = 0; k < 4; ++k) { bre[k] = *(const f32x4*)(bt + lane * 80 + k * 16); bim[k] = *(const f32x4*)(bt + (64 + lane) * 80 + k * 16); }
            asm volatile("s_waitcnt lgkmcnt(0)" ::: "memory");
#pragma unroll
            for (int t = 0; t < 16; ++t) {
                const float nr = q.lr * xr - q.li * xi + bre[t >> 2][t & 3], ni = q.lr * xi + q.li * xr + bim[t >> 2][t & 3];
                xr = nr; xi = ni;
                *(unsigned*)(xs + t * 272 + lane * 4) = pk2(nr, ni);
            }
            asm volatile("s_waitcnt lgkmcnt(0)" ::: "memory");
            f32x4 y = (f32x4){0.f, 0.f, 0.f, 0.f};
#pragma unroll
            for (int ks = 0; ks < 4; ++ks) { const bf16x8 af = *(const bf16x8*)(xs + fr * 272 + ks * 64 + fq * 16); y = MFMA16(af, cf[ks], y); }
#pragma unroll
            for (int i = 0; i < 4; ++i) {
                const size_t row = (size_t)row0 + tb + 4 * fq + i;
                const float uu = b2f(P[row * PW + 2048 + g * 16 + fr]);
                Y5[row * 512 + g * 16 + fr] = f2b(gelu_tanh(y[i] + Dg * uu));
            }
        }
        if (sample) { a.out[O_SSR + (size_t)bg * 64 + lane] = xr; a.out[O_SSI + (size_t)bg * 64 + lane] = xi; }
        else if (seg == 63) { a.out[O_PSR + (size_t)bg * 64 + lane] = xr; a.out[O_PSI + (size_t)bg * 64 + lane] = xi; }
    }
}

constexpr int DB_WN = 0, DB_QG = 17408, DB_KDT = 34816, DB_QK = 53248, DB_U0 = 62464;
constexpr int DBP_SIZE = DB_U0 + 64 * 80;
constexpr int DBS_SIZE = DB_U0 + 64 * 272;
template <int NC> struct DnRegs { u32x4 r[7]; u32x4 u[NC == 32 ? 1 : 2]; };
template <int NC> DI void dn_load(const unsigned char* rec, int tid, int c0, DnRegs<NC>& R) {
    const u32x4* g = (const u32x4*)rec;
    R.r[0] = g[tid]; R.r[1] = g[tid + 512]; R.r[2] = g[1024 + tid]; R.r[3] = g[1024 + tid + 512]; R.r[4] = g[2048 + tid]; R.r[5] = g[2048 + tid + 512]; R.r[6] = g[3072 + tid];
    if (NC == 32) { if (tid < 256) R.u[0] = *(const u32x4*)(rec + R_U0 + (tid >> 2) * 256 + c0 * 2 + (tid & 3) * 16); }
    else { R.u[0] = *(const u32x4*)(rec + R_U0 + tid * 16); R.u[1] = *(const u32x4*)(rec + R_U0 + (tid + 512) * 16); }
}
template <int NC> DI void dn_store(unsigned char* buf, int tid, const DnRegs<NC>& R) {
#pragma unroll
    for (int j = 0; j < 2; ++j) { const int q = tid + 512 * j;
        *(u32x4*)(buf + DB_WN + (q >> 4) * 272 + (q & 15) * 16) = R.r[j];
        *(u32x4*)(buf + DB_QG + (q >> 4) * 272 + (q & 15) * 16) = R.r[2 + j];
        *(u32x4*)(buf + DB_KDT + (q >> 3) * 144 + (q & 7) * 16) = R.r[4 + j]; }
    *(u32x4*)(buf + DB_QK + (tid >> 3) * 144 + (tid & 7) * 16) = R.r[6];
    if (NC == 32) { if (tid < 256) *(u32x4*)(buf + DB_U0 + (tid >> 2) * 80 + (tid & 3) * 16) = R.u[0]; }
    else {
#pragma unroll
        for (int j = 0; j < 2; ++j) { const int q = tid + 512 * j; *(u32x4*)(buf + DB_U0 + (q >> 4) * 272 + (q & 15) * 16) = R.u[j]; }
    }
}
DI bf16x8 pack8(const f32x4& lo, const f32x4& hi) { u32x4 w; w.x = pk2(lo[0], lo[1]); w.y = pk2(lo[2], lo[3]); w.z = pk2(hi[0], hi[1]); w.w = pk2(hi[2], hi[3]); return __builtin_bit_cast(bf16x8, w); }
template <int UPI> DI void dn_step(const unsigned char* buf, f32x4 (&S)[8], const unsigned char* u0, float eg, int fr, int fq, f32x4 (&o)[4]) {
    bf16x8 Sb[4];
#pragma unroll
    for (int ks = 0; ks < 4; ++ks) Sb[ks] = pack8(S[2 * ks], S[2 * ks + 1]);
    f32x4 u[4];
#pragma unroll
    for (int mt = 0; mt < 4; ++mt) {
#pragma unroll
        for (int i = 0; i < 4; ++i) u[mt][i] = b2f(*(const bf16*)(u0 + (16 * mt + 4 * fq + i) * UPI));
#pragma unroll
        for (int ks = 0; ks < 4; ++ks) u[mt] = MFMA16(*(const bf16x8*)(buf + DB_WN + (16 * mt + fr) * 272 + ks * 64 + fq * 16), Sb[ks], u[mt]);
    }
    bf16x8 ub[2];
#pragma unroll
    for (int k2 = 0; k2 < 2; ++k2) ub[k2] = pack8(u[2 * k2], u[2 * k2 + 1]);
#pragma unroll
    for (int mt = 0; mt < 4; ++mt) {
        o[mt] = (f32x4){0.f, 0.f, 0.f, 0.f};
#pragma unroll
        for (int ks = 0; ks < 4; ++ks) o[mt] = MFMA16(*(const bf16x8*)(buf + DB_QG + (16 * mt + fr) * 272 + ks * 64 + fq * 16), Sb[ks], o[mt]);
#pragma unroll
        for (int k2 = 0; k2 < 2; ++k2) o[mt] = MFMA16(*(const bf16x8*)(buf + DB_QK + (16 * mt + fr) * 144 + k2 * 64 + fq * 16), ub[k2], o[mt]);
    }
#pragma unroll
    for (int m8 = 0; m8 < 8; ++m8) {
        S[m8] = S[m8] * eg;
#pragma unroll
        for (int k2 = 0; k2 < 2; ++k2) S[m8] = MFMA16(*(const bf16x8*)(buf + DB_KDT + (16 * m8 + fr) * 144 + k2 * 64 + fq * 16), ub[k2], S[m8]);
    }
}
#if DN_STAGED == 2
#define DNP_SYNC() do { asm volatile("s_waitcnt lgkmcnt(0)" ::: "memory"); __builtin_amdgcn_sched_barrier(0); } while (0)
#else
#define DNP_SYNC() do { } while (0)
#endif
DI void dn_step_p(const unsigned char* buf, f32x4 (&S)[8], const unsigned char* u0, float eg, int fr, int fq, f32x4 (&o)[4]) {
    const unsigned char* aw = buf + DB_WN + fr * 272 + fq * 16;
    const unsigned char* aq = buf + DB_QG + fr * 272 + fq * 16;
    const unsigned char* ak = buf + DB_KDT + fr * 144 + fq * 16;
    const unsigned char* ac = buf + DB_QK + fr * 144 + fq * 16;
    bf16x8 f1[16], f2[16], Sb[4], ub[2];
    f32x4 u[4];
#pragma unroll
    for (int mt = 0; mt < 4; ++mt)
#pragma unroll
        for (int ks = 0; ks < 4; ++ks) f1[4 * mt + ks] = *(const bf16x8*)(aw + mt * 4352 + ks * 64);
#pragma unroll
    for (int mt = 0; mt < 4; ++mt)
#pragma unroll
        for (int i = 0; i < 4; ++i) u[mt][i] = b2f(*(const bf16*)(u0 + (16 * mt + 4 * fq + i) * 80));
#pragma unroll
    for (int ks = 0; ks < 4; ++ks) Sb[ks] = pack8(S[2 * ks], S[2 * ks + 1]);
    __builtin_amdgcn_sched_barrier(0);
#pragma unroll
    for (int mt = 0; mt < 4; ++mt)
#pragma unroll
        for (int ks = 0; ks < 4; ++ks) f2[4 * mt + ks] = *(const bf16x8*)(aq + mt * 4352 + ks * 64);
    DNP_SYNC();
#pragma unroll
    for (int ks = 0; ks < 4; ++ks)
#pragma unroll
        for (int mt = 0; mt < 4; ++mt) u[mt] = MFMA16(f1[4 * mt + ks], Sb[ks], u[mt]);
    __builtin_amdgcn_sched_barrier(0);
#pragma unroll
    for (int k2 = 0; k2 < 2; ++k2) ub[k2] = pack8(u[2 * k2], u[2 * k2 + 1]);
#pragma unroll
    for (int m8 = 0; m8 < 8; ++m8)
#pragma unroll
        for (int k2 = 0; k2 < 2; ++k2) f1[2 * m8 + k2] = *(const bf16x8*)(ak + m8 * 2304 + k2 * 64);
    DNP_SYNC();
#pragma unroll
    for (int mt = 0; mt < 4; ++mt) o[mt] = (f32x4){0.f, 0.f, 0.f, 0.f};
#pragma unroll
    for (int ks = 0; ks < 4; ++ks)
#pragma unroll
        for (int mt = 0; mt < 4; ++mt) o[mt] = MFMA16(f2[4 * mt + ks], Sb[ks], o[mt]);
    __builtin_amdgcn_sched_barrier(0);
#pragma unroll
    for (int mt = 0; mt < 4; ++mt)
#pragma unroll
        for (int k2 = 0; k2 < 2; ++k2) f2[2 * mt + k2] = *(const bf16x8*)(ac + mt * 2304 + k2 * 64);
    DNP_SYNC();
#pragma unroll
    for (int m8 = 0; m8 < 8; ++m8) S[m8] = S[m8] * eg;
#pragma unroll
    for (int k2 = 0; k2 < 2; ++k2)
#pragma unroll
        for (int m8 = 0; m8 < 8; ++m8) S[m8] = MFMA16(f1[2 * m8 + k2], ub[k2], S[m8]);
    __builtin_amdgcn_sched_barrier(0);
#pragma unroll
    for (int k2 = 0; k2 < 2; ++k2)
#pragma unroll
        for (int mt = 0; mt < 4; ++mt) o[mt] = MFMA16(f2[2 * mt + k2], ub[k2], o[mt]);
}
DI void dn_piece(int q, int c0, unsigned& src, unsigned& dst) {
    if (q < 1024) { src = R_WN + q * 16; dst = DB_WN + (q >> 4) * 272 + (q & 15) * 16; }
    else if (q < 2048) { const int p = q - 1024; src = R_QG + p * 16; dst = DB_QG + (p >> 4) * 272 + (p & 15) * 16; }
    else if (q < 3072) { const int p = q - 2048; src = R_KDT + p * 16; dst = DB_KDT + (p >> 3) * 144 + (p & 7) * 16; }
    else if (q < 3584) { const int p = q - 3072; src = R_QK + p * 16; dst = DB_QK + (p >> 3) * 144 + (p & 7) * 16; }
    else { const int p = q - 3584; src = R_U0 + (p >> 2) * 256 + c0 * 2 + (p & 3) * 16; dst = DB_U0 + (p >> 2) * 80 + (p & 3) * 16; }
}
#define DN_LD(R, base) do { _Pragma("unroll") for (int k = 0; k < 10; ++k) { unsigned s_, d_; dn_piece(lt + 384 * k, c0, s_, d_); R[k] = *(const u32x4*)((base) + s_); } } while (0)
#define DN_WAIT(R, cnt) do { } while (0)
#define DN_ST(R, buf) do { _Pragma("unroll") for (int k = 0; k < 10; ++k) { unsigned s_, d_; dn_piece(lt + 384 * k, c0, s_, d_); *(u32x4*)((buf) + d_) = R[k]; } } while (0)
#define DN_BAR() do { asm volatile("s_waitcnt lgkmcnt(0)" ::: "memory"); __builtin_amdgcn_s_barrier(); asm volatile("" ::: "memory"); } while (0)
DI void dn_scan_prompt(const Args& a, unsigned char* lds, int tid) {
    asm volatile("" : "+v"(tid));
    const int wave = __builtin_amdgcn_readfirstlane(tid >> 6), lane = tid & 63, fr = lane & 15, fq = lane >> 4;
    const int bh = blockIdx.x >> 2, qt = blockIdx.x & 3, b = bh >> 2, h = bh & 3;
    const int c0 = qt * 32, v0 = c0 + (wave & 1) * 16;
    const unsigned char* recs = a.ws + WS_DNC + (size_t)bh * 128 * REC;
    const float* egs = (const float*)(a.ws + WS_EG) + bh * 128;
    float* ORAW = (float*)(a.ws + WS_H);
    const bool loader = wave >= 2;
    const int lt = tid - 128;
    f32x4 S[8];
#pragma unroll
    for (int m8 = 0; m8 < 8; ++m8) S[m8] = (f32x4){0.f, 0.f, 0.f, 0.f};
    float egA = egs[lane], egB = egs[64 + lane];
    asm volatile("s_waitcnt vmcnt(0)" : "+v"(egA), "+v"(egB) :: "memory");
    if (loader) {
        const int grp = wave >= 5 ? 1 : 0, lt2 = tid - 128 - grp * 192;
        u32x4 R[20];
#define DN_LD20(base) do { _Pragma("unroll") for (int k = 0; k < 20; ++k) { unsigned s_, d_; dn_piece(lt2 + 192 * k, c0, s_, d_); R[k] = *(const u32x4*)((base) + s_); } } while (0)
#define DN_ST20(buf) do { _Pragma("unroll") for (int k = 0; k < 20; ++k) { unsigned s_, d_; dn_piece(lt2 + 192 * k, c0, s_, d_); *(u32x4*)((buf) + d_) = R[k]; } } while (0)
        if (grp == 0) { DN_LD20(recs); DN_ST20(lds); DN_LD20(recs + 2 * (size_t)REC); }
        else { DN_LD20(recs + REC); }
        DN_BAR();
        for (int n = 0; n < 128; n += 2) {
            if (grp == 1) { DN_ST20(lds + DBP_SIZE); if (n + 3 < 128) DN_LD20(recs + (size_t)(n + 3) * REC); }
            DN_BAR();
            if (grp == 0 && n + 2 < 128) { DN_ST20(lds); if (n + 4 < 128) DN_LD20(recs + (size_t)(n + 4) * REC); }
            DN_BAR();
        }
#undef DN_LD20
#undef DN_ST20
    } else {
        DN_BAR();
        for (int n = 0; n < 128; ++n) {
            const float eg0 = __int_as_float(__builtin_amdgcn_readlane(__float_as_int(n < 64 ? egA : egB), n & 63));
            f32x4 o[4];
#if DN_STAGED
            dn_step_p(lds + (n & 1) * DBP_SIZE, S, lds + (n & 1) * DBP_SIZE + DB_U0 + ((wave & 1) * 16 + fr) * 2, eg0, fr, fq, o);
#else
            dn_step<80>(lds + (n & 1) * DBP_SIZE, S, lds + (n & 1) * DBP_SIZE + DB_U0 + ((wave & 1) * 16 + fr) * 2, eg0, fr, fq, o);
#endif
            float* op = ORAW + (size_t)(b * 8192 + n * 64) * 512 + h * 128 + v0 + fr;
#pragma unroll
            for (int mt = 0; mt < 4; ++mt)
#pragma unroll
                for (int i = 0; i < 4; ++i) op[(size_t)(16 * mt + 4 * fq + i) * 512] = o[mt][i];
            DN_BAR();
        }
    }
    if (!loader) {
        float* so = a.out + O_PDS + (size_t)bh * 128 * 128 + v0 + fr;
#pragma unroll
        for (int m8 = 0; m8 < 8; ++m8)
#pragma unroll
            for (int i = 0; i < 4; ++i) so[(16 * m8 + 4 * fq + i) * 128] = S[m8][i];
    }
    __syncthreads();
}
DI void dn_scan_sample(const Args& a, unsigned char* lds, int tid, int wg, int nwg) {
    asm volatile("" : "+v"(tid));
    const int wave = __builtin_amdgcn_readfirstlane(tid >> 6), lane = tid & 63, fr = lane & 15, fq = lane >> 4;
    const int v0 = wave * 16;
    float* ORAW = (float*)(a.ws + WS_H);
    for (int su = wg; su < 128; su += nwg) {
        const int sb = su >> 2, h = su & 3;
        const unsigned char* rec = a.ws + WS_DNC + (size_t)(2048 + su) * REC;
        DnRegs<128> R; dn_load<128>(rec, tid, 0, R); dn_store<128>(lds, tid, R);
        __syncthreads();
        f32x4 S[8];
        const float* s0 = a.in[3] + (size_t)su * 128 * 128 + v0 + fr;
#pragma unroll
        for (int m8 = 0; m8 < 8; ++m8)
#pragma unroll
            for (int i = 0; i < 4; ++i) S[m8][i] = s0[(16 * m8 + 4 * fq + i) * 128];
        f32x4 o[4];
        dn_step<272>(lds, S, lds + DB_U0 + (v0 + fr) * 2, ((const float*)(a.ws + WS_EG))[2048 + su], fr, fq, o);
        float* op = ORAW + (size_t)(TP + sb * 16) * 512 + h * 128 + v0 + fr;
#pragma unroll
        for (int i = 0; i < 4; ++i) op[(size_t)(4 * fq + i) * 512] = o[0][i];
        float* so = a.out + O_SDS + (size_t)su * 128 * 128 + v0 + fr;
#pragma unroll
        for (int m8 = 0; m8 < 8; ++m8)
#pragma unroll
            for (int i = 0; i < 4; ++i) so[(16 * m8 + 4 * fq + i) * 128] = S[m8][i];
        __syncthreads();
    }
}

DI void mix_phase(const Args& a, int gw, int NGW, int lane) {
    asm volatile("" : "+v"(lane));
    const float* ORAW = (const float*)(a.ws + WS_H);
    const bf16* P = (const bf16*)(a.ws + WS_P);
    const bf16* GLU = (const bf16*)(a.ws + WS_GLU);
    bf16* MIX = (bf16*)(a.ws + WS_DNC);
    const f32x2 dg = *(const f32x2*)(a.in[12] + 2 * lane);
    const f32x4 sg0 = *(const f32x4*)(a.in[23] + 8 * lane), sg1 = *(const f32x4*)(a.in[23] + 8 * lane + 4);
    for (int row = gw; row < T; row += NGW) {
#pragma unroll
        for (int h = 0; h < 4; ++h) {
            const f32x2 ov = *(const f32x2*)(ORAW + (size_t)row * 512 + h * 128 + 2 * lane);
            const float r = rsqrtf(wave_sum(ov.x * ov.x + ov.y * ov.y) * (1.f / 128.f) + EPS);
            const unsigned zz = *(const unsigned*)(P + (size_t)row * PW + 1536 + h * 128 + 2 * lane);
            *(unsigned*)(MIX + (size_t)row * DM + h * 128 + 2 * lane) = pk2(ov.x * r * dg.x * silu(blo(zz)), ov.y * r * dg.y * silu(bhi(zz)));
        }
        const u32x4 gv = *(const u32x4*)(GLU + (size_t)row * 512 + 8 * lane);
        float v[8] = {blo(gv.x), bhi(gv.x), blo(gv.y), bhi(gv.y), blo(gv.z), bhi(gv.z), blo(gv.w), bhi(gv.w)};
        float ss = 0.f;
#pragma unroll
        for (int e = 0; e < 8; ++e) ss += v[e] * v[e];
        const float r5 = rsqrtf(wave_sum(ss) * (1.f / 512.f) + EPS);
        u32x4 w; w.x = pk2(v[0] * r5 * sg0[0], v[1] * r5 * sg0[1]); w.y = pk2(v[2] * r5 * sg0[2], v[3] * r5 * sg0[3]);
        w.z = pk2(v[4] * r5 * sg1[0], v[5] * r5 * sg1[1]); w.w = pk2(v[6] * r5 * sg1[2], v[7] * r5 * sg1[3]);
        *(u32x4*)(MIX + (size_t)row * DM + 512 + 8 * lane) = w;
    }
}

DI void act_phase(const Args& a, int gtid, int NT) {
    asm volatile("" : "+v"(gtid));
    bf16* UP = (bf16*)(a.ws + WS_UP);
    const float* fw = a.in[27]; const float* fb = a.in[28];
    constexpr int NCG = DFF / 8;
    for (int item = gtid; item < (T / 16) * NCG; item += NT) {
        const int cg8 = item % NCG, rb = item / NCG, col = cg8 * 8, row0 = rb * 16;
        float w0[8], w1[8], w2[8], bb[8], g2[8], g1[8];
#pragma unroll
        for (int e = 0; e < 8; ++e) { w0[e] = fw[col + e]; w1[e] = fw[DFF + col + e]; w2[e] = fw[2 * DFF + col + e]; bb[e] = fb[col + e]; g2[e] = 0.f; g1[e] = 0.f; }
        const bool sample = row0 >= TP;
        float* outp = nullptr;
        if (sample) { const int sb = (row0 - TP) >> 4; const float* cc = a.in[6] + (size_t)sb * 2 * DFF + col;
#pragma unroll
            for (int e = 0; e < 8; ++e) { g2[e] = cc[e]; g1[e] = cc[DFF + e]; }
            outp = a.out + O_SFC + (size_t)sb * 2 * DFF + col;
        } else {
            if ((rb & 511) != 0) {
                const u32x4 x2 = *(const u32x4*)(UP + (size_t)(row0 - 2) * UPW + col), x1 = *(const u32x4*)(UP + (size_t)(row0 - 1) * UPW + col);
                g2[0] = blo(x2.x); g2[1] = bhi(x2.x); g2[2] = blo(x2.y); g2[3] = bhi(x2.y); g2[4] = blo(x2.z); g2[5] = bhi(x2.z); g2[6] = blo(x2.w); g2[7] = bhi(x2.w);
                g1[0] = blo(x1.x); g1[1] = bhi(x1.x); g1[2] = blo(x1.y); g1[3] = bhi(x1.y); g1[4] = blo(x1.z); g1[5] = bhi(x1.z); g1[6] = blo(x1.w); g1[7] = bhi(x1.w);
            }
            if ((rb & 511) == 511) outp = a.out + O_PFC + (size_t)(rb >> 9) * 2 * DFF + col;
        }
#pragma unroll 4
        for (int r = 0; r < 16; ++r) {
            bf16* gp = UP + (size_t)(row0 + r) * UPW + col;
            const u32x4 xg = *(const u32x4*)gp, xv = *(const u32x4*)(gp + DFF);
            float g0[8] = {blo(xg.x), bhi(xg.x), blo(xg.y), bhi(xg.y), blo(xg.z), bhi(xg.z), blo(xg.w), bhi(xg.w)};
            float vv[8] = {blo(xv.x), bhi(xv.x), blo(xv.y), bhi(xv.y), blo(xv.z), bhi(xv.z), blo(xv.w), bhi(xv.w)};
            float o[8];
#pragma unroll
            for (int e = 0; e < 8; ++e) { o[e] = silu(g2[e] * w0[e] + g1[e] * w1[e] + g0[e] * w2[e] + bb[e]) * vv[e]; g2[e] = g1[e]; g1[e] = g0[e]; }
            u32x4 w; w.x = pk2(o[0], o[1]); w.y = pk2(o[2], o[3]); w.z = pk2(o[4], o[5]); w.w = pk2(o[6], o[7]);
            *(u32x4*)(gp + DFF) = w;
            if (outp && r >= 14) {
#pragma unroll
                for (int e = 0; e < 8; ++e) outp[(r - 14) * DFF + e] = g0[e];
            }
        }
    }
}

DI void act_fix_phase(const Args& a, int gtid, int NT) {
    asm volatile("" : "+v"(gtid));
    bf16* ACT = (bf16*)(a.ws + WS_UP);
    const bf16* GH = (const bf16*)(a.ws + WS_GH); const bf16* GT = (const bf16*)(a.ws + WS_GT); const bf16* VH = (const bf16*)(a.ws + WS_VH);
    const float* fw = a.in[27]; const float* fb = a.in[28];
    constexpr int NCG = DFF / 8;
    for (int item = gtid; item < (T / 16) * NCG; item += NT) {
        const int cg8 = item % NCG, grp = item / NCG, col = cg8 * 8;
        float w0[8], w1[8], w2[8], bb[8], g2[8], g1[8], h0[8], h1[8], v0[8], v1[8];
#pragma unroll
        for (int e = 0; e < 8; ++e) { w0[e] = fw[col + e]; w1[e] = fw[DFF + col + e]; w2[e] = fw[2 * DFF + col + e]; bb[e] = fb[col + e]; g2[e] = 0.f; g1[e] = 0.f; }
        const bool sample = grp >= TP / 16;
        if (sample) { const float* cc = a.in[6] + (size_t)(grp - TP / 16) * 2 * DFF + col;
#pragma unroll
            for (int e = 0; e < 8; ++e) { g2[e] = cc[e]; g1[e] = cc[DFF + e]; }
        } else if ((grp & 511) != 0) {
            const u32x4 x2 = *(const u32x4*)(GT + ((size_t)(grp - 1) * 2) * DFF + col), x1 = *(const u32x4*)(GT + ((size_t)(grp - 1) * 2 + 1) * DFF + col);
            g2[0] = blo(x2.x); g2[1] = bhi(x2.x); g2[2] = blo(x2.y); g2[3] = bhi(x2.y); g2[4] = blo(x2.z); g2[5] = bhi(x2.z); g2[6] = blo(x2.w); g2[7] = bhi(x2.w);
            g1[0] = blo(x1.x); g1[1] = bhi(x1.x); g1[2] = blo(x1.y); g1[3] = bhi(x1.y); g1[4] = blo(x1.z); g1[5] = bhi(x1.z); g1[6] = blo(x1.w); g1[7] = bhi(x1.w);
        }
        {
            const u32x4 xa = *(const u32x4*)(GH + ((size_t)grp * 2) * DFF + col), xb = *(const u32x4*)(GH + ((size_t)grp * 2 + 1) * DFF + col);
            const u32x4 ya = *(const u32x4*)(VH + ((size_t)grp * 2) * DFF + col), yb = *(const u32x4*)(VH + ((size_t)grp * 2 + 1) * DFF + col);
            h0[0] = blo(xa.x); h0[1] = bhi(xa.x); h0[2] = blo(xa.y); h0[3] = bhi(xa.y); h0[4] = blo(xa.z); h0[5] = bhi(xa.z); h0[6] = blo(xa.w); h0[7] = bhi(xa.w);
            h1[0] = blo(xb.x); h1[1] = bhi(xb.x); h1[2] = blo(xb.y); h1[3] = bhi(xb.y); h1[4] = blo(xb.z); h1[5] = bhi(xb.z); h1[6] = blo(xb.w); h1[7] = bhi(xb.w);
            v0[0] = blo(ya.x); v0[1] = bhi(ya.x); v0[2] = blo(ya.y); v0[3] = bhi(ya.y); v0[4] = blo(ya.z); v0[5] = bhi(ya.z); v0[6] = blo(ya.w); v0[7] = bhi(ya.w);
            v1[0] = blo(yb.x); v1[1] = bhi(yb.x); v1[2] = blo(yb.y); v1[3] = bhi(yb.y); v1[4] = blo(yb.z); v1[5] = bhi(yb.z); v1[6] = blo(yb.w); v1[7] = bhi(yb.w);
        }
        float o0[8], o1[8];
#pragma unroll
        for (int e = 0; e < 8; ++e) { o0[e] = silu(g2[e] * w0[e] + g1[e] * w1[e] + h0[e] * w2[e] + bb[e]) * v0[e]; o1[e] = silu(g1[e] * w0[e] + h0[e] * w1[e] + h1[e] * w2[e] + bb[e]) * v1[e]; }
        u32x4 wa, wb; wa.x = pk2(o0[0], o0[1]); wa.y = pk2(o0[2], o0[3]); wa.z = pk2(o0[4], o0[5]); wa.w = pk2(o0[6], o0[7]);
        wb.x = pk2(o1[0], o1[1]); wb.y = pk2(o1[2], o1[3]); wb.z = pk2(o1[4], o1[5]); wb.w = pk2(o1[6], o1[7]);
        *(u32x4*)(ACT + ((size_t)grp * 16) * DFF + col) = wa; *(u32x4*)(ACT + ((size_t)grp * 16 + 1) * DFF + col) = wb;
        float* outp = nullptr;
        if (sample) outp = a.out + O_SFC + (size_t)(grp - TP / 16) * 2 * DFF + col;
        else if ((grp & 511) == 511) outp = a.out + O_PFC + (size_t)(grp >> 9) * 2 * DFF + col;
        if (outp) {
            const u32x4 t0 = *(const u32x4*)(GT + ((size_t)grp * 2) * DFF + col), t1 = *(const u32x4*)(GT + ((size_t)grp * 2 + 1) * DFF + col);
            outp[0] = blo(t0.x); outp[1] = bhi(t0.x); outp[2] = blo(t0.y); outp[3] = bhi(t0.y); outp[4] = blo(t0.z); outp[5] = bhi(t0.z); outp[6] = blo(t0.w); outp[7] = bhi(t0.w);
            outp[DFF + 0] = blo(t1.x); outp[DFF + 1] = bhi(t1.x); outp[DFF + 2] = blo(t1.y); outp[DFF + 3] = bhi(t1.y); outp[DFF + 4] = blo(t1.z); outp[DFF + 5] = bhi(t1.z); outp[DFF + 6] = blo(t1.w); outp[DFF + 7] = bhi(t1.w);
        }
    }
}

DI void final_phase(const Args& a, int gw, int NGW, int lane) {
    asm volatile("" : "+v"(lane));
    f32x4 gv[4];
#pragma unroll
    for (int j = 0; j < 4; ++j) gv[j] = ((const f32x4*)a.in[30])[lane + 64 * j];
    for (int m0 = gw; m0 < T; m0 += 2 * NGW) {
        const int m1 = m0 + NGW < T ? m0 + NGW : m0;
        f32x4* xr0 = (f32x4*)(a.out + (size_t)m0 * DM) + lane; f32x4* xr1 = (f32x4*)(a.out + (size_t)m1 * DM) + lane;
        f32x4 v0[4], v1[4]; float s0 = 0.f, s1 = 0.f;
#pragma unroll
        for (int j = 0; j < 4; ++j) { v0[j] = xr0[64 * j]; v1[j] = xr1[64 * j]; }
#pragma unroll
        for (int j = 0; j < 4; ++j) { s0 += (v0[j].x * v0[j].x + v0[j].y * v0[j].y) + (v0[j].z * v0[j].z + v0[j].w * v0[j].w); s1 += (v1[j].x * v1[j].x + v1[j].y * v1[j].y) + (v1[j].z * v1[j].z + v1[j].w * v1[j].w); }
        const float r0 = rsqrtf(wave_sum(s0) * (1.f / DM) + EPS), r1 = rsqrtf(wave_sum(s1) * (1.f / DM) + EPS);
#pragma unroll
        for (int j = 0; j < 4; ++j) xr0[64 * j] = v0[j] * r0 * gv[j];
        if (m1 != m0) {
#pragma unroll
            for (int j = 0; j < 4; ++j) xr1[64 * j] = v1[j] * r1 * gv[j];
        }
    }
}

#ifndef PH_MASK
#define PH_MASK 0xffff
#endif
#ifndef SOLVE_RL
#define SOLVE_RL 1
#endif
#ifndef REP0
#define REP0 1
#endif
#ifndef REP1
#define REP1 1
#endif
#ifndef REP2A
#define REP2A 1
#endif
#ifndef REP2B
#define REP2B 1
#endif
#ifndef REP3A
#define REP3A 1
#endif
#ifndef REP3B
#define REP3B 1
#endif
#ifndef REP3C
#define REP3C 1
#endif
#ifndef PH_LO
#define PH_LO 0
#endif
#ifndef PH_HI
#define PH_HI 99
#endif
__global__ void __launch_bounds__(512, 2) fwd_kernel(Args a) {
    extern __shared__ __attribute__((aligned(16))) unsigned char lds[];
    cg::grid_group grid = cg::this_grid();
    const int tid = threadIdx.x, lane = tid & 63, wave = __builtin_amdgcn_readfirstlane(tid >> 6);
    const int G = gridDim.x, gw = blockIdx.x * 8 + wave, NGW = G * 8;
    unsigned char* ws = a.ws;
    PG8_LAS unsigned char* ldsg = (PG8_LAS unsigned char*)lds;
    volatile LAS unsigned* xbst = (volatile LAS unsigned*)(ldsg + (LDS_BYTES - 64));
    if (tid < 2) xbst[tid] = 0u;
    __syncthreads();
    const XcdBarrier xbar = xcd_barrier_post((unsigned*)(ws + WS_CTL), xbst);

    _Pragma("nounroll") for (int rep = 0; rep < REP0; ++rep) { phase0(a, lds, gw, NGW, wave, lane); __syncthreads(); }
    grid.sync();
    _Pragma("nounroll") for (int rep = 0; rep < REP1; ++rep)
    { pg8::Gemm g{(const bf16*)(ws + WS_H), (const bf16*)(ws + WS_WIN), T, NIN, DM, DM}; pg8::StaticOrder S; S.init(T, NIN, G, (int)blockIdx.x);
      EpiP E{(bf16*)(ws + WS_P), (float*)(ws + WS_BA)};
      pg8::gemm_phase<EpiP, pg8::StaticOrder, true, true>(ldsg, g, S, E); }
    xcd_barrier(xbar);
    _Pragma("nounroll") for (int rep = 0; rep < REP2A; ++rep) dn_chunk_phase(a, lds, tid);
#if OLD_S5 && OLD_S5 != 4 && OLD_S5 != 5
    old_s5_pass1(a, gw, NGW, lane);
#elif 0
#else
    _Pragma("nounroll") for (int rep = 0; rep < REP2B; ++rep) s5_pass1(a, gw, NGW, lane);
#endif
    xcd_barrier(xbar);
#if OLD_S5 == 3
    if (blockIdx.x < 64) dn_scan_prompt(a, lds, tid);
    else { if (blockIdx.x >= 192) { dn_scan_sample(a, lds, tid, (int)blockIdx.x - 192, 64); s5_pass2_sample(a, lds + 81920 + wave * 4352, ((int)blockIdx.x - 192) * 8 + wave, 512, lane); __syncthreads(); }
           old_s5_pass2(a, lds + 81920 + wave * 4352, gw - 512, NGW - 512, lane); }
#elif OLD_S5 == 5
    if (blockIdx.x < 64) { _Pragma("nounroll") for (int rep = 0; rep < REP3A; ++rep) dn_scan_prompt(a, lds, tid); }
    else { if (blockIdx.x >= 192) dn_scan_sample(a, lds, tid, (int)blockIdx.x - 192, 64); _Pragma("nounroll") for (int rep = 0; rep < REP3B; ++rep) s5_pass2b(a, lds + wave * 14592, gw - 512, NGW - 512, lane); }
#elif OLD_S5 == 1 || OLD_S5 == 4
    if (blockIdx.x < 64) dn_scan_prompt(a, lds, tid);
    else { if (blockIdx.x >= 192) dn_scan_sample(a, lds, tid, (int)blockIdx.x - 192, 64); old_s5_pass2(a, lds + 81920 + wave * 4352, gw - 512, NGW - 512, lane); }
#else
    if (blockIdx.x < 64) { _Pragma("nounroll") for (int rep = 0; rep < REP3A; ++rep) dn_scan_prompt(a, lds, tid); }
    else if (blockIdx.x < 192) { _Pragma("nounroll") for (int rep = 0; rep < REP3B; ++rep) s5_pass2_prompt(a, lds, (int)blockIdx.x - 64, tid); }
    else { _Pragma("nounroll") for (int rep = 0; rep < REP3C; ++rep) { dn_scan_sample(a, lds, tid, (int)blockIdx.x - 192, 64); s5_pass2_sample(a, lds + 81920 + wave * 4352, ((int)blockIdx.x - 192) * 8 + wave, 512, lane); } }
#endif
    xcd_barrier(xbar);
#if PH_MASK & 512
    { pg8::Gemm g{(const bf16*)(ws + WS_Y5), (const bf16*)(ws + WS_WGLU), T, 1024, 512, 512}; pg8::StaticOrder S; S.init(T, 1024, G, (int)blockIdx.x);
      EpiGlu E{(bf16*)(ws + WS_GLU), a.in[22]};
      pg8::gemm_phase<EpiGlu, pg8::StaticOrder, true, true>(ldsg, g, S, E); }
#endif
    xcd_barrier(xbar);
#if PH_MASK & 32
    mix_phase(a, gw, NGW, lane);
#endif
    xcd_barrier(xbar);
#if PH_MASK & 1024
    { pg8::Gemm g{(const bf16*)(ws + WS_DNC), (const bf16*)(ws + WS_WOUT), T, DM, DM, DM}; pg8::StaticOrder S; S.init(T, DM, G, (int)blockIdx.x);
      EpiX1 E{a.in[0], a.in[1], a.out, (bf16*)(ws + WS_H), (float*)(ws + WS_SS2)};
      pg8::gemm_phase<EpiX1, pg8::StaticOrder, true, true>(ldsg, g, S, E); }
#endif
    xcd_barrier(xbar);
#if FUSE_ACT
    { pg8::Gemm g{(const bf16*)(ws + WS_H), (const bf16*)(ws + WS_WUP), T, UPW, DM, DM}; pg8::StaticOrder S; S.init(T, UPW, G, (int)blockIdx.x);
      EpiUpAct E{(bf16*)(ws + WS_UP), (bf16*)(ws + WS_GH), (bf16*)(ws + WS_GT), (bf16*)(ws + WS_VH), (const float*)(ws + WS_SS2), a.in[27], a.in[28]};
      pg8::gemm_phase<EpiUpAct, pg8::StaticOrder, true, true>(ldsg, g, S, E); }
    xcd_barrier(xbar);
    act_fix_phase(a, (int)blockIdx.x * 512 + tid, G * 512);
    xcd_barrier(xbar);
    { pg8::Gemm g{(const bf16*)(ws + WS_UP), (const bf16*)(ws + WS_WDOWN), T, DM, DFF, DFF}; pg8::StaticOrder S; S.init(T, DM, G, (int)blockIdx.x);
      EpiX2 E{a.out};
      pg8::gemm_phase<EpiX2, pg8::StaticOrder, true, true>(ldsg, g, S, E); }
    xcd_barrier(xbar);
#else
#if PH_MASK & 2048
    { pg8::Gemm g{(const bf16*)(ws + WS_H), (const bf16*)(ws + WS_WUP), T, UPW, DM, DM}; pg8::StaticOrder S; S.init(T, UPW, G, (int)blockIdx.x);
      EpiUp E{(bf16*)(ws + WS_UP), (const float*)(ws + WS_SS2)};
      pg8::gemm_phase<EpiUp, pg8::StaticOrder, true, true>(ldsg, g, S, E); }
#endif
    xcd_barrier(xbar);
#if PH_MASK & 64
    act_phase(a, (int)blockIdx.x * 512 + tid, G * 512);
#endif
    xcd_barrier(xbar);
#if PH_MASK & 4096
    { pg8::Gemm g{(const bf16*)(ws + WS_UP) + DFF, (const bf16*)(ws + WS_WDOWN), T, DM, DFF, UPW}; pg8::StaticOrder S; S.init(T, DM, G, (int)blockIdx.x);
      EpiX2 E{a.out};
      pg8::gemm_phase<EpiX2, pg8::StaticOrder, true, true>(ldsg, g, S, E); }
#endif
    xcd_barrier(xbar);
#endif
#if PH_MASK & 128
    final_phase(a, gw, NGW, lane);
#endif
}

extern "C" void kernel_launch(void* const* d_in, const int* in_sizes, int n_in, void* d_out, int out_size, void* d_ws, size_t ws_size, hipStream_t stream) {
    static int grid = 0;
    if (grid == 0) {
        if (n_in != 31 || (size_t)out_size != O_END || ws_size < WS_END) { fprintf(stderr, "kernel_launch: unexpected shapes n_in %d out %d ws %zu\n", n_in, out_size, ws_size); grid = -1; return; }
        int dev = 0, cus = 0, per_cu = 0;
        hipGetDevice(&dev);
        hipDeviceGetAttribute(&cus, hipDeviceAttributeMultiprocessorCount, dev);
        hipFuncSetAttribute((const void*)fwd_kernel, hipFuncAttributeMaxDynamicSharedMemorySize, LDS_BYTES);
        hipOccupancyMaxActiveBlocksPerMultiprocessor(&per_cu, (const void*)fwd_kernel, 512, LDS_BYTES);
        if (per_cu < 1) { fprintf(stderr, "kernel_launch: occupancy query says %d blocks per CU\n", per_cu); per_cu = 1; }
        grid = cus * 1;
        if (grid != 256) { fprintf(stderr, "kernel_launch: built for a 256-CU device, got %d\n", cus); grid = -1; return; }
        (void)hipGetLastError();
    }
    if (grid < 0) return;
    if (hipMemsetAsync((char*)d_ws + WS_CTL, 0, 16384, stream) != hipSuccess) { fprintf(stderr, "kernel_launch: memset of the barrier words failed\n"); return; }
    Args a{};
    for (int i = 0; i < 31; ++i) a.in[i] = (const float*)d_in[i];
    a.out = (float*)d_out; a.ws = (unsigned char*)d_ws;
    void* args[] = {&a};
    hipError_t e = hipLaunchCooperativeKernel((const void*)fwd_kernel, dim3(grid), dim3(512), args, LDS_BYTES, stream);
    if (e != hipSuccess) fprintf(stderr, "cooperative launch failed: %s (grid %d)\n", hipGetErrorString(e), grid);
}
```

```cpp
#include <hip/hip_runtime.h>
#include <hip/hip_cooperative_groups.h>
#include <cstdio>
#include <cstdint>
namespace cg = cooperative_groups;
#define OLD_S5 5
#define DN_STAGED 3
namespace pg8 {
#define PG8_LAS __attribute__((address_space(3)))
typedef unsigned short bf16_t;
typedef short bf16x8 __attribute__((ext_vector_type(8)));
typedef float f32x4 __attribute__((ext_vector_type(4)));
typedef unsigned u32x4 __attribute__((ext_vector_type(4)));
constexpr int BM = 256, BK = 64, HALF = 128, HTB = HALF * BK * 2  , STAGE_BYTES = 8 * HTB, NXCD = 8, WGM = 8;

__host__ __device__ __forceinline__ int lds_byte(int r, int c) { const int st = (r >> 4) * 2 + (c >> 5), rr = r & 15, cc = c & 31, ob = rr * 64 + cc * 2; return st * 1024 + (ob ^ (((ob >> 9) & 1) << 5)); }
__host__ __device__ __forceinline__ void stage_rc(int b, int& R, int& C) { const int st = b / 1024, sb = b % 1024, swz = sb ^ (((sb >> 9) & 1) << 5); R = (st >> 1) * 16 + swz / 64; C = (st & 1) * 32 + (swz % 64) / 2; }
__host__ __device__ __forceinline__ int perm32(int rho) { const int n = rho >> 4, i = rho & 15; return 8 * (i >> 2) + 4 * n + (i & 3); }

struct Unit { int pm, pn; };
struct Gemm { const bf16_t* A; const bf16_t* Bt; int M, N, K, lda; };

struct StaticOrder {
    int nM, nN, nwg, G, c;
    __host__ __device__ void init(int M, int N, int G_, int c_) { nM = M / BM; nN = N / BM; nwg = nM * nN; G = G_; c = c_; }
    __host__ __device__ bool next(int i, Unit& u) const {
        const long L = (long)i * G + c; if (L >= nwg) return false;
        int wgid = (int)L; { const int q = nwg / NXCD, r = nwg % NXCD, xcd = wgid % NXCD, off = wgid / NXCD; wgid = (xcd < r ? xcd * (q + 1) : r * (q + 1) + (xcd - r) * q) + off; }
        const int nig = WGM * nN, gid = wgid / nig, fm = gid * WGM, gsz = (nM - fm) < WGM ? (nM - fm) : WGM;
        u.pm = fm + ((wgid % nig) % gsz); u.pn = (wgid % nig) / gsz; return true;
    }
    __device__ __forceinline__ void a_ready(const Unit&) const {}
    __device__ __forceinline__ void done(const Unit&) const {}
};
__device__ __forceinline__ unsigned cvt_pk_bf16(float lo, float hi) { unsigned r; asm volatile("v_cvt_pk_bf16_f32 %0, %1, %2" : "=v"(r) : "v"(lo), "v"(hi)); return r; }
typedef float f32x2 __attribute__((ext_vector_type(2)));
template <class Epi, class Sched, bool ALIGN_EPI = false, bool SP2 = false>
__device__ __forceinline__ void gemm_phase(PG8_LAS unsigned char* lds, const Gemm g, const Sched& S, const Epi& E) {
    int tid_ = threadIdx.x; asm volatile("" : "+v"(tid_));
    const int tid = tid_, wid = __builtin_amdgcn_readfirstlane(tid >> 6), lane = tid & 63, wr = wid >> 2, wc = wid & 3, fr = lane & 15, fq = lane >> 4;
    const int K = g.K, nt = K / BK;
    unsigned voffA[2], voffB[2];
#pragma unroll
    for (int i = 0; i < 2; ++i) { int R, C; stage_rc(tid * 16 + i * 8192, R, C); const int Rb = Epi::PERM ? ((R & ~31) + perm32(R & 31)) : R;
        voffA[i] = (unsigned)(R * g.lda + C) * 2u; voffB[i] = (unsigned)(Rb * K + C) * 2u; }
    const size_t kstep = (size_t)(BK * 2);
    const size_t hstep = (size_t)HALF * K * 2;
    const size_t tstep = 2 * hstep; const size_t hstepA = (size_t)HALF * g.lda * 2, tstepA = 2 * hstepA;
    const unsigned ldsw = (unsigned)wid * 1024u;
    const int aoff = lds_byte(wr * 64 + fr, fq * 8), boff = lds_byte(wc * 32 + fr, fq * 8);
#define PG8_SA(b, h) (((b) * 2 + (h)) * HTB)
#define PG8_SB(b, h) ((4 + (b) * 2 + (h)) * HTB)
#define PG8_STAGE(bufoff, gbase, voff) do { _Pragma("unroll") for (int _i = 0; _i < 2; ++_i) \
        __builtin_amdgcn_global_load_lds((const unsigned*)((const char*)(gbase) + (voff)[_i]), (PG8_LAS unsigned*)(lds + (bufoff) + ldsw + _i * 8192), 16, 0, 0); } while (0)
#define PG8_LDA(dst, b, h) do { _Pragma("unroll") for (int m = 0; m < 4; ++m) _Pragma("unroll") for (int k = 0; k < 2; ++k) dst[m][k] = *(const PG8_LAS bf16x8*)(lds + PG8_SA(b, h) + aoff + m * 2048 + k * 1024); } while (0)
#define PG8_LDB(dst, b, h) do { _Pragma("unroll") for (int n = 0; n < 2; ++n) _Pragma("unroll") for (int k = 0; k < 2; ++k) dst[n][k] = *(const PG8_LAS bf16x8*)(lds + PG8_SB(b, h) + boff + n * 2048 + k * 1024); } while (0)
#define PG8_MMA(ai, bj, At, Bt) do { __builtin_amdgcn_s_setprio(1); _Pragma("unroll") for (int m = 0; m < 4; ++m) _Pragma("unroll") for (int n = 0; n < 2; ++n) _Pragma("unroll") for (int k = 0; k < 2; ++k) \
        acc[ai][bj][m][n] = __builtin_amdgcn_mfma_f32_16x16x32_bf16(Bt[n][k], At[m][k], acc[ai][bj][m][n], 0, 0, 0); __builtin_amdgcn_s_setprio(0); } while (0)
#define PG8_WAIT_V(n) asm volatile("s_waitcnt vmcnt(" #n ")" ::: "memory")
#define PG8_WAIT_L(n) asm volatile("s_waitcnt lgkmcnt(" #n ")" ::: "memory")
#define PG8_BAR __builtin_amdgcn_s_barrier()
#define PG8_SCHED __builtin_amdgcn_sched_barrier(0)
    Unit cur, nxt; int ui = 0;
    if (!S.next(0, cur)) return;
    f32x4 acc[2][2][4][2];
#pragma unroll
    for (int a = 0; a < 2; ++a)
#pragma unroll
        for (int b = 0; b < 2; ++b)
#pragma unroll
            for (int m = 0; m < 4; ++m)
#pragma unroll
                for (int n = 0; n < 2; ++n) acc[a][b][m][n] = (f32x4){0.f, 0.f, 0.f, 0.f};
    bf16x8 At[4][2], B0[2][2], B1[2][2];
    const char* cA = (const char*)g.A + (size_t)cur.pm * tstepA; const char* cB = (const char*)g.Bt + (size_t)cur.pn * tstep;
    S.a_ready(cur);
    if constexpr (SP2) {
        PG8_STAGE(PG8_SB(0, 0), cB, voffB); PG8_STAGE(PG8_SB(0, 1), cB + hstep, voffB); PG8_STAGE(PG8_SA(0, 0), cA, voffA); PG8_STAGE(PG8_SA(0, 1), cA + hstepA, voffA);
        if (wr == 1) PG8_BAR;
        PG8_WAIT_V(2); PG8_BAR;
        PG8_STAGE(PG8_SB(1, 0), cB + kstep, voffB); PG8_STAGE(PG8_SA(1, 0), cA + kstep, voffA); PG8_STAGE(PG8_SB(1, 1), cB + hstep + kstep, voffB);
        PG8_WAIT_V(6); PG8_BAR;
    } else {
        PG8_STAGE(PG8_SB(0, 0), cB, voffB); PG8_STAGE(PG8_SA(0, 0), cA, voffA); PG8_STAGE(PG8_SB(0, 1), cB + hstep, voffB); PG8_STAGE(PG8_SA(0, 1), cA + hstepA, voffA);
        if (wr == 1) PG8_BAR;
        PG8_WAIT_V(4); PG8_BAR;
        PG8_STAGE(PG8_SB(1, 0), cB + kstep, voffB); PG8_STAGE(PG8_SA(1, 0), cA + kstep, voffA); PG8_STAGE(PG8_SB(1, 1), cB + hstep + kstep, voffB);
        PG8_WAIT_V(6); PG8_BAR;
    }
    for (;;) {
        const bool has_next = S.next(ui + 1, nxt);
        const char* nA = has_next ? (const char*)g.A + (size_t)nxt.pm * tstepA : cA; const char* nB = has_next ? (const char*)g.Bt + (size_t)nxt.pn * tstep : cB;
        for (int t = 0; t < nt; t += 2) {
            const bool last = (t == nt - 2);
            const char* a1 = cA + (size_t)(t + 1) * kstep;
            const char* a2 = last ? nA : cA + (size_t)(t + 2) * kstep; const char* b2 = last ? nB : cB + (size_t)(t + 2) * kstep;
            const char* a3 = a2 + kstep; const char* b3 = b2 + kstep;
            if (last && has_next) S.a_ready(nxt);
            if constexpr (SP2) {
            PG8_LDB(B0, 0, 0); PG8_LDB(B1, 0, 1); PG8_SCHED; PG8_LDA(At, 0, 0); PG8_STAGE(PG8_SA(1, 1), a1 + hstepA, voffA);
            PG8_WAIT_V(8); PG8_WAIT_L(0); PG8_BAR; PG8_MMA(0, 0, At, B0); PG8_MMA(0, 1, At, B1); PG8_BAR; PG8_SCHED;
            PG8_LDA(At, 0, 1); PG8_STAGE(PG8_SB(0, 0), b2, voffB); PG8_STAGE(PG8_SB(0, 1), b2 + hstep, voffB); PG8_STAGE(PG8_SA(0, 0), a2, voffA);
            PG8_WAIT_V(8); PG8_WAIT_L(0); PG8_BAR; PG8_MMA(1, 0, At, B0); PG8_MMA(1, 1, At, B1); PG8_BAR; PG8_SCHED;
            PG8_LDB(B0, 1, 0); PG8_LDB(B1, 1, 1); PG8_SCHED; PG8_LDA(At, 1, 0); PG8_STAGE(PG8_SA(0, 1), a2 + hstepA, voffA);
            PG8_WAIT_V(8); PG8_WAIT_L(0); PG8_BAR; PG8_MMA(0, 0, At, B0); PG8_MMA(0, 1, At, B1); PG8_BAR; PG8_SCHED;
            PG8_LDA(At, 1, 1); PG8_STAGE(PG8_SB(1, 0), b3, voffB); PG8_STAGE(PG8_SB(1, 1), b3 + hstep, voffB); PG8_STAGE(PG8_SA(1, 0), a3, voffA);
            PG8_WAIT_V(8); PG8_WAIT_L(0); PG8_BAR; PG8_MMA(1, 0, At, B0); PG8_MMA(1, 1, At, B1); PG8_BAR; PG8_SCHED;
            } else {
            PG8_LDB(B0, 0, 0); PG8_SCHED; PG8_LDA(At, 0, 0); PG8_STAGE(PG8_SA(1, 1), a1 + hstepA, voffA);
            PG8_WAIT_L(8); PG8_BAR; PG8_WAIT_L(0); PG8_MMA(0, 0, At, B0); PG8_BAR; PG8_SCHED;
            PG8_LDB(B1, 0, 1); PG8_STAGE(PG8_SB(0, 0), b2, voffB);
            PG8_BAR; PG8_WAIT_L(0); PG8_MMA(0, 1, At, B1); PG8_BAR;
            PG8_LDA(At, 0, 1); PG8_STAGE(PG8_SA(0, 0), a2, voffA);
            PG8_BAR; PG8_WAIT_L(0); PG8_MMA(1, 0, At, B0); PG8_BAR; PG8_SCHED;
            PG8_STAGE(PG8_SB(0, 1), b2 + hstep, voffB);
            PG8_WAIT_V(6); PG8_BAR; PG8_MMA(1, 1, At, B1); PG8_BAR;
            PG8_LDB(B0, 1, 0); PG8_SCHED; PG8_LDA(At, 1, 0); PG8_STAGE(PG8_SA(0, 1), a2 + hstepA, voffA);
            PG8_WAIT_L(8); PG8_BAR; PG8_WAIT_L(0); PG8_MMA(0, 0, At, B0); PG8_BAR; PG8_SCHED;
            PG8_LDB(B1, 1, 1); PG8_STAGE(PG8_SB(1, 0), b3, voffB);
            PG8_BAR; PG8_WAIT_L(0); PG8_MMA(0, 1, At, B1); PG8_BAR;
            PG8_LDA(At, 1, 1); PG8_STAGE(PG8_SA(1, 0), a3, voffA);
            PG8_BAR; PG8_WAIT_L(0); PG8_MMA(1, 0, At, B0); PG8_BAR; PG8_SCHED;
            PG8_STAGE(PG8_SB(1, 1), b3 + hstep, voffB);
            PG8_WAIT_V(6); PG8_BAR; PG8_MMA(1, 1, At, B1); PG8_BAR;
            }
        }
        if constexpr (ALIGN_EPI) { if (wr == 0) PG8_BAR; }
        if constexpr (!Epi::AFTER_DRAIN) { E(acc, cur, wr, wc, fr, fq); S.done(cur); }
        if (!has_next) break;
#pragma unroll
        for (int a = 0; a < 2; ++a)
#pragma unroll
            for (int b = 0; b < 2; ++b)
#pragma unroll
                for (int m = 0; m < 4; ++m)
#pragma unroll
                    for (int n = 0; n < 2; ++n) acc[a][b][m][n] = (f32x4){0.f, 0.f, 0.f, 0.f};
        cur = nxt; cA = nA; cB = nB; ++ui;
        if constexpr (ALIGN_EPI) { if (wr == 1) PG8_BAR; }
    }
    PG8_WAIT_V(0);
    if constexpr (!ALIGN_EPI) { if (wr == 0) PG8_BAR; }
    PG8_BAR;
    if constexpr (Epi::AFTER_DRAIN) { E.fused(acc, cur, wr, wc, fr, fq, lds, wid, lane); S.done(cur); }
#undef PG8_SA
#undef PG8_SB
#undef PG8_STAGE
#undef PG8_LDA
#undef PG8_LDB
#undef PG8_MMA
#undef PG8_WAIT_V
#undef PG8_WAIT_L
#undef PG8_BAR
#undef PG8_SCHED
}
}
#define LAS __attribute__((address_space(3)))
#define XB_TMO      128
#define XB_XCNT(j)  (256  + 64 * (j))
#define XB_XSUB(j)  (1280 + 64 * (j))
#define XB_XGEN(j)  (2304 + 64 * (j))
#define XB_TOP      3328
#define XB_TOPGEN   3392
#define XCD_BAR_WORDS 3456
#define XB_SPIN_CAP (1u << 18)

__device__ __forceinline__ unsigned xb_ld(unsigned* p)              { return __hip_atomic_load(p, __ATOMIC_RELAXED, __HIP_MEMORY_SCOPE_AGENT); }
__device__ __forceinline__ unsigned xb_add(unsigned* p, unsigned v) { return __hip_atomic_fetch_add(p, v, __ATOMIC_RELAXED, __HIP_MEMORY_SCOPE_AGENT); }
__device__ __forceinline__ unsigned xb_xcc_id() { return (unsigned)__builtin_amdgcn_s_getreg((3 << 11) | 20) & 0xFu; }
#define XB_SPIN(cond, bar) do { unsigned _sp = 0; while (cond) { __builtin_amdgcn_s_sleep(1); \
    if ((++_sp & 255u) == 0u) { if (xb_ld(&(bar)[XB_TMO])) break; if (_sp > XB_SPIN_CAP) { atomicAdd(&(bar)[XB_TMO], 1u); break; } } } } while (0)

struct XcdBarrier {
    unsigned* bar; unsigned x;
    volatile LAS unsigned* st;
};

__device__ __forceinline__ XcdBarrier xcd_barrier_post(unsigned* bar, volatile LAS unsigned* st) {
    XcdBarrier b; b.bar = bar; b.x = xb_xcc_id(); b.st = st;
    if (threadIdx.x == 0) (void)xb_add(&bar[XB_XCNT(b.x)], 1u);
    return b;
}
__device__ __forceinline__ void xcd_barrier_complete(unsigned* bar, unsigned x, unsigned& nloc, unsigned& nx) {
    const unsigned G = gridDim.x * gridDim.y * gridDim.z;
    unsigned sum, cnt, mine, sp = 0u;
    for (;;) {
        sum = 0u; cnt = 0u; mine = 0u;
#pragma unroll
        for (unsigned j = 0; j < 16; ++j) { const unsigned c = xb_ld(&bar[XB_XCNT(j)]); sum += c; cnt += (c > 0u) ? 1u : 0u; mine = (j == x) ? c : mine; }
        if (sum == G) break;
        __builtin_amdgcn_s_sleep(1);
        if ((++sp & 255u) == 0u) { if (xb_ld(&bar[XB_TMO])) break; if (sp > XB_SPIN_CAP) { atomicAdd(&bar[XB_TMO], 1u); break; } }
    }
    nloc = mine > 0u ? mine : 1u; nx = cnt > 0u ? cnt : 1u;
}

__device__ __forceinline__ void xcd_barrier(const XcdBarrier& b) {
    asm volatile("s_waitcnt vmcnt(0)" ::: "memory");
    __syncthreads();
    if (threadIdx.x == 0) {
        unsigned* bar = b.bar;
        __builtin_amdgcn_s_waitcnt(0);
        unsigned nloc = b.st[0], nx = b.st[1];
        if (nloc == 0u) { xcd_barrier_complete(bar, b.x, nloc, nx); b.st[0] = nloc; b.st[1] = nx; }
        const unsigned old = xb_add(&bar[XB_XSUB(b.x)], 1u);
        const unsigned gen = old / nloc;
        if (old + 1u == (gen + 1u) * nloc) {
            __builtin_amdgcn_fence(__ATOMIC_RELEASE, "agent");
            asm volatile("s_waitcnt vmcnt(0)" ::: "memory");
            const unsigned og = xb_add(&bar[XB_TOP], 1u);
            const unsigned tg = og / nx;
            if (og + 1u == (tg + 1u) * nx) xb_add(&bar[XB_TOPGEN], 1u);
            else XB_SPIN(xb_ld(&bar[XB_TOPGEN]) == tg, bar);
            __builtin_amdgcn_fence(__ATOMIC_ACQUIRE, "agent");
            xb_add(&bar[XB_XGEN(b.x)], 1u);
            asm volatile("s_waitcnt vmcnt(0)" ::: "memory");
        } else {
            XB_SPIN(xb_ld(&bar[XB_XGEN(b.x)]) == gen, bar);
            __builtin_amdgcn_fence(__ATOMIC_ACQUIRE, "agent");
            asm volatile("s_waitcnt vmcnt(0)" ::: "memory");
        }
    }
    __syncthreads();
}


#ifndef FUSE_ACT
#define FUSE_ACT 1
#endif
#ifndef DN_STAGED
#define DN_STAGED 1
#endif
#ifndef DIAG_Y
#define DIAG_Y 0
#endif
#ifndef OLD_S5
#define OLD_S5 0
#endif
#if OLD_S5 == 3
#define OLD_S5_ULIM 8192
#else
#define OLD_S5_ULIM (4 * 32 * 64 + 32 * 32)
#endif
#define DI __device__ __forceinline__
typedef unsigned short bf16;
typedef float f32x4 __attribute__((ext_vector_type(4)));
typedef float f32x2 __attribute__((ext_vector_type(2)));
typedef short bf16x8 __attribute__((ext_vector_type(8)));
typedef unsigned u32x4 __attribute__((ext_vector_type(4)));
typedef unsigned u32x2 __attribute__((ext_vector_type(2)));
typedef __bf16 bf16x2_t __attribute__((ext_vector_type(2)));

DI unsigned pk2(float lo, float hi) { f32x2 v = {lo, hi}; bf16x2_t b = __builtin_convertvector(v, bf16x2_t); return __builtin_bit_cast(unsigned, b); }
DI bf16 f2b(float x) { return (bf16)(pk2(x, 0.f) & 0xffffu); }
DI float b2f(unsigned b) { return __uint_as_float(b << 16); }
DI float blo(unsigned w) { return __uint_as_float(w << 16); }
DI float bhi(unsigned w) { return __uint_as_float(w & 0xffff0000u); }
DI float wave_sum(float v) {
#pragma unroll
    for (int o = 1; o < 64; o <<= 1) v += __shfl_xor(v, o);
    return v;
}
DI float sigm(float x) { return 1.f / (1.f + __expf(-x)); }
DI float silu(float x) { return x / (1.f + __expf(-x)); }
DI float gelu_tanh(float x) { const float z = 1.5957691216057308f * (x + 0.044715f * x * x * x); return x / (1.f + __expf(-z)); }
#define MFMA16(a, b, c) __builtin_amdgcn_mfma_f32_16x16x32_bf16((a), (b), (c), 0, 0, 0)

constexpr int TP = 32768, TS = 512, T = TP + TS;
constexpr int DM = 1024, PW = 2560, NIN = 2816, DFF = 2816, UPW = 5632;
constexpr float EPS = 1e-6f;
constexpr int NCH = 2048 + 128;
constexpr int REC = 73728;
constexpr int R_WN = 0, R_QG = 16384, R_KDT = 32768, R_QK = 49152, R_U0 = 57344;
constexpr size_t O_Y = 0, O_PDC = (size_t)T * DM, O_PDS = O_PDC + 4 * 3 * 1536, O_PSR = O_PDS + 4 * 4 * 128 * 128, O_PSI = O_PSR + 4 * 32 * 64,
                 O_PFC = O_PSI + 4 * 32 * 64, O_SDC = O_PFC + 4 * 2 * 2816, O_SDS = O_SDC + 32 * 3 * 1536, O_SSR = O_SDS + (size_t)32 * 4 * 128 * 128,
                 O_SSI = O_SSR + 32 * 32 * 64, O_SFC = O_SSI + 32 * 32 * 64, O_END = O_SFC + 32 * 2 * 2816;
constexpr size_t MiB = 1u << 20;
constexpr size_t WS_SS2 = 0;
constexpr size_t WS_EG = 3 * MiB;
constexpr size_t WS_CTL = 5 * MiB + 512 * 1024;
constexpr size_t WS_BA = 4 * MiB;
constexpr size_t WS_WIN = 6 * MiB, WS_WGLU = 12 * MiB, WS_WOUT = 13 * MiB, WS_WUP = 15 * MiB, WS_WDOWN = 26 * MiB;
constexpr size_t WS_H = 32 * MiB;
constexpr size_t WS_P = 98 * MiB;
constexpr size_t WS_DNC = 262 * MiB;
constexpr size_t WS_Y5 = 416 * MiB, WS_GLU = 449 * MiB, WS_S5E = 482 * MiB, WS_END = 487 * MiB;
constexpr size_t WS_GH = 300 * MiB, WS_GT = 324 * MiB, WS_VH = 348 * MiB;
constexpr size_t WS_UP = 98 * MiB;
static_assert(WS_UP + (size_t)T * UPW * 2 <= WS_END && WS_P + (size_t)T * PW * 2 <= WS_DNC && WS_DNC + (size_t)NCH * REC <= WS_Y5, "ws map");
constexpr int LDS_BYTES = 147456;

struct Args { const float* in[31]; float* out; unsigned char* ws; };

DI int colmap(int mode, int n) {
    if (mode == 0) return n;
    if (mode == 1) return n < 2048 ? n : (n < 2560 ? n + 8 : (n < 2568 ? n - 512 : -1));
    const int pn = n >> 8, bj = (n >> 7) & 1, j = n & 127;
    return bj * (mode == 2 ? 512 : 2816) + 128 * pn + j;
}
DI void transpose_item(const float* W, int K, int N, bf16* WT, float* scr, int kb, int nb, int lane, int mode, const float* rs) {
    const int k0 = 64 * kb, n0 = 32 * nb;
    const int sc = colmap(mode, n0 + (lane & 31));
    float tv[32];
#pragma unroll
    for (int i = 0; i < 32; ++i) { const int kk = 2 * i + (lane >> 5); tv[i] = 0.f; if (sc >= 0) tv[i] = W[(size_t)(k0 + kk) * N + sc]; }
#pragma unroll
    for (int i = 0; i < 32; ++i) { const int kk = 2 * i + (lane >> 5); float v = tv[i]; if (rs) v *= rs[k0 + kk]; scr[kk * 33 + (lane & 31)] = v; }
    asm volatile("s_waitcnt lgkmcnt(0)" ::: "memory");
    const int c = lane & 7;
#pragma unroll
    for (int j = 0; j < 4; ++j) { const int n = (lane >> 3) + 8 * j; const float* s = scr + (8 * c) * 33 + n;
        u32x4 o; o.x = pk2(s[0 * 33], s[1 * 33]); o.y = pk2(s[2 * 33], s[3 * 33]); o.z = pk2(s[4 * 33], s[5 * 33]); o.w = pk2(s[6 * 33], s[7 * 33]);
        *(u32x4*)(WT + (size_t)(n0 + n) * K + k0 + 8 * c) = o; }
    asm volatile("s_waitcnt lgkmcnt(0)" ::: "memory");
}
DI void phase0(const Args& a, unsigned char* lds, int gw, int NGW, int wave, int lane) {
    asm volatile("" : "+v"(lane));
    unsigned char* ws = a.ws;
    float* scr = (float*)(lds + wave * 16384);
    constexpr int I_IN = 16 * (NIN / 32), I_GLU = 8 * 32, I_OUT = 16 * 32, I_UP = 16 * (UPW / 32), I_DN = 44 * 32;
    constexpr int NIT = I_IN + I_GLU + I_OUT + I_UP + I_DN;
    for (int it = gw; it < NIT; it += NGW) {
        int r = it;
        if (r < I_IN) { transpose_item(a.in[8], 1024, 2568, (bf16*)(ws + WS_WIN), scr, r / (NIN / 32), r % (NIN / 32), lane, 1, nullptr); continue; } r -= I_IN;
        if (r < I_GLU) { transpose_item(a.in[21], 512, 1024, (bf16*)(ws + WS_WGLU), scr, r / 32, r % 32, lane, 2, nullptr); continue; } r -= I_GLU;
        if (r < I_OUT) { transpose_item(a.in[24], 1024, 1024, (bf16*)(ws + WS_WOUT), scr, r / 32, r % 32, lane, 0, nullptr); continue; } r -= I_OUT;
        if (r < I_UP) { transpose_item(a.in[26], 1024, 5632, (bf16*)(ws + WS_WUP), scr, r / (UPW / 32), r % (UPW / 32), lane, 3, a.in[25]); continue; } r -= I_UP;
        transpose_item(a.in[29], 2816, 1024, (bf16*)(ws + WS_WDOWN), scr, r / 32, r % 32, lane, 0, nullptr);
    }
    const float* g1 = a.in[7];
    f32x4 gv[4];
#pragma unroll
    for (int j = 0; j < 4; ++j) gv[j] = ((const f32x4*)g1)[lane + 64 * j];
    bf16* H = (bf16*)(ws + WS_H);
    for (int m0 = gw; m0 < T; m0 += 2 * NGW) {
        const int m1 = m0 + NGW < T ? m0 + NGW : m0;
        const f32x4* xr0 = (const f32x4*)(m0 < TP ? a.in[0] + (size_t)m0 * DM : a.in[1] + (size_t)(m0 - TP) * DM) + lane;
        const f32x4* xr1 = (const f32x4*)(m1 < TP ? a.in[0] + (size_t)m1 * DM : a.in[1] + (size_t)(m1 - TP) * DM) + lane;
        f32x4 v0[4], v1[4]; float s0 = 0.f, s1 = 0.f;
#pragma unroll
        for (int j = 0; j < 4; ++j) { v0[j] = xr0[64 * j]; v1[j] = xr1[64 * j]; }
#pragma unroll
        for (int j = 0; j < 4; ++j) { s0 += (v0[j].x * v0[j].x + v0[j].y * v0[j].y) + (v0[j].z * v0[j].z + v0[j].w * v0[j].w); s1 += (v1[j].x * v1[j].x + v1[j].y * v1[j].y) + (v1[j].z * v1[j].z + v1[j].w * v1[j].w); }
        const float r0 = rsqrtf(wave_sum(s0) * (1.f / DM) + EPS), r1 = rsqrtf(wave_sum(s1) * (1.f / DM) + EPS);
        u32x2* o0 = (u32x2*)(H + (size_t)m0 * DM) + lane; u32x2* o1 = (u32x2*)(H + (size_t)m1 * DM) + lane;
#pragma unroll
        for (int j = 0; j < 4; ++j) { u32x2 o; o.x = pk2(v0[j].x * r0 * gv[j].x, v0[j].y * r0 * gv[j].y); o.y = pk2(v0[j].z * r0 * gv[j].z, v0[j].w * r0 * gv[j].w); o0[64 * j] = o; }
        if (m1 != m0) {
#pragma unroll
            for (int j = 0; j < 4; ++j) { u32x2 o; o.x = pk2(v1[j].x * r1 * gv[j].x, v1[j].y * r1 * gv[j].y); o.y = pk2(v1[j].z * r1 * gv[j].z, v1[j].w * r1 * gv[j].w); o1[64 * j] = o; }
        }
    }
}

struct EpiP {
    static constexpr bool PERM = true, AFTER_DRAIN = false;
    bf16* P; float* BA;
    DI void operator()(const pg8::f32x4 (&acc)[2][2][4][2], const pg8::Unit& u, int wr, int wc, int fr, int fq) const {
        const int row0 = u.pm * 256 + wr * 64 + fr;
        if (u.pn < 10) {
            const int col0 = u.pn * 256 + wc * 32 + 8 * fq;
#pragma unroll
            for (int ai = 0; ai < 2; ++ai)
#pragma unroll
                for (int m = 0; m < 4; ++m) { bf16* rowp = P + (size_t)(row0 + ai * 128 + m * 16) * PW + col0;
#pragma unroll
                    for (int bj = 0; bj < 2; ++bj) { const pg8::f32x4 v0 = acc[ai][bj][m][0], v1 = acc[ai][bj][m][1];
                        u32x4 w; w.x = pk2(v0[0], v0[1]); w.y = pk2(v0[2], v0[3]); w.z = pk2(v1[0], v1[1]); w.w = pk2(v1[2], v1[3]);
                        *(u32x4*)(rowp + bj * 128) = w; } }
        } else if (wc == 0 && fq == 0) {
#pragma unroll
            for (int ai = 0; ai < 2; ++ai)
#pragma unroll
                for (int m = 0; m < 4; ++m) { float* bp = BA + (size_t)(row0 + ai * 128 + m * 16) * 8;
                    *(pg8::f32x4*)bp = acc[ai][0][m][0]; *(pg8::f32x4*)(bp + 4) = acc[ai][0][m][1]; }
        }
    }
};
struct EpiGlu {
    static constexpr bool PERM = true, AFTER_DRAIN = false;
    bf16* O; const float* gb;
    DI void operator()(const pg8::f32x4 (&acc)[2][2][4][2], const pg8::Unit& u, int wr, int wc, int fr, int fq) const {
        const int row0 = u.pm * 256 + wr * 64 + fr, col0 = u.pn * 128 + wc * 32 + 8 * fq;
        const pg8::f32x4 ba0 = *(const pg8::f32x4*)(gb + col0), ba1 = *(const pg8::f32x4*)(gb + col0 + 4), bg0 = *(const pg8::f32x4*)(gb + 512 + col0), bg1 = *(const pg8::f32x4*)(gb + 512 + col0 + 4);
#pragma unroll
        for (int ai = 0; ai < 2; ++ai)
#pragma unroll
            for (int m = 0; m < 4; ++m) {
                const pg8::f32x4 a0 = acc[ai][0][m][0] + ba0, a1 = acc[ai][0][m][1] + ba1, g0 = acc[ai][1][m][0] + bg0, g1 = acc[ai][1][m][1] + bg1;
                float o[8];
#pragma unroll
                for (int e = 0; e < 4; ++e) { o[e] = a0[e] * sigm(g0[e]); o[4 + e] = a1[e] * sigm(g1[e]); }
                u32x4 w; w.x = pk2(o[0], o[1]); w.y = pk2(o[2], o[3]); w.z = pk2(o[4], o[5]); w.w = pk2(o[6], o[7]);
                *(u32x4*)(O + (size_t)(row0 + ai * 128 + m * 16) * 512 + col0) = w;
            }
    }
};
struct EpiX1 {
    static constexpr bool PERM = false, AFTER_DRAIN = false;
    const float* xp; const float* xs; float* out; bf16* xb; float* ss2;
    DI void operator()(const pg8::f32x4 (&acc)[2][2][4][2], const pg8::Unit& u, int wr, int wc, int fr, int fq) const {
        const int row0 = u.pm * 256 + wr * 64 + fr, col0 = u.pn * 256 + wc * 32 + 4 * fq;
#pragma unroll
        for (int ai = 0; ai < 2; ++ai)
#pragma unroll
            for (int m = 0; m < 4; ++m) {
                const int row = row0 + ai * 128 + m * 16;
                const float* xr = (row < TP ? xp + (size_t)row * DM : xs + (size_t)(row - TP) * DM) + col0;
                float ss = 0.f;
#pragma unroll
                for (int bj = 0; bj < 2; ++bj)
#pragma unroll
                    for (int n = 0; n < 2; ++n) {
                        const pg8::f32x4 v = *(const pg8::f32x4*)(xr + bj * 128 + n * 16) + acc[ai][bj][m][n];
                        *(pg8::f32x4*)(out + (size_t)row * DM + col0 + bj * 128 + n * 16) = v;
                        u32x2 w; w.x = pk2(v[0], v[1]); w.y = pk2(v[2], v[3]);
                        *(u32x2*)(xb + (size_t)row * DM + col0 + bj * 128 + n * 16) = w;
                        ss += (v[0] * v[0] + v[1] * v[1]) + (v[2] * v[2] + v[3] * v[3]);
                    }
                ss += __shfl_xor(ss, 16); ss += __shfl_xor(ss, 32);
                if (fq == 0) ss2[(size_t)row * 16 + u.pn * 4 + wc] = ss;
            }
    }
};
struct EpiUp {
    static constexpr bool PERM = true, AFTER_DRAIN = false;
    bf16* UP; const float* ss2;
    DI void operator()(const pg8::f32x4 (&acc)[2][2][4][2], const pg8::Unit& u, int wr, int wc, int fr, int fq) const {
        const int row0 = u.pm * 256 + wr * 64 + fr, col0 = u.pn * 128 + wc * 32 + 8 * fq;
#pragma unroll
        for (int ai = 0; ai < 2; ++ai)
#pragma unroll
            for (int m = 0; m < 4; ++m) {
                const int row = row0 + ai * 128 + m * 16;
                const pg8::f32x4* sp = (const pg8::f32x4*)(ss2 + (size_t)row * 16);
                const pg8::f32x4 s0 = sp[0], s1 = sp[1], s2 = sp[2], s3 = sp[3];
                const float tot = ((s0[0] + s0[1]) + (s0[2] + s0[3])) + ((s1[0] + s1[1]) + (s1[2] + s1[3])) + ((s2[0] + s2[1]) + (s2[2] + s2[3])) + ((s3[0] + s3[1]) + (s3[2] + s3[3]));
                const float r = rsqrtf(tot * (1.f / DM) + EPS);
                bf16* rowp = UP + (size_t)row * UPW + col0;
#pragma unroll
                for (int bj = 0; bj < 2; ++bj) { const pg8::f32x4 v0 = acc[ai][bj][m][0] * r, v1 = acc[ai][bj][m][1] * r;
                    u32x4 w; w.x = pk2(v0[0], v0[1]); w.y = pk2(v0[2], v0[3]); w.z = pk2(v1[0], v1[1]); w.w = pk2(v1[2], v1[3]);
                    *(u32x4*)(rowp + bj * DFF) = w; }
            }
    }
};
DI float dpp_shr1(float v) { return __int_as_float(__builtin_amdgcn_update_dpp(0, __float_as_int(v), 0x111, 0xf, 0xf, false)); }
DI float dpp_shr2(float v) { return __int_as_float(__builtin_amdgcn_update_dpp(0, __float_as_int(v), 0x112, 0xf, 0xf, false)); }
struct EpiUpAct {
    static constexpr bool PERM = true, AFTER_DRAIN = false;
    bf16* ACT; bf16* GH; bf16* GT; bf16* VH; const float* ss2; const float* fw; const float* fb;
    DI void operator()(const pg8::f32x4 (&acc)[2][2][4][2], const pg8::Unit& u, int wr, int wc, int fr, int fq) const {
        const int row0 = u.pm * 256 + wr * 64 + fr, col0 = u.pn * 128 + wc * 32 + 8 * fq;
        float w0[8], w1[8], w2[8], bb[8];
#pragma unroll
        for (int n = 0; n < 2; ++n) { const pg8::f32x4 a0 = *(const pg8::f32x4*)(fw + col0 + 4 * n), a1 = *(const pg8::f32x4*)(fw + DFF + col0 + 4 * n), a2 = *(const pg8::f32x4*)(fw + 2 * DFF + col0 + 4 * n), a3 = *(const pg8::f32x4*)(fb + col0 + 4 * n);
#pragma unroll
            for (int e = 0; e < 4; ++e) { w0[4 * n + e] = a0[e]; w1[4 * n + e] = a1[e]; w2[4 * n + e] = a2[e]; bb[4 * n + e] = a3[e]; } }
#pragma unroll
        for (int ai = 0; ai < 2; ++ai)
#pragma unroll
            for (int m = 0; m < 4; ++m) {
                const int row = row0 + ai * 128 + m * 16, grp = row >> 4;
                const pg8::f32x4* sp = (const pg8::f32x4*)(ss2 + (size_t)row * 16);
                const pg8::f32x4 s0 = sp[0], s1 = sp[1], s2 = sp[2], s3 = sp[3];
                const float tot = ((s0[0] + s0[1]) + (s0[2] + s0[3])) + ((s1[0] + s1[1]) + (s1[2] + s1[3])) + ((s2[0] + s2[1]) + (s2[2] + s2[3])) + ((s3[0] + s3[1]) + (s3[2] + s3[3]));
                const float r = rsqrtf(tot * (1.f / DM) + EPS);
                float gs[8], vv[8], o[8];
#pragma unroll
                for (int n = 0; n < 2; ++n)
#pragma unroll
                    for (int e = 0; e < 4; ++e) { gs[4 * n + e] = acc[ai][0][m][n][e] * r; vv[4 * n + e] = acc[ai][1][m][n][e] * r; }
#pragma unroll
                for (int e = 0; e < 8; ++e) { const float g1 = dpp_shr1(gs[e]), g2 = dpp_shr2(gs[e]); o[e] = silu(g2 * w0[e] + g1 * w1[e] + gs[e] * w2[e] + bb[e]) * vv[e]; }
                u32x4 wg; wg.x = pk2(gs[0], gs[1]); wg.y = pk2(gs[2], gs[3]); wg.z = pk2(gs[4], gs[5]); wg.w = pk2(gs[6], gs[7]);
                if (fr >= 2) { u32x4 w; w.x = pk2(o[0], o[1]); w.y = pk2(o[2], o[3]); w.z = pk2(o[4], o[5]); w.w = pk2(o[6], o[7]);
                    *(u32x4*)(ACT + (size_t)row * DFF + col0) = w; }
                else { u32x4 wv; wv.x = pk2(vv[0], vv[1]); wv.y = pk2(vv[2], vv[3]); wv.z = pk2(vv[4], vv[5]); wv.w = pk2(vv[6], vv[7]);
                    *(u32x4*)(GH + ((size_t)grp * 2 + fr) * DFF + col0) = wg; *(u32x4*)(VH + ((size_t)grp * 2 + fr) * DFF + col0) = wv; }
                if (fr >= 14) *(u32x4*)(GT + ((size_t)grp * 2 + (fr - 14)) * DFF + col0) = wg;
            }
    }
};
struct EpiX2 {
    static constexpr bool PERM = false, AFTER_DRAIN = false;
    float* out;
    DI void operator()(const pg8::f32x4 (&acc)[2][2][4][2], const pg8::Unit& u, int wr, int wc, int fr, int fq) const {
        const int row0 = u.pm * 256 + wr * 64 + fr, col0 = u.pn * 256 + wc * 32 + 4 * fq;
#pragma unroll
        for (int ai = 0; ai < 2; ++ai)
#pragma unroll
            for (int m = 0; m < 4; ++m) {
                float* orow = out + (size_t)(row0 + ai * 128 + m * 16) * DM + col0;
#pragma unroll
                for (int bj = 0; bj < 2; ++bj)
#pragma unroll
                    for (int n = 0; n < 2; ++n) { pg8::f32x4* p = (pg8::f32x4*)(orow + bj * 128 + n * 16); *p = *p + acc[ai][bj][m][n]; }
            }
    }
};

DI int kperm(int k) { return (k & ~31) | (((k >> 2) & 3) << 3) | (((k >> 4) & 1) << 2) | (k & 3); }
DI void conv_col(const bf16* pcol, float h0, float h1, float h2, const float* cw, int nrows, float* outp, float (&val)[64]) {
    const float w0 = cw[0], w1 = cw[1536], w2 = cw[2 * 1536], w3 = cw[3 * 1536];
    float x3 = h0, x2 = h1, x1 = h2;
#pragma unroll
    for (int r = 0; r < 64; ++r) {
        float x0 = 0.f;
        if (r < nrows) x0 = b2f(pcol[(size_t)r * PW]);
        const float c = x3 * w0 + x2 * w1 + x1 * w2 + x0 * w3;
        val[r] = r < nrows ? silu(c) : 0.f;
        if (outp && r >= nrows - 3 && r < nrows) outp[(r - (nrows - 3)) * 1536] = x0;
        x3 = x2; x2 = x1; x1 = x0;
    }
}
DI void dn_chunk_phase(const Args& a, unsigned char* lds, int tid) {
    unsigned char* ws = a.ws;
    const bf16* P = (const bf16*)(ws + WS_P);
    const float* BA = (const float*)(ws + WS_BA);
    const float* cwt = a.in[9];
    constexpr float QSCALE = 0.08838834764831845f;
    for (int it = blockIdx.x; it < NCH / 2; it += gridDim.x) {
        int tl = tid; asm volatile("" : "+v"(tl));
        const int half = __builtin_amdgcn_readfirstlane(tl >> 8), t8 = tl & 255, hw = __builtin_amdgcn_readfirstlane((tl >> 6) & 3), lane = tl & 63, fr = lane & 15, fq = lane >> 4;
        unsigned char* L = lds + half * 53248;
        unsigned char* qb = L; unsigned char* kb = L + 17408;
        float* Am = (float*)(L + 34816);
        float* Gs = (float*)(L + 51200); float* Bs = Gs + 64; float* RQ = Gs + 128; float* RK = Gs + 192; float* EG = Gs + 256;
        const int unit = it * 2 + half;
        int row0, nrows, h, bidx; bool sample, first, lastc;
        if (unit < 2048) { const int b = unit >> 9, n = unit & 127; h = (unit >> 7) & 3; row0 = b * 8192 + n * 64; nrows = 64; sample = false; first = (n == 0); lastc = (n == 127); bidx = b; }
        else { const int su = unit - 2048; bidx = su >> 2; h = su & 3; row0 = TP + bidx * 16; nrows = 16; sample = true; first = false; lastc = true; }
        unsigned char* rec = ws + WS_DNC + (size_t)unit * REC;
        if (hw == 0) {
            float g = 0.f, be = 0.f;
            if (lane < nrows) {
                const float* bp = BA + (size_t)(row0 + lane) * 8;
                be = sigm(bp[h]);
                const float xx = bp[4 + h] + a.in[11][h];
                const float sp = xx > 20.f ? xx : log1pf(__expf(xx));
                g = -__expf(a.in[10][h]) * sp;
            }
#pragma unroll
            for (int o = 1; o < 64; o <<= 1) { const float v = __shfl_up(g, o); if (lane >= o) g += v; }
            Gs[lane] = g; Bs[lane] = be; EG[lane] = __expf(g);
            if (lane == 63) ((float*)(ws + WS_EG))[unit] = __expf(g);
        }
        float va[64];
        {
            const int c = t8 & 127;
            const int col = (t8 < 128 ? 0 : 512) + h * 128 + c;
            float h0 = 0.f, h1 = 0.f, h2 = 0.f;
            if (sample) { const float* cc = a.in[2] + (size_t)bidx * 3 * 1536 + col; h0 = cc[0]; h1 = cc[1536]; h2 = cc[2 * 1536]; }
            else if (!first) { const bf16* pp = P + (size_t)(row0 - 3) * PW + col; h0 = b2f(pp[0]); h1 = b2f(pp[PW]); h2 = b2f(pp[2 * PW]); }
            float* outp = lastc ? a.out + (sample ? O_SDC : O_PDC) + (size_t)bidx * 3 * 1536 + col : nullptr;
            conv_col(P + (size_t)row0 * PW + col, h0, h1, h2, cwt + col, nrows, outp, va);
            unsigned char* dst = (t8 < 128 ? qb : kb) + c * 2;
#pragma unroll
            for (int r = 0; r < 64; ++r) *(bf16*)(dst + r * 272) = f2b(va[r]);
        }
        __syncthreads();
        f32x4 kk[4], qk[4], qq;
        {
            bf16x8 ak[4], aq[4];
#pragma unroll
            for (int ks = 0; ks < 4; ++ks) { ak[ks] = *(const bf16x8*)(kb + (16 * hw + fr) * 272 + ks * 64 + fq * 16); aq[ks] = *(const bf16x8*)(qb + (16 * hw + fr) * 272 + ks * 64 + fq * 16); }
            qq = (f32x4){0.f, 0.f, 0.f, 0.f};
#pragma unroll
            for (int ks = 0; ks < 4; ++ks) qq = MFMA16(aq[ks], aq[ks], qq);
#pragma unroll
            for (int nt = 0; nt < 4; ++nt) {
                kk[nt] = (f32x4){0.f, 0.f, 0.f, 0.f}; qk[nt] = (f32x4){0.f, 0.f, 0.f, 0.f};
#pragma unroll
                for (int ks = 0; ks < 4; ++ks) { const bf16x8 bk = *(const bf16x8*)(kb + (16 * nt + fr) * 272 + ks * 64 + fq * 16);
                    kk[nt] = MFMA16(ak[ks], bk, kk[nt]); qk[nt] = MFMA16(aq[ks], bk, qk[nt]); }
            }
#pragma unroll
            for (int i = 0; i < 4; ++i) if (fr == 4 * fq + i) {
                float dk = 0.f;
#pragma unroll
                for (int nt = 0; nt < 4; ++nt) if (nt == hw) dk = kk[nt][i];
                RK[16 * hw + fr] = rsqrtf(dk + EPS); RQ[16 * hw + fr] = rsqrtf(qq[i] + EPS);
            }
        }
        __syncthreads();
        {
            bf16* QKr = (bf16*)(rec + R_QK);
#pragma unroll
            for (int i = 0; i < 4; ++i) {
                const int row = 16 * hw + 4 * fq + i;
                const float gr = Gs[row], br = Bs[row], rk = RK[row], rq = RQ[row];
#pragma unroll
                for (int nt = 0; nt < 4; ++nt) {
                    const int col = 16 * nt + fr;
                    const float d = col <= row ? gr - Gs[col] : 0.f;
                    const float e = __expf(d), rkc = RK[col];
                    Am[row * 64 + col] = col < row ? br * kk[nt][i] * rk * rkc * e : 0.f;
                    QKr[row * 64 + kperm(col)] = f2b(col <= row ? qk[nt][i] * rq * rkc * QSCALE * e : 0.f);
                }
            }
        }
        __syncthreads();
        if (t8 < 128) {
            bf16* Qg = (bf16*)(rec + R_QG) + kperm(t8);
#pragma unroll
            for (int r = 0; r < 64; ++r) Qg[r * 128] = f2b(va[r] * RQ[r] * QSCALE * EG[r]);
            {
                const int col = 1024 + h * 128 + t8;
                float h0 = 0.f, h1 = 0.f, h2 = 0.f;
                if (sample) { const float* cc = a.in[2] + (size_t)bidx * 3 * 1536 + col; h0 = cc[0]; h1 = cc[1536]; h2 = cc[2 * 1536]; }
                else if (!first) { const bf16* pp = P + (size_t)(row0 - 3) * PW + col; h0 = b2f(pp[0]); h1 = b2f(pp[PW]); h2 = b2f(pp[2 * PW]); }
                float* outp = lastc ? a.out + (sample ? O_SDC : O_PDC) + (size_t)bidx * 3 * 1536 + col : nullptr;
                conv_col(P + (size_t)row0 * PW + col, h0, h1, h2, cwt + col, nrows, outp, va);
            }
#pragma unroll
            for (int r = 0; r < 64; ++r) va[r] = va[r] * Bs[r];
        } else {
            const int c = t8 - 128;
            const float gl = Gs[63];
            unsigned w[32];
#pragma unroll
            for (int r = 0; r < 64; r += 2) w[kperm(r) >> 1] = pk2(va[r] * RK[r] * __expf(gl - Gs[r]), va[r + 1] * RK[r + 1] * __expf(gl - Gs[r + 1]));
            u32x4* dst = (u32x4*)(rec + R_KDT + c * 128);
#pragma unroll
            for (int j = 0; j < 8; ++j) dst[j] = (u32x4){w[4 * j], w[4 * j + 1], w[4 * j + 2], w[4 * j + 3]};
#pragma unroll
            for (int r = 0; r < 64; ++r) va[r] = va[r] * RK[r] * Bs[r] * EG[r];
        }
#if SOLVE_RL
        {
            float arow[64];
#pragma unroll
            for (int i = 1; i < 64; ++i) arow[i] = Am[i * 64 + lane];
#pragma unroll
            for (int i = 1; i < 64; ++i) {
                if (i < nrows) {
                    float acc0 = va[i], acc1 = 0.f;
#pragma unroll
                    for (int j = 0; j < i; ++j) { const float aij = __int_as_float(__builtin_amdgcn_readlane(__float_as_int(arow[i]), j)); if (j & 1) acc1 -= aij * va[j]; else acc0 -= aij * va[j]; }
                    va[i] = acc0 + acc1;
                }
            }
        }
#else
#pragma unroll
        for (int i = 1; i < 64; ++i) {
            float acc = va[i];
            const f32x4* Ar = (const f32x4*)(Am + i * 64);
#pragma unroll
            for (int j4 = 0; j4 < (i + 3) / 4; ++j4) {
                const f32x4 av = Ar[j4];
#pragma unroll
                for (int e = 0; e < 4; ++e) if (4 * j4 + e < i) acc -= av[e] * va[4 * j4 + e];
            }
            va[i] = acc;
        }
#endif
        if (t8 < 128) { bf16* U0 = (bf16*)(rec + R_U0) + t8;
#pragma unroll
            for (int r = 0; r < 64; ++r) U0[r * 128] = f2b(va[r]);
        } else { bf16* Wn = (bf16*)(rec + R_WN) + kperm(t8 - 128);
#pragma unroll
            for (int r = 0; r < 64; ++r) Wn[r * 128] = f2b(-va[r]);
        }
        __syncthreads();
    }
}

struct S5W { float lr[4], li[4]; bf16x8 bf[8]; };
DI void s5w_setup(const Args& a, int g, int fr, int fq, S5W& w) {
    const float dt = __expf(a.in[15][g]);
#pragma unroll
    for (int j = 0; j < 4; ++j) {
        const int p = 16 * j + fr;
        const float are = a.in[13][g * 64 + p], aim = a.in[14][g * 64 + p];
        const float mag = __expf(are * dt), ang = aim * dt;
        float sn, cs; sincosf(ang, &sn, &cs);
        const float lr = mag * cs, li = mag * sn;
        w.lr[j] = lr; w.li[j] = li;
        const float den = are * are + aim * aim;
        const float fre = ((lr - 1.f) * are + li * aim) / den, fim = (li * are - (lr - 1.f) * aim) / den;
        u32x4 wr = (u32x4){0u, 0u, 0u, 0u}, wi = (u32x4){0u, 0u, 0u, 0u};
        if (fq < 2) {
            const f32x4* br = (const f32x4*)(a.in[16] + (size_t)(g * 64 + p) * 16 + 8 * fq); const f32x4* bi = (const f32x4*)(a.in[17] + (size_t)(g * 64 + p) * 16 + 8 * fq);
            const f32x4 r0 = br[0], r1 = br[1], i0 = bi[0], i1 = bi[1];
            wr.x = pk2(fre * r0[0] - fim * i0[0], fre * r0[1] - fim * i0[1]); wr.y = pk2(fre * r0[2] - fim * i0[2], fre * r0[3] - fim * i0[3]);
            wr.z = pk2(fre * r1[0] - fim * i1[0], fre * r1[1] - fim * i1[1]); wr.w = pk2(fre * r1[2] - fim * i1[2], fre * r1[3] - fim * i1[3]);
            wi.x = pk2(fre * i0[0] + fim * r0[0], fre * i0[1] + fim * r0[1]); wi.y = pk2(fre * i0[2] + fim * r0[2], fre * i0[3] + fim * r0[3]);
            wi.z = pk2(fre * i1[0] + fim * r1[0], fre * i1[1] + fim * r1[1]); wi.w = pk2(fre * i1[2] + fim * r1[2], fre * i1[3] + fim * r1[3]);
        }
        w.bf[j] = __builtin_bit_cast(bf16x8, wr); w.bf[4 + j] = __builtin_bit_cast(bf16x8, wi);
    }
}
DI bf16x8 s5w_uload(const bf16* P, size_t row0, int SS, int ms, int g, int fr, int fq) {
    u32x4 v = (u32x4){0u, 0u, 0u, 0u};
    if (fq < 2) v = *(const u32x4*)(P + (row0 + (size_t)(fr >> 2) * SS + 4 * ms + (fr & 3)) * PW + 2048 + g * 16 + 8 * fq);
    return __builtin_bit_cast(bf16x8, v);
}
DI void s5w_step(const S5W& w, bf16x8 ua, float (&xr)[4], float (&xi)[4], unsigned (&xo)[4][4]) {
    f32x4 br[4], bi[4];
    const f32x4 z = (f32x4){0.f, 0.f, 0.f, 0.f};
#pragma unroll
    for (int j = 0; j < 4; ++j) { br[j] = MFMA16(ua, w.bf[j], z); bi[j] = MFMA16(ua, w.bf[4 + j], z); }
#pragma unroll
    for (int i = 0; i < 4; ++i)
#pragma unroll
        for (int j = 0; j < 4; ++j) {
            const float nr = w.lr[j] * xr[j] - w.li[j] * xi[j] + br[j][i], ni = w.lr[j] * xi[j] + w.li[j] * xr[j] + bi[j][i];
            xr[j] = nr; xi[j] = ni; xo[i][j] = pk2(nr, ni);
        }
#pragma unroll
    for (int j = 0; j < 8; ++j) asm volatile("" :: "v"(w.bf[j]));
    asm volatile("" :: "v"(ua));
}
DI void s5_pass1(const Args& a, int gw, int NGW, int lane) {
    asm volatile("" : "+v"(lane));
    const bf16* P = (const bf16*)(a.ws + WS_P);
    float* E = (float*)(a.ws + WS_S5E);
    const int fr = lane & 15, fq = lane >> 4;
    for (int unit = gw; unit < 4 * 32 * 16; unit += NGW) {
        const int sg = unit & 15, bg = unit >> 4, g = bg & 31, b = bg >> 5;
        S5W w; s5w_setup(a, g, fr, fq, w);
        float xr[4] = {0.f, 0.f, 0.f, 0.f}, xi[4] = {0.f, 0.f, 0.f, 0.f}; unsigned xo[4][4];
        const size_t row0 = (size_t)b * 8192 + sg * 512;
        bf16x8 ua = s5w_uload(P, row0, 128, 0, g, fr, fq);
        for (int ms = 0; ms < 32; ++ms) {
            const bf16x8 un = s5w_uload(P, row0, 128, ms + 1 < 32 ? ms + 1 : ms, g, fr, fq);
            s5w_step(w, ua, xr, xi, xo); ua = un;
        }
        float* e = E + ((size_t)bg * 64 + 4 * sg + fq) * 128;
#pragma unroll
        for (int j = 0; j < 4; ++j) { e[16 * j + fr] = xr[j]; e[64 + 16 * j + fr] = xi[j]; }
    }
}
DI void s5w_run(const Args& a, const S5W& w, const bf16x8 (&cf)[4], float Dg, unsigned char* xs, size_t row0, int SS, int nms, int g, int fr, int fq, float (&xr)[4], float (&xi)[4]) {
    const bf16* P = (const bf16*)(a.ws + WS_P);
    bf16* Y5 = (bf16*)(a.ws + WS_Y5);
    bf16x8 ua = s5w_uload(P, row0, SS, 0, g, fr, fq);
    for (int ms = 0; ms < nms; ++ms) {
        const bf16x8 un = s5w_uload(P, row0, SS, ms + 1 < nms ? ms + 1 : ms, g, fr, fq);
        float uu[4];
#pragma unroll
        for (int i = 0; i < 4; ++i) uu[i] = b2f(P[(row0 + (size_t)fq * SS + 4 * ms + i) * PW + 2048 + g * 16 + fr]);
        unsigned xo[4][4];
        s5w_step(w, ua, xr, xi, xo); ua = un;
#pragma unroll
        for (int i = 0; i < 4; ++i)
#pragma unroll
            for (int j = 0; j < 4; ++j) *(unsigned*)(xs + (4 * fq + i) * 272 + (16 * j + fr) * 4) = xo[i][j];
        asm volatile("s_waitcnt lgkmcnt(0)" ::: "memory");
        f32x4 y = (f32x4){0.f, 0.f, 0.f, 0.f};
        bf16x8 af[4];
#pragma unroll
        for (int ks = 0; ks < 4; ++ks) af[ks] = *(const bf16x8*)(xs + fr * 272 + ks * 64 + fq * 16);
        asm volatile("" ::: "memory");
#pragma unroll
        for (int ks = 0; ks < 4; ++ks) y = MFMA16(af[ks], cf[ks], y);
#if DIAG_Y
        {
            const float* cre = a.in[18] + (size_t)(g * 16 + fr) * 64; const float* cim = a.in[19] + (size_t)(g * 16 + fr) * 64;
#pragma unroll
            for (int i = 0; i < 4; ++i) { float acc = 0.f;
                for (int p = 0; p < 64; ++p) { const unsigned wv = *(const unsigned*)(xs + (4 * fq + i) * 272 + p * 4); acc += cre[p] * blo(wv) - cim[p] * bhi(wv); }
                y[i] = acc; }
        }
#endif
        asm volatile("" :: "v"(y));
#pragma unroll
        for (int ks = 0; ks < 4; ++ks) asm volatile("" :: "v"(af[ks]), "v"(cf[ks]));
#pragma unroll
        for (int i = 0; i < 4; ++i) {
            const size_t row = row0 + (size_t)fq * SS + 4 * ms + i;
            Y5[row * 512 + g * 16 + fr] = f2b(gelu_tanh(y[i] + Dg * uu[i]));
        }
    }
}
DI void s5_cfrag(const Args& a, int g, int fr, int fq, bf16x8 (&cf)[4]) {
#pragma unroll
    for (int ks = 0; ks < 4; ++ks) {
        const f32x4 cr = *(const f32x4*)(a.in[18] + (size_t)(g * 16 + fr) * 64 + 16 * ks + 4 * fq), ci = *(const f32x4*)(a.in[19] + (size_t)(g * 16 + fr) * 64 + 16 * ks + 4 * fq);
        u32x4 w; w.x = pk2(cr[0], -ci[0]); w.y = pk2(cr[1], -ci[1]); w.z = pk2(cr[2], -ci[2]); w.w = pk2(cr[3], -ci[3]);
        cf[ks] = __builtin_bit_cast(bf16x8, w);
    }
}
DI void s5_pass2_prompt(const Args& a, unsigned char* lds, int bg, int tid) {
    asm volatile("" : "+v"(tid));
    const int wave = __builtin_amdgcn_readfirstlane(tid >> 6), lane = tid & 63, fr = lane & 15, fq = lane >> 4;
    const int b = bg >> 5, g4 = (bg >> 2) & 7, part = bg & 3, g = 4 * g4 + (wave & 3);
    bg = b * 32 + g;
    unsigned char* xs = lds + wave * 4352;
    S5W w; s5w_setup(a, g, fr, fq, w);
    bf16x8 cf[4]; s5_cfrag(a, g, fr, fq, cf);
    const float Dg = a.in[20][g * 16 + fr];
    float pr[4], pi[4];
#pragma unroll
    for (int j = 0; j < 4; ++j) { pr[j] = w.lr[j]; pi[j] = w.li[j];
#pragma unroll
        for (int s = 0; s < 7; ++s) { const float nr = pr[j] * pr[j] - pi[j] * pi[j], ni = 2.f * pr[j] * pi[j]; pr[j] = nr; pi[j] = ni; } }
    const float* e = (const float*)(a.ws + WS_S5E) + (size_t)bg * 64 * 128;
    for (int uu = 0; uu < 2; ++uu) {
        const int sg = 4 * part + 2 * (wave >> 2) + uu, seg = 4 * sg + fq;
        float xr[4] = {0.f, 0.f, 0.f, 0.f}, xi[4] = {0.f, 0.f, 0.f, 0.f};
        for (int s = 0; s < 4 * sg + 3; ++s) {
            if (s < seg) {
#pragma unroll
                for (int j = 0; j < 4; ++j) { const float er = e[s * 128 + 16 * j + fr], ei = e[s * 128 + 64 + 16 * j + fr];
                    const float nr = pr[j] * xr[j] - pi[j] * xi[j] + er, ni = pr[j] * xi[j] + pi[j] * xr[j] + ei; xr[j] = nr; xi[j] = ni; }
            }
        }
        s5w_run(a, w, cf, Dg, xs, (size_t)b * 8192 + sg * 512, 128, 32, g, fr, fq, xr, xi);
        if (seg == 63) {
#pragma unroll
            for (int j = 0; j < 4; ++j) { a.out[O_PSR + (size_t)bg * 64 + 16 * j + fr] = xr[j]; a.out[O_PSI + (size_t)bg * 64 + 16 * j + fr] = xi[j]; }
        }
    }
}
DI void s5_pass2_sample(const Args& a, unsigned char* xs, int gw, int NGW, int lane) {
    asm volatile("" : "+v"(lane));
    const int fr = lane & 15, fq = lane >> 4;
    for (int unit = gw; unit < 256; unit += NGW) {
        const int g = unit & 31, q = unit >> 5, sb = 4 * q + fq;
        S5W w; s5w_setup(a, g, fr, fq, w);
        bf16x8 cf[4]; s5_cfrag(a, g, fr, fq, cf);
        const float Dg = a.in[20][g * 16 + fr];
        float xr[4], xi[4];
#pragma unroll
        for (int j = 0; j < 4; ++j) { xr[j] = a.in[4][(size_t)(sb * 32 + g) * 64 + 16 * j + fr]; xi[j] = a.in[5][(size_t)(sb * 32 + g) * 64 + 16 * j + fr]; }
        s5w_run(a, w, cf, Dg, xs, (size_t)TP + (size_t)q * 64, 16, 4, g, fr, fq, xr, xi);
#pragma unroll
        for (int j = 0; j < 4; ++j) { a.out[O_SSR + (size_t)(sb * 32 + g) * 64 + 16 * j + fr] = xr[j]; a.out[O_SSI + (size_t)(sb * 32 + g) * 64 + 16 * j + fr] = xi[j]; }
    }
}

struct S5Par { float lr, li; float bbr[16], bbi[16]; };
DI void s5_setup(const Args& a, int g, int p, S5Par& q) {
    const float are = a.in[13][g * 64 + p], aim = a.in[14][g * 64 + p], dt = __expf(a.in[15][g]);
    const float mag = __expf(are * dt), ang = aim * dt;
    float sn, cs; sincosf(ang, &sn, &cs);
    q.lr = mag * cs; q.li = mag * sn;
    const float den = are * are + aim * aim;
    const float fre = ((q.lr - 1.f) * are + q.li * aim) / den, fim = (q.li * are - (q.lr - 1.f) * aim) / den;
    const f32x4* br = (const f32x4*)(a.in[16] + (size_t)(g * 64 + p) * 16); const f32x4* bi = (const f32x4*)(a.in[17] + (size_t)(g * 64 + p) * 16);
#pragma unroll
    for (int j = 0; j < 4; ++j) { const f32x4 r = br[j], i = bi[j];
#pragma unroll
        for (int e = 0; e < 4; ++e) { q.bbr[4 * j + e] = fre * r[e] - fim * i[e]; q.bbi[4 * j + e] = fre * i[e] + fim * r[e]; } }
}
DI void s5_step4(const S5Par& q, float uv, float& xr, float& xi, unsigned (&xo)[4]) {
#pragma unroll
    for (int j = 0; j < 4; ++j) {
        float br = 0.f, bi = 0.f;
#pragma unroll
        for (int h = 0; h < 16; ++h) { const float uh = __int_as_float(__builtin_amdgcn_readlane(__float_as_int(uv), 16 * j + h)); br += q.bbr[h] * uh; bi += q.bbi[h] * uh; }
        const float nr = q.lr * xr - q.li * xi + br, ni = q.lr * xi + q.li * xr + bi;
        xr = nr; xi = ni; xo[j] = pk2(xr, xi);
    }
}
DI void old_s5_pass1(const Args& a, int gw, int NGW, int lane) {
    asm volatile("" : "+v"(lane));
    const bf16* P = (const bf16*)(a.ws + WS_P);
    float* E = (float*)(a.ws + WS_S5E);
    for (int unit = gw; unit < 4 * 32 * 64; unit += NGW) {
        const int seg = unit & 63, bg = unit >> 6, g = bg & 31, b = bg >> 5;
        S5Par q; s5_setup(a, g, lane, q);
        float xr = 0.f, xi = 0.f; unsigned xo[4];
        const bf16* up = P + (size_t)(b * 8192 + seg * 128 + (lane >> 4)) * PW + 2048 + g * 16 + (lane & 15);
#pragma unroll 2
        for (int t = 0; t < 128; t += 4) { const float uv = b2f(up[(size_t)t * PW]); s5_step4(q, uv, xr, xi, xo); }
        float* e = E + ((size_t)bg * 64 + seg) * 128;
        e[lane] = xr; e[64 + lane] = xi;
    }
}
DI void old_s5_pass2(const Args& a, unsigned char* xs  , int gw, int NGW, int lane) {
    asm volatile("" : "+v"(lane));
    const bf16* P = (const bf16*)(a.ws + WS_P);
    const float* E = (const float*)(a.ws + WS_S5E);
    bf16* Y5 = (bf16*)(a.ws + WS_Y5);
    const int fr = lane & 15, fq = lane >> 4;
    for (int unit = gw; unit < OLD_S5_ULIM; unit += NGW) {
        int g, row0, ntok, seg = 0, bg; bool sample;
        if (unit < 8192) { seg = unit & 63; bg = unit >> 6; g = bg & 31; row0 = (bg >> 5) * 8192 + seg * 128; ntok = 128; sample = false; }
        else { bg = unit - 8192; g = bg & 31; row0 = TP + (bg >> 5) * 16; ntok = 16; sample = true; }
        S5Par q; s5_setup(a, g, lane, q);
        float xr = 0.f, xi = 0.f;
        if (sample) { xr = a.in[4][(size_t)bg * 64 + lane]; xi = a.in[5][(size_t)bg * 64 + lane]; }
        else {
            float pr = q.lr, pi = q.li;
#pragma unroll
            for (int s = 0; s < 7; ++s) { const float nr = pr * pr - pi * pi, ni = 2.f * pr * pi; pr = nr; pi = ni; }
            const float* e = E + (size_t)bg * 64 * 128;
            for (int s = 0; s < seg; ++s) { const float er = e[s * 128 + lane], ei = e[s * 128 + 64 + lane]; const float nr = pr * xr - pi * xi + er, ni = pr * xi + pi * xr + ei; xr = nr; xi = ni; }
        }
        bf16x8 cf[4];
#pragma unroll
        for (int ks = 0; ks < 4; ++ks) {
            const f32x4 cr = *(const f32x4*)(a.in[18] + (size_t)(g * 16 + fr) * 64 + 16 * ks + 4 * fq), ci = *(const f32x4*)(a.in[19] + (size_t)(g * 16 + fr) * 64 + 16 * ks + 4 * fq);
            u32x4 w; w.x = pk2(cr[0], -ci[0]); w.y = pk2(cr[1], -ci[1]); w.z = pk2(cr[2], -ci[2]); w.w = pk2(cr[3], -ci[3]);
            cf[ks] = __builtin_bit_cast(bf16x8, w);
        }
        const float Dg = a.in[20][g * 16 + fr];
        const bf16* up = P + (size_t)(row0 + (lane >> 4)) * PW + 2048 + g * 16 + (lane & 15);
        for (int tb = 0; tb < ntok; tb += 16) {
#pragma unroll
            for (int j4 = 0; j4 < 4; ++j4) {
                const float uv = b2f(up[(size_t)(tb + 4 * j4) * PW]);
                unsigned xo[4]; s5_step4(q, uv, xr, xi, xo);
#pragma unroll
                for (int j = 0; j < 4; ++j) *(unsigned*)(xs + (4 * j4 + j) * 272 + lane * 4) = xo[j];
            }
            f32x4 y = (f32x4){0.f, 0.f, 0.f, 0.f};
#pragma unroll
            for (int ks = 0; ks < 4; ++ks) { const bf16x8 af = *(const bf16x8*)(xs + fr * 272 + ks * 64 + fq * 16); y = MFMA16(af, cf[ks], y); }
#pragma unroll
            for (int i = 0; i < 4; ++i) {
                const size_t row = (size_t)row0 + tb + 4 * fq + i;
                const float uu = b2f(P[row * PW + 2048 + g * 16 + fr]);
                Y5[row * 512 + g * 16 + fr] = f2b(gelu_tanh(y[i] + Dg * uu));
            }
        }
        if (sample) { a.out[O_SSR + (size_t)bg * 64 + lane] = xr; a.out[O_SSI + (size_t)bg * 64 + lane] = xi; }
        else if (seg == 63) { a.out[O_PSR + (size_t)bg * 64 + lane] = xr; a.out[O_PSI + (size_t)bg * 64 + lane] = xi; }
    }
}

DI void s5_pass2b(const Args& a, unsigned char* xs, int gw, int NGW, int lane) {
    asm volatile("" : "+v"(lane));
    const bf16* P = (const bf16*)(a.ws + WS_P);
    const float* E = (const float*)(a.ws + WS_S5E);
    bf16* Y5 = (bf16*)(a.ws + WS_Y5);
    const int fr = lane & 15, fq = lane >> 4;
    for (int unit = gw; unit < 4 * 32 * 64 + 32 * 32; unit += NGW) {
        int g, row0, ntok, seg = 0, bg; bool sample;
        if (unit < 8192) { seg = unit & 63; bg = unit >> 6; g = bg & 31; row0 = (bg >> 5) * 8192 + seg * 128; ntok = 128; sample = false; }
        else { bg = unit - 8192; g = bg & 31; row0 = TP + (bg >> 5) * 16; ntok = 16; sample = true; }
        S5Par q; s5_setup(a, g, lane, q);
        float xr = 0.f, xi = 0.f;
        if (sample) { xr = a.in[4][(size_t)bg * 64 + lane]; xi = a.in[5][(size_t)bg * 64 + lane]; }
        else {
            float pr = q.lr, pi = q.li;
#pragma unroll
            for (int s = 0; s < 7; ++s) { const float nr = pr * pr - pi * pi, ni = 2.f * pr * pi; pr = nr; pi = ni; }
            const float* e = E + (size_t)bg * 64 * 128;
            for (int s0 = 0; s0 < seg; s0 += 8) {
                float er[8], ei[8];
#pragma unroll
                for (int k = 0; k < 8; ++k) { const bool ok = s0 + k < seg; er[k] = ok ? e[(s0 + k) * 128 + lane] : 0.f; ei[k] = ok ? e[(s0 + k) * 128 + 64 + lane] : 0.f; }
#pragma unroll
                for (int k = 0; k < 8; ++k) if (s0 + k < seg) { const float nr = pr * xr - pi * xi + er[k], ni = pr * xi + pi * xr + ei[k]; xr = nr; xi = ni; }
            }
        }
        bf16x8 cf[4];
#pragma unroll
        for (int ks = 0; ks < 4; ++ks) {
            const f32x4 cr = *(const f32x4*)(a.in[18] + (size_t)(g * 16 + fr) * 64 + 16 * ks + 4 * fq), ci = *(const f32x4*)(a.in[19] + (size_t)(g * 16 + fr) * 64 + 16 * ks + 4 * fq);
            u32x4 w; w.x = pk2(cr[0], -ci[0]); w.y = pk2(cr[1], -ci[1]); w.z = pk2(cr[2], -ci[2]); w.w = pk2(cr[3], -ci[3]);
            cf[ks] = __builtin_bit_cast(bf16x8, w);
        }
        const float Dg = a.in[20][g * 16 + fr];
        S5W w; s5w_setup(a, g, fr, fq, w);
        unsigned char* bt = xs + 4352;
        for (int tb = 0; tb < ntok; tb += 16) {
            {
                u32x4 uv = (u32x4){0u, 0u, 0u, 0u};
                if (fq < 2) uv = *(const u32x4*)(P + (size_t)(row0 + tb + fr) * PW + 2048 + g * 16 + 8 * fq);
                const bf16x8 ua = __builtin_bit_cast(bf16x8, uv);
                const f32x4 z = (f32x4){0.f, 0.f, 0.f, 0.f};
#pragma unroll
                for (int j = 0; j < 4; ++j) {
                    const f32x4 br = MFMA16(ua, w.bf[j], z), bi = MFMA16(ua, w.bf[4 + j], z);
                    *(f32x4*)(bt + (16 * j + fr) * 80 + fq * 16) = br; *(f32x4*)(bt + (64 + 16 * j + fr) * 80 + fq * 16) = bi;
                }
            }
            asm volatile("s_waitcnt lgkmcnt(0)" ::: "memory");
            f32x4 bre[4], bim[4];
#pragma unroll
            for (int k = 0; k < 4; ++k) { bre[k] = *(const f32x4*)(bt + lane * 80 + k * 16); bim[k] = *(const f32x4*)(bt + (64 + lane) * 80 + k * 16); }
            asm volatile("s_waitcnt lgkmcnt(0)" ::: "memory");
#pragma unroll
            for (int t = 0; t < 16; ++t) {
                const float nr = q.lr * xr - q.li * xi + bre[t >> 2][t & 3], ni = q.lr * xi + q.li * xr + bim[t >> 2][t & 3];
                xr = nr; xi = ni;
                *(unsigned*)(xs + t * 272 + lane * 4) = pk2(nr, ni);
            }
            asm volatile("s_waitcnt lgkmcnt(0)" ::: "memory");
            f32x4 y = (f32x4){0.f, 0.f, 0.f, 0.f};
#pragma unroll
            for (int ks = 0; ks < 4; ++ks) { const bf16x8 af = *(const bf16x8*)(xs + fr * 272 + ks * 64 + fq * 16); y = MFMA16(af, cf[ks], y); }
#pragma unroll
            for (int i = 0; i < 4; ++i) {
                const size_t row = (size_t)row0 + tb + 4 * fq + i;
                const float uu = b2f(P[row * PW + 2048 + g * 16 + fr]);
                Y5[row * 512 + g * 16 + fr] = f2b(gelu_tanh(y[i] + Dg * uu));
            }
        }
        if (sample) { a.out[O_SSR + (size_t)bg * 64 + lane] = xr; a.out[O_SSI + (size_t)bg * 64 + lane] = xi; }
        else if (seg == 63) { a.out[O_PSR + (size_t)bg * 64 + lane] = xr; a.out[O_PSI + (size_t)bg * 64 + lane] = xi; }
    }
}

constexpr int DB_WN = 0, DB_QG = 17408, DB_KDT = 34816, DB_QK = 53248, DB_U0 = 62464;
constexpr int DBP_SIZE = DB_U0 + 64 * 80;
constexpr int DBS_SIZE = DB_U0 + 64 * 272;
template <int NC> struct DnRegs { u32x4 r[7]; u32x4 u[NC == 32 ? 1 : 2]; };
template <int NC> DI void dn_load(const unsigned char* rec, int tid, int c0, DnRegs<NC>& R) {
    const u32x4* g = (const u32x4*)rec;
    R.r[0] = g[tid]; R.r[1] = g[tid + 512]; R.r[2] = g[1024 + tid]; R.r[3] = g[1024 + tid + 512]; R.r[4] = g[2048 + tid]; R.r[5] = g[2048 + tid + 512]; R.r[6] = g[3072 + tid];
    if (NC == 32) { if (tid < 256) R.u[0] = *(const u32x4*)(rec + R_U0 + (tid >> 2) * 256 + c0 * 2 + (tid & 3) * 16); }
    else { R.u[0] = *(const u32x4*)(rec + R_U0 + tid * 16); R.u[1] = *(const u32x4*)(rec + R_U0 + (tid + 512) * 16); }
}
template <int NC> DI void dn_store(unsigned char* buf, int tid, const DnRegs<NC>& R) {
#pragma unroll
    for (int j = 0; j < 2; ++j) { const int q = tid + 512 * j;
        *(u32x4*)(buf + DB_WN + (q >> 4) * 272 + (q & 15) * 16) = R.r[j];
        *(u32x4*)(buf + DB_QG + (q >> 4) * 272 + (q & 15) * 16) = R.r[2 + j];
        *(u32x4*)(buf + DB_KDT + (q >> 3) * 144 + (q & 7) * 16) = R.r[4 + j]; }
    *(u32x4*)(buf + DB_QK + (tid >> 3) * 144 + (tid & 7) * 16) = R.r[6];
    if (NC == 32) { if (tid < 256) *(u32x4*)(buf + DB_U0 + (tid >> 2) * 80 + (tid & 3) * 16) = R.u[0]; }
    else {
#pragma unroll
        for (int j = 0; j < 2; ++j) { const int q = tid + 512 * j; *(u32x4*)(buf + DB_U0 + (q >> 4) * 272 + (q & 15) * 16) = R.u[j]; }
    }
}
DI bf16x8 pack8(const f32x4& lo, const f32x4& hi) { u32x4 w; w.x = pk2(lo[0], lo[1]); w.y = pk2(lo[2], lo[3]); w.z = pk2(hi[0], hi[1]); w.w = pk2(hi[2], hi[3]); return __builtin_bit_cast(bf16x8, w); }
template <int UPI> DI void dn_step(const unsigned char* buf, f32x4 (&S)[8], const unsigned char* u0, float eg, int fr, int fq, f32x4 (&o)[4]) {
    bf16x8 Sb[4];
#pragma unroll
    for (int ks = 0; ks < 4; ++ks) Sb[ks] = pack8(S[2 * ks], S[2 * ks + 1]);
    f32x4 u[4];
#pragma unroll
    for (int mt = 0; mt < 4; ++mt) {
#pragma unroll
        for (int i = 0; i < 4; ++i) u[mt][i] = b2f(*(const bf16*)(u0 + (16 * mt + 4 * fq + i) * UPI));
#pragma unroll
        for (int ks = 0; ks < 4; ++ks) u[mt] = MFMA16(*(const bf16x8*)(buf + DB_WN + (16 * mt + fr) * 272 + ks * 64 + fq * 16), Sb[ks], u[mt]);
    }
    bf16x8 ub[2];
#pragma unroll
    for (int k2 = 0; k2 < 2; ++k2) ub[k2] = pack8(u[2 * k2], u[2 * k2 + 1]);
#pragma unroll
    for (int mt = 0; mt < 4; ++mt) {
        o[mt] = (f32x4){0.f, 0.f, 0.f, 0.f};
#pragma unroll
        for (int ks = 0; ks < 4; ++ks) o[mt] = MFMA16(*(const bf16x8*)(buf + DB_QG + (16 * mt + fr) * 272 + ks * 64 + fq * 16), Sb[ks], o[mt]);
#pragma unroll
        for (int k2 = 0; k2 < 2; ++k2) o[mt] = MFMA16(*(const bf16x8*)(buf + DB_QK + (16 * mt + fr) * 144 + k2 * 64 + fq * 16), ub[k2], o[mt]);
    }
#pragma unroll
    for (int m8 = 0; m8 < 8; ++m8) {
        S[m8] = S[m8] * eg;
#pragma unroll
        for (int k2 = 0; k2 < 2; ++k2) S[m8] = MFMA16(*(const bf16x8*)(buf + DB_KDT + (16 * m8 + fr) * 144 + k2 * 64 + fq * 16), ub[k2], S[m8]);
    }
}
#if DN_STAGED == 2
#define DNP_SYNC() do { asm volatile("s_waitcnt lgkmcnt(0)" ::: "memory"); __builtin_amdgcn_sched_barrier(0); } while (0)
#else
#define DNP_SYNC() do { } while (0)
#endif
DI void dn_step_p(const unsigned char* buf, f32x4 (&S)[8], const unsigned char* u0, float eg, int fr, int fq, f32x4 (&o)[4]) {
    const unsigned char* aw = buf + DB_WN + fr * 272 + fq * 16;
    const unsigned char* aq = buf + DB_QG + fr * 272 + fq * 16;
    const unsigned char* ak = buf + DB_KDT + fr * 144 + fq * 16;
    const unsigned char* ac = buf + DB_QK + fr * 144 + fq * 16;
    bf16x8 f1[16], f2[16], Sb[4], ub[2];
    f32x4 u[4];
#pragma unroll
    for (int mt = 0; mt < 4; ++mt)
#pragma unroll
        for (int ks = 0; ks < 4; ++ks) f1[4 * mt + ks] = *(const bf16x8*)(aw + mt * 4352 + ks * 64);
#pragma unroll
    for (int mt = 0; mt < 4; ++mt)
#pragma unroll
        for (int i = 0; i < 4; ++i) u[mt][i] = b2f(*(const bf16*)(u0 + (16 * mt + 4 * fq + i) * 80));
#pragma unroll
    for (int ks = 0; ks < 4; ++ks) Sb[ks] = pack8(S[2 * ks], S[2 * ks + 1]);
    __builtin_amdgcn_sched_barrier(0);
#pragma unroll
    for (int mt = 0; mt < 4; ++mt)
#pragma unroll
        for (int ks = 0; ks < 4; ++ks) f2[4 * mt + ks] = *(const bf16x8*)(aq + mt * 4352 + ks * 64);
    DNP_SYNC();
#pragma unroll
    for (int ks = 0; ks < 4; ++ks)
#pragma unroll
        for (int mt = 0; mt < 4; ++mt) u[mt] = MFMA16(f1[4 * mt + ks], Sb[ks], u[mt]);
    __builtin_amdgcn_sched_barrier(0);
#pragma unroll
    for (int k2 = 0; k2 < 2; ++k2) ub[k2] = pack8(u[2 * k2], u[2 * k2 + 1]);
#pragma unroll
    for (int m8 = 0; m8 < 8; ++m8)
#pragma unroll
        for (int k2 = 0; k2 < 2; ++k2) f1[2 * m8 + k2] = *(const bf16x8*)(ak + m8 * 2304 + k2 * 64);
    DNP_SYNC();
#pragma unroll
    for (int mt = 0; mt < 4; ++mt) o[mt] = (f32x4){0.f, 0.f, 0.f, 0.f};
#pragma unroll
    for (int ks = 0; ks < 4; ++ks)
#pragma unroll
        for (int mt = 0; mt < 4; ++mt) o[mt] = MFMA16(f2[4 * mt + ks], Sb[ks], o[mt]);
    __builtin_amdgcn_sched_barrier(0);
#pragma unroll
    for (int mt = 0; mt < 4; ++mt)
#pragma unroll
        for (int k2 = 0; k2 < 2; ++k2) f2[2 * mt + k2] = *(const bf16x8*)(ac + mt * 2304 + k2 * 64);
    DNP_SYNC();
#pragma unroll
    for (int m8 = 0; m8 < 8; ++m8) S[m8] = S[m8] * eg;
#pragma unroll
    for (int k2 = 0; k2 < 2; ++k2)
#pragma unroll
        for (int m8 = 0; m8 < 8; ++m8) S[m8] = MFMA16(f1[2 * m8 + k2], ub[k2], S[m8]);
    __builtin_amdgcn_sched_barrier(0);
#pragma unroll
    for (int k2 = 0; k2 < 2; ++k2)
#pragma unroll
        for (int mt = 0; mt < 4; ++mt) o[mt] = MFMA16(f2[2 * mt + k2], ub[k2], o[mt]);
}
DI void dn_step_o(const unsigned char* buf, f32x4 (&S)[8], const unsigned char* u0, float eg, int fr, int fq, f32x4 (&o)[4]) {
    const unsigned char* aw = buf + DB_WN + fr * 272 + fq * 16;
    const unsigned char* aq = buf + DB_QG + fr * 272 + fq * 16;
    const unsigned char* ak = buf + DB_KDT + fr * 144 + fq * 16;
    const unsigned char* ac = buf + DB_QK + fr * 144 + fq * 16;
    bf16x8 f1[16], f2[16], Sb[4], ub[2];
    f32x4 u[4];
#pragma unroll
    for (int ks = 0; ks < 4; ++ks) Sb[ks] = pack8(S[2 * ks], S[2 * ks + 1]);
    __builtin_amdgcn_sched_barrier(0);
#pragma unroll
    for (int mt = 0; mt < 4; ++mt)
#pragma unroll
        for (int ks = 0; ks < 4; ++ks) f1[4 * mt + ks] = *(const bf16x8*)(aw + mt * 4352 + ks * 64);
#pragma unroll
    for (int mt = 0; mt < 4; ++mt)
#pragma unroll
        for (int i = 0; i < 4; ++i) u[mt][i] = b2f(*(const bf16*)(u0 + (16 * mt + 4 * fq + i) * 80));
#pragma unroll
    for (int mt = 0; mt < 4; ++mt)
#pragma unroll
        for (int ks = 0; ks < 4; ++ks) f2[4 * mt + ks] = *(const bf16x8*)(aq + mt * 4352 + ks * 64);
    __builtin_amdgcn_sched_barrier(0);
#pragma unroll
    for (int ks = 0; ks < 4; ++ks)
#pragma unroll
        for (int mt = 0; mt < 4; ++mt) u[mt] = MFMA16(f1[4 * mt + ks], Sb[ks], u[mt]);
    __builtin_amdgcn_sched_barrier(0);
#pragma unroll
    for (int k2 = 0; k2 < 2; ++k2) ub[k2] = pack8(u[2 * k2], u[2 * k2 + 1]);
    __builtin_amdgcn_sched_barrier(0);
#pragma unroll
    for (int m8 = 0; m8 < 8; ++m8)
#pragma unroll
        for (int k2 = 0; k2 < 2; ++k2) f1[2 * m8 + k2] = *(const bf16x8*)(ak + m8 * 2304 + k2 * 64);
#pragma unroll
    for (int mt = 0; mt < 4; ++mt) o[mt] = (f32x4){0.f, 0.f, 0.f, 0.f};
#pragma unroll
    for (int ks = 0; ks < 4; ++ks)
#pragma unroll
        for (int mt = 0; mt < 4; ++mt) o[mt] = MFMA16(f2[4 * mt + ks], Sb[ks], o[mt]);
    __builtin_amdgcn_sched_barrier(0);
    { float dmy = (o[0][0] + o[1][0]) + (o[2][0] + o[3][0]); asm volatile("" :: "v"(dmy)); }
    __builtin_amdgcn_sched_barrier(0);
#pragma unroll
    for (int mt = 0; mt < 4; ++mt)
#pragma unroll
        for (int k2 = 0; k2 < 2; ++k2) f2[2 * mt + k2] = *(const bf16x8*)(ac + mt * 2304 + k2 * 64);
#pragma unroll
    for (int m8 = 0; m8 < 8; ++m8) S[m8] = S[m8] * eg;
#pragma unroll
    for (int k2 = 0; k2 < 2; ++k2)
#pragma unroll
        for (int m8 = 0; m8 < 8; ++m8) S[m8] = MFMA16(f1[2 * m8 + k2], ub[k2], S[m8]);
    __builtin_amdgcn_sched_barrier(0);
#pragma unroll
    for (int k2 = 0; k2 < 2; ++k2)
#pragma unroll
        for (int mt = 0; mt < 4; ++mt) o[mt] = MFMA16(f2[2 * mt + k2], ub[k2], o[mt]);
}
DI void dn_piece(int q, int c0, unsigned& src, unsigned& dst) {
    if (q < 1024) { src = R_WN + q * 16; dst = DB_WN + (q >> 4) * 272 + (q & 15) * 16; }
    else if (q < 2048) { const int p = q - 1024; src = R_QG + p * 16; dst = DB_QG + (p >> 4) * 272 + (p & 15) * 16; }
    else if (q < 3072) { const int p = q - 2048; src = R_KDT + p * 16; dst = DB_KDT + (p >> 3) * 144 + (p & 7) * 16; }
    else if (q < 3584) { const int p = q - 3072; src = R_QK + p * 16; dst = DB_QK + (p >> 3) * 144 + (p & 7) * 16; }
    else { const int p = q - 3584; src = R_U0 + (p >> 2) * 256 + c0 * 2 + (p & 3) * 16; dst = DB_U0 + (p >> 2) * 80 + (p & 3) * 16; }
}
#define DN_LD(R, base) do { _Pragma("unroll") for (int k = 0; k < 10; ++k) { unsigned s_, d_; dn_piece(lt + 384 * k, c0, s_, d_); R[k] = *(const u32x4*)((base) + s_); } } while (0)
#define DN_WAIT(R, cnt) do { } while (0)
#define DN_ST(R, buf) do { _Pragma("unroll") for (int k = 0; k < 10; ++k) { unsigned s_, d_; dn_piece(lt + 384 * k, c0, s_, d_); *(u32x4*)((buf) + d_) = R[k]; } } while (0)
#define DN_BAR() do { asm volatile("s_waitcnt lgkmcnt(0)" ::: "memory"); __builtin_amdgcn_s_barrier(); asm volatile("" ::: "memory"); } while (0)
DI void dn_scan_prompt(const Args& a, unsigned char* lds, int tid) {
    asm volatile("" : "+v"(tid));
    const int wave = __builtin_amdgcn_readfirstlane(tid >> 6), lane = tid & 63, fr = lane & 15, fq = lane >> 4;
    const int bh = blockIdx.x >> 2, qt = blockIdx.x & 3, b = bh >> 2, h = bh & 3;
    const int c0 = qt * 32, v0 = c0 + (wave & 1) * 16;
    const unsigned char* recs = a.ws + WS_DNC + (size_t)bh * 128 * REC;
    const float* egs = (const float*)(a.ws + WS_EG) + bh * 128;
    float* ORAW = (float*)(a.ws + WS_H);
    const bool loader = wave >= 2;
    const int lt = tid - 128;
    f32x4 S[8];
#pragma unroll
    for (int m8 = 0; m8 < 8; ++m8) S[m8] = (f32x4){0.f, 0.f, 0.f, 0.f};
    float egA = egs[lane], egB = egs[64 + lane];
    asm volatile("s_waitcnt vmcnt(0)" : "+v"(egA), "+v"(egB) :: "memory");
    if (loader) {
        const int grp = wave >= 5 ? 1 : 0, lt2 = tid - 128 - grp * 192;
        u32x4 R[20];
#define DN_LD20(base) do { _Pragma("unroll") for (int k = 0; k < 20; ++k) { unsigned s_, d_; dn_piece(lt2 + 192 * k, c0, s_, d_); R[k] = *(const u32x4*)((base) + s_); } } while (0)
#define DN_ST20(buf) do { _Pragma("unroll") for (int k = 0; k < 20; ++k) { unsigned s_, d_; dn_piece(lt2 + 192 * k, c0, s_, d_); *(u32x4*)((buf) + d_) = R[k]; } } while (0)
        if (grp == 0) { DN_LD20(recs); DN_ST20(lds); DN_LD20(recs + 2 * (size_t)REC); }
        else { DN_LD20(recs + REC); }
        DN_BAR();
        for (int n = 0; n < 128; n += 2) {
            if (grp == 1) { DN_ST20(lds + DBP_SIZE); if (n + 3 < 128) DN_LD20(recs + (size_t)(n + 3) * REC); }
            DN_BAR();
            if (grp == 0 && n + 2 < 128) { DN_ST20(lds); if (n + 4 < 128) DN_LD20(recs + (size_t)(n + 4) * REC); }
            DN_BAR();
        }
#undef DN_LD20
#undef DN_ST20
    } else {
        DN_BAR();
        for (int n = 0; n < 128; ++n) {
            const float eg0 = __int_as_float(__builtin_amdgcn_readlane(__float_as_int(n < 64 ? egA : egB), n & 63));
            f32x4 o[4];
#if DN_STAGED == 3
            dn_step_o(lds + (n & 1) * DBP_SIZE, S, lds + (n & 1) * DBP_SIZE + DB_U0 + ((wave & 1) * 16 + fr) * 2, eg0, fr, fq, o);
#elif DN_STAGED
            dn_step_p(lds + (n & 1) * DBP_SIZE, S, lds + (n & 1) * DBP_SIZE + DB_U0 + ((wave & 1) * 16 + fr) * 2, eg0, fr, fq, o);
#else
            dn_step<80>(lds + (n & 1) * DBP_SIZE, S, lds + (n & 1) * DBP_SIZE + DB_U0 + ((wave & 1) * 16 + fr) * 2, eg0, fr, fq, o);
#endif
            float* op = ORAW + (size_t)(b * 8192 + n * 64) * 512 + h * 128 + v0 + fr;
#pragma unroll
            for (int mt = 0; mt < 4; ++mt)
#pragma unroll
                for (int i = 0; i < 4; ++i) op[(size_t)(16 * mt + 4 * fq + i) * 512] = o[mt][i];
            DN_BAR();
        }
    }
    if (!loader) {
        float* so = a.out + O_PDS + (size_t)bh * 128 * 128 + v0 + fr;
#pragma unroll
        for (int m8 = 0; m8 < 8; ++m8)
#pragma unroll
            for (int i = 0; i < 4; ++i) so[(16 * m8 + 4 * fq + i) * 128] = S[m8][i];
    }
    __syncthreads();
}
DI void dn_scan_sample(const Args& a, unsigned char* lds, int tid, int wg, int nwg) {
    asm volatile("" : "+v"(tid));
    const int wave = __builtin_amdgcn_readfirstlane(tid >> 6), lane = tid & 63, fr = lane & 15, fq = lane >> 4;
    const int v0 = wave * 16;
    float* ORAW = (float*)(a.ws + WS_H);
    for (int su = wg; su < 128; su += nwg) {
        const int sb = su >> 2, h = su & 3;
        const unsigned char* rec = a.ws + WS_DNC + (size_t)(2048 + su) * REC;
        DnRegs<128> R; dn_load<128>(rec, tid, 0, R); dn_store<128>(lds, tid, R);
        __syncthreads();
        f32x4 S[8];
        const float* s0 = a.in[3] + (size_t)su * 128 * 128 + v0 + fr;
#pragma unroll
        for (int m8 = 0; m8 < 8; ++m8)
#pragma unroll
            for (int i = 0; i < 4; ++i) S[m8][i] = s0[(16 * m8 + 4 * fq + i) * 128];
        f32x4 o[4];
        dn_step<272>(lds, S, lds + DB_U0 + (v0 + fr) * 2, ((const float*)(a.ws + WS_EG))[2048 + su], fr, fq, o);
        float* op = ORAW + (size_t)(TP + sb * 16) * 512 + h * 128 + v0 + fr;
#pragma unroll
        for (int i = 0; i < 4; ++i) op[(size_t)(4 * fq + i) * 512] = o[0][i];
        float* so = a.out + O_SDS + (size_t)su * 128 * 128 + v0 + fr;
#pragma unroll
        for (int m8 = 0; m8 < 8; ++m8)
#pragma unroll
            for (int i = 0; i < 4; ++i) so[(16 * m8 + 4 * fq + i) * 128] = S[m8][i];
        __syncthreads();
    }
}

DI void mix_phase(const Args& a, int gw, int NGW, int lane) {
    asm volatile("" : "+v"(lane));
    const float* ORAW = (const float*)(a.ws + WS_H);
    const bf16* P = (const bf16*)(a.ws + WS_P);
    const bf16* GLU = (const bf16*)(a.ws + WS_GLU);
    bf16* MIX = (bf16*)(a.ws + WS_DNC);
    const f32x2 dg = *(const f32x2*)(a.in[12] + 2 * lane);
    const f32x4 sg0 = *(const f32x4*)(a.in[23] + 8 * lane), sg1 = *(const f32x4*)(a.in[23] + 8 * lane + 4);
    for (int row = gw; row < T; row += NGW) {
#pragma unroll
        for (int h = 0; h < 4; ++h) {
            const f32x2 ov = *(const f32x2*)(ORAW + (size_t)row * 512 + h * 128 + 2 * lane);
            const float r = rsqrtf(wave_sum(ov.x * ov.x + ov.y * ov.y) * (1.f / 128.f) + EPS);
            const unsigned zz = *(const unsigned*)(P + (size_t)row * PW + 1536 + h * 128 + 2 * lane);
            *(unsigned*)(MIX + (size_t)row * DM + h * 128 + 2 * lane) = pk2(ov.x * r * dg.x * silu(blo(zz)), ov.y * r * dg.y * silu(bhi(zz)));
        }
        const u32x4 gv = *(const u32x4*)(GLU + (size_t)row * 512 + 8 * lane);
        float v[8] = {blo(gv.x), bhi(gv.x), blo(gv.y), bhi(gv.y), blo(gv.z), bhi(gv.z), blo(gv.w), bhi(gv.w)};
        float ss = 0.f;
#pragma unroll
        for (int e = 0; e < 8; ++e) ss += v[e] * v[e];
        const float r5 = rsqrtf(wave_sum(ss) * (1.f / 512.f) + EPS);
        u32x4 w; w.x = pk2(v[0] * r5 * sg0[0], v[1] * r5 * sg0[1]); w.y = pk2(v[2] * r5 * sg0[2], v[3] * r5 * sg0[3]);
        w.z = pk2(v[4] * r5 * sg1[0], v[5] * r5 * sg1[1]); w.w = pk2(v[6] * r5 * sg1[2], v[7] * r5 * sg1[3]);
        *(u32x4*)(MIX + (size_t)row * DM + 512 + 8 * lane) = w;
    }
}

DI void act_phase(const Args& a, int gtid, int NT) {
    asm volatile("" : "+v"(gtid));
    bf16* UP = (bf16*)(a.ws + WS_UP);
    const float* fw = a.in[27]; const float* fb = a.in[28];
    constexpr int NCG = DFF / 8;
    for (int item = gtid; item < (T / 16) * NCG; item += NT) {
        const int cg8 = item % NCG, rb = item / NCG, col = cg8 * 8, row0 = rb * 16;
        float w0[8], w1[8], w2[8], bb[8], g2[8], g1[8];
#pragma unroll
        for (int e = 0; e < 8; ++e) { w0[e] = fw[col + e]; w1[e] = fw[DFF + col + e]; w2[e] = fw[2 * DFF + col + e]; bb[e] = fb[col + e]; g2[e] = 0.f; g1[e] = 0.f; }
        const bool sample = row0 >= TP;
        float* outp = nullptr;
        if (sample) { const int sb = (row0 - TP) >> 4; const float* cc = a.in[6] + (size_t)sb * 2 * DFF + col;
#pragma unroll
            for (int e = 0; e < 8; ++e) { g2[e] = cc[e]; g1[e] = cc[DFF + e]; }
            outp = a.out + O_SFC + (size_t)sb * 2 * DFF + col;
        } else {
            if ((rb & 511) != 0) {
                const u32x4 x2 = *(const u32x4*)(UP + (size_t)(row0 - 2) * UPW + col), x1 = *(const u32x4*)(UP + (size_t)(row0 - 1) * UPW + col);
                g2[0] = blo(x2.x); g2[1] = bhi(x2.x); g2[2] = blo(x2.y); g2[3] = bhi(x2.y); g2[4] = blo(x2.z); g2[5] = bhi(x2.z); g2[6] = blo(x2.w); g2[7] = bhi(x2.w);
                g1[0] = blo(x1.x); g1[1] = bhi(x1.x); g1[2] = blo(x1.y); g1[3] = bhi(x1.y); g1[4] = blo(x1.z); g1[5] = bhi(x1.z); g1[6] = blo(x1.w); g1[7] = bhi(x1.w);
            }
            if ((rb & 511) == 511) outp = a.out + O_PFC + (size_t)(rb >> 9) * 2 * DFF + col;
        }
#pragma unroll 4
        for (int r = 0; r < 16; ++r) {
            bf16* gp = UP + (size_t)(row0 + r) * UPW + col;
            const u32x4 xg = *(const u32x4*)gp, xv = *(const u32x4*)(gp + DFF);
            float g0[8] = {blo(xg.x), bhi(xg.x), blo(xg.y), bhi(xg.y), blo(xg.z), bhi(xg.z), blo(xg.w), bhi(xg.w)};
            float vv[8] = {blo(xv.x), bhi(xv.x), blo(xv.y), bhi(xv.y), blo(xv.z), bhi(xv.z), blo(xv.w), bhi(xv.w)};
            float o[8];
#pragma unroll
            for (int e = 0; e < 8; ++e) { o[e] = silu(g2[e] * w0[e] + g1[e] * w1[e] + g0[e] * w2[e] + bb[e]) * vv[e]; g2[e] = g1[e]; g1[e] = g0[e]; }
            u32x4 w; w.x = pk2(o[0], o[1]); w.y = pk2(o[2], o[3]); w.z = pk2(o[4], o[5]); w.w = pk2(o[6], o[7]);
            *(u32x4*)(gp + DFF) = w;
            if (outp && r >= 14) {
#pragma unroll
                for (int e = 0; e < 8; ++e) outp[(r - 14) * DFF + e] = g0[e];
            }
        }
    }
}

DI void act_fix_phase(const Args& a, int gtid, int NT) {
    asm volatile("" : "+v"(gtid));
    bf16* ACT = (bf16*)(a.ws + WS_UP);
    const bf16* GH = (const bf16*)(a.ws + WS_GH); const bf16* GT = (const bf16*)(a.ws + WS_GT); const bf16* VH = (const bf16*)(a.ws + WS_VH);
    const float* fw = a.in[27]; const float* fb = a.in[28];
    constexpr int NCG = DFF / 8;
    for (int item = gtid; item < (T / 16) * NCG; item += NT) {
        const int cg8 = item % NCG, grp = item / NCG, col = cg8 * 8;
        float w0[8], w1[8], w2[8], bb[8], g2[8], g1[8], h0[8], h1[8], v0[8], v1[8];
#pragma unroll
        for (int e = 0; e < 8; ++e) { w0[e] = fw[col + e]; w1[e] = fw[DFF + col + e]; w2[e] = fw[2 * DFF + col + e]; bb[e] = fb[col + e]; g2[e] = 0.f; g1[e] = 0.f; }
        const bool sample = grp >= TP / 16;
        if (sample) { const float* cc = a.in[6] + (size_t)(grp - TP / 16) * 2 * DFF + col;
#pragma unroll
            for (int e = 0; e < 8; ++e) { g2[e] = cc[e]; g1[e] = cc[DFF + e]; }
        } else if ((grp & 511) != 0) {
            const u32x4 x2 = *(const u32x4*)(GT + ((size_t)(grp - 1) * 2) * DFF + col), x1 = *(const u32x4*)(GT + ((size_t)(grp - 1) * 2 + 1) * DFF + col);
            g2[0] = blo(x2.x); g2[1] = bhi(x2.x); g2[2] = blo(x2.y); g2[3] = bhi(x2.y); g2[4] = blo(x2.z); g2[5] = bhi(x2.z); g2[6] = blo(x2.w); g2[7] = bhi(x2.w);
            g1[0] = blo(x1.x); g1[1] = bhi(x1.x); g1[2] = blo(x1.y); g1[3] = bhi(x1.y); g1[4] = blo(x1.z); g1[5] = bhi(x1.z); g1[6] = blo(x1.w); g1[7] = bhi(x1.w);
        }
        {
            const u32x4 xa = *(const u32x4*)(GH + ((size_t)grp * 2) * DFF + col), xb = *(const u32x4*)(GH + ((size_t)grp * 2 + 1) * DFF + col);
            const u32x4 ya = *(const u32x4*)(VH + ((size_t)grp * 2) * DFF + col), yb = *(const u32x4*)(VH + ((size_t)grp * 2 + 1) * DFF + col);
            h0[0] = blo(xa.x); h0[1] = bhi(xa.x); h0[2] = blo(xa.y); h0[3] = bhi(xa.y); h0[4] = blo(xa.z); h0[5] = bhi(xa.z); h0[6] = blo(xa.w); h0[7] = bhi(xa.w);
            h1[0] = blo(xb.x); h1[1] = bhi(xb.x); h1[2] = blo(xb.y); h1[3] = bhi(xb.y); h1[4] = blo(xb.z); h1[5] = bhi(xb.z); h1[6] = blo(xb.w); h1[7] = bhi(xb.w);
            v0[0] = blo(ya.x); v0[1] = bhi(ya.x); v0[2] = blo(ya.y); v0[3] = bhi(ya.y); v0[4] = blo(ya.z); v0[5] = bhi(ya.z); v0[6] = blo(ya.w); v0[7] = bhi(ya.w);
            v1[0] = blo(yb.x); v1[1] = bhi(yb.x); v1[2] = blo(yb.y); v1[3] = bhi(yb.y); v1[4] = blo(yb.z); v1[5] = bhi(yb.z); v1[6] = blo(yb.w); v1[7] = bhi(yb.w);
        }
        float o0[8], o1[8];
#pragma unroll
        for (int e = 0; e < 8; ++e) { o0[e] = silu(g2[e] * w0[e] + g1[e] * w1[e] + h0[e] * w2[e] + bb[e]) * v0[e]; o1[e] = silu(g1[e] * w0[e] + h0[e] * w1[e] + h1[e] * w2[e] + bb[e]) * v1[e]; }
        u32x4 wa, wb; wa.x = pk2(o0[0], o0[1]); wa.y = pk2(o0[2], o0[3]); wa.z = pk2(o0[4], o0[5]); wa.w = pk2(o0[6], o0[7]);
        wb.x = pk2(o1[0], o1[1]); wb.y = pk2(o1[2], o1[3]); wb.z = pk2(o1[4], o1[5]); wb.w = pk2(o1[6], o1[7]);
        *(u32x4*)(ACT + ((size_t)grp * 16) * DFF + col) = wa; *(u32x4*)(ACT + ((size_t)grp * 16 + 1) * DFF + col) = wb;
        float* outp = nullptr;
        if (sample) outp = a.out + O_SFC + (size_t)(grp - TP / 16) * 2 * DFF + col;
        else if ((grp & 511) == 511) outp = a.out + O_PFC + (size_t)(grp >> 9) * 2 * DFF + col;
        if (outp) {
            const u32x4 t0 = *(const u32x4*)(GT + ((size_t)grp * 2) * DFF + col), t1 = *(const u32x4*)(GT + ((size_t)grp * 2 + 1) * DFF + col);
            outp[0] = blo(t0.x); outp[1] = bhi(t0.x); outp[2] = blo(t0.y); outp[3] = bhi(t0.y); outp[4] = blo(t0.z); outp[5] = bhi(t0.z); outp[6] = blo(t0.w); outp[7] = bhi(t0.w);
            outp[DFF + 0] = blo(t1.x); outp[DFF + 1] = bhi(t1.x); outp[DFF + 2] = blo(t1.y); outp[DFF + 3] = bhi(t1.y); outp[DFF + 4] = blo(t1.z); outp[DFF + 5] = bhi(t1.z); outp[DFF + 6] = blo(t1.w); outp[DFF + 7] = bhi(t1.w);
        }
    }
}

DI void final_phase(const Args& a, int gw, int NGW, int lane) {
    asm volatile("" : "+v"(lane));
    f32x4 gv[4];
#pragma unroll
    for (int j = 0; j < 4; ++j) gv[j] = ((const f32x4*)a.in[30])[lane + 64 * j];
    for (int m0 = gw; m0 < T; m0 += 2 * NGW) {
        const int m1 = m0 + NGW < T ? m0 + NGW : m0;
        f32x4* xr0 = (f32x4*)(a.out + (size_t)m0 * DM) + lane; f32x4* xr1 = (f32x4*)(a.out + (size_t)m1 * DM) + lane;
        f32x4 v0[4], v1[4]; float s0 = 0.f, s1 = 0.f;
#pragma unroll
        for (int j = 0; j < 4; ++j) { v0[j] = xr0[64 * j]; v1[j] = xr1[64 * j]; }
#pragma unroll
        for (int j = 0; j < 4; ++j) { s0 += (v0[j].x * v0[j].x + v0[j].y * v0[j].y) + (v0[j].z * v0[j].z + v0[j].w * v0[j].w); s1 += (v1[j].x * v1[j].x + v1[j].y * v1[j].y) + (v1[j].z * v1[j].z + v1[j].w * v1[j].w); }
        const float r0 = rsqrtf(wave_sum(s0) * (1.f / DM) + EPS), r1 = rsqrtf(wave_sum(s1) * (1.f / DM) + EPS);
#pragma unroll
        for (int j = 0; j < 4; ++j) xr0[64 * j] = v0[j] * r0 * gv[j];
        if (m1 != m0) {
#pragma unroll
            for (int j = 0; j < 4; ++j) xr1[64 * j] = v1[j] * r1 * gv[j];
        }
    }
}

#ifndef PH_MASK
#define PH_MASK 0xffff
#endif
#ifndef SOLVE_RL
#define SOLVE_RL 1
#endif
#ifndef REP0
#define REP0 1
#endif
#ifndef REP1
#define REP1 1
#endif
#ifndef REP2A
#define REP2A 1
#endif
#ifndef REP2B
#define REP2B 1
#endif
#ifndef REP3A
#define REP3A 1
#endif
#ifndef REP3B
#define REP3B 1
#endif
#ifndef REP3C
#define REP3C 1
#endif
#ifndef PH_LO
#define PH_LO 0
#endif
#ifndef PH_HI
#define PH_HI 99
#endif
__global__ void __launch_bounds__(512, 2) fwd_kernel(Args a) {
    extern __shared__ __attribute__((aligned(16))) unsigned char lds[];
    cg::grid_group grid = cg::this_grid();
    const int tid = threadIdx.x, lane = tid & 63, wave = __builtin_amdgcn_readfirstlane(tid >> 6);
    const int G = gridDim.x, gw = blockIdx.x * 8 + wave, NGW = G * 8;
    unsigned char* ws = a.ws;
    PG8_LAS unsigned char* ldsg = (PG8_LAS unsigned char*)lds;
    volatile LAS unsigned* xbst = (volatile LAS unsigned*)(ldsg + (LDS_BYTES - 64));
    if (tid < 2) xbst[tid] = 0u;
    __syncthreads();
    const XcdBarrier xbar = xcd_barrier_post((unsigned*)(ws + WS_CTL), xbst);

    _Pragma("nounroll") for (int rep = 0; rep < REP0; ++rep) { phase0(a, lds, gw, NGW, wave, lane); __syncthreads(); }
    xcd_barrier(xbar);
    if (a.out == nullptr) grid.sync();
    _Pragma("nounroll") for (int rep = 0; rep < REP1; ++rep)
    { pg8::Gemm g{(const bf16*)(ws + WS_H), (const bf16*)(ws + WS_WIN), T, NIN, DM, DM}; pg8::StaticOrder S; S.init(T, NIN, G, (int)blockIdx.x);
      EpiP E{(bf16*)(ws + WS_P), (float*)(ws + WS_BA)};
      pg8::gemm_phase<EpiP, pg8::StaticOrder, true, true>(ldsg, g, S, E); }
    xcd_barrier(xbar);
    _Pragma("nounroll") for (int rep = 0; rep < REP2A; ++rep) dn_chunk_phase(a, lds, tid);
#if OLD_S5 && OLD_S5 != 4 && OLD_S5 != 5
    old_s5_pass1(a, gw, NGW, lane);
#elif 0
#else
    _Pragma("nounroll") for (int rep = 0; rep < REP2B; ++rep) s5_pass1(a, gw, NGW, lane);
#endif
    xcd_barrier(xbar);
#if OLD_S5 == 3
    if (blockIdx.x < 64) dn_scan_prompt(a, lds, tid);
    else { if (blockIdx.x >= 192) { dn_scan_sample(a, lds, tid, (int)blockIdx.x - 192, 64); s5_pass2_sample(a, lds + 81920 + wave * 4352, ((int)blockIdx.x - 192) * 8 + wave, 512, lane); __syncthreads(); }
           old_s5_pass2(a, lds + 81920 + wave * 4352, gw - 512, NGW - 512, lane); }
#elif OLD_S5 == 5
    if (blockIdx.x < 64) { _Pragma("nounroll") for (int rep = 0; rep < REP3A; ++rep) dn_scan_prompt(a, lds, tid); }
    else { if (blockIdx.x >= 192) dn_scan_sample(a, lds, tid, (int)blockIdx.x - 192, 64); _Pragma("nounroll") for (int rep = 0; rep < REP3B; ++rep) s5_pass2b(a, lds + wave * 14592, gw - 512, NGW - 512, lane); }
#elif OLD_S5 == 1 || OLD_S5 == 4
    if (blockIdx.x < 64) dn_scan_prompt(a, lds, tid);
    else { if (blockIdx.x >= 192) dn_scan_sample(a, lds, tid, (int)blockIdx.x - 192, 64); old_s5_pass2(a, lds + 81920 + wave * 4352, gw - 512, NGW - 512, lane); }
#else
    if (blockIdx.x < 64) { _Pragma("nounroll") for (int rep = 0; rep < REP3A; ++rep) dn_scan_prompt(a, lds, tid); }
    else if (blockIdx.x < 192) { _Pragma("nounroll") for (int rep = 0; rep < REP3B; ++rep) s5_pass2_prompt(a, lds, (int)blockIdx.x - 64, tid); }
    else { _Pragma("nounroll") for (int rep = 0; rep < REP3C; ++rep) { dn_scan_sample(a, lds, tid, (int)blockIdx.x - 192, 64); s5_pass2_sample(a, lds + 81920 + wave * 4352, ((int)blockIdx.x - 192) * 8 + wave, 512, lane); } }
#endif
    xcd_barrier(xbar);
#if PH_MASK & 512
    { pg8::Gemm g{(const bf16*)(ws + WS_Y5), (const bf16*)(ws + WS_WGLU), T, 1024, 512, 512}; pg8::StaticOrder S; S.init(T, 1024, G, (int)blockIdx.x);
      EpiGlu E{(bf16*)(ws + WS_GLU), a.in[22]};
      pg8::gemm_phase<EpiGlu, pg8::StaticOrder, true, true>(ldsg, g, S, E); }
#endif
    xcd_barrier(xbar);
#if PH_MASK & 32
    mix_phase(a, gw, NGW, lane);
#endif
    xcd_barrier(xbar);
#if PH_MASK & 1024
    { pg8::Gemm g{(const bf16*)(ws + WS_DNC), (const bf16*)(ws + WS_WOUT), T, DM, DM, DM}; pg8::StaticOrder S; S.init(T, DM, G, (int)blockIdx.x);
      EpiX1 E{a.in[0], a.in[1], a.out, (bf16*)(ws + WS_H), (float*)(ws + WS_SS2)};
      pg8::gemm_phase<EpiX1, pg8::StaticOrder, true, true>(ldsg, g, S, E); }
#endif
    xcd_barrier(xbar);
#if FUSE_ACT
    { pg8::Gemm g{(const bf16*)(ws + WS_H), (const bf16*)(ws + WS_WUP), T, UPW, DM, DM}; pg8::StaticOrder S; S.init(T, UPW, G, (int)blockIdx.x);
      EpiUpAct E{(bf16*)(ws + WS_UP), (bf16*)(ws + WS_GH), (bf16*)(ws + WS_GT), (bf16*)(ws + WS_VH), (const float*)(ws + WS_SS2), a.in[27], a.in[28]};
      pg8::gemm_phase<EpiUpAct, pg8::StaticOrder, true, true>(ldsg, g, S, E); }
    xcd_barrier(xbar);
    act_fix_phase(a, (int)blockIdx.x * 512 + tid, G * 512);
    xcd_barrier(xbar);
    { pg8::Gemm g{(const bf16*)(ws + WS_UP), (const bf16*)(ws + WS_WDOWN), T, DM, DFF, DFF}; pg8::StaticOrder S; S.init(T, DM, G, (int)blockIdx.x);
      EpiX2 E{a.out};
      pg8::gemm_phase<EpiX2, pg8::StaticOrder, true, true>(ldsg, g, S, E); }
    xcd_barrier(xbar);
#else
#if PH_MASK & 2048
    { pg8::Gemm g{(const bf16*)(ws + WS_H), (const bf16*)(ws + WS_WUP), T, UPW, DM, DM}; pg8::StaticOrder S; S.init(T, UPW, G, (int)blockIdx.x);
      EpiUp E{(bf16*)(ws + WS_UP), (const float*)(ws + WS_SS2)};
      pg8::gemm_phase<EpiUp, pg8::StaticOrder, true, true>(ldsg, g, S, E); }
#endif
    xcd_barrier(xbar);
#if PH_MASK & 64
    act_phase(a, (int)blockIdx.x * 512 + tid, G * 512);
#endif
    xcd_barrier(xbar);
#if PH_MASK & 4096
    { pg8::Gemm g{(const bf16*)(ws + WS_UP) + DFF, (const bf16*)(ws + WS_WDOWN), T, DM, DFF, UPW}; pg8::StaticOrder S; S.init(T, DM, G, (int)blockIdx.x);
      EpiX2 E{a.out};
      pg8::gemm_phase<EpiX2, pg8::StaticOrder, true, true>(ldsg, g, S, E); }
#endif
    xcd_barrier(xbar);
#endif
#if PH_MASK & 128
    final_phase(a, gw, NGW, lane);
#endif
}

extern "C" void kernel_launch(void* const* d_in, const int* in_sizes, int n_in, void* d_out, int out_size, void* d_ws, size_t ws_size, hipStream_t stream) {
    static int grid = 0;
    if (grid == 0) {
        if (n_in != 31 || (size_t)out_size != O_END || ws_size < WS_END) { fprintf(stderr, "kernel_launch: unexpected shapes n_in %d out %d ws %zu\n", n_in, out_size, ws_size); grid = -1; return; }
        int dev = 0, cus = 0, per_cu = 0;
        hipGetDevice(&dev);
        hipDeviceGetAttribute(&cus, hipDeviceAttributeMultiprocessorCount, dev);
        hipFuncSetAttribute((const void*)fwd_kernel, hipFuncAttributeMaxDynamicSharedMemorySize, LDS_BYTES);
        hipOccupancyMaxActiveBlocksPerMultiprocessor(&per_cu, (const void*)fwd_kernel, 512, LDS_BYTES);
        if (per_cu < 1) { fprintf(stderr, "kernel_launch: occupancy query says %d blocks per CU\n", per_cu); per_cu = 1; }
        grid = cus * 1;
        if (grid != 256) { fprintf(stderr, "kernel_launch: built for a 256-CU device, got %d\n", cus); grid = -1; return; }
        (void)hipGetLastError();
    }
    if (grid < 0) return;
    if (hipMemsetAsync((char*)d_ws + WS_CTL, 0, 16384, stream) != hipSuccess) { fprintf(stderr, "kernel_launch: memset of the barrier words failed\n"); return; }
    Args a{};
    for (int i = 0; i < 31; ++i) a.in[i] = (const float*)d_in[i];
    a.out = (float*)d_out; a.ws = (unsigned char*)d_ws;
    void* args[] = {&a};
    hipError_t e = hipLaunchCooperativeKernel((const void*)fwd_kernel, dim3(grid), dim3(512), args, LDS_BYTES, stream);
    if (e != hipSuccess) fprintf(stderr, "cooperative launch failed: %s (grid %d)\n", hipGetErrorString(e), grid);
}
```

```cpp
#include <hip/hip_runtime.h>
#include <hip/hip_cooperative_groups.h>
#include <cstdio>
#include <cstdint>
namespace cg = cooperative_groups;
#define OLD_S5 5
#define DN_STAGED 3
namespace pg8 {
#define PG8_LAS __attribute__((address_space(3)))
typedef unsigned short bf16_t;
typedef short bf16x8 __attribute__((ext_vector_type(8)));
typedef float f32x4 __attribute__((ext_vector_type(4)));
typedef unsigned u32x4 __attribute__((ext_vector_type(4)));
constexpr int BM = 256, BK = 64, HALF = 128, HTB = HALF * BK * 2  , STAGE_BYTES = 8 * HTB, NXCD = 8, WGM = 8;

__host__ __device__ __forceinline__ int lds_byte(int r, int c) { const int st = (r >> 4) * 2 + (c >> 5), rr = r & 15, cc = c & 31, ob = rr * 64 + cc * 2; return st * 1024 + (ob ^ (((ob >> 9) & 1) << 5)); }
__host__ __device__ __forceinline__ void stage_rc(int b, int& R, int& C) { const int st = b / 1024, sb = b % 1024, swz = sb ^ (((sb >> 9) & 1) << 5); R = (st >> 1) * 16 + swz / 64; C = (st & 1) * 32 + (swz % 64) / 2; }
__host__ __device__ __forceinline__ int perm32(int rho) { const int n = rho >> 4, i = rho & 15; return 8 * (i >> 2) + 4 * n + (i & 3); }

struct Unit { int pm, pn; };
struct Gemm { const bf16_t* A; const bf16_t* Bt; int M, N, K, lda; };

struct StaticOrder {
    int nM, nN, nwg, G, c;
    __host__ __device__ void init(int M, int N, int G_, int c_) { nM = M / BM; nN = N / BM; nwg = nM * nN; G = G_; c = c_; }
    __host__ __device__ bool next(int i, Unit& u) const {
        const long L = (long)i * G + c; if (L >= nwg) return false;
        int wgid = (int)L; { const int q = nwg / NXCD, r = nwg % NXCD, xcd = wgid % NXCD, off = wgid / NXCD; wgid = (xcd < r ? xcd * (q + 1) : r * (q + 1) + (xcd - r) * q) + off; }
        const int nig = WGM * nN, gid = wgid / nig, fm = gid * WGM, gsz = (nM - fm) < WGM ? (nM - fm) : WGM;
        u.pm = fm + ((wgid % nig) % gsz); u.pn = (wgid % nig) / gsz; return true;
    }
    __device__ __forceinline__ void a_ready(const Unit&) const {}
    __device__ __forceinline__ void done(const Unit&) const {}
};
__device__ __forceinline__ unsigned cvt_pk_bf16(float lo, float hi) { unsigned r; asm volatile("v_cvt_pk_bf16_f32 %0, %1, %2" : "=v"(r) : "v"(lo), "v"(hi)); return r; }
typedef float f32x2 __attribute__((ext_vector_type(2)));
template <class Epi, class Sched, bool ALIGN_EPI = false, bool SP2 = false>
__device__ __forceinline__ void gemm_phase(PG8_LAS unsigned char* lds, const Gemm g, const Sched& S, const Epi& E) {
    int tid_ = threadIdx.x; asm volatile("" : "+v"(tid_));
    const int tid = tid_, wid = __builtin_amdgcn_readfirstlane(tid >> 6), lane = tid & 63, wr = wid >> 2, wc = wid & 3, fr = lane & 15, fq = lane >> 4;
    const int K = g.K, nt = K / BK;
    unsigned voffA[2], voffB[2];
#pragma unroll
    for (int i = 0; i < 2; ++i) { int R, C; stage_rc(tid * 16 + i * 8192, R, C); const int Rb = Epi::PERM ? ((R & ~31) + perm32(R & 31)) : R;
        voffA[i] = (unsigned)(R * g.lda + C) * 2u; voffB[i] = (unsigned)(Rb * K + C) * 2u; }
    const size_t kstep = (size_t)(BK * 2);
    const size_t hstep = (size_t)HALF * K * 2;
    const size_t tstep = 2 * hstep; const size_t hstepA = (size_t)HALF * g.lda * 2, tstepA = 2 * hstepA;
    const unsigned ldsw = (unsigned)wid * 1024u;
    const int aoff = lds_byte(wr * 64 + fr, fq * 8), boff = lds_byte(wc * 32 + fr, fq * 8);
#define PG8_SA(b, h) (((b) * 2 + (h)) * HTB)
#define PG8_SB(b, h) ((4 + (b) * 2 + (h)) * HTB)
#define PG8_STAGE(bufoff, gbase, voff) do { _Pragma("unroll") for (int _i = 0; _i < 2; ++_i) \
        __builtin_amdgcn_global_load_lds((const unsigned*)((const char*)(gbase) + (voff)[_i]), (PG8_LAS unsigned*)(lds + (bufoff) + ldsw + _i * 8192), 16, 0, 0); } while (0)
#define PG8_LDA(dst, b, h) do { _Pragma("unroll") for (int m = 0; m < 4; ++m) _Pragma("unroll") for (int k = 0; k < 2; ++k) dst[m][k] = *(const PG8_LAS bf16x8*)(lds + PG8_SA(b, h) + aoff + m * 2048 + k * 1024); } while (0)
#define PG8_LDB(dst, b, h) do { _Pragma("unroll") for (int n = 0; n < 2; ++n) _Pragma("unroll") for (int k = 0; k < 2; ++k) dst[n][k] = *(const PG8_LAS bf16x8*)(lds + PG8_SB(b, h) + boff + n * 2048 + k * 1024); } while (0)
#define PG8_MMA(ai, bj, At, Bt) do { __builtin_amdgcn_s_setprio(1); _Pragma("unroll") for (int m = 0; m < 4; ++m) _Pragma("unroll") for (int n = 0; n < 2; ++n) _Pragma("unroll") for (int k = 0; k < 2; ++k) \
        acc[ai][bj][m][n] = __builtin_amdgcn_mfma_f32_16x16x32_bf16(Bt[n][k], At[m][k], acc[ai][bj][m][n], 0, 0, 0); __builtin_amdgcn_s_setprio(0); } while (0)
#define PG8_WAIT_V(n) asm volatile("s_waitcnt vmcnt(" #n ")" ::: "memory")
#define PG8_WAIT_L(n) asm volatile("s_waitcnt lgkmcnt(" #n ")" ::: "memory")
#define PG8_BAR __builtin_amdgcn_s_barrier()
#define PG8_SCHED __builtin_amdgcn_sched_barrier(0)
    Unit cur, nxt; int ui = 0;
    if (!S.next(0, cur)) return;
    f32x4 acc[2][2][4][2];
#pragma unroll
    for (int a = 0; a < 2; ++a)
#pragma unroll
        for (int b = 0; b < 2; ++b)
#pragma unroll
            for (int m = 0; m < 4; ++m)
#pragma unroll
                for (int n = 0; n < 2; ++n) acc[a][b][m][n] = (f32x4){0.f, 0.f, 0.f, 0.f};
    bf16x8 At[4][2], B0[2][2], B1[2][2];
    const char* cA = (const char*)g.A + (size_t)cur.pm * tstepA; const char* cB = (const char*)g.Bt + (size_t)cur.pn * tstep;
    S.a_ready(cur);
    if constexpr (SP2) {
        PG8_STAGE(PG8_SB(0, 0), cB, voffB); PG8_STAGE(PG8_SB(0, 1), cB + hstep, voffB); PG8_STAGE(PG8_SA(0, 0), cA, voffA); PG8_STAGE(PG8_SA(0, 1), cA + hstepA, voffA);
        if (wr == 1) PG8_BAR;
        PG8_WAIT_V(2); PG8_BAR;
        PG8_STAGE(PG8_SB(1, 0), cB + kstep, voffB); PG8_STAGE(PG8_SA(1, 0), cA + kstep, voffA); PG8_STAGE(PG8_SB(1, 1), cB + hstep + kstep, voffB);
        PG8_WAIT_V(6); PG8_BAR;
    } else {
        PG8_STAGE(PG8_SB(0, 0), cB, voffB); PG8_STAGE(PG8_SA(0, 0), cA, voffA); PG8_STAGE(PG8_SB(0, 1), cB + hstep, voffB); PG8_STAGE(PG8_SA(0, 1), cA + hstepA, voffA);
        if (wr == 1) PG8_BAR;
        PG8_WAIT_V(4); PG8_BAR;
        PG8_STAGE(PG8_SB(1, 0), cB + kstep, voffB); PG8_STAGE(PG8_SA(1, 0), cA + kstep, voffA); PG8_STAGE(PG8_SB(1, 1), cB + hstep + kstep, voffB);
        PG8_WAIT_V(6); PG8_BAR;
    }
    for (;;) {
        const bool has_next = S.next(ui + 1, nxt);
        const char* nA = has_next ? (const char*)g.A + (size_t)nxt.pm * tstepA : cA; const char* nB = has_next ? (const char*)g.Bt + (size_t)nxt.pn * tstep : cB;
        for (int t = 0; t < nt; t += 2) {
            const bool last = (t == nt - 2);
            const char* a1 = cA + (size_t)(t + 1) * kstep;
            const char* a2 = last ? nA : cA + (size_t)(t + 2) * kstep; const char* b2 = last ? nB : cB + (size_t)(t + 2) * kstep;
            const char* a3 = a2 + kstep; const char* b3 = b2 + kstep;
            if (last && has_next) S.a_ready(nxt);
            if constexpr (SP2) {
            PG8_LDB(B0, 0, 0); PG8_LDB(B1, 0, 1); PG8_SCHED; PG8_LDA(At, 0, 0); PG8_STAGE(PG8_SA(1, 1), a1 + hstepA, voffA);
            PG8_WAIT_V(8); PG8_WAIT_L(0); PG8_BAR; PG8_MMA(0, 0, At, B0); PG8_MMA(0, 1, At, B1); PG8_BAR; PG8_SCHED;
            PG8_LDA(At, 0, 1); PG8_STAGE(PG8_SB(0, 0), b2, voffB); PG8_STAGE(PG8_SB(0, 1), b2 + hstep, voffB); PG8_STAGE(PG8_SA(0, 0), a2, voffA);
            PG8_WAIT_V(8); PG8_WAIT_L(0); PG8_BAR; PG8_MMA(1, 0, At, B0); PG8_MMA(1, 1, At, B1); PG8_BAR; PG8_SCHED;
            PG8_LDB(B0, 1, 0); PG8_LDB(B1, 1, 1); PG8_SCHED; PG8_LDA(At, 1, 0); PG8_STAGE(PG8_SA(0, 1), a2 + hstepA, voffA);
            PG8_WAIT_V(8); PG8_WAIT_L(0); PG8_BAR; PG8_MMA(0, 0, At, B0); PG8_MMA(0, 1, At, B1); PG8_BAR; PG8_SCHED;
            PG8_LDA(At, 1, 1); PG8_STAGE(PG8_SB(1, 0), b3, voffB); PG8_STAGE(PG8_SB(1, 1), b3 + hstep, voffB); PG8_STAGE(PG8_SA(1, 0), a3, voffA);
            PG8_WAIT_V(8); PG8_WAIT_L(0); PG8_BAR; PG8_MMA(1, 0, At, B0); PG8_MMA(1, 1, At, B1); PG8_BAR; PG8_SCHED;
            } else {
            PG8_LDB(B0, 0, 0); PG8_SCHED; PG8_LDA(At, 0, 0); PG8_STAGE(PG8_SA(1, 1), a1 + hstepA, voffA);
            PG8_WAIT_L(8); PG8_BAR; PG8_WAIT_L(0); PG8_MMA(0, 0, At, B0); PG8_BAR; PG8_SCHED;
            PG8_LDB(B1, 0, 1); PG8_STAGE(PG8_SB(0, 0), b2, voffB);
            PG8_BAR; PG8_WAIT_L(0); PG8_MMA(0, 1, At, B1); PG8_BAR;
            PG8_LDA(At, 0, 1); PG8_STAGE(PG8_SA(0, 0), a2, voffA);
            PG8_BAR; PG8_WAIT_L(0); PG8_MMA(1, 0, At, B0); PG8_BAR; PG8_SCHED;
            PG8_STAGE(PG8_SB(0, 1), b2 + hstep, voffB);
            PG8_WAIT_V(6); PG8_BAR; PG8_MMA(1, 1, At, B1); PG8_BAR;
            PG8_LDB(B0, 1, 0); PG8_SCHED; PG8_LDA(At, 1, 0); PG8_STAGE(PG8_SA(0, 1), a2 + hstepA, voffA);
            PG8_WAIT_L(8); PG8_BAR; PG8_WAIT_L(0); PG8_MMA(0, 0, At, B0); PG8_BAR; PG8_SCHED;
            PG8_LDB(B1, 1, 1); PG8_STAGE(PG8_SB(1, 0), b3, voffB);
            PG8_BAR; PG8_WAIT_L(0); PG8_MMA(0, 1, At, B1); PG8_BAR;
            PG8_LDA(At, 1, 1); PG8_STAGE(PG8_SA(1, 0), a3, voffA);
            PG8_BAR; PG8_WAIT_L(0); PG8_MMA(1, 0, At, B0); PG8_BAR; PG8_SCHED;
            PG8_STAGE(PG8_SB(1, 1), b3 + hstep, voffB);
            PG8_WAIT_V(6); PG8_BAR; PG8_MMA(1, 1, At, B1); PG8_BAR;
            }
        }
        if constexpr (ALIGN_EPI) { if (wr == 0) PG8_BAR; }
        if constexpr (!Epi::AFTER_DRAIN) { E(acc, cur, wr, wc, fr, fq); S.done(cur); }
        if (!has_next) break;
#pragma unroll
        for (int a = 0; a < 2; ++a)
#pragma unroll
            for (int b = 0; b < 2; ++b)
#pragma unroll
                for (int m = 0; m < 4; ++m)
#pragma unroll
                    for (int n = 0; n < 2; ++n) acc[a][b][m][n] = (f32x4){0.f, 0.f, 0.f, 0.f};
        cur = nxt; cA = nA; cB = nB; ++ui;
        if constexpr (ALIGN_EPI) { if (wr == 1) PG8_BAR; }
    }
    PG8_WAIT_V(0);
    if constexpr (!ALIGN_EPI) { if (wr == 0) PG8_BAR; }
    PG8_BAR;
    if constexpr (Epi::AFTER_DRAIN) { E.fused(acc, cur, wr, wc, fr, fq, lds, wid, lane); S.done(cur); }
#undef PG8_SA
#undef PG8_SB
#undef PG8_STAGE
#undef PG8_LDA
#undef PG8_LDB
#undef PG8_MMA
#undef PG8_WAIT_V
#undef PG8_WAIT_L
#undef PG8_BAR
#undef PG8_SCHED
}
}
#define LAS __attribute__((address_space(3)))
#define XB_TMO      128
#define XB_XCNT(j)  (256  + 64 * (j))
#define XB_XSUB(j)  (1280 + 64 * (j))
#define XB_XGEN(j)  (2304 + 64 * (j))
#define XB_TOP      3328
#define XB_TOPGEN   3392
#define XCD_BAR_WORDS 3456
#define XB_SPIN_CAP (1u << 18)

__device__ __forceinline__ unsigned xb_ld(unsigned* p)              { return __hip_atomic_load(p, __ATOMIC_RELAXED, __HIP_MEMORY_SCOPE_AGENT); }
__device__ __forceinline__ unsigned xb_add(unsigned* p, unsigned v) { return __hip_atomic_fetch_add(p, v, __ATOMIC_RELAXED, __HIP_MEMORY_SCOPE_AGENT); }
__device__ __forceinline__ unsigned xb_xcc_id() { return (unsigned)__builtin_amdgcn_s_getreg((3 << 11) | 20) & 0xFu; }
#define XB_SPIN(cond, bar) do { unsigned _sp = 0; while (cond) { __builtin_amdgcn_s_sleep(1); \
    if ((++_sp & 255u) == 0u) { if (xb_ld(&(bar)[XB_TMO])) break; if (_sp > XB_SPIN_CAP) { atomicAdd(&(bar)[XB_TMO], 1u); break; } } } } while (0)

struct XcdBarrier {
    unsigned* bar; unsigned x;
    volatile LAS unsigned* st;
};

__device__ __forceinline__ XcdBarrier xcd_barrier_post(unsigned* bar, volatile LAS unsigned* st) {
    XcdBarrier b; b.bar = bar; b.x = xb_xcc_id(); b.st = st;
    if (threadIdx.x == 0) (void)xb_add(&bar[XB_XCNT(b.x)], 1u);
    return b;
}
__device__ __forceinline__ void xcd_barrier_complete(unsigned* bar, unsigned x, unsigned& nloc, unsigned& nx) {
    const unsigned G = gridDim.x * gridDim.y * gridDim.z;
    unsigned sum, cnt, mine, sp = 0u;
    for (;;) {
        sum = 0u; cnt = 0u; mine = 0u;
#pragma unroll
        for (unsigned j = 0; j < 16; ++j) { const unsigned c = xb_ld(&bar[XB_XCNT(j)]); sum += c; cnt += (c > 0u) ? 1u : 0u; mine = (j == x) ? c : mine; }
        if (sum == G) break;
        __builtin_amdgcn_s_sleep(1);
        if ((++sp & 255u) == 0u) { if (xb_ld(&bar[XB_TMO])) break; if (sp > XB_SPIN_CAP) { atomicAdd(&bar[XB_TMO], 1u); break; } }
    }
    nloc = mine > 0u ? mine : 1u; nx = cnt > 0u ? cnt : 1u;
}

__device__ __forceinline__ void xcd_barrier(const XcdBarrier& b) {
    asm volatile("s_waitcnt vmcnt(0)" ::: "memory");
    __syncthreads();
    if (threadIdx.x == 0) {
        unsigned* bar = b.bar;
        __builtin_amdgcn_s_waitcnt(0);
        unsigned nloc = b.st[0], nx = b.st[1];
        if (nloc == 0u) { xcd_barrier_complete(bar, b.x, nloc, nx); b.st[0] = nloc; b.st[1] = nx; }
        const unsigned old = xb_add(&bar[XB_XSUB(b.x)], 1u);
        const unsigned gen = old / nloc;
        if (old + 1u == (gen + 1u) * nloc) {
            __builtin_amdgcn_fence(__ATOMIC_RELEASE, "agent");
            asm volatile("s_waitcnt vmcnt(0)" ::: "memory");
            const unsigned og = xb_add(&bar[XB_TOP], 1u);
            const unsigned tg = og / nx;
            if (og + 1u == (tg + 1u) * nx) xb_add(&bar[XB_TOPGEN], 1u);
            else XB_SPIN(xb_ld(&bar[XB_TOPGEN]) == tg, bar);
            __builtin_amdgcn_fence(__ATOMIC_ACQUIRE, "agent");
            xb_add(&bar[XB_XGEN(b.x)], 1u);
            asm volatile("s_waitcnt vmcnt(0)" ::: "memory");
        } else {
            XB_SPIN(xb_ld(&bar[XB_XGEN(b.x)]) == gen, bar);
            __builtin_amdgcn_fence(__ATOMIC_ACQUIRE, "agent");
            asm volatile("s_waitcnt vmcnt(0)" ::: "memory");
        }
    }
    __syncthreads();
}


#ifndef FUSE_ACT
#define FUSE_ACT 1
#endif
#ifndef DN_STAGED
#define DN_STAGED 1
#endif
#ifndef DIAG_Y
#define DIAG_Y 0
#endif
#ifndef OLD_S5
#define OLD_S5 0
#endif
#if OLD_S5 == 3
#define OLD_S5_ULIM 8192
#else
#define OLD_S5_ULIM (4 * 32 * 64 + 32 * 32)
#endif
#define DI __device__ __forceinline__
typedef unsigned short bf16;
typedef float f32x4 __attribute__((ext_vector_type(4)));
typedef float f32x2 __attribute__((ext_vector_type(2)));
typedef short bf16x8 __attribute__((ext_vector_type(8)));
typedef unsigned u32x4 __attribute__((ext_vector_type(4)));
typedef unsigned u32x2 __attribute__((ext_vector_type(2)));
typedef __bf16 bf16x2_t __attribute__((ext_vector_type(2)));

DI unsigned pk2(float lo, float hi) { f32x2 v = {lo, hi}; bf16x2_t b = __builtin_convertvector(v, bf16x2_t); return __builtin_bit_cast(unsigned, b); }
DI bf16 f2b(float x) { return (bf16)(pk2(x, 0.f) & 0xffffu); }
DI float b2f(unsigned b) { return __uint_as_float(b << 16); }
DI float blo(unsigned w) { return __uint_as_float(w << 16); }
DI float bhi(unsigned w) { return __uint_as_float(w & 0xffff0000u); }
DI float wave_sum(float v) {
#pragma unroll
    for (int o = 1; o < 64; o <<= 1) v += __shfl_xor(v, o);
    return v;
}
DI float sigm(float x) { return 1.f / (1.f + __expf(-x)); }
DI float silu(float x) { return x / (1.f + __expf(-x)); }
DI float gelu_tanh(float x) { const float z = 1.5957691216057308f * (x + 0.044715f * x * x * x); return x / (1.f + __expf(-z)); }
#define MFMA16(a, b, c) __builtin_amdgcn_mfma_f32_16x16x32_bf16((a), (b), (c), 0, 0, 0)

constexpr int TP = 32768, TS = 512, T = TP + TS;
constexpr int DM = 1024, PW = 2560, NIN = 2816, DFF = 2816, UPW = 5632;
constexpr float EPS = 1e-6f;
constexpr int NCH = 2048 + 128;
constexpr int REC = 73728;
constexpr int R_WN = 0, R_QG = 16384, R_KDT = 32768, R_QK = 49152, R_U0 = 57344;
constexpr size_t O_Y = 0, O_PDC = (size_t)T * DM, O_PDS = O_PDC + 4 * 3 * 1536, O_PSR = O_PDS + 4 * 4 * 128 * 128, O_PSI = O_PSR + 4 * 32 * 64,
                 O_PFC = O_PSI + 4 * 32 * 64, O_SDC = O_PFC + 4 * 2 * 2816, O_SDS = O_SDC + 32 * 3 * 1536, O_SSR = O_SDS + (size_t)32 * 4 * 128 * 128,
                 O_SSI = O_SSR + 32 * 32 * 64, O_SFC = O_SSI + 32 * 32 * 64, O_END = O_SFC + 32 * 2 * 2816;
constexpr size_t MiB = 1u << 20;
constexpr size_t WS_SS2 = 0;
constexpr size_t WS_EG = 3 * MiB;
constexpr size_t WS_CTL = 5 * MiB + 512 * 1024;
constexpr size_t WS_BA = 4 * MiB;
constexpr size_t WS_WIN = 6 * MiB, WS_WGLU = 12 * MiB, WS_WOUT = 13 * MiB, WS_WUP = 15 * MiB, WS_WDOWN = 26 * MiB;
constexpr size_t WS_H = 32 * MiB;
constexpr size_t WS_P = 98 * MiB;
constexpr size_t WS_DNC = 262 * MiB;
constexpr size_t WS_Y5 = 416 * MiB, WS_GLU = 449 * MiB, WS_S5E = 482 * MiB, WS_END = 487 * MiB;
constexpr size_t WS_GH = 300 * MiB, WS_GT = 324 * MiB, WS_VH = 348 * MiB;
constexpr size_t WS_UP = 98 * MiB;
static_assert(WS_UP + (size_t)T * UPW * 2 <= WS_END && WS_P + (size_t)T * PW * 2 <= WS_DNC && WS_DNC + (size_t)NCH * REC <= WS_Y5, "ws map");
constexpr int LDS_BYTES = 147456;

struct Args { const float* in[31]; float* out; unsigned char* ws; };

DI int colmap(int mode, int n) {
    if (mode == 0) return n;
    if (mode == 1) return n < 2048 ? n : (n < 2560 ? n + 8 : (n < 2568 ? n - 512 : -1));
    const int pn = n >> 8, bj = (n >> 7) & 1, j = n & 127;
    return bj * (mode == 2 ? 512 : 2816) + 128 * pn + j;
}
DI void transpose_item(const float* W, int K, int N, bf16* WT, float* scr, int kb, int nb, int lane, int mode, const float* rs) {
    const int k0 = 64 * kb, n0 = 32 * nb;
    const int sc = colmap(mode, n0 + (lane & 31));
    float tv[32];
#pragma unroll
    for (int i = 0; i < 32; ++i) { const int kk = 2 * i + (lane >> 5); tv[i] = 0.f; if (sc >= 0) tv[i] = W[(size_t)(k0 + kk) * N + sc]; }
#pragma unroll
    for (int i = 0; i < 32; ++i) { const int kk = 2 * i + (lane >> 5); float v = tv[i]; if (rs) v *= rs[k0 + kk]; scr[kk * 33 + (lane & 31)] = v; }
    asm volatile("s_waitcnt lgkmcnt(0)" ::: "memory");
    const int c = lane & 7;
#pragma unroll
    for (int j = 0; j < 4; ++j) { const int n = (lane >> 3) + 8 * j; const float* s = scr + (8 * c) * 33 + n;
        u32x4 o; o.x = pk2(s[0 * 33], s[1 * 33]); o.y = pk2(s[2 * 33], s[3 * 33]); o.z = pk2(s[4 * 33], s[5 * 33]); o.w = pk2(s[6 * 33], s[7 * 33]);
        *(u32x4*)(WT + (size_t)(n0 + n) * K + k0 + 8 * c) = o; }
    asm volatile("s_waitcnt lgkmcnt(0)" ::: "memory");
}
DI void phase0(const Args& a, unsigned char* lds, int gw, int NGW, int wave, int lane) {
    asm volatile("" : "+v"(lane));
    unsigned char* ws = a.ws;
    float* scr = (float*)(lds + wave * 16384);
    constexpr int I_IN = 16 * (NIN / 32), I_GLU = 8 * 32, I_OUT = 16 * 32, I_UP = 16 * (UPW / 32), I_DN = 44 * 32;
    constexpr int NIT = I_IN + I_GLU + I_OUT + I_UP + I_DN;
    for (int it = gw; it < NIT; it += NGW) {
        int r = it;
        if (r < I_IN) { transpose_item(a.in[8], 1024, 2568, (bf16*)(ws + WS_WIN), scr, r / (NIN / 32), r % (NIN / 32), lane, 1, nullptr); continue; } r -= I_IN;
        if (r < I_GLU) { transpose_item(a.in[21], 512, 1024, (bf16*)(ws + WS_WGLU), scr, r / 32, r % 32, lane, 2, nullptr); continue; } r -= I_GLU;
        if (r < I_OUT) { transpose_item(a.in[24], 1024, 1024, (bf16*)(ws + WS_WOUT), scr, r / 32, r % 32, lane, 0, nullptr); continue; } r -= I_OUT;
        if (r < I_UP) { transpose_item(a.in[26], 1024, 5632, (bf16*)(ws + WS_WUP), scr, r / (UPW / 32), r % (UPW / 32), lane, 3, a.in[25]); continue; } r -= I_UP;
        transpose_item(a.in[29], 2816, 1024, (bf16*)(ws + WS_WDOWN), scr, r / 32, r % 32, lane, 0, nullptr);
    }
    const float* g1 = a.in[7];
    f32x4 gv[4];
#pragma unroll
    for (int j = 0; j < 4; ++j) gv[j] = ((const f32x4*)g1)[lane + 64 * j];
    bf16* H = (bf16*)(ws + WS_H);
    for (int m0 = gw; m0 < T; m0 += 2 * NGW) {
        const int m1 = m0 + NGW < T ? m0 + NGW : m0;
        const f32x4* xr0 = (const f32x4*)(m0 < TP ? a.in[0] + (size_t)m0 * DM : a.in[1] + (size_t)(m0 - TP) * DM) + lane;
        const f32x4* xr1 = (const f32x4*)(m1 < TP ? a.in[0] + (size_t)m1 * DM : a.in[1] + (size_t)(m1 - TP) * DM) + lane;
        f32x4 v0[4], v1[4]; float s0 = 0.f, s1 = 0.f;
#pragma unroll
        for (int j = 0; j < 4; ++j) { v0[j] = xr0[64 * j]; v1[j] = xr1[64 * j]; }
#pragma unroll
        for (int j = 0; j < 4; ++j) { s0 += (v0[j].x * v0[j].x + v0[j].y * v0[j].y) + (v0[j].z * v0[j].z + v0[j].w * v0[j].w); s1 += (v1[j].x * v1[j].x + v1[j].y * v1[j].y) + (v1[j].z * v1[j].z + v1[j].w * v1[j].w); }
        const float r0 = rsqrtf(wave_sum(s0) * (1.f / DM) + EPS), r1 = rsqrtf(wave_sum(s1) * (1.f / DM) + EPS);
        u32x2* o0 = (u32x2*)(H + (size_t)m0 * DM) + lane; u32x2* o1 = (u32x2*)(H + (size_t)m1 * DM) + lane;
#pragma unroll
        for (int j = 0; j < 4; ++j) { u32x2 o; o.x = pk2(v0[j].x * r0 * gv[j].x, v0[j].y * r0 * gv[j].y); o.y = pk2(v0[j].z * r0 * gv[j].z, v0[j].w * r0 * gv[j].w); o0[64 * j] = o; }
        if (m1 != m0) {
#pragma unroll
            for (int j = 0; j < 4; ++j) { u32x2 o; o.x = pk2(v1[j].x * r1 * gv[j].x, v1[j].y * r1 * gv[j].y); o.y = pk2(v1[j].z * r1 * gv[j].z, v1[j].w * r1 * gv[j].w); o1[64 * j] = o; }
        }
    }
}

struct EpiP {
    static constexpr bool PERM = true, AFTER_DRAIN = false;
    bf16* P; float* BA;
    DI void operator()(const pg8::f32x4 (&acc)[2][2][4][2], const pg8::Unit& u, int wr, int wc, int fr, int fq) const {
        const int row0 = u.pm * 256 + wr * 64 + fr;
        if (u.pn < 10) {
            const int col0 = u.pn * 256 + wc * 32 + 8 * fq;
#pragma unroll
            for (int ai = 0; ai < 2; ++ai)
#pragma unroll
                for (int m = 0; m < 4; ++m) { bf16* rowp = P + (size_t)(row0 + ai * 128 + m * 16) * PW + col0;
#pragma unroll
                    for (int bj = 0; bj < 2; ++bj) { const pg8::f32x4 v0 = acc[ai][bj][m][0], v1 = acc[ai][bj][m][1];
                        u32x4 w; w.x = pk2(v0[0], v0[1]); w.y = pk2(v0[2], v0[3]); w.z = pk2(v1[0], v1[1]); w.w = pk2(v1[2], v1[3]);
                        *(u32x4*)(rowp + bj * 128) = w; } }
        } else if (wc == 0 && fq == 0) {
#pragma unroll
            for (int ai = 0; ai < 2; ++ai)
#pragma unroll
                for (int m = 0; m < 4; ++m) { float* bp = BA + (size_t)(row0 + ai * 128 + m * 16) * 8;
                    *(pg8::f32x4*)bp = acc[ai][0][m][0]; *(pg8::f32x4*)(bp + 4) = acc[ai][0][m][1]; }
        }
    }
};
struct EpiGlu {
    static constexpr bool PERM = true, AFTER_DRAIN = false;
    bf16* O; const float* gb;
    DI void operator()(const pg8::f32x4 (&acc)[2][2][4][2], const pg8::Unit& u, int wr, int wc, int fr, int fq) const {
        const int row0 = u.pm * 256 + wr * 64 + fr, col0 = u.pn * 128 + wc * 32 + 8 * fq;
        const pg8::f32x4 ba0 = *(const pg8::f32x4*)(gb + col0), ba1 = *(const pg8::f32x4*)(gb + col0 + 4), bg0 = *(const pg8::f32x4*)(gb + 512 + col0), bg1 = *(const pg8::f32x4*)(gb + 512 + col0 + 4);
#pragma unroll
        for (int ai = 0; ai < 2; ++ai)
#pragma unroll
            for (int m = 0; m < 4; ++m) {
                const pg8::f32x4 a0 = acc[ai][0][m][0] + ba0, a1 = acc[ai][0][m][1] + ba1, g0 = acc[ai][1][m][0] + bg0, g1 = acc[ai][1][m][1] + bg1;
                float o[8];
#pragma unroll
                for (int e = 0; e < 4; ++e) { o[e] = a0[e] * sigm(g0[e]); o[4 + e] = a1[e] * sigm(g1[e]); }
                u32x4 w; w.x = pk2(o[0], o[1]); w.y = pk2(o[2], o[3]); w.z = pk2(o[4], o[5]); w.w = pk2(o[6], o[7]);
                *(u32x4*)(O + (size_t)(row0 + ai * 128 + m * 16) * 512 + col0) = w;
            }
    }
};
struct EpiX1 {
    static constexpr bool PERM = false, AFTER_DRAIN = false;
    const float* xp; const float* xs; float* out; bf16* xb; float* ss2;
    DI void operator()(const pg8::f32x4 (&acc)[2][2][4][2], const pg8::Unit& u, int wr, int wc, int fr, int fq) const {
        const int row0 = u.pm * 256 + wr * 64 + fr, col0 = u.pn * 256 + wc * 32 + 4 * fq;
#pragma unroll
        for (int ai = 0; ai < 2; ++ai)
#pragma unroll
            for (int m = 0; m < 4; ++m) {
                const int row = row0 + ai * 128 + m * 16;
                const float* xr = (row < TP ? xp + (size_t)row * DM : xs + (size_t)(row - TP) * DM) + col0;
                float ss = 0.f;
#pragma unroll
                for (int bj = 0; bj < 2; ++bj)
#pragma unroll
                    for (int n = 0; n < 2; ++n) {
                        const pg8::f32x4 v = *(const pg8::f32x4*)(xr + bj * 128 + n * 16) + acc[ai][bj][m][n];
                        *(pg8::f32x4*)(out + (size_t)row * DM + col0 + bj * 128 + n * 16) = v;
                        u32x2 w; w.x = pk2(v[0], v[1]); w.y = pk2(v[2], v[3]);
                        *(u32x2*)(xb + (size_t)row * DM + col0 + bj * 128 + n * 16) = w;
                        ss += (v[0] * v[0] + v[1] * v[1]) + (v[2] * v[2] + v[3] * v[3]);
                    }
                ss += __shfl_xor(ss, 16); ss += __shfl_xor(ss, 32);
                if (fq == 0) ss2[(size_t)row * 16 + u.pn * 4 + wc] = ss;
            }
    }
};
struct EpiUp {
    static constexpr bool PERM = true, AFTER_DRAIN = false;
    bf16* UP; const float* ss2;
    DI void operator()(const pg8::f32x4 (&acc)[2][2][4][2], const pg8::Unit& u, int wr, int wc, int fr, int fq) const {
        const int row0 = u.pm * 256 + wr * 64 + fr, col0 = u.pn * 128 + wc * 32 + 8 * fq;
#pragma unroll
        for (int ai = 0; ai < 2; ++ai)
#pragma unroll
            for (int m = 0; m < 4; ++m) {
                const int row = row0 + ai * 128 + m * 16;
                const pg8::f32x4* sp = (const pg8::f32x4*)(ss2 + (size_t)row * 16);
                const pg8::f32x4 s0 = sp[0], s1 = sp[1], s2 = sp[2], s3 = sp[3];
                const float tot = ((s0[0] + s0[1]) + (s0[2] + s0[3])) + ((s1[0] + s1[1]) + (s1[2] + s1[3])) + ((s2[0] + s2[1]) + (s2[2] + s2[3])) + ((s3[0] + s3[1]) + (s3[2] + s3[3]));
                const float r = rsqrtf(tot * (1.f / DM) + EPS);
                bf16* rowp = UP + (size_t)row * UPW + col0;
#pragma unroll
                for (int bj = 0; bj < 2; ++bj) { const pg8::f32x4 v0 = acc[ai][bj][m][0] * r, v1 = acc[ai][bj][m][1] * r;
                    u32x4 w; w.x = pk2(v0[0], v0[1]); w.y = pk2(v0[2], v0[3]); w.z = pk2(v1[0], v1[1]); w.w = pk2(v1[2], v1[3]);
                    *(u32x4*)(rowp + bj * DFF) = w; }
            }
    }
};
DI float dpp_shr1(float v) { return __int_as_float(__builtin_amdgcn_update_dpp(0, __float_as_int(v), 0x111, 0xf, 0xf, false)); }
DI float dpp_shr2(float v) { return __int_as_float(__builtin_amdgcn_update_dpp(0, __float_as_int(v), 0x112, 0xf, 0xf, false)); }
struct EpiUpAct {
    static constexpr bool PERM = true, AFTER_DRAIN = false;
    bf16* ACT; bf16* GH; bf16* GT; bf16* VH; const float* ss2; const float* fw; const float* fb;
    DI void operator()(const pg8::f32x4 (&acc)[2][2][4][2], const pg8::Unit& u, int wr, int wc, int fr, int fq) const {
        const int row0 = u.pm * 256 + wr * 64 + fr, col0 = u.pn * 128 + wc * 32 + 8 * fq;
        float w0[8], w1[8], w2[8], bb[8];
#pragma unroll
        for (int n = 0; n < 2; ++n) { const pg8::f32x4 a0 = *(const pg8::f32x4*)(fw + col0 + 4 * n), a1 = *(const pg8::f32x4*)(fw + DFF + col0 + 4 * n), a2 = *(const pg8::f32x4*)(fw + 2 * DFF + col0 + 4 * n), a3 = *(const pg8::f32x4*)(fb + col0 + 4 * n);
#pragma unroll
            for (int e = 0; e < 4; ++e) { w0[4 * n + e] = a0[e]; w1[4 * n + e] = a1[e]; w2[4 * n + e] = a2[e]; bb[4 * n + e] = a3[e]; } }
#pragma unroll
        for (int ai = 0; ai < 2; ++ai)
#pragma unroll
            for (int m = 0; m < 4; ++m) {
                const int row = row0 + ai * 128 + m * 16, grp = row >> 4;
                const pg8::f32x4* sp = (const pg8::f32x4*)(ss2 + (size_t)row * 16);
                const pg8::f32x4 s0 = sp[0], s1 = sp[1], s2 = sp[2], s3 = sp[3];
                const float tot = ((s0[0] + s0[1]) + (s0[2] + s0[3])) + ((s1[0] + s1[1]) + (s1[2] + s1[3])) + ((s2[0] + s2[1]) + (s2[2] + s2[3])) + ((s3[0] + s3[1]) + (s3[2] + s3[3]));
                const float r = rsqrtf(tot * (1.f / DM) + EPS);
                float gs[8], vv[8], o[8];
#pragma unroll
                for (int n = 0; n < 2; ++n)
#pragma unroll
                    for (int e = 0; e < 4; ++e) { gs[4 * n + e] = acc[ai][0][m][n][e] * r; vv[4 * n + e] = acc[ai][1][m][n][e] * r; }
#pragma unroll
                for (int e = 0; e < 8; ++e) { const float g1 = dpp_shr1(gs[e]), g2 = dpp_shr2(gs[e]); o[e] = silu(g2 * w0[e] + g1 * w1[e] + gs[e] * w2[e] + bb[e]) * vv[e]; }
                u32x4 wg; wg.x = pk2(gs[0], gs[1]); wg.y = pk2(gs[2], gs[3]); wg.z = pk2(gs[4], gs[5]); wg.w = pk2(gs[6], gs[7]);
                if (fr >= 2) { u32x4 w; w.x = pk2(o[0], o[1]); w.y = pk2(o[2], o[3]); w.z = pk2(o[4], o[5]); w.w = pk2(o[6], o[7]);
                    *(u32x4*)(ACT + (size_t)row * DFF + col0) = w; }
                else { u32x4 wv; wv.x = pk2(vv[0], vv[1]); wv.y = pk2(vv[2], vv[3]); wv.z = pk2(vv[4], vv[5]); wv.w = pk2(vv[6], vv[7]);
                    *(u32x4*)(GH + ((size_t)grp * 2 + fr) * DFF + col0) = wg; *(u32x4*)(VH + ((size_t)grp * 2 + fr) * DFF + col0) = wv; }
                if (fr >= 14) *(u32x4*)(GT + ((size_t)grp * 2 + (fr - 14)) * DFF + col0) = wg;
            }
    }
};
struct EpiX2 {
    static constexpr bool PERM = false, AFTER_DRAIN = false;
    float* out;
    DI void operator()(const pg8::f32x4 (&acc)[2][2][4][2], const pg8::Unit& u, int wr, int wc, int fr, int fq) const {
        const int row0 = u.pm * 256 + wr * 64 + fr, col0 = u.pn * 256 + wc * 32 + 4 * fq;
#pragma unroll
        for (int ai = 0; ai < 2; ++ai)
#pragma unroll
            for (int m = 0; m < 4; ++m) {
                float* orow = out + (size_t)(row0 + ai * 128 + m * 16) * DM + col0;
#pragma unroll
                for (int bj = 0; bj < 2; ++bj)
#pragma unroll
                    for (int n = 0; n < 2; ++n) { pg8::f32x4* p = (pg8::f32x4*)(orow + bj * 128 + n * 16); *p = *p + acc[ai][bj][m][n]; }
            }
    }
};

DI int kperm(int k) { return (k & ~31) | (((k >> 2) & 3) << 3) | (((k >> 4) & 1) << 2) | (k & 3); }
DI void conv_col(const bf16* pcol, float h0, float h1, float h2, const float* cw, int nrows, float* outp, float (&val)[64]) {
    const float w0 = cw[0], w1 = cw[1536], w2 = cw[2 * 1536], w3 = cw[3 * 1536];
    float x3 = h0, x2 = h1, x1 = h2;
#pragma unroll
    for (int r = 0; r < 64; ++r) {
        float x0 = 0.f;
        if (r < nrows) x0 = b2f(pcol[(size_t)r * PW]);
        const float c = x3 * w0 + x2 * w1 + x1 * w2 + x0 * w3;
        val[r] = r < nrows ? silu(c) : 0.f;
        if (outp && r >= nrows - 3 && r < nrows) outp[(r - (nrows - 3)) * 1536] = x0;
        x3 = x2; x2 = x1; x1 = x0;
    }
}
DI void dn_chunk_phase(const Args& a, unsigned char* lds, int tid, int it0, int it1, int its) {
    unsigned char* ws = a.ws;
    const bf16* P = (const bf16*)(ws + WS_P);
    const float* BA = (const float*)(ws + WS_BA);
    const float* cwt = a.in[9];
    constexpr float QSCALE = 0.08838834764831845f;
    for (int it = it0; it < it1; it += its) {
        int tl = tid; asm volatile("" : "+v"(tl));
        const int half = __builtin_amdgcn_readfirstlane(tl >> 8), t8 = tl & 255, hw = __builtin_amdgcn_readfirstlane((tl >> 6) & 3), lane = tl & 63, fr = lane & 15, fq = lane >> 4;
        unsigned char* L = lds + half * 53248;
        unsigned char* qb = L; unsigned char* kb = L + 17408;
        float* Am = (float*)(L + 34816);
        float* Gs = (float*)(L + 51200); float* Bs = Gs + 64; float* RQ = Gs + 128; float* RK = Gs + 192; float* EG = Gs + 256;
        const int unit = it * 2 + half;
        int row0, nrows, h, bidx; bool sample, first, lastc;
        if (unit < 2048) { const int b = unit >> 9, n = unit & 127; h = (unit >> 7) & 3; row0 = b * 8192 + n * 64; nrows = 64; sample = false; first = (n == 0); lastc = (n == 127); bidx = b; }
        else { const int su = unit - 2048; bidx = su >> 2; h = su & 3; row0 = TP + bidx * 16; nrows = 16; sample = true; first = false; lastc = true; }
        unsigned char* rec = ws + WS_DNC + (size_t)unit * REC;
        if (hw == 0) {
            float g = 0.f, be = 0.f;
            if (lane < nrows) {
                const float* bp = BA + (size_t)(row0 + lane) * 8;
                be = sigm(bp[h]);
                const float xx = bp[4 + h] + a.in[11][h];
                const float sp = xx > 20.f ? xx : log1pf(__expf(xx));
                g = -__expf(a.in[10][h]) * sp;
            }
#pragma unroll
            for (int o = 1; o < 64; o <<= 1) { const float v = __shfl_up(g, o); if (lane >= o) g += v; }
            Gs[lane] = g; Bs[lane] = be; EG[lane] = __expf(g);
            if (lane == 63) ((float*)(ws + WS_EG))[unit] = __expf(g);
        }
        float va[64];
        {
            const int c = t8 & 127;
            const int col = (t8 < 128 ? 0 : 512) + h * 128 + c;
            float h0 = 0.f, h1 = 0.f, h2 = 0.f;
            if (sample) { const float* cc = a.in[2] + (size_t)bidx * 3 * 1536 + col; h0 = cc[0]; h1 = cc[1536]; h2 = cc[2 * 1536]; }
            else if (!first) { const bf16* pp = P + (size_t)(row0 - 3) * PW + col; h0 = b2f(pp[0]); h1 = b2f(pp[PW]); h2 = b2f(pp[2 * PW]); }
            float* outp = lastc ? a.out + (sample ? O_SDC : O_PDC) + (size_t)bidx * 3 * 1536 + col : nullptr;
            conv_col(P + (size_t)row0 * PW + col, h0, h1, h2, cwt + col, nrows, outp, va);
            unsigned char* dst = (t8 < 128 ? qb : kb) + c * 2;
#pragma unroll
            for (int r = 0; r < 64; ++r) *(bf16*)(dst + r * 272) = f2b(va[r]);
        }
        __syncthreads();
        f32x4 kk[4], qk[4], qq;
        {
            bf16x8 ak[4], aq[4];
#pragma unroll
            for (int ks = 0; ks < 4; ++ks) { ak[ks] = *(const bf16x8*)(kb + (16 * hw + fr) * 272 + ks * 64 + fq * 16); aq[ks] = *(const bf16x8*)(qb + (16 * hw + fr) * 272 + ks * 64 + fq * 16); }
            qq = (f32x4){0.f, 0.f, 0.f, 0.f};
#pragma unroll
            for (int ks = 0; ks < 4; ++ks) qq = MFMA16(aq[ks], aq[ks], qq);
#pragma unroll
            for (int nt = 0; nt < 4; ++nt) {
                kk[nt] = (f32x4){0.f, 0.f, 0.f, 0.f}; qk[nt] = (f32x4){0.f, 0.f, 0.f, 0.f};
#pragma unroll
                for (int ks = 0; ks < 4; ++ks) { const bf16x8 bk = *(const bf16x8*)(kb + (16 * nt + fr) * 272 + ks * 64 + fq * 16);
                    kk[nt] = MFMA16(ak[ks], bk, kk[nt]); qk[nt] = MFMA16(aq[ks], bk, qk[nt]); }
            }
#pragma unroll
            for (int i = 0; i < 4; ++i) if (fr == 4 * fq + i) {
                float dk = 0.f;
#pragma unroll
                for (int nt = 0; nt < 4; ++nt) if (nt == hw) dk = kk[nt][i];
                RK[16 * hw + fr] = rsqrtf(dk + EPS); RQ[16 * hw + fr] = rsqrtf(qq[i] + EPS);
            }
        }
        __syncthreads();
        {
            bf16* QKr = (bf16*)(rec + R_QK);
#pragma unroll
            for (int i = 0; i < 4; ++i) {
                const int row = 16 * hw + 4 * fq + i;
                const float gr = Gs[row], br = Bs[row], rk = RK[row], rq = RQ[row];
#pragma unroll
                for (int nt = 0; nt < 4; ++nt) {
                    const int col = 16 * nt + fr;
                    const float d = col <= row ? gr - Gs[col] : 0.f;
                    const float e = __expf(d), rkc = RK[col];
                    Am[row * 64 + col] = col < row ? br * kk[nt][i] * rk * rkc * e : 0.f;
                    QKr[row * 64 + kperm(col)] = f2b(col <= row ? qk[nt][i] * rq * rkc * QSCALE * e : 0.f);
                }
            }
        }
        __syncthreads();
        if (t8 < 128) {
            bf16* Qg = (bf16*)(rec + R_QG) + kperm(t8);
#pragma unroll
            for (int r = 0; r < 64; ++r) Qg[r * 128] = f2b(va[r] * RQ[r] * QSCALE * EG[r]);
            {
                const int col = 1024 + h * 128 + t8;
                float h0 = 0.f, h1 = 0.f, h2 = 0.f;
                if (sample) { const float* cc = a.in[2] + (size_t)bidx * 3 * 1536 + col; h0 = cc[0]; h1 = cc[1536]; h2 = cc[2 * 1536]; }
                else if (!first) { const bf16* pp = P + (size_t)(row0 - 3) * PW + col; h0 = b2f(pp[0]); h1 = b2f(pp[PW]); h2 = b2f(pp[2 * PW]); }
                float* outp = lastc ? a.out + (sample ? O_SDC : O_PDC) + (size_t)bidx * 3 * 1536 + col : nullptr;
                conv_col(P + (size_t)row0 * PW + col, h0, h1, h2, cwt + col, nrows, outp, va);
            }
#pragma unroll
            for (int r = 0; r < 64; ++r) va[r] = va[r] * Bs[r];
        } else {
            const int c = t8 - 128;
            const float gl = Gs[63];
            unsigned w[32];
#pragma unroll
            for (int r = 0; r < 64; r += 2) w[kperm(r) >> 1] = pk2(va[r] * RK[r] * __expf(gl - Gs[r]), va[r + 1] * RK[r + 1] * __expf(gl - Gs[r + 1]));
            u32x4* dst = (u32x4*)(rec + R_KDT + c * 128);
#pragma unroll
            for (int j = 0; j < 8; ++j) dst[j] = (u32x4){w[4 * j], w[4 * j + 1], w[4 * j + 2], w[4 * j + 3]};
#pragma unroll
            for (int r = 0; r < 64; ++r) va[r] = va[r] * RK[r] * Bs[r] * EG[r];
        }
#if SOLVE_RL
        {
            float arow[64];
#pragma unroll
            for (int i = 1; i < 64; ++i) arow[i] = Am[i * 64 + lane];
#pragma unroll
            for (int i = 1; i < 64; ++i) {
                if (i < nrows) {
                    float acc0 = va[i], acc1 = 0.f;
#pragma unroll
                    for (int j = 0; j < i; ++j) { const float aij = __int_as_float(__builtin_amdgcn_readlane(__float_as_int(arow[i]), j)); if (j & 1) acc1 -= aij * va[j]; else acc0 -= aij * va[j]; }
                    va[i] = acc0 + acc1;
                }
            }
        }
#else
#pragma unroll
        for (int i = 1; i < 64; ++i) {
            float acc = va[i];
            const f32x4* Ar = (const f32x4*)(Am + i * 64);
#pragma unroll
            for (int j4 = 0; j4 < (i + 3) / 4; ++j4) {
                const f32x4 av = Ar[j4];
#pragma unroll
                for (int e = 0; e < 4; ++e) if (4 * j4 + e < i) acc -= av[e] * va[4 * j4 + e];
            }
            va[i] = acc;
        }
#endif
        if (t8 < 128) { bf16* U0 = (bf16*)(rec + R_U0) + t8;
#pragma unroll
            for (int r = 0; r < 64; ++r) U0[r * 128] = f2b(va[r]);
        } else { bf16* Wn = (bf16*)(rec + R_WN) + kperm(t8 - 128);
#pragma unroll
            for (int r = 0; r < 64; ++r) Wn[r * 128] = f2b(-va[r]);
        }
        __syncthreads();
    }
}

struct S5W { float lr[4], li[4]; bf16x8 bf[8]; };
DI void s5w_setup(const Args& a, int g, int fr, int fq, S5W& w) {
    const float dt = __expf(a.in[15][g]);
#pragma unroll
    for (int j = 0; j < 4; ++j) {
        const int p = 16 * j + fr;
        const float are = a.in[13][g * 64 + p], aim = a.in[14][g * 64 + p];
        const float mag = __expf(are * dt), ang = aim * dt;
        float sn, cs; sincosf(ang, &sn, &cs);
        const float lr = mag * cs, li = mag * sn;
        w.lr[j] = lr; w.li[j] = li;
        const float den = are * are + aim * aim;
        const float fre = ((lr - 1.f) * are + li * aim) / den, fim = (li * are - (lr - 1.f) * aim) / den;
        u32x4 wr = (u32x4){0u, 0u, 0u, 0u}, wi = (u32x4){0u, 0u, 0u, 0u};
        if (fq < 2) {
            const f32x4* br = (const f32x4*)(a.in[16] + (size_t)(g * 64 + p) * 16 + 8 * fq); const f32x4* bi = (const f32x4*)(a.in[17] + (size_t)(g * 64 + p) * 16 + 8 * fq);
            const f32x4 r0 = br[0], r1 = br[1], i0 = bi[0], i1 = bi[1];
            wr.x = pk2(fre * r0[0] - fim * i0[0], fre * r0[1] - fim * i0[1]); wr.y = pk2(fre * r0[2] - fim * i0[2], fre * r0[3] - fim * i0[3]);
            wr.z = pk2(fre * r1[0] - fim * i1[0], fre * r1[1] - fim * i1[1]); wr.w = pk2(fre * r1[2] - fim * i1[2], fre * r1[3] - fim * i1[3]);
            wi.x = pk2(fre * i0[0] + fim * r0[0], fre * i0[1] + fim * r0[1]); wi.y = pk2(fre * i0[2] + fim * r0[2], fre * i0[3] + fim * r0[3]);
            wi.z = pk2(fre * i1[0] + fim * r1[0], fre * i1[1] + fim * r1[1]); wi.w = pk2(fre * i1[2] + fim * r1[2], fre * i1[3] + fim * r1[3]);
        }
        w.bf[j] = __builtin_bit_cast(bf16x8, wr); w.bf[4 + j] = __builtin_bit_cast(bf16x8, wi);
    }
}
DI bf16x8 s5w_uload(const bf16* P, size_t row0, int SS, int ms, int g, int fr, int fq) {
    u32x4 v = (u32x4){0u, 0u, 0u, 0u};
    if (fq < 2) v = *(const u32x4*)(P + (row0 + (size_t)(fr >> 2) * SS + 4 * ms + (fr & 3)) * PW + 2048 + g * 16 + 8 * fq);
    return __builtin_bit_cast(bf16x8, v);
}
DI void s5w_step(const S5W& w, bf16x8 ua, float (&xr)[4], float (&xi)[4], unsigned (&xo)[4][4]) {
    f32x4 br[4], bi[4];
    const f32x4 z = (f32x4){0.f, 0.f, 0.f, 0.f};
#pragma unroll
    for (int j = 0; j < 4; ++j) { br[j] = MFMA16(ua, w.bf[j], z); bi[j] = MFMA16(ua, w.bf[4 + j], z); }
#pragma unroll
    for (int i = 0; i < 4; ++i)
#pragma unroll
        for (int j = 0; j < 4; ++j) {
            const float nr = w.lr[j] * xr[j] - w.li[j] * xi[j] + br[j][i], ni = w.lr[j] * xi[j] + w.li[j] * xr[j] + bi[j][i];
            xr[j] = nr; xi[j] = ni; xo[i][j] = pk2(nr, ni);
        }
#pragma unroll
    for (int j = 0; j < 8; ++j) asm volatile("" :: "v"(w.bf[j]));
    asm volatile("" :: "v"(ua));
}
DI void s5_pass1(const Args& a, int gw, int NGW, int lane) {
    asm volatile("" : "+v"(lane));
    const bf16* P = (const bf16*)(a.ws + WS_P);
    float* E = (float*)(a.ws + WS_S5E);
    const int fr = lane & 15, fq = lane >> 4;
    for (int unit = gw; unit < 4 * 32 * 16; unit += NGW) {
        const int sg = unit & 15, bg = unit >> 4, g = bg & 31, b = bg >> 5;
        S5W w; s5w_setup(a, g, fr, fq, w);
        float xr[4] = {0.f, 0.f, 0.f, 0.f}, xi[4] = {0.f, 0.f, 0.f, 0.f}; unsigned xo[4][4];
        const size_t row0 = (size_t)b * 8192 + sg * 512;
        bf16x8 ua = s5w_uload(P, row0, 128, 0, g, fr, fq);
        for (int ms = 0; ms < 32; ++ms) {
            const bf16x8 un = s5w_uload(P, row0, 128, ms + 1 < 32 ? ms + 1 : ms, g, fr, fq);
            s5w_step(w, ua, xr, xi, xo); ua = un;
        }
        float* e = E + ((size_t)bg * 64 + 4 * sg + fq) * 128;
#pragma unroll
        for (int j = 0; j < 4; ++j) { e[16 * j + fr] = xr[j]; e[64 + 16 * j + fr] = xi[j]; }
    }
}
DI void s5w_run(const Args& a, const S5W& w, const bf16x8 (&cf)[4], float Dg, unsigned char* xs, size_t row0, int SS, int nms, int g, int fr, int fq, float (&xr)[4], float (&xi)[4]) {
    const bf16* P = (const bf16*)(a.ws + WS_P);
    bf16* Y5 = (bf16*)(a.ws + WS_Y5);
    bf16x8 ua = s5w_uload(P, row0, SS, 0, g, fr, fq);
    for (int ms = 0; ms < nms; ++ms) {
        const bf16x8 un = s5w_uload(P, row0, SS, ms + 1 < nms ? ms + 1 : ms, g, fr, fq);
        float uu[4];
#pragma unroll
        for (int i = 0; i < 4; ++i) uu[i] = b2f(P[(row0 + (size_t)fq * SS + 4 * ms + i) * PW + 2048 + g * 16 + fr]);
        unsigned xo[4][4];
        s5w_step(w, ua, xr, xi, xo); ua = un;
#pragma unroll
        for (int i = 0; i < 4; ++i)
#pragma unroll
            for (int j = 0; j < 4; ++j) *(unsigned*)(xs + (4 * fq + i) * 272 + (16 * j + fr) * 4) = xo[i][j];
        asm volatile("s_waitcnt lgkmcnt(0)" ::: "memory");
        f32x4 y = (f32x4){0.f, 0.f, 0.f, 0.f};
        bf16x8 af[4];
#pragma unroll
        for (int ks = 0; ks < 4; ++ks) af[ks] = *(const bf16x8*)(xs + fr * 272 + ks * 64 + fq * 16);
        asm volatile("" ::: "memory");
#pragma unroll
        for (int ks = 0; ks < 4; ++ks) y = MFMA16(af[ks], cf[ks], y);
#if DIAG_Y
        {
            const float* cre = a.in[18] + (size_t)(g * 16 + fr) * 64; const float* cim = a.in[19] + (size_t)(g * 16 + fr) * 64;
#pragma unroll
            for (int i = 0; i < 4; ++i) { float acc = 0.f;
                for (int p = 0; p < 64; ++p) { const unsigned wv = *(const unsigned*)(xs + (4 * fq + i) * 272 + p * 4); acc += cre[p] * blo(wv) - cim[p] * bhi(wv); }
                y[i] = acc; }
        }
#endif
        asm volatile("" :: "v"(y));
#pragma unroll
        for (int ks = 0; ks < 4; ++ks) asm volatile("" :: "v"(af[ks]), "v"(cf[ks]));
#pragma unroll
        for (int i = 0; i < 4; ++i) {
            const size_t row = row0 + (size_t)fq * SS + 4 * ms + i;
            Y5[row * 512 + g * 16 + fr] = f2b(gelu_tanh(y[i] + Dg * uu[i]));
        }
    }
}
DI void s5_cfrag(const Args& a, int g, int fr, int fq, bf16x8 (&cf)[4]) {
#pragma unroll
    for (int ks = 0; ks < 4; ++ks) {
        const f32x4 cr = *(const f32x4*)(a.in[18] + (size_t)(g * 16 + fr) * 64 + 16 * ks + 4 * fq), ci = *(const f32x4*)(a.in[19] + (size_t)(g * 16 + fr) * 64 + 16 * ks + 4 * fq);
        u32x4 w; w.x = pk2(cr[0], -ci[0]); w.y = pk2(cr[1], -ci[1]); w.z = pk2(cr[2], -ci[2]); w.w = pk2(cr[3], -ci[3]);
        cf[ks] = __builtin_bit_cast(bf16x8, w);
    }
}
DI void s5_pass2_prompt(const Args& a, unsigned char* lds, int bg, int tid) {
    asm volatile("" : "+v"(tid));
    const int wave = __builtin_amdgcn_readfirstlane(tid >> 6), lane = tid & 63, fr = lane & 15, fq = lane >> 4;
    const int b = bg >> 5, g4 = (bg >> 2) & 7, part = bg & 3, g = 4 * g4 + (wave & 3);
    bg = b * 32 + g;
    unsigned char* xs = lds + wave * 4352;
    S5W w; s5w_setup(a, g, fr, fq, w);
    bf16x8 cf[4]; s5_cfrag(a, g, fr, fq, cf);
    const float Dg = a.in[20][g * 16 + fr];
    float pr[4], pi[4];
#pragma unroll
    for (int j = 0; j < 4; ++j) { pr[j] = w.lr[j]; pi[j] = w.li[j];
#pragma unroll
        for (int s = 0; s < 7; ++s) { const float nr = pr[j] * pr[j] - pi[j] * pi[j], ni = 2.f * pr[j] * pi[j]; pr[j] = nr; pi[j] = ni; } }
    const float* e = (const float*)(a.ws + WS_S5E) + (size_t)bg * 64 * 128;
    for (int uu = 0; uu < 2; ++uu) {
        const int sg = 4 * part + 2 * (wave >> 2) + uu, seg = 4 * sg + fq;
        float xr[4] = {0.f, 0.f, 0.f, 0.f}, xi[4] = {0.f, 0.f, 0.f, 0.f};
        for (int s = 0; s < 4 * sg + 3; ++s) {
            if (s < seg) {
#pragma unroll
                for (int j = 0; j < 4; ++j) { const float er = e[s * 128 + 16 * j + fr], ei = e[s * 128 + 64 + 16 * j + fr];
                    const float nr = pr[j] * xr[j] - pi[j] * xi[j] + er, ni = pr[j] * xi[j] + pi[j] * xr[j] + ei; xr[j] = nr; xi[j] = ni; }
            }
        }
        s5w_run(a, w, cf, Dg, xs, (size_t)b * 8192 + sg * 512, 128, 32, g, fr, fq, xr, xi);
        if (seg == 63) {
#pragma unroll
            for (int j = 0; j < 4; ++j) { a.out[O_PSR + (size_t)bg * 64 + 16 * j + fr] = xr[j]; a.out[O_PSI + (size_t)bg * 64 + 16 * j + fr] = xi[j]; }
        }
    }
}
DI void s5_pass2_sample(const Args& a, unsigned char* xs, int gw, int NGW, int lane) {
    asm volatile("" : "+v"(lane));
    const int fr = lane & 15, fq = lane >> 4;
    for (int unit = gw; unit < 256; unit += NGW) {
        const int g = unit & 31, q = unit >> 5, sb = 4 * q + fq;
        S5W w; s5w_setup(a, g, fr, fq, w);
        bf16x8 cf[4]; s5_cfrag(a, g, fr, fq, cf);
        const float Dg = a.in[20][g * 16 + fr];
        float xr[4], xi[4];
#pragma unroll
        for (int j = 0; j < 4; ++j) { xr[j] = a.in[4][(size_t)(sb * 32 + g) * 64 + 16 * j + fr]; xi[j] = a.in[5][(size_t)(sb * 32 + g) * 64 + 16 * j + fr]; }
        s5w_run(a, w, cf, Dg, xs, (size_t)TP + (size_t)q * 64, 16, 4, g, fr, fq, xr, xi);
#pragma unroll
        for (int j = 0; j < 4; ++j) { a.out[O_SSR + (size_t)(sb * 32 + g) * 64 + 16 * j + fr] = xr[j]; a.out[O_SSI + (size_t)(sb * 32 + g) * 64 + 16 * j + fr] = xi[j]; }
    }
}

struct S5Par { float lr, li; float bbr[16], bbi[16]; };
DI void s5_setup(const Args& a, int g, int p, S5Par& q) {
    const float are = a.in[13][g * 64 + p], aim = a.in[14][g * 64 + p], dt = __expf(a.in[15][g]);
    const float mag = __expf(are * dt), ang = aim * dt;
    float sn, cs; sincosf(ang, &sn, &cs);
    q.lr = mag * cs; q.li = mag * sn;
    const float den = are * are + aim * aim;
    const float fre = ((q.lr - 1.f) * are + q.li * aim) / den, fim = (q.li * are - (q.lr - 1.f) * aim) / den;
    const f32x4* br = (const f32x4*)(a.in[16] + (size_t)(g * 64 + p) * 16); const f32x4* bi = (const f32x4*)(a.in[17] + (size_t)(g * 64 + p) * 16);
#pragma unroll
    for (int j = 0; j < 4; ++j) { const f32x4 r = br[j], i = bi[j];
#pragma unroll
        for (int e = 0; e < 4; ++e) { q.bbr[4 * j + e] = fre * r[e] - fim * i[e]; q.bbi[4 * j + e] = fre * i[e] + fim * r[e]; } }
}
DI void s5_step4(const S5Par& q, float uv, float& xr, float& xi, unsigned (&xo)[4]) {
#pragma unroll
    for (int j = 0; j < 4; ++j) {
        float br = 0.f, bi = 0.f;
#pragma unroll
        for (int h = 0; h < 16; ++h) { const float uh = __int_as_float(__builtin_amdgcn_readlane(__float_as_int(uv), 16 * j + h)); br += q.bbr[h] * uh; bi += q.bbi[h] * uh; }
        const float nr = q.lr * xr - q.li * xi + br, ni = q.lr * xi + q.li * xr + bi;
        xr = nr; xi = ni; xo[j] = pk2(xr, xi);
    }
}
DI void old_s5_pass1(const Args& a, int gw, int NGW, int lane) {
    asm volatile("" : "+v"(lane));
    const bf16* P = (const bf16*)(a.ws + WS_P);
    float* E = (float*)(a.ws + WS_S5E);
    for (int unit = gw; unit < 4 * 32 * 64; unit += NGW) {
        const int seg = unit & 63, bg = unit >> 6, g = bg & 31, b = bg >> 5;
        S5Par q; s5_setup(a, g, lane, q);
        float xr = 0.f, xi = 0.f; unsigned xo[4];
        const bf16* up = P + (size_t)(b * 8192 + seg * 128 + (lane >> 4)) * PW + 2048 + g * 16 + (lane & 15);
#pragma unroll 2
        for (int t = 0; t < 128; t += 4) { const float uv = b2f(up[(size_t)t * PW]); s5_step4(q, uv, xr, xi, xo); }
        float* e = E + ((size_t)bg * 64 + seg) * 128;
        e[lane] = xr; e[64 + lane] = xi;
    }
}
DI void old_s5_pass2(const Args& a, unsigned char* xs  , int gw, int NGW, int lane) {
    asm volatile("" : "+v"(lane));
    const bf16* P = (const bf16*)(a.ws + WS_P);
    const float* E = (const float*)(a.ws + WS_S5E);
    bf16* Y5 = (bf16*)(a.ws + WS_Y5);
    const int fr = lane & 15, fq = lane >> 4;
    for (int unit = gw; unit < OLD_S5_ULIM; unit += NGW) {
        int g, row0, ntok, seg = 0, bg; bool sample;
        if (unit < 8192) { seg = unit & 63; bg = unit >> 6; g = bg & 31; row0 = (bg >> 5) * 8192 + seg * 128; ntok = 128; sample = false; }
        else { bg = unit - 8192; g = bg & 31; row0 = TP + (bg >> 5) * 16; ntok = 16; sample = true; }
        S5Par q; s5_setup(a, g, lane, q);
        float xr = 0.f, xi = 0.f;
        if (sample) { xr = a.in[4][(size_t)bg * 64 + lane]; xi = a.in[5][(size_t)bg * 64 + lane]; }
        else {
            float pr = q.lr, pi = q.li;
#pragma unroll
            for (int s = 0; s < 7; ++s) { const float nr = pr * pr - pi * pi, ni = 2.f * pr * pi; pr = nr; pi = ni; }
            const float* e = E + (size_t)bg * 64 * 128;
            for (int s = 0; s < seg; ++s) { const float er = e[s * 128 + lane], ei = e[s * 128 + 64 + lane]; const float nr = pr * xr - pi * xi + er, ni = pr * xi + pi * xr + ei; xr = nr; xi = ni; }
        }
        bf16x8 cf[4];
#pragma unroll
        for (int ks = 0; ks < 4; ++ks) {
            const f32x4 cr = *(const f32x4*)(a.in[18] + (size_t)(g * 16 + fr) * 64 + 16 * ks + 4 * fq), ci = *(const f32x4*)(a.in[19] + (size_t)(g * 16 + fr) * 64 + 16 * ks + 4 * fq);
            u32x4 w; w.x = pk2(cr[0], -ci[0]); w.y = pk2(cr[1], -ci[1]); w.z = pk2(cr[2], -ci[2]); w.w = pk2(cr[3], -ci[3]);
            cf[ks] = __builtin_bit_cast(bf16x8, w);
        }
        const float Dg = a.in[20][g * 16 + fr];
        const bf16* up = P + (size_t)(row0 + (lane >> 4)) * PW + 2048 + g * 16 + (lane & 15);
        for (int tb = 0; tb < ntok; tb += 16) {
#pragma unroll
            for (int j4 = 0; j4 < 4; ++j4) {
                const float uv = b2f(up[(size_t)(tb + 4 * j4) * PW]);
                unsigned xo[4]; s5_step4(q, uv, xr, xi, xo);
#pragma unroll
                for (int j = 0; j < 4; ++j) *(unsigned*)(xs + (4 * j4 + j) * 272 + lane * 4) = xo[j];
            }
            f32x4 y = (f32x4){0.f, 0.f, 0.f, 0.f};
#pragma unroll
            for (int ks = 0; ks < 4; ++ks) { const bf16x8 af = *(const bf16x8*)(xs + fr * 272 + ks * 64 + fq * 16); y = MFMA16(af, cf[ks], y); }
#pragma unroll
            for (int i = 0; i < 4; ++i) {
                const size_t row = (size_t)row0 + tb + 4 * fq + i;
                const float uu = b2f(P[row * PW + 2048 + g * 16 + fr]);
                Y5[row * 512 + g * 16 + fr] = f2b(gelu_tanh(y[i] + Dg * uu));
            }
        }
        if (sample) { a.out[O_SSR + (size_t)bg * 64 + lane] = xr; a.out[O_SSI + (size_t)bg * 64 + lane] = xi; }
        else if (seg == 63) { a.out[O_PSR + (size_t)bg * 64 + lane] = xr; a.out[O_PSI + (size_t)bg * 64 + lane] = xi; }
    }
}

DI void s5_pass2b(const Args& a, unsigned char* xs, int gw, int NGW, int lane) {
    asm volatile("" : "+v"(lane));
    const bf16* P = (const bf16*)(a.ws + WS_P);
    const float* E = (const float*)(a.ws + WS_S5E);
    bf16* Y5 = (bf16*)(a.ws + WS_Y5);
    const int fr = lane & 15, fq = lane >> 4;
    for (int unit = gw; unit < 4 * 32 * 64 + 32 * 32; unit += NGW) {
        int g, row0, ntok, seg = 0, bg; bool sample;
        if (unit < 8192) { seg = unit & 63; bg = unit >> 6; g = bg & 31; row0 = (bg >> 5) * 8192 + seg * 128; ntok = 128; sample = false; }
        else { bg = unit - 8192; g = bg & 31; row0 = TP + (bg >> 5) * 16; ntok = 16; sample = true; }
        S5Par q; s5_setup(a, g, lane, q);
        float xr = 0.f, xi = 0.f;
        if (sample) { xr = a.in[4][(size_t)bg * 64 + lane]; xi = a.in[5][(size_t)bg * 64 + lane]; }
        else {
            float pr = q.lr, pi = q.li;
#pragma unroll
            for (int s = 0; s < 7; ++s) { const float nr = pr * pr - pi * pi, ni = 2.f * pr * pi; pr = nr; pi = ni; }
            const float* e = E + (size_t)bg * 64 * 128;
            for (int s0 = 0; s0 < seg; s0 += 8) {
                float er[8], ei[8];
#pragma unroll
                for (int k = 0; k < 8; ++k) { const bool ok = s0 + k < seg; er[k] = ok ? e[(s0 + k) * 128 + lane] : 0.f; ei[k] = ok ? e[(s0 + k) * 128 + 64 + lane] : 0.f; }
#pragma unroll
                for (int k = 0; k < 8; ++k) if (s0 + k < seg) { const float nr = pr * xr - pi * xi + er[k], ni = pr * xi + pi * xr + ei[k]; xr = nr; xi = ni; }
            }
        }
        bf16x8 cf[4];
#pragma unroll
        for (int ks = 0; ks < 4; ++ks) {
            const f32x4 cr = *(const f32x4*)(a.in[18] + (size_t)(g * 16 + fr) * 64 + 16 * ks + 4 * fq), ci = *(const f32x4*)(a.in[19] + (size_t)(g * 16 + fr) * 64 + 16 * ks + 4 * fq);
            u32x4 w; w.x = pk2(cr[0], -ci[0]); w.y = pk2(cr[1], -ci[1]); w.z = pk2(cr[2], -ci[2]); w.w = pk2(cr[3], -ci[3]);
            cf[ks] = __builtin_bit_cast(bf16x8, w);
        }
        const float Dg = a.in[20][g * 16 + fr];
        S5W w; s5w_setup(a, g, fr, fq, w);
        unsigned char* bt = xs + 4352;
        for (int tb = 0; tb < ntok; tb += 16) {
            {
                u32x4 uv = (u32x4){0u, 0u, 0u, 0u};
                if (fq < 2) uv = *(const u32x4*)(P + (size_t)(row0 + tb + fr) * PW + 2048 + g * 16 + 8 * fq);
                const bf16x8 ua = __builtin_bit_cast(bf16x8, uv);
                const f32x4 z = (f32x4){0.f, 0.f, 0.f, 0.f};
#pragma unroll
                for (int j = 0; j < 4; ++j) {
                    const f32x4 br = MFMA16(ua, w.bf[j], z), bi = MFMA16(ua, w.bf[4 + j], z);
                    *(f32x4*)(bt + (16 * j + fr) * 80 + fq * 16) = br; *(f32x4*)(bt + (64 + 16 * j + fr) * 80 + fq * 16) = bi;
                }
            }
            asm volatile("s_waitcnt lgkmcnt(0)" ::: "memory");
            f32x4 bre[4], bim[4];
#pragma unroll
            for (int k = 0; k < 4; ++k) { bre[k] = *(const f32x4*)(bt + lane * 80 + k * 16); bim[k] = *(const f32x4*)(bt + (64 + lane) * 80 + k * 16); }
            asm volatile("s_waitcnt lgkmcnt(0)" ::: "memory");
#pragma unroll
            for (int t = 0; t < 16; ++t) {
                const float nr = q.lr * xr - q.li * xi + bre[t >> 2][t & 3], ni = q.lr * xi + q.li * xr + bim[t >> 2][t & 3];
                xr = nr; xi = ni;
                *(unsigned*)(xs + t * 272 + lane * 4) = pk2(nr, ni);
            }
            asm volatile("s_waitcnt lgkmcnt(0)" ::: "memory");
            f32x4 y = (f32x4){0.f, 0.f, 0.f, 0.f};
#pragma unroll
            for (int ks = 0; ks < 4; ++ks) { const bf16x8 af = *(const bf16x8*)(xs + fr * 272 + ks * 64 + fq * 16); y = MFMA16(af, cf[ks], y); }
#pragma unroll
            for (int i = 0; i < 4; ++i) {
                const size_t row = (size_t)row0 + tb + 4 * fq + i;
                const float uu = b2f(P[row * PW + 2048 + g * 16 + fr]);
                Y5[row * 512 + g * 16 + fr] = f2b(gelu_tanh(y[i] + Dg * uu));
            }
        }
        if (sample) { a.out[O_SSR + (size_t)bg * 64 + lane] = xr; a.out[O_SSI + (size_t)bg * 64 + lane] = xi; }
        else if (seg == 63) { a.out[O_PSR + (size_t)bg * 64 + lane] = xr; a.out[O_PSI + (size_t)bg * 64 + lane] = xi; }
    }
}

constexpr int DB_WN = 0, DB_QG = 17408, DB_KDT = 34816, DB_QK = 53248, DB_U0 = 62464;
constexpr int DBP_SIZE = DB_U0 + 64 * 80;
constexpr int DBS_SIZE = DB_U0 + 64 * 272;
template <int NC> struct DnRegs { u32x4 r[7]; u32x4 u[NC == 32 ? 1 : 2]; };
template <int NC> DI void dn_load(const unsigned char* rec, int tid, int c0, DnRegs<NC>& R) {
    const u32x4* g = (const u32x4*)rec;
    R.r[0] = g[tid]; R.r[1] = g[tid + 512]; R.r[2] = g[1024 + tid]; R.r[3] = g[1024 + tid + 512]; R.r[4] = g[2048 + tid]; R.r[5] = g[2048 + tid + 512]; R.r[6] = g[3072 + tid];
    if (NC == 32) { if (tid < 256) R.u[0] = *(const u32x4*)(rec + R_U0 + (tid >> 2) * 256 + c0 * 2 + (tid & 3) * 16); }
    else { R.u[0] = *(const u32x4*)(rec + R_U0 + tid * 16); R.u[1] = *(const u32x4*)(rec + R_U0 + (tid + 512) * 16); }
}
template <int NC> DI void dn_store(unsigned char* buf, int tid, const DnRegs<NC>& R) {
#pragma unroll
    for (int j = 0; j < 2; ++j) { const int q = tid + 512 * j;
        *(u32x4*)(buf + DB_WN + (q >> 4) * 272 + (q & 15) * 16) = R.r[j];
        *(u32x4*)(buf + DB_QG + (q >> 4) * 272 + (q & 15) * 16) = R.r[2 + j];
        *(u32x4*)(buf + DB_KDT + (q >> 3) * 144 + (q & 7) * 16) = R.r[4 + j]; }
    *(u32x4*)(buf + DB_QK + (tid >> 3) * 144 + (tid & 7) * 16) = R.r[6];
    if (NC == 32) { if (tid < 256) *(u32x4*)(buf + DB_U0 + (tid >> 2) * 80 + (tid & 3) * 16) = R.u[0]; }
    else {
#pragma unroll
        for (int j = 0; j < 2; ++j) { const int q = tid + 512 * j; *(u32x4*)(buf + DB_U0 + (q >> 4) * 272 + (q & 15) * 16) = R.u[j]; }
    }
}
DI bf16x8 pack8(const f32x4& lo, const f32x4& hi) { u32x4 w; w.x = pk2(lo[0], lo[1]); w.y = pk2(lo[2], lo[3]); w.z = pk2(hi[0], hi[1]); w.w = pk2(hi[2], hi[3]); return __builtin_bit_cast(bf16x8, w); }
template <int UPI> DI void dn_step(const unsigned char* buf, f32x4 (&S)[8], const unsigned char* u0, float eg, int fr, int fq, f32x4 (&o)[4]) {
    bf16x8 Sb[4];
#pragma unroll
    for (int ks = 0; ks < 4; ++ks) Sb[ks] = pack8(S[2 * ks], S[2 * ks + 1]);
    f32x4 u[4];
#pragma unroll
    for (int mt = 0; mt < 4; ++mt) {
#pragma unroll
        for (int i = 0; i < 4; ++i) u[mt][i] = b2f(*(const bf16*)(u0 + (16 * mt + 4 * fq + i) * UPI));
#pragma unroll
        for (int ks = 0; ks < 4; ++ks) u[mt] = MFMA16(*(const bf16x8*)(buf + DB_WN + (16 * mt + fr) * 272 + ks * 64 + fq * 16), Sb[ks], u[mt]);
    }
    bf16x8 ub[2];
#pragma unroll
    for (int k2 = 0; k2 < 2; ++k2) ub[k2] = pack8(u[2 * k2], u[2 * k2 + 1]);
#pragma unroll
    for (int mt = 0; mt < 4; ++mt) {
        o[mt] = (f32x4){0.f, 0.f, 0.f, 0.f};
#pragma unroll
        for (int ks = 0; ks < 4; ++ks) o[mt] = MFMA16(*(const bf16x8*)(buf + DB_QG + (16 * mt + fr) * 272 + ks * 64 + fq * 16), Sb[ks], o[mt]);
#pragma unroll
        for (int k2 = 0; k2 < 2; ++k2) o[mt] = MFMA16(*(const bf16x8*)(buf + DB_QK + (16 * mt + fr) * 144 + k2 * 64 + fq * 16), ub[k2], o[mt]);
    }
#pragma unroll
    for (int m8 = 0; m8 < 8; ++m8) {
        S[m8] = S[m8] * eg;
#pragma unroll
        for (int k2 = 0; k2 < 2; ++k2) S[m8] = MFMA16(*(const bf16x8*)(buf + DB_KDT + (16 * m8 + fr) * 144 + k2 * 64 + fq * 16), ub[k2], S[m8]);
    }
}
#if DN_STAGED == 2
#define DNP_SYNC() do { asm volatile("s_waitcnt lgkmcnt(0)" ::: "memory"); __builtin_amdgcn_sched_barrier(0); } while (0)
#else
#define DNP_SYNC() do { } while (0)
#endif
DI void dn_step_p(const unsigned char* buf, f32x4 (&S)[8], const unsigned char* u0, float eg, int fr, int fq, f32x4 (&o)[4]) {
    const unsigned char* aw = buf + DB_WN + fr * 272 + fq * 16;
    const unsigned char* aq = buf + DB_QG + fr * 272 + fq * 16;
    const unsigned char* ak = buf + DB_KDT + fr * 144 + fq * 16;
    const unsigned char* ac = buf + DB_QK + fr * 144 + fq * 16;
    bf16x8 f1[16], f2[16], Sb[4], ub[2];
    f32x4 u[4];
#pragma unroll
    for (int mt = 0; mt < 4; ++mt)
#pragma unroll
        for (int ks = 0; ks < 4; ++ks) f1[4 * mt + ks] = *(const bf16x8*)(aw + mt * 4352 + ks * 64);
#pragma unroll
    for (int mt = 0; mt < 4; ++mt)
#pragma unroll
        for (int i = 0; i < 4; ++i) u[mt][i] = b2f(*(const bf16*)(u0 + (16 * mt + 4 * fq + i) * 80));
#pragma unroll
    for (int ks = 0; ks < 4; ++ks) Sb[ks] = pack8(S[2 * ks], S[2 * ks + 1]);
    __builtin_amdgcn_sched_barrier(0);
#pragma unroll
    for (int mt = 0; mt < 4; ++mt)
#pragma unroll
        for (int ks = 0; ks < 4; ++ks) f2[4 * mt + ks] = *(const bf16x8*)(aq + mt * 4352 + ks * 64);
    DNP_SYNC();
#pragma unroll
    for (int ks = 0; ks < 4; ++ks)
#pragma unroll
        for (int mt = 0; mt < 4; ++mt) u[mt] = MFMA16(f1[4 * mt + ks], Sb[ks], u[mt]);
    __builtin_amdgcn_sched_barrier(0);
#pragma unroll
    for (int k2 = 0; k2 < 2; ++k2) ub[k2] = pack8(u[2 * k2], u[2 * k2 + 1]);
#pragma unroll
    for (int m8 = 0; m8 < 8; ++m8)
#pragma unroll
        for (int k2 = 0; k2 < 2; ++k2) f1[2 * m8 + k2] = *(const bf16x8*)(ak + m8 * 2304 + k2 * 64);
    DNP_SYNC();
#pragma unroll
    for (int mt = 0; mt < 4; ++mt) o[mt] = (f32x4){0.f, 0.f, 0.f, 0.f};
#pragma unroll
    for (int ks = 0; ks < 4; ++ks)
#pragma unroll
        for (int mt = 0; mt < 4; ++mt) o[mt] = MFMA16(f2[4 * mt + ks], Sb[ks], o[mt]);
    __builtin_amdgcn_sched_barrier(0);
#pragma unroll
    for (int mt = 0; mt < 4; ++mt)
#pragma unroll
        for (int k2 = 0; k2 < 2; ++k2) f2[2 * mt + k2] = *(const bf16x8*)(ac + mt * 2304 + k2 * 64);
    DNP_SYNC();
#pragma unroll
    for (int m8 = 0; m8 < 8; ++m8) S[m8] = S[m8] * eg;
#pragma unroll
    for (int k2 = 0; k2 < 2; ++k2)
#pragma unroll
        for (int m8 = 0; m8 < 8; ++m8) S[m8] = MFMA16(f1[2 * m8 + k2], ub[k2], S[m8]);
    __builtin_amdgcn_sched_barrier(0);
#pragma unroll
    for (int k2 = 0; k2 < 2; ++k2)
#pragma unroll
        for (int mt = 0; mt < 4; ++mt) o[mt] = MFMA16(f2[2 * mt + k2], ub[k2], o[mt]);
}
DI void dn_step_o(const unsigned char* buf, f32x4 (&S)[8], const unsigned char* u0, float eg, int fr, int fq, f32x4 (&o)[4]) {
    const unsigned char* aw = buf + DB_WN + fr * 272 + fq * 16;
    const unsigned char* aq = buf + DB_QG + fr * 272 + fq * 16;
    const unsigned char* ak = buf + DB_KDT + fr * 144 + fq * 16;
    const unsigned char* ac = buf + DB_QK + fr * 144 + fq * 16;
    bf16x8 f1[16], f2[16], Sb[4], ub[2];
    f32x4 u[4];
#pragma unroll
    for (int ks = 0; ks < 4; ++ks) Sb[ks] = pack8(S[2 * ks], S[2 * ks + 1]);
    __builtin_amdgcn_sched_barrier(0);
#pragma unroll
    for (int mt = 0; mt < 4; ++mt)
#pragma unroll
        for (int ks = 0; ks < 4; ++ks) f1[4 * mt + ks] = *(const bf16x8*)(aw + mt * 4352 + ks * 64);
#pragma unroll
    for (int mt = 0; mt < 4; ++mt)
#pragma unroll
        for (int i = 0; i < 4; ++i) u[mt][i] = b2f(*(const bf16*)(u0 + (16 * mt + 4 * fq + i) * 80));
#pragma unroll
    for (int mt = 0; mt < 4; ++mt)
#pragma unroll
        for (int ks = 0; ks < 4; ++ks) f2[4 * mt + ks] = *(const bf16x8*)(aq + mt * 4352 + ks * 64);
    __builtin_amdgcn_sched_barrier(0);
#pragma unroll
    for (int ks = 0; ks < 4; ++ks)
#pragma unroll
        for (int mt = 0; mt < 4; ++mt) u[mt] = MFMA16(f1[4 * mt + ks], Sb[ks], u[mt]);
    __builtin_amdgcn_sched_barrier(0);
#pragma unroll
    for (int k2 = 0; k2 < 2; ++k2) ub[k2] = pack8(u[2 * k2], u[2 * k2 + 1]);
    __builtin_amdgcn_sched_barrier(0);
#pragma unroll
    for (int m8 = 0; m8 < 8; ++m8)
#pragma unroll
        for (int k2 = 0; k2 < 2; ++k2) f1[2 * m8 + k2] = *(const bf16x8*)(ak + m8 * 2304 + k2 * 64);
#pragma unroll
    for (int mt = 0; mt < 4; ++mt) o[mt] = (f32x4){0.f, 0.f, 0.f, 0.f};
#pragma unroll
    for (int ks = 0; ks < 4; ++ks)
#pragma unroll
        for (int mt = 0; mt < 4; ++mt) o[mt] = MFMA16(f2[4 * mt + ks], Sb[ks], o[mt]);
    __builtin_amdgcn_sched_barrier(0);
    { float dmy = (o[0][0] + o[1][0]) + (o[2][0] + o[3][0]); asm volatile("" :: "v"(dmy)); }
    __builtin_amdgcn_sched_barrier(0);
#pragma unroll
    for (int mt = 0; mt < 4; ++mt)
#pragma unroll
        for (int k2 = 0; k2 < 2; ++k2) f2[2 * mt + k2] = *(const bf16x8*)(ac + mt * 2304 + k2 * 64);
#pragma unroll
    for (int m8 = 0; m8 < 8; ++m8) S[m8] = S[m8] * eg;
#pragma unroll
    for (int k2 = 0; k2 < 2; ++k2)
#pragma unroll
        for (int m8 = 0; m8 < 8; ++m8) S[m8] = MFMA16(f1[2 * m8 + k2], ub[k2], S[m8]);
    __builtin_amdgcn_sched_barrier(0);
#pragma unroll
    for (int k2 = 0; k2 < 2; ++k2)
#pragma unroll
        for (int mt = 0; mt < 4; ++mt) o[mt] = MFMA16(f2[2 * mt + k2], ub[k2], o[mt]);
}
DI void dn_piece(int q, int c0, unsigned& src, unsigned& dst) {
    if (q < 1024) { src = R_WN + q * 16; dst = DB_WN + (q >> 4) * 272 + (q & 15) * 16; }
    else if (q < 2048) { const int p = q - 1024; src = R_QG + p * 16; dst = DB_QG + (p >> 4) * 272 + (p & 15) * 16; }
    else if (q < 3072) { const int p = q - 2048; src = R_KDT + p * 16; dst = DB_KDT + (p >> 3) * 144 + (p & 7) * 16; }
    else if (q < 3584) { const int p = q - 3072; src = R_QK + p * 16; dst = DB_QK + (p >> 3) * 144 + (p & 7) * 16; }
    else { const int p = q - 3584; src = R_U0 + (p >> 2) * 256 + c0 * 2 + (p & 3) * 16; dst = DB_U0 + (p >> 2) * 80 + (p & 3) * 16; }
}
#define DN_LD(R, base) do { _Pragma("unroll") for (int k = 0; k < 10; ++k) { unsigned s_, d_; dn_piece(lt + 384 * k, c0, s_, d_); R[k] = *(const u32x4*)((base) + s_); } } while (0)
#define DN_WAIT(R, cnt) do { } while (0)
#define DN_ST(R, buf) do { _Pragma("unroll") for (int k = 0; k < 10; ++k) { unsigned s_, d_; dn_piece(lt + 384 * k, c0, s_, d_); *(u32x4*)((buf) + d_) = R[k]; } } while (0)
#define DN_BAR() do { asm volatile("s_waitcnt lgkmcnt(0)" ::: "memory"); __builtin_amdgcn_s_barrier(); asm volatile("" ::: "memory"); } while (0)
DI void dn_scan_prompt(const Args& a, unsigned char* lds, int tid) {
    asm volatile("" : "+v"(tid));
    const int wave = __builtin_amdgcn_readfirstlane(tid >> 6), lane = tid & 63, fr = lane & 15, fq = lane >> 4;
    const int bh = blockIdx.x >> 2, qt = blockIdx.x & 3, b = bh >> 2, h = bh & 3;
    const int c0 = qt * 32, v0 = c0 + (wave & 1) * 16;
    const unsigned char* recs = a.ws + WS_DNC + (size_t)bh * 128 * REC;
    const float* egs = (const float*)(a.ws + WS_EG) + bh * 128;
    float* ORAW = (float*)(a.ws + WS_H);
    const bool loader = wave >= 2;
    const int lt = tid - 128;
    f32x4 S[8];
#pragma unroll
    for (int m8 = 0; m8 < 8; ++m8) S[m8] = (f32x4){0.f, 0.f, 0.f, 0.f};
    float egA = egs[lane], egB = egs[64 + lane];
    asm volatile("s_waitcnt vmcnt(0)" : "+v"(egA), "+v"(egB) :: "memory");
    if (loader) {
        const int grp = wave >= 5 ? 1 : 0, lt2 = tid - 128 - grp * 192;
        u32x4 R[20];
#define DN_LD20(base) do { _Pragma("unroll") for (int k = 0; k < 20; ++k) { unsigned s_, d_; dn_piece(lt2 + 192 * k, c0, s_, d_); R[k] = *(const u32x4*)((base) + s_); } } while (0)
#define DN_ST20(buf) do { _Pragma("unroll") for (int k = 0; k < 20; ++k) { unsigned s_, d_; dn_piece(lt2 + 192 * k, c0, s_, d_); *(u32x4*)((buf) + d_) = R[k]; } } while (0)
        if (grp == 0) { DN_LD20(recs); DN_ST20(lds); DN_LD20(recs + 2 * (size_t)REC); }
        else { DN_LD20(recs + REC); }
        DN_BAR();
        for (int n = 0; n < 128; n += 2) {
            if (grp == 1) { DN_ST20(lds + DBP_SIZE); if (n + 3 < 128) DN_LD20(recs + (size_t)(n + 3) * REC); }
            DN_BAR();
            if (grp == 0 && n + 2 < 128) { DN_ST20(lds); if (n + 4 < 128) DN_LD20(recs + (size_t)(n + 4) * REC); }
            DN_BAR();
        }
#undef DN_LD20
#undef DN_ST20
    } else {
        DN_BAR();
        for (int n = 0; n < 128; ++n) {
            const float eg0 = __int_as_float(__builtin_amdgcn_readlane(__float_as_int(n < 64 ? egA : egB), n & 63));
            f32x4 o[4];
#if DN_STAGED == 3
            dn_step_o(lds + (n & 1) * DBP_SIZE, S, lds + (n & 1) * DBP_SIZE + DB_U0 + ((wave & 1) * 16 + fr) * 2, eg0, fr, fq, o);
#elif DN_STAGED
            dn_step_p(lds + (n & 1) * DBP_SIZE, S, lds + (n & 1) * DBP_SIZE + DB_U0 + ((wave & 1) * 16 + fr) * 2, eg0, fr, fq, o);
#else
            dn_step<80>(lds + (n & 1) * DBP_SIZE, S, lds + (n & 1) * DBP_SIZE + DB_U0 + ((wave & 1) * 16 + fr) * 2, eg0, fr, fq, o);
#endif
            float* op = ORAW + (size_t)(b * 8192 + n * 64) * 512 + h * 128 + v0 + fr;
#pragma unroll
            for (int mt = 0; mt < 4; ++mt)
#pragma unroll
                for (int i = 0; i < 4; ++i) op[(size_t)(16 * mt + 4 * fq + i) * 512] = o[mt][i];
            DN_BAR();
        }
    }
    if (!loader) {
        float* so = a.out + O_PDS + (size_t)bh * 128 * 128 + v0 + fr;
#pragma unroll
        for (int m8 = 0; m8 < 8; ++m8)
#pragma unroll
            for (int i = 0; i < 4; ++i) so[(16 * m8 + 4 * fq + i) * 128] = S[m8][i];
    }
    __syncthreads();
}
DI void dn_scan_sample(const Args& a, unsigned char* lds, int tid, int su0, int su1, int sus) {
    asm volatile("" : "+v"(tid));
    const int wave = __builtin_amdgcn_readfirstlane(tid >> 6), lane = tid & 63, fr = lane & 15, fq = lane >> 4;
    const int v0 = wave * 16;
    float* ORAW = (float*)(a.ws + WS_H);
    for (int su = su0; su < su1; su += sus) {
        const int sb = su >> 2, h = su & 3;
        const unsigned char* rec = a.ws + WS_DNC + (size_t)(2048 + su) * REC;
        DnRegs<128> R; dn_load<128>(rec, tid, 0, R); dn_store<128>(lds, tid, R);
        __syncthreads();
        f32x4 S[8];
        const float* s0 = a.in[3] + (size_t)su * 128 * 128 + v0 + fr;
#pragma unroll
        for (int m8 = 0; m8 < 8; ++m8)
#pragma unroll
            for (int i = 0; i < 4; ++i) S[m8][i] = s0[(16 * m8 + 4 * fq + i) * 128];
        f32x4 o[4];
        dn_step<272>(lds, S, lds + DB_U0 + (v0 + fr) * 2, ((const float*)(a.ws + WS_EG))[2048 + su], fr, fq, o);
        float* op = ORAW + (size_t)(TP + sb * 16) * 512 + h * 128 + v0 + fr;
#pragma unroll
        for (int i = 0; i < 4; ++i) op[(size_t)(4 * fq + i) * 512] = o[0][i];
        float* so = a.out + O_SDS + (size_t)su * 128 * 128 + v0 + fr;
#pragma unroll
        for (int m8 = 0; m8 < 8; ++m8)
#pragma unroll
            for (int i = 0; i < 4; ++i) so[(16 * m8 + 4 * fq + i) * 128] = S[m8][i];
        __syncthreads();
    }
}

DI void mix_phase(const Args& a, int gw, int NGW, int lane) {
    asm volatile("" : "+v"(lane));
    const float* ORAW = (const float*)(a.ws + WS_H);
    const bf16* P = (const bf16*)(a.ws + WS_P);
    const bf16* GLU = (const bf16*)(a.ws + WS_GLU);
    bf16* MIX = (bf16*)(a.ws + WS_DNC);
    const f32x2 dg = *(const f32x2*)(a.in[12] + 2 * lane);
    const f32x4 sg0 = *(const f32x4*)(a.in[23] + 8 * lane), sg1 = *(const f32x4*)(a.in[23] + 8 * lane + 4);
    constexpr int NR = 4;
    for (int row0 = gw; row0 < T; row0 += NR * NGW) {
        f32x2 ov[NR][4]; unsigned zz[NR][4]; u32x4 gv[NR]; float ssq[NR][5];
#pragma unroll
        for (int r = 0; r < NR; ++r) { const size_t row = row0 + r * NGW < T ? row0 + r * NGW : row0;
#pragma unroll
            for (int h = 0; h < 4; ++h) { ov[r][h] = *(const f32x2*)(ORAW + row * 512 + h * 128 + 2 * lane); zz[r][h] = *(const unsigned*)(P + row * PW + 1536 + h * 128 + 2 * lane); }
            gv[r] = *(const u32x4*)(GLU + row * 512 + 8 * lane); }
#pragma unroll
        for (int r = 0; r < NR; ++r) {
#pragma unroll
            for (int h = 0; h < 4; ++h) ssq[r][h] = ov[r][h].x * ov[r][h].x + ov[r][h].y * ov[r][h].y;
            const float v[8] = {blo(gv[r].x), bhi(gv[r].x), blo(gv[r].y), bhi(gv[r].y), blo(gv[r].z), bhi(gv[r].z), blo(gv[r].w), bhi(gv[r].w)};
            float ss = 0.f;
#pragma unroll
            for (int e = 0; e < 8; ++e) ss += v[e] * v[e];
            ssq[r][4] = ss; }
#pragma unroll
        for (int o = 1; o < 64; o <<= 1)
#pragma unroll
            for (int r = 0; r < NR; ++r)
#pragma unroll
                for (int k = 0; k < 5; ++k) ssq[r][k] += __shfl_xor(ssq[r][k], o);
#pragma unroll
        for (int r = 0; r < NR; ++r) if (r == 0 || row0 + r * NGW < T) { const size_t row = row0 + r * NGW;
#pragma unroll
            for (int h = 0; h < 4; ++h) { const float rr = rsqrtf(ssq[r][h] * (1.f / 128.f) + EPS);
                *(unsigned*)(MIX + row * DM + h * 128 + 2 * lane) = pk2(ov[r][h].x * rr * dg.x * silu(blo(zz[r][h])), ov[r][h].y * rr * dg.y * silu(bhi(zz[r][h]))); }
            const float v[8] = {blo(gv[r].x), bhi(gv[r].x), blo(gv[r].y), bhi(gv[r].y), blo(gv[r].z), bhi(gv[r].z), blo(gv[r].w), bhi(gv[r].w)};
            const float r5 = rsqrtf(ssq[r][4] * (1.f / 512.f) + EPS);
            u32x4 w; w.x = pk2(v[0] * r5 * sg0[0], v[1] * r5 * sg0[1]); w.y = pk2(v[2] * r5 * sg0[2], v[3] * r5 * sg0[3]);
            w.z = pk2(v[4] * r5 * sg1[0], v[5] * r5 * sg1[1]); w.w = pk2(v[6] * r5 * sg1[2], v[7] * r5 * sg1[3]);
            *(u32x4*)(MIX + row * DM + 512 + 8 * lane) = w; }
    }
}

DI void act_phase(const Args& a, int gtid, int NT) {
    asm volatile("" : "+v"(gtid));
    bf16* UP = (bf16*)(a.ws + WS_UP);
    const float* fw = a.in[27]; const float* fb = a.in[28];
    constexpr int NCG = DFF / 8;
    for (int item = gtid; item < (T / 16) * NCG; item += NT) {
        const int cg8 = item % NCG, rb = item / NCG, col = cg8 * 8, row0 = rb * 16;
        float w0[8], w1[8], w2[8], bb[8], g2[8], g1[8];
#pragma unroll
        for (int e = 0; e < 8; ++e) { w0[e] = fw[col + e]; w1[e] = fw[DFF + col + e]; w2[e] = fw[2 * DFF + col + e]; bb[e] = fb[col + e]; g2[e] = 0.f; g1[e] = 0.f; }
        const bool sample = row0 >= TP;
        float* outp = nullptr;
        if (sample) { const int sb = (row0 - TP) >> 4; const float* cc = a.in[6] + (size_t)sb * 2 * DFF + col;
#pragma unroll
            for (int e = 0; e < 8; ++e) { g2[e] = cc[e]; g1[e] = cc[DFF + e]; }
            outp = a.out + O_SFC + (size_t)sb * 2 * DFF + col;
        } else {
            if ((rb & 511) != 0) {
                const u32x4 x2 = *(const u32x4*)(UP + (size_t)(row0 - 2) * UPW + col), x1 = *(const u32x4*)(UP + (size_t)(row0 - 1) * UPW + col);
                g2[0] = blo(x2.x); g2[1] = bhi(x2.x); g2[2] = blo(x2.y); g2[3] = bhi(x2.y); g2[4] = blo(x2.z); g2[5] = bhi(x2.z); g2[6] = blo(x2.w); g2[7] = bhi(x2.w);
                g1[0] = blo(x1.x); g1[1] = bhi(x1.x); g1[2] = blo(x1.y); g1[3] = bhi(x1.y); g1[4] = blo(x1.z); g1[5] = bhi(x1.z); g1[6] = blo(x1.w); g1[7] = bhi(x1.w);
            }
            if ((rb & 511) == 511) outp = a.out + O_PFC + (size_t)(rb >> 9) * 2 * DFF + col;
        }
#pragma unroll 4
        for (int r = 0; r < 16; ++r) {
            bf16* gp = UP + (size_t)(row0 + r) * UPW + col;
            const u32x4 xg = *(const u32x4*)gp, xv = *(const u32x4*)(gp + DFF);
            float g0[8] = {blo(xg.x), bhi(xg.x), blo(xg.y), bhi(xg.y), blo(xg.z), bhi(xg.z), blo(xg.w), bhi(xg.w)};
            float vv[8] = {blo(xv.x), bhi(xv.x), blo(xv.y), bhi(xv.y), blo(xv.z), bhi(xv.z), blo(xv.w), bhi(xv.w)};
            float o[8];
#pragma unroll
            for (int e = 0; e < 8; ++e) { o[e] = silu(g2[e] * w0[e] + g1[e] * w1[e] + g0[e] * w2[e] + bb[e]) * vv[e]; g2[e] = g1[e]; g1[e] = g0[e]; }
            u32x4 w; w.x = pk2(o[0], o[1]); w.y = pk2(o[2], o[3]); w.z = pk2(o[4], o[5]); w.w = pk2(o[6], o[7]);
            *(u32x4*)(gp + DFF) = w;
            if (outp && r >= 14) {
#pragma unroll
                for (int e = 0; e < 8; ++e) outp[(r - 14) * DFF + e] = g0[e];
            }
        }
    }
}

DI void act_fix_phase(const Args& a, int gtid, int NT) {
    asm volatile("" : "+v"(gtid));
    bf16* ACT = (bf16*)(a.ws + WS_UP);
    const bf16* GH = (const bf16*)(a.ws + WS_GH); const bf16* GT = (const bf16*)(a.ws + WS_GT); const bf16* VH = (const bf16*)(a.ws + WS_VH);
    const float* fw = a.in[27]; const float* fb = a.in[28];
    constexpr int NCG = DFF / 8;
    for (int item = gtid; item < (T / 16) * NCG; item += NT) {
        const int cg8 = item % NCG, grp = item / NCG, col = cg8 * 8;
        float w0[8], w1[8], w2[8], bb[8], g2[8], g1[8], h0[8], h1[8], v0[8], v1[8];
#pragma unroll
        for (int e = 0; e < 8; ++e) { w0[e] = fw[col + e]; w1[e] = fw[DFF + col + e]; w2[e] = fw[2 * DFF + col + e]; bb[e] = fb[col + e]; g2[e] = 0.f; g1[e] = 0.f; }
        const bool sample = grp >= TP / 16;
        if (sample) { const float* cc = a.in[6] + (size_t)(grp - TP / 16) * 2 * DFF + col;
#pragma unroll
            for (int e = 0; e < 8; ++e) { g2[e] = cc[e]; g1[e] = cc[DFF + e]; }
        } else if ((grp & 511) != 0) {
            const u32x4 x2 = *(const u32x4*)(GT + ((size_t)(grp - 1) * 2) * DFF + col), x1 = *(const u32x4*)(GT + ((size_t)(grp - 1) * 2 + 1) * DFF + col);
            g2[0] = blo(x2.x); g2[1] = bhi(x2.x); g2[2] = blo(x2.y); g2[3] = bhi(x2.y); g2[4] = blo(x2.z); g2[5] = bhi(x2.z); g2[6] = blo(x2.w); g2[7] = bhi(x2.w);
            g1[0] = blo(x1.x); g1[1] = bhi(x1.x); g1[2] = blo(x1.y); g1[3] = bhi(x1.y); g1[4] = blo(x1.z); g1[5] = bhi(x1.z); g1[6] = blo(x1.w); g1[7] = bhi(x1.w);
        }
        {
            const u32x4 xa = *(const u32x4*)(GH + ((size_t)grp * 2) * DFF + col), xb = *(const u32x4*)(GH + ((size_t)grp * 2 + 1) * DFF + col);
            const u32x4 ya = *(const u32x4*)(VH + ((size_t)grp * 2) * DFF + col), yb = *(const u32x4*)(VH + ((size_t)grp * 2 + 1) * DFF + col);
            h0[0] = blo(xa.x); h0[1] = bhi(xa.x); h0[2] = blo(xa.y); h0[3] = bhi(xa.y); h0[4] = blo(xa.z); h0[5] = bhi(xa.z); h0[6] = blo(xa.w); h0[7] = bhi(xa.w);
            h1[0] = blo(xb.x); h1[1] = bhi(xb.x); h1[2] = blo(xb.y); h1[3] = bhi(xb.y); h1[4] = blo(xb.z); h1[5] = bhi(xb.z); h1[6] = blo(xb.w); h1[7] = bhi(xb.w);
            v0[0] = blo(ya.x); v0[1] = bhi(ya.x); v0[2] = blo(ya.y); v0[3] = bhi(ya.y); v0[4] = blo(ya.z); v0[5] = bhi(ya.z); v0[6] = blo(ya.w); v0[7] = bhi(ya.w);
            v1[0] = blo(yb.x); v1[1] = bhi(yb.x); v1[2] = blo(yb.y); v1[3] = bhi(yb.y); v1[4] = blo(yb.z); v1[5] = bhi(yb.z); v1[6] = blo(yb.w); v1[7] = bhi(yb.w);
        }
        float o0[8], o1[8];
#pragma unroll
        for (int e = 0; e < 8; ++e) { o0[e] = silu(g2[e] * w0[e] + g1[e] * w1[e] + h0[e] * w2[e] + bb[e]) * v0[e]; o1[e] = silu(g1[e] * w0[e] + h0[e] * w1[e] + h1[e] * w2[e] + bb[e]) * v1[e]; }
        u32x4 wa, wb; wa.x = pk2(o0[0], o0[1]); wa.y = pk2(o0[2], o0[3]); wa.z = pk2(o0[4], o0[5]); wa.w = pk2(o0[6], o0[7]);
        wb.x = pk2(o1[0], o1[1]); wb.y = pk2(o1[2], o1[3]); wb.z = pk2(o1[4], o1[5]); wb.w = pk2(o1[6], o1[7]);
        *(u32x4*)(ACT + ((size_t)grp * 16) * DFF + col) = wa; *(u32x4*)(ACT + ((size_t)grp * 16 + 1) * DFF + col) = wb;
        float* outp = nullptr;
        if (sample) outp = a.out + O_SFC + (size_t)(grp - TP / 16) * 2 * DFF + col;
        else if ((grp & 511) == 511) outp = a.out + O_PFC + (size_t)(grp >> 9) * 2 * DFF + col;
        if (outp) {
            const u32x4 t0 = *(const u32x4*)(GT + ((size_t)grp * 2) * DFF + col), t1 = *(const u32x4*)(GT + ((size_t)grp * 2 + 1) * DFF + col);
            outp[0] = blo(t0.x); outp[1] = bhi(t0.x); outp[2] = blo(t0.y); outp[3] = bhi(t0.y); outp[4] = blo(t0.z); outp[5] = bhi(t0.z); outp[6] = blo(t0.w); outp[7] = bhi(t0.w);
            outp[DFF + 0] = blo(t1.x); outp[DFF + 1] = bhi(t1.x); outp[DFF + 2] = blo(t1.y); outp[DFF + 3] = bhi(t1.y); outp[DFF + 4] = blo(t1.z); outp[DFF + 5] = bhi(t1.z); outp[DFF + 6] = blo(t1.w); outp[DFF + 7] = bhi(t1.w);
        }
    }
}

DI void final_phase(const Args& a, int gw, int NGW, int lane) {
    asm volatile("" : "+v"(lane));
    f32x4 gv[4];
#pragma unroll
    for (int j = 0; j < 4; ++j) gv[j] = ((const f32x4*)a.in[30])[lane + 64 * j];
    for (int m0 = gw; m0 < T; m0 += 2 * NGW) {
        const int m1 = m0 + NGW < T ? m0 + NGW : m0;
        f32x4* xr0 = (f32x4*)(a.out + (size_t)m0 * DM) + lane; f32x4* xr1 = (f32x4*)(a.out + (size_t)m1 * DM) + lane;
        f32x4 v0[4], v1[4]; float s0 = 0.f, s1 = 0.f;
#pragma unroll
        for (int j = 0; j < 4; ++j) { v0[j] = xr0[64 * j]; v1[j] = xr1[64 * j]; }
#pragma unroll
        for (int j = 0; j < 4; ++j) { s0 += (v0[j].x * v0[j].x + v0[j].y * v0[j].y) + (v0[j].z * v0[j].z + v0[j].w * v0[j].w); s1 += (v1[j].x * v1[j].x + v1[j].y * v1[j].y) + (v1[j].z * v1[j].z + v1[j].w * v1[j].w); }
        const float r0 = rsqrtf(wave_sum(s0) * (1.f / DM) + EPS), r1 = rsqrtf(wave_sum(s1) * (1.f / DM) + EPS);
#pragma unroll
        for (int j = 0; j < 4; ++j) xr0[64 * j] = v0[j] * r0 * gv[j];
        if (m1 != m0) {
#pragma unroll
            for (int j = 0; j < 4; ++j) xr1[64 * j] = v1[j] * r1 * gv[j];
        }
    }
}

#ifndef PH_MASK
#define PH_MASK 0xffff
#endif
#ifndef SOLVE_RL
#define SOLVE_RL 1
#endif
#ifndef REP0
#define REP0 1
#endif
#ifndef REP1
#define REP1 1
#endif
#ifndef REP2A
#define REP2A 1
#endif
#ifndef REP2B
#define REP2B 1
#endif
#ifndef REP3A
#define REP3A 1
#endif
#ifndef REP3B
#define REP3B 1
#endif
#ifndef REP3C
#define REP3C 1
#endif
#ifndef PH_LO
#define PH_LO 0
#endif
#ifndef PH_HI
#define PH_HI 99
#endif
__global__ void __launch_bounds__(512, 2) fwd_kernel(Args a) {
    extern __shared__ __attribute__((aligned(16))) unsigned char lds[];
    cg::grid_group grid = cg::this_grid();
    const int tid = threadIdx.x, lane = tid & 63, wave = __builtin_amdgcn_readfirstlane(tid >> 6);
    const int G = gridDim.x, gw = blockIdx.x * 8 + wave, NGW = G * 8;
    unsigned char* ws = a.ws;
    PG8_LAS unsigned char* ldsg = (PG8_LAS unsigned char*)lds;
    volatile LAS unsigned* xbst = (volatile LAS unsigned*)(ldsg + (LDS_BYTES - 64));
    if (tid < 2) xbst[tid] = 0u;
    __syncthreads();
    const XcdBarrier xbar = xcd_barrier_post((unsigned*)(ws + WS_CTL), xbst);

    _Pragma("nounroll") for (int rep = 0; rep < REP0; ++rep) { phase0(a, lds, gw, NGW, wave, lane); __syncthreads(); }
    xcd_barrier(xbar);
    if (a.out == nullptr) grid.sync();
    _Pragma("nounroll") for (int rep = 0; rep < REP1; ++rep)
    { pg8::Gemm g{(const bf16*)(ws + WS_H), (const bf16*)(ws + WS_WIN), T, NIN, DM, DM}; pg8::StaticOrder S; S.init(T, NIN, G, (int)blockIdx.x);
      EpiP E{(bf16*)(ws + WS_P), (float*)(ws + WS_BA)};
      pg8::gemm_phase<EpiP, pg8::StaticOrder, true, true>(ldsg, g, S, E); }
    xcd_barrier(xbar);
    _Pragma("nounroll") for (int rep = 0; rep < REP2A; ++rep) dn_chunk_phase(a, lds, tid, (int)blockIdx.x, 1024, G);
#if OLD_S5 && OLD_S5 != 4 && OLD_S5 != 5
    old_s5_pass1(a, gw, NGW, lane);
#elif 0
#else
    _Pragma("nounroll") for (int rep = 0; rep < REP2B; ++rep) s5_pass1(a, gw, NGW, lane);
#endif
    xcd_barrier(xbar);
#if OLD_S5 == 3
    if (blockIdx.x < 64) dn_scan_prompt(a, lds, tid);
    else { if (blockIdx.x >= 192) { dn_scan_sample(a, lds, tid, (int)blockIdx.x - 192, 128, 64); s5_pass2_sample(a, lds + 81920 + wave * 4352, ((int)blockIdx.x - 192) * 8 + wave, 512, lane); __syncthreads(); }
           old_s5_pass2(a, lds + 81920 + wave * 4352, gw - 512, NGW - 512, lane); }
#elif OLD_S5 == 5
    if (blockIdx.x < 64) { _Pragma("nounroll") for (int rep = 0; rep < REP3A; ++rep) dn_scan_prompt(a, lds, tid); }
    else {
        if (blockIdx.x >= 192) {
            const int w = (int)blockIdx.x - 192;
            dn_chunk_phase(a, lds, tid, 1024 + w, 1025 + w, 1);
            __threadfence_block(); __syncthreads();
            dn_scan_sample(a, lds, tid, 2 * w, 2 * w + 2, 1);
        }
        _Pragma("nounroll") for (int rep = 0; rep < REP3B; ++rep) s5_pass2b(a, lds + wave * 14592, gw - 512, NGW - 512, lane);
    }
#elif OLD_S5 == 1 || OLD_S5 == 4
    if (blockIdx.x < 64) dn_scan_prompt(a, lds, tid);
    else { if (blockIdx.x >= 192) dn_scan_sample(a, lds, tid, (int)blockIdx.x - 192, 128, 64); old_s5_pass2(a, lds + 81920 + wave * 4352, gw - 512, NGW - 512, lane); }
#else
    if (blockIdx.x < 64) { _Pragma("nounroll") for (int rep = 0; rep < REP3A; ++rep) dn_scan_prompt(a, lds, tid); }
    else if (blockIdx.x < 192) { _Pragma("nounroll") for (int rep = 0; rep < REP3B; ++rep) s5_pass2_prompt(a, lds, (int)blockIdx.x - 64, tid); }
    else { _Pragma("nounroll") for (int rep = 0; rep < REP3C; ++rep) { dn_scan_sample(a, lds, tid, (int)blockIdx.x - 192, 128, 64); s5_pass2_sample(a, lds + 81920 + wave * 4352, ((int)blockIdx.x - 192) * 8 + wave, 512, lane); } }
#endif
    xcd_barrier(xbar);
#if PH_MASK & 512
    { pg8::Gemm g{(const bf16*)(ws + WS_Y5), (const bf16*)(ws + WS_WGLU), T, 1024, 512, 512}; pg8::StaticOrder S; S.init(T, 1024, G, (int)blockIdx.x);
      EpiGlu E{(bf16*)(ws + WS_GLU), a.in[22]};
      pg8::gemm_phase<EpiGlu, pg8::StaticOrder, true, true>(ldsg, g, S, E); }
#endif
    xcd_barrier(xbar);
#if PH_MASK & 32
    mix_phase(a, gw, NGW, lane);
#endif
    xcd_barrier(xbar);
#if PH_MASK & 1024
    { pg8::Gemm g{(const bf16*)(ws + WS_DNC), (const bf16*)(ws + WS_WOUT), T, DM, DM, DM}; pg8::StaticOrder S; S.init(T, DM, G, (int)blockIdx.x);
      EpiX1 E{a.in[0], a.in[1], a.out, (bf16*)(ws + WS_H), (float*)(ws + WS_SS2)};
      pg8::gemm_phase<EpiX1, pg8::StaticOrder, true, true>(ldsg, g, S, E); }
#endif
    xcd_barrier(xbar);
#if FUSE_ACT
    { pg8::Gemm g{(const bf16*)(ws + WS_H), (const bf16*)(ws + WS_WUP), T, UPW, DM, DM}; pg8::StaticOrder S; S.init(T, UPW, G, (int)blockIdx.x);
      EpiUpAct E{(bf16*)(ws + WS_UP), (bf16*)(ws + WS_GH), (bf16*)(ws + WS_GT), (bf16*)(ws + WS_VH), (const float*)(ws + WS_SS2), a.in[27], a.in[28]};
      pg8::gemm_phase<EpiUpAct, pg8::StaticOrder, true, true>(ldsg, g, S, E); }
    xcd_barrier(xbar);
    act_fix_phase(a, (int)blockIdx.x * 512 + tid, G * 512);
    xcd_barrier(xbar);
    { pg8::Gemm g{(const bf16*)(ws + WS_UP), (const bf16*)(ws + WS_WDOWN), T, DM, DFF, DFF}; pg8::StaticOrder S; S.init(T, DM, G, (int)blockIdx.x);
      EpiX2 E{a.out};
      pg8::gemm_phase<EpiX2, pg8::StaticOrder, true, true>(ldsg, g, S, E); }
    xcd_barrier(xbar);
#else
#if PH_MASK & 2048
    { pg8::Gemm g{(const bf16*)(ws + WS_H), (const bf16*)(ws + WS_WUP), T, UPW, DM, DM}; pg8::StaticOrder S; S.init(T, UPW, G, (int)blockIdx.x);
      EpiUp E{(bf16*)(ws + WS_UP), (const float*)(ws + WS_SS2)};
      pg8::gemm_phase<EpiUp, pg8::StaticOrder, true, true>(ldsg, g, S, E); }
#endif
    xcd_barrier(xbar);
#if PH_MASK & 64
    act_phase(a, (int)blockIdx.x * 512 + tid, G * 512);
#endif
    xcd_barrier(xbar);
#if PH_MASK & 4096
    { pg8::Gemm g{(const bf16*)(ws + WS_UP) + DFF, (const bf16*)(ws + WS_WDOWN), T, DM, DFF, UPW}; pg8::StaticOrder S; S.init(T, DM, G, (int)blockIdx.x);
      EpiX2 E{a.out};
      pg8::gemm_phase<EpiX2, pg8::StaticOrder, true, true>(ldsg, g, S, E); }
#endif
    xcd_barrier(xbar);
#endif
#if PH_MASK & 128
    final_phase(a, gw, NGW, lane);
#endif
}

extern "C" void kernel_launch(void* const* d_in, const int* in_sizes, int n_in, void* d_out, int out_size, void* d_ws, size_t ws_size, hipStream_t stream) {
    static int grid = 0;
    if (grid == 0) {
        if (n_in != 31 || (size_t)out_size != O_END || ws_size < WS_END) { fprintf(stderr, "kernel_launch: unexpected shapes n_in %d out %d ws %zu\n", n_in, out_size, ws_size); grid = -1; return; }
        int dev = 0, cus = 0, per_cu = 0;
        hipGetDevice(&dev);
        hipDeviceGetAttribute(&cus, hipDeviceAttributeMultiprocessorCount, dev);
        hipFuncSetAttribute((const void*)fwd_kernel, hipFuncAttributeMaxDynamicSharedMemorySize, LDS_BYTES);
        hipOccupancyMaxActiveBlocksPerMultiprocessor(&per_cu, (const void*)fwd_kernel, 512, LDS_BYTES);
        if (per_cu < 1) { fprintf(stderr, "kernel_launch: occupancy query says %d blocks per CU\n", per_cu); per_cu = 1; }
        grid = cus * 1;
        if (grid != 256) { fprintf(stderr, "kernel_launch: built for a 256-CU device, got %d\n", cus); grid = -1; return; }
        (void)hipGetLastError();
    }
    if (grid < 0) return;
    if (hipMemsetAsync((char*)d_ws + WS_CTL, 0, 16384, stream) != hipSuccess) { fprintf(stderr, "kernel_launch: memset of the barrier words failed\n"); return; }
    Args a{};
    for (int i = 0; i < 31; ++i) a.in[i] = (const float*)d_in[i];
    a.out = (float*)d_out; a.ws = (unsigned char*)d_ws;
    void* args[] = {&a};
    hipError_t e = hipLaunchCooperativeKernel((const void*)fwd_kernel, dim3(grid), dim3(512), args, LDS_BYTES, stream);
    if (e != hipSuccess) fprintf(stderr, "cooperative launch failed: %s (grid %d)\n", hipGetErrorString(e), grid);
}
```

```cpp
#include <hip/hip_runtime.h>
#include <hip/hip_cooperative_groups.h>
#include <cstdio>
#include <cstdint>
namespace cg = cooperative_groups;
#define OLD_S5 5
#define DN_STAGED 3
namespace pg8 {
#define PG8_LAS __attribute__((address_space(3)))
typedef unsigned short bf16_t;
typedef short bf16x8 __attribute__((ext_vector_type(8)));
typedef float f32x4 __attribute__((ext_vector_type(4)));
typedef unsigned u32x4 __attribute__((ext_vector_type(4)));
constexpr int BM = 256, BK = 64, HALF = 128, HTB = HALF * BK * 2  , STAGE_BYTES = 8 * HTB, NXCD = 8, WGM = 8;

__host__ __device__ __forceinline__ int lds_byte(int r, int c) { const int st = (r >> 4) * 2 + (c >> 5), rr = r & 15, cc = c & 31, ob = rr * 64 + cc * 2; return st * 1024 + (ob ^ (((ob >> 9) & 1) << 5)); }
__host__ __device__ __forceinline__ void stage_rc(int b, int& R, int& C) { const int st = b / 1024, sb = b % 1024, swz = sb ^ (((sb >> 9) & 1) << 5); R = (st >> 1) * 16 + swz / 64; C = (st & 1) * 32 + (swz % 64) / 2; }
__host__ __device__ __forceinline__ int perm32(int rho) { const int n = rho >> 4, i = rho & 15; return 8 * (i >> 2) + 4 * n + (i & 3); }

struct Unit { int pm, pn; };
struct Gemm { const bf16_t* A; const bf16_t* Bt; int M, N, K, lda; };

struct StaticOrder {
    int nM, nN, nwg, G, c;
    __host__ __device__ void init(int M, int N, int G_, int c_) { nM = M / BM; nN = N / BM; nwg = nM * nN; G = G_; c = c_; }
    __host__ __device__ bool next(int i, Unit& u) const {
        const long L = (long)i * G + c; if (L >= nwg) return false;
        int wgid = (int)L; { const int q = nwg / NXCD, r = nwg % NXCD, xcd = wgid % NXCD, off = wgid / NXCD; wgid = (xcd < r ? xcd * (q + 1) : r * (q + 1) + (xcd - r) * q) + off; }
        const int nig = WGM * nN, gid = wgid / nig, fm = gid * WGM, gsz = (nM - fm) < WGM ? (nM - fm) : WGM;
        u.pm = fm + ((wgid % nig) % gsz); u.pn = (wgid % nig) / gsz; return true;
    }
    __device__ __forceinline__ void a_ready(const Unit&) const {}
    __device__ __forceinline__ void done(const Unit&) const {}
};
__device__ __forceinline__ unsigned cvt_pk_bf16(float lo, float hi) { unsigned r; asm volatile("v_cvt_pk_bf16_f32 %0, %1, %2" : "=v"(r) : "v"(lo), "v"(hi)); return r; }
typedef float f32x2 __attribute__((ext_vector_type(2)));
template <class Epi, class Sched, bool ALIGN_EPI = false, bool SP2 = false>
__device__ __forceinline__ void gemm_phase(PG8_LAS unsigned char* lds, const Gemm g, const Sched& S, const Epi& E) {
    int tid_ = threadIdx.x; asm volatile("" : "+v"(tid_));
    const int tid = tid_, wid = __builtin_amdgcn_readfirstlane(tid >> 6), lane = tid & 63, wr = wid >> 2, wc = wid & 3, fr = lane & 15, fq = lane >> 4;
    const int K = g.K, nt = K / BK;
    unsigned voffA[2], voffB[2];
#pragma unroll
    for (int i = 0; i < 2; ++i) { int R, C; stage_rc(tid * 16 + i * 8192, R, C); const int Rb = Epi::PERM ? ((R & ~31) + perm32(R & 31)) : R;
        voffA[i] = (unsigned)(R * g.lda + C) * 2u; voffB[i] = (unsigned)(Rb * K + C) * 2u; }
    const size_t kstep = (size_t)(BK * 2);
    const size_t hstep = (size_t)HALF * K * 2;
    const size_t tstep = 2 * hstep; const size_t hstepA = (size_t)HALF * g.lda * 2, tstepA = 2 * hstepA;
    const unsigned ldsw = (unsigned)wid * 1024u;
    const int aoff = lds_byte(wr * 64 + fr, fq * 8), boff = lds_byte(wc * 32 + fr, fq * 8);
#define PG8_SA(b, h) (((b) * 2 + (h)) * HTB)
#define PG8_SB(b, h) ((4 + (b) * 2 + (h)) * HTB)
#define PG8_STAGE(bufoff, gbase, voff) do { _Pragma("unroll") for (int _i = 0; _i < 2; ++_i) \
        __builtin_amdgcn_global_load_lds((const unsigned*)((const char*)(gbase) + (voff)[_i]), (PG8_LAS unsigned*)(lds + (bufoff) + ldsw + _i * 8192), 16, 0, 0); } while (0)
#define PG8_LDA(dst, b, h) do { _Pragma("unroll") for (int m = 0; m < 4; ++m) _Pragma("unroll") for (int k = 0; k < 2; ++k) dst[m][k] = *(const PG8_LAS bf16x8*)(lds + PG8_SA(b, h) + aoff + m * 2048 + k * 1024); } while (0)
#define PG8_LDB(dst, b, h) do { _Pragma("unroll") for (int n = 0; n < 2; ++n) _Pragma("unroll") for (int k = 0; k < 2; ++k) dst[n][k] = *(const PG8_LAS bf16x8*)(lds + PG8_SB(b, h) + boff + n * 2048 + k * 1024); } while (0)
#define PG8_MMA(ai, bj, At, Bt) do { __builtin_amdgcn_s_setprio(1); _Pragma("unroll") for (int m = 0; m < 4; ++m) _Pragma("unroll") for (int n = 0; n < 2; ++n) _Pragma("unroll") for (int k = 0; k < 2; ++k) \
        acc[ai][bj][m][n] = __builtin_amdgcn_mfma_f32_16x16x32_bf16(Bt[n][k], At[m][k], acc[ai][bj][m][n], 0, 0, 0); __builtin_amdgcn_s_setprio(0); } while (0)
#define PG8_WAIT_V(n) asm volatile("s_waitcnt vmcnt(" #n ")" ::: "memory")
#define PG8_WAIT_L(n) asm volatile("s_waitcnt lgkmcnt(" #n ")" ::: "memory")
#define PG8_BAR __builtin_amdgcn_s_barrier()
#define PG8_SCHED __builtin_amdgcn_sched_barrier(0)
    Unit cur, nxt; int ui = 0;
    if (!S.next(0, cur)) return;
    f32x4 acc[2][2][4][2];
#pragma unroll
    for (int a = 0; a < 2; ++a)
#pragma unroll
        for (int b = 0; b < 2; ++b)
#pragma unroll
            for (int m = 0; m < 4; ++m)
#pragma unroll
                for (int n = 0; n < 2; ++n) acc[a][b][m][n] = (f32x4){0.f, 0.f, 0.f, 0.f};
    bf16x8 At[4][2], B0[2][2], B1[2][2];
    const char* cA = (const char*)g.A + (size_t)cur.pm * tstepA; const char* cB = (const char*)g.Bt + (size_t)cur.pn * tstep;
    S.a_ready(cur);
    if constexpr (SP2) {
        PG8_STAGE(PG8_SB(0, 0), cB, voffB); PG8_STAGE(PG8_SB(0, 1), cB + hstep, voffB); PG8_STAGE(PG8_SA(0, 0), cA, voffA); PG8_STAGE(PG8_SA(0, 1), cA + hstepA, voffA);
        if (wr == 1) PG8_BAR;
        PG8_WAIT_V(2); PG8_BAR;
        PG8_STAGE(PG8_SB(1, 0), cB + kstep, voffB); PG8_STAGE(PG8_SA(1, 0), cA + kstep, voffA); PG8_STAGE(PG8_SB(1, 1), cB + hstep + kstep, voffB);
        PG8_WAIT_V(6); PG8_BAR;
    } else {
        PG8_STAGE(PG8_SB(0, 0), cB, voffB); PG8_STAGE(PG8_SA(0, 0), cA, voffA); PG8_STAGE(PG8_SB(0, 1), cB + hstep, voffB); PG8_STAGE(PG8_SA(0, 1), cA + hstepA, voffA);
        if (wr == 1) PG8_BAR;
        PG8_WAIT_V(4); PG8_BAR;
        PG8_STAGE(PG8_SB(1, 0), cB + kstep, voffB); PG8_STAGE(PG8_SA(1, 0), cA + kstep, voffA); PG8_STAGE(PG8_SB(1, 1), cB + hstep + kstep, voffB);
        PG8_WAIT_V(6); PG8_BAR;
    }
    for (;;) {
        const bool has_next = S.next(ui + 1, nxt);
        const char* nA = has_next ? (const char*)g.A + (size_t)nxt.pm * tstepA : cA; const char* nB = has_next ? (const char*)g.Bt + (size_t)nxt.pn * tstep : cB;
        for (int t = 0; t < nt; t += 2) {
            const bool last = (t == nt - 2);
            const char* a1 = cA + (size_t)(t + 1) * kstep;
            const char* a2 = last ? nA : cA + (size_t)(t + 2) * kstep; const char* b2 = last ? nB : cB + (size_t)(t + 2) * kstep;
            const char* a3 = a2 + kstep; const char* b3 = b2 + kstep;
            if (last && has_next) S.a_ready(nxt);
            if constexpr (SP2) {
            PG8_LDB(B0, 0, 0); PG8_LDB(B1, 0, 1); PG8_SCHED; PG8_LDA(At, 0, 0); PG8_STAGE(PG8_SA(1, 1), a1 + hstepA, voffA);
            PG8_WAIT_V(8); PG8_WAIT_L(0); PG8_BAR; PG8_MMA(0, 0, At, B0); PG8_MMA(0, 1, At, B1); PG8_BAR; PG8_SCHED;
            PG8_LDA(At, 0, 1); PG8_STAGE(PG8_SB(0, 0), b2, voffB); PG8_STAGE(PG8_SB(0, 1), b2 + hstep, voffB); PG8_STAGE(PG8_SA(0, 0), a2, voffA);
            PG8_WAIT_V(8); PG8_WAIT_L(0); PG8_BAR; PG8_MMA(1, 0, At, B0); PG8_MMA(1, 1, At, B1); PG8_BAR; PG8_SCHED;
            PG8_LDB(B0, 1, 0); PG8_LDB(B1, 1, 1); PG8_SCHED; PG8_LDA(At, 1, 0); PG8_STAGE(PG8_SA(0, 1), a2 + hstepA, voffA);
            PG8_WAIT_V(8); PG8_WAIT_L(0); PG8_BAR; PG8_MMA(0, 0, At, B0); PG8_MMA(0, 1, At, B1); PG8_BAR; PG8_SCHED;
            PG8_LDA(At, 1, 1); PG8_STAGE(PG8_SB(1, 0), b3, voffB); PG8_STAGE(PG8_SB(1, 1), b3 + hstep, voffB); PG8_STAGE(PG8_SA(1, 0), a3, voffA);
            PG8_WAIT_V(8); PG8_WAIT_L(0); PG8_BAR; PG8_MMA(1, 0, At, B0); PG8_MMA(1, 1, At, B1); PG8_BAR; PG8_SCHED;
            } else {
            PG8_LDB(B0, 0, 0); PG8_SCHED; PG8_LDA(At, 0, 0); PG8_STAGE(PG8_SA(1, 1), a1 + hstepA, voffA);
            PG8_WAIT_L(8); PG8_BAR; PG8_WAIT_L(0); PG8_MMA(0, 0, At, B0); PG8_BAR; PG8_SCHED;
            PG8_LDB(B1, 0, 1); PG8_STAGE(PG8_SB(0, 0), b2, voffB);
            PG8_BAR; PG8_WAIT_L(0); PG8_MMA(0, 1, At, B1); PG8_BAR;
            PG8_LDA(At, 0, 1); PG8_STAGE(PG8_SA(0, 0), a2, voffA);
            PG8_BAR; PG8_WAIT_L(0); PG8_MMA(1, 0, At, B0); PG8_BAR; PG8_SCHED;
            PG8_STAGE(PG8_SB(0, 1), b2 + hstep, voffB);
            PG8_WAIT_V(6); PG8_BAR; PG8_MMA(1, 1, At, B1); PG8_BAR;
            PG8_LDB(B0, 1, 0); PG8_SCHED; PG8_LDA(At, 1, 0); PG8_STAGE(PG8_SA(0, 1), a2 + hstepA, voffA);
            PG8_WAIT_L(8); PG8_BAR; PG8_WAIT_L(0); PG8_MMA(0, 0, At, B0); PG8_BAR; PG8_SCHED;
            PG8_LDB(B1, 1, 1); PG8_STAGE(PG8_SB(1, 0), b3, voffB);
            PG8_BAR; PG8_WAIT_L(0); PG8_MMA(0, 1, At, B1); PG8_BAR;
            PG8_LDA(At, 1, 1); PG8_STAGE(PG8_SA(1, 0), a3, voffA);
            PG8_BAR; PG8_WAIT_L(0); PG8_MMA(1, 0, At, B0); PG8_BAR; PG8_SCHED;
            PG8_STAGE(PG8_SB(1, 1), b3 + hstep, voffB);
            PG8_WAIT_V(6); PG8_BAR; PG8_MMA(1, 1, At, B1); PG8_BAR;
            }
        }
        if constexpr (ALIGN_EPI) { if (wr == 0) PG8_BAR; }
        if constexpr (!Epi::AFTER_DRAIN) { E(acc, cur, wr, wc, fr, fq); S.done(cur); }
        if (!has_next) break;
#pragma unroll
        for (int a = 0; a < 2; ++a)
#pragma unroll
            for (int b = 0; b < 2; ++b)
#pragma unroll
                for (int m = 0; m < 4; ++m)
#pragma unroll
                    for (int n = 0; n < 2; ++n) acc[a][b][m][n] = (f32x4){0.f, 0.f, 0.f, 0.f};
        cur = nxt; cA = nA; cB = nB; ++ui;
        if constexpr (ALIGN_EPI) { if (wr == 1) PG8_BAR; }
    }
    PG8_WAIT_V(0);
    if constexpr (!ALIGN_EPI) { if (wr == 0) PG8_BAR; }
    PG8_BAR;
    if constexpr (Epi::AFTER_DRAIN) { E.fused(acc, cur, wr, wc, fr, fq, lds, wid, lane); S.done(cur); }
#undef PG8_SA
#undef PG8_SB
#undef PG8_STAGE
#undef PG8_LDA
#undef PG8_LDB
#undef PG8_MMA
#undef PG8_WAIT_V
#undef PG8_WAIT_L
#undef PG8_BAR
#undef PG8_SCHED
}
}
#define LAS __attribute__((address_space(3)))
#define XB_TMO      128
#define XB_XCNT(j)  (256  + 64 * (j))
#define XB_XSUB(j)  (1280 + 64 * (j))
#define XB_XGEN(j)  (2304 + 64 * (j))
#define XB_TOP      3328
#define XB_TOPGEN   3392
#define XCD_BAR_WORDS 3456
#define XB_SPIN_CAP (1u << 18)

__device__ __forceinline__ unsigned xb_ld(unsigned* p)              { return __hip_atomic_load(p, __ATOMIC_RELAXED, __HIP_MEMORY_SCOPE_AGENT); }
__device__ __forceinline__ unsigned xb_add(unsigned* p, unsigned v) { return __hip_atomic_fetch_add(p, v, __ATOMIC_RELAXED, __HIP_MEMORY_SCOPE_AGENT); }
__device__ __forceinline__ unsigned xb_xcc_id() { return (unsigned)__builtin_amdgcn_s_getreg((3 << 11) | 20) & 0xFu; }
#define XB_SPIN(cond, bar) do { unsigned _sp = 0; while (cond) { __builtin_amdgcn_s_sleep(1); \
    if ((++_sp & 255u) == 0u) { if (xb_ld(&(bar)[XB_TMO])) break; if (_sp > XB_SPIN_CAP) { atomicAdd(&(bar)[XB_TMO], 1u); break; } } } } while (0)

struct XcdBarrier {
    unsigned* bar; unsigned x;
    volatile LAS unsigned* st;
};

__device__ __forceinline__ XcdBarrier xcd_barrier_post(unsigned* bar, volatile LAS unsigned* st) {
    XcdBarrier b; b.bar = bar; b.x = xb_xcc_id(); b.st = st;
    if (threadIdx.x == 0) (void)xb_add(&bar[XB_XCNT(b.x)], 1u);
    return b;
}
__device__ __forceinline__ void xcd_barrier_complete(unsigned* bar, unsigned x, unsigned& nloc, unsigned& nx) {
    const unsigned G = gridDim.x * gridDim.y * gridDim.z;
    unsigned sum, cnt, mine, sp = 0u;
    for (;;) {
        sum = 0u; cnt = 0u; mine = 0u;
#pragma unroll
        for (unsigned j = 0; j < 16; ++j) { const unsigned c = xb_ld(&bar[XB_XCNT(j)]); sum += c; cnt += (c > 0u) ? 1u : 0u; mine = (j == x) ? c : mine; }
        if (sum == G) break;
        __builtin_amdgcn_s_sleep(1);
        if ((++sp & 255u) == 0u) { if (xb_ld(&bar[XB_TMO])) break; if (sp > XB_SPIN_CAP) { atomicAdd(&bar[XB_TMO], 1u); break; } }
    }
    nloc = mine > 0u ? mine : 1u; nx = cnt > 0u ? cnt : 1u;
}

__device__ __forceinline__ void xcd_barrier(const XcdBarrier& b) {
    asm volatile("s_waitcnt vmcnt(0)" ::: "memory");
    __syncthreads();
    if (threadIdx.x == 0) {
        unsigned* bar = b.bar;
        __builtin_amdgcn_s_waitcnt(0);
        unsigned nloc = b.st[0], nx = b.st[1];
        if (nloc == 0u) { xcd_barrier_complete(bar, b.x, nloc, nx); b.st[0] = nloc; b.st[1] = nx; }
        const unsigned old = xb_add(&bar[XB_XSUB(b.x)], 1u);
        const unsigned gen = old / nloc;
        if (old + 1u == (gen + 1u) * nloc) {
            __builtin_amdgcn_fence(__ATOMIC_RELEASE, "agent");
            asm volatile("s_waitcnt vmcnt(0)" ::: "memory");
            const unsigned og = xb_add(&bar[XB_TOP], 1u);
            const unsigned tg = og / nx;
            if (og + 1u == (tg + 1u) * nx) xb_add(&bar[XB_TOPGEN], 1u);
            else XB_SPIN(xb_ld(&bar[XB_TOPGEN]) == tg, bar);
            __builtin_amdgcn_fence(__ATOMIC_ACQUIRE, "agent");
            xb_add(&bar[XB_XGEN(b.x)], 1u);
            asm volatile("s_waitcnt vmcnt(0)" ::: "memory");
        } else {
            XB_SPIN(xb_ld(&bar[XB_XGEN(b.x)]) == gen, bar);
            __builtin_amdgcn_fence(__ATOMIC_ACQUIRE, "agent");
            asm volatile("s_waitcnt vmcnt(0)" ::: "memory");
        }
    }
    __syncthreads();
}


#ifndef FUSE_ACT
#define FUSE_ACT 1
#endif
#ifndef DN_STAGED
#define DN_STAGED 1
#endif
#ifndef DIAG_Y
#define DIAG_Y 0
#endif
#ifndef OLD_S5
#define OLD_S5 0
#endif
#if OLD_S5 == 3
#define OLD_S5_ULIM 8192
#else
#define OLD_S5_ULIM (4 * 32 * 64 + 32 * 32)
#endif
#define DI __device__ __forceinline__
typedef unsigned short bf16;
typedef float f32x4 __attribute__((ext_vector_type(4)));
typedef float f32x2 __attribute__((ext_vector_type(2)));
typedef short bf16x8 __attribute__((ext_vector_type(8)));
typedef unsigned u32x4 __attribute__((ext_vector_type(4)));
typedef unsigned u32x2 __attribute__((ext_vector_type(2)));
typedef __bf16 bf16x2_t __attribute__((ext_vector_type(2)));

DI unsigned pk2(float lo, float hi) { f32x2 v = {lo, hi}; bf16x2_t b = __builtin_convertvector(v, bf16x2_t); return __builtin_bit_cast(unsigned, b); }
DI bf16 f2b(float x) { return (bf16)(pk2(x, 0.f) & 0xffffu); }
DI float b2f(unsigned b) { return __uint_as_float(b << 16); }
DI float blo(unsigned w) { return __uint_as_float(w << 16); }
DI float bhi(unsigned w) { return __uint_as_float(w & 0xffff0000u); }
DI float wave_sum(float v) {
#pragma unroll
    for (int o = 1; o < 64; o <<= 1) v += __shfl_xor(v, o);
    return v;
}
DI float sigm(float x) { return __builtin_amdgcn_rcpf(1.f + __expf(-x)); }
DI float silu(float x) { return x * __builtin_amdgcn_rcpf(1.f + __expf(-x)); }
DI float gelu_tanh(float x) { const float z = 1.5957691216057308f * (x + 0.044715f * x * x * x); return x * __builtin_amdgcn_rcpf(1.f + __expf(-z)); }
#define MFMA16(a, b, c) __builtin_amdgcn_mfma_f32_16x16x32_bf16((a), (b), (c), 0, 0, 0)

constexpr int TP = 32768, TS = 512, T = TP + TS;
constexpr int DM = 1024, PW = 2560, NIN = 2816, DFF = 2816, UPW = 5632;
constexpr float EPS = 1e-6f;
constexpr int NCH = 2048 + 128;
constexpr int REC = 73728;
constexpr int R_WN = 0, R_QG = 16384, R_KDT = 32768, R_QK = 49152, R_U0 = 57344;
constexpr size_t O_Y = 0, O_PDC = (size_t)T * DM, O_PDS = O_PDC + 4 * 3 * 1536, O_PSR = O_PDS + 4 * 4 * 128 * 128, O_PSI = O_PSR + 4 * 32 * 64,
                 O_PFC = O_PSI + 4 * 32 * 64, O_SDC = O_PFC + 4 * 2 * 2816, O_SDS = O_SDC + 32 * 3 * 1536, O_SSR = O_SDS + (size_t)32 * 4 * 128 * 128,
                 O_SSI = O_SSR + 32 * 32 * 64, O_SFC = O_SSI + 32 * 32 * 64, O_END = O_SFC + 32 * 2 * 2816;
constexpr size_t MiB = 1u << 20;
constexpr size_t WS_SS2 = 0;
constexpr size_t WS_EG = 3 * MiB;
constexpr size_t WS_CTL = 5 * MiB + 512 * 1024;
constexpr size_t WS_BA = 4 * MiB;
constexpr size_t WS_WIN = 6 * MiB, WS_WGLU = 12 * MiB, WS_WOUT = 13 * MiB, WS_WUP = 15 * MiB, WS_WDOWN = 26 * MiB;
constexpr size_t WS_H = 32 * MiB;
constexpr size_t WS_P = 98 * MiB;
constexpr size_t WS_DNC = 262 * MiB;
constexpr size_t WS_Y5 = 416 * MiB, WS_GLU = 449 * MiB, WS_S5E = 482 * MiB, WS_END = 487 * MiB;
constexpr size_t WS_GH = 300 * MiB, WS_GT = 324 * MiB, WS_VH = 348 * MiB;
constexpr size_t WS_UP = 98 * MiB;
static_assert(WS_UP + (size_t)T * UPW * 2 <= WS_END && WS_P + (size_t)T * PW * 2 <= WS_DNC && WS_DNC + (size_t)NCH * REC <= WS_Y5, "ws map");
constexpr int LDS_BYTES = 147456;

struct Args { const float* in[31]; float* out; unsigned char* ws; };

DI int colmap(int mode, int n) {
    if (mode == 0) return n;
    if (mode == 1) return n < 2048 ? n : (n < 2560 ? n + 8 : (n < 2568 ? n - 512 : -1));
    const int pn = n >> 8, bj = (n >> 7) & 1, j = n & 127;
    return bj * (mode == 2 ? 512 : 2816) + 128 * pn + j;
}
DI void transpose_item(const float* W, int K, int N, bf16* WT, float* scr, int kb, int nb, int lane, int mode, const float* rs) {
    const int k0 = 64 * kb, n0 = 32 * nb;
    const int sc = colmap(mode, n0 + (lane & 31));
    float tv[32];
#pragma unroll
    for (int i = 0; i < 32; ++i) { const int kk = 2 * i + (lane >> 5); tv[i] = 0.f; if (sc >= 0) tv[i] = W[(size_t)(k0 + kk) * N + sc]; }
#pragma unroll
    for (int i = 0; i < 32; ++i) { const int kk = 2 * i + (lane >> 5); float v = tv[i]; if (rs) v *= rs[k0 + kk]; scr[kk * 33 + (lane & 31)] = v; }
    asm volatile("s_waitcnt lgkmcnt(0)" ::: "memory");
    const int c = lane & 7;
#pragma unroll
    for (int j = 0; j < 4; ++j) { const int n = (lane >> 3) + 8 * j; const float* s = scr + (8 * c) * 33 + n;
        u32x4 o; o.x = pk2(s[0 * 33], s[1 * 33]); o.y = pk2(s[2 * 33], s[3 * 33]); o.z = pk2(s[4 * 33], s[5 * 33]); o.w = pk2(s[6 * 33], s[7 * 33]);
        *(u32x4*)(WT + (size_t)(n0 + n) * K + k0 + 8 * c) = o; }
    asm volatile("s_waitcnt lgkmcnt(0)" ::: "memory");
}
DI void phase0(const Args& a, unsigned char* lds, int gw, int NGW, int wave, int lane) {
    asm volatile("" : "+v"(lane));
    unsigned char* ws = a.ws;
    float* scr = (float*)(lds + wave * 16384);
    constexpr int I_IN = 16 * (NIN / 32), I_GLU = 8 * 32, I_OUT = 16 * 32, I_UP = 16 * (UPW / 32), I_DN = 44 * 32;
    constexpr int NIT = I_IN + I_GLU + I_OUT + I_UP + I_DN;
    for (int it = gw; it < NIT; it += NGW) {
        int r = it;
        if (r < I_IN) { transpose_item(a.in[8], 1024, 2568, (bf16*)(ws + WS_WIN), scr, r / (NIN / 32), r % (NIN / 32), lane, 1, nullptr); continue; } r -= I_IN;
        if (r < I_GLU) { transpose_item(a.in[21], 512, 1024, (bf16*)(ws + WS_WGLU), scr, r / 32, r % 32, lane, 2, nullptr); continue; } r -= I_GLU;
        if (r < I_OUT) { transpose_item(a.in[24], 1024, 1024, (bf16*)(ws + WS_WOUT), scr, r / 32, r % 32, lane, 0, nullptr); continue; } r -= I_OUT;
        if (r < I_UP) { transpose_item(a.in[26], 1024, 5632, (bf16*)(ws + WS_WUP), scr, r / (UPW / 32), r % (UPW / 32), lane, 3, a.in[25]); continue; } r -= I_UP;
        transpose_item(a.in[29], 2816, 1024, (bf16*)(ws + WS_WDOWN), scr, r / 32, r % 32, lane, 0, nullptr);
    }
    const float* g1 = a.in[7];
    f32x4 gv[4];
#pragma unroll
    for (int j = 0; j < 4; ++j) gv[j] = ((const f32x4*)g1)[lane + 64 * j];
    bf16* H = (bf16*)(ws + WS_H);
    for (int m0 = gw; m0 < T; m0 += 2 * NGW) {
        const int m1 = m0 + NGW < T ? m0 + NGW : m0;
        const f32x4* xr0 = (const f32x4*)(m0 < TP ? a.in[0] + (size_t)m0 * DM : a.in[1] + (size_t)(m0 - TP) * DM) + lane;
        const f32x4* xr1 = (const f32x4*)(m1 < TP ? a.in[0] + (size_t)m1 * DM : a.in[1] + (size_t)(m1 - TP) * DM) + lane;
        f32x4 v0[4], v1[4]; float s0 = 0.f, s1 = 0.f;
#pragma unroll
        for (int j = 0; j < 4; ++j) { v0[j] = xr0[64 * j]; v1[j] = xr1[64 * j]; }
#pragma unroll
        for (int j = 0; j < 4; ++j) { s0 += (v0[j].x * v0[j].x + v0[j].y * v0[j].y) + (v0[j].z * v0[j].z + v0[j].w * v0[j].w); s1 += (v1[j].x * v1[j].x + v1[j].y * v1[j].y) + (v1[j].z * v1[j].z + v1[j].w * v1[j].w); }
        const float r0 = rsqrtf(wave_sum(s0) * (1.f / DM) + EPS), r1 = rsqrtf(wave_sum(s1) * (1.f / DM) + EPS);
        u32x2* o0 = (u32x2*)(H + (size_t)m0 * DM) + lane; u32x2* o1 = (u32x2*)(H + (size_t)m1 * DM) + lane;
#pragma unroll
        for (int j = 0; j < 4; ++j) { u32x2 o; o.x = pk2(v0[j].x * r0 * gv[j].x, v0[j].y * r0 * gv[j].y); o.y = pk2(v0[j].z * r0 * gv[j].z, v0[j].w * r0 * gv[j].w); o0[64 * j] = o; }
        if (m1 != m0) {
#pragma unroll
            for (int j = 0; j < 4; ++j) { u32x2 o; o.x = pk2(v1[j].x * r1 * gv[j].x, v1[j].y * r1 * gv[j].y); o.y = pk2(v1[j].z * r1 * gv[j].z, v1[j].w * r1 * gv[j].w); o1[64 * j] = o; }
        }
    }
}

struct EpiP {
    static constexpr bool PERM = true, AFTER_DRAIN = false;
    bf16* P; float* BA;
    DI void operator()(const pg8::f32x4 (&acc)[2][2][4][2], const pg8::Unit& u, int wr, int wc, int fr, int fq) const {
        const int row0 = u.pm * 256 + wr * 64 + fr;
        if (u.pn < 10) {
            const int col0 = u.pn * 256 + wc * 32 + 8 * fq;
#pragma unroll
            for (int ai = 0; ai < 2; ++ai)
#pragma unroll
                for (int m = 0; m < 4; ++m) { bf16* rowp = P + (size_t)(row0 + ai * 128 + m * 16) * PW + col0;
#pragma unroll
                    for (int bj = 0; bj < 2; ++bj) { const pg8::f32x4 v0 = acc[ai][bj][m][0], v1 = acc[ai][bj][m][1];
                        u32x4 w; w.x = pk2(v0[0], v0[1]); w.y = pk2(v0[2], v0[3]); w.z = pk2(v1[0], v1[1]); w.w = pk2(v1[2], v1[3]);
                        *(u32x4*)(rowp + bj * 128) = w; } }
        } else if (wc == 0 && fq == 0) {
#pragma unroll
            for (int ai = 0; ai < 2; ++ai)
#pragma unroll
                for (int m = 0; m < 4; ++m) { float* bp = BA + (size_t)(row0 + ai * 128 + m * 16) * 8;
                    *(pg8::f32x4*)bp = acc[ai][0][m][0]; *(pg8::f32x4*)(bp + 4) = acc[ai][0][m][1]; }
        }
    }
};
struct EpiGlu {
    static constexpr bool PERM = true, AFTER_DRAIN = false;
    bf16* O; const float* gb;
    DI void operator()(const pg8::f32x4 (&acc)[2][2][4][2], const pg8::Unit& u, int wr, int wc, int fr, int fq) const {
        const int row0 = u.pm * 256 + wr * 64 + fr, col0 = u.pn * 128 + wc * 32 + 8 * fq;
        const pg8::f32x4 ba0 = *(const pg8::f32x4*)(gb + col0), ba1 = *(const pg8::f32x4*)(gb + col0 + 4), bg0 = *(const pg8::f32x4*)(gb + 512 + col0), bg1 = *(const pg8::f32x4*)(gb + 512 + col0 + 4);
#pragma unroll
        for (int ai = 0; ai < 2; ++ai)
#pragma unroll
            for (int m = 0; m < 4; ++m) {
                const pg8::f32x4 a0 = acc[ai][0][m][0] + ba0, a1 = acc[ai][0][m][1] + ba1, g0 = acc[ai][1][m][0] + bg0, g1 = acc[ai][1][m][1] + bg1;
                float o[8];
#pragma unroll
                for (int e = 0; e < 4; ++e) { o[e] = a0[e] * sigm(g0[e]); o[4 + e] = a1[e] * sigm(g1[e]); }
                u32x4 w; w.x = pk2(o[0], o[1]); w.y = pk2(o[2], o[3]); w.z = pk2(o[4], o[5]); w.w = pk2(o[6], o[7]);
                *(u32x4*)(O + (size_t)(row0 + ai * 128 + m * 16) * 512 + col0) = w;
            }
    }
};
struct EpiX1 {
    static constexpr bool PERM = false, AFTER_DRAIN = false;
    const float* xp; const float* xs; float* out; bf16* xb; float* ss2;
    DI void operator()(const pg8::f32x4 (&acc)[2][2][4][2], const pg8::Unit& u, int wr, int wc, int fr, int fq) const {
        const int row0 = u.pm * 256 + wr * 64 + fr, col0 = u.pn * 256 + wc * 32 + 4 * fq;
#pragma unroll
        for (int ai = 0; ai < 2; ++ai)
#pragma unroll
            for (int m = 0; m < 4; ++m) {
                const int row = row0 + ai * 128 + m * 16;
                const float* xr = (row < TP ? xp + (size_t)row * DM : xs + (size_t)(row - TP) * DM) + col0;
                float ss = 0.f;
#pragma unroll
                for (int bj = 0; bj < 2; ++bj)
#pragma unroll
                    for (int n = 0; n < 2; ++n) {
                        const pg8::f32x4 v = *(const pg8::f32x4*)(xr + bj * 128 + n * 16) + acc[ai][bj][m][n];
                        *(pg8::f32x4*)(out + (size_t)row * DM + col0 + bj * 128 + n * 16) = v;
                        u32x2 w; w.x = pk2(v[0], v[1]); w.y = pk2(v[2], v[3]);
                        *(u32x2*)(xb + (size_t)row * DM + col0 + bj * 128 + n * 16) = w;
                        ss += (v[0] * v[0] + v[1] * v[1]) + (v[2] * v[2] + v[3] * v[3]);
                    }
                ss += __shfl_xor(ss, 16); ss += __shfl_xor(ss, 32);
                if (fq == 0) ss2[(size_t)row * 16 + u.pn * 4 + wc] = ss;
            }
    }
};
struct EpiUp {
    static constexpr bool PERM = true, AFTER_DRAIN = false;
    bf16* UP; const float* ss2;
    DI void operator()(const pg8::f32x4 (&acc)[2][2][4][2], const pg8::Unit& u, int wr, int wc, int fr, int fq) const {
        const int row0 = u.pm * 256 + wr * 64 + fr, col0 = u.pn * 128 + wc * 32 + 8 * fq;
#pragma unroll
        for (int ai = 0; ai < 2; ++ai)
#pragma unroll
            for (int m = 0; m < 4; ++m) {
                const int row = row0 + ai * 128 + m * 16;
                const pg8::f32x4* sp = (const pg8::f32x4*)(ss2 + (size_t)row * 16);
                const pg8::f32x4 s0 = sp[0], s1 = sp[1], s2 = sp[2], s3 = sp[3];
                const float tot = ((s0[0] + s0[1]) + (s0[2] + s0[3])) + ((s1[0] + s1[1]) + (s1[2] + s1[3])) + ((s2[0] + s2[1]) + (s2[2] + s2[3])) + ((s3[0] + s3[1]) + (s3[2] + s3[3]));
                const float r = rsqrtf(tot * (1.f / DM) + EPS);
                bf16* rowp = UP + (size_t)row * UPW + col0;
#pragma unroll
                for (int bj = 0; bj < 2; ++bj) { const pg8::f32x4 v0 = acc[ai][bj][m][0] * r, v1 = acc[ai][bj][m][1] * r;
                    u32x4 w; w.x = pk2(v0[0], v0[1]); w.y = pk2(v0[2], v0[3]); w.z = pk2(v1[0], v1[1]); w.w = pk2(v1[2], v1[3]);
                    *(u32x4*)(rowp + bj * DFF) = w; }
            }
    }
};
DI float dpp_shr1(float v) { return __int_as_float(__builtin_amdgcn_update_dpp(0, __float_as_int(v), 0x111, 0xf, 0xf, false)); }
DI float dpp_shr2(float v) { return __int_as_float(__builtin_amdgcn_update_dpp(0, __float_as_int(v), 0x112, 0xf, 0xf, false)); }
struct EpiUpAct {
    static constexpr bool PERM = true, AFTER_DRAIN = false;
    bf16* ACT; bf16* GH; bf16* GT; bf16* VH; const float* ss2; const float* fw; const float* fb;
    DI void operator()(const pg8::f32x4 (&acc)[2][2][4][2], const pg8::Unit& u, int wr, int wc, int fr, int fq) const {
        const int row0 = u.pm * 256 + wr * 64 + fr, col0 = u.pn * 128 + wc * 32 + 8 * fq;
        float w0[8], w1[8], w2[8], bb[8];
#pragma unroll
        for (int n = 0; n < 2; ++n) { const pg8::f32x4 a0 = *(const pg8::f32x4*)(fw + col0 + 4 * n), a1 = *(const pg8::f32x4*)(fw + DFF + col0 + 4 * n), a2 = *(const pg8::f32x4*)(fw + 2 * DFF + col0 + 4 * n), a3 = *(const pg8::f32x4*)(fb + col0 + 4 * n);
#pragma unroll
            for (int e = 0; e < 4; ++e) { w0[4 * n + e] = a0[e]; w1[4 * n + e] = a1[e]; w2[4 * n + e] = a2[e]; bb[4 * n + e] = a3[e]; } }
#pragma unroll
        for (int ai = 0; ai < 2; ++ai)
#pragma unroll
            for (int m = 0; m < 4; ++m) {
                const int row = row0 + ai * 128 + m * 16, grp = row >> 4;
                const pg8::f32x4* sp = (const pg8::f32x4*)(ss2 + (size_t)row * 16);
                const pg8::f32x4 s0 = sp[0], s1 = sp[1], s2 = sp[2], s3 = sp[3];
                const float tot = ((s0[0] + s0[1]) + (s0[2] + s0[3])) + ((s1[0] + s1[1]) + (s1[2] + s1[3])) + ((s2[0] + s2[1]) + (s2[2] + s2[3])) + ((s3[0] + s3[1]) + (s3[2] + s3[3]));
                const float r = rsqrtf(tot * (1.f / DM) + EPS);
                float gs[8], vv[8], o[8];
#pragma unroll
                for (int n = 0; n < 2; ++n)
#pragma unroll
                    for (int e = 0; e < 4; ++e) { gs[4 * n + e] = acc[ai][0][m][n][e] * r; vv[4 * n + e] = acc[ai][1][m][n][e] * r; }
#pragma unroll
                for (int e = 0; e < 8; ++e) { const float g1 = dpp_shr1(gs[e]), g2 = dpp_shr2(gs[e]); o[e] = silu(g2 * w0[e] + g1 * w1[e] + gs[e] * w2[e] + bb[e]) * vv[e]; }
                u32x4 wg; wg.x = pk2(gs[0], gs[1]); wg.y = pk2(gs[2], gs[3]); wg.z = pk2(gs[4], gs[5]); wg.w = pk2(gs[6], gs[7]);
                if (fr >= 2) { u32x4 w; w.x = pk2(o[0], o[1]); w.y = pk2(o[2], o[3]); w.z = pk2(o[4], o[5]); w.w = pk2(o[6], o[7]);
                    *(u32x4*)(ACT + (size_t)row * DFF + col0) = w; }
                else { u32x4 wv; wv.x = pk2(vv[0], vv[1]); wv.y = pk2(vv[2], vv[3]); wv.z = pk2(vv[4], vv[5]); wv.w = pk2(vv[6], vv[7]);
                    *(u32x4*)(GH + ((size_t)grp * 2 + fr) * DFF + col0) = wg; *(u32x4*)(VH + ((size_t)grp * 2 + fr) * DFF + col0) = wv; }
                if (fr >= 14) *(u32x4*)(GT + ((size_t)grp * 2 + (fr - 14)) * DFF + col0) = wg;
            }
    }
};
struct EpiX2 {
    static constexpr bool PERM = false, AFTER_DRAIN = false;
    float* out;
    DI void operator()(const pg8::f32x4 (&acc)[2][2][4][2], const pg8::Unit& u, int wr, int wc, int fr, int fq) const {
        const int row0 = u.pm * 256 + wr * 64 + fr, col0 = u.pn * 256 + wc * 32 + 4 * fq;
#pragma unroll
        for (int ai = 0; ai < 2; ++ai)
#pragma unroll
            for (int m = 0; m < 4; ++m) {
                float* orow = out + (size_t)(row0 + ai * 128 + m * 16) * DM + col0;
#pragma unroll
                for (int bj = 0; bj < 2; ++bj)
#pragma unroll
                    for (int n = 0; n < 2; ++n) { pg8::f32x4* p = (pg8::f32x4*)(orow + bj * 128 + n * 16); *p = *p + acc[ai][bj][m][n]; }
            }
    }
};

DI int kperm(int k) { return (k & ~31) | (((k >> 2) & 3) << 3) | (((k >> 4) & 1) << 2) | (k & 3); }
DI void conv_col(const bf16* pcol, float h0, float h1, float h2, const float* cw, int nrows, float* outp, float (&val)[64]) {
    const float w0 = cw[0], w1 = cw[1536], w2 = cw[2 * 1536], w3 = cw[3 * 1536];
    float x3 = h0, x2 = h1, x1 = h2;
#pragma unroll
    for (int r = 0; r < 64; ++r) {
        float x0 = 0.f;
        if (r < nrows) x0 = b2f(pcol[(size_t)r * PW]);
        const float c = x3 * w0 + x2 * w1 + x1 * w2 + x0 * w3;
        val[r] = r < nrows ? silu(c) : 0.f;
        if (outp && r >= nrows - 3 && r < nrows) outp[(r - (nrows - 3)) * 1536] = x0;
        x3 = x2; x2 = x1; x1 = x0;
    }
}
DI void dn_chunk_phase(const Args& a, unsigned char* lds, int tid, int it0, int it1, int its) {
    unsigned char* ws = a.ws;
    const bf16* P = (const bf16*)(ws + WS_P);
    const float* BA = (const float*)(ws + WS_BA);
    const float* cwt = a.in[9];
    constexpr float QSCALE = 0.08838834764831845f;
    for (int it = it0; it < it1; it += its) {
        int tl = tid; asm volatile("" : "+v"(tl));
        const int half = __builtin_amdgcn_readfirstlane(tl >> 8), t8 = tl & 255, hw = __builtin_amdgcn_readfirstlane((tl >> 6) & 3), lane = tl & 63, fr = lane & 15, fq = lane >> 4;
        unsigned char* L = lds + half * 53248;
        unsigned char* qb = L; unsigned char* kb = L + 17408;
        float* Am = (float*)(L + 34816);
        float* Gs = (float*)(L + 51200); float* Bs = Gs + 64; float* RQ = Gs + 128; float* RK = Gs + 192; float* EG = Gs + 256;
        const int unit = it * 2 + half;
        int row0, nrows, h, bidx; bool sample, first, lastc;
        if (unit < 2048) { const int b = unit >> 9, n = unit & 127; h = (unit >> 7) & 3; row0 = b * 8192 + n * 64; nrows = 64; sample = false; first = (n == 0); lastc = (n == 127); bidx = b; }
        else { const int su = unit - 2048; bidx = su >> 2; h = su & 3; row0 = TP + bidx * 16; nrows = 16; sample = true; first = false; lastc = true; }
        unsigned char* rec = ws + WS_DNC + (size_t)unit * REC;
        if (hw == 0) {
            float g = 0.f, be = 0.f;
            if (lane < nrows) {
                const float* bp = BA + (size_t)(row0 + lane) * 8;
                be = sigm(bp[h]);
                const float xx = bp[4 + h] + a.in[11][h];
                const float sp = xx > 20.f ? xx : log1pf(__expf(xx));
                g = -__expf(a.in[10][h]) * sp;
            }
#pragma unroll
            for (int o = 1; o < 64; o <<= 1) { const float v = __shfl_up(g, o); if (lane >= o) g += v; }
            Gs[lane] = g; Bs[lane] = be; EG[lane] = __expf(g);
            if (lane == 63) ((float*)(ws + WS_EG))[unit] = __expf(g);
        }
        float va[64];
        {
            const int c = t8 & 127;
            const int col = (t8 < 128 ? 0 : 512) + h * 128 + c;
            float h0 = 0.f, h1 = 0.f, h2 = 0.f;
            if (sample) { const float* cc = a.in[2] + (size_t)bidx * 3 * 1536 + col; h0 = cc[0]; h1 = cc[1536]; h2 = cc[2 * 1536]; }
            else if (!first) { const bf16* pp = P + (size_t)(row0 - 3) * PW + col; h0 = b2f(pp[0]); h1 = b2f(pp[PW]); h2 = b2f(pp[2 * PW]); }
            float* outp = lastc ? a.out + (sample ? O_SDC : O_PDC) + (size_t)bidx * 3 * 1536 + col : nullptr;
            conv_col(P + (size_t)row0 * PW + col, h0, h1, h2, cwt + col, nrows, outp, va);
            unsigned char* dst = (t8 < 128 ? qb : kb) + c * 2;
#pragma unroll
            for (int r = 0; r < 64; ++r) *(bf16*)(dst + r * 272) = f2b(va[r]);
        }
        __syncthreads();
        f32x4 kk[4], qk[4], qq;
        {
            bf16x8 ak[4], aq[4];
#pragma unroll
            for (int ks = 0; ks < 4; ++ks) { ak[ks] = *(const bf16x8*)(kb + (16 * hw + fr) * 272 + ks * 64 + fq * 16); aq[ks] = *(const bf16x8*)(qb + (16 * hw + fr) * 272 + ks * 64 + fq * 16); }
            qq = (f32x4){0.f, 0.f, 0.f, 0.f};
#pragma unroll
            for (int ks = 0; ks < 4; ++ks) qq = MFMA16(aq[ks], aq[ks], qq);
#pragma unroll
            for (int nt = 0; nt < 4; ++nt) {
                kk[nt] = (f32x4){0.f, 0.f, 0.f, 0.f}; qk[nt] = (f32x4){0.f, 0.f, 0.f, 0.f};
#pragma unroll
                for (int ks = 0; ks < 4; ++ks) { const bf16x8 bk = *(const bf16x8*)(kb + (16 * nt + fr) * 272 + ks * 64 + fq * 16);
                    kk[nt] = MFMA16(ak[ks], bk, kk[nt]); qk[nt] = MFMA16(aq[ks], bk, qk[nt]); }
            }
#pragma unroll
            for (int i = 0; i < 4; ++i) if (fr == 4 * fq + i) {
                float dk = 0.f;
#pragma unroll
                for (int nt = 0; nt < 4; ++nt) if (nt == hw) dk = kk[nt][i];
                RK[16 * hw + fr] = rsqrtf(dk + EPS); RQ[16 * hw + fr] = rsqrtf(qq[i] + EPS);
            }
        }
        __syncthreads();
        {
            bf16* QKr = (bf16*)(rec + R_QK);
#pragma unroll
            for (int i = 0; i < 4; ++i) {
                const int row = 16 * hw + 4 * fq + i;
                const float gr = Gs[row], br = Bs[row], rk = RK[row], rq = RQ[row];
#pragma unroll
                for (int nt = 0; nt < 4; ++nt) {
                    const int col = 16 * nt + fr;
                    const float d = col <= row ? gr - Gs[col] : 0.f;
                    const float e = __expf(d), rkc = RK[col];
                    Am[row * 64 + col] = col < row ? br * kk[nt][i] * rk * rkc * e : 0.f;
                    QKr[row * 64 + kperm(col)] = f2b(col <= row ? qk[nt][i] * rq * rkc * QSCALE * e : 0.f);
                }
            }
        }
        __syncthreads();
        if (t8 < 128) {
            bf16* Qg = (bf16*)(rec + R_QG) + kperm(t8);
#pragma unroll
            for (int r = 0; r < 64; ++r) Qg[r * 128] = f2b(va[r] * RQ[r] * QSCALE * EG[r]);
            {
                const int col = 1024 + h * 128 + t8;
                float h0 = 0.f, h1 = 0.f, h2 = 0.f;
                if (sample) { const float* cc = a.in[2] + (size_t)bidx * 3 * 1536 + col; h0 = cc[0]; h1 = cc[1536]; h2 = cc[2 * 1536]; }
                else if (!first) { const bf16* pp = P + (size_t)(row0 - 3) * PW + col; h0 = b2f(pp[0]); h1 = b2f(pp[PW]); h2 = b2f(pp[2 * PW]); }
                float* outp = lastc ? a.out + (sample ? O_SDC : O_PDC) + (size_t)bidx * 3 * 1536 + col : nullptr;
                conv_col(P + (size_t)row0 * PW + col, h0, h1, h2, cwt + col, nrows, outp, va);
            }
#pragma unroll
            for (int r = 0; r < 64; ++r) va[r] = va[r] * Bs[r];
        } else {
            const int c = t8 - 128;
            const float gl = Gs[63];
            unsigned w[32];
#pragma unroll
            for (int r = 0; r < 64; r += 2) w[kperm(r) >> 1] = pk2(va[r] * RK[r] * __expf(gl - Gs[r]), va[r + 1] * RK[r + 1] * __expf(gl - Gs[r + 1]));
            u32x4* dst = (u32x4*)(rec + R_KDT + c * 128);
#pragma unroll
            for (int j = 0; j < 8; ++j) dst[j] = (u32x4){w[4 * j], w[4 * j + 1], w[4 * j + 2], w[4 * j + 3]};
#pragma unroll
            for (int r = 0; r < 64; ++r) va[r] = va[r] * RK[r] * Bs[r] * EG[r];
        }
#if SOLVE_RL
        {
            float arow[64];
#pragma unroll
            for (int i = 1; i < 64; ++i) arow[i] = Am[i * 64 + lane];
#pragma unroll
            for (int i = 1; i < 64; ++i) {
                if (i < nrows) {
                    float acc0 = va[i], acc1 = 0.f;
#pragma unroll
                    for (int j = 0; j < i; ++j) { const float aij = __int_as_float(__builtin_amdgcn_readlane(__float_as_int(arow[i]), j)); if (j & 1) acc1 -= aij * va[j]; else acc0 -= aij * va[j]; }
                    va[i] = acc0 + acc1;
                }
            }
        }
#else
#pragma unroll
        for (int i = 1; i < 64; ++i) {
            float acc = va[i];
            const f32x4* Ar = (const f32x4*)(Am + i * 64);
#pragma unroll
            for (int j4 = 0; j4 < (i + 3) / 4; ++j4) {
                const f32x4 av = Ar[j4];
#pragma unroll
                for (int e = 0; e < 4; ++e) if (4 * j4 + e < i) acc -= av[e] * va[4 * j4 + e];
            }
            va[i] = acc;
        }
#endif
        if (t8 < 128) { bf16* U0 = (bf16*)(rec + R_U0) + t8;
#pragma unroll
            for (int r = 0; r < 64; ++r) U0[r * 128] = f2b(va[r]);
        } else { bf16* Wn = (bf16*)(rec + R_WN) + kperm(t8 - 128);
#pragma unroll
            for (int r = 0; r < 64; ++r) Wn[r * 128] = f2b(-va[r]);
        }
        __syncthreads();
    }
}

struct S5W { float lr[4], li[4]; bf16x8 bf[8]; };
DI void s5w_setup(const Args& a, int g, int fr, int fq, S5W& w) {
    const float dt = __expf(a.in[15][g]);
#pragma unroll
    for (int j = 0; j < 4; ++j) {
        const int p = 16 * j + fr;
        const float are = a.in[13][g * 64 + p], aim = a.in[14][g * 64 + p];
        const float mag = __expf(are * dt), ang = aim * dt;
        float sn, cs; sincosf(ang, &sn, &cs);
        const float lr = mag * cs, li = mag * sn;
        w.lr[j] = lr; w.li[j] = li;
        const float den = are * are + aim * aim;
        const float fre = ((lr - 1.f) * are + li * aim) / den, fim = (li * are - (lr - 1.f) * aim) / den;
        u32x4 wr = (u32x4){0u, 0u, 0u, 0u}, wi = (u32x4){0u, 0u, 0u, 0u};
        if (fq < 2) {
            const f32x4* br = (const f32x4*)(a.in[16] + (size_t)(g * 64 + p) * 16 + 8 * fq); const f32x4* bi = (const f32x4*)(a.in[17] + (size_t)(g * 64 + p) * 16 + 8 * fq);
            const f32x4 r0 = br[0], r1 = br[1], i0 = bi[0], i1 = bi[1];
            wr.x = pk2(fre * r0[0] - fim * i0[0], fre * r0[1] - fim * i0[1]); wr.y = pk2(fre * r0[2] - fim * i0[2], fre * r0[3] - fim * i0[3]);
            wr.z = pk2(fre * r1[0] - fim * i1[0], fre * r1[1] - fim * i1[1]); wr.w = pk2(fre * r1[2] - fim * i1[2], fre * r1[3] - fim * i1[3]);
            wi.x = pk2(fre * i0[0] + fim * r0[0], fre * i0[1] + fim * r0[1]); wi.y = pk2(fre * i0[2] + fim * r0[2], fre * i0[3] + fim * r0[3]);
            wi.z = pk2(fre * i1[0] + fim * r1[0], fre * i1[1] + fim * r1[1]); wi.w = pk2(fre * i1[2] + fim * r1[2], fre * i1[3] + fim * r1[3]);
        }
        w.bf[j] = __builtin_bit_cast(bf16x8, wr); w.bf[4 + j] = __builtin_bit_cast(bf16x8, wi);
    }
}
DI bf16x8 s5w_uload(const bf16* P, size_t row0, int SS, int ms, int g, int fr, int fq) {
    u32x4 v = (u32x4){0u, 0u, 0u, 0u};
    if (fq < 2) v = *(const u32x4*)(P + (row0 + (size_t)(fr >> 2) * SS + 4 * ms + (fr & 3)) * PW + 2048 + g * 16 + 8 * fq);
    return __builtin_bit_cast(bf16x8, v);
}
DI void s5w_step(const S5W& w, bf16x8 ua, float (&xr)[4], float (&xi)[4], unsigned (&xo)[4][4]) {
    f32x4 br[4], bi[4];
    const f32x4 z = (f32x4){0.f, 0.f, 0.f, 0.f};
#pragma unroll
    for (int j = 0; j < 4; ++j) { br[j] = MFMA16(ua, w.bf[j], z); bi[j] = MFMA16(ua, w.bf[4 + j], z); }
#pragma unroll
    for (int i = 0; i < 4; ++i)
#pragma unroll
        for (int j = 0; j < 4; ++j) {
            const float nr = w.lr[j] * xr[j] - w.li[j] * xi[j] + br[j][i], ni = w.lr[j] * xi[j] + w.li[j] * xr[j] + bi[j][i];
            xr[j] = nr; xi[j] = ni; xo[i][j] = pk2(nr, ni);
        }
#pragma unroll
    for (int j = 0; j < 8; ++j) asm volatile("" :: "v"(w.bf[j]));
    asm volatile("" :: "v"(ua));
}
DI void s5_pass1(const Args& a, int gw, int NGW, int lane) {
    asm volatile("" : "+v"(lane));
    const bf16* P = (const bf16*)(a.ws + WS_P);
    float* E = (float*)(a.ws + WS_S5E);
    const int fr = lane & 15, fq = lane >> 4;
    for (int unit = gw; unit < 4 * 32 * 16; unit += NGW) {
        const int sg = unit & 15, bg = unit >> 4, g = bg & 31, b = bg >> 5;
        S5W w; s5w_setup(a, g, fr, fq, w);
        float xr[4] = {0.f, 0.f, 0.f, 0.f}, xi[4] = {0.f, 0.f, 0.f, 0.f}; unsigned xo[4][4];
        const size_t row0 = (size_t)b * 8192 + sg * 512;
        bf16x8 ua = s5w_uload(P, row0, 128, 0, g, fr, fq);
        for (int ms = 0; ms < 32; ++ms) {
            const bf16x8 un = s5w_uload(P, row0, 128, ms + 1 < 32 ? ms + 1 : ms, g, fr, fq);
            s5w_step(w, ua, xr, xi, xo); ua = un;
        }
        float* e = E + ((size_t)bg * 64 + 4 * sg + fq) * 128;
#pragma unroll
        for (int j = 0; j < 4; ++j) { e[16 * j + fr] = xr[j]; e[64 + 16 * j + fr] = xi[j]; }
    }
}
DI void s5w_run(const Args& a, const S5W& w, const bf16x8 (&cf)[4], float Dg, unsigned char* xs, size_t row0, int SS, int nms, int g, int fr, int fq, float (&xr)[4], float (&xi)[4]) {
    const bf16* P = (const bf16*)(a.ws + WS_P);
    bf16* Y5 = (bf16*)(a.ws + WS_Y5);
    bf16x8 ua = s5w_uload(P, row0, SS, 0, g, fr, fq);
    for (int ms = 0; ms < nms; ++ms) {
        const bf16x8 un = s5w_uload(P, row0, SS, ms + 1 < nms ? ms + 1 : ms, g, fr, fq);
        float uu[4];
#pragma unroll
        for (int i = 0; i < 4; ++i) uu[i] = b2f(P[(row0 + (size_t)fq * SS + 4 * ms + i) * PW + 2048 + g * 16 + fr]);
        unsigned xo[4][4];
        s5w_step(w, ua, xr, xi, xo); ua = un;
#pragma unroll
        for (int i = 0; i < 4; ++i)
#pragma unroll
            for (int j = 0; j < 4; ++j) *(unsigned*)(xs + (4 * fq + i) * 272 + (16 * j + fr) * 4) = xo[i][j];
        asm volatile("s_waitcnt lgkmcnt(0)" ::: "memory");
        f32x4 y = (f32x4){0.f, 0.f, 0.f, 0.f};
        bf16x8 af[4];
#pragma unroll
        for (int ks = 0; ks < 4; ++ks) af[ks] = *(const bf16x8*)(xs + fr * 272 + ks * 64 + fq * 16);
        asm volatile("" ::: "memory");
#pragma unroll
        for (int ks = 0; ks < 4; ++ks) y = MFMA16(af[ks], cf[ks], y);
#if DIAG_Y
        {
            const float* cre = a.in[18] + (size_t)(g * 16 + fr) * 64; const float* cim = a.in[19] + (size_t)(g * 16 + fr) * 64;
#pragma unroll
            for (int i = 0; i < 4; ++i) { float acc = 0.f;
                for (int p = 0; p < 64; ++p) { const unsigned wv = *(const unsigned*)(xs + (4 * fq + i) * 272 + p * 4); acc += cre[p] * blo(wv) - cim[p] * bhi(wv); }
                y[i] = acc; }
        }
#endif
        asm volatile("" :: "v"(y));
#pragma unroll
        for (int ks = 0; ks < 4; ++ks) asm volatile("" :: "v"(af[ks]), "v"(cf[ks]));
#pragma unroll
        for (int i = 0; i < 4; ++i) {
            const size_t row = row0 + (size_t)fq * SS + 4 * ms + i;
            Y5[row * 512 + g * 16 + fr] = f2b(gelu_tanh(y[i] + Dg * uu[i]));
        }
    }
}
DI void s5_cfrag(const Args& a, int g, int fr, int fq, bf16x8 (&cf)[4]) {
#pragma unroll
    for (int ks = 0; ks < 4; ++ks) {
        const f32x4 cr = *(const f32x4*)(a.in[18] + (size_t)(g * 16 + fr) * 64 + 16 * ks + 4 * fq), ci = *(const f32x4*)(a.in[19] + (size_t)(g * 16 + fr) * 64 + 16 * ks + 4 * fq);
        u32x4 w; w.x = pk2(cr[0], -ci[0]); w.y = pk2(cr[1], -ci[1]); w.z = pk2(cr[2], -ci[2]); w.w = pk2(cr[3], -ci[3]);
        cf[ks] = __builtin_bit_cast(bf16x8, w);
    }
}
DI void s5_pass2_prompt(const Args& a, unsigned char* lds, int bg, int tid) {
    asm volatile("" : "+v"(tid));
    const int wave = __builtin_amdgcn_readfirstlane(tid >> 6), lane = tid & 63, fr = lane & 15, fq = lane >> 4;
    const int b = bg >> 5, g4 = (bg >> 2) & 7, part = bg & 3, g = 4 * g4 + (wave & 3);
    bg = b * 32 + g;
    unsigned char* xs = lds + wave * 4352;
    S5W w; s5w_setup(a, g, fr, fq, w);
    bf16x8 cf[4]; s5_cfrag(a, g, fr, fq, cf);
    const float Dg = a.in[20][g * 16 + fr];
    float pr[4], pi[4];
#pragma unroll
    for (int j = 0; j < 4; ++j) { pr[j] = w.lr[j]; pi[j] = w.li[j];
#pragma unroll
        for (int s = 0; s < 7; ++s) { const float nr = pr[j] * pr[j] - pi[j] * pi[j], ni = 2.f * pr[j] * pi[j]; pr[j] = nr; pi[j] = ni; } }
    const float* e = (const float*)(a.ws + WS_S5E) + (size_t)bg * 64 * 128;
    for (int uu = 0; uu < 2; ++uu) {
        const int sg = 4 * part + 2 * (wave >> 2) + uu, seg = 4 * sg + fq;
        float xr[4] = {0.f, 0.f, 0.f, 0.f}, xi[4] = {0.f, 0.f, 0.f, 0.f};
        for (int s = 0; s < 4 * sg + 3; ++s) {
            if (s < seg) {
#pragma unroll
                for (int j = 0; j < 4; ++j) { const float er = e[s * 128 + 16 * j + fr], ei = e[s * 128 + 64 + 16 * j + fr];
                    const float nr = pr[j] * xr[j] - pi[j] * xi[j] + er, ni = pr[j] * xi[j] + pi[j] * xr[j] + ei; xr[j] = nr; xi[j] = ni; }
            }
        }
        s5w_run(a, w, cf, Dg, xs, (size_t)b * 8192 + sg * 512, 128, 32, g, fr, fq, xr, xi);
        if (seg == 63) {
#pragma unroll
            for (int j = 0; j < 4; ++j) { a.out[O_PSR + (size_t)bg * 64 + 16 * j + fr] = xr[j]; a.out[O_PSI + (size_t)bg * 64 + 16 * j + fr] = xi[j]; }
        }
    }
}
DI void s5_pass2_sample(const Args& a, unsigned char* xs, int gw, int NGW, int lane) {
    asm volatile("" : "+v"(lane));
    const int fr = lane & 15, fq = lane >> 4;
    for (int unit = gw; unit < 256; unit += NGW) {
        const int g = unit & 31, q = unit >> 5, sb = 4 * q + fq;
        S5W w; s5w_setup(a, g, fr, fq, w);
        bf16x8 cf[4]; s5_cfrag(a, g, fr, fq, cf);
        const float Dg = a.in[20][g * 16 + fr];
        float xr[4], xi[4];
#pragma unroll
        for (int j = 0; j < 4; ++j) { xr[j] = a.in[4][(size_t)(sb * 32 + g) * 64 + 16 * j + fr]; xi[j] = a.in[5][(size_t)(sb * 32 + g) * 64 + 16 * j + fr]; }
        s5w_run(a, w, cf, Dg, xs, (size_t)TP + (size_t)q * 64, 16, 4, g, fr, fq, xr, xi);
#pragma unroll
        for (int j = 0; j < 4; ++j) { a.out[O_SSR + (size_t)(sb * 32 + g) * 64 + 16 * j + fr] = xr[j]; a.out[O_SSI + (size_t)(sb * 32 + g) * 64 + 16 * j + fr] = xi[j]; }
    }
}

struct S5Par { float lr, li; float bbr[16], bbi[16]; };
DI void s5_setup(const Args& a, int g, int p, S5Par& q) {
    const float are = a.in[13][g * 64 + p], aim = a.in[14][g * 64 + p], dt = __expf(a.in[15][g]);
    const float mag = __expf(are * dt), ang = aim * dt;
    float sn, cs; sincosf(ang, &sn, &cs);
    q.lr = mag * cs; q.li = mag * sn;
    const float den = are * are + aim * aim;
    const float fre = ((q.lr - 1.f) * are + q.li * aim) / den, fim = (q.li * are - (q.lr - 1.f) * aim) / den;
    const f32x4* br = (const f32x4*)(a.in[16] + (size_t)(g * 64 + p) * 16); const f32x4* bi = (const f32x4*)(a.in[17] + (size_t)(g * 64 + p) * 16);
#pragma unroll
    for (int j = 0; j < 4; ++j) { const f32x4 r = br[j], i = bi[j];
#pragma unroll
        for (int e = 0; e < 4; ++e) { q.bbr[4 * j + e] = fre * r[e] - fim * i[e]; q.bbi[4 * j + e] = fre * i[e] + fim * r[e]; } }
}
DI void s5_step4(const S5Par& q, float uv, float& xr, float& xi, unsigned (&xo)[4]) {
#pragma unroll
    for (int j = 0; j < 4; ++j) {
        float br = 0.f, bi = 0.f;
#pragma unroll
        for (int h = 0; h < 16; ++h) { const float uh = __int_as_float(__builtin_amdgcn_readlane(__float_as_int(uv), 16 * j + h)); br += q.bbr[h] * uh; bi += q.bbi[h] * uh; }
        const float nr = q.lr * xr - q.li * xi + br, ni = q.lr * xi + q.li * xr + bi;
        xr = nr; xi = ni; xo[j] = pk2(xr, xi);
    }
}
DI void old_s5_pass1(const Args& a, int gw, int NGW, int lane) {
    asm volatile("" : "+v"(lane));
    const bf16* P = (const bf16*)(a.ws + WS_P);
    float* E = (float*)(a.ws + WS_S5E);
    for (int unit = gw; unit < 4 * 32 * 64; unit += NGW) {
        const int seg = unit & 63, bg = unit >> 6, g = bg & 31, b = bg >> 5;
        S5Par q; s5_setup(a, g, lane, q);
        float xr = 0.f, xi = 0.f; unsigned xo[4];
        const bf16* up = P + (size_t)(b * 8192 + seg * 128 + (lane >> 4)) * PW + 2048 + g * 16 + (lane & 15);
#pragma unroll 2
        for (int t = 0; t < 128; t += 4) { const float uv = b2f(up[(size_t)t * PW]); s5_step4(q, uv, xr, xi, xo); }
        float* e = E + ((size_t)bg * 64 + seg) * 128;
        e[lane] = xr; e[64 + lane] = xi;
    }
}
DI void old_s5_pass2(const Args& a, unsigned char* xs  , int gw, int NGW, int lane) {
    asm volatile("" : "+v"(lane));
    const bf16* P = (const bf16*)(a.ws + WS_P);
    const float* E = (const float*)(a.ws + WS_S5E);
    bf16* Y5 = (bf16*)(a.ws + WS_Y5);
    const int fr = lane & 15, fq = lane >> 4;
    for (int unit = gw; unit < OLD_S5_ULIM; unit += NGW) {
        int g, row0, ntok, seg = 0, bg; bool sample;
        if (unit < 8192) { seg = unit & 63; bg = unit >> 6; g = bg & 31; row0 = (bg >> 5) * 8192 + seg * 128; ntok = 128; sample = false; }
        else { bg = unit - 8192; g = bg & 31; row0 = TP + (bg >> 5) * 16; ntok = 16; sample = true; }
        S5Par q; s5_setup(a, g, lane, q);
        float xr = 0.f, xi = 0.f;
        if (sample) { xr = a.in[4][(size_t)bg * 64 + lane]; xi = a.in[5][(size_t)bg * 64 + lane]; }
        else {
            float pr = q.lr, pi = q.li;
#pragma unroll
            for (int s = 0; s < 7; ++s) { const float nr = pr * pr - pi * pi, ni = 2.f * pr * pi; pr = nr; pi = ni; }
            const float* e = E + (size_t)bg * 64 * 128;
            for (int s = 0; s < seg; ++s) { const float er = e[s * 128 + lane], ei = e[s * 128 + 64 + lane]; const float nr = pr * xr - pi * xi + er, ni = pr * xi + pi * xr + ei; xr = nr; xi = ni; }
        }
        bf16x8 cf[4];
#pragma unroll
        for (int ks = 0; ks < 4; ++ks) {
            const f32x4 cr = *(const f32x4*)(a.in[18] + (size_t)(g * 16 + fr) * 64 + 16 * ks + 4 * fq), ci = *(const f32x4*)(a.in[19] + (size_t)(g * 16 + fr) * 64 + 16 * ks + 4 * fq);
            u32x4 w; w.x = pk2(cr[0], -ci[0]); w.y = pk2(cr[1], -ci[1]); w.z = pk2(cr[2], -ci[2]); w.w = pk2(cr[3], -ci[3]);
            cf[ks] = __builtin_bit_cast(bf16x8, w);
        }
        const float Dg = a.in[20][g * 16 + fr];
        const bf16* up = P + (size_t)(row0 + (lane >> 4)) * PW + 2048 + g * 16 + (lane & 15);
        for (int tb = 0; tb < ntok; tb += 16) {
#pragma unroll
            for (int j4 = 0; j4 < 4; ++j4) {
                const float uv = b2f(up[(size_t)(tb + 4 * j4) * PW]);
                unsigned xo[4]; s5_step4(q, uv, xr, xi, xo);
#pragma unroll
                for (int j = 0; j < 4; ++j) *(unsigned*)(xs + (4 * j4 + j) * 272 + lane * 4) = xo[j];
            }
            f32x4 y = (f32x4){0.f, 0.f, 0.f, 0.f};
#pragma unroll
            for (int ks = 0; ks < 4; ++ks) { const bf16x8 af = *(const bf16x8*)(xs + fr * 272 + ks * 64 + fq * 16); y = MFMA16(af, cf[ks], y); }
#pragma unroll
            for (int i = 0; i < 4; ++i) {
                const size_t row = (size_t)row0 + tb + 4 * fq + i;
                const float uu = b2f(P[row * PW + 2048 + g * 16 + fr]);
                Y5[row * 512 + g * 16 + fr] = f2b(gelu_tanh(y[i] + Dg * uu));
            }
        }
        if (sample) { a.out[O_SSR + (size_t)bg * 64 + lane] = xr; a.out[O_SSI + (size_t)bg * 64 + lane] = xi; }
        else if (seg == 63) { a.out[O_PSR + (size_t)bg * 64 + lane] = xr; a.out[O_PSI + (size_t)bg * 64 + lane] = xi; }
    }
}

DI void s5_pass2b(const Args& a, unsigned char* xs, int gw, int NGW, int lane) {
    asm volatile("" : "+v"(lane));
    const bf16* P = (const bf16*)(a.ws + WS_P);
    const float* E = (const float*)(a.ws + WS_S5E);
    bf16* Y5 = (bf16*)(a.ws + WS_Y5);
    const int fr = lane & 15, fq = lane >> 4;
    for (int unit = gw; unit < 4 * 32 * 64 + 32 * 32; unit += NGW) {
        int g, row0, ntok, seg = 0, bg; bool sample;
        if (unit < 8192) { seg = unit & 63; bg = unit >> 6; g = bg & 31; row0 = (bg >> 5) * 8192 + seg * 128; ntok = 128; sample = false; }
        else { bg = unit - 8192; g = bg & 31; row0 = TP + (bg >> 5) * 16; ntok = 16; sample = true; }
        S5Par q; s5_setup(a, g, lane, q);
        float xr = 0.f, xi = 0.f;
        if (sample) { xr = a.in[4][(size_t)bg * 64 + lane]; xi = a.in[5][(size_t)bg * 64 + lane]; }
        else {
            float pr = q.lr, pi = q.li;
#pragma unroll
            for (int s = 0; s < 7; ++s) { const float nr = pr * pr - pi * pi, ni = 2.f * pr * pi; pr = nr; pi = ni; }
            const float* e = E + (size_t)bg * 64 * 128;
            for (int s0 = 0; s0 < seg; s0 += 8) {
                float er[8], ei[8];
#pragma unroll
                for (int k = 0; k < 8; ++k) { const bool ok = s0 + k < seg; er[k] = ok ? e[(s0 + k) * 128 + lane] : 0.f; ei[k] = ok ? e[(s0 + k) * 128 + 64 + lane] : 0.f; }
#pragma unroll
                for (int k = 0; k < 8; ++k) if (s0 + k < seg) { const float nr = pr * xr - pi * xi + er[k], ni = pr * xi + pi * xr + ei[k]; xr = nr; xi = ni; }
            }
        }
        bf16x8 cf[4];
#pragma unroll
        for (int ks = 0; ks < 4; ++ks) {
            const f32x4 cr = *(const f32x4*)(a.in[18] + (size_t)(g * 16 + fr) * 64 + 16 * ks + 4 * fq), ci = *(const f32x4*)(a.in[19] + (size_t)(g * 16 + fr) * 64 + 16 * ks + 4 * fq);
            u32x4 w; w.x = pk2(cr[0], -ci[0]); w.y = pk2(cr[1], -ci[1]); w.z = pk2(cr[2], -ci[2]); w.w = pk2(cr[3], -ci[3]);
            cf[ks] = __builtin_bit_cast(bf16x8, w);
        }
        const float Dg = a.in[20][g * 16 + fr];
        S5W w; s5w_setup(a, g, fr, fq, w);
        unsigned char* bt = xs + 4352;
        for (int tb = 0; tb < ntok; tb += 16) {
            {
                u32x4 uv = (u32x4){0u, 0u, 0u, 0u};
                if (fq < 2) uv = *(const u32x4*)(P + (size_t)(row0 + tb + fr) * PW + 2048 + g * 16 + 8 * fq);
                const bf16x8 ua = __builtin_bit_cast(bf16x8, uv);
                const f32x4 z = (f32x4){0.f, 0.f, 0.f, 0.f};
#pragma unroll
                for (int j = 0; j < 4; ++j) {
                    const f32x4 br = MFMA16(ua, w.bf[j], z), bi = MFMA16(ua, w.bf[4 + j], z);
                    *(f32x4*)(bt + (16 * j + fr) * 80 + fq * 16) = br; *(f32x4*)(bt + (64 + 16 * j + fr) * 80 + fq * 16) = bi;
                }
            }
            asm volatile("s_waitcnt lgkmcnt(0)" ::: "memory");
            f32x4 bre[4], bim[4];
#pragma unroll
            for (int k = 0; k < 4; ++k) { bre[k] = *(const f32x4*)(bt + lane * 80 + k * 16); bim[k] = *(const f32x4*)(bt + (64 + lane) * 80 + k * 16); }
            asm volatile("s_waitcnt lgkmcnt(0)" ::: "memory");
#pragma unroll
            for (int t = 0; t < 16; ++t) {
                const float nr = q.lr * xr - q.li * xi + bre[t >> 2][t & 3], ni = q.lr * xi + q.li * xr + bim[t >> 2][t & 3];
                xr = nr; xi = ni;
                *(unsigned*)(xs + t * 272 + lane * 4) = pk2(nr, ni);
            }
            asm volatile("s_waitcnt lgkmcnt(0)" ::: "memory");
            f32x4 y = (f32x4){0.f, 0.f, 0.f, 0.f};
#pragma unroll
            for (int ks = 0; ks < 4; ++ks) { const bf16x8 af = *(const bf16x8*)(xs + fr * 272 + ks * 64 + fq * 16); y = MFMA16(af, cf[ks], y); }
#pragma unroll
            for (int i = 0; i < 4; ++i) {
                const size_t row = (size_t)row0 + tb + 4 * fq + i;
                const float uu = b2f(P[row * PW + 2048 + g * 16 + fr]);
                Y5[row * 512 + g * 16 + fr] = f2b(gelu_tanh(y[i] + Dg * uu));
            }
        }
        if (sample) { a.out[O_SSR + (size_t)bg * 64 + lane] = xr; a.out[O_SSI + (size_t)bg * 64 + lane] = xi; }
        else if (seg == 63) { a.out[O_PSR + (size_t)bg * 64 + lane] = xr; a.out[O_PSI + (size_t)bg * 64 + lane] = xi; }
    }
}

constexpr int DB_WN = 0, DB_QG = 17408, DB_KDT = 34816, DB_QK = 53248, DB_U0 = 62464;
constexpr int DBP_SIZE = DB_U0 + 64 * 80;
constexpr int DBS_SIZE = DB_U0 + 64 * 272;
template <int NC> struct DnRegs { u32x4 r[7]; u32x4 u[NC == 32 ? 1 : 2]; };
template <int NC> DI void dn_load(const unsigned char* rec, int tid, int c0, DnRegs<NC>& R) {
    const u32x4* g = (const u32x4*)rec;
    R.r[0] = g[tid]; R.r[1] = g[tid + 512]; R.r[2] = g[1024 + tid]; R.r[3] = g[1024 + tid + 512]; R.r[4] = g[2048 + tid]; R.r[5] = g[2048 + tid + 512]; R.r[6] = g[3072 + tid];
    if (NC == 32) { if (tid < 256) R.u[0] = *(const u32x4*)(rec + R_U0 + (tid >> 2) * 256 + c0 * 2 + (tid & 3) * 16); }
    else { R.u[0] = *(const u32x4*)(rec + R_U0 + tid * 16); R.u[1] = *(const u32x4*)(rec + R_U0 + (tid + 512) * 16); }
}
template <int NC> DI void dn_store(unsigned char* buf, int tid, const DnRegs<NC>& R) {
#pragma unroll
    for (int j = 0; j < 2; ++j) { const int q = tid + 512 * j;
        *(u32x4*)(buf + DB_WN + (q >> 4) * 272 + (q & 15) * 16) = R.r[j];
        *(u32x4*)(buf + DB_QG + (q >> 4) * 272 + (q & 15) * 16) = R.r[2 + j];
        *(u32x4*)(buf + DB_KDT + (q >> 3) * 144 + (q & 7) * 16) = R.r[4 + j]; }
    *(u32x4*)(buf + DB_QK + (tid >> 3) * 144 + (tid & 7) * 16) = R.r[6];
    if (NC == 32) { if (tid < 256) *(u32x4*)(buf + DB_U0 + (tid >> 2) * 80 + (tid & 3) * 16) = R.u[0]; }
    else {
#pragma unroll
        for (int j = 0; j < 2; ++j) { const int q = tid + 512 * j; *(u32x4*)(buf + DB_U0 + (q >> 4) * 272 + (q & 15) * 16) = R.u[j]; }
    }
}
DI bf16x8 pack8(const f32x4& lo, const f32x4& hi) { u32x4 w; w.x = pk2(lo[0], lo[1]); w.y = pk2(lo[2], lo[3]); w.z = pk2(hi[0], hi[1]); w.w = pk2(hi[2], hi[3]); return __builtin_bit_cast(bf16x8, w); }
template <int UPI> DI void dn_step(const unsigned char* buf, f32x4 (&S)[8], const unsigned char* u0, float eg, int fr, int fq, f32x4 (&o)[4]) {
    bf16x8 Sb[4];
#pragma unroll
    for (int ks = 0; ks < 4; ++ks) Sb[ks] = pack8(S[2 * ks], S[2 * ks + 1]);
    f32x4 u[4];
#pragma unroll
    for (int mt = 0; mt < 4; ++mt) {
#pragma unroll
        for (int i = 0; i < 4; ++i) u[mt][i] = b2f(*(const bf16*)(u0 + (16 * mt + 4 * fq + i) * UPI));
#pragma unroll
        for (int ks = 0; ks < 4; ++ks) u[mt] = MFMA16(*(const bf16x8*)(buf + DB_WN + (16 * mt + fr) * 272 + ks * 64 + fq * 16), Sb[ks], u[mt]);
    }
    bf16x8 ub[2];
#pragma unroll
    for (int k2 = 0; k2 < 2; ++k2) ub[k2] = pack8(u[2 * k2], u[2 * k2 + 1]);
#pragma unroll
    for (int mt = 0; mt < 4; ++mt) {
        o[mt] = (f32x4){0.f, 0.f, 0.f, 0.f};
#pragma unroll
        for (int ks = 0; ks < 4; ++ks) o[mt] = MFMA16(*(const bf16x8*)(buf + DB_QG + (16 * mt + fr) * 272 + ks * 64 + fq * 16), Sb[ks], o[mt]);
#pragma unroll
        for (int k2 = 0; k2 < 2; ++k2) o[mt] = MFMA16(*(const bf16x8*)(buf + DB_QK + (16 * mt + fr) * 144 + k2 * 64 + fq * 16), ub[k2], o[mt]);
    }
#pragma unroll
    for (int m8 = 0; m8 < 8; ++m8) {
        S[m8] = S[m8] * eg;
#pragma unroll
        for (int k2 = 0; k2 < 2; ++k2) S[m8] = MFMA16(*(const bf16x8*)(buf + DB_KDT + (16 * m8 + fr) * 144 + k2 * 64 + fq * 16), ub[k2], S[m8]);
    }
}
#if DN_STAGED == 2
#define DNP_SYNC() do { asm volatile("s_waitcnt lgkmcnt(0)" ::: "memory"); __builtin_amdgcn_sched_barrier(0); } while (0)
#else
#define DNP_SYNC() do { } while (0)
#endif
DI void dn_step_p(const unsigned char* buf, f32x4 (&S)[8], const unsigned char* u0, float eg, int fr, int fq, f32x4 (&o)[4]) {
    const unsigned char* aw = buf + DB_WN + fr * 272 + fq * 16;
    const unsigned char* aq = buf + DB_QG + fr * 272 + fq * 16;
    const unsigned char* ak = buf + DB_KDT + fr * 144 + fq * 16;
    const unsigned char* ac = buf + DB_QK + fr * 144 + fq * 16;
    bf16x8 f1[16], f2[16], Sb[4], ub[2];
    f32x4 u[4];
#pragma unroll
    for (int mt = 0; mt < 4; ++mt)
#pragma unroll
        for (int ks = 0; ks < 4; ++ks) f1[4 * mt + ks] = *(const bf16x8*)(aw + mt * 4352 + ks * 64);
#pragma unroll
    for (int mt = 0; mt < 4; ++mt)
#pragma unroll
        for (int i = 0; i < 4; ++i) u[mt][i] = b2f(*(const bf16*)(u0 + (16 * mt + 4 * fq + i) * 80));
#pragma unroll
    for (int ks = 0; ks < 4; ++ks) Sb[ks] = pack8(S[2 * ks], S[2 * ks + 1]);
    __builtin_amdgcn_sched_barrier(0);
#pragma unroll
    for (int mt = 0; mt < 4; ++mt)
#pragma unroll
        for (int ks = 0; ks < 4; ++ks) f2[4 * mt + ks] = *(const bf16x8*)(aq + mt * 4352 + ks * 64);
    DNP_SYNC();
#pragma unroll
    for (int ks = 0; ks < 4; ++ks)
#pragma unroll
        for (int mt = 0; mt < 4; ++mt) u[mt] = MFMA16(f1[4 * mt + ks], Sb[ks], u[mt]);
    __builtin_amdgcn_sched_barrier(0);
#pragma unroll
    for (int k2 = 0; k2 < 2; ++k2) ub[k2] = pack8(u[2 * k2], u[2 * k2 + 1]);
#pragma unroll
    for (int m8 = 0; m8 < 8; ++m8)
#pragma unroll
        for (int k2 = 0; k2 < 2; ++k2) f1[2 * m8 + k2] = *(const bf16x8*)(ak + m8 * 2304 + k2 * 64);
    DNP_SYNC();
#pragma unroll
    for (int mt = 0; mt < 4; ++mt) o[mt] = (f32x4){0.f, 0.f, 0.f, 0.f};
#pragma unroll
    for (int ks = 0; ks < 4; ++ks)
#pragma unroll
        for (int mt = 0; mt < 4; ++mt) o[mt] = MFMA16(f2[4 * mt + ks], Sb[ks], o[mt]);
    __builtin_amdgcn_sched_barrier(0);
#pragma unroll
    for (int mt = 0; mt < 4; ++mt)
#pragma unroll
        for (int k2 = 0; k2 < 2; ++k2) f2[2 * mt + k2] = *(const bf16x8*)(ac + mt * 2304 + k2 * 64);
    DNP_SYNC();
#pragma unroll
    for (int m8 = 0; m8 < 8; ++m8) S[m8] = S[m8] * eg;
#pragma unroll
    for (int k2 = 0; k2 < 2; ++k2)
#pragma unroll
        for (int m8 = 0; m8 < 8; ++m8) S[m8] = MFMA16(f1[2 * m8 + k2], ub[k2], S[m8]);
    __builtin_amdgcn_sched_barrier(0);
#pragma unroll
    for (int k2 = 0; k2 < 2; ++k2)
#pragma unroll
        for (int mt = 0; mt < 4; ++mt) o[mt] = MFMA16(f2[2 * mt + k2], ub[k2], o[mt]);
}
DI void dn_step_o(const unsigned char* buf, f32x4 (&S)[8], const unsigned char* u0, float eg, int fr, int fq, f32x4 (&o)[4]) {
    const unsigned char* aw = buf + DB_WN + fr * 272 + fq * 16;
    const unsigned char* aq = buf + DB_QG + fr * 272 + fq * 16;
    const unsigned char* ak = buf + DB_KDT + fr * 144 + fq * 16;
    const unsigned char* ac = buf + DB_QK + fr * 144 + fq * 16;
    bf16x8 f1[16], f2[16], Sb[4], ub[2];
    f32x4 u[4];
#pragma unroll
    for (int ks = 0; ks < 4; ++ks) Sb[ks] = pack8(S[2 * ks], S[2 * ks + 1]);
    __builtin_amdgcn_sched_barrier(0);
#pragma unroll
    for (int mt = 0; mt < 4; ++mt)
#pragma unroll
        for (int ks = 0; ks < 4; ++ks) f1[4 * mt + ks] = *(const bf16x8*)(aw + mt * 4352 + ks * 64);
#pragma unroll
    for (int mt = 0; mt < 4; ++mt)
#pragma unroll
        for (int i = 0; i < 4; ++i) u[mt][i] = b2f(*(const bf16*)(u0 + (16 * mt + 4 * fq + i) * 80));
#pragma unroll
    for (int mt = 0; mt < 4; ++mt)
#pragma unroll
        for (int ks = 0; ks < 4; ++ks) f2[4 * mt + ks] = *(const bf16x8*)(aq + mt * 4352 + ks * 64);
    __builtin_amdgcn_sched_barrier(0);
#pragma unroll
    for (int ks = 0; ks < 4; ++ks)
#pragma unroll
        for (int mt = 0; mt < 4; ++mt) u[mt] = MFMA16(f1[4 * mt + ks], Sb[ks], u[mt]);
    __builtin_amdgcn_sched_barrier(0);
#pragma unroll
    for (int k2 = 0; k2 < 2; ++k2) ub[k2] = pack8(u[2 * k2], u[2 * k2 + 1]);
    __builtin_amdgcn_sched_barrier(0);
#pragma unroll
    for (int m8 = 0; m8 < 8; ++m8)
#pragma unroll
        for (int k2 = 0; k2 < 2; ++k2) f1[2 * m8 + k2] = *(const bf16x8*)(ak + m8 * 2304 + k2 * 64);
#pragma unroll
    for (int mt = 0; mt < 4; ++mt) o[mt] = (f32x4){0.f, 0.f, 0.f, 0.f};
#pragma unroll
    for (int ks = 0; ks < 4; ++ks)
#pragma unroll
        for (int mt = 0; mt < 4; ++mt) o[mt] = MFMA16(f2[4 * mt + ks], Sb[ks], o[mt]);
    __builtin_amdgcn_sched_barrier(0);
    { float dmy = (o[0][0] + o[1][0]) + (o[2][0] + o[3][0]); asm volatile("" :: "v"(dmy)); }
    __builtin_amdgcn_sched_barrier(0);
#pragma unroll
    for (int mt = 0; mt < 4; ++mt)
#pragma unroll
        for (int k2 = 0; k2 < 2; ++k2) f2[2 * mt + k2] = *(const bf16x8*)(ac + mt * 2304 + k2 * 64);
#pragma unroll
    for (int m8 = 0; m8 < 8; ++m8) S[m8] = S[m8] * eg;
#pragma unroll
    for (int k2 = 0; k2 < 2; ++k2)
#pragma unroll
        for (int m8 = 0; m8 < 8; ++m8) S[m8] = MFMA16(f1[2 * m8 + k2], ub[k2], S[m8]);
    __builtin_amdgcn_sched_barrier(0);
#pragma unroll
    for (int k2 = 0; k2 < 2; ++k2)
#pragma unroll
        for (int mt = 0; mt < 4; ++mt) o[mt] = MFMA16(f2[2 * mt + k2], ub[k2], o[mt]);
}
DI void dn_piece(int q, int c0, unsigned& src, unsigned& dst) {
    if (q < 1024) { src = R_WN + q * 16; dst = DB_WN + (q >> 4) * 272 + (q & 15) * 16; }
    else if (q < 2048) { const int p = q - 1024; src = R_QG + p * 16; dst = DB_QG + (p >> 4) * 272 + (p & 15) * 16; }
    else if (q < 3072) { const int p = q - 2048; src = R_KDT + p * 16; dst = DB_KDT + (p >> 3) * 144 + (p & 7) * 16; }
    else if (q < 3584) { const int p = q - 3072; src = R_QK + p * 16; dst = DB_QK + (p >> 3) * 144 + (p & 7) * 16; }
    else { const int p = q - 3584; src = R_U0 + (p >> 2) * 256 + c0 * 2 + (p & 3) * 16; dst = DB_U0 + (p >> 2) * 80 + (p & 3) * 16; }
}
#define DN_LD(R, base) do { _Pragma("unroll") for (int k = 0; k < 10; ++k) { unsigned s_, d_; dn_piece(lt + 384 * k, c0, s_, d_); R[k] = *(const u32x4*)((base) + s_); } } while (0)
#define DN_WAIT(R, cnt) do { } while (0)
#define DN_ST(R, buf) do { _Pragma("unroll") for (int k = 0; k < 10; ++k) { unsigned s_, d_; dn_piece(lt + 384 * k, c0, s_, d_); *(u32x4*)((buf) + d_) = R[k]; } } while (0)
#define DN_BAR() do { asm volatile("s_waitcnt lgkmcnt(0)" ::: "memory"); __builtin_amdgcn_s_barrier(); asm volatile("" ::: "memory"); } while (0)
DI void dn_scan_prompt(const Args& a, unsigned char* lds, int tid) {
    asm volatile("" : "+v"(tid));
    const int wave = __builtin_amdgcn_readfirstlane(tid >> 6), lane = tid & 63, fr = lane & 15, fq = lane >> 4;
    const int bh = blockIdx.x >> 2, qt = blockIdx.x & 3, b = bh >> 2, h = bh & 3;
    const int c0 = qt * 32, v0 = c0 + (wave & 1) * 16;
    const unsigned char* recs = a.ws + WS_DNC + (size_t)bh * 128 * REC;
    const float* egs = (const float*)(a.ws + WS_EG) + bh * 128;
    float* ORAW = (float*)(a.ws + WS_H);
    const bool loader = wave >= 2;
    const int lt = tid - 128;
    f32x4 S[8];
#pragma unroll
    for (int m8 = 0; m8 < 8; ++m8) S[m8] = (f32x4){0.f, 0.f, 0.f, 0.f};
    float egA = egs[lane], egB = egs[64 + lane];
    asm volatile("s_waitcnt vmcnt(0)" : "+v"(egA), "+v"(egB) :: "memory");
    if (loader) {
        const int grp = wave >= 5 ? 1 : 0, lt2 = tid - 128 - grp * 192;
        u32x4 R[20];
#define DN_LD20(base) do { _Pragma("unroll") for (int k = 0; k < 20; ++k) { unsigned s_, d_; dn_piece(lt2 + 192 * k, c0, s_, d_); R[k] = *(const u32x4*)((base) + s_); } } while (0)
#define DN_ST20(buf) do { _Pragma("unroll") for (int k = 0; k < 20; ++k) { unsigned s_, d_; dn_piece(lt2 + 192 * k, c0, s_, d_); *(u32x4*)((buf) + d_) = R[k]; } } while (0)
        if (grp == 0) { DN_LD20(recs); DN_ST20(lds); DN_LD20(recs + 2 * (size_t)REC); }
        else { DN_LD20(recs + REC); }
        DN_BAR();
        for (int n = 0; n < 128; n += 2) {
            if (grp == 1) { DN_ST20(lds + DBP_SIZE); if (n + 3 < 128) DN_LD20(recs + (size_t)(n + 3) * REC); }
            DN_BAR();
            if (grp == 0 && n + 2 < 128) { DN_ST20(lds); if (n + 4 < 128) DN_LD20(recs + (size_t)(n + 4) * REC); }
            DN_BAR();
        }
#undef DN_LD20
#undef DN_ST20
    } else {
        DN_BAR();
        for (int n = 0; n < 128; ++n) {
            const float eg0 = __int_as_float(__builtin_amdgcn_readlane(__float_as_int(n < 64 ? egA : egB), n & 63));
            f32x4 o[4];
#if DN_STAGED == 3
            dn_step_o(lds + (n & 1) * DBP_SIZE, S, lds + (n & 1) * DBP_SIZE + DB_U0 + ((wave & 1) * 16 + fr) * 2, eg0, fr, fq, o);
#elif DN_STAGED
            dn_step_p(lds + (n & 1) * DBP_SIZE, S, lds + (n & 1) * DBP_SIZE + DB_U0 + ((wave & 1) * 16 + fr) * 2, eg0, fr, fq, o);
#else
            dn_step<80>(lds + (n & 1) * DBP_SIZE, S, lds + (n & 1) * DBP_SIZE + DB_U0 + ((wave & 1) * 16 + fr) * 2, eg0, fr, fq, o);
#endif
            float* op = ORAW + (size_t)(b * 8192 + n * 64) * 512 + h * 128 + v0 + fr;
#pragma unroll
            for (int mt = 0; mt < 4; ++mt)
#pragma unroll
                for (int i = 0; i < 4; ++i) op[(size_t)(16 * mt + 4 * fq + i) * 512] = o[mt][i];
            DN_BAR();
        }
    }
    if (!loader) {
        float* so = a.out + O_PDS + (size_t)bh * 128 * 128 + v0 + fr;
#pragma unroll
        for (int m8 = 0; m8 < 8; ++m8)
#pragma unroll
            for (int i = 0; i < 4; ++i) so[(16 * m8 + 4 * fq + i) * 128] = S[m8][i];
    }
    __syncthreads();
}
DI void dn_scan_sample(const Args& a, unsigned char* lds, int tid, int su0, int su1, int sus) {
    asm volatile("" : "+v"(tid));
    const int wave = __builtin_amdgcn_readfirstlane(tid >> 6), lane = tid & 63, fr = lane & 15, fq = lane >> 4;
    const int v0 = wave * 16;
    float* ORAW = (float*)(a.ws + WS_H);
    for (int su = su0; su < su1; su += sus) {
        const int sb = su >> 2, h = su & 3;
        const unsigned char* rec = a.ws + WS_DNC + (size_t)(2048 + su) * REC;
        DnRegs<128> R; dn_load<128>(rec, tid, 0, R); dn_store<128>(lds, tid, R);
        __syncthreads();
        f32x4 S[8];
        const float* s0 = a.in[3] + (size_t)su * 128 * 128 + v0 + fr;
#pragma unroll
        for (int m8 = 0; m8 < 8; ++m8)
#pragma unroll
            for (int i = 0; i < 4; ++i) S[m8][i] = s0[(16 * m8 + 4 * fq + i) * 128];
        f32x4 o[4];
        dn_step<272>(lds, S, lds + DB_U0 + (v0 + fr) * 2, ((const float*)(a.ws + WS_EG))[2048 + su], fr, fq, o);
        float* op = ORAW + (size_t)(TP + sb * 16) * 512 + h * 128 + v0 + fr;
#pragma unroll
        for (int i = 0; i < 4; ++i) op[(size_t)(4 * fq + i) * 512] = o[0][i];
        float* so = a.out + O_SDS + (size_t)su * 128 * 128 + v0 + fr;
#pragma unroll
        for (int m8 = 0; m8 < 8; ++m8)
#pragma unroll
            for (int i = 0; i < 4; ++i) so[(16 * m8 + 4 * fq + i) * 128] = S[m8][i];
        __syncthreads();
    }
}

DI void mix_phase(const Args& a, int gw, int NGW, int lane) {
    asm volatile("" : "+v"(lane));
    const float* ORAW = (const float*)(a.ws + WS_H);
    const bf16* P = (const bf16*)(a.ws + WS_P);
    const bf16* GLU = (const bf16*)(a.ws + WS_GLU);
    bf16* MIX = (bf16*)(a.ws + WS_DNC);
    const f32x2 dg = *(const f32x2*)(a.in[12] + 2 * lane);
    const f32x4 sg0 = *(const f32x4*)(a.in[23] + 8 * lane), sg1 = *(const f32x4*)(a.in[23] + 8 * lane + 4);
    constexpr int NR = 4;
    for (int row0 = gw; row0 < T; row0 += NR * NGW) {
        f32x2 ov[NR][4]; unsigned zz[NR][4]; u32x4 gv[NR]; float ssq[NR][5];
#pragma unroll
        for (int r = 0; r < NR; ++r) { const size_t row = row0 + r * NGW < T ? row0 + r * NGW : row0;
#pragma unroll
            for (int h = 0; h < 4; ++h) { ov[r][h] = *(const f32x2*)(ORAW + row * 512 + h * 128 + 2 * lane); zz[r][h] = *(const unsigned*)(P + row * PW + 1536 + h * 128 + 2 * lane); }
            gv[r] = *(const u32x4*)(GLU + row * 512 + 8 * lane); }
#pragma unroll
        for (int r = 0; r < NR; ++r) {
#pragma unroll
            for (int h = 0; h < 4; ++h) ssq[r][h] = ov[r][h].x * ov[r][h].x + ov[r][h].y * ov[r][h].y;
            const float v[8] = {blo(gv[r].x), bhi(gv[r].x), blo(gv[r].y), bhi(gv[r].y), blo(gv[r].z), bhi(gv[r].z), blo(gv[r].w), bhi(gv[r].w)};
            float ss = 0.f;
#pragma unroll
            for (int e = 0; e < 8; ++e) ss += v[e] * v[e];
            ssq[r][4] = ss; }
#pragma unroll
        for (int o = 1; o < 64; o <<= 1)
#pragma unroll
            for (int r = 0; r < NR; ++r)
#pragma unroll
                for (int k = 0; k < 5; ++k) ssq[r][k] += __shfl_xor(ssq[r][k], o);
#pragma unroll
        for (int r = 0; r < NR; ++r) if (r == 0 || row0 + r * NGW < T) { const size_t row = row0 + r * NGW;
#pragma unroll
            for (int h = 0; h < 4; ++h) { const float rr = rsqrtf(ssq[r][h] * (1.f / 128.f) + EPS);
                *(unsigned*)(MIX + row * DM + h * 128 + 2 * lane) = pk2(ov[r][h].x * rr * dg.x * silu(blo(zz[r][h])), ov[r][h].y * rr * dg.y * silu(bhi(zz[r][h]))); }
            const float v[8] = {blo(gv[r].x), bhi(gv[r].x), blo(gv[r].y), bhi(gv[r].y), blo(gv[r].z), bhi(gv[r].z), blo(gv[r].w), bhi(gv[r].w)};
            const float r5 = rsqrtf(ssq[r][4] * (1.f / 512.f) + EPS);
            u32x4 w; w.x = pk2(v[0] * r5 * sg0[0], v[1] * r5 * sg0[1]); w.y = pk2(v[2] * r5 * sg0[2], v[3] * r5 * sg0[3]);
            w.z = pk2(v[4] * r5 * sg1[0], v[5] * r5 * sg1[1]); w.w = pk2(v[6] * r5 * sg1[2], v[7] * r5 * sg1[3]);
            *(u32x4*)(MIX + row * DM + 512 + 8 * lane) = w; }
    }
}

DI void act_phase(const Args& a, int gtid, int NT) {
    asm volatile("" : "+v"(gtid));
    bf16* UP = (bf16*)(a.ws + WS_UP);
    const float* fw = a.in[27]; const float* fb = a.in[28];
    constexpr int NCG = DFF / 8;
    for (int item = gtid; item < (T / 16) * NCG; item += NT) {
        const int cg8 = item % NCG, rb = item / NCG, col = cg8 * 8, row0 = rb * 16;
        float w0[8], w1[8], w2[8], bb[8], g2[8], g1[8];
#pragma unroll
        for (int e = 0; e < 8; ++e) { w0[e] = fw[col + e]; w1[e] = fw[DFF + col + e]; w2[e] = fw[2 * DFF + col + e]; bb[e] = fb[col + e]; g2[e] = 0.f; g1[e] = 0.f; }
        const bool sample = row0 >= TP;
        float* outp = nullptr;
        if (sample) { const int sb = (row0 - TP) >> 4; const float* cc = a.in[6] + (size_t)sb * 2 * DFF + col;
#pragma unroll
            for (int e = 0; e < 8; ++e) { g2[e] = cc[e]; g1[e] = cc[DFF + e]; }
            outp = a.out + O_SFC + (size_t)sb * 2 * DFF + col;
        } else {
            if ((rb & 511) != 0) {
                const u32x4 x2 = *(const u32x4*)(UP + (size_t)(row0 - 2) * UPW + col), x1 = *(const u32x4*)(UP + (size_t)(row0 - 1) * UPW + col);
                g2[0] = blo(x2.x); g2[1] = bhi(x2.x); g2[2] = blo(x2.y); g2[3] = bhi(x2.y); g2[4] = blo(x2.z); g2[5] = bhi(x2.z); g2[6] = blo(x2.w); g2[7] = bhi(x2.w);
                g1[0] = blo(x1.x); g1[1] = bhi(x1.x); g1[2] = blo(x1.y); g1[3] = bhi(x1.y); g1[4] = blo(x1.z); g1[5] = bhi(x1.z); g1[6] = blo(x1.w); g1[7] = bhi(x1.w);
            }
            if ((rb & 511) == 511) outp = a.out + O_PFC + (size_t)(rb >> 9) * 2 * DFF + col;
        }
#pragma unroll 4
        for (int r = 0; r < 16; ++r) {
            bf16* gp = UP + (size_t)(row0 + r) * UPW + col;
            const u32x4 xg = *(const u32x4*)gp, xv = *(const u32x4*)(gp + DFF);
            float g0[8] = {blo(xg.x), bhi(xg.x), blo(xg.y), bhi(xg.y), blo(xg.z), bhi(xg.z), blo(xg.w), bhi(xg.w)};
            float vv[8] = {blo(xv.x), bhi(xv.x), blo(xv.y), bhi(xv.y), blo(xv.z), bhi(xv.z), blo(xv.w), bhi(xv.w)};
            float o[8];
#pragma unroll
            for (int e = 0; e < 8; ++e) { o[e] = silu(g2[e] * w0[e] + g1[e] * w1[e] + g0[e] * w2[e] + bb[e]) * vv[e]; g2[e] = g1[e]; g1[e] = g0[e]; }
            u32x4 w; w.x = pk2(o[0], o[1]); w.y = pk2(o[2], o[3]); w.z = pk2(o[4], o[5]); w.w = pk2(o[6], o[7]);
            *(u32x4*)(gp + DFF) = w;
            if (outp && r >= 14) {
#pragma unroll
                for (int e = 0; e < 8; ++e) outp[(r - 14) * DFF + e] = g0[e];
            }
        }
    }
}

DI void act_fix_phase(const Args& a, int gtid, int NT) {
    asm volatile("" : "+v"(gtid));
    bf16* ACT = (bf16*)(a.ws + WS_UP);
    const bf16* GH = (const bf16*)(a.ws + WS_GH); const bf16* GT = (const bf16*)(a.ws + WS_GT); const bf16* VH = (const bf16*)(a.ws + WS_VH);
    const float* fw = a.in[27]; const float* fb = a.in[28];
    constexpr int NCG = DFF / 8;
    for (int item = gtid; item < (T / 16) * NCG; item += NT) {
        const int cg8 = item % NCG, grp = item / NCG, col = cg8 * 8;
        float w0[8], w1[8], w2[8], bb[8], g2[8], g1[8], h0[8], h1[8], v0[8], v1[8];
#pragma unroll
        for (int e = 0; e < 8; ++e) { w0[e] = fw[col + e]; w1[e] = fw[DFF + col + e]; w2[e] = fw[2 * DFF + col + e]; bb[e] = fb[col + e]; g2[e] = 0.f; g1[e] = 0.f; }
        const bool sample = grp >= TP / 16;
        if (sample) { const float* cc = a.in[6] + (size_t)(grp - TP / 16) * 2 * DFF + col;
#pragma unroll
            for (int e = 0; e < 8; ++e) { g2[e] = cc[e]; g1[e] = cc[DFF + e]; }
        } else if ((grp & 511) != 0) {
            const u32x4 x2 = *(const u32x4*)(GT + ((size_t)(grp - 1) * 2) * DFF + col), x1 = *(const u32x4*)(GT + ((size_t)(grp - 1) * 2 + 1) * DFF + col);
            g2[0] = blo(x2.x); g2[1] = bhi(x2.x); g2[2] = blo(x2.y); g2[3] = bhi(x2.y); g2[4] = blo(x2.z); g2[5] = bhi(x2.z); g2[6] = blo(x2.w); g2[7] = bhi(x2.w);
            g1[0] = blo(x1.x); g1[1] = bhi(x1.x); g1[2] = blo(x1.y); g1[3] = bhi(x1.y); g1[4] = blo(x1.z); g1[5] = bhi(x1.z); g1[6] = blo(x1.w); g1[7] = bhi(x1.w);
        }
        {
            const u32x4 xa = *(const u32x4*)(GH + ((size_t)grp * 2) * DFF + col), xb = *(const u32x4*)(GH + ((size_t)grp * 2 + 1) * DFF + col);
            const u32x4 ya = *(const u32x4*)(VH + ((size_t)grp * 2) * DFF + col), yb = *(const u32x4*)(VH + ((size_t)grp * 2 + 1) * DFF + col);
            h0[0] = blo(xa.x); h0[1] = bhi(xa.x); h0[2] = blo(xa.y); h0[3] = bhi(xa.y); h0[4] = blo(xa.z); h0[5] = bhi(xa.z); h0[6] = blo(xa.w); h0[7] = bhi(xa.w);
            h1[0] = blo(xb.x); h1[1] = bhi(xb.x); h1[2] = blo(xb.y); h1[3] = bhi(xb.y); h1[4] = blo(xb.z); h1[5] = bhi(xb.z); h1[6] = blo(xb.w); h1[7] = bhi(xb.w);
            v0[0] = blo(ya.x); v0[1] = bhi(ya.x); v0[2] = blo(ya.y); v0[3] = bhi(ya.y); v0[4] = blo(ya.z); v0[5] = bhi(ya.z); v0[6] = blo(ya.w); v0[7] = bhi(ya.w);
            v1[0] = blo(yb.x); v1[1] = bhi(yb.x); v1[2] = blo(yb.y); v1[3] = bhi(yb.y); v1[4] = blo(yb.z); v1[5] = bhi(yb.z); v1[6] = blo(yb.w); v1[7] = bhi(yb.w);
        }
        float o0[8], o1[8];
#pragma unroll
        for (int e = 0; e < 8; ++e) { o0[e] = silu(g2[e] * w0[e] + g1[e] * w1[e] + h0[e] * w2[e] + bb[e]) * v0[e]; o1[e] = silu(g1[e] * w0[e] + h0[e] * w1[e] + h1[e] * w2[e] + bb[e]) * v1[e]; }
        u32x4 wa, wb; wa.x = pk2(o0[0], o0[1]); wa.y = pk2(o0[2], o0[3]); wa.z = pk2(o0[4], o0[5]); wa.w = pk2(o0[6], o0[7]);
        wb.x = pk2(o1[0], o1[1]); wb.y = pk2(o1[2], o1[3]); wb.z = pk2(o1[4], o1[5]); wb.w = pk2(o1[6], o1[7]);
        *(u32x4*)(ACT + ((size_t)grp * 16) * DFF + col) = wa; *(u32x4*)(ACT + ((size_t)grp * 16 + 1) * DFF + col) = wb;
        float* outp = nullptr;
        if (sample) outp = a.out + O_SFC + (size_t)(grp - TP / 16) * 2 * DFF + col;
        else if ((grp & 511) == 511) outp = a.out + O_PFC + (size_t)(grp >> 9) * 2 * DFF + col;
        if (outp) {
            const u32x4 t0 = *(const u32x4*)(GT + ((size_t)grp * 2) * DFF + col), t1 = *(const u32x4*)(GT + ((size_t)grp * 2 + 1) * DFF + col);
            outp[0] = blo(t0.x); outp[1] = bhi(t0.x); outp[2] = blo(t0.y); outp[3] = bhi(t0.y); outp[4] = blo(t0.z); outp[5] = bhi(t0.z); outp[6] = blo(t0.w); outp[7] = bhi(t0.w);
            outp[DFF + 0] = blo(t1.x); outp[DFF + 1] = bhi(t1.x); outp[DFF + 2] = blo(t1.y); outp[DFF + 3] = bhi(t1.y); outp[DFF + 4] = blo(t1.z); outp[DFF + 5] = bhi(t1.z); outp[DFF + 6] = blo(t1.w); outp[DFF + 7] = bhi(t1.w);
        }
    }
}

DI void final_phase(const Args& a, int gw, int NGW, int lane) {
    asm volatile("" : "+v"(lane));
    f32x4 gv[4];
#pragma unroll
    for (int j = 0; j < 4; ++j) gv[j] = ((const f32x4*)a.in[30])[lane + 64 * j];
    for (int m0 = gw; m0 < T; m0 += 2 * NGW) {
        const int m1 = m0 + NGW < T ? m0 + NGW : m0;
        f32x4* xr0 = (f32x4*)(a.out + (size_t)m0 * DM) + lane; f32x4* xr1 = (f32x4*)(a.out + (size_t)m1 * DM) + lane;
        f32x4 v0[4], v1[4]; float s0 = 0.f, s1 = 0.f;
#pragma unroll
        for (int j = 0; j < 4; ++j) { v0[j] = xr0[64 * j]; v1[j] = xr1[64 * j]; }
#pragma unroll
        for (int j = 0; j < 4; ++j) { s0 += (v0[j].x * v0[j].x + v0[j].y * v0[j].y) + (v0[j].z * v0[j].z + v0[j].w * v0[j].w); s1 += (v1[j].x * v1[j].x + v1[j].y * v1[j].y) + (v1[j].z * v1[j].z + v1[j].w * v1[j].w); }
        const float r0 = rsqrtf(wave_sum(s0) * (1.f / DM) + EPS), r1 = rsqrtf(wave_sum(s1) * (1.f / DM) + EPS);
#pragma unroll
        for (int j = 0; j < 4; ++j) xr0[64 * j] = v0[j] * r0 * gv[j];
        if (m1 != m0) {
#pragma unroll
            for (int j = 0; j < 4; ++j) xr1[64 * j] = v1[j] * r1 * gv[j];
        }
    }
}

#ifndef PH_MASK
#define PH_MASK 0xffff
#endif
#ifndef SOLVE_RL
#define SOLVE_RL 1
#endif
#ifndef REP0
#define REP0 1
#endif
#ifndef REP1
#define REP1 1
#endif
#ifndef REP2A
#define REP2A 1
#endif
#ifndef REP2B
#define REP2B 1
#endif
#ifndef REP3A
#define REP3A 1
#endif
#ifndef REP3B
#define REP3B 1
#endif
#ifndef REP3C
#define REP3C 1
#endif
#ifndef PH_LO
#define PH_LO 0
#endif
#ifndef PH_HI
#define PH_HI 99
#endif
__global__ void __launch_bounds__(512, 2) fwd_kernel(Args a) {
    extern __shared__ __attribute__((aligned(16))) unsigned char lds[];
    cg::grid_group grid = cg::this_grid();
    const int tid = threadIdx.x, lane = tid & 63, wave = __builtin_amdgcn_readfirstlane(tid >> 6);
    const int G = gridDim.x, gw = blockIdx.x * 8 + wave, NGW = G * 8;
    unsigned char* ws = a.ws;
    PG8_LAS unsigned char* ldsg = (PG8_LAS unsigned char*)lds;
    volatile LAS unsigned* xbst = (volatile LAS unsigned*)(ldsg + (LDS_BYTES - 64));
    if (tid < 2) xbst[tid] = 0u;
    __syncthreads();
    const XcdBarrier xbar = xcd_barrier_post((unsigned*)(ws + WS_CTL), xbst);

    _Pragma("nounroll") for (int rep = 0; rep < REP0; ++rep) { phase0(a, lds, gw, NGW, wave, lane); __syncthreads(); }
    xcd_barrier(xbar);
    if (a.out == nullptr) grid.sync();
    _Pragma("nounroll") for (int rep = 0; rep < REP1; ++rep)
    { pg8::Gemm g{(const bf16*)(ws + WS_H), (const bf16*)(ws + WS_WIN), T, NIN, DM, DM}; pg8::StaticOrder S; S.init(T, NIN, G, (int)blockIdx.x);
      EpiP E{(bf16*)(ws + WS_P), (float*)(ws + WS_BA)};
      pg8::gemm_phase<EpiP, pg8::StaticOrder, true, true>(ldsg, g, S, E); }
    xcd_barrier(xbar);
    _Pragma("nounroll") for (int rep = 0; rep < REP2A; ++rep) dn_chunk_phase(a, lds, tid, (int)blockIdx.x, 1024, G);
#if OLD_S5 && OLD_S5 != 4 && OLD_S5 != 5
    old_s5_pass1(a, gw, NGW, lane);
#elif 0
#else
    _Pragma("nounroll") for (int rep = 0; rep < REP2B; ++rep) s5_pass1(a, gw, NGW, lane);
#endif
    xcd_barrier(xbar);
#if OLD_S5 == 3
    if (blockIdx.x < 64) dn_scan_prompt(a, lds, tid);
    else { if (blockIdx.x >= 192) { dn_scan_sample(a, lds, tid, (int)blockIdx.x - 192, 128, 64); s5_pass2_sample(a, lds + 81920 + wave * 4352, ((int)blockIdx.x - 192) * 8 + wave, 512, lane); __syncthreads(); }
           old_s5_pass2(a, lds + 81920 + wave * 4352, gw - 512, NGW - 512, lane); }
#elif OLD_S5 == 5
    if (blockIdx.x < 64) { _Pragma("nounroll") for (int rep = 0; rep < REP3A; ++rep) dn_scan_prompt(a, lds, tid); }
    else {
        if (blockIdx.x >= 192) {
            const int w = (int)blockIdx.x - 192;
            dn_chunk_phase(a, lds, tid, 1024 + w, 1025 + w, 1);
            __threadfence_block(); __syncthreads();
            dn_scan_sample(a, lds, tid, 2 * w, 2 * w + 2, 1);
        }
        _Pragma("nounroll") for (int rep = 0; rep < REP3B; ++rep) s5_pass2b(a, lds + wave * 14592, gw - 512, NGW - 512, lane);
    }
#elif OLD_S5 == 1 || OLD_S5 == 4
    if (blockIdx.x < 64) dn_scan_prompt(a, lds, tid);
    else { if (blockIdx.x >= 192) dn_scan_sample(a, lds, tid, (int)blockIdx.x - 192, 128, 64); old_s5_pass2(a, lds + 81920 + wave * 4352, gw - 512, NGW - 512, lane); }
#else
    if (blockIdx.x < 64) { _Pragma("nounroll") for (int rep = 0; rep < REP3A; ++rep) dn_scan_prompt(a, lds, tid); }
    else if (blockIdx.x < 192) { _Pragma("nounroll") for (int rep = 0; rep < REP3B; ++rep) s5_pass2_prompt(a, lds, (int)blockIdx.x - 64, tid); }
    else { _Pragma("nounroll") for (int rep = 0; rep < REP3C; ++rep) { dn_scan_sample(a, lds, tid, (int)blockIdx.x - 192, 128, 64); s5_pass2_sample(a, lds + 81920 + wave * 4352, ((int)blockIdx.x - 192) * 8 + wave, 512, lane); } }
#endif
    xcd_barrier(xbar);
#if PH_MASK & 512
    { pg8::Gemm g{(const bf16*)(ws + WS_Y5), (const bf16*)(ws + WS_WGLU), T, 1024, 512, 512}; pg8::StaticOrder S; S.init(T, 1024, G, (int)blockIdx.x);
      EpiGlu E{(bf16*)(ws + WS_GLU), a.in[22]};
      pg8::gemm_phase<EpiGlu, pg8::StaticOrder, true, true>(ldsg, g, S, E); }
#endif
    xcd_barrier(xbar);
#if PH_MASK & 32
    mix_phase(a, gw, NGW, lane);
#endif
    xcd_barrier(xbar);
#if PH_MASK & 1024
    { pg8::Gemm g{(const bf16*)(ws + WS_DNC), (const bf16*)(ws + WS_WOUT), T, DM, DM, DM}; pg8::StaticOrder S; S.init(T, DM, G, (int)blockIdx.x);
      EpiX1 E{a.in[0], a.in[1], a.out, (bf16*)(ws + WS_H), (float*)(ws + WS_SS2)};
      pg8::gemm_phase<EpiX1, pg8::StaticOrder, true, true>(ldsg, g, S, E); }
#endif
    xcd_barrier(xbar);
#if FUSE_ACT
    { pg8::Gemm g{(const bf16*)(ws + WS_H), (const bf16*)(ws + WS_WUP), T, UPW, DM, DM}; pg8::StaticOrder S; S.init(T, UPW, G, (int)blockIdx.x);
      EpiUpAct E{(bf16*)(ws + WS_UP), (bf16*)(ws + WS_GH), (bf16*)(ws + WS_GT), (bf16*)(ws + WS_VH), (const float*)(ws + WS_SS2), a.in[27], a.in[28]};
      pg8::gemm_phase<EpiUpAct, pg8::StaticOrder, true, true>(ldsg, g, S, E); }
    xcd_barrier(xbar);
    act_fix_phase(a, (int)blockIdx.x * 512 + tid, G * 512);
    xcd_barrier(xbar);
    { pg8::Gemm g{(const bf16*)(ws + WS_UP), (const bf16*)(ws + WS_WDOWN), T, DM, DFF, DFF}; pg8::StaticOrder S; S.init(T, DM, G, (int)blockIdx.x);
      EpiX2 E{a.out};
      pg8::gemm_phase<EpiX2, pg8::StaticOrder, true, true>(ldsg, g, S, E); }
    xcd_barrier(xbar);
#else
#if PH_MASK & 2048
    { pg8::Gemm g{(const bf16*)(ws + WS_H), (const bf16*)(ws + WS_WUP), T, UPW, DM, DM}; pg8::StaticOrder S; S.init(T, UPW, G, (int)blockIdx.x);
      EpiUp E{(bf16*)(ws + WS_UP), (const float*)(ws + WS_SS2)};
      pg8::gemm_phase<EpiUp, pg8::StaticOrder, true, true>(ldsg, g, S, E); }
#endif
    xcd_barrier(xbar);
#if PH_MASK & 64
    act_phase(a, (int)blockIdx.x * 512 + tid, G * 512);
#endif
    xcd_barrier(xbar);
#if PH_MASK & 4096
    { pg8::Gemm g{(const bf16*)(ws + WS_UP) + DFF, (const bf16*)(ws + WS_WDOWN), T, DM, DFF, UPW}; pg8::StaticOrder S; S.init(T, DM, G, (int)blockIdx.x);
      EpiX2 E{a.out};
      pg8::gemm_phase<EpiX2, pg8::StaticOrder, true, true>(ldsg, g, S, E); }
#endif
    xcd_barrier(xbar);
#endif
#if PH_MASK & 128
    final_phase(a, gw, NGW, lane);
#endif
}

extern "C" void kernel_launch(void* const* d_in, const int* in_sizes, int n_in, void* d_out, int out_size, void* d_ws, size_t ws_size, hipStream_t stream) {
    static int grid = 0;
    if (grid == 0) {
        if (n_in != 31 || (size_t)out_size != O_END || ws_size < WS_END) { fprintf(stderr, "kernel_launch: unexpected shapes n_in %d out %d ws %zu\n", n_in, out_size, ws_size); grid = -1; return; }
        int dev = 0, cus = 0, per_cu = 0;
        hipGetDevice(&dev);
        hipDeviceGetAttribute(&cus, hipDeviceAttributeMultiprocessorCount, dev);
        hipFuncSetAttribute((const void*)fwd_kernel, hipFuncAttributeMaxDynamicSharedMemorySize, LDS_BYTES);
        hipOccupancyMaxActiveBlocksPerMultiprocessor(&per_cu, (const void*)fwd_kernel, 512, LDS_BYTES);
        if (per_cu < 1) { fprintf(stderr, "kernel_launch: occupancy query says %d blocks per CU\n", per_cu); per_cu = 1; }
        grid = cus * 1;
        if (grid != 256) { fprintf(stderr, "kernel_launch: built for a 256-CU device, got %d\n", cus); grid = -1; return; }
        (void)hipGetLastError();
    }
    if (grid < 0) return;
    if (hipMemsetAsync((char*)d_ws + WS_CTL, 0, 16384, stream) != hipSuccess) { fprintf(stderr, "kernel_launch: memset of the barrier words failed\n"); return; }
    Args a{};
    for (int i = 0; i < 31; ++i) a.in[i] = (const float*)d_in[i];
    a.out = (float*)d_out; a.ws = (unsigned char*)d_ws;
    void* args[] = {&a};
    hipError_t e = hipLaunchCooperativeKernel((const void*)fwd_kernel, dim3(grid), dim3(512), args, LDS_BYTES, stream);
    if (e != hipSuccess) fprintf(stderr, "cooperative launch failed: %s (grid %d)\n", hipGetErrorString(e), grid);
}
```

```cpp
#include <hip/hip_runtime.h>
#include <hip/hip_cooperative_groups.h>
#include <cstdio>
#include <cstdint>
namespace cg = cooperative_groups;
#define OLD_S5 5
#define DN_STAGED 3
namespace pg8 {
#define PG8_LAS __attribute__((address_space(3)))
typedef unsigned short bf16_t;
typedef short bf16x8 __attribute__((ext_vector_type(8)));
typedef float f32x4 __attribute__((ext_vector_type(4)));
typedef unsigned u32x4 __attribute__((ext_vector_type(4)));
constexpr int BM = 256, BK = 64, HALF = 128, HTB = HALF * BK * 2  , STAGE_BYTES = 8 * HTB, NXCD = 8, WGM = 8;

__host__ __device__ __forceinline__ int lds_byte(int r, int c) { const int st = (r >> 4) * 2 + (c >> 5), rr = r & 15, cc = c & 31, ob = rr * 64 + cc * 2; return st * 1024 + (ob ^ (((ob >> 9) & 1) << 5)); }
__host__ __device__ __forceinline__ void stage_rc(int b, int& R, int& C) { const int st = b / 1024, sb = b % 1024, swz = sb ^ (((sb >> 9) & 1) << 5); R = (st >> 1) * 16 + swz / 64; C = (st & 1) * 32 + (swz % 64) / 2; }
__host__ __device__ __forceinline__ int perm32(int rho) { const int n = rho >> 4, i = rho & 15; return 8 * (i >> 2) + 4 * n + (i & 3); }

struct Unit { int pm, pn; };
struct Gemm { const bf16_t* A; const bf16_t* Bt; int M, N, K, lda; };

struct StaticOrder {
    int nM, nN, nwg, G, c;
    __host__ __device__ void init(int M, int N, int G_, int c_) { nM = M / BM; nN = N / BM; nwg = nM * nN; G = G_; c = c_; }
    __host__ __device__ bool next(int i, Unit& u) const {
        const long L = (long)i * G + c; if (L >= nwg) return false;
        int wgid = (int)L; { const int q = nwg / NXCD, r = nwg % NXCD, xcd = wgid % NXCD, off = wgid / NXCD; wgid = (xcd < r ? xcd * (q + 1) : r * (q + 1) + (xcd - r) * q) + off; }
        const int nig = WGM * nN, gid = wgid / nig, fm = gid * WGM, gsz = (nM - fm) < WGM ? (nM - fm) : WGM;
        u.pm = fm + ((wgid % nig) % gsz); u.pn = (wgid % nig) / gsz; return true;
    }
    __device__ __forceinline__ void a_ready(const Unit&) const {}
    __device__ __forceinline__ void done(const Unit&) const {}
};
__device__ __forceinline__ unsigned cvt_pk_bf16(float lo, float hi) { unsigned r; asm volatile("v_cvt_pk_bf16_f32 %0, %1, %2" : "=v"(r) : "v"(lo), "v"(hi)); return r; }
typedef float f32x2 __attribute__((ext_vector_type(2)));
template <class Epi, class Sched, bool ALIGN_EPI = false, bool SP2 = false>
__device__ __forceinline__ void gemm_phase(PG8_LAS unsigned char* lds, const Gemm g, const Sched& S, const Epi& E) {
    int tid_ = threadIdx.x; asm volatile("" : "+v"(tid_));
    const int tid = tid_, wid = __builtin_amdgcn_readfirstlane(tid >> 6), lane = tid & 63, wr = wid >> 2, wc = wid & 3, fr = lane & 15, fq = lane >> 4;
    const int K = g.K, nt = K / BK;
    unsigned voffA[2], voffB[2];
#pragma unroll
    for (int i = 0; i < 2; ++i) { int R, C; stage_rc(tid * 16 + i * 8192, R, C); const int Rb = Epi::PERM ? ((R & ~31) + perm32(R & 31)) : R;
        voffA[i] = (unsigned)(R * g.lda + C) * 2u; voffB[i] = (unsigned)(Rb * K + C) * 2u; }
    const size_t kstep = (size_t)(BK * 2);
    const size_t hstep = (size_t)HALF * K * 2;
    const size_t tstep = 2 * hstep; const size_t hstepA = (size_t)HALF * g.lda * 2, tstepA = 2 * hstepA;
    const unsigned ldsw = (unsigned)wid * 1024u;
    const int aoff = lds_byte(wr * 64 + fr, fq * 8), boff = lds_byte(wc * 32 + fr, fq * 8);
#define PG8_SA(b, h) (((b) * 2 + (h)) * HTB)
#define PG8_SB(b, h) ((4 + (b) * 2 + (h)) * HTB)
#define PG8_STAGE(bufoff, gbase, voff) do { _Pragma("unroll") for (int _i = 0; _i < 2; ++_i) \
        __builtin_amdgcn_global_load_lds((const unsigned*)((const char*)(gbase) + (voff)[_i]), (PG8_LAS unsigned*)(lds + (bufoff) + ldsw + _i * 8192), 16, 0, 0); } while (0)
#define PG8_LDA(dst, b, h) do { _Pragma("unroll") for (int m = 0; m < 4; ++m) _Pragma("unroll") for (int k = 0; k < 2; ++k) dst[m][k] = *(const PG8_LAS bf16x8*)(lds + PG8_SA(b, h) + aoff + m * 2048 + k * 1024); } while (0)
#define PG8_LDB(dst, b, h) do { _Pragma("unroll") for (int n = 0; n < 2; ++n) _Pragma("unroll") for (int k = 0; k < 2; ++k) dst[n][k] = *(const PG8_LAS bf16x8*)(lds + PG8_SB(b, h) + boff + n * 2048 + k * 1024); } while (0)
#define PG8_MMA(ai, bj, At, Bt) do { __builtin_amdgcn_s_setprio(1); _Pragma("unroll") for (int m = 0; m < 4; ++m) _Pragma("unroll") for (int n = 0; n < 2; ++n) _Pragma("unroll") for (int k = 0; k < 2; ++k) \
        acc[ai][bj][m][n] = __builtin_amdgcn_mfma_f32_16x16x32_bf16(Bt[n][k], At[m][k], acc[ai][bj][m][n], 0, 0, 0); __builtin_amdgcn_s_setprio(0); } while (0)
#define PG8_WAIT_V(n) asm volatile("s_waitcnt vmcnt(" #n ")" ::: "memory")
#define PG8_WAIT_L(n) asm volatile("s_waitcnt lgkmcnt(" #n ")" ::: "memory")
#define PG8_BAR __builtin_amdgcn_s_barrier()
#define PG8_SCHED __builtin_amdgcn_sched_barrier(0)
    Unit cur, nxt; int ui = 0;
    if (!S.next(0, cur)) return;
    f32x4 acc[2][2][4][2];
#pragma unroll
    for (int a = 0; a < 2; ++a)
#pragma unroll
        for (int b = 0; b < 2; ++b)
#pragma unroll
            for (int m = 0; m < 4; ++m)
#pragma unroll
                for (int n = 0; n < 2; ++n) acc[a][b][m][n] = (f32x4){0.f, 0.f, 0.f, 0.f};
    bf16x8 At[4][2], B0[2][2], B1[2][2];
    const char* cA = (const char*)g.A + (size_t)cur.pm * tstepA; const char* cB = (const char*)g.Bt + (size_t)cur.pn * tstep;
    S.a_ready(cur);
    if constexpr (SP2) {
        PG8_STAGE(PG8_SB(0, 0), cB, voffB); PG8_STAGE(PG8_SB(0, 1), cB + hstep, voffB); PG8_STAGE(PG8_SA(0, 0), cA, voffA); PG8_STAGE(PG8_SA(0, 1), cA + hstepA, voffA);
        if (wr == 1) PG8_BAR;
        PG8_WAIT_V(2); PG8_BAR;
        PG8_STAGE(PG8_SB(1, 0), cB + kstep, voffB); PG8_STAGE(PG8_SA(1, 0), cA + kstep, voffA); PG8_STAGE(PG8_SB(1, 1), cB + hstep + kstep, voffB);
        PG8_WAIT_V(6); PG8_BAR;
    } else {
        PG8_STAGE(PG8_SB(0, 0), cB, voffB); PG8_STAGE(PG8_SA(0, 0), cA, voffA); PG8_STAGE(PG8_SB(0, 1), cB + hstep, voffB); PG8_STAGE(PG8_SA(0, 1), cA + hstepA, voffA);
        if (wr == 1) PG8_BAR;
        PG8_WAIT_V(4); PG8_BAR;
        PG8_STAGE(PG8_SB(1, 0), cB + kstep, voffB); PG8_STAGE(PG8_SA(1, 0), cA + kstep, voffA); PG8_STAGE(PG8_SB(1, 1), cB + hstep + kstep, voffB);
        PG8_WAIT_V(6); PG8_BAR;
    }
    for (;;) {
        const bool has_next = S.next(ui + 1, nxt);
        const char* nA = has_next ? (const char*)g.A + (size_t)nxt.pm * tstepA : cA; const char* nB = has_next ? (const char*)g.Bt + (size_t)nxt.pn * tstep : cB;
        for (int t = 0; t < nt; t += 2) {
            const bool last = (t == nt - 2);
            const char* a1 = cA + (size_t)(t + 1) * kstep;
            const char* a2 = last ? nA : cA + (size_t)(t + 2) * kstep; const char* b2 = last ? nB : cB + (size_t)(t + 2) * kstep;
            const char* a3 = a2 + kstep; const char* b3 = b2 + kstep;
            if (last && has_next) S.a_ready(nxt);
            if constexpr (SP2) {
            PG8_LDB(B0, 0, 0); PG8_LDB(B1, 0, 1); PG8_SCHED; PG8_LDA(At, 0, 0); PG8_STAGE(PG8_SA(1, 1), a1 + hstepA, voffA);
            PG8_WAIT_V(8); PG8_WAIT_L(0); PG8_BAR; PG8_MMA(0, 0, At, B0); PG8_MMA(0, 1, At, B1); PG8_BAR; PG8_SCHED;
            PG8_LDA(At, 0, 1); PG8_STAGE(PG8_SB(0, 0), b2, voffB); PG8_STAGE(PG8_SB(0, 1), b2 + hstep, voffB); PG8_STAGE(PG8_SA(0, 0), a2, voffA);
            PG8_WAIT_V(8); PG8_WAIT_L(0); PG8_BAR; PG8_MMA(1, 0, At, B0); PG8_MMA(1, 1, At, B1); PG8_BAR; PG8_SCHED;
            PG8_LDB(B0, 1, 0); PG8_LDB(B1, 1, 1); PG8_SCHED; PG8_LDA(At, 1, 0); PG8_STAGE(PG8_SA(0, 1), a2 + hstepA, voffA);
            PG8_WAIT_V(8); PG8_WAIT_L(0); PG8_BAR; PG8_MMA(0, 0, At, B0); PG8_MMA(0, 1, At, B1); PG8_BAR; PG8_SCHED;
            PG8_LDA(At, 1, 1); PG8_STAGE(PG8_SB(1, 0), b3, voffB); PG8_STAGE(PG8_SB(1, 1), b3 + hstep, voffB); PG8_STAGE(PG8_SA(1, 0), a3, voffA);
            PG8_WAIT_V(8); PG8_WAIT_L(0); PG8_BAR; PG8_MMA(1, 0, At, B0); PG8_MMA(1, 1, At, B1); PG8_BAR; PG8_SCHED;
            } else {
            PG8_LDB(B0, 0, 0); PG8_SCHED; PG8_LDA(At, 0, 0); PG8_STAGE(PG8_SA(1, 1), a1 + hstepA, voffA);
            PG8_WAIT_L(8); PG8_BAR; PG8_WAIT_L(0); PG8_MMA(0, 0, At, B0); PG8_BAR; PG8_SCHED;
            PG8_LDB(B1, 0, 1); PG8_STAGE(PG8_SB(0, 0), b2, voffB);
            PG8_BAR; PG8_WAIT_L(0); PG8_MMA(0, 1, At, B1); PG8_BAR;
            PG8_LDA(At, 0, 1); PG8_STAGE(PG8_SA(0, 0), a2, voffA);
            PG8_BAR; PG8_WAIT_L(0); PG8_MMA(1, 0, At, B0); PG8_BAR; PG8_SCHED;
            PG8_STAGE(PG8_SB(0, 1), b2 + hstep, voffB);
            PG8_WAIT_V(6); PG8_BAR; PG8_MMA(1, 1, At, B1); PG8_BAR;
            PG8_LDB(B0, 1, 0); PG8_SCHED; PG8_LDA(At, 1, 0); PG8_STAGE(PG8_SA(0, 1), a2 + hstepA, voffA);
            PG8_WAIT_L(8); PG8_BAR; PG8_WAIT_L(0); PG8_MMA(0, 0, At, B0); PG8_BAR; PG8_SCHED;
            PG8_LDB(B1, 1, 1); PG8_STAGE(PG8_SB(1, 0), b3, voffB);
            PG8_BAR; PG8_WAIT_L(0); PG8_MMA(0, 1, At, B1); PG8_BAR;
            PG8_LDA(At, 1, 1); PG8_STAGE(PG8_SA(1, 0), a3, voffA);
            PG8_BAR; PG8_WAIT_L(0); PG8_MMA(1, 0, At, B0); PG8_BAR; PG8_SCHED;
            PG8_STAGE(PG8_SB(1, 1), b3 + hstep, voffB);
            PG8_WAIT_V(6); PG8_BAR; PG8_MMA(1, 1, At, B1); PG8_BAR;
            }
        }
        if constexpr (ALIGN_EPI) { if (wr == 0) PG8_BAR; }
        if constexpr (!Epi::AFTER_DRAIN) { E(acc, cur, wr, wc, fr, fq); S.done(cur); }
        if (!has_next) break;
#pragma unroll
        for (int a = 0; a < 2; ++a)
#pragma unroll
            for (int b = 0; b < 2; ++b)
#pragma unroll
                for (int m = 0; m < 4; ++m)
#pragma unroll
                    for (int n = 0; n < 2; ++n) acc[a][b][m][n] = (f32x4){0.f, 0.f, 0.f, 0.f};
        cur = nxt; cA = nA; cB = nB; ++ui;
        if constexpr (ALIGN_EPI) { if (wr == 1) PG8_BAR; }
    }
    PG8_WAIT_V(0);
    if constexpr (!ALIGN_EPI) { if (wr == 0) PG8_BAR; }
    PG8_BAR;
    if constexpr (Epi::AFTER_DRAIN) { E.fused(acc, cur, wr, wc, fr, fq, lds, wid, lane); S.done(cur); }
#undef PG8_SA
#undef PG8_SB
#undef PG8_STAGE
#undef PG8_LDA
#undef PG8_LDB
#undef PG8_MMA
#undef PG8_WAIT_V
#undef PG8_WAIT_L
#undef PG8_BAR
#undef PG8_SCHED
}
}
#define LAS __attribute__((address_space(3)))
#define XB_TMO      128
#define XB_XCNT(j)  (256  + 64 * (j))
#define XB_XSUB(j)  (1280 + 64 * (j))
#define XB_XGEN(j)  (2304 + 64 * (j))
#define XB_TOP      3328
#define XB_TOPGEN   3392
#define XCD_BAR_WORDS 3456
#define XB_SPIN_CAP (1u << 18)

__device__ __forceinline__ unsigned xb_ld(unsigned* p)              { return __hip_atomic_load(p, __ATOMIC_RELAXED, __HIP_MEMORY_SCOPE_AGENT); }
__device__ __forceinline__ unsigned xb_add(unsigned* p, unsigned v) { return __hip_atomic_fetch_add(p, v, __ATOMIC_RELAXED, __HIP_MEMORY_SCOPE_AGENT); }
__device__ __forceinline__ unsigned xb_xcc_id() { return (unsigned)__builtin_amdgcn_s_getreg((3 << 11) | 20) & 0xFu; }
#define XB_SPIN(cond, bar) do { unsigned _sp = 0; while (cond) { __builtin_amdgcn_s_sleep(1); \
    if ((++_sp & 255u) == 0u) { if (xb_ld(&(bar)[XB_TMO])) break; if (_sp > XB_SPIN_CAP) { atomicAdd(&(bar)[XB_TMO], 1u); break; } } } } while (0)

struct XcdBarrier {
    unsigned* bar; unsigned x;
    volatile LAS unsigned* st;
};

__device__ __forceinline__ XcdBarrier xcd_barrier_post(unsigned* bar, volatile LAS unsigned* st) {
    XcdBarrier b; b.bar = bar; b.x = xb_xcc_id(); b.st = st;
    if (threadIdx.x == 0) (void)xb_add(&bar[XB_XCNT(b.x)], 1u);
    return b;
}
__device__ __forceinline__ void xcd_barrier_complete(unsigned* bar, unsigned x, unsigned& nloc, unsigned& nx) {
    const unsigned G = gridDim.x * gridDim.y * gridDim.z;
    unsigned sum, cnt, mine, sp = 0u;
    for (;;) {
        sum = 0u; cnt = 0u; mine = 0u;
#pragma unroll
        for (unsigned j = 0; j < 16; ++j) { const unsigned c = xb_ld(&bar[XB_XCNT(j)]); sum += c; cnt += (c > 0u) ? 1u : 0u; mine = (j == x) ? c : mine; }
        if (sum == G) break;
        __builtin_amdgcn_s_sleep(1);
        if ((++sp & 255u) == 0u) { if (xb_ld(&bar[XB_TMO])) break; if (sp > XB_SPIN_CAP) { atomicAdd(&bar[XB_TMO], 1u); break; } }
    }
    nloc = mine > 0u ? mine : 1u; nx = cnt > 0u ? cnt : 1u;
}

__device__ __forceinline__ void xcd_barrier(const XcdBarrier& b) {
    asm volatile("s_waitcnt vmcnt(0)" ::: "memory");
    __syncthreads();
    if (threadIdx.x == 0) {
        unsigned* bar = b.bar;
        __builtin_amdgcn_s_waitcnt(0);
        unsigned nloc = b.st[0], nx = b.st[1];
        if (nloc == 0u) { xcd_barrier_complete(bar, b.x, nloc, nx); b.st[0] = nloc; b.st[1] = nx; }
        const unsigned old = xb_add(&bar[XB_XSUB(b.x)], 1u);
        const unsigned gen = old / nloc;
        if (old + 1u == (gen + 1u) * nloc) {
            __builtin_amdgcn_fence(__ATOMIC_RELEASE, "agent");
            asm volatile("s_waitcnt vmcnt(0)" ::: "memory");
            const unsigned og = xb_add(&bar[XB_TOP], 1u);
            const unsigned tg = og / nx;
            if (og + 1u == (tg + 1u) * nx) xb_add(&bar[XB_TOPGEN], 1u);
            else XB_SPIN(xb_ld(&bar[XB_TOPGEN]) == tg, bar);
            __builtin_amdgcn_fence(__ATOMIC_ACQUIRE, "agent");
            xb_add(&bar[XB_XGEN(b.x)], 1u);
            asm volatile("s_waitcnt vmcnt(0)" ::: "memory");
        } else {
            XB_SPIN(xb_ld(&bar[XB_XGEN(b.x)]) == gen, bar);
            __builtin_amdgcn_fence(__ATOMIC_ACQUIRE, "agent");
            asm volatile("s_waitcnt vmcnt(0)" ::: "memory");
        }
    }
    __syncthreads();
}


#ifndef FUSE_ACT
#define FUSE_ACT 1
#endif
#ifndef DN_STAGED
#define DN_STAGED 1
#endif
#ifndef DIAG_Y
#define DIAG_Y 0
#endif
#ifndef OLD_S5
#define OLD_S5 0
#endif
#if OLD_S5 == 3
#define OLD_S5_ULIM 8192
#else
#define OLD_S5_ULIM (4 * 32 * 64 + 32 * 32)
#endif
#define DI __device__ __forceinline__
typedef unsigned short bf16;
typedef float f32x4 __attribute__((ext_vector_type(4)));
typedef float f32x2 __attribute__((ext_vector_type(2)));
typedef short bf16x8 __attribute__((ext_vector_type(8)));
typedef unsigned u32x4 __attribute__((ext_vector_type(4)));
typedef unsigned u32x2 __attribute__((ext_vector_type(2)));
typedef __bf16 bf16x2_t __attribute__((ext_vector_type(2)));

DI unsigned pk2(float lo, float hi) { f32x2 v = {lo, hi}; bf16x2_t b = __builtin_convertvector(v, bf16x2_t); return __builtin_bit_cast(unsigned, b); }
DI bf16 f2b(float x) { return (bf16)(pk2(x, 0.f) & 0xffffu); }
DI float b2f(unsigned b) { return __uint_as_float(b << 16); }
DI float blo(unsigned w) { return __uint_as_float(w << 16); }
DI float bhi(unsigned w) { return __uint_as_float(w & 0xffff0000u); }
DI float wave_sum(float v) {
#pragma unroll
    for (int o = 1; o < 64; o <<= 1) v += __shfl_xor(v, o);
    return v;
}
DI float sigm(float x) { return __builtin_amdgcn_rcpf(1.f + __expf(-x)); }
DI float silu(float x) { return x * __builtin_amdgcn_rcpf(1.f + __expf(-x)); }
DI float gelu_tanh(float x) { const float z = 1.5957691216057308f * (x + 0.044715f * x * x * x); return x * __builtin_amdgcn_rcpf(1.f + __expf(-z)); }
#define MFMA16(a, b, c) __builtin_amdgcn_mfma_f32_16x16x32_bf16((a), (b), (c), 0, 0, 0)

constexpr int TP = 32768, TS = 512, T = TP + TS;
constexpr int DM = 1024, PW = 2560, NIN = 2816, DFF = 2816, UPW = 5632;
constexpr float EPS = 1e-6f;
constexpr int NCH = 2048 + 128;
constexpr int REC = 73728;
constexpr int R_WN = 0, R_QG = 16384, R_KDT = 32768, R_QK = 49152, R_U0 = 57344;
constexpr size_t O_Y = 0, O_PDC = (size_t)T * DM, O_PDS = O_PDC + 4 * 3 * 1536, O_PSR = O_PDS + 4 * 4 * 128 * 128, O_PSI = O_PSR + 4 * 32 * 64,
                 O_PFC = O_PSI + 4 * 32 * 64, O_SDC = O_PFC + 4 * 2 * 2816, O_SDS = O_SDC + 32 * 3 * 1536, O_SSR = O_SDS + (size_t)32 * 4 * 128 * 128,
                 O_SSI = O_SSR + 32 * 32 * 64, O_SFC = O_SSI + 32 * 32 * 64, O_END = O_SFC + 32 * 2 * 2816;
constexpr size_t MiB = 1u << 20;
constexpr size_t WS_SS2 = 0;
constexpr size_t WS_EG = 3 * MiB;
constexpr size_t WS_CTL = 5 * MiB + 512 * 1024;
constexpr size_t WS_BA = 4 * MiB;
constexpr size_t WS_WIN = 6 * MiB, WS_WGLU = 12 * MiB, WS_WOUT = 13 * MiB, WS_WUP = 15 * MiB, WS_WDOWN = 26 * MiB;
constexpr size_t WS_H = 32 * MiB;
constexpr size_t WS_P = 98 * MiB;
constexpr size_t WS_DNC = 262 * MiB;
constexpr size_t WS_Y5 = 416 * MiB, WS_GLU = 449 * MiB, WS_S5E = 482 * MiB, WS_END = 487 * MiB;
constexpr size_t WS_GH = 300 * MiB, WS_GT = 324 * MiB, WS_VH = 348 * MiB;
constexpr size_t WS_UP = 98 * MiB;
static_assert(WS_UP + (size_t)T * UPW * 2 <= WS_END && WS_P + (size_t)T * PW * 2 <= WS_DNC && WS_DNC + (size_t)NCH * REC <= WS_Y5, "ws map");
constexpr int LDS_BYTES = 147456;

struct Args { const float* in[31]; float* out; unsigned char* ws; };

DI int colmap(int mode, int n) {
    if (mode == 0) return n;
    if (mode == 1) return n < 2048 ? n : (n < 2560 ? n + 8 : (n < 2568 ? n - 512 : -1));
    const int pn = n >> 8, bj = (n >> 7) & 1, j = n & 127;
    return bj * (mode == 2 ? 512 : 2816) + 128 * pn + j;
}
DI void transpose_item(const float* W, int K, int N, bf16* WT, float* scr, int kb, int nb, int lane, int mode, const float* rs) {
    const int k0 = 64 * kb, n0 = 32 * nb;
    const int sc = colmap(mode, n0 + (lane & 31));
    float tv[32];
#pragma unroll
    for (int i = 0; i < 32; ++i) { const int kk = 2 * i + (lane >> 5); tv[i] = 0.f; if (sc >= 0) tv[i] = W[(size_t)(k0 + kk) * N + sc]; }
#pragma unroll
    for (int i = 0; i < 32; ++i) { const int kk = 2 * i + (lane >> 5); float v = tv[i]; if (rs) v *= rs[k0 + kk]; scr[kk * 33 + (lane & 31)] = v; }
    asm volatile("s_waitcnt lgkmcnt(0)" ::: "memory");
    const int c = lane & 7;
#pragma unroll
    for (int j = 0; j < 4; ++j) { const int n = (lane >> 3) + 8 * j; const float* s = scr + (8 * c) * 33 + n;
        u32x4 o; o.x = pk2(s[0 * 33], s[1 * 33]); o.y = pk2(s[2 * 33], s[3 * 33]); o.z = pk2(s[4 * 33], s[5 * 33]); o.w = pk2(s[6 * 33], s[7 * 33]);
        *(u32x4*)(WT + (size_t)(n0 + n) * K + k0 + 8 * c) = o; }
    asm volatile("s_waitcnt lgkmcnt(0)" ::: "memory");
}
DI void phase0(const Args& a, unsigned char* lds, int gw, int NGW, int wave, int lane) {
    asm volatile("" : "+v"(lane));
    unsigned char* ws = a.ws;
    float* scr = (float*)(lds + wave * 16384);
    constexpr int I_IN = 16 * (NIN / 32), I_GLU = 8 * 32, I_OUT = 16 * 32, I_UP = 16 * (UPW / 32), I_DN = 44 * 32;
    constexpr int NIT = I_IN + I_GLU + I_OUT + I_UP + I_DN;
    for (int it = gw; it < NIT; it += NGW) {
        int r = it;
        if (r < I_IN) { transpose_item(a.in[8], 1024, 2568, (bf16*)(ws + WS_WIN), scr, r / (NIN / 32), r % (NIN / 32), lane, 1, nullptr); continue; } r -= I_IN;
        if (r < I_GLU) { transpose_item(a.in[21], 512, 1024, (bf16*)(ws + WS_WGLU), scr, r / 32, r % 32, lane, 2, nullptr); continue; } r -= I_GLU;
        if (r < I_OUT) { transpose_item(a.in[24], 1024, 1024, (bf16*)(ws + WS_WOUT), scr, r / 32, r % 32, lane, 0, nullptr); continue; } r -= I_OUT;
        if (r < I_UP) { transpose_item(a.in[26], 1024, 5632, (bf16*)(ws + WS_WUP), scr, r / (UPW / 32), r % (UPW / 32), lane, 3, a.in[25]); continue; } r -= I_UP;
        transpose_item(a.in[29], 2816, 1024, (bf16*)(ws + WS_WDOWN), scr, r / 32, r % 32, lane, 0, nullptr);
    }
    const float* g1 = a.in[7];
    f32x4 gv[4];
#pragma unroll
    for (int j = 0; j < 4; ++j) gv[j] = ((const f32x4*)g1)[lane + 64 * j];
    bf16* H = (bf16*)(ws + WS_H);
    for (int m0 = gw; m0 < T; m0 += 2 * NGW) {
        const int m1 = m0 + NGW < T ? m0 + NGW : m0;
        const f32x4* xr0 = (const f32x4*)(m0 < TP ? a.in[0] + (size_t)m0 * DM : a.in[1] + (size_t)(m0 - TP) * DM) + lane;
        const f32x4* xr1 = (const f32x4*)(m1 < TP ? a.in[0] + (size_t)m1 * DM : a.in[1] + (size_t)(m1 - TP) * DM) + lane;
        f32x4 v0[4], v1[4]; float s0 = 0.f, s1 = 0.f;
#pragma unroll
        for (int j = 0; j < 4; ++j) { v0[j] = xr0[64 * j]; v1[j] = xr1[64 * j]; }
#pragma unroll
        for (int j = 0; j < 4; ++j) { s0 += (v0[j].x * v0[j].x + v0[j].y * v0[j].y) + (v0[j].z * v0[j].z + v0[j].w * v0[j].w); s1 += (v1[j].x * v1[j].x + v1[j].y * v1[j].y) + (v1[j].z * v1[j].z + v1[j].w * v1[j].w); }
        const float r0 = rsqrtf(wave_sum(s0) * (1.f / DM) + EPS), r1 = rsqrtf(wave_sum(s1) * (1.f / DM) + EPS);
        u32x2* o0 = (u32x2*)(H + (size_t)m0 * DM) + lane; u32x2* o1 = (u32x2*)(H + (size_t)m1 * DM) + lane;
#pragma unroll
        for (int j = 0; j < 4; ++j) { u32x2 o; o.x = pk2(v0[j].x * r0 * gv[j].x, v0[j].y * r0 * gv[j].y); o.y = pk2(v0[j].z * r0 * gv[j].z, v0[j].w * r0 * gv[j].w); o0[64 * j] = o; }
        if (m1 != m0) {
#pragma unroll
            for (int j = 0; j < 4; ++j) { u32x2 o; o.x = pk2(v1[j].x * r1 * gv[j].x, v1[j].y * r1 * gv[j].y); o.y = pk2(v1[j].z * r1 * gv[j].z, v1[j].w * r1 * gv[j].w); o1[64 * j] = o; }
        }
    }
}

struct EpiP {
    static constexpr bool PERM = true, AFTER_DRAIN = false;
    bf16* P; float* BA;
    DI void operator()(const pg8::f32x4 (&acc)[2][2][4][2], const pg8::Unit& u, int wr, int wc, int fr, int fq) const {
        const int row0 = u.pm * 256 + wr * 64 + fr;
        if (u.pn < 10) {
            const int col0 = u.pn * 256 + wc * 32 + 8 * fq;
#pragma unroll
            for (int ai = 0; ai < 2; ++ai)
#pragma unroll
                for (int m = 0; m < 4; ++m) { bf16* rowp = P + (size_t)(row0 + ai * 128 + m * 16) * PW + col0;
#pragma unroll
                    for (int bj = 0; bj < 2; ++bj) { const pg8::f32x4 v0 = acc[ai][bj][m][0], v1 = acc[ai][bj][m][1];
                        u32x4 w; w.x = pk2(v0[0], v0[1]); w.y = pk2(v0[2], v0[3]); w.z = pk2(v1[0], v1[1]); w.w = pk2(v1[2], v1[3]);
                        *(u32x4*)(rowp + bj * 128) = w; } }
        } else if (wc == 0 && fq == 0) {
#pragma unroll
            for (int ai = 0; ai < 2; ++ai)
#pragma unroll
                for (int m = 0; m < 4; ++m) { float* bp = BA + (size_t)(row0 + ai * 128 + m * 16) * 8;
                    *(pg8::f32x4*)bp = acc[ai][0][m][0]; *(pg8::f32x4*)(bp + 4) = acc[ai][0][m][1]; }
        }
    }
};
struct EpiGlu {
    static constexpr bool PERM = true, AFTER_DRAIN = false;
    bf16* O; const float* gb;
    DI void operator()(const pg8::f32x4 (&acc)[2][2][4][2], const pg8::Unit& u, int wr, int wc, int fr, int fq) const {
        const int row0 = u.pm * 256 + wr * 64 + fr, col0 = u.pn * 128 + wc * 32 + 8 * fq;
        const pg8::f32x4 ba0 = *(const pg8::f32x4*)(gb + col0), ba1 = *(const pg8::f32x4*)(gb + col0 + 4), bg0 = *(const pg8::f32x4*)(gb + 512 + col0), bg1 = *(const pg8::f32x4*)(gb + 512 + col0 + 4);
#pragma unroll
        for (int ai = 0; ai < 2; ++ai)
#pragma unroll
            for (int m = 0; m < 4; ++m) {
                const pg8::f32x4 a0 = acc[ai][0][m][0] + ba0, a1 = acc[ai][0][m][1] + ba1, g0 = acc[ai][1][m][0] + bg0, g1 = acc[ai][1][m][1] + bg1;
                float o[8];
#pragma unroll
                for (int e = 0; e < 4; ++e) { o[e] = a0[e] * sigm(g0[e]); o[4 + e] = a1[e] * sigm(g1[e]); }
                u32x4 w; w.x = pk2(o[0], o[1]); w.y = pk2(o[2], o[3]); w.z = pk2(o[4], o[5]); w.w = pk2(o[6], o[7]);
                *(u32x4*)(O + (size_t)(row0 + ai * 128 + m * 16) * 512 + col0) = w;
            }
    }
};
struct EpiX1 {
    static constexpr bool PERM = false, AFTER_DRAIN = false;
    const float* xp; const float* xs; float* out; bf16* xb; float* ss2;
    DI void operator()(const pg8::f32x4 (&acc)[2][2][4][2], const pg8::Unit& u, int wr, int wc, int fr, int fq) const {
        const int row0 = u.pm * 256 + wr * 64 + fr, col0 = u.pn * 256 + wc * 32 + 4 * fq;
#pragma unroll
        for (int ai = 0; ai < 2; ++ai)
#pragma unroll
            for (int m = 0; m < 4; ++m) {
                const int row = row0 + ai * 128 + m * 16;
                const float* xr = (row < TP ? xp + (size_t)row * DM : xs + (size_t)(row - TP) * DM) + col0;
                float ss = 0.f;
#pragma unroll
                for (int bj = 0; bj < 2; ++bj)
#pragma unroll
                    for (int n = 0; n < 2; ++n) {
                        const pg8::f32x4 v = *(const pg8::f32x4*)(xr + bj * 128 + n * 16) + acc[ai][bj][m][n];
                        *(pg8::f32x4*)(out + (size_t)row * DM + col0 + bj * 128 + n * 16) = v;
                        u32x2 w; w.x = pk2(v[0], v[1]); w.y = pk2(v[2], v[3]);
                        *(u32x2*)(xb + (size_t)row * DM + col0 + bj * 128 + n * 16) = w;
                        ss += (v[0] * v[0] + v[1] * v[1]) + (v[2] * v[2] + v[3] * v[3]);
                    }
                ss += __shfl_xor(ss, 16); ss += __shfl_xor(ss, 32);
                if (fq == 0) ss2[(size_t)row * 16 + u.pn * 4 + wc] = ss;
            }
    }
};
struct EpiUp {
    static constexpr bool PERM = true, AFTER_DRAIN = false;
    bf16* UP; const float* ss2;
    DI void operator()(const pg8::f32x4 (&acc)[2][2][4][2], const pg8::Unit& u, int wr, int wc, int fr, int fq) const {
        const int row0 = u.pm * 256 + wr * 64 + fr, col0 = u.pn * 128 + wc * 32 + 8 * fq;
#pragma unroll
        for (int ai = 0; ai < 2; ++ai)
#pragma unroll
            for (int m = 0; m < 4; ++m) {
                const int row = row0 + ai * 128 + m * 16;
                const pg8::f32x4* sp = (const pg8::f32x4*)(ss2 + (size_t)row * 16);
                const pg8::f32x4 s0 = sp[0], s1 = sp[1], s2 = sp[2], s3 = sp[3];
                const float tot = ((s0[0] + s0[1]) + (s0[2] + s0[3])) + ((s1[0] + s1[1]) + (s1[2] + s1[3])) + ((s2[0] + s2[1]) + (s2[2] + s2[3])) + ((s3[0] + s3[1]) + (s3[2] + s3[3]));
                const float r = rsqrtf(tot * (1.f / DM) + EPS);
                bf16* rowp = UP + (size_t)row * UPW + col0;
#pragma unroll
                for (int bj = 0; bj < 2; ++bj) { const pg8::f32x4 v0 = acc[ai][bj][m][0] * r, v1 = acc[ai][bj][m][1] * r;
                    u32x4 w; w.x = pk2(v0[0], v0[1]); w.y = pk2(v0[2], v0[3]); w.z = pk2(v1[0], v1[1]); w.w = pk2(v1[2], v1[3]);
                    *(u32x4*)(rowp + bj * DFF) = w; }
            }
    }
};
DI float dpp_shr1(float v) { return __int_as_float(__builtin_amdgcn_update_dpp(0, __float_as_int(v), 0x111, 0xf, 0xf, false)); }
DI float dpp_shr2(float v) { return __int_as_float(__builtin_amdgcn_update_dpp(0, __float_as_int(v), 0x112, 0xf, 0xf, false)); }
struct EpiUpAct {
    static constexpr bool PERM = true, AFTER_DRAIN = false;
    bf16* ACT; bf16* GH; bf16* GT; bf16* VH; const float* ss2; const float* fw; const float* fb;
    DI void operator()(const pg8::f32x4 (&acc)[2][2][4][2], const pg8::Unit& u, int wr, int wc, int fr, int fq) const {
        const int row0 = u.pm * 256 + wr * 64 + fr, col0 = u.pn * 128 + wc * 32 + 8 * fq;
        float w0[8], w1[8], w2[8], bb[8];
#pragma unroll
        for (int n = 0; n < 2; ++n) { const pg8::f32x4 a0 = *(const pg8::f32x4*)(fw + col0 + 4 * n), a1 = *(const pg8::f32x4*)(fw + DFF + col0 + 4 * n), a2 = *(const pg8::f32x4*)(fw + 2 * DFF + col0 + 4 * n), a3 = *(const pg8::f32x4*)(fb + col0 + 4 * n);
#pragma unroll
            for (int e = 0; e < 4; ++e) { w0[4 * n + e] = a0[e]; w1[4 * n + e] = a1[e]; w2[4 * n + e] = a2[e]; bb[4 * n + e] = a3[e]; } }
#pragma unroll
        for (int ai = 0; ai < 2; ++ai)
#pragma unroll
            for (int m = 0; m < 4; ++m) {
                const int row = row0 + ai * 128 + m * 16, grp = row >> 4;
                const pg8::f32x4* sp = (const pg8::f32x4*)(ss2 + (size_t)row * 16);
                const pg8::f32x4 s0 = sp[0], s1 = sp[1], s2 = sp[2], s3 = sp[3];
                const float tot = ((s0[0] + s0[1]) + (s0[2] + s0[3])) + ((s1[0] + s1[1]) + (s1[2] + s1[3])) + ((s2[0] + s2[1]) + (s2[2] + s2[3])) + ((s3[0] + s3[1]) + (s3[2] + s3[3]));
                const float r = rsqrtf(tot * (1.f / DM) + EPS);
                float gs[8], vv[8], o[8];
#pragma unroll
                for (int n = 0; n < 2; ++n)
#pragma unroll
                    for (int e = 0; e < 4; ++e) { gs[4 * n + e] = acc[ai][0][m][n][e] * r; vv[4 * n + e] = acc[ai][1][m][n][e] * r; }
#pragma unroll
                for (int e = 0; e < 8; ++e) { const float g1 = dpp_shr1(gs[e]), g2 = dpp_shr2(gs[e]); o[e] = silu(g2 * w0[e] + g1 * w1[e] + gs[e] * w2[e] + bb[e]) * vv[e]; }
                u32x4 wg; wg.x = pk2(gs[0], gs[1]); wg.y = pk2(gs[2], gs[3]); wg.z = pk2(gs[4], gs[5]); wg.w = pk2(gs[6], gs[7]);
                if (fr >= 2) { u32x4 w; w.x = pk2(o[0], o[1]); w.y = pk2(o[2], o[3]); w.z = pk2(o[4], o[5]); w.w = pk2(o[6], o[7]);
                    *(u32x4*)(ACT + (size_t)row * DFF + col0) = w; }
                else { u32x4 wv; wv.x = pk2(vv[0], vv[1]); wv.y = pk2(vv[2], vv[3]); wv.z = pk2(vv[4], vv[5]); wv.w = pk2(vv[6], vv[7]);
                    *(u32x4*)(GH + ((size_t)grp * 2 + fr) * DFF + col0) = wg; *(u32x4*)(VH + ((size_t)grp * 2 + fr) * DFF + col0) = wv; }
                if (fr >= 14) *(u32x4*)(GT + ((size_t)grp * 2 + (fr - 14)) * DFF + col0) = wg;
            }
    }
};
struct EpiX2 {
    static constexpr bool PERM = false, AFTER_DRAIN = false;
    float* out;
    DI void operator()(const pg8::f32x4 (&acc)[2][2][4][2], const pg8::Unit& u, int wr, int wc, int fr, int fq) const {
        const int row0 = u.pm * 256 + wr * 64 + fr, col0 = u.pn * 256 + wc * 32 + 4 * fq;
#pragma unroll
        for (int ai = 0; ai < 2; ++ai)
#pragma unroll
            for (int m = 0; m < 4; ++m) {
                float* orow = out + (size_t)(row0 + ai * 128 + m * 16) * DM + col0;
#pragma unroll
                for (int bj = 0; bj < 2; ++bj)
#pragma unroll
                    for (int n = 0; n < 2; ++n) { pg8::f32x4* p = (pg8::f32x4*)(orow + bj * 128 + n * 16); *p = *p + acc[ai][bj][m][n]; }
            }
    }
};

DI int kperm(int k) { return (k & ~31) | (((k >> 2) & 3) << 3) | (((k >> 4) & 1) << 2) | (k & 3); }
DI void conv_col(const bf16* pcol, float h0, float h1, float h2, const float* cw, int nrows, float* outp, float (&val)[64]) {
    const float w0 = cw[0], w1 = cw[1536], w2 = cw[2 * 1536], w3 = cw[3 * 1536];
    float x3 = h0, x2 = h1, x1 = h2;
#pragma unroll
    for (int r = 0; r < 64; ++r) {
        float x0 = 0.f;
        if (r < nrows) x0 = b2f(pcol[(size_t)r * PW]);
        const float c = x3 * w0 + x2 * w1 + x1 * w2 + x0 * w3;
        val[r] = r < nrows ? silu(c) : 0.f;
        if (outp && r >= nrows - 3 && r < nrows) outp[(r - (nrows - 3)) * 1536] = x0;
        x3 = x2; x2 = x1; x1 = x0;
    }
}
DI void dn_chunk_phase(const Args& a, unsigned char* lds, int tid, int it0, int it1, int its) {
    unsigned char* ws = a.ws;
    const bf16* P = (const bf16*)(ws + WS_P);
    const float* BA = (const float*)(ws + WS_BA);
    const float* cwt = a.in[9];
    constexpr float QSCALE = 0.08838834764831845f;
    for (int it = it0; it < it1; it += its) {
        int tl = tid; asm volatile("" : "+v"(tl));
        const int half = __builtin_amdgcn_readfirstlane(tl >> 8), t8 = tl & 255, hw = __builtin_amdgcn_readfirstlane((tl >> 6) & 3), lane = tl & 63, fr = lane & 15, fq = lane >> 4;
        unsigned char* L = lds + half * 53248;
        unsigned char* qb = L; unsigned char* kb = L + 17408;
        float* Am = (float*)(L + 34816);
        float* Gs = (float*)(L + 51200); float* Bs = Gs + 64; float* RQ = Gs + 128; float* RK = Gs + 192; float* EG = Gs + 256;
        const int unit = it * 2 + half;
        int row0, nrows, h, bidx; bool sample, first, lastc;
        if (unit < 2048) { const int b = unit >> 9, n = unit & 127; h = (unit >> 7) & 3; row0 = b * 8192 + n * 64; nrows = 64; sample = false; first = (n == 0); lastc = (n == 127); bidx = b; }
        else { const int su = unit - 2048; bidx = su >> 2; h = su & 3; row0 = TP + bidx * 16; nrows = 16; sample = true; first = false; lastc = true; }
        unsigned char* rec = ws + WS_DNC + (size_t)unit * REC;
        if (hw == 0) {
            float g = 0.f, be = 0.f;
            if (lane < nrows) {
                const float* bp = BA + (size_t)(row0 + lane) * 8;
                be = sigm(bp[h]);
                const float xx = bp[4 + h] + a.in[11][h];
                const float sp = xx > 20.f ? xx : log1pf(__expf(xx));
                g = -__expf(a.in[10][h]) * sp;
            }
#pragma unroll
            for (int o = 1; o < 64; o <<= 1) { const float v = __shfl_up(g, o); if (lane >= o) g += v; }
            Gs[lane] = g; Bs[lane] = be; EG[lane] = __expf(g);
            if (lane == 63) ((float*)(ws + WS_EG))[unit] = __expf(g);
        }
        float va[64];
        {
            const int c = t8 & 127;
            const int col = (t8 < 128 ? 0 : 512) + h * 128 + c;
            float h0 = 0.f, h1 = 0.f, h2 = 0.f;
            if (sample) { const float* cc = a.in[2] + (size_t)bidx * 3 * 1536 + col; h0 = cc[0]; h1 = cc[1536]; h2 = cc[2 * 1536]; }
            else if (!first) { const bf16* pp = P + (size_t)(row0 - 3) * PW + col; h0 = b2f(pp[0]); h1 = b2f(pp[PW]); h2 = b2f(pp[2 * PW]); }
            float* outp = lastc ? a.out + (sample ? O_SDC : O_PDC) + (size_t)bidx * 3 * 1536 + col : nullptr;
            conv_col(P + (size_t)row0 * PW + col, h0, h1, h2, cwt + col, nrows, outp, va);
            unsigned char* dst = (t8 < 128 ? qb : kb) + c * 2;
#pragma unroll
            for (int r = 0; r < 64; ++r) *(bf16*)(dst + r * 272) = f2b(va[r]);
        }
        __syncthreads();
        f32x4 kk[4], qk[4], qq;
        {
            bf16x8 ak[4], aq[4];
#pragma unroll
            for (int ks = 0; ks < 4; ++ks) { ak[ks] = *(const bf16x8*)(kb + (16 * hw + fr) * 272 + ks * 64 + fq * 16); aq[ks] = *(const bf16x8*)(qb + (16 * hw + fr) * 272 + ks * 64 + fq * 16); }
            qq = (f32x4){0.f, 0.f, 0.f, 0.f};
#pragma unroll
            for (int ks = 0; ks < 4; ++ks) qq = MFMA16(aq[ks], aq[ks], qq);
#pragma unroll
            for (int nt = 0; nt < 4; ++nt) {
                kk[nt] = (f32x4){0.f, 0.f, 0.f, 0.f}; qk[nt] = (f32x4){0.f, 0.f, 0.f, 0.f};
#pragma unroll
                for (int ks = 0; ks < 4; ++ks) { const bf16x8 bk = *(const bf16x8*)(kb + (16 * nt + fr) * 272 + ks * 64 + fq * 16);
                    kk[nt] = MFMA16(ak[ks], bk, kk[nt]); qk[nt] = MFMA16(aq[ks], bk, qk[nt]); }
            }
#pragma unroll
            for (int i = 0; i < 4; ++i) if (fr == 4 * fq + i) {
                float dk = 0.f;
#pragma unroll
                for (int nt = 0; nt < 4; ++nt) if (nt == hw) dk = kk[nt][i];
                RK[16 * hw + fr] = rsqrtf(dk + EPS); RQ[16 * hw + fr] = rsqrtf(qq[i] + EPS);
            }
        }
        __syncthreads();
        {
            bf16* QKr = (bf16*)(rec + R_QK);
#pragma unroll
            for (int i = 0; i < 4; ++i) {
                const int row = 16 * hw + 4 * fq + i;
                const float gr = Gs[row], br = Bs[row], rk = RK[row], rq = RQ[row];
#pragma unroll
                for (int nt = 0; nt < 4; ++nt) {
                    const int col = 16 * nt + fr;
                    const float d = col <= row ? gr - Gs[col] : 0.f;
                    const float e = __expf(d), rkc = RK[col];
                    Am[row * 64 + col] = col < row ? br * kk[nt][i] * rk * rkc * e : 0.f;
                    QKr[row * 64 + kperm(col)] = f2b(col <= row ? qk[nt][i] * rq * rkc * QSCALE * e : 0.f);
                }
            }
        }
        __syncthreads();
        if (t8 < 128) {
            bf16* Qg = (bf16*)(rec + R_QG) + kperm(t8);
#pragma unroll
            for (int r = 0; r < 64; ++r) Qg[r * 128] = f2b(va[r] * RQ[r] * QSCALE * EG[r]);
            {
                const int col = 1024 + h * 128 + t8;
                float h0 = 0.f, h1 = 0.f, h2 = 0.f;
                if (sample) { const float* cc = a.in[2] + (size_t)bidx * 3 * 1536 + col; h0 = cc[0]; h1 = cc[1536]; h2 = cc[2 * 1536]; }
                else if (!first) { const bf16* pp = P + (size_t)(row0 - 3) * PW + col; h0 = b2f(pp[0]); h1 = b2f(pp[PW]); h2 = b2f(pp[2 * PW]); }
                float* outp = lastc ? a.out + (sample ? O_SDC : O_PDC) + (size_t)bidx * 3 * 1536 + col : nullptr;
                conv_col(P + (size_t)row0 * PW + col, h0, h1, h2, cwt + col, nrows, outp, va);
            }
#pragma unroll
            for (int r = 0; r < 64; ++r) va[r] = va[r] * Bs[r];
        } else {
            const int c = t8 - 128;
            const float gl = Gs[63];
            unsigned w[32];
#pragma unroll
            for (int r = 0; r < 64; r += 2) w[kperm(r) >> 1] = pk2(va[r] * RK[r] * __expf(gl - Gs[r]), va[r + 1] * RK[r + 1] * __expf(gl - Gs[r + 1]));
            u32x4* dst = (u32x4*)(rec + R_KDT + c * 128);
#pragma unroll
            for (int j = 0; j < 8; ++j) dst[j] = (u32x4){w[4 * j], w[4 * j + 1], w[4 * j + 2], w[4 * j + 3]};
#pragma unroll
            for (int r = 0; r < 64; ++r) va[r] = va[r] * RK[r] * Bs[r] * EG[r];
        }
#if SOLVE_RL
        {
            float arow[64];
#pragma unroll
            for (int i = 1; i < 64; ++i) arow[i] = Am[i * 64 + lane];
#pragma unroll
            for (int i = 1; i < 64; ++i) {
                if (i < nrows) {
                    float acc0 = va[i], acc1 = 0.f;
#pragma unroll
                    for (int j = 0; j < i; ++j) { const float aij = __int_as_float(__builtin_amdgcn_readlane(__float_as_int(arow[i]), j)); if (j & 1) acc1 -= aij * va[j]; else acc0 -= aij * va[j]; }
                    va[i] = acc0 + acc1;
                }
            }
        }
#else
#pragma unroll
        for (int i = 1; i < 64; ++i) {
            float acc = va[i];
            const f32x4* Ar = (const f32x4*)(Am + i * 64);
#pragma unroll
            for (int j4 = 0; j4 < (i + 3) / 4; ++j4) {
                const f32x4 av = Ar[j4];
#pragma unroll
                for (int e = 0; e < 4; ++e) if (4 * j4 + e < i) acc -= av[e] * va[4 * j4 + e];
            }
            va[i] = acc;
        }
#endif
        if (t8 < 128) { bf16* U0 = (bf16*)(rec + R_U0) + t8;
#pragma unroll
            for (int r = 0; r < 64; ++r) U0[r * 128] = f2b(va[r]);
        } else { bf16* Wn = (bf16*)(rec + R_WN) + kperm(t8 - 128);
#pragma unroll
            for (int r = 0; r < 64; ++r) Wn[r * 128] = f2b(-va[r]);
        }
        __syncthreads();
    }
}

struct S5W { float lr[4], li[4]; bf16x8 bf[8]; };
DI void s5w_setup(const Args& a, int g, int fr, int fq, S5W& w) {
    const float dt = __expf(a.in[15][g]);
#pragma unroll
    for (int j = 0; j < 4; ++j) {
        const int p = 16 * j + fr;
        const float are = a.in[13][g * 64 + p], aim = a.in[14][g * 64 + p];
        const float mag = __expf(are * dt), ang = aim * dt;
        float sn, cs; sincosf(ang, &sn, &cs);
        const float lr = mag * cs, li = mag * sn;
        w.lr[j] = lr; w.li[j] = li;
        const float den = are * are + aim * aim;
        const float fre = ((lr - 1.f) * are + li * aim) / den, fim = (li * are - (lr - 1.f) * aim) / den;
        u32x4 wr = (u32x4){0u, 0u, 0u, 0u}, wi = (u32x4){0u, 0u, 0u, 0u};
        if (fq < 2) {
            const f32x4* br = (const f32x4*)(a.in[16] + (size_t)(g * 64 + p) * 16 + 8 * fq); const f32x4* bi = (const f32x4*)(a.in[17] + (size_t)(g * 64 + p) * 16 + 8 * fq);
            const f32x4 r0 = br[0], r1 = br[1], i0 = bi[0], i1 = bi[1];
            wr.x = pk2(fre * r0[0] - fim * i0[0], fre * r0[1] - fim * i0[1]); wr.y = pk2(fre * r0[2] - fim * i0[2], fre * r0[3] - fim * i0[3]);
            wr.z = pk2(fre * r1[0] - fim * i1[0], fre * r1[1] - fim * i1[1]); wr.w = pk2(fre * r1[2] - fim * i1[2], fre * r1[3] - fim * i1[3]);
            wi.x = pk2(fre * i0[0] + fim * r0[0], fre * i0[1] + fim * r0[1]); wi.y = pk2(fre * i0[2] + fim * r0[2], fre * i0[3] + fim * r0[3]);
            wi.z = pk2(fre * i1[0] + fim * r1[0], fre * i1[1] + fim * r1[1]); wi.w = pk2(fre * i1[2] + fim * r1[2], fre * i1[3] + fim * r1[3]);
        }
        w.bf[j] = __builtin_bit_cast(bf16x8, wr); w.bf[4 + j] = __builtin_bit_cast(bf16x8, wi);
    }
}
DI bf16x8 s5w_uload(const bf16* P, size_t row0, int SS, int ms, int g, int fr, int fq) {
    u32x4 v = (u32x4){0u, 0u, 0u, 0u};
    if (fq < 2) v = *(const u32x4*)(P + (row0 + (size_t)(fr >> 2) * SS + 4 * ms + (fr & 3)) * PW + 2048 + g * 16 + 8 * fq);
    return __builtin_bit_cast(bf16x8, v);
}
DI void s5w_step(const S5W& w, bf16x8 ua, float (&xr)[4], float (&xi)[4], unsigned (&xo)[4][4]) {
    f32x4 br[4], bi[4];
    const f32x4 z = (f32x4){0.f, 0.f, 0.f, 0.f};
#pragma unroll
    for (int j = 0; j < 4; ++j) { br[j] = MFMA16(ua, w.bf[j], z); bi[j] = MFMA16(ua, w.bf[4 + j], z); }
#pragma unroll
    for (int i = 0; i < 4; ++i)
#pragma unroll
        for (int j = 0; j < 4; ++j) {
            const float nr = w.lr[j] * xr[j] - w.li[j] * xi[j] + br[j][i], ni = w.lr[j] * xi[j] + w.li[j] * xr[j] + bi[j][i];
            xr[j] = nr; xi[j] = ni; xo[i][j] = pk2(nr, ni);
        }
#pragma unroll
    for (int j = 0; j < 8; ++j) asm volatile("" :: "v"(w.bf[j]));
    asm volatile("" :: "v"(ua));
}
DI void s5_pass1(const Args& a, int gw, int NGW, int lane) {
    asm volatile("" : "+v"(lane));
    const bf16* P = (const bf16*)(a.ws + WS_P);
    float* E = (float*)(a.ws + WS_S5E);
    const int fr = lane & 15, fq = lane >> 4;
    for (int unit = gw; unit < 4 * 32 * 16; unit += NGW) {
        const int sg = unit & 15, bg = unit >> 4, g = bg & 31, b = bg >> 5;
        S5W w; s5w_setup(a, g, fr, fq, w);
        float xr[4] = {0.f, 0.f, 0.f, 0.f}, xi[4] = {0.f, 0.f, 0.f, 0.f}; unsigned xo[4][4];
        const size_t row0 = (size_t)b * 8192 + sg * 512;
        bf16x8 ua = s5w_uload(P, row0, 128, 0, g, fr, fq);
        for (int ms = 0; ms < 32; ++ms) {
            const bf16x8 un = s5w_uload(P, row0, 128, ms + 1 < 32 ? ms + 1 : ms, g, fr, fq);
            s5w_step(w, ua, xr, xi, xo); ua = un;
        }
        float* e = E + ((size_t)bg * 64 + 4 * sg + fq) * 128;
#pragma unroll
        for (int j = 0; j < 4; ++j) { e[16 * j + fr] = xr[j]; e[64 + 16 * j + fr] = xi[j]; }
    }
}
DI void s5w_run(const Args& a, const S5W& w, const bf16x8 (&cf)[4], float Dg, unsigned char* xs, size_t row0, int SS, int nms, int g, int fr, int fq, float (&xr)[4], float (&xi)[4]) {
    const bf16* P = (const bf16*)(a.ws + WS_P);
    bf16* Y5 = (bf16*)(a.ws + WS_Y5);
    bf16x8 ua = s5w_uload(P, row0, SS, 0, g, fr, fq);
    for (int ms = 0; ms < nms; ++ms) {
        const bf16x8 un = s5w_uload(P, row0, SS, ms + 1 < nms ? ms + 1 : ms, g, fr, fq);
        float uu[4];
#pragma unroll
        for (int i = 0; i < 4; ++i) uu[i] = b2f(P[(row0 + (size_t)fq * SS + 4 * ms + i) * PW + 2048 + g * 16 + fr]);
        unsigned xo[4][4];
        s5w_step(w, ua, xr, xi, xo); ua = un;
#pragma unroll
        for (int i = 0; i < 4; ++i)
#pragma unroll
            for (int j = 0; j < 4; ++j) *(unsigned*)(xs + (4 * fq + i) * 272 + (16 * j + fr) * 4) = xo[i][j];
        asm volatile("s_waitcnt lgkmcnt(0)" ::: "memory");
        f32x4 y = (f32x4){0.f, 0.f, 0.f, 0.f};
        bf16x8 af[4];
#pragma unroll
        for (int ks = 0; ks < 4; ++ks) af[ks] = *(const bf16x8*)(xs + fr * 272 + ks * 64 + fq * 16);
        asm volatile("" ::: "memory");
#pragma unroll
        for (int ks = 0; ks < 4; ++ks) y = MFMA16(af[ks], cf[ks], y);
#if DIAG_Y
        {
            const float* cre = a.in[18] + (size_t)(g * 16 + fr) * 64; const float* cim = a.in[19] + (size_t)(g * 16 + fr) * 64;
#pragma unroll
            for (int i = 0; i < 4; ++i) { float acc = 0.f;
                for (int p = 0; p < 64; ++p) { const unsigned wv = *(const unsigned*)(xs + (4 * fq + i) * 272 + p * 4); acc += cre[p] * blo(wv) - cim[p] * bhi(wv); }
                y[i] = acc; }
        }
#endif
        asm volatile("" :: "v"(y));
#pragma unroll
        for (int ks = 0; ks < 4; ++ks) asm volatile("" :: "v"(af[ks]), "v"(cf[ks]));
#pragma unroll
        for (int i = 0; i < 4; ++i) {
            const size_t row = row0 + (size_t)fq * SS + 4 * ms + i;
            Y5[row * 512 + g * 16 + fr] = f2b(gelu_tanh(y[i] + Dg * uu[i]));
        }
    }
}
DI void s5_cfrag(const Args& a, int g, int fr, int fq, bf16x8 (&cf)[4]) {
#pragma unroll
    for (int ks = 0; ks < 4; ++ks) {
        const f32x4 cr = *(const f32x4*)(a.in[18] + (size_t)(g * 16 + fr) * 64 + 16 * ks + 4 * fq), ci = *(const f32x4*)(a.in[19] + (size_t)(g * 16 + fr) * 64 + 16 * ks + 4 * fq);
        u32x4 w; w.x = pk2(cr[0], -ci[0]); w.y = pk2(cr[1], -ci[1]); w.z = pk2(cr[2], -ci[2]); w.w = pk2(cr[3], -ci[3]);
        cf[ks] = __builtin_bit_cast(bf16x8, w);
    }
}
DI void s5_pass2_prompt(const Args& a, unsigned char* lds, int bg, int tid) {
    asm volatile("" : "+v"(tid));
    const int wave = __builtin_amdgcn_readfirstlane(tid >> 6), lane = tid & 63, fr = lane & 15, fq = lane >> 4;
    const int b = bg >> 5, g4 = (bg >> 2) & 7, part = bg & 3, g = 4 * g4 + (wave & 3);
    bg = b * 32 + g;
    unsigned char* xs = lds + wave * 4352;
    S5W w; s5w_setup(a, g, fr, fq, w);
    bf16x8 cf[4]; s5_cfrag(a, g, fr, fq, cf);
    const float Dg = a.in[20][g * 16 + fr];
    float pr[4], pi[4];
#pragma unroll
    for (int j = 0; j < 4; ++j) { pr[j] = w.lr[j]; pi[j] = w.li[j];
#pragma unroll
        for (int s = 0; s < 7; ++s) { const float nr = pr[j] * pr[j] - pi[j] * pi[j], ni = 2.f * pr[j] * pi[j]; pr[j] = nr; pi[j] = ni; } }
    const float* e = (const float*)(a.ws + WS_S5E) + (size_t)bg * 64 * 128;
    for (int uu = 0; uu < 2; ++uu) {
        const int sg = 4 * part + 2 * (wave >> 2) + uu, seg = 4 * sg + fq;
        float xr[4] = {0.f, 0.f, 0.f, 0.f}, xi[4] = {0.f, 0.f, 0.f, 0.f};
        for (int s = 0; s < 4 * sg + 3; ++s) {
            if (s < seg) {
#pragma unroll
                for (int j = 0; j < 4; ++j) { const float er = e[s * 128 + 16 * j + fr], ei = e[s * 128 + 64 + 16 * j + fr];
                    const float nr = pr[j] * xr[j] - pi[j] * xi[j] + er, ni = pr[j] * xi[j] + pi[j] * xr[j] + ei; xr[j] = nr; xi[j] = ni; }
            }
        }
        s5w_run(a, w, cf, Dg, xs, (size_t)b * 8192 + sg * 512, 128, 32, g, fr, fq, xr, xi);
        if (seg == 63) {
#pragma unroll
            for (int j = 0; j < 4; ++j) { a.out[O_PSR + (size_t)bg * 64 + 16 * j + fr] = xr[j]; a.out[O_PSI + (size_t)bg * 64 + 16 * j + fr] = xi[j]; }
        }
    }
}
DI void s5_pass2_sample(const Args& a, unsigned char* xs, int gw, int NGW, int lane) {
    asm volatile("" : "+v"(lane));
    const int fr = lane & 15, fq = lane >> 4;
    for (int unit = gw; unit < 256; unit += NGW) {
        const int g = unit & 31, q = unit >> 5, sb = 4 * q + fq;
        S5W w; s5w_setup(a, g, fr, fq, w);
        bf16x8 cf[4]; s5_cfrag(a, g, fr, fq, cf);
        const float Dg = a.in[20][g * 16 + fr];
        float xr[4], xi[4];
#pragma unroll
        for (int j = 0; j < 4; ++j) { xr[j] = a.in[4][(size_t)(sb * 32 + g) * 64 + 16 * j + fr]; xi[j] = a.in[5][(size_t)(sb * 32 + g) * 64 + 16 * j + fr]; }
        s5w_run(a, w, cf, Dg, xs, (size_t)TP + (size_t)q * 64, 16, 4, g, fr, fq, xr, xi);
#pragma unroll
        for (int j = 0; j < 4; ++j) { a.out[O_SSR + (size_t)(sb * 32 + g) * 64 + 16 * j + fr] = xr[j]; a.out[O_SSI + (size_t)(sb * 32 + g) * 64 + 16 * j + fr] = xi[j]; }
    }
}

struct S5Par { float lr, li; float bbr[16], bbi[16]; };
DI void s5_setup(const Args& a, int g, int p, S5Par& q) {
    const float are = a.in[13][g * 64 + p], aim = a.in[14][g * 64 + p], dt = __expf(a.in[15][g]);
    const float mag = __expf(are * dt), ang = aim * dt;
    float sn, cs; sincosf(ang, &sn, &cs);
    q.lr = mag * cs; q.li = mag * sn;
    const float den = are * are + aim * aim;
    const float fre = ((q.lr - 1.f) * are + q.li * aim) / den, fim = (q.li * are - (q.lr - 1.f) * aim) / den;
    const f32x4* br = (const f32x4*)(a.in[16] + (size_t)(g * 64 + p) * 16); const f32x4* bi = (const f32x4*)(a.in[17] + (size_t)(g * 64 + p) * 16);
#pragma unroll
    for (int j = 0; j < 4; ++j) { const f32x4 r = br[j], i = bi[j];
#pragma unroll
        for (int e = 0; e < 4; ++e) { q.bbr[4 * j + e] = fre * r[e] - fim * i[e]; q.bbi[4 * j + e] = fre * i[e] + fim * r[e]; } }
}
DI void s5_step4(const S5Par& q, float uv, float& xr, float& xi, unsigned (&xo)[4]) {
#pragma unroll
    for (int j = 0; j < 4; ++j) {
        float br = 0.f, bi = 0.f;
#pragma unroll
        for (int h = 0; h < 16; ++h) { const float uh = __int_as_float(__builtin_amdgcn_readlane(__float_as_int(uv), 16 * j + h)); br += q.bbr[h] * uh; bi += q.bbi[h] * uh; }
        const float nr = q.lr * xr - q.li * xi + br, ni = q.lr * xi + q.li * xr + bi;
        xr = nr; xi = ni; xo[j] = pk2(xr, xi);
    }
}
DI void old_s5_pass1(const Args& a, int gw, int NGW, int lane) {
    asm volatile("" : "+v"(lane));
    const bf16* P = (const bf16*)(a.ws + WS_P);
    float* E = (float*)(a.ws + WS_S5E);
    for (int unit = gw; unit < 4 * 32 * 64; unit += NGW) {
        const int seg = unit & 63, bg = unit >> 6, g = bg & 31, b = bg >> 5;
        S5Par q; s5_setup(a, g, lane, q);
        float xr = 0.f, xi = 0.f; unsigned xo[4];
        const bf16* up = P + (size_t)(b * 8192 + seg * 128 + (lane >> 4)) * PW + 2048 + g * 16 + (lane & 15);
#pragma unroll 2
        for (int t = 0; t < 128; t += 4) { const float uv = b2f(up[(size_t)t * PW]); s5_step4(q, uv, xr, xi, xo); }
        float* e = E + ((size_t)bg * 64 + seg) * 128;
        e[lane] = xr; e[64 + lane] = xi;
    }
}
DI void old_s5_pass2(const Args& a, unsigned char* xs  , int gw, int NGW, int lane) {
    asm volatile("" : "+v"(lane));
    const bf16* P = (const bf16*)(a.ws + WS_P);
    const float* E = (const float*)(a.ws + WS_S5E);
    bf16* Y5 = (bf16*)(a.ws + WS_Y5);
    const int fr = lane & 15, fq = lane >> 4;
    for (int unit = gw; unit < OLD_S5_ULIM; unit += NGW) {
        int g, row0, ntok, seg = 0, bg; bool sample;
        if (unit < 8192) { seg = unit & 63; bg = unit >> 6; g = bg & 31; row0 = (bg >> 5) * 8192 + seg * 128; ntok = 128; sample = false; }
        else { bg = unit - 8192; g = bg & 31; row0 = TP + (bg >> 5) * 16; ntok = 16; sample = true; }
        S5Par q; s5_setup(a, g, lane, q);
        float xr = 0.f, xi = 0.f;
        if (sample) { xr = a.in[4][(size_t)bg * 64 + lane]; xi = a.in[5][(size_t)bg * 64 + lane]; }
        else {
            float pr = q.lr, pi = q.li;
#pragma unroll
            for (int s = 0; s < 7; ++s) { const float nr = pr * pr - pi * pi, ni = 2.f * pr * pi; pr = nr; pi = ni; }
            const float* e = E + (size_t)bg * 64 * 128;
            for (int s = 0; s < seg; ++s) { const float er = e[s * 128 + lane], ei = e[s * 128 + 64 + lane]; const float nr = pr * xr - pi * xi + er, ni = pr * xi + pi * xr + ei; xr = nr; xi = ni; }
        }
        bf16x8 cf[4];
#pragma unroll
        for (int ks = 0; ks < 4; ++ks) {
            const f32x4 cr = *(const f32x4*)(a.in[18] + (size_t)(g * 16 + fr) * 64 + 16 * ks + 4 * fq), ci = *(const f32x4*)(a.in[19] + (size_t)(g * 16 + fr) * 64 + 16 * ks + 4 * fq);
            u32x4 w; w.x = pk2(cr[0], -ci[0]); w.y = pk2(cr[1], -ci[1]); w.z = pk2(cr[2], -ci[2]); w.w = pk2(cr[3], -ci[3]);
            cf[ks] = __builtin_bit_cast(bf16x8, w);
        }
        const float Dg = a.in[20][g * 16 + fr];
        const bf16* up = P + (size_t)(row0 + (lane >> 4)) * PW + 2048 + g * 16 + (lane & 15);
        for (int tb = 0; tb < ntok; tb += 16) {
#pragma unroll
            for (int j4 = 0; j4 < 4; ++j4) {
                const float uv = b2f(up[(size_t)(tb + 4 * j4) * PW]);
                unsigned xo[4]; s5_step4(q, uv, xr, xi, xo);
#pragma unroll
                for (int j = 0; j < 4; ++j) *(unsigned*)(xs + (4 * j4 + j) * 272 + lane * 4) = xo[j];
            }
            f32x4 y = (f32x4){0.f, 0.f, 0.f, 0.f};
#pragma unroll
            for (int ks = 0; ks < 4; ++ks) { const bf16x8 af = *(const bf16x8*)(xs + fr * 272 + ks * 64 + fq * 16); y = MFMA16(af, cf[ks], y); }
#pragma unroll
            for (int i = 0; i < 4; ++i) {
                const size_t row = (size_t)row0 + tb + 4 * fq + i;
                const float uu = b2f(P[row * PW + 2048 + g * 16 + fr]);
                Y5[row * 512 + g * 16 + fr] = f2b(gelu_tanh(y[i] + Dg * uu));
            }
        }
        if (sample) { a.out[O_SSR + (size_t)bg * 64 + lane] = xr; a.out[O_SSI + (size_t)bg * 64 + lane] = xi; }
        else if (seg == 63) { a.out[O_PSR + (size_t)bg * 64 + lane] = xr; a.out[O_PSI + (size_t)bg * 64 + lane] = xi; }
    }
}

DI void s5_pass2b(const Args& a, unsigned char* xs, int gw, int NGW, int lane) {
    asm volatile("" : "+v"(lane));
    const bf16* P = (const bf16*)(a.ws + WS_P);
    const float* E = (const float*)(a.ws + WS_S5E);
    bf16* Y5 = (bf16*)(a.ws + WS_Y5);
    const int fr = lane & 15, fq = lane >> 4;
    for (int unit = gw; unit < 4 * 32 * 64 + 32 * 32; unit += NGW) {
        int g, row0, ntok, seg = 0, bg; bool sample;
        if (unit < 8192) { seg = unit & 63; bg = unit >> 6; g = bg & 31; row0 = (bg >> 5) * 8192 + seg * 128; ntok = 128; sample = false; }
        else { bg = unit - 8192; g = bg & 31; row0 = TP + (bg >> 5) * 16; ntok = 16; sample = true; }
        S5Par q; s5_setup(a, g, lane, q);
        float xr = 0.f, xi = 0.f;
        if (sample) { xr = a.in[4][(size_t)bg * 64 + lane]; xi = a.in[5][(size_t)bg * 64 + lane]; }
        else {
            float pr = q.lr, pi = q.li;
#pragma unroll
            for (int s = 0; s < 7; ++s) { const float nr = pr * pr - pi * pi, ni = 2.f * pr * pi; pr = nr; pi = ni; }
            const float* e = E + (size_t)bg * 64 * 128;
            for (int s0 = 0; s0 < seg; s0 += 8) {
                float er[8], ei[8];
#pragma unroll
                for (int k = 0; k < 8; ++k) { const bool ok = s0 + k < seg; er[k] = ok ? e[(s0 + k) * 128 + lane] : 0.f; ei[k] = ok ? e[(s0 + k) * 128 + 64 + lane] : 0.f; }
#pragma unroll
                for (int k = 0; k < 8; ++k) if (s0 + k < seg) { const float nr = pr * xr - pi * xi + er[k], ni = pr * xi + pi * xr + ei[k]; xr = nr; xi = ni; }
            }
        }
        bf16x8 cf[4];
#pragma unroll
        for (int ks = 0; ks < 4; ++ks) {
            const f32x4 cr = *(const f32x4*)(a.in[18] + (size_t)(g * 16 + fr) * 64 + 16 * ks + 4 * fq), ci = *(const f32x4*)(a.in[19] + (size_t)(g * 16 + fr) * 64 + 16 * ks + 4 * fq);
            u32x4 w; w.x = pk2(cr[0], -ci[0]); w.y = pk2(cr[1], -ci[1]); w.z = pk2(cr[2], -ci[2]); w.w = pk2(cr[3], -ci[3]);
            cf[ks] = __builtin_bit_cast(bf16x8, w);
        }
        const float Dg = a.in[20][g * 16 + fr];
        S5W w; s5w_setup(a, g, fr, fq, w);
        unsigned char* bt = xs + 4352;
        for (int tb = 0; tb < ntok; tb += 16) {
            {
                u32x4 uv = (u32x4){0u, 0u, 0u, 0u};
                if (fq < 2) uv = *(const u32x4*)(P + (size_t)(row0 + tb + fr) * PW + 2048 + g * 16 + 8 * fq);
                const bf16x8 ua = __builtin_bit_cast(bf16x8, uv);
                const f32x4 z = (f32x4){0.f, 0.f, 0.f, 0.f};
#pragma unroll
                for (int j = 0; j < 4; ++j) {
                    const f32x4 br = MFMA16(ua, w.bf[j], z), bi = MFMA16(ua, w.bf[4 + j], z);
                    *(f32x4*)(bt + (16 * j + fr) * 80 + fq * 16) = br; *(f32x4*)(bt + (64 + 16 * j + fr) * 80 + fq * 16) = bi;
                }
            }
            asm volatile("s_waitcnt lgkmcnt(0)" ::: "memory");
            f32x4 bre[4], bim[4];
#pragma unroll
            for (int k = 0; k < 4; ++k) { bre[k] = *(const f32x4*)(bt + lane * 80 + k * 16); bim[k] = *(const f32x4*)(bt + (64 + lane) * 80 + k * 16); }
            asm volatile("s_waitcnt lgkmcnt(0)" ::: "memory");
#pragma unroll
            for (int t = 0; t < 16; ++t) {
                const float nr = q.lr * xr - q.li * xi + bre[t >> 2][t & 3], ni = q.lr * xi + q.li * xr + bim[t >> 2][t & 3];
                xr = nr; xi = ni;
                *(unsigned*)(xs + t * 272 + lane * 4) = pk2(nr, ni);
            }
            asm volatile("s_waitcnt lgkmcnt(0)" ::: "memory");
            f32x4 y = (f32x4){0.f, 0.f, 0.f, 0.f};
#pragma unroll
            for (int ks = 0; ks < 4; ++ks) { const bf16x8 af = *(const bf16x8*)(xs + fr * 272 + ks * 64 + fq * 16); y = MFMA16(af, cf[ks], y); }
#pragma unroll
            for (int i = 0; i < 4; ++i) {
                const size_t row = (size_t)row0 + tb + 4 * fq + i;
                const float uu = b2f(P[row * PW + 2048 + g * 16 + fr]);
                Y5[row * 512 + g * 16 + fr] = f2b(gelu_tanh(y[i] + Dg * uu));
            }
        }
        if (sample) { a.out[O_SSR + (size_t)bg * 64 + lane] = xr; a.out[O_SSI + (size_t)bg * 64 + lane] = xi; }
        else if (seg == 63) { a.out[O_PSR + (size_t)bg * 64 + lane] = xr; a.out[O_PSI + (size_t)bg * 64 + lane] = xi; }
    }
}

constexpr int DB_WN = 0, DB_QG = 17408, DB_KDT = 34816, DB_QK = 53248, DB_U0 = 62464;
constexpr int DBP_SIZE = DB_U0 + 64 * 80;
constexpr int DBS_SIZE = DB_U0 + 64 * 272;
template <int NC> struct DnRegs { u32x4 r[7]; u32x4 u[NC == 32 ? 1 : 2]; };
template <int NC> DI void dn_load(const unsigned char* rec, int tid, int c0, DnRegs<NC>& R) {
    const u32x4* g = (const u32x4*)rec;
    R.r[0] = g[tid]; R.r[1] = g[tid + 512]; R.r[2] = g[1024 + tid]; R.r[3] = g[1024 + tid + 512]; R.r[4] = g[2048 + tid]; R.r[5] = g[2048 + tid + 512]; R.r[6] = g[3072 + tid];
    if (NC == 32) { if (tid < 256) R.u[0] = *(const u32x4*)(rec + R_U0 + (tid >> 2) * 256 + c0 * 2 + (tid & 3) * 16); }
    else { R.u[0] = *(const u32x4*)(rec + R_U0 + tid * 16); R.u[1] = *(const u32x4*)(rec + R_U0 + (tid + 512) * 16); }
}
template <int NC> DI void dn_store(unsigned char* buf, int tid, const DnRegs<NC>& R) {
#pragma unroll
    for (int j = 0; j < 2; ++j) { const int q = tid + 512 * j;
        *(u32x4*)(buf + DB_WN + (q >> 4) * 272 + (q & 15) * 16) = R.r[j];
        *(u32x4*)(buf + DB_QG + (q >> 4) * 272 + (q & 15) * 16) = R.r[2 + j];
        *(u32x4*)(buf + DB_KDT + (q >> 3) * 144 + (q & 7) * 16) = R.r[4 + j]; }
    *(u32x4*)(buf + DB_QK + (tid >> 3) * 144 + (tid & 7) * 16) = R.r[6];
    if (NC == 32) { if (tid < 256) *(u32x4*)(buf + DB_U0 + (tid >> 2) * 80 + (tid & 3) * 16) = R.u[0]; }
    else {
#pragma unroll
        for (int j = 0; j < 2; ++j) { const int q = tid + 512 * j; *(u32x4*)(buf + DB_U0 + (q >> 4) * 272 + (q & 15) * 16) = R.u[j]; }
    }
}
DI bf16x8 pack8(const f32x4& lo, const f32x4& hi) { u32x4 w; w.x = pk2(lo[0], lo[1]); w.y = pk2(lo[2], lo[3]); w.z = pk2(hi[0], hi[1]); w.w = pk2(hi[2], hi[3]); return __builtin_bit_cast(bf16x8, w); }
template <int UPI> DI void dn_step(const unsigned char* buf, f32x4 (&S)[8], const unsigned char* u0, float eg, int fr, int fq, f32x4 (&o)[4]) {
    bf16x8 Sb[4];
#pragma unroll
    for (int ks = 0; ks < 4; ++ks) Sb[ks] = pack8(S[2 * ks], S[2 * ks + 1]);
    f32x4 u[4];
#pragma unroll
    for (int mt = 0; mt < 4; ++mt) {
#pragma unroll
        for (int i = 0; i < 4; ++i) u[mt][i] = b2f(*(const bf16*)(u0 + (16 * mt + 4 * fq + i) * UPI));
#pragma unroll
        for (int ks = 0; ks < 4; ++ks) u[mt] = MFMA16(*(const bf16x8*)(buf + DB_WN + (16 * mt + fr) * 272 + ks * 64 + fq * 16), Sb[ks], u[mt]);
    }
    bf16x8 ub[2];
#pragma unroll
    for (int k2 = 0; k2 < 2; ++k2) ub[k2] = pack8(u[2 * k2], u[2 * k2 + 1]);
#pragma unroll
    for (int mt = 0; mt < 4; ++mt) {
        o[mt] = (f32x4){0.f, 0.f, 0.f, 0.f};
#pragma unroll
        for (int ks = 0; ks < 4; ++ks) o[mt] = MFMA16(*(const bf16x8*)(buf + DB_QG + (16 * mt + fr) * 272 + ks * 64 + fq * 16), Sb[ks], o[mt]);
#pragma unroll
        for (int k2 = 0; k2 < 2; ++k2) o[mt] = MFMA16(*(const bf16x8*)(buf + DB_QK + (16 * mt + fr) * 144 + k2 * 64 + fq * 16), ub[k2], o[mt]);
    }
#pragma unroll
    for (int m8 = 0; m8 < 8; ++m8) {
        S[m8] = S[m8] * eg;
#pragma unroll
        for (int k2 = 0; k2 < 2; ++k2) S[m8] = MFMA16(*(const bf16x8*)(buf + DB_KDT + (16 * m8 + fr) * 144 + k2 * 64 + fq * 16), ub[k2], S[m8]);
    }
}
#if DN_STAGED == 2
#define DNP_SYNC() do { asm volatile("s_waitcnt lgkmcnt(0)" ::: "memory"); __builtin_amdgcn_sched_barrier(0); } while (0)
#else
#define DNP_SYNC() do { } while (0)
#endif
DI void dn_step_p(const unsigned char* buf, f32x4 (&S)[8], const unsigned char* u0, float eg, int fr, int fq, f32x4 (&o)[4]) {
    const unsigned char* aw = buf + DB_WN + fr * 272 + fq * 16;
    const unsigned char* aq = buf + DB_QG + fr * 272 + fq * 16;
    const unsigned char* ak = buf + DB_KDT + fr * 144 + fq * 16;
    const unsigned char* ac = buf + DB_QK + fr * 144 + fq * 16;
    bf16x8 f1[16], f2[16], Sb[4], ub[2];
    f32x4 u[4];
#pragma unroll
    for (int mt = 0; mt < 4; ++mt)
#pragma unroll
        for (int ks = 0; ks < 4; ++ks) f1[4 * mt + ks] = *(const bf16x8*)(aw + mt * 4352 + ks * 64);
#pragma unroll
    for (int mt = 0; mt < 4; ++mt)
#pragma unroll
        for (int i = 0; i < 4; ++i) u[mt][i] = b2f(*(const bf16*)(u0 + (16 * mt + 4 * fq + i) * 80));
#pragma unroll
    for (int ks = 0; ks < 4; ++ks) Sb[ks] = pack8(S[2 * ks], S[2 * ks + 1]);
    __builtin_amdgcn_sched_barrier(0);
#pragma unroll
    for (int mt = 0; mt < 4; ++mt)
#pragma unroll
        for (int ks = 0; ks < 4; ++ks) f2[4 * mt + ks] = *(const bf16x8*)(aq + mt * 4352 + ks * 64);
    DNP_SYNC();
#pragma unroll
    for (int ks = 0; ks < 4; ++ks)
#pragma unroll
        for (int mt = 0; mt < 4; ++mt) u[mt] = MFMA16(f1[4 * mt + ks], Sb[ks], u[mt]);
    __builtin_amdgcn_sched_barrier(0);
#pragma unroll
    for (int k2 = 0; k2 < 2; ++k2) ub[k2] = pack8(u[2 * k2], u[2 * k2 + 1]);
#pragma unroll
    for (int m8 = 0; m8 < 8; ++m8)
#pragma unroll
        for (int k2 = 0; k2 < 2; ++k2) f1[2 * m8 + k2] = *(const bf16x8*)(ak + m8 * 2304 + k2 * 64);
    DNP_SYNC();
#pragma unroll
    for (int mt = 0; mt < 4; ++mt) o[mt] = (f32x4){0.f, 0.f, 0.f, 0.f};
#pragma unroll
    for (int ks = 0; ks < 4; ++ks)
#pragma unroll
        for (int mt = 0; mt < 4; ++mt) o[mt] = MFMA16(f2[4 * mt + ks], Sb[ks], o[mt]);
    __builtin_amdgcn_sched_barrier(0);
#pragma unroll
    for (int mt = 0; mt < 4; ++mt)
#pragma unroll
        for (int k2 = 0; k2 < 2; ++k2) f2[2 * mt + k2] = *(const bf16x8*)(ac + mt * 2304 + k2 * 64);
    DNP_SYNC();
#pragma unroll
    for (int m8 = 0; m8 < 8; ++m8) S[m8] = S[m8] * eg;
#pragma unroll
    for (int k2 = 0; k2 < 2; ++k2)
#pragma unroll
        for (int m8 = 0; m8 < 8; ++m8) S[m8] = MFMA16(f1[2 * m8 + k2], ub[k2], S[m8]);
    __builtin_amdgcn_sched_barrier(0);
#pragma unroll
    for (int k2 = 0; k2 < 2; ++k2)
#pragma unroll
        for (int mt = 0; mt < 4; ++mt) o[mt] = MFMA16(f2[2 * mt + k2], ub[k2], o[mt]);
}
DI void dn_step_o(const unsigned char* buf, f32x4 (&S)[8], const unsigned char* u0, float eg, int fr, int fq, f32x4 (&o)[4]) {
    const unsigned char* aw = buf + DB_WN + fr * 272 + fq * 16;
    const unsigned char* aq = buf + DB_QG + fr * 272 + fq * 16;
    const unsigned char* ak = buf + DB_KDT + fr * 144 + fq * 16;
    const unsigned char* ac = buf + DB_QK + fr * 144 + fq * 16;
    bf16x8 f1[16], f2[16], Sb[4], ub[2];
    f32x4 u[4];
#pragma unroll
    for (int ks = 0; ks < 4; ++ks) Sb[ks] = pack8(S[2 * ks], S[2 * ks + 1]);
    __builtin_amdgcn_sched_barrier(0);
#pragma unroll
    for (int mt = 0; mt < 4; ++mt)
#pragma unroll
        for (int ks = 0; ks < 4; ++ks) f1[4 * mt + ks] = *(const bf16x8*)(aw + mt * 4352 + ks * 64);
#pragma unroll
    for (int mt = 0; mt < 4; ++mt)
#pragma unroll
        for (int i = 0; i < 4; ++i) u[mt][i] = b2f(*(const bf16*)(u0 + (16 * mt + 4 * fq + i) * 80));
#pragma unroll
    for (int mt = 0; mt < 4; ++mt)
#pragma unroll
        for (int ks = 0; ks < 4; ++ks) f2[4 * mt + ks] = *(const bf16x8*)(aq + mt * 4352 + ks * 64);
    __builtin_amdgcn_sched_barrier(0);
#pragma unroll
    for (int ks = 0; ks < 4; ++ks)
#pragma unroll
        for (int mt = 0; mt < 4; ++mt) u[mt] = MFMA16(f1[4 * mt + ks], Sb[ks], u[mt]);
    __builtin_amdgcn_sched_barrier(0);
#pragma unroll
    for (int k2 = 0; k2 < 2; ++k2) ub[k2] = pack8(u[2 * k2], u[2 * k2 + 1]);
    __builtin_amdgcn_sched_barrier(0);
#pragma unroll
    for (int m8 = 0; m8 < 8; ++m8)
#pragma unroll
        for (int k2 = 0; k2 < 2; ++k2) f1[2 * m8 + k2] = *(const bf16x8*)(ak + m8 * 2304 + k2 * 64);
#pragma unroll
    for (int mt = 0; mt < 4; ++mt) o[mt] = (f32x4){0.f, 0.f, 0.f, 0.f};
#pragma unroll
    for (int ks = 0; ks < 4; ++ks)
#pragma unroll
        for (int mt = 0; mt < 4; ++mt) o[mt] = MFMA16(f2[4 * mt + ks], Sb[ks], o[mt]);
    __builtin_amdgcn_sched_barrier(0);
    { float dmy = (o[0][0] + o[1][0]) + (o[2][0] + o[3][0]); asm volatile("" :: "v"(dmy)); }
    __builtin_amdgcn_sched_barrier(0);
#pragma unroll
    for (int mt = 0; mt < 4; ++mt)
#pragma unroll
        for (int k2 = 0; k2 < 2; ++k2) f2[2 * mt + k2] = *(const bf16x8*)(ac + mt * 2304 + k2 * 64);
#pragma unroll
    for (int m8 = 0; m8 < 8; ++m8) S[m8] = S[m8] * eg;
#pragma unroll
    for (int k2 = 0; k2 < 2; ++k2)
#pragma unroll
        for (int m8 = 0; m8 < 8; ++m8) S[m8] = MFMA16(f1[2 * m8 + k2], ub[k2], S[m8]);
    __builtin_amdgcn_sched_barrier(0);
#pragma unroll
    for (int k2 = 0; k2 < 2; ++k2)
#pragma unroll
        for (int mt = 0; mt < 4; ++mt) o[mt] = MFMA16(f2[2 * mt + k2], ub[k2], o[mt]);
}
DI void dn_piece(int q, int c0, unsigned& src, unsigned& dst) {
    if (q < 1024) { src = R_WN + q * 16; dst = DB_WN + (q >> 4) * 272 + (q & 15) * 16; }
    else if (q < 2048) { const int p = q - 1024; src = R_QG + p * 16; dst = DB_QG + (p >> 4) * 272 + (p & 15) * 16; }
    else if (q < 3072) { const int p = q - 2048; src = R_KDT + p * 16; dst = DB_KDT + (p >> 3) * 144 + (p & 7) * 16; }
    else if (q < 3584) { const int p = q - 3072; src = R_QK + p * 16; dst = DB_QK + (p >> 3) * 144 + (p & 7) * 16; }
    else { const int p = q - 3584; src = R_U0 + (p >> 2) * 256 + c0 * 2 + (p & 3) * 16; dst = DB_U0 + (p >> 2) * 80 + (p & 3) * 16; }
}
#define DN_LD(R, base) do { _Pragma("unroll") for (int k = 0; k < 10; ++k) { unsigned s_, d_; dn_piece(lt + 384 * k, c0, s_, d_); R[k] = *(const u32x4*)((base) + s_); } } while (0)
#define DN_WAIT(R, cnt) do { } while (0)
#define DN_ST(R, buf) do { _Pragma("unroll") for (int k = 0; k < 10; ++k) { unsigned s_, d_; dn_piece(lt + 384 * k, c0, s_, d_); *(u32x4*)((buf) + d_) = R[k]; } } while (0)
#define DN_BAR() do { asm volatile("s_waitcnt lgkmcnt(0)" ::: "memory"); __builtin_amdgcn_s_barrier(); asm volatile("" ::: "memory"); } while (0)
DI void dn_scan_prompt(const Args& a, unsigned char* lds, int tid) {
    asm volatile("" : "+v"(tid));
    const int wave = __builtin_amdgcn_readfirstlane(tid >> 6), lane = tid & 63, fr = lane & 15, fq = lane >> 4;
    const int bh = blockIdx.x >> 2, qt = blockIdx.x & 3, b = bh >> 2, h = bh & 3;
    const int c0 = qt * 32, v0 = c0 + (wave & 1) * 16;
    const unsigned char* recs = a.ws + WS_DNC + (size_t)bh * 128 * REC;
    const float* egs = (const float*)(a.ws + WS_EG) + bh * 128;
    float* ORAW = (float*)(a.ws + WS_H);
    const bool loader = wave >= 2;
    const int lt = tid - 128;
    f32x4 S[8];
#pragma unroll
    for (int m8 = 0; m8 < 8; ++m8) S[m8] = (f32x4){0.f, 0.f, 0.f, 0.f};
    float egA = egs[lane], egB = egs[64 + lane];
    asm volatile("s_waitcnt vmcnt(0)" : "+v"(egA), "+v"(egB) :: "memory");
    if (loader) {
        const int grp = wave >= 5 ? 1 : 0, lt2 = tid - 128 - grp * 192;
        u32x4 R[20];
        unsigned srcs[20], dsts[20];
        _Pragma("unroll") for (int k = 0; k < 20; ++k) dn_piece(lt2 + 192 * k, c0, srcs[k], dsts[k]);
#define DN_LD20(base) do { _Pragma("unroll") for (int k = 0; k < 20; ++k) R[k] = *(const u32x4*)((base) + srcs[k]); } while (0)
#define DN_ST20(buf) do { _Pragma("unroll") for (int k = 0; k < 20; ++k) *(u32x4*)((buf) + dsts[k]) = R[k]; } while (0)
        if (grp == 0) { DN_LD20(recs); DN_ST20(lds); DN_LD20(recs + 2 * (size_t)REC); }
        else { DN_LD20(recs + REC); }
        DN_BAR();
        for (int n = 0; n < 128; n += 2) {
            if (grp == 1) { DN_ST20(lds + DBP_SIZE); if (n + 3 < 128) DN_LD20(recs + (size_t)(n + 3) * REC); }
            DN_BAR();
            if (grp == 0 && n + 2 < 128) { DN_ST20(lds); if (n + 4 < 128) DN_LD20(recs + (size_t)(n + 4) * REC); }
            DN_BAR();
        }
#undef DN_LD20
#undef DN_ST20
    } else {
        DN_BAR();
        for (int n = 0; n < 128; ++n) {
            const float eg0 = __int_as_float(__builtin_amdgcn_readlane(__float_as_int(n < 64 ? egA : egB), n & 63));
            f32x4 o[4];
#if DN_STAGED == 3
            dn_step_o(lds + (n & 1) * DBP_SIZE, S, lds + (n & 1) * DBP_SIZE + DB_U0 + ((wave & 1) * 16 + fr) * 2, eg0, fr, fq, o);
#elif DN_STAGED
            dn_step_p(lds + (n & 1) * DBP_SIZE, S, lds + (n & 1) * DBP_SIZE + DB_U0 + ((wave & 1) * 16 + fr) * 2, eg0, fr, fq, o);
#else
            dn_step<80>(lds + (n & 1) * DBP_SIZE, S, lds + (n & 1) * DBP_SIZE + DB_U0 + ((wave & 1) * 16 + fr) * 2, eg0, fr, fq, o);
#endif
            float* op = ORAW + (size_t)(b * 8192 + n * 64) * 512 + h * 128 + v0 + fr;
#pragma unroll
            for (int mt = 0; mt < 4; ++mt)
#pragma unroll
                for (int i = 0; i < 4; ++i) op[(size_t)(16 * mt + 4 * fq + i) * 512] = o[mt][i];
            DN_BAR();
        }
    }
    if (!loader) {
        float* so = a.out + O_PDS + (size_t)bh * 128 * 128 + v0 + fr;
#pragma unroll
        for (int m8 = 0; m8 < 8; ++m8)
#pragma unroll
            for (int i = 0; i < 4; ++i) so[(16 * m8 + 4 * fq + i) * 128] = S[m8][i];
    }
    __syncthreads();
}
DI void dn_scan_sample(const Args& a, unsigned char* lds, int tid, int su0, int su1, int sus) {
    asm volatile("" : "+v"(tid));
    const int wave = __builtin_amdgcn_readfirstlane(tid >> 6), lane = tid & 63, fr = lane & 15, fq = lane >> 4;
    const int v0 = wave * 16;
    float* ORAW = (float*)(a.ws + WS_H);
    for (int su = su0; su < su1; su += sus) {
        const int sb = su >> 2, h = su & 3;
        const unsigned char* rec = a.ws + WS_DNC + (size_t)(2048 + su) * REC;
        DnRegs<128> R; dn_load<128>(rec, tid, 0, R); dn_store<128>(lds, tid, R);
        __syncthreads();
        f32x4 S[8];
        const float* s0 = a.in[3] + (size_t)su * 128 * 128 + v0 + fr;
#pragma unroll
        for (int m8 = 0; m8 < 8; ++m8)
#pragma unroll
            for (int i = 0; i < 4; ++i) S[m8][i] = s0[(16 * m8 + 4 * fq + i) * 128];
        f32x4 o[4];
        dn_step<272>(lds, S, lds + DB_U0 + (v0 + fr) * 2, ((const float*)(a.ws + WS_EG))[2048 + su], fr, fq, o);
        float* op = ORAW + (size_t)(TP + sb * 16) * 512 + h * 128 + v0 + fr;
#pragma unroll
        for (int i = 0; i < 4; ++i) op[(size_t)(4 * fq + i) * 512] = o[0][i];
        float* so = a.out + O_SDS + (size_t)su * 128 * 128 + v0 + fr;
#pragma unroll
        for (int m8 = 0; m8 < 8; ++m8)
#pragma unroll
            for (int i = 0; i < 4; ++i) so[(16 * m8 + 4 * fq + i) * 128] = S[m8][i];
        __syncthreads();
    }
}

DI void mix_phase(const Args& a, int gw, int NGW, int lane) {
    asm volatile("" : "+v"(lane));
    const float* ORAW = (const float*)(a.ws + WS_H);
    const bf16* P = (const bf16*)(a.ws + WS_P);
    const bf16* GLU = (const bf16*)(a.ws + WS_GLU);
    bf16* MIX = (bf16*)(a.ws + WS_DNC);
    const f32x2 dg = *(const f32x2*)(a.in[12] + 2 * lane);
    const f32x4 sg0 = *(const f32x4*)(a.in[23] + 8 * lane), sg1 = *(const f32x4*)(a.in[23] + 8 * lane + 4);
    constexpr int NR = 4;
    for (int row0 = gw; row0 < T; row0 += NR * NGW) {
        f32x2 ov[NR][4]; unsigned zz[NR][4]; u32x4 gv[NR]; float ssq[NR][5];
#pragma unroll
        for (int r = 0; r < NR; ++r) { const size_t row = row0 + r * NGW < T ? row0 + r * NGW : row0;
#pragma unroll
            for (int h = 0; h < 4; ++h) { ov[r][h] = *(const f32x2*)(ORAW + row * 512 + h * 128 + 2 * lane); zz[r][h] = *(const unsigned*)(P + row * PW + 1536 + h * 128 + 2 * lane); }
            gv[r] = *(const u32x4*)(GLU + row * 512 + 8 * lane); }
#pragma unroll
        for (int r = 0; r < NR; ++r) {
#pragma unroll
            for (int h = 0; h < 4; ++h) ssq[r][h] = ov[r][h].x * ov[r][h].x + ov[r][h].y * ov[r][h].y;
            const float v[8] = {blo(gv[r].x), bhi(gv[r].x), blo(gv[r].y), bhi(gv[r].y), blo(gv[r].z), bhi(gv[r].z), blo(gv[r].w), bhi(gv[r].w)};
            float ss = 0.f;
#pragma unroll
            for (int e = 0; e < 8; ++e) ss += v[e] * v[e];
            ssq[r][4] = ss; }
#pragma unroll
        for (int o = 1; o < 64; o <<= 1)
#pragma unroll
            for (int r = 0; r < NR; ++r)
#pragma unroll
                for (int k = 0; k < 5; ++k) ssq[r][k] += __shfl_xor(ssq[r][k], o);
#pragma unroll
        for (int r = 0; r < NR; ++r) if (r == 0 || row0 + r * NGW < T) { const size_t row = row0 + r * NGW;
#pragma unroll
            for (int h = 0; h < 4; ++h) { const float rr = rsqrtf(ssq[r][h] * (1.f / 128.f) + EPS);
                *(unsigned*)(MIX + row * DM + h * 128 + 2 * lane) = pk2(ov[r][h].x * rr * dg.x * silu(blo(zz[r][h])), ov[r][h].y * rr * dg.y * silu(bhi(zz[r][h]))); }
            const float v[8] = {blo(gv[r].x), bhi(gv[r].x), blo(gv[r].y), bhi(gv[r].y), blo(gv[r].z), bhi(gv[r].z), blo(gv[r].w), bhi(gv[r].w)};
            const float r5 = rsqrtf(ssq[r][4] * (1.f / 512.f) + EPS);
            u32x4 w; w.x = pk2(v[0] * r5 * sg0[0], v[1] * r5 * sg0[1]); w.y = pk2(v[2] * r5 * sg0[2], v[3] * r5 * sg0[3]);
            w.z = pk2(v[4] * r5 * sg1[0], v[5] * r5 * sg1[1]); w.w = pk2(v[6] * r5 * sg1[2], v[7] * r5 * sg1[3]);
            *(u32x4*)(MIX + row * DM + 512 + 8 * lane) = w; }
    }
}

DI void act_phase(const Args& a, int gtid, int NT) {
    asm volatile("" : "+v"(gtid));
    bf16* UP = (bf16*)(a.ws + WS_UP);
    const float* fw = a.in[27]; const float* fb = a.in[28];
    constexpr int NCG = DFF / 8;
    for (int item = gtid; item < (T / 16) * NCG; item += NT) {
        const int cg8 = item % NCG, rb = item / NCG, col = cg8 * 8, row0 = rb * 16;
        float w0[8], w1[8], w2[8], bb[8], g2[8], g1[8];
#pragma unroll
        for (int e = 0; e < 8; ++e) { w0[e] = fw[col + e]; w1[e] = fw[DFF + col + e]; w2[e] = fw[2 * DFF + col + e]; bb[e] = fb[col + e]; g2[e] = 0.f; g1[e] = 0.f; }
        const bool sample = row0 >= TP;
        float* outp = nullptr;
        if (sample) { const int sb = (row0 - TP) >> 4; const float* cc = a.in[6] + (size_t)sb * 2 * DFF + col;
#pragma unroll
            for (int e = 0; e < 8; ++e) { g2[e] = cc[e]; g1[e] = cc[DFF + e]; }
            outp = a.out + O_SFC + (size_t)sb * 2 * DFF + col;
        } else {
            if ((rb & 511) != 0) {
                const u32x4 x2 = *(const u32x4*)(UP + (size_t)(row0 - 2) * UPW + col), x1 = *(const u32x4*)(UP + (size_t)(row0 - 1) * UPW + col);
                g2[0] = blo(x2.x); g2[1] = bhi(x2.x); g2[2] = blo(x2.y); g2[3] = bhi(x2.y); g2[4] = blo(x2.z); g2[5] = bhi(x2.z); g2[6] = blo(x2.w); g2[7] = bhi(x2.w);
                g1[0] = blo(x1.x); g1[1] = bhi(x1.x); g1[2] = blo(x1.y); g1[3] = bhi(x1.y); g1[4] = blo(x1.z); g1[5] = bhi(x1.z); g1[6] = blo(x1.w); g1[7] = bhi(x1.w);
            }
            if ((rb & 511) == 511) outp = a.out + O_PFC + (size_t)(rb >> 9) * 2 * DFF + col;
        }
#pragma unroll 4
        for (int r = 0; r < 16; ++r) {
            bf16* gp = UP + (size_t)(row0 + r) * UPW + col;
            const u32x4 xg = *(const u32x4*)gp, xv = *(const u32x4*)(gp + DFF);
            float g0[8] = {blo(xg.x), bhi(xg.x), blo(xg.y), bhi(xg.y), blo(xg.z), bhi(xg.z), blo(xg.w), bhi(xg.w)};
            float vv[8] = {blo(xv.x), bhi(xv.x), blo(xv.y), bhi(xv.y), blo(xv.z), bhi(xv.z), blo(xv.w), bhi(xv.w)};
            float o[8];
#pragma unroll
            for (int e = 0; e < 8; ++e) { o[e] = silu(g2[e] * w0[e] + g1[e] * w1[e] + g0[e] * w2[e] + bb[e]) * vv[e]; g2[e] = g1[e]; g1[e] = g0[e]; }
            u32x4 w; w.x = pk2(o[0], o[1]); w.y = pk2(o[2], o[3]); w.z = pk2(o[4], o[5]); w.w = pk2(o[6], o[7]);
            *(u32x4*)(gp + DFF) = w;
            if (outp && r >= 14) {
#pragma unroll
                for (int e = 0; e < 8; ++e) outp[(r - 14) * DFF + e] = g0[e];
            }
        }
    }
}

DI void act_fix_phase(const Args& a, int gtid, int NT) {
    asm volatile("" : "+v"(gtid));
    bf16* ACT = (bf16*)(a.ws + WS_UP);
    const bf16* GH = (const bf16*)(a.ws + WS_GH); const bf16* GT = (const bf16*)(a.ws + WS_GT); const bf16* VH = (const bf16*)(a.ws + WS_VH);
    const float* fw = a.in[27]; const float* fb = a.in[28];
    constexpr int NCG = DFF / 8;
    for (int item = gtid; item < (T / 16) * NCG; item += NT) {
        const int cg8 = item % NCG, grp = item / NCG, col = cg8 * 8;
        float w0[8], w1[8], w2[8], bb[8], g2[8], g1[8], h0[8], h1[8], v0[8], v1[8];
#pragma unroll
        for (int e = 0; e < 8; ++e) { w0[e] = fw[col + e]; w1[e] = fw[DFF + col + e]; w2[e] = fw[2 * DFF + col + e]; bb[e] = fb[col + e]; g2[e] = 0.f; g1[e] = 0.f; }
        const bool sample = grp >= TP / 16;
        if (sample) { const float* cc = a.in[6] + (size_t)(grp - TP / 16) * 2 * DFF + col;
#pragma unroll
            for (int e = 0; e < 8; ++e) { g2[e] = cc[e]; g1[e] = cc[DFF + e]; }
        } else if ((grp & 511) != 0) {
            const u32x4 x2 = *(const u32x4*)(GT + ((size_t)(grp - 1) * 2) * DFF + col), x1 = *(const u32x4*)(GT + ((size_t)(grp - 1) * 2 + 1) * DFF + col);
            g2[0] = blo(x2.x); g2[1] = bhi(x2.x); g2[2] = blo(x2.y); g2[3] = bhi(x2.y); g2[4] = blo(x2.z); g2[5] = bhi(x2.z); g2[6] = blo(x2.w); g2[7] = bhi(x2.w);
            g1[0] = blo(x1.x); g1[1] = bhi(x1.x); g1[2] = blo(x1.y); g1[3] = bhi(x1.y); g1[4] = blo(x1.z); g1[5] = bhi(x1.z); g1[6] = blo(x1.w); g1[7] = bhi(x1.w);
        }
        {
            const u32x4 xa = *(const u32x4*)(GH + ((size_t)grp * 2) * DFF + col), xb = *(const u32x4*)(GH + ((size_t)grp * 2 + 1) * DFF + col);
            const u32x4 ya = *(const u32x4*)(VH + ((size_t)grp * 2) * DFF + col), yb = *(const u32x4*)(VH + ((size_t)grp * 2 + 1) * DFF + col);
            h0[0] = blo(xa.x); h0[1] = bhi(xa.x); h0[2] = blo(xa.y); h0[3] = bhi(xa.y); h0[4] = blo(xa.z); h0[5] = bhi(xa.z); h0[6] = blo(xa.w); h0[7] = bhi(xa.w);
            h1[0] = blo(xb.x); h1[1] = bhi(xb.x); h1[2] = blo(xb.y); h1[3] = bhi(xb.y); h1[4] = blo(xb.z); h1[5] = bhi(xb.z); h1[6] = blo(xb.w); h1[7] = bhi(xb.w);
            v0[0] = blo(ya.x); v0[1] = bhi(ya.x); v0[2] = blo(ya.y); v0[3] = bhi(ya.y); v0[4] = blo(ya.z); v0[5] = bhi(ya.z); v0[6] = blo(ya.w); v0[7] = bhi(ya.w);
            v1[0] = blo(yb.x); v1[1] = bhi(yb.x); v1[2] = blo(yb.y); v1[3] = bhi(yb.y); v1[4] = blo(yb.z); v1[5] = bhi(yb.z); v1[6] = blo(yb.w); v1[7] = bhi(yb.w);
        }
        float o0[8], o1[8];
#pragma unroll
        for (int e = 0; e < 8; ++e) { o0[e] = silu(g2[e] * w0[e] + g1[e] * w1[e] + h0[e] * w2[e] + bb[e]) * v0[e]; o1[e] = silu(g1[e] * w0[e] + h0[e] * w1[e] + h1[e] * w2[e] + bb[e]) * v1[e]; }
        u32x4 wa, wb; wa.x = pk2(o0[0], o0[1]); wa.y = pk2(o0[2], o0[3]); wa.z = pk2(o0[4], o0[5]); wa.w = pk2(o0[6], o0[7]);
        wb.x = pk2(o1[0], o1[1]); wb.y = pk2(o1[2], o1[3]); wb.z = pk2(o1[4], o1[5]); wb.w = pk2(o1[6], o1[7]);
        *(u32x4*)(ACT + ((size_t)grp * 16) * DFF + col) = wa; *(u32x4*)(ACT + ((size_t)grp * 16 + 1) * DFF + col) = wb;
        float* outp = nullptr;
        if (sample) outp = a.out + O_SFC + (size_t)(grp - TP / 16) * 2 * DFF + col;
        else if ((grp & 511) == 511) outp = a.out + O_PFC + (size_t)(grp >> 9) * 2 * DFF + col;
        if (outp) {
            const u32x4 t0 = *(const u32x4*)(GT + ((size_t)grp * 2) * DFF + col), t1 = *(const u32x4*)(GT + ((size_t)grp * 2 + 1) * DFF + col);
            outp[0] = blo(t0.x); outp[1] = bhi(t0.x); outp[2] = blo(t0.y); outp[3] = bhi(t0.y); outp[4] = blo(t0.z); outp[5] = bhi(t0.z); outp[6] = blo(t0.w); outp[7] = bhi(t0.w);
            outp[DFF + 0] = blo(t1.x); outp[DFF + 1] = bhi(t1.x); outp[DFF + 2] = blo(t1.y); outp[DFF + 3] = bhi(t1.y); outp[DFF + 4] = blo(t1.z); outp[DFF + 5] = bhi(t1.z); outp[DFF + 6] = blo(t1.w); outp[DFF + 7] = bhi(t1.w);
        }
    }
}

DI void final_phase(const Args& a, int gw, int NGW, int lane) {
    asm volatile("" : "+v"(lane));
    f32x4 gv[4];
#pragma unroll
    for (int j = 0; j < 4; ++j) gv[j] = ((const f32x4*)a.in[30])[lane + 64 * j];
    for (int m0 = gw; m0 < T; m0 += 2 * NGW) {
        const int m1 = m0 + NGW < T ? m0 + NGW : m0;
        f32x4* xr0 = (f32x4*)(a.out + (size_t)m0 * DM) + lane; f32x4* xr1 = (f32x4*)(a.out + (size_t)m1 * DM) + lane;
        f32x4 v0[4], v1[4]; float s0 = 0.f, s1 = 0.f;
#pragma unroll
        for (int j = 0; j < 4; ++j) { v0[j] = xr0[64 * j]; v1[j] = xr1[64 * j]; }
#pragma unroll
        for (int j = 0; j < 4; ++j) { s0 += (v0[j].x * v0[j].x + v0[j].y * v0[j].y) + (v0[j].z * v0[j].z + v0[j].w * v0[j].w); s1 += (v1[j].x * v1[j].x + v1[j].y * v1[j].y) + (v1[j].z * v1[j].z + v1[j].w * v1[j].w); }
        const float r0 = rsqrtf(wave_sum(s0) * (1.f / DM) + EPS), r1 = rsqrtf(wave_sum(s1) * (1.f / DM) + EPS);
#pragma unroll
        for (int j = 0; j < 4; ++j) xr0[64 * j] = v0[j] * r0 * gv[j];
        if (m1 != m0) {
#pragma unroll
            for (int j = 0; j < 4; ++j) xr1[64 * j] = v1[j] * r1 * gv[j];
        }
    }
}

#ifndef PH_MASK
#define PH_MASK 0xffff
#endif
#ifndef SOLVE_RL
#define SOLVE_RL 1
#endif
#ifndef REP0
#define REP0 1
#endif
#ifndef REP1
#define REP1 1
#endif
#ifndef REP2A
#define REP2A 1
#endif
#ifndef REP2B
#define REP2B 1
#endif
#ifndef REP3A
#define REP3A 1
#endif
#ifndef REP3B
#define REP3B 1
#endif
#ifndef REP3C
#define REP3C 1
#endif
#ifndef PH_LO
#define PH_LO 0
#endif
#ifndef PH_HI
#define PH_HI 99
#endif
__global__ void __launch_bounds__(512, 2) fwd_kernel(Args a) {
    extern __shared__ __attribute__((aligned(16))) unsigned char lds[];
    cg::grid_group grid = cg::this_grid();
    const int tid = threadIdx.x, lane = tid & 63, wave = __builtin_amdgcn_readfirstlane(tid >> 6);
    const int G = gridDim.x, gw = blockIdx.x * 8 + wave, NGW = G * 8;
    unsigned char* ws = a.ws;
    PG8_LAS unsigned char* ldsg = (PG8_LAS unsigned char*)lds;
    volatile LAS unsigned* xbst = (volatile LAS unsigned*)(ldsg + (LDS_BYTES - 64));
    if (tid < 2) xbst[tid] = 0u;
    __syncthreads();
    const XcdBarrier xbar = xcd_barrier_post((unsigned*)(ws + WS_CTL), xbst);

    _Pragma("nounroll") for (int rep = 0; rep < REP0; ++rep) { phase0(a, lds, gw, NGW, wave, lane); __syncthreads(); }
    xcd_barrier(xbar);
    if (a.out == nullptr) grid.sync();
    _Pragma("nounroll") for (int rep = 0; rep < REP1; ++rep)
    { pg8::Gemm g{(const bf16*)(ws + WS_H), (const bf16*)(ws + WS_WIN), T, NIN, DM, DM}; pg8::StaticOrder S; S.init(T, NIN, G, (int)blockIdx.x);
      EpiP E{(bf16*)(ws + WS_P), (float*)(ws + WS_BA)};
      pg8::gemm_phase<EpiP, pg8::StaticOrder, true, true>(ldsg, g, S, E); }
    xcd_barrier(xbar);
    _Pragma("nounroll") for (int rep = 0; rep < REP2A; ++rep) dn_chunk_phase(a, lds, tid, (int)blockIdx.x, 1024, G);
#if OLD_S5 && OLD_S5 != 4 && OLD_S5 != 5
    old_s5_pass1(a, gw, NGW, lane);
#elif 0
#else
    _Pragma("nounroll") for (int rep = 0; rep < REP2B; ++rep) s5_pass1(a, gw, NGW, lane);
#endif
    xcd_barrier(xbar);
#if OLD_S5 == 3
    if (blockIdx.x < 64) dn_scan_prompt(a, lds, tid);
    else { if (blockIdx.x >= 192) { dn_scan_sample(a, lds, tid, (int)blockIdx.x - 192, 128, 64); s5_pass2_sample(a, lds + 81920 + wave * 4352, ((int)blockIdx.x - 192) * 8 + wave, 512, lane); __syncthreads(); }
           old_s5_pass2(a, lds + 81920 + wave * 4352, gw - 512, NGW - 512, lane); }
#elif OLD_S5 == 5
    if (blockIdx.x < 64) { _Pragma("nounroll") for (int rep = 0; rep < REP3A; ++rep) dn_scan_prompt(a, lds, tid); }
    else {
        if (blockIdx.x >= 192) {
            const int w = (int)blockIdx.x - 192;
            dn_chunk_phase(a, lds, tid, 1024 + w, 1025 + w, 1);
            __threadfence_block(); __syncthreads();
            dn_scan_sample(a, lds, tid, 2 * w, 2 * w + 2, 1);
        }
        _Pragma("nounroll") for (int rep = 0; rep < REP3B; ++rep) s5_pass2b(a, lds + wave * 14592, gw - 512, NGW - 512, lane);
    }
#elif OLD_S5 == 1 || OLD_S5 == 4
    if (blockIdx.x < 64) dn_scan_prompt(a, lds, tid);
    else { if (blockIdx.x >= 192) dn_scan_sample(a, lds, tid, (int)blockIdx.x - 192, 128, 64); old_s5_pass2(a, lds + 81920 + wave * 4352, gw - 512, NGW - 512, lane); }
#else
    if (blockIdx.x < 64) { _Pragma("nounroll") for (int rep = 0; rep < REP3A; ++rep) dn_scan_prompt(a, lds, tid); }
    else if (blockIdx.x < 192) { _Pragma("nounroll") for (int rep = 0; rep < REP3B; ++rep) s5_pass2_prompt(a, lds, (int)blockIdx.x - 64, tid); }
    else { _Pragma("nounroll") for (int rep = 0; rep < REP3C; ++rep) { dn_scan_sample(a, lds, tid, (int)blockIdx.x - 192, 128, 64); s5_pass2_sample(a, lds + 81920 + wave * 4352, ((int)blockIdx.x - 192) * 8 + wave, 512, lane); } }
#endif
    xcd_barrier(xbar);
#if PH_MASK & 512
    { pg8::Gemm g{(const bf16*)(ws + WS_Y5), (const bf16*)(ws + WS_WGLU), T, 1024, 512, 512}; pg8::StaticOrder S; S.init(T, 1024, G, (int)blockIdx.x);
      EpiGlu E{(bf16*)(ws + WS_GLU), a.in[22]};
      pg8::gemm_phase<EpiGlu, pg8::StaticOrder, true, true>(ldsg, g, S, E); }
#endif
    xcd_barrier(xbar);
#if PH_MASK & 32
    mix_phase(a, gw, NGW, lane);
#endif
    xcd_barrier(xbar);
#if PH_MASK & 1024
    { pg8::Gemm g{(const bf16*)(ws + WS_DNC), (const bf16*)(ws + WS_WOUT), T, DM, DM, DM}; pg8::StaticOrder S; S.init(T, DM, G, (int)blockIdx.x);
      EpiX1 E{a.in[0], a.in[1], a.out, (bf16*)(ws + WS_H), (float*)(ws + WS_SS2)};
      pg8::gemm_phase<EpiX1, pg8::StaticOrder, true, true>(ldsg, g, S, E); }
#endif
    xcd_barrier(xbar);
#if FUSE_ACT
    { pg8::Gemm g{(const bf16*)(ws + WS_H), (const bf16*)(ws + WS_WUP), T, UPW, DM, DM}; pg8::StaticOrder S; S.init(T, UPW, G, (int)blockIdx.x);
      EpiUpAct E{(bf16*)(ws + WS_UP), (bf16*)(ws + WS_GH), (bf16*)(ws + WS_GT), (bf16*)(ws + WS_VH), (const float*)(ws + WS_SS2), a.in[27], a.in[28]};
      pg8::gemm_phase<EpiUpAct, pg8::StaticOrder, true, true>(ldsg, g, S, E); }
    xcd_barrier(xbar);
    act_fix_phase(a, (int)blockIdx.x * 512 + tid, G * 512);
    xcd_barrier(xbar);
    { pg8::Gemm g{(const bf16*)(ws + WS_UP), (const bf16*)(ws + WS_WDOWN), T, DM, DFF, DFF}; pg8::StaticOrder S; S.init(T, DM, G, (int)blockIdx.x);
      EpiX2 E{a.out};
      pg8::gemm_phase<EpiX2, pg8::StaticOrder, true, true>(ldsg, g, S, E); }
    xcd_barrier(xbar);
#else
#if PH_MASK & 2048
    { pg8::Gemm g{(const bf16*)(ws + WS_H), (const bf16*)(ws + WS_WUP), T, UPW, DM, DM}; pg8::StaticOrder S; S.init(T, UPW, G, (int)blockIdx.x);
      EpiUp E{(bf16*)(ws + WS_UP), (const float*)(ws + WS_SS2)};
      pg8::gemm_phase<EpiUp, pg8::StaticOrder, true, true>(ldsg, g, S, E); }
#endif
    xcd_barrier(xbar);
#if PH_MASK & 64
    act_phase(a, (int)blockIdx.x * 512 + tid, G * 512);
#endif
    xcd_barrier(xbar);
#if PH_MASK & 4096
    { pg8::Gemm g{(const bf16*)(ws + WS_UP) + DFF, (const bf16*)(ws + WS_WDOWN), T, DM, DFF, UPW}; pg8::StaticOrder S; S.init(T, DM, G, (int)blockIdx.x);
      EpiX2 E{a.out};
      pg8::gemm_phase<EpiX2, pg8::StaticOrder, true, true>(ldsg, g, S, E); }
#endif
    xcd_barrier(xbar);
#endif
#if PH_MASK & 128
    final_phase(a, gw, NGW, lane);
#endif
}

extern "C" void kernel_launch(void* const* d_in, const int* in_sizes, int n_in, void* d_out, int out_size, void* d_ws, size_t ws_size, hipStream_t stream) {
    static int grid = 0;
    if (grid == 0) {
        if (n_in != 31 || (size_t)out_size != O_END || ws_size < WS_END) { fprintf(stderr, "kernel_launch: unexpected shapes n_in %d out %d ws %zu\n", n_in, out_size, ws_size); grid = -1; return; }
        int dev = 0, cus = 0, per_cu = 0;
        hipGetDevice(&dev);
        hipDeviceGetAttribute(&cus, hipDeviceAttributeMultiprocessorCount, dev);
        hipFuncSetAttribute((const void*)fwd_kernel, hipFuncAttributeMaxDynamicSharedMemorySize, LDS_BYTES);
        hipOccupancyMaxActiveBlocksPerMultiprocessor(&per_cu, (const void*)fwd_kernel, 512, LDS_BYTES);
        if (per_cu < 1) { fprintf(stderr, "kernel_launch: occupancy query says %d blocks per CU\n", per_cu); per_cu = 1; }
        grid = cus * 1;
        if (grid != 256) { fprintf(stderr, "kernel_launch: built for a 256-CU device, got %d\n", cus); grid = -1; return; }
        (void)hipGetLastError();
    }
    if (grid < 0) return;
    if (hipMemsetAsync((char*)d_ws + WS_CTL, 0, 16384, stream) != hipSuccess) { fprintf(stderr, "kernel_launch: memset of the barrier words failed\n"); return; }
    Args a{};
    for (int i = 0; i < 31; ++i) a.in[i] = (const float*)d_in[i];
    a.out = (float*)d_out; a.ws = (unsigned char*)d_ws;
    void* args[] = {&a};
    hipError_t e = hipLaunchCooperativeKernel((const void*)fwd_kernel, dim3(grid), dim3(512), args, LDS_BYTES, stream);
    if (e != hipSuccess) fprintf(stderr, "cooperative launch failed: %s (grid %d)\n", hipGetErrorString(e), grid);
}
```

```cpp
#include <hip/hip_runtime.h>
#include <hip/hip_cooperative_groups.h>
#include <cstdio>
#include <cstdint>
namespace cg = cooperative_groups;
#define OLD_S5 5
#define DN_STAGED 3
namespace pg8 {
#define PG8_LAS __attribute__((address_space(3)))
typedef unsigned short bf16_t;
typedef short bf16x8 __attribute__((ext_vector_type(8)));
typedef float f32x4 __attribute__((ext_vector_type(4)));
typedef unsigned u32x4 __attribute__((ext_vector_type(4)));
constexpr int BM = 256, BK = 64, HALF = 128, HTB = HALF * BK * 2  , STAGE_BYTES = 8 * HTB, NXCD = 8, WGM = 8;

__host__ __device__ __forceinline__ int lds_byte(int r, int c) { const int st = (r >> 4) * 2 + (c >> 5), rr = r & 15, cc = c & 31, ob = rr * 64 + cc * 2; return st * 1024 + (ob ^ (((ob >> 9) & 1) << 5)); }
__host__ __device__ __forceinline__ void stage_rc(int b, int& R, int& C) { const int st = b / 1024, sb = b % 1024, swz = sb ^ (((sb >> 9) & 1) << 5); R = (st >> 1) * 16 + swz / 64; C = (st & 1) * 32 + (swz % 64) / 2; }
__host__ __device__ __forceinline__ int perm32(int rho) { const int n = rho >> 4, i = rho & 15; return 8 * (i >> 2) + 4 * n + (i & 3); }

struct Unit { int pm, pn; };
struct Gemm { const bf16_t* A; const bf16_t* Bt; int M, N, K, lda; };

struct StaticOrder {
    int nM, nN, nwg, G, c;
    __host__ __device__ void init(int M, int N, int G_, int c_) { nM = M / BM; nN = N / BM; nwg = nM * nN; G = G_; c = c_; }
    __host__ __device__ bool next(int i, Unit& u) const {
        const long L = (long)i * G + c; if (L >= nwg) return false;
        int wgid = (int)L; { const int q = nwg / NXCD, r = nwg % NXCD, xcd = wgid % NXCD, off = wgid / NXCD; wgid = (xcd < r ? xcd * (q + 1) : r * (q + 1) + (xcd - r) * q) + off; }
        const int nig = WGM * nN, gid = wgid / nig, fm = gid * WGM, gsz = (nM - fm) < WGM ? (nM - fm) : WGM;
        u.pm = fm + ((wgid % nig) % gsz); u.pn = (wgid % nig) / gsz; return true;
    }
    __device__ __forceinline__ void a_ready(const Unit&) const {}
    __device__ __forceinline__ void done(const Unit&) const {}
};
__device__ __forceinline__ unsigned cvt_pk_bf16(float lo, float hi) { unsigned r; asm volatile("v_cvt_pk_bf16_f32 %0, %1, %2" : "=v"(r) : "v"(lo), "v"(hi)); return r; }
typedef float f32x2 __attribute__((ext_vector_type(2)));
template <class Epi, class Sched, bool ALIGN_EPI = false, bool SP2 = false>
__device__ __forceinline__ void gemm_phase(PG8_LAS unsigned char* lds, const Gemm g, const Sched& S, const Epi& E) {
    int tid_ = threadIdx.x; asm volatile("" : "+v"(tid_));
    const int tid = tid_, wid = __builtin_amdgcn_readfirstlane(tid >> 6), lane = tid & 63, wr = wid >> 2, wc = wid & 3, fr = lane & 15, fq = lane >> 4;
    const int K = g.K, nt = K / BK;
    unsigned voffA[2], voffB[2];
#pragma unroll
    for (int i = 0; i < 2; ++i) { int R, C; stage_rc(tid * 16 + i * 8192, R, C); const int Rb = Epi::PERM ? ((R & ~31) + perm32(R & 31)) : R;
        voffA[i] = (unsigned)(R * g.lda + C) * 2u; voffB[i] = (unsigned)(Rb * K + C) * 2u; }
    const size_t kstep = (size_t)(BK * 2);
    const size_t hstep = (size_t)HALF * K * 2;
    const size_t tstep = 2 * hstep; const size_t hstepA = (size_t)HALF * g.lda * 2, tstepA = 2 * hstepA;
    const unsigned ldsw = (unsigned)wid * 1024u;
    const int aoff = lds_byte(wr * 64 + fr, fq * 8), boff = lds_byte(wc * 32 + fr, fq * 8);
#define PG8_SA(b, h) (((b) * 2 + (h)) * HTB)
#define PG8_SB(b, h) ((4 + (b) * 2 + (h)) * HTB)
#define PG8_STAGE(bufoff, gbase, voff) do { _Pragma("unroll") for (int _i = 0; _i < 2; ++_i) \
        __builtin_amdgcn_global_load_lds((const unsigned*)((const char*)(gbase) + (voff)[_i]), (PG8_LAS unsigned*)(lds + (bufoff) + ldsw + _i * 8192), 16, 0, 0); } while (0)
#define PG8_LDA(dst, b, h) do { _Pragma("unroll") for (int m = 0; m < 4; ++m) _Pragma("unroll") for (int k = 0; k < 2; ++k) dst[m][k] = *(const PG8_LAS bf16x8*)(lds + PG8_SA(b, h) + aoff + m * 2048 + k * 1024); } while (0)
#define PG8_LDB(dst, b, h) do { _Pragma("unroll") for (int n = 0; n < 2; ++n) _Pragma("unroll") for (int k = 0; k < 2; ++k) dst[n][k] = *(const PG8_LAS bf16x8*)(lds + PG8_SB(b, h) + boff + n * 2048 + k * 1024); } while (0)
#define PG8_MMA(ai, bj, At, Bt) do { __builtin_amdgcn_s_setprio(1); _Pragma("unroll") for (int m = 0; m < 4; ++m) _Pragma("unroll") for (int n = 0; n < 2; ++n) _Pragma("unroll") for (int k = 0; k < 2; ++k) \
        acc[ai][bj][m][n] = __builtin_amdgcn_mfma_f32_16x16x32_bf16(Bt[n][k], At[m][k], acc[ai][bj][m][n], 0, 0, 0); __builtin_amdgcn_s_setprio(0); } while (0)
#define PG8_WAIT_V(n) asm volatile("s_waitcnt vmcnt(" #n ")" ::: "memory")
#define PG8_WAIT_L(n) asm volatile("s_waitcnt lgkmcnt(" #n ")" ::: "memory")
#define PG8_BAR __builtin_amdgcn_s_barrier()
#define PG8_SCHED __builtin_amdgcn_sched_barrier(0)
    Unit cur, nxt; int ui = 0;
    if (!S.next(0, cur)) return;
    f32x4 acc[2][2][4][2];
#pragma unroll
    for (int a = 0; a < 2; ++a)
#pragma unroll
        for (int b = 0; b < 2; ++b)
#pragma unroll
            for (int m = 0; m < 4; ++m)
#pragma unroll
                for (int n = 0; n < 2; ++n) acc[a][b][m][n] = (f32x4){0.f, 0.f, 0.f, 0.f};
    bf16x8 At[4][2], B0[2][2], B1[2][2];
    const char* cA = (const char*)g.A + (size_t)cur.pm * tstepA; const char* cB = (const char*)g.Bt + (size_t)cur.pn * tstep;
    S.a_ready(cur);
    if constexpr (SP2) {
        PG8_STAGE(PG8_SB(0, 0), cB, voffB); PG8_STAGE(PG8_SB(0, 1), cB + hstep, voffB); PG8_STAGE(PG8_SA(0, 0), cA, voffA); PG8_STAGE(PG8_SA(0, 1), cA + hstepA, voffA);
        if (wr == 1) PG8_BAR;
        PG8_WAIT_V(2); PG8_BAR;
        PG8_STAGE(PG8_SB(1, 0), cB + kstep, voffB); PG8_STAGE(PG8_SA(1, 0), cA + kstep, voffA); PG8_STAGE(PG8_SB(1, 1), cB + hstep + kstep, voffB);
        PG8_WAIT_V(6); PG8_BAR;
    } else {
        PG8_STAGE(PG8_SB(0, 0), cB, voffB); PG8_STAGE(PG8_SA(0, 0), cA, voffA); PG8_STAGE(PG8_SB(0, 1), cB + hstep, voffB); PG8_STAGE(PG8_SA(0, 1), cA + hstepA, voffA);
        if (wr == 1) PG8_BAR;
        PG8_WAIT_V(4); PG8_BAR;
        PG8_STAGE(PG8_SB(1, 0), cB + kstep, voffB); PG8_STAGE(PG8_SA(1, 0), cA + kstep, voffA); PG8_STAGE(PG8_SB(1, 1), cB + hstep + kstep, voffB);
        PG8_WAIT_V(6); PG8_BAR;
    }
    for (;;) {
        const bool has_next = S.next(ui + 1, nxt);
        const char* nA = has_next ? (const char*)g.A + (size_t)nxt.pm * tstepA : cA; const char* nB = has_next ? (const char*)g.Bt + (size_t)nxt.pn * tstep : cB;
        for (int t = 0; t < nt; t += 2) {
            const bool last = (t == nt - 2);
            const char* a1 = cA + (size_t)(t + 1) * kstep;
            const char* a2 = last ? nA : cA + (size_t)(t + 2) * kstep; const char* b2 = last ? nB : cB + (size_t)(t + 2) * kstep;
            const char* a3 = a2 + kstep; const char* b3 = b2 + kstep;
            if (last && has_next) S.a_ready(nxt);
            if constexpr (SP2) {
            PG8_LDB(B0, 0, 0); PG8_LDB(B1, 0, 1); PG8_SCHED; PG8_LDA(At, 0, 0); PG8_STAGE(PG8_SA(1, 1), a1 + hstepA, voffA);
            PG8_WAIT_V(8); PG8_WAIT_L(0); PG8_BAR; PG8_MMA(0, 0, At, B0); PG8_MMA(0, 1, At, B1); PG8_BAR; PG8_SCHED;
            PG8_LDA(At, 0, 1); PG8_STAGE(PG8_SB(0, 0), b2, voffB); PG8_STAGE(PG8_SB(0, 1), b2 + hstep, voffB); PG8_STAGE(PG8_SA(0, 0), a2, voffA);
            PG8_WAIT_V(8); PG8_WAIT_L(0); PG8_BAR; PG8_MMA(1, 0, At, B0); PG8_MMA(1, 1, At, B1); PG8_BAR; PG8_SCHED;
            PG8_LDB(B0, 1, 0); PG8_LDB(B1, 1, 1); PG8_SCHED; PG8_LDA(At, 1, 0); PG8_STAGE(PG8_SA(0, 1), a2 + hstepA, voffA);
            PG8_WAIT_V(8); PG8_WAIT_L(0); PG8_BAR; PG8_MMA(0, 0, At, B0); PG8_MMA(0, 1, At, B1); PG8_BAR; PG8_SCHED;
            PG8_LDA(At, 1, 1); PG8_STAGE(PG8_SB(1, 0), b3, voffB); PG8_STAGE(PG8_SB(1, 1), b3 + hstep, voffB); PG8_STAGE(PG8_SA(1, 0), a3, voffA);
            PG8_WAIT_V(8); PG8_WAIT_L(0); PG8_BAR; PG8_MMA(1, 0, At, B0); PG8_MMA(1, 1, At, B1); PG8_BAR; PG8_SCHED;
            } else {
            PG8_LDB(B0, 0, 0); PG8_SCHED; PG8_LDA(At, 0, 0); PG8_STAGE(PG8_SA(1, 1), a1 + hstepA, voffA);
            PG8_WAIT_L(8); PG8_BAR; PG8_WAIT_L(0); PG8_MMA(0, 0, At, B0); PG8_BAR; PG8_SCHED;
            PG8_LDB(B1, 0, 1); PG8_STAGE(PG8_SB(0, 0), b2, voffB);
            PG8_BAR; PG8_WAIT_L(0); PG8_MMA(0, 1, At, B1); PG8_BAR;
            PG8_LDA(At, 0, 1); PG8_STAGE(PG8_SA(0, 0), a2, voffA);
            PG8_BAR; PG8_WAIT_L(0); PG8_MMA(1, 0, At, B0); PG8_BAR; PG8_SCHED;
            PG8_STAGE(PG8_SB(0, 1), b2 + hstep, voffB);
            PG8_WAIT_V(6); PG8_BAR; PG8_MMA(1, 1, At, B1); PG8_BAR;
            PG8_LDB(B0, 1, 0); PG8_SCHED; PG8_LDA(At, 1, 0); PG8_STAGE(PG8_SA(0, 1), a2 + hstepA, voffA);
            PG8_WAIT_L(8); PG8_BAR; PG8_WAIT_L(0); PG8_MMA(0, 0, At, B0); PG8_BAR; PG8_SCHED;
            PG8_LDB(B1, 1, 1); PG8_STAGE(PG8_SB(1, 0), b3, voffB);
            PG8_BAR; PG8_WAIT_L(0); PG8_MMA(0, 1, At, B1); PG8_BAR;
            PG8_LDA(At, 1, 1); PG8_STAGE(PG8_SA(1, 0), a3, voffA);
            PG8_BAR; PG8_WAIT_L(0); PG8_MMA(1, 0, At, B0); PG8_BAR; PG8_SCHED;
            PG8_STAGE(PG8_SB(1, 1), b3 + hstep, voffB);
            PG8_WAIT_V(6); PG8_BAR; PG8_MMA(1, 1, At, B1); PG8_BAR;
            }
        }
        if constexpr (ALIGN_EPI) { if (wr == 0) PG8_BAR; }
        if constexpr (!Epi::AFTER_DRAIN) { E(acc, cur, wr, wc, fr, fq); S.done(cur); }
        if (!has_next) break;
#pragma unroll
        for (int a = 0; a < 2; ++a)
#pragma unroll
            for (int b = 0; b < 2; ++b)
#pragma unroll
                for (int m = 0; m < 4; ++m)
#pragma unroll
                    for (int n = 0; n < 2; ++n) acc[a][b][m][n] = (f32x4){0.f, 0.f, 0.f, 0.f};
        cur = nxt; cA = nA; cB = nB; ++ui;
        if constexpr (ALIGN_EPI) { if (wr == 1) PG8_BAR; }
    }
    PG8_WAIT_V(0);
    if constexpr (!ALIGN_EPI) { if (wr == 0) PG8_BAR; }
    PG8_BAR;
    if constexpr (Epi::AFTER_DRAIN) { E.fused(acc, cur, wr, wc, fr, fq, lds, wid, lane); S.done(cur); }
#undef PG8_SA
#undef PG8_SB
#undef PG8_STAGE
#undef PG8_LDA
#undef PG8_LDB
#undef PG8_MMA
#undef PG8_WAIT_V
#undef PG8_WAIT_L
#undef PG8_BAR
#undef PG8_SCHED
}
}
#define LAS __attribute__((address_space(3)))
#define XB_TMO      128
#define XB_XCNT(j)  (256  + 64 * (j))
#define XB_XSUB(j)  (1280 + 64 * (j))
#define XB_XGEN(j)  (2304 + 64 * (j))
#define XB_TOP      3328
#define XB_TOPGEN   3392
#define XCD_BAR_WORDS 3456
#define XB_SPIN_CAP (1u << 18)

__device__ __forceinline__ unsigned xb_ld(unsigned* p)              { return __hip_atomic_load(p, __ATOMIC_RELAXED, __HIP_MEMORY_SCOPE_AGENT); }
__device__ __forceinline__ unsigned xb_add(unsigned* p, unsigned v) { return __hip_atomic_fetch_add(p, v, __ATOMIC_RELAXED, __HIP_MEMORY_SCOPE_AGENT); }
__device__ __forceinline__ unsigned xb_xcc_id() { return (unsigned)__builtin_amdgcn_s_getreg((3 << 11) | 20) & 0xFu; }
#define XB_SPIN(cond, bar) do { unsigned _sp = 0; while (cond) { __builtin_amdgcn_s_sleep(1); \
    if ((++_sp & 255u) == 0u) { if (xb_ld(&(bar)[XB_TMO])) break; if (_sp > XB_SPIN_CAP) { atomicAdd(&(bar)[XB_TMO], 1u); break; } } } } while (0)

struct XcdBarrier {
    unsigned* bar; unsigned x;
    volatile LAS unsigned* st;
};

__device__ __forceinline__ XcdBarrier xcd_barrier_post(unsigned* bar, volatile LAS unsigned* st) {
    XcdBarrier b; b.bar = bar; b.x = xb_xcc_id(); b.st = st;
    if (threadIdx.x == 0) (void)xb_add(&bar[XB_XCNT(b.x)], 1u);
    return b;
}
__device__ __forceinline__ void xcd_barrier_complete(unsigned* bar, unsigned x, unsigned& nloc, unsigned& nx) {
    const unsigned G = gridDim.x * gridDim.y * gridDim.z;
    unsigned sum, cnt, mine, sp = 0u;
    for (;;) {
        sum = 0u; cnt = 0u; mine = 0u;
#pragma unroll
        for (unsigned j = 0; j < 16; ++j) { const unsigned c = xb_ld(&bar[XB_XCNT(j)]); sum += c; cnt += (c > 0u) ? 1u : 0u; mine = (j == x) ? c : mine; }
        if (sum == G) break;
        __builtin_amdgcn_s_sleep(1);
        if ((++sp & 255u) == 0u) { if (xb_ld(&bar[XB_TMO])) break; if (sp > XB_SPIN_CAP) { atomicAdd(&bar[XB_TMO], 1u); break; } }
    }
    nloc = mine > 0u ? mine : 1u; nx = cnt > 0u ? cnt : 1u;
}

__device__ __forceinline__ void xcd_barrier(const XcdBarrier& b) {
    asm volatile("s_waitcnt vmcnt(0)" ::: "memory");
    __syncthreads();
    if (threadIdx.x == 0) {
        unsigned* bar = b.bar;
        __builtin_amdgcn_s_waitcnt(0);
        unsigned nloc = b.st[0], nx = b.st[1];
        if (nloc == 0u) { xcd_barrier_complete(bar, b.x, nloc, nx); b.st[0] = nloc; b.st[1] = nx; }
        const unsigned old = xb_add(&bar[XB_XSUB(b.x)], 1u);
        const unsigned gen = old / nloc;
        if (old + 1u == (gen + 1u) * nloc) {
            __builtin_amdgcn_fence(__ATOMIC_RELEASE, "agent");
            asm volatile("s_waitcnt vmcnt(0)" ::: "memory");
            const unsigned og = xb_add(&bar[XB_TOP], 1u);
            const unsigned tg = og / nx;
            if (og + 1u == (tg + 1u) * nx) xb_add(&bar[XB_TOPGEN], 1u);
            else XB_SPIN(xb_ld(&bar[XB_TOPGEN]) == tg, bar);
            __builtin_amdgcn_fence(__ATOMIC_ACQUIRE, "agent");
            xb_add(&bar[XB_XGEN(b.x)], 1u);
            asm volatile("s_waitcnt vmcnt(0)" ::: "memory");
        } else {
            XB_SPIN(xb_ld(&bar[XB_XGEN(b.x)]) == gen, bar);
            __builtin_amdgcn_fence(__ATOMIC_ACQUIRE, "agent");
            asm volatile("s_waitcnt vmcnt(0)" ::: "memory");
        }
    }
    __syncthreads();
}


#ifndef FUSE_ACT
#define FUSE_ACT 1
#endif
#ifndef DN_STAGED
#define DN_STAGED 1
#endif
#ifndef DIAG_Y
#define DIAG_Y 0
#endif
#ifndef OLD_S5
#define OLD_S5 0
#endif
#if OLD_S5 == 3
#define OLD_S5_ULIM 8192
#else
#define OLD_S5_ULIM (4 * 32 * 64 + 32 * 32)
#endif
#define DI __device__ __forceinline__
typedef unsigned short bf16;
typedef float f32x4 __attribute__((ext_vector_type(4)));
typedef float f32x2 __attribute__((ext_vector_type(2)));
typedef short bf16x8 __attribute__((ext_vector_type(8)));
typedef unsigned u32x4 __attribute__((ext_vector_type(4)));
typedef unsigned u32x2 __attribute__((ext_vector_type(2)));
typedef __bf16 bf16x2_t __attribute__((ext_vector_type(2)));

DI unsigned pk2(float lo, float hi) { f32x2 v = {lo, hi}; bf16x2_t b = __builtin_convertvector(v, bf16x2_t); return __builtin_bit_cast(unsigned, b); }
DI bf16 f2b(float x) { return (bf16)(pk2(x, 0.f) & 0xffffu); }
DI float b2f(unsigned b) { return __uint_as_float(b << 16); }
DI float blo(unsigned w) { return __uint_as_float(w << 16); }
DI float bhi(unsigned w) { return __uint_as_float(w & 0xffff0000u); }
DI float wave_sum(float v) {
#pragma unroll
    for (int o = 1; o < 64; o <<= 1) v += __shfl_xor(v, o);
    return v;
}
DI float sigm(float x) { return __builtin_amdgcn_rcpf(1.f + __expf(-x)); }
DI float silu(float x) { return x * __builtin_amdgcn_rcpf(1.f + __expf(-x)); }
DI float gelu_tanh(float x) { const float z = 1.5957691216057308f * (x + 0.044715f * x * x * x); return x * __builtin_amdgcn_rcpf(1.f + __expf(-z)); }
#define MFMA16(a, b, c) __builtin_amdgcn_mfma_f32_16x16x32_bf16((a), (b), (c), 0, 0, 0)

constexpr int TP = 32768, TS = 512, T = TP + TS;
constexpr int DM = 1024, PW = 2560, NIN = 2816, DFF = 2816, UPW = 5632;
constexpr float EPS = 1e-6f;
constexpr int NCH = 2048 + 128;
constexpr int REC = 73728;
constexpr int R_WN = 0, R_QG = 16384, R_KDT = 32768, R_QK = 49152, R_U0 = 57344;
constexpr size_t O_Y = 0, O_PDC = (size_t)T * DM, O_PDS = O_PDC + 4 * 3 * 1536, O_PSR = O_PDS + 4 * 4 * 128 * 128, O_PSI = O_PSR + 4 * 32 * 64,
                 O_PFC = O_PSI + 4 * 32 * 64, O_SDC = O_PFC + 4 * 2 * 2816, O_SDS = O_SDC + 32 * 3 * 1536, O_SSR = O_SDS + (size_t)32 * 4 * 128 * 128,
                 O_SSI = O_SSR + 32 * 32 * 64, O_SFC = O_SSI + 32 * 32 * 64, O_END = O_SFC + 32 * 2 * 2816;
constexpr size_t MiB = 1u << 20;
constexpr size_t WS_SS2 = 0;
constexpr size_t WS_EG = 3 * MiB;
constexpr size_t WS_CTL = 5 * MiB + 512 * 1024;
constexpr size_t WS_BA = 4 * MiB;
constexpr size_t WS_WIN = 6 * MiB, WS_WGLU = 12 * MiB, WS_WOUT = 13 * MiB, WS_WUP = 15 * MiB, WS_WDOWN = 26 * MiB;
constexpr size_t WS_H = 32 * MiB;
constexpr size_t WS_P = 98 * MiB;
constexpr size_t WS_DNC = 262 * MiB;
constexpr size_t WS_Y5 = 416 * MiB, WS_GLU = 449 * MiB, WS_S5E = 482 * MiB, WS_END = 487 * MiB;
constexpr size_t WS_GH = 300 * MiB, WS_GT = 324 * MiB, WS_VH = 348 * MiB;
constexpr size_t WS_UP = 98 * MiB;
static_assert(WS_UP + (size_t)T * UPW * 2 <= WS_END && WS_P + (size_t)T * PW * 2 <= WS_DNC && WS_DNC + (size_t)NCH * REC <= WS_Y5, "ws map");
constexpr int LDS_BYTES = 147456;

struct Args { const float* in[31]; float* out; unsigned char* ws; };

DI int colmap(int mode, int n) {
    if (mode == 0) return n;
    if (mode == 1) return n < 2048 ? n : (n < 2560 ? n + 8 : (n < 2568 ? n - 512 : -1));
    const int pn = n >> 8, bj = (n >> 7) & 1, j = n & 127;
    return bj * (mode == 2 ? 512 : 2816) + 128 * pn + j;
}
DI void transpose_item(const float* W, int K, int N, bf16* WT, float* scr, int kb, int nb, int lane, int mode, const float* rs) {
    const int k0 = 64 * kb, n0 = 32 * nb;
    const int sc = colmap(mode, n0 + (lane & 31));
    float tv[32];
#pragma unroll
    for (int i = 0; i < 32; ++i) { const int kk = 2 * i + (lane >> 5); tv[i] = 0.f; if (sc >= 0) tv[i] = W[(size_t)(k0 + kk) * N + sc]; }
#pragma unroll
    for (int i = 0; i < 32; ++i) { const int kk = 2 * i + (lane >> 5); float v = tv[i]; if (rs) v *= rs[k0 + kk]; scr[kk * 33 + (lane & 31)] = v; }
    asm volatile("s_waitcnt lgkmcnt(0)" ::: "memory");
    const int c = lane & 7;
#pragma unroll
    for (int j = 0; j < 4; ++j) { const int n = (lane >> 3) + 8 * j; const float* s = scr + (8 * c) * 33 + n;
        u32x4 o; o.x = pk2(s[0 * 33], s[1 * 33]); o.y = pk2(s[2 * 33], s[3 * 33]); o.z = pk2(s[4 * 33], s[5 * 33]); o.w = pk2(s[6 * 33], s[7 * 33]);
        *(u32x4*)(WT + (size_t)(n0 + n) * K + k0 + 8 * c) = o; }
    asm volatile("s_waitcnt lgkmcnt(0)" ::: "memory");
}
DI void phase0(const Args& a, unsigned char* lds, int gw, int NGW, int wave, int lane) {
    asm volatile("" : "+v"(lane));
    unsigned char* ws = a.ws;
    float* scr = (float*)(lds + wave * 16384);
    constexpr int I_IN = 16 * (NIN / 32), I_GLU = 8 * 32, I_OUT = 16 * 32, I_UP = 16 * (UPW / 32), I_DN = 44 * 32;
    constexpr int NIT = I_IN + I_GLU + I_OUT + I_UP + I_DN;
    for (int it = gw; it < NIT; it += NGW) {
        int r = it;
        if (r < I_IN) { transpose_item(a.in[8], 1024, 2568, (bf16*)(ws + WS_WIN), scr, r / (NIN / 32), r % (NIN / 32), lane, 1, nullptr); continue; } r -= I_IN;
        if (r < I_GLU) { transpose_item(a.in[21], 512, 1024, (bf16*)(ws + WS_WGLU), scr, r / 32, r % 32, lane, 2, nullptr); continue; } r -= I_GLU;
        if (r < I_OUT) { transpose_item(a.in[24], 1024, 1024, (bf16*)(ws + WS_WOUT), scr, r / 32, r % 32, lane, 0, nullptr); continue; } r -= I_OUT;
        if (r < I_UP) { transpose_item(a.in[26], 1024, 5632, (bf16*)(ws + WS_WUP), scr, r / (UPW / 32), r % (UPW / 32), lane, 3, a.in[25]); continue; } r -= I_UP;
        transpose_item(a.in[29], 2816, 1024, (bf16*)(ws + WS_WDOWN), scr, r / 32, r % 32, lane, 0, nullptr);
    }
    const float* g1 = a.in[7];
    f32x4 gv[4];
#pragma unroll
    for (int j = 0; j < 4; ++j) gv[j] = ((const f32x4*)g1)[lane + 64 * j];
    bf16* H = (bf16*)(ws + WS_H);
    for (int m0 = gw; m0 < T; m0 += 2 * NGW) {
        const int m1 = m0 + NGW < T ? m0 + NGW : m0;
        const f32x4* xr0 = (const f32x4*)(m0 < TP ? a.in[0] + (size_t)m0 * DM : a.in[1] + (size_t)(m0 - TP) * DM) + lane;
        const f32x4* xr1 = (const f32x4*)(m1 < TP ? a.in[0] + (size_t)m1 * DM : a.in[1] + (size_t)(m1 - TP) * DM) + lane;
        f32x4 v0[4], v1[4]; float s0 = 0.f, s1 = 0.f;
#pragma unroll
        for (int j = 0; j < 4; ++j) { v0[j] = xr0[64 * j]; v1[j] = xr1[64 * j]; }
#pragma unroll
        for (int j = 0; j < 4; ++j) { s0 += (v0[j].x * v0[j].x + v0[j].y * v0[j].y) + (v0[j].z * v0[j].z + v0[j].w * v0[j].w); s1 += (v1[j].x * v1[j].x + v1[j].y * v1[j].y) + (v1[j].z * v1[j].z + v1[j].w * v1[j].w); }
        const float r0 = rsqrtf(wave_sum(s0) * (1.f / DM) + EPS), r1 = rsqrtf(wave_sum(s1) * (1.f / DM) + EPS);
        u32x2* o0 = (u32x2*)(H + (size_t)m0 * DM) + lane; u32x2* o1 = (u32x2*)(H + (size_t)m1 * DM) + lane;
#pragma unroll
        for (int j = 0; j < 4; ++j) { u32x2 o; o.x = pk2(v0[j].x * r0 * gv[j].x, v0[j].y * r0 * gv[j].y); o.y = pk2(v0[j].z * r0 * gv[j].z, v0[j].w * r0 * gv[j].w); o0[64 * j] = o; }
        if (m1 != m0) {
#pragma unroll
            for (int j = 0; j < 4; ++j) { u32x2 o; o.x = pk2(v1[j].x * r1 * gv[j].x, v1[j].y * r1 * gv[j].y); o.y = pk2(v1[j].z * r1 * gv[j].z, v1[j].w * r1 * gv[j].w); o1[64 * j] = o; }
        }
    }
}

struct EpiP {
    static constexpr bool PERM = true, AFTER_DRAIN = false;
    bf16* P; float* BA;
    DI void operator()(const pg8::f32x4 (&acc)[2][2][4][2], const pg8::Unit& u, int wr, int wc, int fr, int fq) const {
        const int row0 = u.pm * 256 + wr * 64 + fr;
        if (u.pn < 10) {
            const int col0 = u.pn * 256 + wc * 32 + 8 * fq;
#pragma unroll
            for (int ai = 0; ai < 2; ++ai)
#pragma unroll
                for (int m = 0; m < 4; ++m) { bf16* rowp = P + (size_t)(row0 + ai * 128 + m * 16) * PW + col0;
#pragma unroll
                    for (int bj = 0; bj < 2; ++bj) { const pg8::f32x4 v0 = acc[ai][bj][m][0], v1 = acc[ai][bj][m][1];
                        u32x4 w; w.x = pk2(v0[0], v0[1]); w.y = pk2(v0[2], v0[3]); w.z = pk2(v1[0], v1[1]); w.w = pk2(v1[2], v1[3]);
                        *(u32x4*)(rowp + bj * 128) = w; } }
        } else if (wc == 0 && fq == 0) {
#pragma unroll
            for (int ai = 0; ai < 2; ++ai)
#pragma unroll
                for (int m = 0; m < 4; ++m) { float* bp = BA + (size_t)(row0 + ai * 128 + m * 16) * 8;
                    *(pg8::f32x4*)bp = acc[ai][0][m][0]; *(pg8::f32x4*)(bp + 4) = acc[ai][0][m][1]; }
        }
    }
};
struct EpiGlu {
    static constexpr bool PERM = true, AFTER_DRAIN = false;
    bf16* O; const float* gb;
    DI void operator()(const pg8::f32x4 (&acc)[2][2][4][2], const pg8::Unit& u, int wr, int wc, int fr, int fq) const {
        const int row0 = u.pm * 256 + wr * 64 + fr, col0 = u.pn * 128 + wc * 32 + 8 * fq;
        const pg8::f32x4 ba0 = *(const pg8::f32x4*)(gb + col0), ba1 = *(const pg8::f32x4*)(gb + col0 + 4), bg0 = *(const pg8::f32x4*)(gb + 512 + col0), bg1 = *(const pg8::f32x4*)(gb + 512 + col0 + 4);
#pragma unroll
        for (int ai = 0; ai < 2; ++ai)
#pragma unroll
            for (int m = 0; m < 4; ++m) {
                const pg8::f32x4 a0 = acc[ai][0][m][0] + ba0, a1 = acc[ai][0][m][1] + ba1, g0 = acc[ai][1][m][0] + bg0, g1 = acc[ai][1][m][1] + bg1;
                float o[8];
#pragma unroll
                for (int e = 0; e < 4; ++e) { o[e] = a0[e] * sigm(g0[e]); o[4 + e] = a1[e] * sigm(g1[e]); }
                u32x4 w; w.x = pk2(o[0], o[1]); w.y = pk2(o[2], o[3]); w.z = pk2(o[4], o[5]); w.w = pk2(o[6], o[7]);
                *(u32x4*)(O + (size_t)(row0 + ai * 128 + m * 16) * 512 + col0) = w;
            }
    }
};
struct EpiX1 {
    static constexpr bool PERM = false, AFTER_DRAIN = false;
    const float* xp; const float* xs; float* out; bf16* xb; float* ss2;
    DI void operator()(const pg8::f32x4 (&acc)[2][2][4][2], const pg8::Unit& u, int wr, int wc, int fr, int fq) const {
        const int row0 = u.pm * 256 + wr * 64 + fr, col0 = u.pn * 256 + wc * 32 + 4 * fq;
#pragma unroll
        for (int ai = 0; ai < 2; ++ai)
#pragma unroll
            for (int m = 0; m < 4; ++m) {
                const int row = row0 + ai * 128 + m * 16;
                const float* xr = (row < TP ? xp + (size_t)row * DM : xs + (size_t)(row - TP) * DM) + col0;
                float ss = 0.f;
#pragma unroll
                for (int bj = 0; bj < 2; ++bj)
#pragma unroll
                    for (int n = 0; n < 2; ++n) {
                        const pg8::f32x4 v = *(const pg8::f32x4*)(xr + bj * 128 + n * 16) + acc[ai][bj][m][n];
                        u32x2 w; w.x = pk2(v[0], v[1]); w.y = pk2(v[2], v[3]);
                        *(u32x2*)(xb + (size_t)row * DM + col0 + bj * 128 + n * 16) = w;
                        ss += (v[0] * v[0] + v[1] * v[1]) + (v[2] * v[2] + v[3] * v[3]);
                    }
                ss += __shfl_xor(ss, 16); ss += __shfl_xor(ss, 32);
                if (fq == 0) ss2[(size_t)row * 16 + u.pn * 4 + wc] = ss;
            }
    }
};
struct EpiUp {
    static constexpr bool PERM = true, AFTER_DRAIN = false;
    bf16* UP; const float* ss2;
    DI void operator()(const pg8::f32x4 (&acc)[2][2][4][2], const pg8::Unit& u, int wr, int wc, int fr, int fq) const {
        const int row0 = u.pm * 256 + wr * 64 + fr, col0 = u.pn * 128 + wc * 32 + 8 * fq;
#pragma unroll
        for (int ai = 0; ai < 2; ++ai)
#pragma unroll
            for (int m = 0; m < 4; ++m) {
                const int row = row0 + ai * 128 + m * 16;
                const pg8::f32x4* sp = (const pg8::f32x4*)(ss2 + (size_t)row * 16);
                const pg8::f32x4 s0 = sp[0], s1 = sp[1], s2 = sp[2], s3 = sp[3];
                const float tot = ((s0[0] + s0[1]) + (s0[2] + s0[3])) + ((s1[0] + s1[1]) + (s1[2] + s1[3])) + ((s2[0] + s2[1]) + (s2[2] + s2[3])) + ((s3[0] + s3[1]) + (s3[2] + s3[3]));
                const float r = rsqrtf(tot * (1.f / DM) + EPS);
                bf16* rowp = UP + (size_t)row * UPW + col0;
#pragma unroll
                for (int bj = 0; bj < 2; ++bj) { const pg8::f32x4 v0 = acc[ai][bj][m][0] * r, v1 = acc[ai][bj][m][1] * r;
                    u32x4 w; w.x = pk2(v0[0], v0[1]); w.y = pk2(v0[2], v0[3]); w.z = pk2(v1[0], v1[1]); w.w = pk2(v1[2], v1[3]);
                    *(u32x4*)(rowp + bj * DFF) = w; }
            }
    }
};
DI float dpp_shr1(float v) { return __int_as_float(__builtin_amdgcn_update_dpp(0, __float_as_int(v), 0x111, 0xf, 0xf, false)); }
DI float dpp_shr2(float v) { return __int_as_float(__builtin_amdgcn_update_dpp(0, __float_as_int(v), 0x112, 0xf, 0xf, false)); }
struct EpiUpAct {
    static constexpr bool PERM = true, AFTER_DRAIN = false;
    bf16* ACT; bf16* GH; bf16* GT; bf16* VH; const float* ss2; const float* fw; const float* fb;
    DI void operator()(const pg8::f32x4 (&acc)[2][2][4][2], const pg8::Unit& u, int wr, int wc, int fr, int fq) const {
        const int row0 = u.pm * 256 + wr * 64 + fr, col0 = u.pn * 128 + wc * 32 + 8 * fq;
        float w0[8], w1[8], w2[8], bb[8];
#pragma unroll
        for (int n = 0; n < 2; ++n) { const pg8::f32x4 a0 = *(const pg8::f32x4*)(fw + col0 + 4 * n), a1 = *(const pg8::f32x4*)(fw + DFF + col0 + 4 * n), a2 = *(const pg8::f32x4*)(fw + 2 * DFF + col0 + 4 * n), a3 = *(const pg8::f32x4*)(fb + col0 + 4 * n);
#pragma unroll
            for (int e = 0; e < 4; ++e) { w0[4 * n + e] = a0[e]; w1[4 * n + e] = a1[e]; w2[4 * n + e] = a2[e]; bb[4 * n + e] = a3[e]; } }
#pragma unroll
        for (int ai = 0; ai < 2; ++ai)
#pragma unroll
            for (int m = 0; m < 4; ++m) {
                const int row = row0 + ai * 128 + m * 16, grp = row >> 4;
                const pg8::f32x4* sp = (const pg8::f32x4*)(ss2 + (size_t)row * 16);
                const pg8::f32x4 s0 = sp[0], s1 = sp[1], s2 = sp[2], s3 = sp[3];
                const float tot = ((s0[0] + s0[1]) + (s0[2] + s0[3])) + ((s1[0] + s1[1]) + (s1[2] + s1[3])) + ((s2[0] + s2[1]) + (s2[2] + s2[3])) + ((s3[0] + s3[1]) + (s3[2] + s3[3]));
                const float r = rsqrtf(tot * (1.f / DM) + EPS);
                float gs[8], vv[8], o[8];
#pragma unroll
                for (int n = 0; n < 2; ++n)
#pragma unroll
                    for (int e = 0; e < 4; ++e) { gs[4 * n + e] = acc[ai][0][m][n][e] * r; vv[4 * n + e] = acc[ai][1][m][n][e] * r; }
#pragma unroll
                for (int e = 0; e < 8; ++e) { const float g1 = dpp_shr1(gs[e]), g2 = dpp_shr2(gs[e]); o[e] = silu(g2 * w0[e] + g1 * w1[e] + gs[e] * w2[e] + bb[e]) * vv[e]; }
                u32x4 wg; wg.x = pk2(gs[0], gs[1]); wg.y = pk2(gs[2], gs[3]); wg.z = pk2(gs[4], gs[5]); wg.w = pk2(gs[6], gs[7]);
                if (fr >= 2) { u32x4 w; w.x = pk2(o[0], o[1]); w.y = pk2(o[2], o[3]); w.z = pk2(o[4], o[5]); w.w = pk2(o[6], o[7]);
                    *(u32x4*)(ACT + (size_t)row * DFF + col0) = w; }
                else { u32x4 wv; wv.x = pk2(vv[0], vv[1]); wv.y = pk2(vv[2], vv[3]); wv.z = pk2(vv[4], vv[5]); wv.w = pk2(vv[6], vv[7]);
                    *(u32x4*)(GH + ((size_t)grp * 2 + fr) * DFF + col0) = wg; *(u32x4*)(VH + ((size_t)grp * 2 + fr) * DFF + col0) = wv; }
                if (fr >= 14) *(u32x4*)(GT + ((size_t)grp * 2 + (fr - 14)) * DFF + col0) = wg;
            }
    }
};
struct EpiX2 {
    static constexpr bool PERM = false, AFTER_DRAIN = false;
    float* out; const bf16* xb;
    DI void operator()(const pg8::f32x4 (&acc)[2][2][4][2], const pg8::Unit& u, int wr, int wc, int fr, int fq) const {
        const int row0 = u.pm * 256 + wr * 64 + fr, col0 = u.pn * 256 + wc * 32 + 4 * fq;
#pragma unroll
        for (int ai = 0; ai < 2; ++ai)
#pragma unroll
            for (int m = 0; m < 4; ++m) {
                float* orow = out + (size_t)(row0 + ai * 128 + m * 16) * DM + col0;
#pragma unroll
                for (int bj = 0; bj < 2; ++bj)
#pragma unroll
                    for (int n = 0; n < 2; ++n) { const u32x2 xb2 = *(const u32x2*)(xb + (size_t)(row0 + ai * 128 + m * 16) * DM + col0 + bj * 128 + n * 16);
                        pg8::f32x4 v = acc[ai][bj][m][n]; v[0] += blo(xb2.x); v[1] += bhi(xb2.x); v[2] += blo(xb2.y); v[3] += bhi(xb2.y);
                        *(pg8::f32x4*)(orow + bj * 128 + n * 16) = v; }
            }
    }
};

DI int kperm(int k) { return (k & ~31) | (((k >> 2) & 3) << 3) | (((k >> 4) & 1) << 2) | (k & 3); }
DI void conv_col(const bf16* pcol, float h0, float h1, float h2, const float* cw, int nrows, float* outp, float (&val)[64]) {
    const float w0 = cw[0], w1 = cw[1536], w2 = cw[2 * 1536], w3 = cw[3 * 1536];
    float x3 = h0, x2 = h1, x1 = h2;
#pragma unroll
    for (int r = 0; r < 64; ++r) {
        float x0 = 0.f;
        if (r < nrows) x0 = b2f(pcol[(size_t)r * PW]);
        const float c = x3 * w0 + x2 * w1 + x1 * w2 + x0 * w3;
        val[r] = r < nrows ? silu(c) : 0.f;
        if (outp && r >= nrows - 3 && r < nrows) outp[(r - (nrows - 3)) * 1536] = x0;
        x3 = x2; x2 = x1; x1 = x0;
    }
}
DI void dn_chunk_phase(const Args& a, unsigned char* lds, int tid, int it0, int it1, int its) {
    unsigned char* ws = a.ws;
    const bf16* P = (const bf16*)(ws + WS_P);
    const float* BA = (const float*)(ws + WS_BA);
    const float* cwt = a.in[9];
    constexpr float QSCALE = 0.08838834764831845f;
    for (int it = it0; it < it1; it += its) {
        int tl = tid; asm volatile("" : "+v"(tl));
        const int half = __builtin_amdgcn_readfirstlane(tl >> 8), t8 = tl & 255, hw = __builtin_amdgcn_readfirstlane((tl >> 6) & 3), lane = tl & 63, fr = lane & 15, fq = lane >> 4;
        unsigned char* L = lds + half * 53248;
        unsigned char* qb = L; unsigned char* kb = L + 17408;
        float* Am = (float*)(L + 34816);
        float* Gs = (float*)(L + 51200); float* Bs = Gs + 64; float* RQ = Gs + 128; float* RK = Gs + 192; float* EG = Gs + 256;
        const int unit = it * 2 + half;
        int row0, nrows, h, bidx; bool sample, first, lastc;
        if (unit < 2048) { const int b = unit >> 9, n = unit & 127; h = (unit >> 7) & 3; row0 = b * 8192 + n * 64; nrows = 64; sample = false; first = (n == 0); lastc = (n == 127); bidx = b; }
        else { const int su = unit - 2048; bidx = su >> 2; h = su & 3; row0 = TP + bidx * 16; nrows = 16; sample = true; first = false; lastc = true; }
        unsigned char* rec = ws + WS_DNC + (size_t)unit * REC;
        if (hw == 0) {
            float g = 0.f, be = 0.f;
            if (lane < nrows) {
                const float* bp = BA + (size_t)(row0 + lane) * 8;
                be = sigm(bp[h]);
                const float xx = bp[4 + h] + a.in[11][h];
                const float sp = xx > 20.f ? xx : log1pf(__expf(xx));
                g = -__expf(a.in[10][h]) * sp;
            }
#pragma unroll
            for (int o = 1; o < 64; o <<= 1) { const float v = __shfl_up(g, o); if (lane >= o) g += v; }
            Gs[lane] = g; Bs[lane] = be; EG[lane] = __expf(g);
            if (lane == 63) ((float*)(ws + WS_EG))[unit] = __expf(g);
        }
        float va[64];
        {
            const int c = t8 & 127;
            const int col = (t8 < 128 ? 0 : 512) + h * 128 + c;
            float h0 = 0.f, h1 = 0.f, h2 = 0.f;
            if (sample) { const float* cc = a.in[2] + (size_t)bidx * 3 * 1536 + col; h0 = cc[0]; h1 = cc[1536]; h2 = cc[2 * 1536]; }
            else if (!first) { const bf16* pp = P + (size_t)(row0 - 3) * PW + col; h0 = b2f(pp[0]); h1 = b2f(pp[PW]); h2 = b2f(pp[2 * PW]); }
            float* outp = lastc ? a.out + (sample ? O_SDC : O_PDC) + (size_t)bidx * 3 * 1536 + col : nullptr;
            conv_col(P + (size_t)row0 * PW + col, h0, h1, h2, cwt + col, nrows, outp, va);
            unsigned char* dst = (t8 < 128 ? qb : kb) + c * 2;
#pragma unroll
            for (int r = 0; r < 64; ++r) *(bf16*)(dst + r * 272) = f2b(va[r]);
        }
        __syncthreads();
        f32x4 kk[4], qk[4], qq;
        {
            bf16x8 ak[4], aq[4];
#pragma unroll
            for (int ks = 0; ks < 4; ++ks) { ak[ks] = *(const bf16x8*)(kb + (16 * hw + fr) * 272 + ks * 64 + fq * 16); aq[ks] = *(const bf16x8*)(qb + (16 * hw + fr) * 272 + ks * 64 + fq * 16); }
            qq = (f32x4){0.f, 0.f, 0.f, 0.f};
#pragma unroll
            for (int ks = 0; ks < 4; ++ks) qq = MFMA16(aq[ks], aq[ks], qq);
#pragma unroll
            for (int nt = 0; nt < 4; ++nt) {
                kk[nt] = (f32x4){0.f, 0.f, 0.f, 0.f}; qk[nt] = (f32x4){0.f, 0.f, 0.f, 0.f};
#pragma unroll
                for (int ks = 0; ks < 4; ++ks) { const bf16x8 bk = *(const bf16x8*)(kb + (16 * nt + fr) * 272 + ks * 64 + fq * 16);
                    kk[nt] = MFMA16(ak[ks], bk, kk[nt]); qk[nt] = MFMA16(aq[ks], bk, qk[nt]); }
            }
#pragma unroll
            for (int i = 0; i < 4; ++i) if (fr == 4 * fq + i) {
                float dk = 0.f;
#pragma unroll
                for (int nt = 0; nt < 4; ++nt) if (nt == hw) dk = kk[nt][i];
                RK[16 * hw + fr] = rsqrtf(dk + EPS); RQ[16 * hw + fr] = rsqrtf(qq[i] + EPS);
            }
        }
        __syncthreads();
        {
            bf16* QKr = (bf16*)(rec + R_QK);
#pragma unroll
            for (int i = 0; i < 4; ++i) {
                const int row = 16 * hw + 4 * fq + i;
                const float gr = Gs[row], br = Bs[row], rk = RK[row], rq = RQ[row];
#pragma unroll
                for (int nt = 0; nt < 4; ++nt) {
                    const int col = 16 * nt + fr;
                    const float d = col <= row ? gr - Gs[col] : 0.f;
                    const float e = __expf(d), rkc = RK[col];
                    Am[row * 64 + col] = col < row ? br * kk[nt][i] * rk * rkc * e : 0.f;
                    QKr[row * 64 + kperm(col)] = f2b(col <= row ? qk[nt][i] * rq * rkc * QSCALE * e : 0.f);
                }
            }
        }
        __syncthreads();
        if (t8 < 128) {
            bf16* Qg = (bf16*)(rec + R_QG) + kperm(t8);
#pragma unroll
            for (int r = 0; r < 64; ++r) Qg[r * 128] = f2b(va[r] * RQ[r] * QSCALE * EG[r]);
            {
                const int col = 1024 + h * 128 + t8;
                float h0 = 0.f, h1 = 0.f, h2 = 0.f;
                if (sample) { const float* cc = a.in[2] + (size_t)bidx * 3 * 1536 + col; h0 = cc[0]; h1 = cc[1536]; h2 = cc[2 * 1536]; }
                else if (!first) { const bf16* pp = P + (size_t)(row0 - 3) * PW + col; h0 = b2f(pp[0]); h1 = b2f(pp[PW]); h2 = b2f(pp[2 * PW]); }
                float* outp = lastc ? a.out + (sample ? O_SDC : O_PDC) + (size_t)bidx * 3 * 1536 + col : nullptr;
                conv_col(P + (size_t)row0 * PW + col, h0, h1, h2, cwt + col, nrows, outp, va);
            }
#pragma unroll
            for (int r = 0; r < 64; ++r) va[r] = va[r] * Bs[r];
        } else {
            const int c = t8 - 128;
            const float gl = Gs[63];
            unsigned w[32];
#pragma unroll
            for (int r = 0; r < 64; r += 2) w[kperm(r) >> 1] = pk2(va[r] * RK[r] * __expf(gl - Gs[r]), va[r + 1] * RK[r + 1] * __expf(gl - Gs[r + 1]));
            u32x4* dst = (u32x4*)(rec + R_KDT + c * 128);
#pragma unroll
            for (int j = 0; j < 8; ++j) dst[j] = (u32x4){w[4 * j], w[4 * j + 1], w[4 * j + 2], w[4 * j + 3]};
#pragma unroll
            for (int r = 0; r < 64; ++r) va[r] = va[r] * RK[r] * Bs[r] * EG[r];
        }
#if SOLVE_RL
        {
            float arow[64];
#pragma unroll
            for (int i = 1; i < 64; ++i) arow[i] = Am[i * 64 + lane];
#pragma unroll
            for (int i = 1; i < 64; ++i) {
                if (i < nrows) {
                    float acc0 = va[i], acc1 = 0.f;
#pragma unroll
                    for (int j = 0; j < i; ++j) { const float aij = __int_as_float(__builtin_amdgcn_readlane(__float_as_int(arow[i]), j)); if (j & 1) acc1 -= aij * va[j]; else acc0 -= aij * va[j]; }
                    va[i] = acc0 + acc1;
                }
            }
        }
#else
#pragma unroll
        for (int i = 1; i < 64; ++i) {
            float acc = va[i];
            const f32x4* Ar = (const f32x4*)(Am + i * 64);
#pragma unroll
            for (int j4 = 0; j4 < (i + 3) / 4; ++j4) {
                const f32x4 av = Ar[j4];
#pragma unroll
                for (int e = 0; e < 4; ++e) if (4 * j4 + e < i) acc -= av[e] * va[4 * j4 + e];
            }
            va[i] = acc;
        }
#endif
        if (t8 < 128) { bf16* U0 = (bf16*)(rec + R_U0) + t8;
#pragma unroll
            for (int r = 0; r < 64; ++r) U0[r * 128] = f2b(va[r]);
        } else { bf16* Wn = (bf16*)(rec + R_WN) + kperm(t8 - 128);
#pragma unroll
            for (int r = 0; r < 64; ++r) Wn[r * 128] = f2b(-va[r]);
        }
        __syncthreads();
    }
}

struct S5W { float lr[4], li[4]; bf16x8 bf[8]; };
DI void s5w_setup(const Args& a, int g, int fr, int fq, S5W& w) {
    const float dt = __expf(a.in[15][g]);
#pragma unroll
    for (int j = 0; j < 4; ++j) {
        const int p = 16 * j + fr;
        const float are = a.in[13][g * 64 + p], aim = a.in[14][g * 64 + p];
        const float mag = __expf(are * dt), ang = aim * dt;
        float sn, cs; sincosf(ang, &sn, &cs);
        const float lr = mag * cs, li = mag * sn;
        w.lr[j] = lr; w.li[j] = li;
        const float den = are * are + aim * aim;
        const float fre = ((lr - 1.f) * are + li * aim) / den, fim = (li * are - (lr - 1.f) * aim) / den;
        u32x4 wr = (u32x4){0u, 0u, 0u, 0u}, wi = (u32x4){0u, 0u, 0u, 0u};
        if (fq < 2) {
            const f32x4* br = (const f32x4*)(a.in[16] + (size_t)(g * 64 + p) * 16 + 8 * fq); const f32x4* bi = (const f32x4*)(a.in[17] + (size_t)(g * 64 + p) * 16 + 8 * fq);
            const f32x4 r0 = br[0], r1 = br[1], i0 = bi[0], i1 = bi[1];
            wr.x = pk2(fre * r0[0] - fim * i0[0], fre * r0[1] - fim * i0[1]); wr.y = pk2(fre * r0[2] - fim * i0[2], fre * r0[3] - fim * i0[3]);
            wr.z = pk2(fre * r1[0] - fim * i1[0], fre * r1[1] - fim * i1[1]); wr.w = pk2(fre * r1[2] - fim * i1[2], fre * r1[3] - fim * i1[3]);
            wi.x = pk2(fre * i0[0] + fim * r0[0], fre * i0[1] + fim * r0[1]); wi.y = pk2(fre * i0[2] + fim * r0[2], fre * i0[3] + fim * r0[3]);
            wi.z = pk2(fre * i1[0] + fim * r1[0], fre * i1[1] + fim * r1[1]); wi.w = pk2(fre * i1[2] + fim * r1[2], fre * i1[3] + fim * r1[3]);
        }
        w.bf[j] = __builtin_bit_cast(bf16x8, wr); w.bf[4 + j] = __builtin_bit_cast(bf16x8, wi);
    }
}
DI bf16x8 s5w_uload(const bf16* P, size_t row0, int SS, int ms, int g, int fr, int fq) {
    u32x4 v = (u32x4){0u, 0u, 0u, 0u};
    if (fq < 2) v = *(const u32x4*)(P + (row0 + (size_t)(fr >> 2) * SS + 4 * ms + (fr & 3)) * PW + 2048 + g * 16 + 8 * fq);
    return __builtin_bit_cast(bf16x8, v);
}
DI void s5w_step(const S5W& w, bf16x8 ua, float (&xr)[4], float (&xi)[4], unsigned (&xo)[4][4]) {
    f32x4 br[4], bi[4];
    const f32x4 z = (f32x4){0.f, 0.f, 0.f, 0.f};
#pragma unroll
    for (int j = 0; j < 4; ++j) { br[j] = MFMA16(ua, w.bf[j], z); bi[j] = MFMA16(ua, w.bf[4 + j], z); }
#pragma unroll
    for (int i = 0; i < 4; ++i)
#pragma unroll
        for (int j = 0; j < 4; ++j) {
            const float nr = w.lr[j] * xr[j] - w.li[j] * xi[j] + br[j][i], ni = w.lr[j] * xi[j] + w.li[j] * xr[j] + bi[j][i];
            xr[j] = nr; xi[j] = ni; xo[i][j] = pk2(nr, ni);
        }
#pragma unroll
    for (int j = 0; j < 8; ++j) asm volatile("" :: "v"(w.bf[j]));
    asm volatile("" :: "v"(ua));
}
DI void s5_pass1(const Args& a, int gw, int NGW, int lane) {
    asm volatile("" : "+v"(lane));
    const bf16* P = (const bf16*)(a.ws + WS_P);
    float* E = (float*)(a.ws + WS_S5E);
    const int fr = lane & 15, fq = lane >> 4;
    for (int unit = gw; unit < 4 * 32 * 16; unit += NGW) {
        const int sg = unit & 15, bg = unit >> 4, g = bg & 31, b = bg >> 5;
        S5W w; s5w_setup(a, g, fr, fq, w);
        float xr[4] = {0.f, 0.f, 0.f, 0.f}, xi[4] = {0.f, 0.f, 0.f, 0.f}; unsigned xo[4][4];
        const size_t row0 = (size_t)b * 8192 + sg * 512;
        bf16x8 ua = s5w_uload(P, row0, 128, 0, g, fr, fq);
        for (int ms = 0; ms < 32; ++ms) {
            const bf16x8 un = s5w_uload(P, row0, 128, ms + 1 < 32 ? ms + 1 : ms, g, fr, fq);
            s5w_step(w, ua, xr, xi, xo); ua = un;
        }
        float* e = E + ((size_t)bg * 64 + 4 * sg + fq) * 128;
#pragma unroll
        for (int j = 0; j < 4; ++j) { e[16 * j + fr] = xr[j]; e[64 + 16 * j + fr] = xi[j]; }
    }
}
DI void s5w_run(const Args& a, const S5W& w, const bf16x8 (&cf)[4], float Dg, unsigned char* xs, size_t row0, int SS, int nms, int g, int fr, int fq, float (&xr)[4], float (&xi)[4]) {
    const bf16* P = (const bf16*)(a.ws + WS_P);
    bf16* Y5 = (bf16*)(a.ws + WS_Y5);
    bf16x8 ua = s5w_uload(P, row0, SS, 0, g, fr, fq);
    for (int ms = 0; ms < nms; ++ms) {
        const bf16x8 un = s5w_uload(P, row0, SS, ms + 1 < nms ? ms + 1 : ms, g, fr, fq);
        float uu[4];
#pragma unroll
        for (int i = 0; i < 4; ++i) uu[i] = b2f(P[(row0 + (size_t)fq * SS + 4 * ms + i) * PW + 2048 + g * 16 + fr]);
        unsigned xo[4][4];
        s5w_step(w, ua, xr, xi, xo); ua = un;
#pragma unroll
        for (int i = 0; i < 4; ++i)
#pragma unroll
            for (int j = 0; j < 4; ++j) *(unsigned*)(xs + (4 * fq + i) * 272 + (16 * j + fr) * 4) = xo[i][j];
        asm volatile("s_waitcnt lgkmcnt(0)" ::: "memory");
        f32x4 y = (f32x4){0.f, 0.f, 0.f, 0.f};
        bf16x8 af[4];
#pragma unroll
        for (int ks = 0; ks < 4; ++ks) af[ks] = *(const bf16x8*)(xs + fr * 272 + ks * 64 + fq * 16);
        asm volatile("" ::: "memory");
#pragma unroll
        for (int ks = 0; ks < 4; ++ks) y = MFMA16(af[ks], cf[ks], y);
#if DIAG_Y
        {
            const float* cre = a.in[18] + (size_t)(g * 16 + fr) * 64; const float* cim = a.in[19] + (size_t)(g * 16 + fr) * 64;
#pragma unroll
            for (int i = 0; i < 4; ++i) { float acc = 0.f;
                for (int p = 0; p < 64; ++p) { const unsigned wv = *(const unsigned*)(xs + (4 * fq + i) * 272 + p * 4); acc += cre[p] * blo(wv) - cim[p] * bhi(wv); }
                y[i] = acc; }
        }
#endif
        asm volatile("" :: "v"(y));
#pragma unroll
        for (int ks = 0; ks < 4; ++ks) asm volatile("" :: "v"(af[ks]), "v"(cf[ks]));
#pragma unroll
        for (int i = 0; i < 4; ++i) {
            const size_t row = row0 + (size_t)fq * SS + 4 * ms + i;
            Y5[row * 512 + g * 16 + fr] = f2b(gelu_tanh(y[i] + Dg * uu[i]));
        }
    }
}
DI void s5_cfrag(const Args& a, int g, int fr, int fq, bf16x8 (&cf)[4]) {
#pragma unroll
    for (int ks = 0; ks < 4; ++ks) {
        const f32x4 cr = *(const f32x4*)(a.in[18] + (size_t)(g * 16 + fr) * 64 + 16 * ks + 4 * fq), ci = *(const f32x4*)(a.in[19] + (size_t)(g * 16 + fr) * 64 + 16 * ks + 4 * fq);
        u32x4 w; w.x = pk2(cr[0], -ci[0]); w.y = pk2(cr[1], -ci[1]); w.z = pk2(cr[2], -ci[2]); w.w = pk2(cr[3], -ci[3]);
        cf[ks] = __builtin_bit_cast(bf16x8, w);
    }
}
DI void s5_pass2_prompt(const Args& a, unsigned char* lds, int bg, int tid) {
    asm volatile("" : "+v"(tid));
    const int wave = __builtin_amdgcn_readfirstlane(tid >> 6), lane = tid & 63, fr = lane & 15, fq = lane >> 4;
    const int b = bg >> 5, g4 = (bg >> 2) & 7, part = bg & 3, g = 4 * g4 + (wave & 3);
    bg = b * 32 + g;
    unsigned char* xs = lds + wave * 4352;
    S5W w; s5w_setup(a, g, fr, fq, w);
    bf16x8 cf[4]; s5_cfrag(a, g, fr, fq, cf);
    const float Dg = a.in[20][g * 16 + fr];
    float pr[4], pi[4];
#pragma unroll
    for (int j = 0; j < 4; ++j) { pr[j] = w.lr[j]; pi[j] = w.li[j];
#pragma unroll
        for (int s = 0; s < 7; ++s) { const float nr = pr[j] * pr[j] - pi[j] * pi[j], ni = 2.f * pr[j] * pi[j]; pr[j] = nr; pi[j] = ni; } }
    const float* e = (const float*)(a.ws + WS_S5E) + (size_t)bg * 64 * 128;
    for (int uu = 0; uu < 2; ++uu) {
        const int sg = 4 * part + 2 * (wave >> 2) + uu, seg = 4 * sg + fq;
        float xr[4] = {0.f, 0.f, 0.f, 0.f}, xi[4] = {0.f, 0.f, 0.f, 0.f};
        for (int s = 0; s < 4 * sg + 3; ++s) {
            if (s < seg) {
#pragma unroll
                for (int j = 0; j < 4; ++j) { const float er = e[s * 128 + 16 * j + fr], ei = e[s * 128 + 64 + 16 * j + fr];
                    const float nr = pr[j] * xr[j] - pi[j] * xi[j] + er, ni = pr[j] * xi[j] + pi[j] * xr[j] + ei; xr[j] = nr; xi[j] = ni; }
            }
        }
        s5w_run(a, w, cf, Dg, xs, (size_t)b * 8192 + sg * 512, 128, 32, g, fr, fq, xr, xi);
        if (seg == 63) {
#pragma unroll
            for (int j = 0; j < 4; ++j) { a.out[O_PSR + (size_t)bg * 64 + 16 * j + fr] = xr[j]; a.out[O_PSI + (size_t)bg * 64 + 16 * j + fr] = xi[j]; }
        }
    }
}
DI void s5_pass2_sample(const Args& a, unsigned char* xs, int gw, int NGW, int lane) {
    asm volatile("" : "+v"(lane));
    const int fr = lane & 15, fq = lane >> 4;
    for (int unit = gw; unit < 256; unit += NGW) {
        const int g = unit & 31, q = unit >> 5, sb = 4 * q + fq;
        S5W w; s5w_setup(a, g, fr, fq, w);
        bf16x8 cf[4]; s5_cfrag(a, g, fr, fq, cf);
        const float Dg = a.in[20][g * 16 + fr];
        float xr[4], xi[4];
#pragma unroll
        for (int j = 0; j < 4; ++j) { xr[j] = a.in[4][(size_t)(sb * 32 + g) * 64 + 16 * j + fr]; xi[j] = a.in[5][(size_t)(sb * 32 + g) * 64 + 16 * j + fr]; }
        s5w_run(a, w, cf, Dg, xs, (size_t)TP + (size_t)q * 64, 16, 4, g, fr, fq, xr, xi);
#pragma unroll
        for (int j = 0; j < 4; ++j) { a.out[O_SSR + (size_t)(sb * 32 + g) * 64 + 16 * j + fr] = xr[j]; a.out[O_SSI + (size_t)(sb * 32 + g) * 64 + 16 * j + fr] = xi[j]; }
    }
}

struct S5Par { float lr, li; float bbr[16], bbi[16]; };
DI void s5_setup(const Args& a, int g, int p, S5Par& q) {
    const float are = a.in[13][g * 64 + p], aim = a.in[14][g * 64 + p], dt = __expf(a.in[15][g]);
    const float mag = __expf(are * dt), ang = aim * dt;
    float sn, cs; sincosf(ang, &sn, &cs);
    q.lr = mag * cs; q.li = mag * sn;
    const float den = are * are + aim * aim;
    const float fre = ((q.lr - 1.f) * are + q.li * aim) / den, fim = (q.li * are - (q.lr - 1.f) * aim) / den;
    const f32x4* br = (const f32x4*)(a.in[16] + (size_t)(g * 64 + p) * 16); const f32x4* bi = (const f32x4*)(a.in[17] + (size_t)(g * 64 + p) * 16);
#pragma unroll
    for (int j = 0; j < 4; ++j) { const f32x4 r = br[j], i = bi[j];
#pragma unroll
        for (int e = 0; e < 4; ++e) { q.bbr[4 * j + e] = fre * r[e] - fim * i[e]; q.bbi[4 * j + e] = fre * i[e] + fim * r[e]; } }
}
DI void s5_step4(const S5Par& q, float uv, float& xr, float& xi, unsigned (&xo)[4]) {
#pragma unroll
    for (int j = 0; j < 4; ++j) {
        float br = 0.f, bi = 0.f;
#pragma unroll
        for (int h = 0; h < 16; ++h) { const float uh = __int_as_float(__builtin_amdgcn_readlane(__float_as_int(uv), 16 * j + h)); br += q.bbr[h] * uh; bi += q.bbi[h] * uh; }
        const float nr = q.lr * xr - q.li * xi + br, ni = q.lr * xi + q.li * xr + bi;
        xr = nr; xi = ni; xo[j] = pk2(xr, xi);
    }
}
DI void old_s5_pass1(const Args& a, int gw, int NGW, int lane) {
    asm volatile("" : "+v"(lane));
    const bf16* P = (const bf16*)(a.ws + WS_P);
    float* E = (float*)(a.ws + WS_S5E);
    for (int unit = gw; unit < 4 * 32 * 64; unit += NGW) {
        const int seg = unit & 63, bg = unit >> 6, g = bg & 31, b = bg >> 5;
        S5Par q; s5_setup(a, g, lane, q);
        float xr = 0.f, xi = 0.f; unsigned xo[4];
        const bf16* up = P + (size_t)(b * 8192 + seg * 128 + (lane >> 4)) * PW + 2048 + g * 16 + (lane & 15);
#pragma unroll 2
        for (int t = 0; t < 128; t += 4) { const float uv = b2f(up[(size_t)t * PW]); s5_step4(q, uv, xr, xi, xo); }
        float* e = E + ((size_t)bg * 64 + seg) * 128;
        e[lane] = xr; e[64 + lane] = xi;
    }
}
DI void old_s5_pass2(const Args& a, unsigned char* xs  , int gw, int NGW, int lane) {
    asm volatile("" : "+v"(lane));
    const bf16* P = (const bf16*)(a.ws + WS_P);
    const float* E = (const float*)(a.ws + WS_S5E);
    bf16* Y5 = (bf16*)(a.ws + WS_Y5);
    const int fr = lane & 15, fq = lane >> 4;
    for (int unit = gw; unit < OLD_S5_ULIM; unit += NGW) {
        int g, row0, ntok, seg = 0, bg; bool sample;
        if (unit < 8192) { seg = unit & 63; bg = unit >> 6; g = bg & 31; row0 = (bg >> 5) * 8192 + seg * 128; ntok = 128; sample = false; }
        else { bg = unit - 8192; g = bg & 31; row0 = TP + (bg >> 5) * 16; ntok = 16; sample = true; }
        S5Par q; s5_setup(a, g, lane, q);
        float xr = 0.f, xi = 0.f;
        if (sample) { xr = a.in[4][(size_t)bg * 64 + lane]; xi = a.in[5][(size_t)bg * 64 + lane]; }
        else {
            float pr = q.lr, pi = q.li;
#pragma unroll
            for (int s = 0; s < 7; ++s) { const float nr = pr * pr - pi * pi, ni = 2.f * pr * pi; pr = nr; pi = ni; }
            const float* e = E + (size_t)bg * 64 * 128;
            for (int s = 0; s < seg; ++s) { const float er = e[s * 128 + lane], ei = e[s * 128 + 64 + lane]; const float nr = pr * xr - pi * xi + er, ni = pr * xi + pi * xr + ei; xr = nr; xi = ni; }
        }
        bf16x8 cf[4];
#pragma unroll
        for (int ks = 0; ks < 4; ++ks) {
            const f32x4 cr = *(const f32x4*)(a.in[18] + (size_t)(g * 16 + fr) * 64 + 16 * ks + 4 * fq), ci = *(const f32x4*)(a.in[19] + (size_t)(g * 16 + fr) * 64 + 16 * ks + 4 * fq);
            u32x4 w; w.x = pk2(cr[0], -ci[0]); w.y = pk2(cr[1], -ci[1]); w.z = pk2(cr[2], -ci[2]); w.w = pk2(cr[3], -ci[3]);
            cf[ks] = __builtin_bit_cast(bf16x8, w);
        }
        const float Dg = a.in[20][g * 16 + fr];
        const bf16* up = P + (size_t)(row0 + (lane >> 4)) * PW + 2048 + g * 16 + (lane & 15);
        for (int tb = 0; tb < ntok; tb += 16) {
#pragma unroll
            for (int j4 = 0; j4 < 4; ++j4) {
                const float uv = b2f(up[(size_t)(tb + 4 * j4) * PW]);
                unsigned xo[4]; s5_step4(q, uv, xr, xi, xo);
#pragma unroll
                for (int j = 0; j < 4; ++j) *(unsigned*)(xs + (4 * j4 + j) * 272 + lane * 4) = xo[j];
            }
            f32x4 y = (f32x4){0.f, 0.f, 0.f, 0.f};
#pragma unroll
            for (int ks = 0; ks < 4; ++ks) { const bf16x8 af = *(const bf16x8*)(xs + fr * 272 + ks * 64 + fq * 16); y = MFMA16(af, cf[ks], y); }
#pragma unroll
            for (int i = 0; i < 4; ++i) {
                const size_t row = (size_t)row0 + tb + 4 * fq + i;
                const float uu = b2f(P[row * PW + 2048 + g * 16 + fr]);
                Y5[row * 512 + g * 16 + fr] = f2b(gelu_tanh(y[i] + Dg * uu));
            }
        }
        if (sample) { a.out[O_SSR + (size_t)bg * 64 + lane] = xr; a.out[O_SSI + (size_t)bg * 64 + lane] = xi; }
        else if (seg == 63) { a.out[O_PSR + (size_t)bg * 64 + lane] = xr; a.out[O_PSI + (size_t)bg * 64 + lane] = xi; }
    }
}

DI void s5_pass2b(const Args& a, unsigned char* xs, int gw, int NGW, int lane) {
    asm volatile("" : "+v"(lane));
    const bf16* P = (const bf16*)(a.ws + WS_P);
    const float* E = (const float*)(a.ws + WS_S5E);
    bf16* Y5 = (bf16*)(a.ws + WS_Y5);
    const int fr = lane & 15, fq = lane >> 4;
    for (int unit = gw; unit < 4 * 32 * 64 + 32 * 32; unit += NGW) {
        int g, row0, ntok, seg = 0, bg; bool sample;
        if (unit < 8192) { seg = unit & 63; bg = unit >> 6; g = bg & 31; row0 = (bg >> 5) * 8192 + seg * 128; ntok = 128; sample = false; }
        else { bg = unit - 8192; g = bg & 31; row0 = TP + (bg >> 5) * 16; ntok = 16; sample = true; }
        S5Par q; s5_setup(a, g, lane, q);
        float xr = 0.f, xi = 0.f;
        if (sample) { xr = a.in[4][(size_t)bg * 64 + lane]; xi = a.in[5][(size_t)bg * 64 + lane]; }
        else {
            float pr = q.lr, pi = q.li;
#pragma unroll
            for (int s = 0; s < 7; ++s) { const float nr = pr * pr - pi * pi, ni = 2.f * pr * pi; pr = nr; pi = ni; }
            const float* e = E + (size_t)bg * 64 * 128;
            for (int s0 = 0; s0 < seg; s0 += 8) {
                float er[8], ei[8];
#pragma unroll
                for (int k = 0; k < 8; ++k) { const bool ok = s0 + k < seg; er[k] = ok ? e[(s0 + k) * 128 + lane] : 0.f; ei[k] = ok ? e[(s0 + k) * 128 + 64 + lane] : 0.f; }
#pragma unroll
                for (int k = 0; k < 8; ++k) if (s0 + k < seg) { const float nr = pr * xr - pi * xi + er[k], ni = pr * xi + pi * xr + ei[k]; xr = nr; xi = ni; }
            }
        }
        bf16x8 cf[4];
#pragma unroll
        for (int ks = 0; ks < 4; ++ks) {
            const f32x4 cr = *(const f32x4*)(a.in[18] + (size_t)(g * 16 + fr) * 64 + 16 * ks + 4 * fq), ci = *(const f32x4*)(a.in[19] + (size_t)(g * 16 + fr) * 64 + 16 * ks + 4 * fq);
            u32x4 w; w.x = pk2(cr[0], -ci[0]); w.y = pk2(cr[1], -ci[1]); w.z = pk2(cr[2], -ci[2]); w.w = pk2(cr[3], -ci[3]);
            cf[ks] = __builtin_bit_cast(bf16x8, w);
        }
        const float Dg = a.in[20][g * 16 + fr];
        S5W w; s5w_setup(a, g, fr, fq, w);
        unsigned char* bt = xs + 4352;
        for (int tb = 0; tb < ntok; tb += 16) {
            {
                u32x4 uv = (u32x4){0u, 0u, 0u, 0u};
                if (fq < 2) uv = *(const u32x4*)(P + (size_t)(row0 + tb + fr) * PW + 2048 + g * 16 + 8 * fq);
                const bf16x8 ua = __builtin_bit_cast(bf16x8, uv);
                const f32x4 z = (f32x4){0.f, 0.f, 0.f, 0.f};
#pragma unroll
                for (int j = 0; j < 4; ++j) {
                    const f32x4 br = MFMA16(ua, w.bf[j], z), bi = MFMA16(ua, w.bf[4 + j], z);
                    *(f32x4*)(bt + (16 * j + fr) * 80 + fq * 16) = br; *(f32x4*)(bt + (64 + 16 * j + fr) * 80 + fq * 16) = bi;
                }
            }
            asm volatile("s_waitcnt lgkmcnt(0)" ::: "memory");
            f32x4 bre[4], bim[4];
#pragma unroll
            for (int k = 0; k < 4; ++k) { bre[k] = *(const f32x4*)(bt + lane * 80 + k * 16); bim[k] = *(const f32x4*)(bt + (64 + lane) * 80 + k * 16); }
            asm volatile("s_waitcnt lgkmcnt(0)" ::: "memory");
#pragma unroll
            for (int t = 0; t < 16; ++t) {
                const float nr = q.lr * xr - q.li * xi + bre[t >> 2][t & 3], ni = q.lr * xi + q.li * xr + bim[t >> 2][t & 3];
                xr = nr; xi = ni;
                *(unsigned*)(xs + t * 272 + lane * 4) = pk2(nr, ni);
            }
            asm volatile("s_waitcnt lgkmcnt(0)" ::: "memory");
            f32x4 y = (f32x4){0.f, 0.f, 0.f, 0.f};
#pragma unroll
            for (int ks = 0; ks < 4; ++ks) { const bf16x8 af = *(const bf16x8*)(xs + fr * 272 + ks * 64 + fq * 16); y = MFMA16(af, cf[ks], y); }
#pragma unroll
            for (int i = 0; i < 4; ++i) {
                const size_t row = (size_t)row0 + tb + 4 * fq + i;
                const float uu = b2f(P[row * PW + 2048 + g * 16 + fr]);
                Y5[row * 512 + g * 16 + fr] = f2b(gelu_tanh(y[i] + Dg * uu));
            }
        }
        if (sample) { a.out[O_SSR + (size_t)bg * 64 + lane] = xr; a.out[O_SSI + (size_t)bg * 64 + lane] = xi; }
        else if (seg == 63) { a.out[O_PSR + (size_t)bg * 64 + lane] = xr; a.out[O_PSI + (size_t)bg * 64 + lane] = xi; }
    }
}

constexpr int DB_WN = 0, DB_QG = 17408, DB_KDT = 34816, DB_QK = 53248, DB_U0 = 62464;
constexpr int DBP_SIZE = DB_U0 + 64 * 80;
constexpr int DBS_SIZE = DB_U0 + 64 * 272;
template <int NC> struct DnRegs { u32x4 r[7]; u32x4 u[NC == 32 ? 1 : 2]; };
template <int NC> DI void dn_load(const unsigned char* rec, int tid, int c0, DnRegs<NC>& R) {
    const u32x4* g = (const u32x4*)rec;
    R.r[0] = g[tid]; R.r[1] = g[tid + 512]; R.r[2] = g[1024 + tid]; R.r[3] = g[1024 + tid + 512]; R.r[4] = g[2048 + tid]; R.r[5] = g[2048 + tid + 512]; R.r[6] = g[3072 + tid];
    if (NC == 32) { if (tid < 256) R.u[0] = *(const u32x4*)(rec + R_U0 + (tid >> 2) * 256 + c0 * 2 + (tid & 3) * 16); }
    else { R.u[0] = *(const u32x4*)(rec + R_U0 + tid * 16); R.u[1] = *(const u32x4*)(rec + R_U0 + (tid + 512) * 16); }
}
template <int NC> DI void dn_store(unsigned char* buf, int tid, const DnRegs<NC>& R) {
#pragma unroll
    for (int j = 0; j < 2; ++j) { const int q = tid + 512 * j;
        *(u32x4*)(buf + DB_WN + (q >> 4) * 272 + (q & 15) * 16) = R.r[j];
        *(u32x4*)(buf + DB_QG + (q >> 4) * 272 + (q & 15) * 16) = R.r[2 + j];
        *(u32x4*)(buf + DB_KDT + (q >> 3) * 144 + (q & 7) * 16) = R.r[4 + j]; }
    *(u32x4*)(buf + DB_QK + (tid >> 3) * 144 + (tid & 7) * 16) = R.r[6];
    if (NC == 32) { if (tid < 256) *(u32x4*)(buf + DB_U0 + (tid >> 2) * 80 + (tid & 3) * 16) = R.u[0]; }
    else {
#pragma unroll
        for (int j = 0; j < 2; ++j) { const int q = tid + 512 * j; *(u32x4*)(buf + DB_U0 + (q >> 4) * 272 + (q & 15) * 16) = R.u[j]; }
    }
}
DI bf16x8 pack8(const f32x4& lo, const f32x4& hi) { u32x4 w; w.x = pk2(lo[0], lo[1]); w.y = pk2(lo[2], lo[3]); w.z = pk2(hi[0], hi[1]); w.w = pk2(hi[2], hi[3]); return __builtin_bit_cast(bf16x8, w); }
template <int UPI> DI void dn_step(const unsigned char* buf, f32x4 (&S)[8], const unsigned char* u0, float eg, int fr, int fq, f32x4 (&o)[4]) {
    bf16x8 Sb[4];
#pragma unroll
    for (int ks = 0; ks < 4; ++ks) Sb[ks] = pack8(S[2 * ks], S[2 * ks + 1]);
    f32x4 u[4];
#pragma unroll
    for (int mt = 0; mt < 4; ++mt) {
#pragma unroll
        for (int i = 0; i < 4; ++i) u[mt][i] = b2f(*(const bf16*)(u0 + (16 * mt + 4 * fq + i) * UPI));
#pragma unroll
        for (int ks = 0; ks < 4; ++ks) u[mt] = MFMA16(*(const bf16x8*)(buf + DB_WN + (16 * mt + fr) * 272 + ks * 64 + fq * 16), Sb[ks], u[mt]);
    }
    bf16x8 ub[2];
#pragma unroll
    for (int k2 = 0; k2 < 2; ++k2) ub[k2] = pack8(u[2 * k2], u[2 * k2 + 1]);
#pragma unroll
    for (int mt = 0; mt < 4; ++mt) {
        o[mt] = (f32x4){0.f, 0.f, 0.f, 0.f};
#pragma unroll
        for (int ks = 0; ks < 4; ++ks) o[mt] = MFMA16(*(const bf16x8*)(buf + DB_QG + (16 * mt + fr) * 272 + ks * 64 + fq * 16), Sb[ks], o[mt]);
#pragma unroll
        for (int k2 = 0; k2 < 2; ++k2) o[mt] = MFMA16(*(const bf16x8*)(buf + DB_QK + (16 * mt + fr) * 144 + k2 * 64 + fq * 16), ub[k2], o[mt]);
    }
#pragma unroll
    for (int m8 = 0; m8 < 8; ++m8) {
        S[m8] = S[m8] * eg;
#pragma unroll
        for (int k2 = 0; k2 < 2; ++k2) S[m8] = MFMA16(*(const bf16x8*)(buf + DB_KDT + (16 * m8 + fr) * 144 + k2 * 64 + fq * 16), ub[k2], S[m8]);
    }
}
#if DN_STAGED == 2
#define DNP_SYNC() do { asm volatile("s_waitcnt lgkmcnt(0)" ::: "memory"); __builtin_amdgcn_sched_barrier(0); } while (0)
#else
#define DNP_SYNC() do { } while (0)
#endif
DI void dn_step_p(const unsigned char* buf, f32x4 (&S)[8], const unsigned char* u0, float eg, int fr, int fq, f32x4 (&o)[4]) {
    const unsigned char* aw = buf + DB_WN + fr * 272 + fq * 16;
    const unsigned char* aq = buf + DB_QG + fr * 272 + fq * 16;
    const unsigned char* ak = buf + DB_KDT + fr * 144 + fq * 16;
    const unsigned char* ac = buf + DB_QK + fr * 144 + fq * 16;
    bf16x8 f1[16], f2[16], Sb[4], ub[2];
    f32x4 u[4];
#pragma unroll
    for (int mt = 0; mt < 4; ++mt)
#pragma unroll
        for (int ks = 0; ks < 4; ++ks) f1[4 * mt + ks] = *(const bf16x8*)(aw + mt * 4352 + ks * 64);
#pragma unroll
    for (int mt = 0; mt < 4; ++mt)
#pragma unroll
        for (int i = 0; i < 4; ++i) u[mt][i] = b2f(*(const bf16*)(u0 + (16 * mt + 4 * fq + i) * 80));
#pragma unroll
    for (int ks = 0; ks < 4; ++ks) Sb[ks] = pack8(S[2 * ks], S[2 * ks + 1]);
    __builtin_amdgcn_sched_barrier(0);
#pragma unroll
    for (int mt = 0; mt < 4; ++mt)
#pragma unroll
        for (int ks = 0; ks < 4; ++ks) f2[4 * mt + ks] = *(const bf16x8*)(aq + mt * 4352 + ks * 64);
    DNP_SYNC();
#pragma unroll
    for (int ks = 0; ks < 4; ++ks)
#pragma unroll
        for (int mt = 0; mt < 4; ++mt) u[mt] = MFMA16(f1[4 * mt + ks], Sb[ks], u[mt]);
    __builtin_amdgcn_sched_barrier(0);
#pragma unroll
    for (int k2 = 0; k2 < 2; ++k2) ub[k2] = pack8(u[2 * k2], u[2 * k2 + 1]);
#pragma unroll
    for (int m8 = 0; m8 < 8; ++m8)
#pragma unroll
        for (int k2 = 0; k2 < 2; ++k2) f1[2 * m8 + k2] = *(const bf16x8*)(ak + m8 * 2304 + k2 * 64);
    DNP_SYNC();
#pragma unroll
    for (int mt = 0; mt < 4; ++mt) o[mt] = (f32x4){0.f, 0.f, 0.f, 0.f};
#pragma unroll
    for (int ks = 0; ks < 4; ++ks)
#pragma unroll
        for (int mt = 0; mt < 4; ++mt) o[mt] = MFMA16(f2[4 * mt + ks], Sb[ks], o[mt]);
    __builtin_amdgcn_sched_barrier(0);
#pragma unroll
    for (int mt = 0; mt < 4; ++mt)
#pragma unroll
        for (int k2 = 0; k2 < 2; ++k2) f2[2 * mt + k2] = *(const bf16x8*)(ac + mt * 2304 + k2 * 64);
    DNP_SYNC();
#pragma unroll
    for (int m8 = 0; m8 < 8; ++m8) S[m8] = S[m8] * eg;
#pragma unroll
    for (int k2 = 0; k2 < 2; ++k2)
#pragma unroll
        for (int m8 = 0; m8 < 8; ++m8) S[m8] = MFMA16(f1[2 * m8 + k2], ub[k2], S[m8]);
    __builtin_amdgcn_sched_barrier(0);
#pragma unroll
    for (int k2 = 0; k2 < 2; ++k2)
#pragma unroll
        for (int mt = 0; mt < 4; ++mt) o[mt] = MFMA16(f2[2 * mt + k2], ub[k2], o[mt]);
}
DI void dn_step_o(const unsigned char* buf, f32x4 (&S)[8], const unsigned char* u0, float eg, int fr, int fq, f32x4 (&o)[4]) {
    const unsigned char* aw = buf + DB_WN + fr * 272 + fq * 16;
    const unsigned char* aq = buf + DB_QG + fr * 272 + fq * 16;
    const unsigned char* ak = buf + DB_KDT + fr * 144 + fq * 16;
    const unsigned char* ac = buf + DB_QK + fr * 144 + fq * 16;
    bf16x8 f1[16], f2[16], Sb[4], ub[2];
    f32x4 u[4];
#pragma unroll
    for (int ks = 0; ks < 4; ++ks) Sb[ks] = pack8(S[2 * ks], S[2 * ks + 1]);
    __builtin_amdgcn_sched_barrier(0);
#pragma unroll
    for (int mt = 0; mt < 4; ++mt)
#pragma unroll
        for (int ks = 0; ks < 4; ++ks) f1[4 * mt + ks] = *(const bf16x8*)(aw + mt * 4352 + ks * 64);
#pragma unroll
    for (int mt = 0; mt < 4; ++mt)
#pragma unroll
        for (int i = 0; i < 4; ++i) u[mt][i] = b2f(*(const bf16*)(u0 + (16 * mt + 4 * fq + i) * 80));
#pragma unroll
    for (int mt = 0; mt < 4; ++mt)
#pragma unroll
        for (int ks = 0; ks < 4; ++ks) f2[4 * mt + ks] = *(const bf16x8*)(aq + mt * 4352 + ks * 64);
    __builtin_amdgcn_sched_barrier(0);
#pragma unroll
    for (int ks = 0; ks < 4; ++ks)
#pragma unroll
        for (int mt = 0; mt < 4; ++mt) u[mt] = MFMA16(f1[4 * mt + ks], Sb[ks], u[mt]);
    __builtin_amdgcn_sched_barrier(0);
#pragma unroll
    for (int k2 = 0; k2 < 2; ++k2) ub[k2] = pack8(u[2 * k2], u[2 * k2 + 1]);
    __builtin_amdgcn_sched_barrier(0);
#pragma unroll
    for (int m8 = 0; m8 < 8; ++m8)
#pragma unroll
        for (int k2 = 0; k2 < 2; ++k2) f1[2 * m8 + k2] = *(const bf16x8*)(ak + m8 * 2304 + k2 * 64);
#pragma unroll
    for (int mt = 0; mt < 4; ++mt) o[mt] = (f32x4){0.f, 0.f, 0.f, 0.f};
#pragma unroll
    for (int ks = 0; ks < 4; ++ks)
#pragma unroll
        for (int mt = 0; mt < 4; ++mt) o[mt] = MFMA16(f2[4 * mt + ks], Sb[ks], o[mt]);
    __builtin_amdgcn_sched_barrier(0);
    { float dmy = (o[0][0] + o[1][0]) + (o[2][0] + o[3][0]); asm volatile("" :: "v"(dmy)); }
    __builtin_amdgcn_sched_barrier(0);
#pragma unroll
    for (int mt = 0; mt < 4; ++mt)
#pragma unroll
        for (int k2 = 0; k2 < 2; ++k2) f2[2 * mt + k2] = *(const bf16x8*)(ac + mt * 2304 + k2 * 64);
#pragma unroll
    for (int m8 = 0; m8 < 8; ++m8) S[m8] = S[m8] * eg;
#pragma unroll
    for (int k2 = 0; k2 < 2; ++k2)
#pragma unroll
        for (int m8 = 0; m8 < 8; ++m8) S[m8] = MFMA16(f1[2 * m8 + k2], ub[k2], S[m8]);
    __builtin_amdgcn_sched_barrier(0);
#pragma unroll
    for (int k2 = 0; k2 < 2; ++k2)
#pragma unroll
        for (int mt = 0; mt < 4; ++mt) o[mt] = MFMA16(f2[2 * mt + k2], ub[k2], o[mt]);
}
DI void dn_piece(int q, int c0, unsigned& src, unsigned& dst) {
    if (q < 1024) { src = R_WN + q * 16; dst = DB_WN + (q >> 4) * 272 + (q & 15) * 16; }
    else if (q < 2048) { const int p = q - 1024; src = R_QG + p * 16; dst = DB_QG + (p >> 4) * 272 + (p & 15) * 16; }
    else if (q < 3072) { const int p = q - 2048; src = R_KDT + p * 16; dst = DB_KDT + (p >> 3) * 144 + (p & 7) * 16; }
    else if (q < 3584) { const int p = q - 3072; src = R_QK + p * 16; dst = DB_QK + (p >> 3) * 144 + (p & 7) * 16; }
    else { const int p = q - 3584; src = R_U0 + (p >> 2) * 256 + c0 * 2 + (p & 3) * 16; dst = DB_U0 + (p >> 2) * 80 + (p & 3) * 16; }
}
#define DN_LD(R, base) do { _Pragma("unroll") for (int k = 0; k < 10; ++k) { unsigned s_, d_; dn_piece(lt + 384 * k, c0, s_, d_); R[k] = *(const u32x4*)((base) + s_); } } while (0)
#define DN_WAIT(R, cnt) do { } while (0)
#define DN_ST(R, buf) do { _Pragma("unroll") for (int k = 0; k < 10; ++k) { unsigned s_, d_; dn_piece(lt + 384 * k, c0, s_, d_); *(u32x4*)((buf) + d_) = R[k]; } } while (0)
#define DN_BAR() do { asm volatile("s_waitcnt lgkmcnt(0)" ::: "memory"); __builtin_amdgcn_s_barrier(); asm volatile("" ::: "memory"); } while (0)
DI void dn_scan_prompt(const Args& a, unsigned char* lds, int tid) {
    asm volatile("" : "+v"(tid));
    const int wave = __builtin_amdgcn_readfirstlane(tid >> 6), lane = tid & 63, fr = lane & 15, fq = lane >> 4;
    const int bh = blockIdx.x >> 2, qt = blockIdx.x & 3, b = bh >> 2, h = bh & 3;
    const int c0 = qt * 32, v0 = c0 + (wave & 1) * 16;
    const unsigned char* recs = a.ws + WS_DNC + (size_t)bh * 128 * REC;
    const float* egs = (const float*)(a.ws + WS_EG) + bh * 128;
    float* ORAW = (float*)(a.ws + WS_H);
    const bool loader = wave >= 2;
    const int lt = tid - 128;
    f32x4 S[8];
#pragma unroll
    for (int m8 = 0; m8 < 8; ++m8) S[m8] = (f32x4){0.f, 0.f, 0.f, 0.f};
    float egA = egs[lane], egB = egs[64 + lane];
    asm volatile("s_waitcnt vmcnt(0)" : "+v"(egA), "+v"(egB) :: "memory");
    if (loader) {
        const int grp = wave >= 5 ? 1 : 0, lt2 = tid - 128 - grp * 192;
        u32x4 R[20];
        unsigned srcs[20], dsts[20];
        _Pragma("unroll") for (int k = 0; k < 20; ++k) dn_piece(lt2 + 192 * k, c0, srcs[k], dsts[k]);
#define DN_LD20(base) do { _Pragma("unroll") for (int k = 0; k < 20; ++k) R[k] = *(const u32x4*)((base) + srcs[k]); } while (0)
#define DN_ST20(buf) do { _Pragma("unroll") for (int k = 0; k < 20; ++k) *(u32x4*)((buf) + dsts[k]) = R[k]; } while (0)
        if (grp == 0) { DN_LD20(recs); DN_ST20(lds); DN_LD20(recs + 2 * (size_t)REC); }
        else { DN_LD20(recs + REC); }
        DN_BAR();
        for (int n = 0; n < 128; n += 2) {
            if (grp == 1) { DN_ST20(lds + DBP_SIZE); if (n + 3 < 128) DN_LD20(recs + (size_t)(n + 3) * REC); }
            DN_BAR();
            if (grp == 0 && n + 2 < 128) { DN_ST20(lds); if (n + 4 < 128) DN_LD20(recs + (size_t)(n + 4) * REC); }
            DN_BAR();
        }
#undef DN_LD20
#undef DN_ST20
    } else {
        DN_BAR();
        for (int n = 0; n < 128; ++n) {
            const float eg0 = __int_as_float(__builtin_amdgcn_readlane(__float_as_int(n < 64 ? egA : egB), n & 63));
            f32x4 o[4];
#if DN_STAGED == 3
            dn_step_o(lds + (n & 1) * DBP_SIZE, S, lds + (n & 1) * DBP_SIZE + DB_U0 + ((wave & 1) * 16 + fr) * 2, eg0, fr, fq, o);
#elif DN_STAGED
            dn_step_p(lds + (n & 1) * DBP_SIZE, S, lds + (n & 1) * DBP_SIZE + DB_U0 + ((wave & 1) * 16 + fr) * 2, eg0, fr, fq, o);
#else
            dn_step<80>(lds + (n & 1) * DBP_SIZE, S, lds + (n & 1) * DBP_SIZE + DB_U0 + ((wave & 1) * 16 + fr) * 2, eg0, fr, fq, o);
#endif
            float* op = ORAW + (size_t)(b * 8192 + n * 64) * 512 + h * 128 + v0 + fr;
#pragma unroll
            for (int mt = 0; mt < 4; ++mt)
#pragma unroll
                for (int i = 0; i < 4; ++i) op[(size_t)(16 * mt + 4 * fq + i) * 512] = o[mt][i];
            DN_BAR();
        }
    }
    if (!loader) {
        float* so = a.out + O_PDS + (size_t)bh * 128 * 128 + v0 + fr;
#pragma unroll
        for (int m8 = 0; m8 < 8; ++m8)
#pragma unroll
            for (int i = 0; i < 4; ++i) so[(16 * m8 + 4 * fq + i) * 128] = S[m8][i];
    }
    __syncthreads();
}
DI void dn_scan_sample(const Args& a, unsigned char* lds, int tid, int su0, int su1, int sus) {
    asm volatile("" : "+v"(tid));
    const int wave = __builtin_amdgcn_readfirstlane(tid >> 6), lane = tid & 63, fr = lane & 15, fq = lane >> 4;
    const int v0 = wave * 16;
    float* ORAW = (float*)(a.ws + WS_H);
    for (int su = su0; su < su1; su += sus) {
        const int sb = su >> 2, h = su & 3;
        const unsigned char* rec = a.ws + WS_DNC + (size_t)(2048 + su) * REC;
        DnRegs<128> R; dn_load<128>(rec, tid, 0, R); dn_store<128>(lds, tid, R);
        __syncthreads();
        f32x4 S[8];
        const float* s0 = a.in[3] + (size_t)su * 128 * 128 + v0 + fr;
#pragma unroll
        for (int m8 = 0; m8 < 8; ++m8)
#pragma unroll
            for (int i = 0; i < 4; ++i) S[m8][i] = s0[(16 * m8 + 4 * fq + i) * 128];
        f32x4 o[4];
        dn_step<272>(lds, S, lds + DB_U0 + (v0 + fr) * 2, ((const float*)(a.ws + WS_EG))[2048 + su], fr, fq, o);
        float* op = ORAW + (size_t)(TP + sb * 16) * 512 + h * 128 + v0 + fr;
#pragma unroll
        for (int i = 0; i < 4; ++i) op[(size_t)(4 * fq + i) * 512] = o[0][i];
        float* so = a.out + O_SDS + (size_t)su * 128 * 128 + v0 + fr;
#pragma unroll
        for (int m8 = 0; m8 < 8; ++m8)
#pragma unroll
            for (int i = 0; i < 4; ++i) so[(16 * m8 + 4 * fq + i) * 128] = S[m8][i];
        __syncthreads();
    }
}

DI void mix_phase(const Args& a, int gw, int NGW, int lane) {
    asm volatile("" : "+v"(lane));
    const float* ORAW = (const float*)(a.ws + WS_H);
    const bf16* P = (const bf16*)(a.ws + WS_P);
    const bf16* GLU = (const bf16*)(a.ws + WS_GLU);
    bf16* MIX = (bf16*)(a.ws + WS_DNC);
    const f32x2 dg = *(const f32x2*)(a.in[12] + 2 * lane);
    const f32x4 sg0 = *(const f32x4*)(a.in[23] + 8 * lane), sg1 = *(const f32x4*)(a.in[23] + 8 * lane + 4);
    constexpr int NR = 4;
    for (int row0 = gw; row0 < T; row0 += NR * NGW) {
        f32x2 ov[NR][4]; unsigned zz[NR][4]; u32x4 gv[NR]; float ssq[NR][5];
#pragma unroll
        for (int r = 0; r < NR; ++r) { const size_t row = row0 + r * NGW < T ? row0 + r * NGW : row0;
#pragma unroll
            for (int h = 0; h < 4; ++h) { ov[r][h] = *(const f32x2*)(ORAW + row * 512 + h * 128 + 2 * lane); zz[r][h] = *(const unsigned*)(P + row * PW + 1536 + h * 128 + 2 * lane); }
            gv[r] = *(const u32x4*)(GLU + row * 512 + 8 * lane); }
#pragma unroll
        for (int r = 0; r < NR; ++r) {
#pragma unroll
            for (int h = 0; h < 4; ++h) ssq[r][h] = ov[r][h].x * ov[r][h].x + ov[r][h].y * ov[r][h].y;
            const float v[8] = {blo(gv[r].x), bhi(gv[r].x), blo(gv[r].y), bhi(gv[r].y), blo(gv[r].z), bhi(gv[r].z), blo(gv[r].w), bhi(gv[r].w)};
            float ss = 0.f;
#pragma unroll
            for (int e = 0; e < 8; ++e) ss += v[e] * v[e];
            ssq[r][4] = ss; }
#pragma unroll
        for (int o = 1; o < 64; o <<= 1)
#pragma unroll
            for (int r = 0; r < NR; ++r)
#pragma unroll
                for (int k = 0; k < 5; ++k) ssq[r][k] += __shfl_xor(ssq[r][k], o);
#pragma unroll
        for (int r = 0; r < NR; ++r) if (r == 0 || row0 + r * NGW < T) { const size_t row = row0 + r * NGW;
#pragma unroll
            for (int h = 0; h < 4; ++h) { const float rr = rsqrtf(ssq[r][h] * (1.f / 128.f) + EPS);
                *(unsigned*)(MIX + row * DM + h * 128 + 2 * lane) = pk2(ov[r][h].x * rr * dg.x * silu(blo(zz[r][h])), ov[r][h].y * rr * dg.y * silu(bhi(zz[r][h]))); }
            const float v[8] = {blo(gv[r].x), bhi(gv[r].x), blo(gv[r].y), bhi(gv[r].y), blo(gv[r].z), bhi(gv[r].z), blo(gv[r].w), bhi(gv[r].w)};
            const float r5 = rsqrtf(ssq[r][4] * (1.f / 512.f) + EPS);
            u32x4 w; w.x = pk2(v[0] * r5 * sg0[0], v[1] * r5 * sg0[1]); w.y = pk2(v[2] * r5 * sg0[2], v[3] * r5 * sg0[3]);
            w.z = pk2(v[4] * r5 * sg1[0], v[5] * r5 * sg1[1]); w.w = pk2(v[6] * r5 * sg1[2], v[7] * r5 * sg1[3]);
            *(u32x4*)(MIX + row * DM + 512 + 8 * lane) = w; }
    }
}

DI void act_phase(const Args& a, int gtid, int NT) {
    asm volatile("" : "+v"(gtid));
    bf16* UP = (bf16*)(a.ws + WS_UP);
    const float* fw = a.in[27]; const float* fb = a.in[28];
    constexpr int NCG = DFF / 8;
    for (int item = gtid; item < (T / 16) * NCG; item += NT) {
        const int cg8 = item % NCG, rb = item / NCG, col = cg8 * 8, row0 = rb * 16;
        float w0[8], w1[8], w2[8], bb[8], g2[8], g1[8];
#pragma unroll
        for (int e = 0; e < 8; ++e) { w0[e] = fw[col + e]; w1[e] = fw[DFF + col + e]; w2[e] = fw[2 * DFF + col + e]; bb[e] = fb[col + e]; g2[e] = 0.f; g1[e] = 0.f; }
        const bool sample = row0 >= TP;
        float* outp = nullptr;
        if (sample) { const int sb = (row0 - TP) >> 4; const float* cc = a.in[6] + (size_t)sb * 2 * DFF + col;
#pragma unroll
            for (int e = 0; e < 8; ++e) { g2[e] = cc[e]; g1[e] = cc[DFF + e]; }
            outp = a.out + O_SFC + (size_t)sb * 2 * DFF + col;
        } else {
            if ((rb & 511) != 0) {
                const u32x4 x2 = *(const u32x4*)(UP + (size_t)(row0 - 2) * UPW + col), x1 = *(const u32x4*)(UP + (size_t)(row0 - 1) * UPW + col);
                g2[0] = blo(x2.x); g2[1] = bhi(x2.x); g2[2] = blo(x2.y); g2[3] = bhi(x2.y); g2[4] = blo(x2.z); g2[5] = bhi(x2.z); g2[6] = blo(x2.w); g2[7] = bhi(x2.w);
                g1[0] = blo(x1.x); g1[1] = bhi(x1.x); g1[2] = blo(x1.y); g1[3] = bhi(x1.y); g1[4] = blo(x1.z); g1[5] = bhi(x1.z); g1[6] = blo(x1.w); g1[7] = bhi(x1.w);
            }
            if ((rb & 511) == 511) outp = a.out + O_PFC + (size_t)(rb >> 9) * 2 * DFF + col;
        }
#pragma unroll 4
        for (int r = 0; r < 16; ++r) {
            bf16* gp = UP + (size_t)(row0 + r) * UPW + col;
            const u32x4 xg = *(const u32x4*)gp, xv = *(const u32x4*)(gp + DFF);
            float g0[8] = {blo(xg.x), bhi(xg.x), blo(xg.y), bhi(xg.y), blo(xg.z), bhi(xg.z), blo(xg.w), bhi(xg.w)};
            float vv[8] = {blo(xv.x), bhi(xv.x), blo(xv.y), bhi(xv.y), blo(xv.z), bhi(xv.z), blo(xv.w), bhi(xv.w)};
            float o[8];
#pragma unroll
            for (int e = 0; e < 8; ++e) { o[e] = silu(g2[e] * w0[e] + g1[e] * w1[e] + g0[e] * w2[e] + bb[e]) * vv[e]; g2[e] = g1[e]; g1[e] = g0[e]; }
            u32x4 w; w.x = pk2(o[0], o[1]); w.y = pk2(o[2], o[3]); w.z = pk2(o[4], o[5]); w.w = pk2(o[6], o[7]);
            *(u32x4*)(gp + DFF) = w;
            if (outp && r >= 14) {
#pragma unroll
                for (int e = 0; e < 8; ++e) outp[(r - 14) * DFF + e] = g0[e];
            }
        }
    }
}

DI void act_fix_phase(const Args& a, int gtid, int NT) {
    asm volatile("" : "+v"(gtid));
    bf16* ACT = (bf16*)(a.ws + WS_UP);
    const bf16* GH = (const bf16*)(a.ws + WS_GH); const bf16* GT = (const bf16*)(a.ws + WS_GT); const bf16* VH = (const bf16*)(a.ws + WS_VH);
    const float* fw = a.in[27]; const float* fb = a.in[28];
    constexpr int NCG = DFF / 8;
    for (int item = gtid; item < (T / 16) * NCG; item += NT) {
        const int cg8 = item % NCG, grp = item / NCG, col = cg8 * 8;
        float w0[8], w1[8], w2[8], bb[8], g2[8], g1[8], h0[8], h1[8], v0[8], v1[8];
#pragma unroll
        for (int e = 0; e < 8; ++e) { w0[e] = fw[col + e]; w1[e] = fw[DFF + col + e]; w2[e] = fw[2 * DFF + col + e]; bb[e] = fb[col + e]; g2[e] = 0.f; g1[e] = 0.f; }
        const bool sample = grp >= TP / 16;
        if (sample) { const float* cc = a.in[6] + (size_t)(grp - TP / 16) * 2 * DFF + col;
#pragma unroll
            for (int e = 0; e < 8; ++e) { g2[e] = cc[e]; g1[e] = cc[DFF + e]; }
        } else if ((grp & 511) != 0) {
            const u32x4 x2 = *(const u32x4*)(GT + ((size_t)(grp - 1) * 2) * DFF + col), x1 = *(const u32x4*)(GT + ((size_t)(grp - 1) * 2 + 1) * DFF + col);
            g2[0] = blo(x2.x); g2[1] = bhi(x2.x); g2[2] = blo(x2.y); g2[3] = bhi(x2.y); g2[4] = blo(x2.z); g2[5] = bhi(x2.z); g2[6] = blo(x2.w); g2[7] = bhi(x2.w);
            g1[0] = blo(x1.x); g1[1] = bhi(x1.x); g1[2] = blo(x1.y); g1[3] = bhi(x1.y); g1[4] = blo(x1.z); g1[5] = bhi(x1.z); g1[6] = blo(x1.w); g1[7] = bhi(x1.w);
        }
        {
            const u32x4 xa = *(const u32x4*)(GH + ((size_t)grp * 2) * DFF + col), xb = *(const u32x4*)(GH + ((size_t)grp * 2 + 1) * DFF + col);
            const u32x4 ya = *(const u32x4*)(VH + ((size_t)grp * 2) * DFF + col), yb = *(const u32x4*)(VH + ((size_t)grp * 2 + 1) * DFF + col);
            h0[0] = blo(xa.x); h0[1] = bhi(xa.x); h0[2] = blo(xa.y); h0[3] = bhi(xa.y); h0[4] = blo(xa.z); h0[5] = bhi(xa.z); h0[6] = blo(xa.w); h0[7] = bhi(xa.w);
            h1[0] = blo(xb.x); h1[1] = bhi(xb.x); h1[2] = blo(xb.y); h1[3] = bhi(xb.y); h1[4] = blo(xb.z); h1[5] = bhi(xb.z); h1[6] = blo(xb.w); h1[7] = bhi(xb.w);
            v0[0] = blo(ya.x); v0[1] = bhi(ya.x); v0[2] = blo(ya.y); v0[3] = bhi(ya.y); v0[4] = blo(ya.z); v0[5] = bhi(ya.z); v0[6] = blo(ya.w); v0[7] = bhi(ya.w);
            v1[0] = blo(yb.x); v1[1] = bhi(yb.x); v1[2] = blo(yb.y); v1[3] = bhi(yb.y); v1[4] = blo(yb.z); v1[5] = bhi(yb.z); v1[6] = blo(yb.w); v1[7] = bhi(yb.w);
        }
        float o0[8], o1[8];
#pragma unroll
        for (int e = 0; e < 8; ++e) { o0[e] = silu(g2[e] * w0[e] + g1[e] * w1[e] + h0[e] * w2[e] + bb[e]) * v0[e]; o1[e] = silu(g1[e] * w0[e] + h0[e] * w1[e] + h1[e] * w2[e] + bb[e]) * v1[e]; }
        u32x4 wa, wb; wa.x = pk2(o0[0], o0[1]); wa.y = pk2(o0[2], o0[3]); wa.z = pk2(o0[4], o0[5]); wa.w = pk2(o0[6], o0[7]);
        wb.x = pk2(o1[0], o1[1]); wb.y = pk2(o1[2], o1[3]); wb.z = pk2(o1[4], o1[5]); wb.w = pk2(o1[6], o1[7]);
        *(u32x4*)(ACT + ((size_t)grp * 16) * DFF + col) = wa; *(u32x4*)(ACT + ((size_t)grp * 16 + 1) * DFF + col) = wb;
        float* outp = nullptr;
        if (sample) outp = a.out + O_SFC + (size_t)(grp - TP / 16) * 2 * DFF + col;
        else if ((grp & 511) == 511) outp = a.out + O_PFC + (size_t)(grp >> 9) * 2 * DFF + col;
        if (outp) {
            const u32x4 t0 = *(const u32x4*)(GT + ((size_t)grp * 2) * DFF + col), t1 = *(const u32x4*)(GT + ((size_t)grp * 2 + 1) * DFF + col);
            outp[0] = blo(t0.x); outp[1] = bhi(t0.x); outp[2] = blo(t0.y); outp[3] = bhi(t0.y); outp[4] = blo(t0.z); outp[5] = bhi(t0.z); outp[6] = blo(t0.w); outp[7] = bhi(t0.w);
            outp[DFF + 0] = blo(t1.x); outp[DFF + 1] = bhi(t1.x); outp[DFF + 2] = blo(t1.y); outp[DFF + 3] = bhi(t1.y); outp[DFF + 4] = blo(t1.z); outp[DFF + 5] = bhi(t1.z); outp[DFF + 6] = blo(t1.w); outp[DFF + 7] = bhi(t1.w);
        }
    }
}

DI void final_phase(const Args& a, int gw, int NGW, int lane) {
    asm volatile("" : "+v"(lane));
    f32x4 gv[4];
#pragma unroll
    for (int j = 0; j < 4; ++j) gv[j] = ((const f32x4*)a.in[30])[lane + 64 * j];
    for (int m0 = gw; m0 < T; m0 += 2 * NGW) {
        const int m1 = m0 + NGW < T ? m0 + NGW : m0;
        f32x4* xr0 = (f32x4*)(a.out + (size_t)m0 * DM) + lane; f32x4* xr1 = (f32x4*)(a.out + (size_t)m1 * DM) + lane;
        f32x4 v0[4], v1[4]; float s0 = 0.f, s1 = 0.f;
#pragma unroll
        for (int j = 0; j < 4; ++j) { v0[j] = xr0[64 * j]; v1[j] = xr1[64 * j]; }
#pragma unroll
        for (int j = 0; j < 4; ++j) { s0 += (v0[j].x * v0[j].x + v0[j].y * v0[j].y) + (v0[j].z * v0[j].z + v0[j].w * v0[j].w); s1 += (v1[j].x * v1[j].x + v1[j].y * v1[j].y) + (v1[j].z * v1[j].z + v1[j].w * v1[j].w); }
        const float r0 = rsqrtf(wave_sum(s0) * (1.f / DM) + EPS), r1 = rsqrtf(wave_sum(s1) * (1.f / DM) + EPS);
#pragma unroll
        for (int j = 0; j < 4; ++j) xr0[64 * j] = v0[j] * r0 * gv[j];
        if (m1 != m0) {
#pragma unroll
            for (int j = 0; j < 4; ++j) xr1[64 * j] = v1[j] * r1 * gv[j];
        }
    }
}

#ifndef PH_MASK
#define PH_MASK 0xffff
#endif
#ifndef SOLVE_RL
#define SOLVE_RL 1
#endif
#ifndef REP0
#define REP0 1
#endif
#ifndef REP1
#define REP1 1
#endif
#ifndef REP2A
#define REP2A 1
#endif
#ifndef REP2B
#define REP2B 1
#endif
#ifndef REP3A
#define REP3A 1
#endif
#ifndef REP3B
#define REP3B 1
#endif
#ifndef REP3C
#define REP3C 1
#endif
#ifndef PH_LO
#define PH_LO 0
#endif
#ifndef PH_HI
#define PH_HI 99
#endif
__global__ void __launch_bounds__(512, 2) fwd_kernel(Args a) {
    extern __shared__ __attribute__((aligned(16))) unsigned char lds[];
    cg::grid_group grid = cg::this_grid();
    const int tid = threadIdx.x, lane = tid & 63, wave = __builtin_amdgcn_readfirstlane(tid >> 6);
    const int G = gridDim.x, gw = blockIdx.x * 8 + wave, NGW = G * 8;
    unsigned char* ws = a.ws;
    PG8_LAS unsigned char* ldsg = (PG8_LAS unsigned char*)lds;
    volatile LAS unsigned* xbst = (volatile LAS unsigned*)(ldsg + (LDS_BYTES - 64));
    if (tid < 2) xbst[tid] = 0u;
    __syncthreads();
    const XcdBarrier xbar = xcd_barrier_post((unsigned*)(ws + WS_CTL), xbst);

    _Pragma("nounroll") for (int rep = 0; rep < REP0; ++rep) { phase0(a, lds, gw, NGW, wave, lane); __syncthreads(); }
    xcd_barrier(xbar);
    if (a.out == nullptr) grid.sync();
    _Pragma("nounroll") for (int rep = 0; rep < REP1; ++rep)
    { pg8::Gemm g{(const bf16*)(ws + WS_H), (const bf16*)(ws + WS_WIN), T, NIN, DM, DM}; pg8::StaticOrder S; S.init(T, NIN, G, (int)blockIdx.x);
      EpiP E{(bf16*)(ws + WS_P), (float*)(ws + WS_BA)};
      pg8::gemm_phase<EpiP, pg8::StaticOrder, true, true>(ldsg, g, S, E); }
    xcd_barrier(xbar);
    _Pragma("nounroll") for (int rep = 0; rep < REP2A; ++rep) dn_chunk_phase(a, lds, tid, (int)blockIdx.x, 1024, G);
#if OLD_S5 && OLD_S5 != 4 && OLD_S5 != 5
    old_s5_pass1(a, gw, NGW, lane);
#elif 0
#else
    _Pragma("nounroll") for (int rep = 0; rep < REP2B; ++rep) s5_pass1(a, gw, NGW, lane);
#endif
    xcd_barrier(xbar);
#if OLD_S5 == 3
    if (blockIdx.x < 64) dn_scan_prompt(a, lds, tid);
    else { if (blockIdx.x >= 192) { dn_scan_sample(a, lds, tid, (int)blockIdx.x - 192, 128, 64); s5_pass2_sample(a, lds + 81920 + wave * 4352, ((int)blockIdx.x - 192) * 8 + wave, 512, lane); __syncthreads(); }
           old_s5_pass2(a, lds + 81920 + wave * 4352, gw - 512, NGW - 512, lane); }
#elif OLD_S5 == 5
    if (blockIdx.x < 64) { _Pragma("nounroll") for (int rep = 0; rep < REP3A; ++rep) dn_scan_prompt(a, lds, tid); }
    else {
        if (blockIdx.x >= 192) {
            const int w = (int)blockIdx.x - 192;
            dn_chunk_phase(a, lds, tid, 1024 + w, 1025 + w, 1);
            __threadfence_block(); __syncthreads();
            dn_scan_sample(a, lds, tid, 2 * w, 2 * w + 2, 1);
        }
        _Pragma("nounroll") for (int rep = 0; rep < REP3B; ++rep) s5_pass2b(a, lds + wave * 14592, gw - 512, NGW - 512, lane);
    }
#elif OLD_S5 == 1 || OLD_S5 == 4
    if (blockIdx.x < 64) dn_scan_prompt(a, lds, tid);
    else { if (blockIdx.x >= 192) dn_scan_sample(a, lds, tid, (int)blockIdx.x - 192, 128, 64); old_s5_pass2(a, lds + 81920 + wave * 4352, gw - 512, NGW - 512, lane); }
#else
    if (blockIdx.x < 64) { _Pragma("nounroll") for (int rep = 0; rep < REP3A; ++rep) dn_scan_prompt(a, lds, tid); }
    else if (blockIdx.x < 192) { _Pragma("nounroll") for (int rep = 0; rep < REP3B; ++rep) s5_pass2_prompt(a, lds, (int)blockIdx.x - 64, tid); }
    else { _Pragma("nounroll") for (int rep = 0; rep < REP3C; ++rep) { dn_scan_sample(a, lds, tid, (int)blockIdx.x - 192, 128, 64); s5_pass2_sample(a, lds + 81920 + wave * 4352, ((int)blockIdx.x - 192) * 8 + wave, 512, lane); } }
#endif
    xcd_barrier(xbar);
#if PH_MASK & 512
    { pg8::Gemm g{(const bf16*)(ws + WS_Y5), (const bf16*)(ws + WS_WGLU), T, 1024, 512, 512}; pg8::StaticOrder S; S.init(T, 1024, G, (int)blockIdx.x);
      EpiGlu E{(bf16*)(ws + WS_GLU), a.in[22]};
      pg8::gemm_phase<EpiGlu, pg8::StaticOrder, true, true>(ldsg, g, S, E); }
#endif
    xcd_barrier(xbar);
#if PH_MASK & 32
    mix_phase(a, gw, NGW, lane);
#endif
    xcd_barrier(xbar);
#if PH_MASK & 1024
    { pg8::Gemm g{(const bf16*)(ws + WS_DNC), (const bf16*)(ws + WS_WOUT), T, DM, DM, DM}; pg8::StaticOrder S; S.init(T, DM, G, (int)blockIdx.x);
      EpiX1 E{a.in[0], a.in[1], a.out, (bf16*)(ws + WS_H), (float*)(ws + WS_SS2)};
      pg8::gemm_phase<EpiX1, pg8::StaticOrder, true, true>(ldsg, g, S, E); }
#endif
    xcd_barrier(xbar);
#if FUSE_ACT
    { pg8::Gemm g{(const bf16*)(ws + WS_H), (const bf16*)(ws + WS_WUP), T, UPW, DM, DM}; pg8::StaticOrder S; S.init(T, UPW, G, (int)blockIdx.x);
      EpiUpAct E{(bf16*)(ws + WS_UP), (bf16*)(ws + WS_GH), (bf16*)(ws + WS_GT), (bf16*)(ws + WS_VH), (const float*)(ws + WS_SS2), a.in[27], a.in[28]};
      pg8::gemm_phase<EpiUpAct, pg8::StaticOrder, true, true>(ldsg, g, S, E); }
    xcd_barrier(xbar);
    act_fix_phase(a, (int)blockIdx.x * 512 + tid, G * 512);
    xcd_barrier(xbar);
    { pg8::Gemm g{(const bf16*)(ws + WS_UP), (const bf16*)(ws + WS_WDOWN), T, DM, DFF, DFF}; pg8::StaticOrder S; S.init(T, DM, G, (int)blockIdx.x);
      EpiX2 E{a.out, (const bf16*)(ws + WS_H)};
      pg8::gemm_phase<EpiX2, pg8::StaticOrder, true, true>(ldsg, g, S, E); }
    xcd_barrier(xbar);
#else
#if PH_MASK & 2048
    { pg8::Gemm g{(const bf16*)(ws + WS_H), (const bf16*)(ws + WS_WUP), T, UPW, DM, DM}; pg8::StaticOrder S; S.init(T, UPW, G, (int)blockIdx.x);
      EpiUp E{(bf16*)(ws + WS_UP), (const float*)(ws + WS_SS2)};
      pg8::gemm_phase<EpiUp, pg8::StaticOrder, true, true>(ldsg, g, S, E); }
#endif
    xcd_barrier(xbar);
#if PH_MASK & 64
    act_phase(a, (int)blockIdx.x * 512 + tid, G * 512);
#endif
    xcd_barrier(xbar);
#if PH_MASK & 4096
    { pg8::Gemm g{(const bf16*)(ws + WS_UP) + DFF, (const bf16*)(ws + WS_WDOWN), T, DM, DFF, UPW}; pg8::StaticOrder S; S.init(T, DM, G, (int)blockIdx.x);
      EpiX2 E{a.out, (const bf16*)(ws + WS_H)};
      pg8::gemm_phase<EpiX2, pg8::StaticOrder, true, true>(ldsg, g, S, E); }
#endif
    xcd_barrier(xbar);
#endif
#if PH_MASK & 128
    final_phase(a, gw, NGW, lane);
#endif
}

extern "C" void kernel_launch(void* const* d_in, const int* in_sizes, int n_in, void* d_out, int out_size, void* d_ws, size_t ws_size, hipStream_t stream) {
    static int grid = 0;
    if (grid == 0) {
        if (n_in != 31 || (size_t)out_size != O_END || ws_size < WS_END) { fprintf(stderr, "kernel_launch: unexpected shapes n_in %d out %d ws %zu\n", n_in, out_size, ws_size); grid = -1; return; }
        int dev = 0, cus = 0, per_cu = 0;
        hipGetDevice(&dev);
        hipDeviceGetAttribute(&cus, hipDeviceAttributeMultiprocessorCount, dev);
        hipFuncSetAttribute((const void*)fwd_kernel, hipFuncAttributeMaxDynamicSharedMemorySize, LDS_BYTES);
        hipOccupancyMaxActiveBlocksPerMultiprocessor(&per_cu, (const void*)fwd_kernel, 512, LDS_BYTES);
        if (per_cu < 1) { fprintf(stderr, "kernel_launch: occupancy query says %d blocks per CU\n", per_cu); per_cu = 1; }
        grid = cus * 1;
        if (grid != 256) { fprintf(stderr, "kernel_launch: built for a 256-CU device, got %d\n", cus); grid = -1; return; }
        (void)hipGetLastError();
    }
    if (grid < 0) return;
    if (hipMemsetAsync((char*)d_ws + WS_CTL, 0, 16384, stream) != hipSuccess) { fprintf(stderr, "kernel_launch: memset of the barrier words failed\n"); return; }
    Args a{};
    for (int i = 0; i < 31; ++i) a.in[i] = (const float*)d_in[i];
    a.out = (float*)d_out; a.ws = (unsigned char*)d_ws;
    void* args[] = {&a};
    hipError_t e = hipLaunchCooperativeKernel((const void*)fwd_kernel, dim3(grid), dim3(512), args, LDS_BYTES, stream);
    if (e != hipSuccess) fprintf(stderr, "cooperative launch failed: %s (grid %d)\n", hipGetErrorString(e), grid);
}
```

```cpp
#include <hip/hip_runtime.h>
#include <hip/hip_cooperative_groups.h>
#include <cstdio>
#include <cstdint>
namespace cg = cooperative_groups;
#define OLD_S5 5
#define DN_STAGED 3
namespace pg8 {
#define PG8_LAS __attribute__((address_space(3)))
typedef unsigned short bf16_t;
typedef short bf16x8 __attribute__((ext_vector_type(8)));
typedef float f32x4 __attribute__((ext_vector_type(4)));
typedef unsigned u32x4 __attribute__((ext_vector_type(4)));
constexpr int BM = 256, BK = 64, HALF = 128, HTB = HALF * BK * 2  , STAGE_BYTES = 8 * HTB, NXCD = 8, WGM = 8;

__host__ __device__ __forceinline__ int lds_byte(int r, int c) { const int st = (r >> 4) * 2 + (c >> 5), rr = r & 15, cc = c & 31, ob = rr * 64 + cc * 2; return st * 1024 + (ob ^ (((ob >> 9) & 1) << 5)); }
__host__ __device__ __forceinline__ void stage_rc(int b, int& R, int& C) { const int st = b / 1024, sb = b % 1024, swz = sb ^ (((sb >> 9) & 1) << 5); R = (st >> 1) * 16 + swz / 64; C = (st & 1) * 32 + (swz % 64) / 2; }
__host__ __device__ __forceinline__ int perm32(int rho) { const int n = rho >> 4, i = rho & 15; return 8 * (i >> 2) + 4 * n + (i & 3); }

struct Unit { int pm, pn; };
struct Gemm { const bf16_t* A; const bf16_t* Bt; int M, N, K, lda; };

struct StaticOrder {
    int nM, nN, nwg, G, c;
    __host__ __device__ void init(int M, int N, int G_, int c_) { nM = M / BM; nN = N / BM; nwg = nM * nN; G = G_; c = c_; }
    __host__ __device__ bool next(int i, Unit& u) const {
        const long L = (long)i * G + c; if (L >= nwg) return false;
        int wgid = (int)L; { const int q = nwg / NXCD, r = nwg % NXCD, xcd = wgid % NXCD, off = wgid / NXCD; wgid = (xcd < r ? xcd * (q + 1) : r * (q + 1) + (xcd - r) * q) + off; }
        const int nig = WGM * nN, gid = wgid / nig, fm = gid * WGM, gsz = (nM - fm) < WGM ? (nM - fm) : WGM;
        u.pm = fm + ((wgid % nig) % gsz); u.pn = (wgid % nig) / gsz; return true;
    }
    __device__ __forceinline__ void a_ready(const Unit&) const {}
    __device__ __forceinline__ void done(const Unit&) const {}
};
__device__ __forceinline__ unsigned cvt_pk_bf16(float lo, float hi) { unsigned r; asm volatile("v_cvt_pk_bf16_f32 %0, %1, %2" : "=v"(r) : "v"(lo), "v"(hi)); return r; }
typedef float f32x2 __attribute__((ext_vector_type(2)));
template <class Epi, class Sched, bool ALIGN_EPI = false, bool SP2 = false>
__device__ __forceinline__ void gemm_phase(PG8_LAS unsigned char* lds, const Gemm g, const Sched& S, const Epi& E) {
    int tid_ = threadIdx.x; asm volatile("" : "+v"(tid_));
    const int tid = tid_, wid = __builtin_amdgcn_readfirstlane(tid >> 6), lane = tid & 63, wr = wid >> 2, wc = wid & 3, fr = lane & 15, fq = lane >> 4;
    const int K = g.K, nt = K / BK;
    unsigned voffA[2], voffB[2];
#pragma unroll
    for (int i = 0; i < 2; ++i) { int R, C; stage_rc(tid * 16 + i * 8192, R, C); const int Rb = Epi::PERM ? ((R & ~31) + perm32(R & 31)) : R;
        voffA[i] = (unsigned)(R * g.lda + C) * 2u; voffB[i] = (unsigned)(Rb * K + C) * 2u; }
    const size_t kstep = (size_t)(BK * 2);
    const size_t hstep = (size_t)HALF * K * 2;
    const size_t tstep = 2 * hstep; const size_t hstepA = (size_t)HALF * g.lda * 2, tstepA = 2 * hstepA;
    const unsigned ldsw = (unsigned)wid * 1024u;
    const int aoff = lds_byte(wr * 64 + fr, fq * 8), boff = lds_byte(wc * 32 + fr, fq * 8);
#define PG8_SA(b, h) (((b) * 2 + (h)) * HTB)
#define PG8_SB(b, h) ((4 + (b) * 2 + (h)) * HTB)
#define PG8_STAGE(bufoff, gbase, voff) do { _Pragma("unroll") for (int _i = 0; _i < 2; ++_i) \
        __builtin_amdgcn_global_load_lds((const unsigned*)((const char*)(gbase) + (voff)[_i]), (PG8_LAS unsigned*)(lds + (bufoff) + ldsw + _i * 8192), 16, 0, 0); } while (0)
#define PG8_LDA(dst, b, h) do { _Pragma("unroll") for (int m = 0; m < 4; ++m) _Pragma("unroll") for (int k = 0; k < 2; ++k) dst[m][k] = *(const PG8_LAS bf16x8*)(lds + PG8_SA(b, h) + aoff + m * 2048 + k * 1024); } while (0)
#define PG8_LDB(dst, b, h) do { _Pragma("unroll") for (int n = 0; n < 2; ++n) _Pragma("unroll") for (int k = 0; k < 2; ++k) dst[n][k] = *(const PG8_LAS bf16x8*)(lds + PG8_SB(b, h) + boff + n * 2048 + k * 1024); } while (0)
#define PG8_MMA(ai, bj, At, Bt) do { __builtin_amdgcn_s_setprio(1); _Pragma("unroll") for (int m = 0; m < 4; ++m) _Pragma("unroll") for (int n = 0; n < 2; ++n) _Pragma("unroll") for (int k = 0; k < 2; ++k) \
        acc[ai][bj][m][n] = __builtin_amdgcn_mfma_f32_16x16x32_bf16(Bt[n][k], At[m][k], acc[ai][bj][m][n], 0, 0, 0); __builtin_amdgcn_s_setprio(0); } while (0)
#define PG8_WAIT_V(n) asm volatile("s_waitcnt vmcnt(" #n ")" ::: "memory")
#define PG8_WAIT_L(n) asm volatile("s_waitcnt lgkmcnt(" #n ")" ::: "memory")
#define PG8_BAR __builtin_amdgcn_s_barrier()
#define PG8_SCHED __builtin_amdgcn_sched_barrier(0)
    Unit cur, nxt; int ui = 0;
    if (!S.next(0, cur)) return;
    f32x4 acc[2][2][4][2];
#pragma unroll
    for (int a = 0; a < 2; ++a)
#pragma unroll
        for (int b = 0; b < 2; ++b)
#pragma unroll
            for (int m = 0; m < 4; ++m)
#pragma unroll
                for (int n = 0; n < 2; ++n) acc[a][b][m][n] = (f32x4){0.f, 0.f, 0.f, 0.f};
    bf16x8 At[4][2], B0[2][2], B1[2][2];
    const char* cA = (const char*)g.A + (size_t)cur.pm * tstepA; const char* cB = (const char*)g.Bt + (size_t)cur.pn * tstep;
    S.a_ready(cur);
    if constexpr (SP2) {
        PG8_STAGE(PG8_SB(0, 0), cB, voffB); PG8_STAGE(PG8_SB(0, 1), cB + hstep, voffB); PG8_STAGE(PG8_SA(0, 0), cA, voffA); PG8_STAGE(PG8_SA(0, 1), cA + hstepA, voffA);
        if (wr == 1) PG8_BAR;
        PG8_WAIT_V(2); PG8_BAR;
        PG8_STAGE(PG8_SB(1, 0), cB + kstep, voffB); PG8_STAGE(PG8_SA(1, 0), cA + kstep, voffA); PG8_STAGE(PG8_SB(1, 1), cB + hstep + kstep, voffB);
        PG8_WAIT_V(6); PG8_BAR;
    } else {
        PG8_STAGE(PG8_SB(0, 0), cB, voffB); PG8_STAGE(PG8_SA(0, 0), cA, voffA); PG8_STAGE(PG8_SB(0, 1), cB + hstep, voffB); PG8_STAGE(PG8_SA(0, 1), cA + hstepA, voffA);
        if (wr == 1) PG8_BAR;
        PG8_WAIT_V(4); PG8_BAR;
        PG8_STAGE(PG8_SB(1, 0), cB + kstep, voffB); PG8_STAGE(PG8_SA(1, 0), cA + kstep, voffA); PG8_STAGE(PG8_SB(1, 1), cB + hstep + kstep, voffB);
        PG8_WAIT_V(6); PG8_BAR;
    }
    for (;;) {
        const bool has_next = S.next(ui + 1, nxt);
        const char* nA = has_next ? (const char*)g.A + (size_t)nxt.pm * tstepA : cA; const char* nB = has_next ? (const char*)g.Bt + (size_t)nxt.pn * tstep : cB;
        for (int t = 0; t < nt; t += 2) {
            const bool last = (t == nt - 2);
            const char* a1 = cA + (size_t)(t + 1) * kstep;
            const char* a2 = last ? nA : cA + (size_t)(t + 2) * kstep; const char* b2 = last ? nB : cB + (size_t)(t + 2) * kstep;
            const char* a3 = a2 + kstep; const char* b3 = b2 + kstep;
            if (last && has_next) S.a_ready(nxt);
            if constexpr (SP2) {
            PG8_LDB(B0, 0, 0); PG8_LDB(B1, 0, 1); PG8_SCHED; PG8_LDA(At, 0, 0); PG8_STAGE(PG8_SA(1, 1), a1 + hstepA, voffA);
            PG8_WAIT_V(8); PG8_WAIT_L(0); PG8_BAR; PG8_MMA(0, 0, At, B0); PG8_MMA(0, 1, At, B1); PG8_BAR; PG8_SCHED;
            PG8_LDA(At, 0, 1); PG8_STAGE(PG8_SB(0, 0), b2, voffB); PG8_STAGE(PG8_SB(0, 1), b2 + hstep, voffB); PG8_STAGE(PG8_SA(0, 0), a2, voffA);
            PG8_WAIT_V(8); PG8_WAIT_L(0); PG8_BAR; PG8_MMA(1, 0, At, B0); PG8_MMA(1, 1, At, B1); PG8_BAR; PG8_SCHED;
            PG8_LDB(B0, 1, 0); PG8_LDB(B1, 1, 1); PG8_SCHED; PG8_LDA(At, 1, 0); PG8_STAGE(PG8_SA(0, 1), a2 + hstepA, voffA);
            PG8_WAIT_V(8); PG8_WAIT_L(0); PG8_BAR; PG8_MMA(0, 0, At, B0); PG8_MMA(0, 1, At, B1); PG8_BAR; PG8_SCHED;
            PG8_LDA(At, 1, 1); PG8_STAGE(PG8_SB(1, 0), b3, voffB); PG8_STAGE(PG8_SB(1, 1), b3 + hstep, voffB); PG8_STAGE(PG8_SA(1, 0), a3, voffA);
            PG8_WAIT_V(8); PG8_WAIT_L(0); PG8_BAR; PG8_MMA(1, 0, At, B0); PG8_MMA(1, 1, At, B1); PG8_BAR; PG8_SCHED;
            } else {
            PG8_LDB(B0, 0, 0); PG8_SCHED; PG8_LDA(At, 0, 0); PG8_STAGE(PG8_SA(1, 1), a1 + hstepA, voffA);
            PG8_WAIT_L(8); PG8_BAR; PG8_WAIT_L(0); PG8_MMA(0, 0, At, B0); PG8_BAR; PG8_SCHED;
            PG8_LDB(B1, 0, 1); PG8_STAGE(PG8_SB(0, 0), b2, voffB);
            PG8_BAR; PG8_WAIT_L(0); PG8_MMA(0, 1, At, B1); PG8_BAR;
            PG8_LDA(At, 0, 1); PG8_STAGE(PG8_SA(0, 0), a2, voffA);
            PG8_BAR; PG8_WAIT_L(0); PG8_MMA(1, 0, At, B0); PG8_BAR; PG8_SCHED;
            PG8_STAGE(PG8_SB(0, 1), b2 + hstep, voffB);
            PG8_WAIT_V(6); PG8_BAR; PG8_MMA(1, 1, At, B1); PG8_BAR;
            PG8_LDB(B0, 1, 0); PG8_SCHED; PG8_LDA(At, 1, 0); PG8_STAGE(PG8_SA(0, 1), a2 + hstepA, voffA);
            PG8_WAIT_L(8); PG8_BAR; PG8_WAIT_L(0); PG8_MMA(0, 0, At, B0); PG8_BAR; PG8_SCHED;
            PG8_LDB(B1, 1, 1); PG8_STAGE(PG8_SB(1, 0), b3, voffB);
            PG8_BAR; PG8_WAIT_L(0); PG8_MMA(0, 1, At, B1); PG8_BAR;
            PG8_LDA(At, 1, 1); PG8_STAGE(PG8_SA(1, 0), a3, voffA);
            PG8_BAR; PG8_WAIT_L(0); PG8_MMA(1, 0, At, B0); PG8_BAR; PG8_SCHED;
            PG8_STAGE(PG8_SB(1, 1), b3 + hstep, voffB);
            PG8_WAIT_V(6); PG8_BAR; PG8_MMA(1, 1, At, B1); PG8_BAR;
            }
        }
        if constexpr (ALIGN_EPI) { if (wr == 0) PG8_BAR; }
        if constexpr (!Epi::AFTER_DRAIN) { E(acc, cur, wr, wc, fr, fq); S.done(cur); }
        if (!has_next) break;
#pragma unroll
        for (int a = 0; a < 2; ++a)
#pragma unroll
            for (int b = 0; b < 2; ++b)
#pragma unroll
                for (int m = 0; m < 4; ++m)
#pragma unroll
                    for (int n = 0; n < 2; ++n) acc[a][b][m][n] = (f32x4){0.f, 0.f, 0.f, 0.f};
        cur = nxt; cA = nA; cB = nB; ++ui;
        if constexpr (ALIGN_EPI) { if (wr == 1) PG8_BAR; }
    }
    PG8_WAIT_V(0);
    if constexpr (!ALIGN_EPI) { if (wr == 0) PG8_BAR; }
    PG8_BAR;
    if constexpr (Epi::AFTER_DRAIN) { E.fused(acc, cur, wr, wc, fr, fq, lds, wid, lane); S.done(cur); }
#undef PG8_SA
#undef PG8_SB
#undef PG8_STAGE
#undef PG8_LDA
#undef PG8_LDB
#undef PG8_MMA
#undef PG8_WAIT_V
#undef PG8_WAIT_L
#undef PG8_BAR
#undef PG8_SCHED
}
}
#define LAS __attribute__((address_space(3)))
#define XB_TMO      128
#define XB_XCNT(j)  (256  + 64 * (j))
#define XB_XSUB(j)  (1280 + 64 * (j))
#define XB_XGEN(j)  (2304 + 64 * (j))
#define XB_TOP      3328
#define XB_TOPGEN   3392
#define XCD_BAR_WORDS 3456
#define XB_SPIN_CAP (1u << 18)

__device__ __forceinline__ unsigned xb_ld(unsigned* p)              { return __hip_atomic_load(p, __ATOMIC_RELAXED, __HIP_MEMORY_SCOPE_AGENT); }
__device__ __forceinline__ unsigned xb_add(unsigned* p, unsigned v) { return __hip_atomic_fetch_add(p, v, __ATOMIC_RELAXED, __HIP_MEMORY_SCOPE_AGENT); }
__device__ __forceinline__ unsigned xb_xcc_id() { return (unsigned)__builtin_amdgcn_s_getreg((3 << 11) | 20) & 0xFu; }
#define XB_SPIN(cond, bar) do { unsigned _sp = 0; while (cond) { __builtin_amdgcn_s_sleep(1); \
    if ((++_sp & 255u) == 0u) { if (xb_ld(&(bar)[XB_TMO])) break; if (_sp > XB_SPIN_CAP) { atomicAdd(&(bar)[XB_TMO], 1u); break; } } } } while (0)

struct XcdBarrier {
    unsigned* bar; unsigned x;
    volatile LAS unsigned* st;
};

__device__ __forceinline__ XcdBarrier xcd_barrier_post(unsigned* bar, volatile LAS unsigned* st) {
    XcdBarrier b; b.bar = bar; b.x = xb_xcc_id(); b.st = st;
    if (threadIdx.x == 0) (void)xb_add(&bar[XB_XCNT(b.x)], 1u);
    return b;
}
__device__ __forceinline__ void xcd_barrier_complete(unsigned* bar, unsigned x, unsigned& nloc, unsigned& nx) {
    const unsigned G = gridDim.x * gridDim.y * gridDim.z;
    unsigned sum, cnt, mine, sp = 0u;
    for (;;) {
        sum = 0u; cnt = 0u; mine = 0u;
#pragma unroll
        for (unsigned j = 0; j < 16; ++j) { const unsigned c = xb_ld(&bar[XB_XCNT(j)]); sum += c; cnt += (c > 0u) ? 1u : 0u; mine = (j == x) ? c : mine; }
        if (sum == G) break;
        __builtin_amdgcn_s_sleep(1);
        if ((++sp & 255u) == 0u) { if (xb_ld(&bar[XB_TMO])) break; if (sp > XB_SPIN_CAP) { atomicAdd(&bar[XB_TMO], 1u); break; } }
    }
    nloc = mine > 0u ? mine : 1u; nx = cnt > 0u ? cnt : 1u;
}

__device__ __forceinline__ void xcd_barrier(const XcdBarrier& b) {
    asm volatile("s_waitcnt vmcnt(0)" ::: "memory");
    __syncthreads();
    if (threadIdx.x == 0) {
        unsigned* bar = b.bar;
        __builtin_amdgcn_s_waitcnt(0);
        unsigned nloc = b.st[0], nx = b.st[1];
        if (nloc == 0u) { xcd_barrier_complete(bar, b.x, nloc, nx); b.st[0] = nloc; b.st[1] = nx; }
        const unsigned old = xb_add(&bar[XB_XSUB(b.x)], 1u);
        const unsigned gen = old / nloc;
        if (old + 1u == (gen + 1u) * nloc) {
            __builtin_amdgcn_fence(__ATOMIC_RELEASE, "agent");
            asm volatile("s_waitcnt vmcnt(0)" ::: "memory");
            const unsigned og = xb_add(&bar[XB_TOP], 1u);
            const unsigned tg = og / nx;
            if (og + 1u == (tg + 1u) * nx) xb_add(&bar[XB_TOPGEN], 1u);
            else XB_SPIN(xb_ld(&bar[XB_TOPGEN]) == tg, bar);
            __builtin_amdgcn_fence(__ATOMIC_ACQUIRE, "agent");
            xb_add(&bar[XB_XGEN(b.x)], 1u);
            asm volatile("s_waitcnt vmcnt(0)" ::: "memory");
        } else {
            XB_SPIN(xb_ld(&bar[XB_XGEN(b.x)]) == gen, bar);
            __builtin_amdgcn_fence(__ATOMIC_ACQUIRE, "agent");
            asm volatile("s_waitcnt vmcnt(0)" ::: "memory");
        }
    }
    __syncthreads();
}


#ifndef FUSE_ACT
#define FUSE_ACT 1
#endif
#ifndef DN_STAGED
#define DN_STAGED 1
#endif
#ifndef DIAG_Y
#define DIAG_Y 0
#endif
#ifndef OLD_S5
#define OLD_S5 0
#endif
#if OLD_S5 == 3
#define OLD_S5_ULIM 8192
#else
#define OLD_S5_ULIM (4 * 32 * 64 + 32 * 32)
#endif
#define DI __device__ __forceinline__
typedef unsigned short bf16;
typedef float f32x4 __attribute__((ext_vector_type(4)));
typedef float f32x2 __attribute__((ext_vector_type(2)));
typedef short bf16x8 __attribute__((ext_vector_type(8)));
typedef unsigned u32x4 __attribute__((ext_vector_type(4)));
typedef unsigned u32x2 __attribute__((ext_vector_type(2)));
typedef __bf16 bf16x2_t __attribute__((ext_vector_type(2)));

DI unsigned pk2(float lo, float hi) { f32x2 v = {lo, hi}; bf16x2_t b = __builtin_convertvector(v, bf16x2_t); return __builtin_bit_cast(unsigned, b); }
DI bf16 f2b(float x) { return (bf16)(pk2(x, 0.f) & 0xffffu); }
DI float b2f(unsigned b) { return __uint_as_float(b << 16); }
DI float blo(unsigned w) { return __uint_as_float(w << 16); }
DI float bhi(unsigned w) { return __uint_as_float(w & 0xffff0000u); }
DI float wave_sum(float v) {
#pragma unroll
    for (int o = 1; o < 64; o <<= 1) v += __shfl_xor(v, o);
    return v;
}
DI float sigm(float x) { return __builtin_amdgcn_rcpf(1.f + __expf(-x)); }
DI float silu(float x) { return x * __builtin_amdgcn_rcpf(1.f + __expf(-x)); }
DI float gelu_tanh(float x) { const float z = 1.5957691216057308f * (x + 0.044715f * x * x * x); return x * __builtin_amdgcn_rcpf(1.f + __expf(-z)); }
#define MFMA16(a, b, c) __builtin_amdgcn_mfma_f32_16x16x32_bf16((a), (b), (c), 0, 0, 0)

constexpr int TP = 32768, TS = 512, T = TP + TS;
constexpr int DM = 1024, PW = 2560, NIN = 2816, DFF = 2816, UPW = 5632;
constexpr float EPS = 1e-6f;
constexpr int NCH = 2048 + 128;
constexpr int REC = 73728;
constexpr int R_WN = 0, R_QG = 16384, R_KDT = 32768, R_QK = 49152, R_U0 = 57344;
constexpr size_t O_Y = 0, O_PDC = (size_t)T * DM, O_PDS = O_PDC + 4 * 3 * 1536, O_PSR = O_PDS + 4 * 4 * 128 * 128, O_PSI = O_PSR + 4 * 32 * 64,
                 O_PFC = O_PSI + 4 * 32 * 64, O_SDC = O_PFC + 4 * 2 * 2816, O_SDS = O_SDC + 32 * 3 * 1536, O_SSR = O_SDS + (size_t)32 * 4 * 128 * 128,
                 O_SSI = O_SSR + 32 * 32 * 64, O_SFC = O_SSI + 32 * 32 * 64, O_END = O_SFC + 32 * 2 * 2816;
constexpr size_t MiB = 1u << 20;
constexpr size_t WS_SS2 = 0;
constexpr size_t WS_EG = 3 * MiB;
constexpr size_t WS_CTL = 5 * MiB + 512 * 1024;
constexpr size_t WS_BA = 4 * MiB;
constexpr size_t WS_WIN = 6 * MiB, WS_WGLU = 12 * MiB, WS_WOUT = 13 * MiB, WS_WUP = 15 * MiB, WS_WDOWN = 26 * MiB;
constexpr size_t WS_H = 32 * MiB;
constexpr size_t WS_P = 98 * MiB;
constexpr size_t WS_DNC = 262 * MiB;
constexpr size_t WS_Y5 = 416 * MiB, WS_GLU = 449 * MiB, WS_S5E = 482 * MiB, WS_END = 487 * MiB;
constexpr size_t WS_GH = 300 * MiB, WS_GT = 324 * MiB, WS_VH = 348 * MiB;
constexpr size_t WS_X2 = 416 * MiB;
constexpr size_t WS_UP = 98 * MiB;
static_assert(WS_UP + (size_t)T * UPW * 2 <= WS_END && WS_P + (size_t)T * PW * 2 <= WS_DNC && WS_DNC + (size_t)NCH * REC <= WS_Y5, "ws map");
constexpr int LDS_BYTES = 147456;

struct Args { const float* in[31]; float* out; unsigned char* ws; };

DI int colmap(int mode, int n) {
    if (mode == 0) return n;
    if (mode == 1) return n < 2048 ? n : (n < 2560 ? n + 8 : (n < 2568 ? n - 512 : -1));
    const int pn = n >> 8, bj = (n >> 7) & 1, j = n & 127;
    return bj * (mode == 2 ? 512 : 2816) + 128 * pn + j;
}
DI void transpose_item(const float* W, int K, int N, bf16* WT, float* scr, int kb, int nb, int lane, int mode, const float* rs) {
    const int k0 = 64 * kb, n0 = 32 * nb;
    const int sc = colmap(mode, n0 + (lane & 31));
    float tv[32];
#pragma unroll
    for (int i = 0; i < 32; ++i) { const int kk = 2 * i + (lane >> 5); tv[i] = 0.f; if (sc >= 0) tv[i] = W[(size_t)(k0 + kk) * N + sc]; }
#pragma unroll
    for (int i = 0; i < 32; ++i) { const int kk = 2 * i + (lane >> 5); float v = tv[i]; if (rs) v *= rs[k0 + kk]; scr[kk * 33 + (lane & 31)] = v; }
    asm volatile("s_waitcnt lgkmcnt(0)" ::: "memory");
    const int c = lane & 7;
#pragma unroll
    for (int j = 0; j < 4; ++j) { const int n = (lane >> 3) + 8 * j; const float* s = scr + (8 * c) * 33 + n;
        u32x4 o; o.x = pk2(s[0 * 33], s[1 * 33]); o.y = pk2(s[2 * 33], s[3 * 33]); o.z = pk2(s[4 * 33], s[5 * 33]); o.w = pk2(s[6 * 33], s[7 * 33]);
        *(u32x4*)(WT + (size_t)(n0 + n) * K + k0 + 8 * c) = o; }
    asm volatile("s_waitcnt lgkmcnt(0)" ::: "memory");
}
DI void phase0(const Args& a, unsigned char* lds, int gw, int NGW, int wave, int lane) {
    asm volatile("" : "+v"(lane));
    unsigned char* ws = a.ws;
    float* scr = (float*)(lds + wave * 16384);
    constexpr int I_IN = 16 * (NIN / 32), I_GLU = 8 * 32, I_OUT = 16 * 32, I_UP = 16 * (UPW / 32), I_DN = 44 * 32;
    constexpr int NIT = I_IN + I_GLU + I_OUT + I_UP + I_DN;
    for (int it = gw; it < NIT; it += NGW) {
        int r = it;
        if (r < I_IN) { transpose_item(a.in[8], 1024, 2568, (bf16*)(ws + WS_WIN), scr, r / (NIN / 32), r % (NIN / 32), lane, 1, nullptr); continue; } r -= I_IN;
        if (r < I_GLU) { transpose_item(a.in[21], 512, 1024, (bf16*)(ws + WS_WGLU), scr, r / 32, r % 32, lane, 2, nullptr); continue; } r -= I_GLU;
        if (r < I_OUT) { transpose_item(a.in[24], 1024, 1024, (bf16*)(ws + WS_WOUT), scr, r / 32, r % 32, lane, 0, nullptr); continue; } r -= I_OUT;
        if (r < I_UP) { transpose_item(a.in[26], 1024, 5632, (bf16*)(ws + WS_WUP), scr, r / (UPW / 32), r % (UPW / 32), lane, 3, a.in[25]); continue; } r -= I_UP;
        transpose_item(a.in[29], 2816, 1024, (bf16*)(ws + WS_WDOWN), scr, r / 32, r % 32, lane, 0, nullptr);
    }
    const float* g1 = a.in[7];
    f32x4 gv[4];
#pragma unroll
    for (int j = 0; j < 4; ++j) gv[j] = ((const f32x4*)g1)[lane + 64 * j];
    bf16* H = (bf16*)(ws + WS_H);
    for (int m0 = gw; m0 < T; m0 += 2 * NGW) {
        const int m1 = m0 + NGW < T ? m0 + NGW : m0;
        const f32x4* xr0 = (const f32x4*)(m0 < TP ? a.in[0] + (size_t)m0 * DM : a.in[1] + (size_t)(m0 - TP) * DM) + lane;
        const f32x4* xr1 = (const f32x4*)(m1 < TP ? a.in[0] + (size_t)m1 * DM : a.in[1] + (size_t)(m1 - TP) * DM) + lane;
        f32x4 v0[4], v1[4]; float s0 = 0.f, s1 = 0.f;
#pragma unroll
        for (int j = 0; j < 4; ++j) { v0[j] = xr0[64 * j]; v1[j] = xr1[64 * j]; }
#pragma unroll
        for (int j = 0; j < 4; ++j) { s0 += (v0[j].x * v0[j].x + v0[j].y * v0[j].y) + (v0[j].z * v0[j].z + v0[j].w * v0[j].w); s1 += (v1[j].x * v1[j].x + v1[j].y * v1[j].y) + (v1[j].z * v1[j].z + v1[j].w * v1[j].w); }
        const float r0 = rsqrtf(wave_sum(s0) * (1.f / DM) + EPS), r1 = rsqrtf(wave_sum(s1) * (1.f / DM) + EPS);
        u32x2* o0 = (u32x2*)(H + (size_t)m0 * DM) + lane; u32x2* o1 = (u32x2*)(H + (size_t)m1 * DM) + lane;
#pragma unroll
        for (int j = 0; j < 4; ++j) { u32x2 o; o.x = pk2(v0[j].x * r0 * gv[j].x, v0[j].y * r0 * gv[j].y); o.y = pk2(v0[j].z * r0 * gv[j].z, v0[j].w * r0 * gv[j].w); o0[64 * j] = o; }
        if (m1 != m0) {
#pragma unroll
            for (int j = 0; j < 4; ++j) { u32x2 o; o.x = pk2(v1[j].x * r1 * gv[j].x, v1[j].y * r1 * gv[j].y); o.y = pk2(v1[j].z * r1 * gv[j].z, v1[j].w * r1 * gv[j].w); o1[64 * j] = o; }
        }
    }
}

struct EpiP {
    static constexpr bool PERM = true, AFTER_DRAIN = false;
    bf16* P; float* BA;
    DI void operator()(const pg8::f32x4 (&acc)[2][2][4][2], const pg8::Unit& u, int wr, int wc, int fr, int fq) const {
        const int row0 = u.pm * 256 + wr * 64 + fr;
        if (u.pn < 10) {
            const int col0 = u.pn * 256 + wc * 32 + 8 * fq;
#pragma unroll
            for (int ai = 0; ai < 2; ++ai)
#pragma unroll
                for (int m = 0; m < 4; ++m) { bf16* rowp = P + (size_t)(row0 + ai * 128 + m * 16) * PW + col0;
#pragma unroll
                    for (int bj = 0; bj < 2; ++bj) { const pg8::f32x4 v0 = acc[ai][bj][m][0], v1 = acc[ai][bj][m][1];
                        u32x4 w; w.x = pk2(v0[0], v0[1]); w.y = pk2(v0[2], v0[3]); w.z = pk2(v1[0], v1[1]); w.w = pk2(v1[2], v1[3]);
                        *(u32x4*)(rowp + bj * 128) = w; } }
        } else if (wc == 0 && fq == 0) {
#pragma unroll
            for (int ai = 0; ai < 2; ++ai)
#pragma unroll
                for (int m = 0; m < 4; ++m) { float* bp = BA + (size_t)(row0 + ai * 128 + m * 16) * 8;
                    *(pg8::f32x4*)bp = acc[ai][0][m][0]; *(pg8::f32x4*)(bp + 4) = acc[ai][0][m][1]; }
        }
    }
};
struct EpiGlu {
    static constexpr bool PERM = true, AFTER_DRAIN = false;
    bf16* O; const float* gb;
    DI void operator()(const pg8::f32x4 (&acc)[2][2][4][2], const pg8::Unit& u, int wr, int wc, int fr, int fq) const {
        const int row0 = u.pm * 256 + wr * 64 + fr, col0 = u.pn * 128 + wc * 32 + 8 * fq;
        const pg8::f32x4 ba0 = *(const pg8::f32x4*)(gb + col0), ba1 = *(const pg8::f32x4*)(gb + col0 + 4), bg0 = *(const pg8::f32x4*)(gb + 512 + col0), bg1 = *(const pg8::f32x4*)(gb + 512 + col0 + 4);
#pragma unroll
        for (int ai = 0; ai < 2; ++ai)
#pragma unroll
            for (int m = 0; m < 4; ++m) {
                const pg8::f32x4 a0 = acc[ai][0][m][0] + ba0, a1 = acc[ai][0][m][1] + ba1, g0 = acc[ai][1][m][0] + bg0, g1 = acc[ai][1][m][1] + bg1;
                float o[8];
#pragma unroll
                for (int e = 0; e < 4; ++e) { o[e] = a0[e] * sigm(g0[e]); o[4 + e] = a1[e] * sigm(g1[e]); }
                u32x4 w; w.x = pk2(o[0], o[1]); w.y = pk2(o[2], o[3]); w.z = pk2(o[4], o[5]); w.w = pk2(o[6], o[7]);
                *(u32x4*)(O + (size_t)(row0 + ai * 128 + m * 16) * 512 + col0) = w;
            }
    }
};
struct EpiX1 {
    static constexpr bool PERM = false, AFTER_DRAIN = false;
    const float* xp; const float* xs; float* out; bf16* xb; float* ss2;
    DI void operator()(const pg8::f32x4 (&acc)[2][2][4][2], const pg8::Unit& u, int wr, int wc, int fr, int fq) const {
        const int row0 = u.pm * 256 + wr * 64 + fr, col0 = u.pn * 256 + wc * 32 + 4 * fq;
#pragma unroll
        for (int ai = 0; ai < 2; ++ai)
#pragma unroll
            for (int m = 0; m < 4; ++m) {
                const int row = row0 + ai * 128 + m * 16;
                const float* xr = (row < TP ? xp + (size_t)row * DM : xs + (size_t)(row - TP) * DM) + col0;
                float ss = 0.f;
#pragma unroll
                for (int bj = 0; bj < 2; ++bj)
#pragma unroll
                    for (int n = 0; n < 2; ++n) {
                        const pg8::f32x4 v = *(const pg8::f32x4*)(xr + bj * 128 + n * 16) + acc[ai][bj][m][n];
                        u32x2 w; w.x = pk2(v[0], v[1]); w.y = pk2(v[2], v[3]);
                        *(u32x2*)(xb + (size_t)row * DM + col0 + bj * 128 + n * 16) = w;
                        ss += (v[0] * v[0] + v[1] * v[1]) + (v[2] * v[2] + v[3] * v[3]);
                    }
                ss += __shfl_xor(ss, 16); ss += __shfl_xor(ss, 32);
                if (fq == 0) ss2[(size_t)row * 16 + u.pn * 4 + wc] = ss;
            }
    }
};
struct EpiUp {
    static constexpr bool PERM = true, AFTER_DRAIN = false;
    bf16* UP; const float* ss2;
    DI void operator()(const pg8::f32x4 (&acc)[2][2][4][2], const pg8::Unit& u, int wr, int wc, int fr, int fq) const {
        const int row0 = u.pm * 256 + wr * 64 + fr, col0 = u.pn * 128 + wc * 32 + 8 * fq;
#pragma unroll
        for (int ai = 0; ai < 2; ++ai)
#pragma unroll
            for (int m = 0; m < 4; ++m) {
                const int row = row0 + ai * 128 + m * 16;
                const pg8::f32x4* sp = (const pg8::f32x4*)(ss2 + (size_t)row * 16);
                const pg8::f32x4 s0 = sp[0], s1 = sp[1], s2 = sp[2], s3 = sp[3];
                const float tot = ((s0[0] + s0[1]) + (s0[2] + s0[3])) + ((s1[0] + s1[1]) + (s1[2] + s1[3])) + ((s2[0] + s2[1]) + (s2[2] + s2[3])) + ((s3[0] + s3[1]) + (s3[2] + s3[3]));
                const float r = rsqrtf(tot * (1.f / DM) + EPS);
                bf16* rowp = UP + (size_t)row * UPW + col0;
#pragma unroll
                for (int bj = 0; bj < 2; ++bj) { const pg8::f32x4 v0 = acc[ai][bj][m][0] * r, v1 = acc[ai][bj][m][1] * r;
                    u32x4 w; w.x = pk2(v0[0], v0[1]); w.y = pk2(v0[2], v0[3]); w.z = pk2(v1[0], v1[1]); w.w = pk2(v1[2], v1[3]);
                    *(u32x4*)(rowp + bj * DFF) = w; }
            }
    }
};
DI float dpp_shr1(float v) { return __int_as_float(__builtin_amdgcn_update_dpp(0, __float_as_int(v), 0x111, 0xf, 0xf, false)); }
DI float dpp_shr2(float v) { return __int_as_float(__builtin_amdgcn_update_dpp(0, __float_as_int(v), 0x112, 0xf, 0xf, false)); }
struct EpiUpAct {
    static constexpr bool PERM = true, AFTER_DRAIN = false;
    bf16* ACT; bf16* GH; bf16* GT; bf16* VH; const float* ss2; const float* fw; const float* fb;
    DI void operator()(const pg8::f32x4 (&acc)[2][2][4][2], const pg8::Unit& u, int wr, int wc, int fr, int fq) const {
        const int row0 = u.pm * 256 + wr * 64 + fr, col0 = u.pn * 128 + wc * 32 + 8 * fq;
        float w0[8], w1[8], w2[8], bb[8];
#pragma unroll
        for (int n = 0; n < 2; ++n) { const pg8::f32x4 a0 = *(const pg8::f32x4*)(fw + col0 + 4 * n), a1 = *(const pg8::f32x4*)(fw + DFF + col0 + 4 * n), a2 = *(const pg8::f32x4*)(fw + 2 * DFF + col0 + 4 * n), a3 = *(const pg8::f32x4*)(fb + col0 + 4 * n);
#pragma unroll
            for (int e = 0; e < 4; ++e) { w0[4 * n + e] = a0[e]; w1[4 * n + e] = a1[e]; w2[4 * n + e] = a2[e]; bb[4 * n + e] = a3[e]; } }
#pragma unroll
        for (int ai = 0; ai < 2; ++ai)
#pragma unroll
            for (int m = 0; m < 4; ++m) {
                const int row = row0 + ai * 128 + m * 16, grp = row >> 4;
                const pg8::f32x4* sp = (const pg8::f32x4*)(ss2 + (size_t)row * 16);
                const pg8::f32x4 s0 = sp[0], s1 = sp[1], s2 = sp[2], s3 = sp[3];
                const float tot = ((s0[0] + s0[1]) + (s0[2] + s0[3])) + ((s1[0] + s1[1]) + (s1[2] + s1[3])) + ((s2[0] + s2[1]) + (s2[2] + s2[3])) + ((s3[0] + s3[1]) + (s3[2] + s3[3]));
                const float r = rsqrtf(tot * (1.f / DM) + EPS);
                float gs[8], vv[8], o[8];
#pragma unroll
                for (int n = 0; n < 2; ++n)
#pragma unroll
                    for (int e = 0; e < 4; ++e) { gs[4 * n + e] = acc[ai][0][m][n][e] * r; vv[4 * n + e] = acc[ai][1][m][n][e] * r; }
#pragma unroll
                for (int e = 0; e < 8; ++e) { const float g1 = dpp_shr1(gs[e]), g2 = dpp_shr2(gs[e]); o[e] = silu(g2 * w0[e] + g1 * w1[e] + gs[e] * w2[e] + bb[e]) * vv[e]; }
                u32x4 wg; wg.x = pk2(gs[0], gs[1]); wg.y = pk2(gs[2], gs[3]); wg.z = pk2(gs[4], gs[5]); wg.w = pk2(gs[6], gs[7]);
                if (fr >= 2) { u32x4 w; w.x = pk2(o[0], o[1]); w.y = pk2(o[2], o[3]); w.z = pk2(o[4], o[5]); w.w = pk2(o[6], o[7]);
                    *(u32x4*)(ACT + (size_t)row * DFF + col0) = w; }
                else { u32x4 wv; wv.x = pk2(vv[0], vv[1]); wv.y = pk2(vv[2], vv[3]); wv.z = pk2(vv[4], vv[5]); wv.w = pk2(vv[6], vv[7]);
                    *(u32x4*)(GH + ((size_t)grp * 2 + fr) * DFF + col0) = wg; *(u32x4*)(VH + ((size_t)grp * 2 + fr) * DFF + col0) = wv; }
                if (fr >= 14) *(u32x4*)(GT + ((size_t)grp * 2 + (fr - 14)) * DFF + col0) = wg;
            }
    }
};
struct EpiX2 {
    static constexpr bool PERM = false, AFTER_DRAIN = false;
    float* out; const bf16* xb; bf16* x2;
    DI void operator()(const pg8::f32x4 (&acc)[2][2][4][2], const pg8::Unit& u, int wr, int wc, int fr, int fq) const {
        const int row0 = u.pm * 256 + wr * 64 + fr, col0 = u.pn * 256 + wc * 32 + 4 * fq;
#pragma unroll
        for (int ai = 0; ai < 2; ++ai)
#pragma unroll
            for (int m = 0; m < 4; ++m) {
                float* orow = out + (size_t)(row0 + ai * 128 + m * 16) * DM + col0;
#pragma unroll
                for (int bj = 0; bj < 2; ++bj)
#pragma unroll
                    for (int n = 0; n < 2; ++n) { const u32x2 xb2 = *(const u32x2*)(xb + (size_t)(row0 + ai * 128 + m * 16) * DM + col0 + bj * 128 + n * 16);
                        pg8::f32x4 v = acc[ai][bj][m][n]; v[0] += blo(xb2.x); v[1] += bhi(xb2.x); v[2] += blo(xb2.y); v[3] += bhi(xb2.y);
                        u32x2 w; w.x = pk2(v[0], v[1]); w.y = pk2(v[2], v[3]);
                        *(u32x2*)(x2 + (size_t)(row0 + ai * 128 + m * 16) * DM + col0 + bj * 128 + n * 16) = w; }
            }
    }
};

DI int kperm(int k) { return (k & ~31) | (((k >> 2) & 3) << 3) | (((k >> 4) & 1) << 2) | (k & 3); }
DI void conv_col(const bf16* pcol, float h0, float h1, float h2, const float* cw, int nrows, float* outp, float (&val)[64]) {
    const float w0 = cw[0], w1 = cw[1536], w2 = cw[2 * 1536], w3 = cw[3 * 1536];
    float x3 = h0, x2 = h1, x1 = h2;
#pragma unroll
    for (int r = 0; r < 64; ++r) {
        float x0 = 0.f;
        if (r < nrows) x0 = b2f(pcol[(size_t)r * PW]);
        const float c = x3 * w0 + x2 * w1 + x1 * w2 + x0 * w3;
        val[r] = r < nrows ? silu(c) : 0.f;
        if (outp && r >= nrows - 3 && r < nrows) outp[(r - (nrows - 3)) * 1536] = x0;
        x3 = x2; x2 = x1; x1 = x0;
    }
}
DI void dn_chunk_phase(const Args& a, unsigned char* lds, int tid, int it0, int it1, int its) {
    unsigned char* ws = a.ws;
    const bf16* P = (const bf16*)(ws + WS_P);
    const float* BA = (const float*)(ws + WS_BA);
    const float* cwt = a.in[9];
    constexpr float QSCALE = 0.08838834764831845f;
    for (int it = it0; it < it1; it += its) {
        int tl = tid; asm volatile("" : "+v"(tl));
        const int half = __builtin_amdgcn_readfirstlane(tl >> 8), t8 = tl & 255, hw = __builtin_amdgcn_readfirstlane((tl >> 6) & 3), lane = tl & 63, fr = lane & 15, fq = lane >> 4;
        unsigned char* L = lds + half * 53248;
        unsigned char* qb = L; unsigned char* kb = L + 17408;
        float* Am = (float*)(L + 34816);
        float* Gs = (float*)(L + 51200); float* Bs = Gs + 64; float* RQ = Gs + 128; float* RK = Gs + 192; float* EG = Gs + 256;
        const int unit = it * 2 + half;
        int row0, nrows, h, bidx; bool sample, first, lastc;
        if (unit < 2048) { const int b = unit >> 9, n = unit & 127; h = (unit >> 7) & 3; row0 = b * 8192 + n * 64; nrows = 64; sample = false; first = (n == 0); lastc = (n == 127); bidx = b; }
        else { const int su = unit - 2048; bidx = su >> 2; h = su & 3; row0 = TP + bidx * 16; nrows = 16; sample = true; first = false; lastc = true; }
        unsigned char* rec = ws + WS_DNC + (size_t)unit * REC;
        if (hw == 0) {
            float g = 0.f, be = 0.f;
            if (lane < nrows) {
                const float* bp = BA + (size_t)(row0 + lane) * 8;
                be = sigm(bp[h]);
                const float xx = bp[4 + h] + a.in[11][h];
                const float sp = xx > 20.f ? xx : log1pf(__expf(xx));
                g = -__expf(a.in[10][h]) * sp;
            }
#pragma unroll
            for (int o = 1; o < 64; o <<= 1) { const float v = __shfl_up(g, o); if (lane >= o) g += v; }
            Gs[lane] = g; Bs[lane] = be; EG[lane] = __expf(g);
            if (lane == 63) ((float*)(ws + WS_EG))[unit] = __expf(g);
        }
        float va[64];
        {
            const int c = t8 & 127;
            const int col = (t8 < 128 ? 0 : 512) + h * 128 + c;
            float h0 = 0.f, h1 = 0.f, h2 = 0.f;
            if (sample) { const float* cc = a.in[2] + (size_t)bidx * 3 * 1536 + col; h0 = cc[0]; h1 = cc[1536]; h2 = cc[2 * 1536]; }
            else if (!first) { const bf16* pp = P + (size_t)(row0 - 3) * PW + col; h0 = b2f(pp[0]); h1 = b2f(pp[PW]); h2 = b2f(pp[2 * PW]); }
            float* outp = lastc ? a.out + (sample ? O_SDC : O_PDC) + (size_t)bidx * 3 * 1536 + col : nullptr;
            conv_col(P + (size_t)row0 * PW + col, h0, h1, h2, cwt + col, nrows, outp, va);
            unsigned char* dst = (t8 < 128 ? qb : kb) + c * 2;
#pragma unroll
            for (int r = 0; r < 64; ++r) *(bf16*)(dst + r * 272) = f2b(va[r]);
        }
        __syncthreads();
        f32x4 kk[4], qk[4], qq;
        {
            bf16x8 ak[4], aq[4];
#pragma unroll
            for (int ks = 0; ks < 4; ++ks) { ak[ks] = *(const bf16x8*)(kb + (16 * hw + fr) * 272 + ks * 64 + fq * 16); aq[ks] = *(const bf16x8*)(qb + (16 * hw + fr) * 272 + ks * 64 + fq * 16); }
            qq = (f32x4){0.f, 0.f, 0.f, 0.f};
#pragma unroll
            for (int ks = 0; ks < 4; ++ks) qq = MFMA16(aq[ks], aq[ks], qq);
#pragma unroll
            for (int nt = 0; nt < 4; ++nt) {
                kk[nt] = (f32x4){0.f, 0.f, 0.f, 0.f}; qk[nt] = (f32x4){0.f, 0.f, 0.f, 0.f};
#pragma unroll
                for (int ks = 0; ks < 4; ++ks) { const bf16x8 bk = *(const bf16x8*)(kb + (16 * nt + fr) * 272 + ks * 64 + fq * 16);
                    kk[nt] = MFMA16(ak[ks], bk, kk[nt]); qk[nt] = MFMA16(aq[ks], bk, qk[nt]); }
            }
#pragma unroll
            for (int i = 0; i < 4; ++i) if (fr == 4 * fq + i) {
                float dk = 0.f;
#pragma unroll
                for (int nt = 0; nt < 4; ++nt) if (nt == hw) dk = kk[nt][i];
                RK[16 * hw + fr] = rsqrtf(dk + EPS); RQ[16 * hw + fr] = rsqrtf(qq[i] + EPS);
            }
        }
        __syncthreads();
        {
            bf16* QKr = (bf16*)(rec + R_QK);
#pragma unroll
            for (int i = 0; i < 4; ++i) {
                const int row = 16 * hw + 4 * fq + i;
                const float gr = Gs[row], br = Bs[row], rk = RK[row], rq = RQ[row];
#pragma unroll
                for (int nt = 0; nt < 4; ++nt) {
                    const int col = 16 * nt + fr;
                    const float d = col <= row ? gr - Gs[col] : 0.f;
                    const float e = __expf(d), rkc = RK[col];
                    Am[row * 64 + col] = col < row ? br * kk[nt][i] * rk * rkc * e : 0.f;
                    QKr[row * 64 + kperm(col)] = f2b(col <= row ? qk[nt][i] * rq * rkc * QSCALE * e : 0.f);
                }
            }
        }
        __syncthreads();
        if (t8 < 128) {
            bf16* Qg = (bf16*)(rec + R_QG) + kperm(t8);
#pragma unroll
            for (int r = 0; r < 64; ++r) Qg[r * 128] = f2b(va[r] * RQ[r] * QSCALE * EG[r]);
            {
                const int col = 1024 + h * 128 + t8;
                float h0 = 0.f, h1 = 0.f, h2 = 0.f;
                if (sample) { const float* cc = a.in[2] + (size_t)bidx * 3 * 1536 + col; h0 = cc[0]; h1 = cc[1536]; h2 = cc[2 * 1536]; }
                else if (!first) { const bf16* pp = P + (size_t)(row0 - 3) * PW + col; h0 = b2f(pp[0]); h1 = b2f(pp[PW]); h2 = b2f(pp[2 * PW]); }
                float* outp = lastc ? a.out + (sample ? O_SDC : O_PDC) + (size_t)bidx * 3 * 1536 + col : nullptr;
                conv_col(P + (size_t)row0 * PW + col, h0, h1, h2, cwt + col, nrows, outp, va);
            }
#pragma unroll
            for (int r = 0; r < 64; ++r) va[r] = va[r] * Bs[r];
        } else {
            const int c = t8 - 128;
            const float gl = Gs[63];
            unsigned w[32];
#pragma unroll
            for (int r = 0; r < 64; r += 2) w[kperm(r) >> 1] = pk2(va[r] * RK[r] * __expf(gl - Gs[r]), va[r + 1] * RK[r + 1] * __expf(gl - Gs[r + 1]));
            u32x4* dst = (u32x4*)(rec + R_KDT + c * 128);
#pragma unroll
            for (int j = 0; j < 8; ++j) dst[j] = (u32x4){w[4 * j], w[4 * j + 1], w[4 * j + 2], w[4 * j + 3]};
#pragma unroll
            for (int r = 0; r < 64; ++r) va[r] = va[r] * RK[r] * Bs[r] * EG[r];
        }
#if SOLVE_RL
        {
            float arow[64];
#pragma unroll
            for (int i = 1; i < 64; ++i) arow[i] = Am[i * 64 + lane];
#pragma unroll
            for (int i = 1; i < 64; ++i) {
                if (i < nrows) {
                    float acc0 = va[i], acc1 = 0.f;
#pragma unroll
                    for (int j = 0; j < i; ++j) { const float aij = __int_as_float(__builtin_amdgcn_readlane(__float_as_int(arow[i]), j)); if (j & 1) acc1 -= aij * va[j]; else acc0 -= aij * va[j]; }
                    va[i] = acc0 + acc1;
                }
            }
        }
#else
#pragma unroll
        for (int i = 1; i < 64; ++i) {
            float acc = va[i];
            const f32x4* Ar = (const f32x4*)(Am + i * 64);
#pragma unroll
            for (int j4 = 0; j4 < (i + 3) / 4; ++j4) {
                const f32x4 av = Ar[j4];
#pragma unroll
                for (int e = 0; e < 4; ++e) if (4 * j4 + e < i) acc -= av[e] * va[4 * j4 + e];
            }
            va[i] = acc;
        }
#endif
        if (t8 < 128) { bf16* U0 = (bf16*)(rec + R_U0) + t8;
#pragma unroll
            for (int r = 0; r < 64; ++r) U0[r * 128] = f2b(va[r]);
        } else { bf16* Wn = (bf16*)(rec + R_WN) + kperm(t8 - 128);
#pragma unroll
            for (int r = 0; r < 64; ++r) Wn[r * 128] = f2b(-va[r]);
        }
        __syncthreads();
    }
}

struct S5W { float lr[4], li[4]; bf16x8 bf[8]; };
DI void s5w_setup(const Args& a, int g, int fr, int fq, S5W& w) {
    const float dt = __expf(a.in[15][g]);
#pragma unroll
    for (int j = 0; j < 4; ++j) {
        const int p = 16 * j + fr;
        const float are = a.in[13][g * 64 + p], aim = a.in[14][g * 64 + p];
        const float mag = __expf(are * dt), ang = aim * dt;
        float sn, cs; sincosf(ang, &sn, &cs);
        const float lr = mag * cs, li = mag * sn;
        w.lr[j] = lr; w.li[j] = li;
        const float den = are * are + aim * aim;
        const float fre = ((lr - 1.f) * are + li * aim) / den, fim = (li * are - (lr - 1.f) * aim) / den;
        u32x4 wr = (u32x4){0u, 0u, 0u, 0u}, wi = (u32x4){0u, 0u, 0u, 0u};
        if (fq < 2) {
            const f32x4* br = (const f32x4*)(a.in[16] + (size_t)(g * 64 + p) * 16 + 8 * fq); const f32x4* bi = (const f32x4*)(a.in[17] + (size_t)(g * 64 + p) * 16 + 8 * fq);
            const f32x4 r0 = br[0], r1 = br[1], i0 = bi[0], i1 = bi[1];
            wr.x = pk2(fre * r0[0] - fim * i0[0], fre * r0[1] - fim * i0[1]); wr.y = pk2(fre * r0[2] - fim * i0[2], fre * r0[3] - fim * i0[3]);
            wr.z = pk2(fre * r1[0] - fim * i1[0], fre * r1[1] - fim * i1[1]); wr.w = pk2(fre * r1[2] - fim * i1[2], fre * r1[3] - fim * i1[3]);
            wi.x = pk2(fre * i0[0] + fim * r0[0], fre * i0[1] + fim * r0[1]); wi.y = pk2(fre * i0[2] + fim * r0[2], fre * i0[3] + fim * r0[3]);
            wi.z = pk2(fre * i1[0] + fim * r1[0], fre * i1[1] + fim * r1[1]); wi.w = pk2(fre * i1[2] + fim * r1[2], fre * i1[3] + fim * r1[3]);
        }
        w.bf[j] = __builtin_bit_cast(bf16x8, wr); w.bf[4 + j] = __builtin_bit_cast(bf16x8, wi);
    }
}
DI bf16x8 s5w_uload(const bf16* P, size_t row0, int SS, int ms, int g, int fr, int fq) {
    u32x4 v = (u32x4){0u, 0u, 0u, 0u};
    if (fq < 2) v = *(const u32x4*)(P + (row0 + (size_t)(fr >> 2) * SS + 4 * ms + (fr & 3)) * PW + 2048 + g * 16 + 8 * fq);
    return __builtin_bit_cast(bf16x8, v);
}
DI void s5w_step(const S5W& w, bf16x8 ua, float (&xr)[4], float (&xi)[4], unsigned (&xo)[4][4]) {
    f32x4 br[4], bi[4];
    const f32x4 z = (f32x4){0.f, 0.f, 0.f, 0.f};
#pragma unroll
    for (int j = 0; j < 4; ++j) { br[j] = MFMA16(ua, w.bf[j], z); bi[j] = MFMA16(ua, w.bf[4 + j], z); }
#pragma unroll
    for (int i = 0; i < 4; ++i)
#pragma unroll
        for (int j = 0; j < 4; ++j) {
            const float nr = w.lr[j] * xr[j] - w.li[j] * xi[j] + br[j][i], ni = w.lr[j] * xi[j] + w.li[j] * xr[j] + bi[j][i];
            xr[j] = nr; xi[j] = ni; xo[i][j] = pk2(nr, ni);
        }
#pragma unroll
    for (int j = 0; j < 8; ++j) asm volatile("" :: "v"(w.bf[j]));
    asm volatile("" :: "v"(ua));
}
DI void s5_pass1(const Args& a, int gw, int NGW, int lane) {
    asm volatile("" : "+v"(lane));
    const bf16* P = (const bf16*)(a.ws + WS_P);
    float* E = (float*)(a.ws + WS_S5E);
    const int fr = lane & 15, fq = lane >> 4;
    for (int unit = gw; unit < 4 * 32 * 16; unit += NGW) {
        const int sg = unit & 15, bg = unit >> 4, g = bg & 31, b = bg >> 5;
        S5W w; s5w_setup(a, g, fr, fq, w);
        float xr[4] = {0.f, 0.f, 0.f, 0.f}, xi[4] = {0.f, 0.f, 0.f, 0.f}; unsigned xo[4][4];
        const size_t row0 = (size_t)b * 8192 + sg * 512;
        bf16x8 ua = s5w_uload(P, row0, 128, 0, g, fr, fq);
        for (int ms = 0; ms < 32; ++ms) {
            const bf16x8 un = s5w_uload(P, row0, 128, ms + 1 < 32 ? ms + 1 : ms, g, fr, fq);
            s5w_step(w, ua, xr, xi, xo); ua = un;
        }
        float* e = E + ((size_t)bg * 64 + 4 * sg + fq) * 128;
#pragma unroll
        for (int j = 0; j < 4; ++j) { e[16 * j + fr] = xr[j]; e[64 + 16 * j + fr] = xi[j]; }
    }
}
DI void s5w_run(const Args& a, const S5W& w, const bf16x8 (&cf)[4], float Dg, unsigned char* xs, size_t row0, int SS, int nms, int g, int fr, int fq, float (&xr)[4], float (&xi)[4]) {
    const bf16* P = (const bf16*)(a.ws + WS_P);
    bf16* Y5 = (bf16*)(a.ws + WS_Y5);
    bf16x8 ua = s5w_uload(P, row0, SS, 0, g, fr, fq);
    for (int ms = 0; ms < nms; ++ms) {
        const bf16x8 un = s5w_uload(P, row0, SS, ms + 1 < nms ? ms + 1 : ms, g, fr, fq);
        float uu[4];
#pragma unroll
        for (int i = 0; i < 4; ++i) uu[i] = b2f(P[(row0 + (size_t)fq * SS + 4 * ms + i) * PW + 2048 + g * 16 + fr]);
        unsigned xo[4][4];
        s5w_step(w, ua, xr, xi, xo); ua = un;
#pragma unroll
        for (int i = 0; i < 4; ++i)
#pragma unroll
            for (int j = 0; j < 4; ++j) *(unsigned*)(xs + (4 * fq + i) * 272 + (16 * j + fr) * 4) = xo[i][j];
        asm volatile("s_waitcnt lgkmcnt(0)" ::: "memory");
        f32x4 y = (f32x4){0.f, 0.f, 0.f, 0.f};
        bf16x8 af[4];
#pragma unroll
        for (int ks = 0; ks < 4; ++ks) af[ks] = *(const bf16x8*)(xs + fr * 272 + ks * 64 + fq * 16);
        asm volatile("" ::: "memory");
#pragma unroll
        for (int ks = 0; ks < 4; ++ks) y = MFMA16(af[ks], cf[ks], y);
#if DIAG_Y
        {
            const float* cre = a.in[18] + (size_t)(g * 16 + fr) * 64; const float* cim = a.in[19] + (size_t)(g * 16 + fr) * 64;
#pragma unroll
            for (int i = 0; i < 4; ++i) { float acc = 0.f;
                for (int p = 0; p < 64; ++p) { const unsigned wv = *(const unsigned*)(xs + (4 * fq + i) * 272 + p * 4); acc += cre[p] * blo(wv) - cim[p] * bhi(wv); }
                y[i] = acc; }
        }
#endif
        asm volatile("" :: "v"(y));
#pragma unroll
        for (int ks = 0; ks < 4; ++ks) asm volatile("" :: "v"(af[ks]), "v"(cf[ks]));
#pragma unroll
        for (int i = 0; i < 4; ++i) {
            const size_t row = row0 + (size_t)fq * SS + 4 * ms + i;
            Y5[row * 512 + g * 16 + fr] = f2b(gelu_tanh(y[i] + Dg * uu[i]));
        }
    }
}
DI void s5_cfrag(const Args& a, int g, int fr, int fq, bf16x8 (&cf)[4]) {
#pragma unroll
    for (int ks = 0; ks < 4; ++ks) {
        const f32x4 cr = *(const f32x4*)(a.in[18] + (size_t)(g * 16 + fr) * 64 + 16 * ks + 4 * fq), ci = *(const f32x4*)(a.in[19] + (size_t)(g * 16 + fr) * 64 + 16 * ks + 4 * fq);
        u32x4 w; w.x = pk2(cr[0], -ci[0]); w.y = pk2(cr[1], -ci[1]); w.z = pk2(cr[2], -ci[2]); w.w = pk2(cr[3], -ci[3]);
        cf[ks] = __builtin_bit_cast(bf16x8, w);
    }
}
DI void s5_pass2_prompt(const Args& a, unsigned char* lds, int bg, int tid) {
    asm volatile("" : "+v"(tid));
    const int wave = __builtin_amdgcn_readfirstlane(tid >> 6), lane = tid & 63, fr = lane & 15, fq = lane >> 4;
    const int b = bg >> 5, g4 = (bg >> 2) & 7, part = bg & 3, g = 4 * g4 + (wave & 3);
    bg = b * 32 + g;
    unsigned char* xs = lds + wave * 4352;
    S5W w; s5w_setup(a, g, fr, fq, w);
    bf16x8 cf[4]; s5_cfrag(a, g, fr, fq, cf);
    const float Dg = a.in[20][g * 16 + fr];
    float pr[4], pi[4];
#pragma unroll
    for (int j = 0; j < 4; ++j) { pr[j] = w.lr[j]; pi[j] = w.li[j];
#pragma unroll
        for (int s = 0; s < 7; ++s) { const float nr = pr[j] * pr[j] - pi[j] * pi[j], ni = 2.f * pr[j] * pi[j]; pr[j] = nr; pi[j] = ni; } }
    const float* e = (const float*)(a.ws + WS_S5E) + (size_t)bg * 64 * 128;
    for (int uu = 0; uu < 2; ++uu) {
        const int sg = 4 * part + 2 * (wave >> 2) + uu, seg = 4 * sg + fq;
        float xr[4] = {0.f, 0.f, 0.f, 0.f}, xi[4] = {0.f, 0.f, 0.f, 0.f};
        for (int s = 0; s < 4 * sg + 3; ++s) {
            if (s < seg) {
#pragma unroll
                for (int j = 0; j < 4; ++j) { const float er = e[s * 128 + 16 * j + fr], ei = e[s * 128 + 64 + 16 * j + fr];
                    const float nr = pr[j] * xr[j] - pi[j] * xi[j] + er, ni = pr[j] * xi[j] + pi[j] * xr[j] + ei; xr[j] = nr; xi[j] = ni; }
            }
        }
        s5w_run(a, w, cf, Dg, xs, (size_t)b * 8192 + sg * 512, 128, 32, g, fr, fq, xr, xi);
        if (seg == 63) {
#pragma unroll
            for (int j = 0; j < 4; ++j) { a.out[O_PSR + (size_t)bg * 64 + 16 * j + fr] = xr[j]; a.out[O_PSI + (size_t)bg * 64 + 16 * j + fr] = xi[j]; }
        }
    }
}
DI void s5_pass2_sample(const Args& a, unsigned char* xs, int gw, int NGW, int lane) {
    asm volatile("" : "+v"(lane));
    const int fr = lane & 15, fq = lane >> 4;
    for (int unit = gw; unit < 256; unit += NGW) {
        const int g = unit & 31, q = unit >> 5, sb = 4 * q + fq;
        S5W w; s5w_setup(a, g, fr, fq, w);
        bf16x8 cf[4]; s5_cfrag(a, g, fr, fq, cf);
        const float Dg = a.in[20][g * 16 + fr];
        float xr[4], xi[4];
#pragma unroll
        for (int j = 0; j < 4; ++j) { xr[j] = a.in[4][(size_t)(sb * 32 + g) * 64 + 16 * j + fr]; xi[j] = a.in[5][(size_t)(sb * 32 + g) * 64 + 16 * j + fr]; }
        s5w_run(a, w, cf, Dg, xs, (size_t)TP + (size_t)q * 64, 16, 4, g, fr, fq, xr, xi);
#pragma unroll
        for (int j = 0; j < 4; ++j) { a.out[O_SSR + (size_t)(sb * 32 + g) * 64 + 16 * j + fr] = xr[j]; a.out[O_SSI + (size_t)(sb * 32 + g) * 64 + 16 * j + fr] = xi[j]; }
    }
}

struct S5Par { float lr, li; float bbr[16], bbi[16]; };
DI void s5_setup(const Args& a, int g, int p, S5Par& q) {
    const float are = a.in[13][g * 64 + p], aim = a.in[14][g * 64 + p], dt = __expf(a.in[15][g]);
    const float mag = __expf(are * dt), ang = aim * dt;
    float sn, cs; sincosf(ang, &sn, &cs);
    q.lr = mag * cs; q.li = mag * sn;
    const float den = are * are + aim * aim;
    const float fre = ((q.lr - 1.f) * are + q.li * aim) / den, fim = (q.li * are - (q.lr - 1.f) * aim) / den;
    const f32x4* br = (const f32x4*)(a.in[16] + (size_t)(g * 64 + p) * 16); const f32x4* bi = (const f32x4*)(a.in[17] + (size_t)(g * 64 + p) * 16);
#pragma unroll
    for (int j = 0; j < 4; ++j) { const f32x4 r = br[j], i = bi[j];
#pragma unroll
        for (int e = 0; e < 4; ++e) { q.bbr[4 * j + e] = fre * r[e] - fim * i[e]; q.bbi[4 * j + e] = fre * i[e] + fim * r[e]; } }
}
DI void s5_step4(const S5Par& q, float uv, float& xr, float& xi, unsigned (&xo)[4]) {
#pragma unroll
    for (int j = 0; j < 4; ++j) {
        float br = 0.f, bi = 0.f;
#pragma unroll
        for (int h = 0; h < 16; ++h) { const float uh = __int_as_float(__builtin_amdgcn_readlane(__float_as_int(uv), 16 * j + h)); br += q.bbr[h] * uh; bi += q.bbi[h] * uh; }
        const float nr = q.lr * xr - q.li * xi + br, ni = q.lr * xi + q.li * xr + bi;
        xr = nr; xi = ni; xo[j] = pk2(xr, xi);
    }
}
DI void old_s5_pass1(const Args& a, int gw, int NGW, int lane) {
    asm volatile("" : "+v"(lane));
    const bf16* P = (const bf16*)(a.ws + WS_P);
    float* E = (float*)(a.ws + WS_S5E);
    for (int unit = gw; unit < 4 * 32 * 64; unit += NGW) {
        const int seg = unit & 63, bg = unit >> 6, g = bg & 31, b = bg >> 5;
        S5Par q; s5_setup(a, g, lane, q);
        float xr = 0.f, xi = 0.f; unsigned xo[4];
        const bf16* up = P + (size_t)(b * 8192 + seg * 128 + (lane >> 4)) * PW + 2048 + g * 16 + (lane & 15);
#pragma unroll 2
        for (int t = 0; t < 128; t += 4) { const float uv = b2f(up[(size_t)t * PW]); s5_step4(q, uv, xr, xi, xo); }
        float* e = E + ((size_t)bg * 64 + seg) * 128;
        e[lane] = xr; e[64 + lane] = xi;
    }
}
DI void old_s5_pass2(const Args& a, unsigned char* xs  , int gw, int NGW, int lane) {
    asm volatile("" : "+v"(lane));
    const bf16* P = (const bf16*)(a.ws + WS_P);
    const float* E = (const float*)(a.ws + WS_S5E);
    bf16* Y5 = (bf16*)(a.ws + WS_Y5);
    const int fr = lane & 15, fq = lane >> 4;
    for (int unit = gw; unit < OLD_S5_ULIM; unit += NGW) {
        int g, row0, ntok, seg = 0, bg; bool sample;
        if (unit < 8192) { seg = unit & 63; bg = unit >> 6; g = bg & 31; row0 = (bg >> 5) * 8192 + seg * 128; ntok = 128; sample = false; }
        else { bg = unit - 8192; g = bg & 31; row0 = TP + (bg >> 5) * 16; ntok = 16; sample = true; }
        S5Par q; s5_setup(a, g, lane, q);
        float xr = 0.f, xi = 0.f;
        if (sample) { xr = a.in[4][(size_t)bg * 64 + lane]; xi = a.in[5][(size_t)bg * 64 + lane]; }
        else {
            float pr = q.lr, pi = q.li;
#pragma unroll
            for (int s = 0; s < 7; ++s) { const float nr = pr * pr - pi * pi, ni = 2.f * pr * pi; pr = nr; pi = ni; }
            const float* e = E + (size_t)bg * 64 * 128;
            for (int s = 0; s < seg; ++s) { const float er = e[s * 128 + lane], ei = e[s * 128 + 64 + lane]; const float nr = pr * xr - pi * xi + er, ni = pr * xi + pi * xr + ei; xr = nr; xi = ni; }
        }
        bf16x8 cf[4];
#pragma unroll
        for (int ks = 0; ks < 4; ++ks) {
            const f32x4 cr = *(const f32x4*)(a.in[18] + (size_t)(g * 16 + fr) * 64 + 16 * ks + 4 * fq), ci = *(const f32x4*)(a.in[19] + (size_t)(g * 16 + fr) * 64 + 16 * ks + 4 * fq);
            u32x4 w; w.x = pk2(cr[0], -ci[0]); w.y = pk2(cr[1], -ci[1]); w.z = pk2(cr[2], -ci[2]); w.w = pk2(cr[3], -ci[3]);
            cf[ks] = __builtin_bit_cast(bf16x8, w);
        }
        const float Dg = a.in[20][g * 16 + fr];
        const bf16* up = P + (size_t)(row0 + (lane >> 4)) * PW + 2048 + g * 16 + (lane & 15);
        for (int tb = 0; tb < ntok; tb += 16) {
#pragma unroll
            for (int j4 = 0; j4 < 4; ++j4) {
                const float uv = b2f(up[(size_t)(tb + 4 * j4) * PW]);
                unsigned xo[4]; s5_step4(q, uv, xr, xi, xo);
#pragma unroll
                for (int j = 0; j < 4; ++j) *(unsigned*)(xs + (4 * j4 + j) * 272 + lane * 4) = xo[j];
            }
            f32x4 y = (f32x4){0.f, 0.f, 0.f, 0.f};
#pragma unroll
            for (int ks = 0; ks < 4; ++ks) { const bf16x8 af = *(const bf16x8*)(xs + fr * 272 + ks * 64 + fq * 16); y = MFMA16(af, cf[ks], y); }
#pragma unroll
            for (int i = 0; i < 4; ++i) {
                const size_t row = (size_t)row0 + tb + 4 * fq + i;
                const float uu = b2f(P[row * PW + 2048 + g * 16 + fr]);
                Y5[row * 512 + g * 16 + fr] = f2b(gelu_tanh(y[i] + Dg * uu));
            }
        }
        if (sample) { a.out[O_SSR + (size_t)bg * 64 + lane] = xr; a.out[O_SSI + (size_t)bg * 64 + lane] = xi; }
        else if (seg == 63) { a.out[O_PSR + (size_t)bg * 64 + lane] = xr; a.out[O_PSI + (size_t)bg * 64 + lane] = xi; }
    }
}

DI void s5_pass2b(const Args& a, unsigned char* xs, int gw, int NGW, int lane) {
    asm volatile("" : "+v"(lane));
    const bf16* P = (const bf16*)(a.ws + WS_P);
    const float* E = (const float*)(a.ws + WS_S5E);
    bf16* Y5 = (bf16*)(a.ws + WS_Y5);
    const int fr = lane & 15, fq = lane >> 4;
    for (int unit = gw; unit < 4 * 32 * 64 + 32 * 32; unit += NGW) {
        int g, row0, ntok, seg = 0, bg; bool sample;
        if (unit < 8192) { seg = unit & 63; bg = unit >> 6; g = bg & 31; row0 = (bg >> 5) * 8192 + seg * 128; ntok = 128; sample = false; }
        else { bg = unit - 8192; g = bg & 31; row0 = TP + (bg >> 5) * 16; ntok = 16; sample = true; }
        S5Par q; s5_setup(a, g, lane, q);
        float xr = 0.f, xi = 0.f;
        if (sample) { xr = a.in[4][(size_t)bg * 64 + lane]; xi = a.in[5][(size_t)bg * 64 + lane]; }
        else {
            float pr = q.lr, pi = q.li;
#pragma unroll
            for (int s = 0; s < 7; ++s) { const float nr = pr * pr - pi * pi, ni = 2.f * pr * pi; pr = nr; pi = ni; }
            const float* e = E + (size_t)bg * 64 * 128;
            for (int s0 = 0; s0 < seg; s0 += 8) {
                float er[8], ei[8];
#pragma unroll
                for (int k = 0; k < 8; ++k) { const bool ok = s0 + k < seg; er[k] = ok ? e[(s0 + k) * 128 + lane] : 0.f; ei[k] = ok ? e[(s0 + k) * 128 + 64 + lane] : 0.f; }
#pragma unroll
                for (int k = 0; k < 8; ++k) if (s0 + k < seg) { const float nr = pr * xr - pi * xi + er[k], ni = pr * xi + pi * xr + ei[k]; xr = nr; xi = ni; }
            }
        }
        bf16x8 cf[4];
#pragma unroll
        for (int ks = 0; ks < 4; ++ks) {
            const f32x4 cr = *(const f32x4*)(a.in[18] + (size_t)(g * 16 + fr) * 64 + 16 * ks + 4 * fq), ci = *(const f32x4*)(a.in[19] + (size_t)(g * 16 + fr) * 64 + 16 * ks + 4 * fq);
            u32x4 w; w.x = pk2(cr[0], -ci[0]); w.y = pk2(cr[1], -ci[1]); w.z = pk2(cr[2], -ci[2]); w.w = pk2(cr[3], -ci[3]);
            cf[ks] = __builtin_bit_cast(bf16x8, w);
        }
        const float Dg = a.in[20][g * 16 + fr];
        S5W w; s5w_setup(a, g, fr, fq, w);
        unsigned char* bt = xs + 4352;
        for (int tb = 0; tb < ntok; tb += 16) {
            {
                u32x4 uv = (u32x4){0u, 0u, 0u, 0u};
                if (fq < 2) uv = *(const u32x4*)(P + (size_t)(row0 + tb + fr) * PW + 2048 + g * 16 + 8 * fq);
                const bf16x8 ua = __builtin_bit_cast(bf16x8, uv);
                const f32x4 z = (f32x4){0.f, 0.f, 0.f, 0.f};
#pragma unroll
                for (int j = 0; j < 4; ++j) {
                    const f32x4 br = MFMA16(ua, w.bf[j], z), bi = MFMA16(ua, w.bf[4 + j], z);
                    *(f32x4*)(bt + (16 * j + fr) * 80 + fq * 16) = br; *(f32x4*)(bt + (64 + 16 * j + fr) * 80 + fq * 16) = bi;
                }
            }
            asm volatile("s_waitcnt lgkmcnt(0)" ::: "memory");
            f32x4 bre[4], bim[4];
#pragma unroll
            for (int k = 0; k < 4; ++k) { bre[k] = *(const f32x4*)(bt + lane * 80 + k * 16); bim[k] = *(const f32x4*)(bt + (64 + lane) * 80 + k * 16); }
            asm volatile("s_waitcnt lgkmcnt(0)" ::: "memory");
#pragma unroll
            for (int t = 0; t < 16; ++t) {
                const float nr = q.lr * xr - q.li * xi + bre[t >> 2][t & 3], ni = q.lr * xi + q.li * xr + bim[t >> 2][t & 3];
                xr = nr; xi = ni;
                *(unsigned*)(xs + t * 272 + lane * 4) = pk2(nr, ni);
            }
            asm volatile("s_waitcnt lgkmcnt(0)" ::: "memory");
            f32x4 y = (f32x4){0.f, 0.f, 0.f, 0.f};
#pragma unroll
            for (int ks = 0; ks < 4; ++ks) { const bf16x8 af = *(const bf16x8*)(xs + fr * 272 + ks * 64 + fq * 16); y = MFMA16(af, cf[ks], y); }
#pragma unroll
            for (int i = 0; i < 4; ++i) {
                const size_t row = (size_t)row0 + tb + 4 * fq + i;
                const float uu = b2f(P[row * PW + 2048 + g * 16 + fr]);
                Y5[row * 512 + g * 16 + fr] = f2b(gelu_tanh(y[i] + Dg * uu));
            }
        }
        if (sample) { a.out[O_SSR + (size_t)bg * 64 + lane] = xr; a.out[O_SSI + (size_t)bg * 64 + lane] = xi; }
        else if (seg == 63) { a.out[O_PSR + (size_t)bg * 64 + lane] = xr; a.out[O_PSI + (size_t)bg * 64 + lane] = xi; }
    }
}

constexpr int DB_WN = 0, DB_QG = 17408, DB_KDT = 34816, DB_QK = 53248, DB_U0 = 62464;
constexpr int DBP_SIZE = DB_U0 + 64 * 80;
constexpr int DBS_SIZE = DB_U0 + 64 * 272;
template <int NC> struct DnRegs { u32x4 r[7]; u32x4 u[NC == 32 ? 1 : 2]; };
template <int NC> DI void dn_load(const unsigned char* rec, int tid, int c0, DnRegs<NC>& R) {
    const u32x4* g = (const u32x4*)rec;
    R.r[0] = g[tid]; R.r[1] = g[tid + 512]; R.r[2] = g[1024 + tid]; R.r[3] = g[1024 + tid + 512]; R.r[4] = g[2048 + tid]; R.r[5] = g[2048 + tid + 512]; R.r[6] = g[3072 + tid];
    if (NC == 32) { if (tid < 256) R.u[0] = *(const u32x4*)(rec + R_U0 + (tid >> 2) * 256 + c0 * 2 + (tid & 3) * 16); }
    else { R.u[0] = *(const u32x4*)(rec + R_U0 + tid * 16); R.u[1] = *(const u32x4*)(rec + R_U0 + (tid + 512) * 16); }
}
template <int NC> DI void dn_store(unsigned char* buf, int tid, const DnRegs<NC>& R) {
#pragma unroll
    for (int j = 0; j < 2; ++j) { const int q = tid + 512 * j;
        *(u32x4*)(buf + DB_WN + (q >> 4) * 272 + (q & 15) * 16) = R.r[j];
        *(u32x4*)(buf + DB_QG + (q >> 4) * 272 + (q & 15) * 16) = R.r[2 + j];
        *(u32x4*)(buf + DB_KDT + (q >> 3) * 144 + (q & 7) * 16) = R.r[4 + j]; }
    *(u32x4*)(buf + DB_QK + (tid >> 3) * 144 + (tid & 7) * 16) = R.r[6];
    if (NC == 32) { if (tid < 256) *(u32x4*)(buf + DB_U0 + (tid >> 2) * 80 + (tid & 3) * 16) = R.u[0]; }
    else {
#pragma unroll
        for (int j = 0; j < 2; ++j) { const int q = tid + 512 * j; *(u32x4*)(buf + DB_U0 + (q >> 4) * 272 + (q & 15) * 16) = R.u[j]; }
    }
}
DI bf16x8 pack8(const f32x4& lo, const f32x4& hi) { u32x4 w; w.x = pk2(lo[0], lo[1]); w.y = pk2(lo[2], lo[3]); w.z = pk2(hi[0], hi[1]); w.w = pk2(hi[2], hi[3]); return __builtin_bit_cast(bf16x8, w); }
template <int UPI> DI void dn_step(const unsigned char* buf, f32x4 (&S)[8], const unsigned char* u0, float eg, int fr, int fq, f32x4 (&o)[4]) {
    bf16x8 Sb[4];
#pragma unroll
    for (int ks = 0; ks < 4; ++ks) Sb[ks] = pack8(S[2 * ks], S[2 * ks + 1]);
    f32x4 u[4];
#pragma unroll
    for (int mt = 0; mt < 4; ++mt) {
#pragma unroll
        for (int i = 0; i < 4; ++i) u[mt][i] = b2f(*(const bf16*)(u0 + (16 * mt + 4 * fq + i) * UPI));
#pragma unroll
        for (int ks = 0; ks < 4; ++ks) u[mt] = MFMA16(*(const bf16x8*)(buf + DB_WN + (16 * mt + fr) * 272 + ks * 64 + fq * 16), Sb[ks], u[mt]);
    }
    bf16x8 ub[2];
#pragma unroll
    for (int k2 = 0; k2 < 2; ++k2) ub[k2] = pack8(u[2 * k2], u[2 * k2 + 1]);
#pragma unroll
    for (int mt = 0; mt < 4; ++mt) {
        o[mt] = (f32x4){0.f, 0.f, 0.f, 0.f};
#pragma unroll
        for (int ks = 0; ks < 4; ++ks) o[mt] = MFMA16(*(const bf16x8*)(buf + DB_QG + (16 * mt + fr) * 272 + ks * 64 + fq * 16), Sb[ks], o[mt]);
#pragma unroll
        for (int k2 = 0; k2 < 2; ++k2) o[mt] = MFMA16(*(const bf16x8*)(buf + DB_QK + (16 * mt + fr) * 144 + k2 * 64 + fq * 16), ub[k2], o[mt]);
    }
#pragma unroll
    for (int m8 = 0; m8 < 8; ++m8) {
        S[m8] = S[m8] * eg;
#pragma unroll
        for (int k2 = 0; k2 < 2; ++k2) S[m8] = MFMA16(*(const bf16x8*)(buf + DB_KDT + (16 * m8 + fr) * 144 + k2 * 64 + fq * 16), ub[k2], S[m8]);
    }
}
#if DN_STAGED == 2
#define DNP_SYNC() do { asm volatile("s_waitcnt lgkmcnt(0)" ::: "memory"); __builtin_amdgcn_sched_barrier(0); } while (0)
#else
#define DNP_SYNC() do { } while (0)
#endif
DI void dn_step_p(const unsigned char* buf, f32x4 (&S)[8], const unsigned char* u0, float eg, int fr, int fq, f32x4 (&o)[4]) {
    const unsigned char* aw = buf + DB_WN + fr * 272 + fq * 16;
    const unsigned char* aq = buf + DB_QG + fr * 272 + fq * 16;
    const unsigned char* ak = buf + DB_KDT + fr * 144 + fq * 16;
    const unsigned char* ac = buf + DB_QK + fr * 144 + fq * 16;
    bf16x8 f1[16], f2[16], Sb[4], ub[2];
    f32x4 u[4];
#pragma unroll
    for (int mt = 0; mt < 4; ++mt)
#pragma unroll
        for (int ks = 0; ks < 4; ++ks) f1[4 * mt + ks] = *(const bf16x8*)(aw + mt * 4352 + ks * 64);
#pragma unroll
    for (int mt = 0; mt < 4; ++mt)
#pragma unroll
        for (int i = 0; i < 4; ++i) u[mt][i] = b2f(*(const bf16*)(u0 + (16 * mt + 4 * fq + i) * 80));
#pragma unroll
    for (int ks = 0; ks < 4; ++ks) Sb[ks] = pack8(S[2 * ks], S[2 * ks + 1]);
    __builtin_amdgcn_sched_barrier(0);
#pragma unroll
    for (int mt = 0; mt < 4; ++mt)
#pragma unroll
        for (int ks = 0; ks < 4; ++ks) f2[4 * mt + ks] = *(const bf16x8*)(aq + mt * 4352 + ks * 64);
    DNP_SYNC();
#pragma unroll
    for (int ks = 0; ks < 4; ++ks)
#pragma unroll
        for (int mt = 0; mt < 4; ++mt) u[mt] = MFMA16(f1[4 * mt + ks], Sb[ks], u[mt]);
    __builtin_amdgcn_sched_barrier(0);
#pragma unroll
    for (int k2 = 0; k2 < 2; ++k2) ub[k2] = pack8(u[2 * k2], u[2 * k2 + 1]);
#pragma unroll
    for (int m8 = 0; m8 < 8; ++m8)
#pragma unroll
        for (int k2 = 0; k2 < 2; ++k2) f1[2 * m8 + k2] = *(const bf16x8*)(ak + m8 * 2304 + k2 * 64);
    DNP_SYNC();
#pragma unroll
    for (int mt = 0; mt < 4; ++mt) o[mt] = (f32x4){0.f, 0.f, 0.f, 0.f};
#pragma unroll
    for (int ks = 0; ks < 4; ++ks)
#pragma unroll
        for (int mt = 0; mt < 4; ++mt) o[mt] = MFMA16(f2[4 * mt + ks], Sb[ks], o[mt]);
    __builtin_amdgcn_sched_barrier(0);
#pragma unroll
    for (int mt = 0; mt < 4; ++mt)
#pragma unroll
        for (int k2 = 0; k2 < 2; ++k2) f2[2 * mt + k2] = *(const bf16x8*)(ac + mt * 2304 + k2 * 64);
    DNP_SYNC();
#pragma unroll
    for (int m8 = 0; m8 < 8; ++m8) S[m8] = S[m8] * eg;
#pragma unroll
    for (int k2 = 0; k2 < 2; ++k2)
#pragma unroll
        for (int m8 = 0; m8 < 8; ++m8) S[m8] = MFMA16(f1[2 * m8 + k2], ub[k2], S[m8]);
    __builtin_amdgcn_sched_barrier(0);
#pragma unroll
    for (int k2 = 0; k2 < 2; ++k2)
#pragma unroll
        for (int mt = 0; mt < 4; ++mt) o[mt] = MFMA16(f2[2 * mt + k2], ub[k2], o[mt]);
}
DI void dn_step_o(const unsigned char* buf, f32x4 (&S)[8], const unsigned char* u0, float eg, int fr, int fq, f32x4 (&o)[4]) {
    const unsigned char* aw = buf + DB_WN + fr * 272 + fq * 16;
    const unsigned char* aq = buf + DB_QG + fr * 272 + fq * 16;
    const unsigned char* ak = buf + DB_KDT + fr * 144 + fq * 16;
    const unsigned char* ac = buf + DB_QK + fr * 144 + fq * 16;
    bf16x8 f1[16], f2[16], Sb[4], ub[2];
    f32x4 u[4];
#pragma unroll
    for (int ks = 0; ks < 4; ++ks) Sb[ks] = pack8(S[2 * ks], S[2 * ks + 1]);
    __builtin_amdgcn_sched_barrier(0);
#pragma unroll
    for (int mt = 0; mt < 4; ++mt)
#pragma unroll
        for (int ks = 0; ks < 4; ++ks) f1[4 * mt + ks] = *(const bf16x8*)(aw + mt * 4352 + ks * 64);
#pragma unroll
    for (int mt = 0; mt < 4; ++mt)
#pragma unroll
        for (int i = 0; i < 4; ++i) u[mt][i] = b2f(*(const bf16*)(u0 + (16 * mt + 4 * fq + i) * 80));
#pragma unroll
    for (int mt = 0; mt < 4; ++mt)
#pragma unroll
        for (int ks = 0; ks < 4; ++ks) f2[4 * mt + ks] = *(const bf16x8*)(aq + mt * 4352 + ks * 64);
    __builtin_amdgcn_sched_barrier(0);
#pragma unroll
    for (int ks = 0; ks < 4; ++ks)
#pragma unroll
        for (int mt = 0; mt < 4; ++mt) u[mt] = MFMA16(f1[4 * mt + ks], Sb[ks], u[mt]);
    __builtin_amdgcn_sched_barrier(0);
#pragma unroll
    for (int k2 = 0; k2 < 2; ++k2) ub[k2] = pack8(u[2 * k2], u[2 * k2 + 1]);
    __builtin_amdgcn_sched_barrier(0);
#pragma unroll
    for (int m8 = 0; m8 < 8; ++m8)
#pragma unroll
        for (int k2 = 0; k2 < 2; ++k2) f1[2 * m8 + k2] = *(const bf16x8*)(ak + m8 * 2304 + k2 * 64);
#pragma unroll
    for (int mt = 0; mt < 4; ++mt) o[mt] = (f32x4){0.f, 0.f, 0.f, 0.f};
#pragma unroll
    for (int ks = 0; ks < 4; ++ks)
#pragma unroll
        for (int mt = 0; mt < 4; ++mt) o[mt] = MFMA16(f2[4 * mt + ks], Sb[ks], o[mt]);
    __builtin_amdgcn_sched_barrier(0);
    { float dmy = (o[0][0] + o[1][0]) + (o[2][0] + o[3][0]); asm volatile("" :: "v"(dmy)); }
    __builtin_amdgcn_sched_barrier(0);
#pragma unroll
    for (int mt = 0; mt < 4; ++mt)
#pragma unroll
        for (int k2 = 0; k2 < 2; ++k2) f2[2 * mt + k2] = *(const bf16x8*)(ac + mt * 2304 + k2 * 64);
#pragma unroll
    for (int m8 = 0; m8 < 8; ++m8) S[m8] = S[m8] * eg;
#pragma unroll
    for (int k2 = 0; k2 < 2; ++k2)
#pragma unroll
        for (int m8 = 0; m8 < 8; ++m8) S[m8] = MFMA16(f1[2 * m8 + k2], ub[k2], S[m8]);
    __builtin_amdgcn_sched_barrier(0);
#pragma unroll
    for (int k2 = 0; k2 < 2; ++k2)
#pragma unroll
        for (int mt = 0; mt < 4; ++mt) o[mt] = MFMA16(f2[2 * mt + k2], ub[k2], o[mt]);
}
DI void dn_piece(int q, int c0, unsigned& src, unsigned& dst) {
    if (q < 1024) { src = R_WN + q * 16; dst = DB_WN + (q >> 4) * 272 + (q & 15) * 16; }
    else if (q < 2048) { const int p = q - 1024; src = R_QG + p * 16; dst = DB_QG + (p >> 4) * 272 + (p & 15) * 16; }
    else if (q < 3072) { const int p = q - 2048; src = R_KDT + p * 16; dst = DB_KDT + (p >> 3) * 144 + (p & 7) * 16; }
    else if (q < 3584) { const int p = q - 3072; src = R_QK + p * 16; dst = DB_QK + (p >> 3) * 144 + (p & 7) * 16; }
    else { const int p = q - 3584; src = R_U0 + (p >> 2) * 256 + c0 * 2 + (p & 3) * 16; dst = DB_U0 + (p >> 2) * 80 + (p & 3) * 16; }
}
#define DN_LD(R, base) do { _Pragma("unroll") for (int k = 0; k < 10; ++k) { unsigned s_, d_; dn_piece(lt + 384 * k, c0, s_, d_); R[k] = *(const u32x4*)((base) + s_); } } while (0)
#define DN_WAIT(R, cnt) do { } while (0)
#define DN_ST(R, buf) do { _Pragma("unroll") for (int k = 0; k < 10; ++k) { unsigned s_, d_; dn_piece(lt + 384 * k, c0, s_, d_); *(u32x4*)((buf) + d_) = R[k]; } } while (0)
#define DN_BAR() do { asm volatile("s_waitcnt lgkmcnt(0)" ::: "memory"); __builtin_amdgcn_s_barrier(); asm volatile("" ::: "memory"); } while (0)
DI void dn_scan_prompt(const Args& a, unsigned char* lds, int tid) {
    asm volatile("" : "+v"(tid));
    const int wave = __builtin_amdgcn_readfirstlane(tid >> 6), lane = tid & 63, fr = lane & 15, fq = lane >> 4;
    const int bh = blockIdx.x >> 2, qt = blockIdx.x & 3, b = bh >> 2, h = bh & 3;
    const int c0 = qt * 32, v0 = c0 + (wave & 1) * 16;
    const unsigned char* recs = a.ws + WS_DNC + (size_t)bh * 128 * REC;
    const float* egs = (const float*)(a.ws + WS_EG) + bh * 128;
    float* ORAW = (float*)(a.ws + WS_H);
    const bool loader = wave >= 2;
    const int lt = tid - 128;
    f32x4 S[8];
#pragma unroll
    for (int m8 = 0; m8 < 8; ++m8) S[m8] = (f32x4){0.f, 0.f, 0.f, 0.f};
    float egA = egs[lane], egB = egs[64 + lane];
    asm volatile("s_waitcnt vmcnt(0)" : "+v"(egA), "+v"(egB) :: "memory");
    if (loader) {
        const int grp = wave >= 5 ? 1 : 0, lt2 = tid - 128 - grp * 192;
        u32x4 R[20];
        unsigned srcs[20], dsts[20];
        _Pragma("unroll") for (int k = 0; k < 20; ++k) dn_piece(lt2 + 192 * k, c0, srcs[k], dsts[k]);
#define DN_LD20(base) do { _Pragma("unroll") for (int k = 0; k < 20; ++k) R[k] = *(const u32x4*)((base) + srcs[k]); } while (0)
#define DN_ST20(buf) do { _Pragma("unroll") for (int k = 0; k < 20; ++k) *(u32x4*)((buf) + dsts[k]) = R[k]; } while (0)
        if (grp == 0) { DN_LD20(recs); DN_ST20(lds); DN_LD20(recs + 2 * (size_t)REC); }
        else { DN_LD20(recs + REC); }
        DN_BAR();
        for (int n = 0; n < 128; n += 2) {
            if (grp == 1) { DN_ST20(lds + DBP_SIZE); if (n + 3 < 128) DN_LD20(recs + (size_t)(n + 3) * REC); }
            DN_BAR();
            if (grp == 0 && n + 2 < 128) { DN_ST20(lds); if (n + 4 < 128) DN_LD20(recs + (size_t)(n + 4) * REC); }
            DN_BAR();
        }
#undef DN_LD20
#undef DN_ST20
    } else {
        DN_BAR();
        for (int n = 0; n < 128; ++n) {
            const float eg0 = __int_as_float(__builtin_amdgcn_readlane(__float_as_int(n < 64 ? egA : egB), n & 63));
            f32x4 o[4];
#if DN_STAGED == 3
            dn_step_o(lds + (n & 1) * DBP_SIZE, S, lds + (n & 1) * DBP_SIZE + DB_U0 + ((wave & 1) * 16 + fr) * 2, eg0, fr, fq, o);
#elif DN_STAGED
            dn_step_p(lds + (n & 1) * DBP_SIZE, S, lds + (n & 1) * DBP_SIZE + DB_U0 + ((wave & 1) * 16 + fr) * 2, eg0, fr, fq, o);
#else
            dn_step<80>(lds + (n & 1) * DBP_SIZE, S, lds + (n & 1) * DBP_SIZE + DB_U0 + ((wave & 1) * 16 + fr) * 2, eg0, fr, fq, o);
#endif
            float* op = ORAW + (size_t)(b * 8192 + n * 64) * 512 + h * 128 + v0 + fr;
#pragma unroll
            for (int mt = 0; mt < 4; ++mt)
#pragma unroll
                for (int i = 0; i < 4; ++i) op[(size_t)(16 * mt + 4 * fq + i) * 512] = o[mt][i];
            DN_BAR();
        }
    }
    if (!loader) {
        float* so = a.out + O_PDS + (size_t)bh * 128 * 128 + v0 + fr;
#pragma unroll
        for (int m8 = 0; m8 < 8; ++m8)
#pragma unroll
            for (int i = 0; i < 4; ++i) so[(16 * m8 + 4 * fq + i) * 128] = S[m8][i];
    }
    __syncthreads();
}
DI void dn_scan_sample(const Args& a, unsigned char* lds, int tid, int su0, int su1, int sus) {
    asm volatile("" : "+v"(tid));
    const int wave = __builtin_amdgcn_readfirstlane(tid >> 6), lane = tid & 63, fr = lane & 15, fq = lane >> 4;
    const int v0 = wave * 16;
    float* ORAW = (float*)(a.ws + WS_H);
    for (int su = su0; su < su1; su += sus) {
        const int sb = su >> 2, h = su & 3;
        const unsigned char* rec = a.ws + WS_DNC + (size_t)(2048 + su) * REC;
        DnRegs<128> R; dn_load<128>(rec, tid, 0, R); dn_store<128>(lds, tid, R);
        __syncthreads();
        f32x4 S[8];
        const float* s0 = a.in[3] + (size_t)su * 128 * 128 + v0 + fr;
#pragma unroll
        for (int m8 = 0; m8 < 8; ++m8)
#pragma unroll
            for (int i = 0; i < 4; ++i) S[m8][i] = s0[(16 * m8 + 4 * fq + i) * 128];
        f32x4 o[4];
        dn_step<272>(lds, S, lds + DB_U0 + (v0 + fr) * 2, ((const float*)(a.ws + WS_EG))[2048 + su], fr, fq, o);
        float* op = ORAW + (size_t)(TP + sb * 16) * 512 + h * 128 + v0 + fr;
#pragma unroll
        for (int i = 0; i < 4; ++i) op[(size_t)(4 * fq + i) * 512] = o[0][i];
        float* so = a.out + O_SDS + (size_t)su * 128 * 128 + v0 + fr;
#pragma unroll
        for (int m8 = 0; m8 < 8; ++m8)
#pragma unroll
            for (int i = 0; i < 4; ++i) so[(16 * m8 + 4 * fq + i) * 128] = S[m8][i];
        __syncthreads();
    }
}

DI void mix_phase(const Args& a, int gw, int NGW, int lane) {
    asm volatile("" : "+v"(lane));
    const float* ORAW = (const float*)(a.ws + WS_H);
    const bf16* P = (const bf16*)(a.ws + WS_P);
    const bf16* GLU = (const bf16*)(a.ws + WS_GLU);
    bf16* MIX = (bf16*)(a.ws + WS_DNC);
    const f32x2 dg = *(const f32x2*)(a.in[12] + 2 * lane);
    const f32x4 sg0 = *(const f32x4*)(a.in[23] + 8 * lane), sg1 = *(const f32x4*)(a.in[23] + 8 * lane + 4);
    constexpr int NR = 4;
    for (int row0 = gw; row0 < T; row0 += NR * NGW) {
        f32x2 ov[NR][4]; unsigned zz[NR][4]; u32x4 gv[NR]; float ssq[NR][5];
#pragma unroll
        for (int r = 0; r < NR; ++r) { const size_t row = row0 + r * NGW < T ? row0 + r * NGW : row0;
#pragma unroll
            for (int h = 0; h < 4; ++h) { ov[r][h] = *(const f32x2*)(ORAW + row * 512 + h * 128 + 2 * lane); zz[r][h] = *(const unsigned*)(P + row * PW + 1536 + h * 128 + 2 * lane); }
            gv[r] = *(const u32x4*)(GLU + row * 512 + 8 * lane); }
#pragma unroll
        for (int r = 0; r < NR; ++r) {
#pragma unroll
            for (int h = 0; h < 4; ++h) ssq[r][h] = ov[r][h].x * ov[r][h].x + ov[r][h].y * ov[r][h].y;
            const float v[8] = {blo(gv[r].x), bhi(gv[r].x), blo(gv[r].y), bhi(gv[r].y), blo(gv[r].z), bhi(gv[r].z), blo(gv[r].w), bhi(gv[r].w)};
            float ss = 0.f;
#pragma unroll
            for (int e = 0; e < 8; ++e) ss += v[e] * v[e];
            ssq[r][4] = ss; }
#pragma unroll
        for (int o = 1; o < 64; o <<= 1)
#pragma unroll
            for (int r = 0; r < NR; ++r)
#pragma unroll
                for (int k = 0; k < 5; ++k) ssq[r][k] += __shfl_xor(ssq[r][k], o);
#pragma unroll
        for (int r = 0; r < NR; ++r) if (r == 0 || row0 + r * NGW < T) { const size_t row = row0 + r * NGW;
#pragma unroll
            for (int h = 0; h < 4; ++h) { const float rr = rsqrtf(ssq[r][h] * (1.f / 128.f) + EPS);
                *(unsigned*)(MIX + row * DM + h * 128 + 2 * lane) = pk2(ov[r][h].x * rr * dg.x * silu(blo(zz[r][h])), ov[r][h].y * rr * dg.y * silu(bhi(zz[r][h]))); }
            const float v[8] = {blo(gv[r].x), bhi(gv[r].x), blo(gv[r].y), bhi(gv[r].y), blo(gv[r].z), bhi(gv[r].z), blo(gv[r].w), bhi(gv[r].w)};
            const float r5 = rsqrtf(ssq[r][4] * (1.f / 512.f) + EPS);
            u32x4 w; w.x = pk2(v[0] * r5 * sg0[0], v[1] * r5 * sg0[1]); w.y = pk2(v[2] * r5 * sg0[2], v[3] * r5 * sg0[3]);
            w.z = pk2(v[4] * r5 * sg1[0], v[5] * r5 * sg1[1]); w.w = pk2(v[6] * r5 * sg1[2], v[7] * r5 * sg1[3]);
            *(u32x4*)(MIX + row * DM + 512 + 8 * lane) = w; }
    }
}

DI void act_phase(const Args& a, int gtid, int NT) {
    asm volatile("" : "+v"(gtid));
    bf16* UP = (bf16*)(a.ws + WS_UP);
    const float* fw = a.in[27]; const float* fb = a.in[28];
    constexpr int NCG = DFF / 8;
    for (int item = gtid; item < (T / 16) * NCG; item += NT) {
        const int cg8 = item % NCG, rb = item / NCG, col = cg8 * 8, row0 = rb * 16;
        float w0[8], w1[8], w2[8], bb[8], g2[8], g1[8];
#pragma unroll
        for (int e = 0; e < 8; ++e) { w0[e] = fw[col + e]; w1[e] = fw[DFF + col + e]; w2[e] = fw[2 * DFF + col + e]; bb[e] = fb[col + e]; g2[e] = 0.f; g1[e] = 0.f; }
        const bool sample = row0 >= TP;
        float* outp = nullptr;
        if (sample) { const int sb = (row0 - TP) >> 4; const float* cc = a.in[6] + (size_t)sb * 2 * DFF + col;
#pragma unroll
            for (int e = 0; e < 8; ++e) { g2[e] = cc[e]; g1[e] = cc[DFF + e]; }
            outp = a.out + O_SFC + (size_t)sb * 2 * DFF + col;
        } else {
            if ((rb & 511) != 0) {
                const u32x4 x2 = *(const u32x4*)(UP + (size_t)(row0 - 2) * UPW + col), x1 = *(const u32x4*)(UP + (size_t)(row0 - 1) * UPW + col);
                g2[0] = blo(x2.x); g2[1] = bhi(x2.x); g2[2] = blo(x2.y); g2[3] = bhi(x2.y); g2[4] = blo(x2.z); g2[5] = bhi(x2.z); g2[6] = blo(x2.w); g2[7] = bhi(x2.w);
                g1[0] = blo(x1.x); g1[1] = bhi(x1.x); g1[2] = blo(x1.y); g1[3] = bhi(x1.y); g1[4] = blo(x1.z); g1[5] = bhi(x1.z); g1[6] = blo(x1.w); g1[7] = bhi(x1.w);
            }
            if ((rb & 511) == 511) outp = a.out + O_PFC + (size_t)(rb >> 9) * 2 * DFF + col;
        }
#pragma unroll 4
        for (int r = 0; r < 16; ++r) {
            bf16* gp = UP + (size_t)(row0 + r) * UPW + col;
            const u32x4 xg = *(const u32x4*)gp, xv = *(const u32x4*)(gp + DFF);
            float g0[8] = {blo(xg.x), bhi(xg.x), blo(xg.y), bhi(xg.y), blo(xg.z), bhi(xg.z), blo(xg.w), bhi(xg.w)};
            float vv[8] = {blo(xv.x), bhi(xv.x), blo(xv.y), bhi(xv.y), blo(xv.z), bhi(xv.z), blo(xv.w), bhi(xv.w)};
            float o[8];
#pragma unroll
            for (int e = 0; e < 8; ++e) { o[e] = silu(g2[e] * w0[e] + g1[e] * w1[e] + g0[e] * w2[e] + bb[e]) * vv[e]; g2[e] = g1[e]; g1[e] = g0[e]; }
            u32x4 w; w.x = pk2(o[0], o[1]); w.y = pk2(o[2], o[3]); w.z = pk2(o[4], o[5]); w.w = pk2(o[6], o[7]);
            *(u32x4*)(gp + DFF) = w;
            if (outp && r >= 14) {
#pragma unroll
                for (int e = 0; e < 8; ++e) outp[(r - 14) * DFF + e] = g0[e];
            }
        }
    }
}

DI void act_fix_phase(const Args& a, int gtid, int NT) {
    asm volatile("" : "+v"(gtid));
    bf16* ACT = (bf16*)(a.ws + WS_UP);
    const bf16* GH = (const bf16*)(a.ws + WS_GH); const bf16* GT = (const bf16*)(a.ws + WS_GT); const bf16* VH = (const bf16*)(a.ws + WS_VH);
    const float* fw = a.in[27]; const float* fb = a.in[28];
    constexpr int NCG = DFF / 8;
    for (int item = gtid; item < (T / 16) * NCG; item += NT) {
        const int cg8 = item % NCG, grp = item / NCG, col = cg8 * 8;
        float w0[8], w1[8], w2[8], bb[8], g2[8], g1[8], h0[8], h1[8], v0[8], v1[8];
#pragma unroll
        for (int e = 0; e < 8; ++e) { w0[e] = fw[col + e]; w1[e] = fw[DFF + col + e]; w2[e] = fw[2 * DFF + col + e]; bb[e] = fb[col + e]; g2[e] = 0.f; g1[e] = 0.f; }
        const bool sample = grp >= TP / 16;
        if (sample) { const float* cc = a.in[6] + (size_t)(grp - TP / 16) * 2 * DFF + col;
#pragma unroll
            for (int e = 0; e < 8; ++e) { g2[e] = cc[e]; g1[e] = cc[DFF + e]; }
        } else if ((grp & 511) != 0) {
            const u32x4 x2 = *(const u32x4*)(GT + ((size_t)(grp - 1) * 2) * DFF + col), x1 = *(const u32x4*)(GT + ((size_t)(grp - 1) * 2 + 1) * DFF + col);
            g2[0] = blo(x2.x); g2[1] = bhi(x2.x); g2[2] = blo(x2.y); g2[3] = bhi(x2.y); g2[4] = blo(x2.z); g2[5] = bhi(x2.z); g2[6] = blo(x2.w); g2[7] = bhi(x2.w);
            g1[0] = blo(x1.x); g1[1] = bhi(x1.x); g1[2] = blo(x1.y); g1[3] = bhi(x1.y); g1[4] = blo(x1.z); g1[5] = bhi(x1.z); g1[6] = blo(x1.w); g1[7] = bhi(x1.w);
        }
        {
            const u32x4 xa = *(const u32x4*)(GH + ((size_t)grp * 2) * DFF + col), xb = *(const u32x4*)(GH + ((size_t)grp * 2 + 1) * DFF + col);
            const u32x4 ya = *(const u32x4*)(VH + ((size_t)grp * 2) * DFF + col), yb = *(const u32x4*)(VH + ((size_t)grp * 2 + 1) * DFF + col);
            h0[0] = blo(xa.x); h0[1] = bhi(xa.x); h0[2] = blo(xa.y); h0[3] = bhi(xa.y); h0[4] = blo(xa.z); h0[5] = bhi(xa.z); h0[6] = blo(xa.w); h0[7] = bhi(xa.w);
            h1[0] = blo(xb.x); h1[1] = bhi(xb.x); h1[2] = blo(xb.y); h1[3] = bhi(xb.y); h1[4] = blo(xb.z); h1[5] = bhi(xb.z); h1[6] = blo(xb.w); h1[7] = bhi(xb.w);
            v0[0] = blo(ya.x); v0[1] = bhi(ya.x); v0[2] = blo(ya.y); v0[3] = bhi(ya.y); v0[4] = blo(ya.z); v0[5] = bhi(ya.z); v0[6] = blo(ya.w); v0[7] = bhi(ya.w);
            v1[0] = blo(yb.x); v1[1] = bhi(yb.x); v1[2] = blo(yb.y); v1[3] = bhi(yb.y); v1[4] = blo(yb.z); v1[5] = bhi(yb.z); v1[6] = blo(yb.w); v1[7] = bhi(yb.w);
        }
        float o0[8], o1[8];
#pragma unroll
        for (int e = 0; e < 8; ++e) { o0[e] = silu(g2[e] * w0[e] + g1[e] * w1[e] + h0[e] * w2[e] + bb[e]) * v0[e]; o1[e] = silu(g1[e] * w0[e] + h0[e] * w1[e] + h1[e] * w2[e] + bb[e]) * v1[e]; }
        u32x4 wa, wb; wa.x = pk2(o0[0], o0[1]); wa.y = pk2(o0[2], o0[3]); wa.z = pk2(o0[4], o0[5]); wa.w = pk2(o0[6], o0[7]);
        wb.x = pk2(o1[0], o1[1]); wb.y = pk2(o1[2], o1[3]); wb.z = pk2(o1[4], o1[5]); wb.w = pk2(o1[6], o1[7]);
        *(u32x4*)(ACT + ((size_t)grp * 16) * DFF + col) = wa; *(u32x4*)(ACT + ((size_t)grp * 16 + 1) * DFF + col) = wb;
        float* outp = nullptr;
        if (sample) outp = a.out + O_SFC + (size_t)(grp - TP / 16) * 2 * DFF + col;
        else if ((grp & 511) == 511) outp = a.out + O_PFC + (size_t)(grp >> 9) * 2 * DFF + col;
        if (outp) {
            const u32x4 t0 = *(const u32x4*)(GT + ((size_t)grp * 2) * DFF + col), t1 = *(const u32x4*)(GT + ((size_t)grp * 2 + 1) * DFF + col);
            outp[0] = blo(t0.x); outp[1] = bhi(t0.x); outp[2] = blo(t0.y); outp[3] = bhi(t0.y); outp[4] = blo(t0.z); outp[5] = bhi(t0.z); outp[6] = blo(t0.w); outp[7] = bhi(t0.w);
            outp[DFF + 0] = blo(t1.x); outp[DFF + 1] = bhi(t1.x); outp[DFF + 2] = blo(t1.y); outp[DFF + 3] = bhi(t1.y); outp[DFF + 4] = blo(t1.z); outp[DFF + 5] = bhi(t1.z); outp[DFF + 6] = blo(t1.w); outp[DFF + 7] = bhi(t1.w);
        }
    }
}

DI void final_phase(const Args& a, int gw, int NGW, int lane) {
    asm volatile("" : "+v"(lane));
    f32x4 gv[4];
#pragma unroll
    for (int j = 0; j < 4; ++j) gv[j] = ((const f32x4*)a.in[30])[lane + 64 * j];
    const bf16* X2 = (const bf16*)(a.ws + WS_X2);
    for (int m0 = gw; m0 < T; m0 += 2 * NGW) {
        const int m1 = m0 + NGW < T ? m0 + NGW : m0;
        const u32x2* xr0 = (const u32x2*)(X2 + (size_t)m0 * DM) + lane; const u32x2* xr1 = (const u32x2*)(X2 + (size_t)m1 * DM) + lane;
        u32x2 b0[4], b1[4];
#pragma unroll
        for (int j = 0; j < 4; ++j) { b0[j] = xr0[64 * j]; b1[j] = xr1[64 * j]; }
        f32x4 v0[4], v1[4]; float s0 = 0.f, s1 = 0.f;
#pragma unroll
        for (int j = 0; j < 4; ++j) { v0[j] = (f32x4){blo(b0[j].x), bhi(b0[j].x), blo(b0[j].y), bhi(b0[j].y)}; v1[j] = (f32x4){blo(b1[j].x), bhi(b1[j].x), blo(b1[j].y), bhi(b1[j].y)};
            s0 += (v0[j].x * v0[j].x + v0[j].y * v0[j].y) + (v0[j].z * v0[j].z + v0[j].w * v0[j].w); s1 += (v1[j].x * v1[j].x + v1[j].y * v1[j].y) + (v1[j].z * v1[j].z + v1[j].w * v1[j].w); }
        const float r0 = rsqrtf(wave_sum(s0) * (1.f / DM) + EPS), r1 = rsqrtf(wave_sum(s1) * (1.f / DM) + EPS);
        f32x4* o0 = (f32x4*)(a.out + (size_t)m0 * DM) + lane; f32x4* o1 = (f32x4*)(a.out + (size_t)m1 * DM) + lane;
#pragma unroll
        for (int j = 0; j < 4; ++j) o0[64 * j] = v0[j] * r0 * gv[j];
        if (m1 != m0) {
#pragma unroll
            for (int j = 0; j < 4; ++j) o1[64 * j] = v1[j] * r1 * gv[j];
        }
    }
}

#ifndef PH_MASK
#define PH_MASK 0xffff
#endif
#ifndef SOLVE_RL
#define SOLVE_RL 1
#endif
#ifndef REP0
#define REP0 1
#endif
#ifndef REP1
#define REP1 1
#endif
#ifndef REP2A
#define REP2A 1
#endif
#ifndef REP2B
#define REP2B 1
#endif
#ifndef REP3A
#define REP3A 1
#endif
#ifndef REP3B
#define REP3B 1
#endif
#ifndef REP3C
#define REP3C 1
#endif
#ifndef PH_LO
#define PH_LO 0
#endif
#ifndef PH_HI
#define PH_HI 99
#endif
__global__ void __launch_bounds__(512, 2) fwd_kernel(Args a) {
    extern __shared__ __attribute__((aligned(16))) unsigned char lds[];
    cg::grid_group grid = cg::this_grid();
    const int tid = threadIdx.x, lane = tid & 63, wave = __builtin_amdgcn_readfirstlane(tid >> 6);
    const int G = gridDim.x, gw = blockIdx.x * 8 + wave, NGW = G * 8;
    unsigned char* ws = a.ws;
    PG8_LAS unsigned char* ldsg = (PG8_LAS unsigned char*)lds;
    volatile LAS unsigned* xbst = (volatile LAS unsigned*)(ldsg + (LDS_BYTES - 64));
    if (tid < 2) xbst[tid] = 0u;
    __syncthreads();
    const XcdBarrier xbar = xcd_barrier_post((unsigned*)(ws + WS_CTL), xbst);

    _Pragma("nounroll") for (int rep = 0; rep < REP0; ++rep) { phase0(a, lds, gw, NGW, wave, lane); __syncthreads(); }
    xcd_barrier(xbar);
    if (a.out == nullptr) grid.sync();
    _Pragma("nounroll") for (int rep = 0; rep < REP1; ++rep)
    { pg8::Gemm g{(const bf16*)(ws + WS_H), (const bf16*)(ws + WS_WIN), T, NIN, DM, DM}; pg8::StaticOrder S; S.init(T, NIN, G, (int)blockIdx.x);
      EpiP E{(bf16*)(ws + WS_P), (float*)(ws + WS_BA)};
      pg8::gemm_phase<EpiP, pg8::StaticOrder, true, true>(ldsg, g, S, E); }
    xcd_barrier(xbar);
    _Pragma("nounroll") for (int rep = 0; rep < REP2A; ++rep) dn_chunk_phase(a, lds, tid, (int)blockIdx.x, 1024, G);
#if OLD_S5 && OLD_S5 != 4 && OLD_S5 != 5
    old_s5_pass1(a, gw, NGW, lane);
#elif 0
#else
    _Pragma("nounroll") for (int rep = 0; rep < REP2B; ++rep) s5_pass1(a, gw, NGW, lane);
#endif
    xcd_barrier(xbar);
#if OLD_S5 == 3
    if (blockIdx.x < 64) dn_scan_prompt(a, lds, tid);
    else { if (blockIdx.x >= 192) { dn_scan_sample(a, lds, tid, (int)blockIdx.x - 192, 128, 64); s5_pass2_sample(a, lds + 81920 + wave * 4352, ((int)blockIdx.x - 192) * 8 + wave, 512, lane); __syncthreads(); }
           old_s5_pass2(a, lds + 81920 + wave * 4352, gw - 512, NGW - 512, lane); }
#elif OLD_S5 == 5
    if (blockIdx.x < 64) { _Pragma("nounroll") for (int rep = 0; rep < REP3A; ++rep) dn_scan_prompt(a, lds, tid); }
    else {
        if (blockIdx.x >= 192) {
            const int w = (int)blockIdx.x - 192;
            dn_chunk_phase(a, lds, tid, 1024 + w, 1025 + w, 1);
            __threadfence_block(); __syncthreads();
            dn_scan_sample(a, lds, tid, 2 * w, 2 * w + 2, 1);
        }
        _Pragma("nounroll") for (int rep = 0; rep < REP3B; ++rep) s5_pass2b(a, lds + wave * 14592, gw - 512, NGW - 512, lane);
    }
#elif OLD_S5 == 1 || OLD_S5 == 4
    if (blockIdx.x < 64) dn_scan_prompt(a, lds, tid);
    else { if (blockIdx.x >= 192) dn_scan_sample(a, lds, tid, (int)blockIdx.x - 192, 128, 64); old_s5_pass2(a, lds + 81920 + wave * 4352, gw - 512, NGW - 512, lane); }
#else
    if (blockIdx.x < 64) { _Pragma("nounroll") for (int rep = 0; rep < REP3A; ++rep) dn_scan_prompt(a, lds, tid); }
    else if (blockIdx.x < 192) { _Pragma("nounroll") for (int rep = 0; rep < REP3B; ++rep) s5_pass2_prompt(a, lds, (int)blockIdx.x - 64, tid); }
    else { _Pragma("nounroll") for (int rep = 0; rep < REP3C; ++rep) { dn_scan_sample(a, lds, tid, (int)blockIdx.x - 192, 128, 64); s5_pass2_sample(a, lds + 81920 + wave * 4352, ((int)blockIdx.x - 192) * 8 + wave, 512, lane); } }
#endif
    xcd_barrier(xbar);
#if PH_MASK & 512
    { pg8::Gemm g{(const bf16*)(ws + WS_Y5), (const bf16*)(ws + WS_WGLU), T, 1024, 512, 512}; pg8::StaticOrder S; S.init(T, 1024, G, (int)blockIdx.x);
      EpiGlu E{(bf16*)(ws + WS_GLU), a.in[22]};
      pg8::gemm_phase<EpiGlu, pg8::StaticOrder, true, true>(ldsg, g, S, E); }
#endif
    xcd_barrier(xbar);
#if PH_MASK & 32
    mix_phase(a, gw, NGW, lane);
#endif
    xcd_barrier(xbar);
#if PH_MASK & 1024
    { pg8::Gemm g{(const bf16*)(ws + WS_DNC), (const bf16*)(ws + WS_WOUT), T, DM, DM, DM}; pg8::StaticOrder S; S.init(T, DM, G, (int)blockIdx.x);
      EpiX1 E{a.in[0], a.in[1], a.out, (bf16*)(ws + WS_H), (float*)(ws + WS_SS2)};
      pg8::gemm_phase<EpiX1, pg8::StaticOrder, true, true>(ldsg, g, S, E); }
#endif
    xcd_barrier(xbar);
#if FUSE_ACT
    { pg8::Gemm g{(const bf16*)(ws + WS_H), (const bf16*)(ws + WS_WUP), T, UPW, DM, DM}; pg8::StaticOrder S; S.init(T, UPW, G, (int)blockIdx.x);
      EpiUpAct E{(bf16*)(ws + WS_UP), (bf16*)(ws + WS_GH), (bf16*)(ws + WS_GT), (bf16*)(ws + WS_VH), (const float*)(ws + WS_SS2), a.in[27], a.in[28]};
      pg8::gemm_phase<EpiUpAct, pg8::StaticOrder, true, true>(ldsg, g, S, E); }
    xcd_barrier(xbar);
    act_fix_phase(a, (int)blockIdx.x * 512 + tid, G * 512);
    xcd_barrier(xbar);
    { pg8::Gemm g{(const bf16*)(ws + WS_UP), (const bf16*)(ws + WS_WDOWN), T, DM, DFF, DFF}; pg8::StaticOrder S; S.init(T, DM, G, (int)blockIdx.x);
      EpiX2 E{a.out, (const bf16*)(ws + WS_H), (bf16*)(ws + WS_X2)};
      pg8::gemm_phase<EpiX2, pg8::StaticOrder, true, true>(ldsg, g, S, E); }
    xcd_barrier(xbar);
#else
#if PH_MASK & 2048
    { pg8::Gemm g{(const bf16*)(ws + WS_H), (const bf16*)(ws + WS_WUP), T, UPW, DM, DM}; pg8::StaticOrder S; S.init(T, UPW, G, (int)blockIdx.x);
      EpiUp E{(bf16*)(ws + WS_UP), (const float*)(ws + WS_SS2)};
      pg8::gemm_phase<EpiUp, pg8::StaticOrder, true, true>(ldsg, g, S, E); }
#endif
    xcd_barrier(xbar);
#if PH_MASK & 64
    act_phase(a, (int)blockIdx.x * 512 + tid, G * 512);
#endif
    xcd_barrier(xbar);
#if PH_MASK & 4096
    { pg8::Gemm g{(const bf16*)(ws + WS_UP) + DFF, (const bf16*)(ws + WS_WDOWN), T, DM, DFF, UPW}; pg8::StaticOrder S; S.init(T, DM, G, (int)blockIdx.x);
      EpiX2 E{a.out, (const bf16*)(ws + WS_H), (bf16*)(ws + WS_X2)};
      pg8::gemm_phase<EpiX2, pg8::StaticOrder, true, true>(ldsg, g, S, E); }
#endif
    xcd_barrier(xbar);
#endif
#if PH_MASK & 128
    final_phase(a, gw, NGW, lane);
#endif
}

extern "C" void kernel_launch(void* const* d_in, const int* in_sizes, int n_in, void* d_out, int out_size, void* d_ws, size_t ws_size, hipStream_t stream) {
    static int grid = 0;
    if (grid == 0) {
        if (n_in != 31 || (size_t)out_size != O_END || ws_size < WS_END) { fprintf(stderr, "kernel_launch: unexpected shapes n_in %d out %d ws %zu\n", n_in, out_size, ws_size); grid = -1; return; }
        int dev = 0, cus = 0, per_cu = 0;
        hipGetDevice(&dev);
        hipDeviceGetAttribute(&cus, hipDeviceAttributeMultiprocessorCount, dev);
        hipFuncSetAttribute((const void*)fwd_kernel, hipFuncAttributeMaxDynamicSharedMemorySize, LDS_BYTES);
        hipOccupancyMaxActiveBlocksPerMultiprocessor(&per_cu, (const void*)fwd_kernel, 512, LDS_BYTES);
        if (per_cu < 1) { fprintf(stderr, "kernel_launch: occupancy query says %d blocks per CU\n", per_cu); per_cu = 1; }
        grid = cus * 1;
        if (grid != 256) { fprintf(stderr, "kernel_launch: built for a 256-CU device, got %d\n", cus); grid = -1; return; }
        (void)hipGetLastError();
    }
    if (grid < 0) return;
    if (hipMemsetAsync((char*)d_ws + WS_CTL, 0, 16384, stream) != hipSuccess) { fprintf(stderr, "kernel_launch: memset of the barrier words failed\n"); return; }
    Args a{};
    for (int i = 0; i < 31; ++i) a.in[i] = (const float*)d_in[i];
    a.out = (float*)d_out; a.ws = (unsigned char*)d_ws;
    void* args[] = {&a};
    hipError_t e = hipLaunchCooperativeKernel((const void*)fwd_kernel, dim3(grid), dim3(512), args, LDS_BYTES, stream);
    if (e != hipSuccess) fprintf(stderr, "cooperative launch failed: %s (grid %d)\n", hipGetErrorString(e), grid);
}
```

```cpp
#include <hip/hip_runtime.h>
#include <hip/hip_cooperative_groups.h>
#include <cstdio>
#include <cstdint>
namespace cg = cooperative_groups;
#define OLD_S5 5
#define DN_STAGED 3
namespace pg8 {
#define PG8_LAS __attribute__((address_space(3)))
typedef unsigned short bf16_t;
typedef short bf16x8 __attribute__((ext_vector_type(8)));
typedef float f32x4 __attribute__((ext_vector_type(4)));
typedef unsigned u32x4 __attribute__((ext_vector_type(4)));
constexpr int BM = 256, BK = 64, HALF = 128, HTB = HALF * BK * 2  , STAGE_BYTES = 8 * HTB, NXCD = 8, WGM = 8;

__host__ __device__ __forceinline__ int lds_byte(int r, int c) { const int st = (r >> 4) * 2 + (c >> 5), rr = r & 15, cc = c & 31, ob = rr * 64 + cc * 2; return st * 1024 + (ob ^ (((ob >> 9) & 1) << 5)); }
__host__ __device__ __forceinline__ void stage_rc(int b, int& R, int& C) { const int st = b / 1024, sb = b % 1024, swz = sb ^ (((sb >> 9) & 1) << 5); R = (st >> 1) * 16 + swz / 64; C = (st & 1) * 32 + (swz % 64) / 2; }
__host__ __device__ __forceinline__ int perm32(int rho) { const int n = rho >> 4, i = rho & 15; return 8 * (i >> 2) + 4 * n + (i & 3); }

struct Unit { int pm, pn; };
struct Gemm { const bf16_t* A; const bf16_t* Bt; int M, N, K, lda; };

struct StaticOrder {
    int nM, nN, nwg, G, c;
    __host__ __device__ void init(int M, int N, int G_, int c_) { nM = M / BM; nN = N / BM; nwg = nM * nN; G = G_; c = c_; }
    __host__ __device__ bool next(int i, Unit& u) const {
        const long L = (long)i * G + c; if (L >= nwg) return false;
        int wgid = (int)L; { const int q = nwg / NXCD, r = nwg % NXCD, xcd = wgid % NXCD, off = wgid / NXCD; wgid = (xcd < r ? xcd * (q + 1) : r * (q + 1) + (xcd - r) * q) + off; }
        const int nig = WGM * nN, gid = wgid / nig, fm = gid * WGM, gsz = (nM - fm) < WGM ? (nM - fm) : WGM;
        u.pm = fm + ((wgid % nig) % gsz); u.pn = (wgid % nig) / gsz; return true;
    }
    __device__ __forceinline__ void a_ready(const Unit&) const {}
    __device__ __forceinline__ void done(const Unit&) const {}
};
__device__ __forceinline__ unsigned cvt_pk_bf16(float lo, float hi) { unsigned r; asm volatile("v_cvt_pk_bf16_f32 %0, %1, %2" : "=v"(r) : "v"(lo), "v"(hi)); return r; }
typedef float f32x2 __attribute__((ext_vector_type(2)));
template <class Epi, class Sched, bool ALIGN_EPI = false, bool SP2 = false>
__device__ __forceinline__ void gemm_phase(PG8_LAS unsigned char* lds, const Gemm g, const Sched& S, const Epi& E) {
    int tid_ = threadIdx.x; asm volatile("" : "+v"(tid_));
    const int tid = tid_, wid = __builtin_amdgcn_readfirstlane(tid >> 6), lane = tid & 63, wr = wid >> 2, wc = wid & 3, fr = lane & 15, fq = lane >> 4;
    const int K = g.K, nt = K / BK;
    unsigned voffA[2], voffB[2];
#pragma unroll
    for (int i = 0; i < 2; ++i) { int R, C; stage_rc(tid * 16 + i * 8192, R, C); const int Rb = Epi::PERM ? ((R & ~31) + perm32(R & 31)) : R;
        voffA[i] = (unsigned)(R * g.lda + C) * 2u; voffB[i] = (unsigned)(Rb * K + C) * 2u; }
    const size_t kstep = (size_t)(BK * 2);
    const size_t hstep = (size_t)HALF * K * 2;
    const size_t tstep = 2 * hstep; const size_t hstepA = (size_t)HALF * g.lda * 2, tstepA = 2 * hstepA;
    const unsigned ldsw = (unsigned)wid * 1024u;
    const int aoff = lds_byte(wr * 64 + fr, fq * 8), boff = lds_byte(wc * 32 + fr, fq * 8);
#define PG8_SA(b, h) (((b) * 2 + (h)) * HTB)
#define PG8_SB(b, h) ((4 + (b) * 2 + (h)) * HTB)
#define PG8_STAGE(bufoff, gbase, voff) do { _Pragma("unroll") for (int _i = 0; _i < 2; ++_i) \
        __builtin_amdgcn_global_load_lds((const unsigned*)((const char*)(gbase) + (voff)[_i]), (PG8_LAS unsigned*)(lds + (bufoff) + ldsw + _i * 8192), 16, 0, 0); } while (0)
#define PG8_LDA(dst, b, h) do { _Pragma("unroll") for (int m = 0; m < 4; ++m) _Pragma("unroll") for (int k = 0; k < 2; ++k) dst[m][k] = *(const PG8_LAS bf16x8*)(lds + PG8_SA(b, h) + aoff + m * 2048 + k * 1024); } while (0)
#define PG8_LDB(dst, b, h) do { _Pragma("unroll") for (int n = 0; n < 2; ++n) _Pragma("unroll") for (int k = 0; k < 2; ++k) dst[n][k] = *(const PG8_LAS bf16x8*)(lds + PG8_SB(b, h) + boff + n * 2048 + k * 1024); } while (0)
#define PG8_MMA(ai, bj, At, Bt) do { __builtin_amdgcn_s_setprio(1); _Pragma("unroll") for (int m = 0; m < 4; ++m) _Pragma("unroll") for (int n = 0; n < 2; ++n) _Pragma("unroll") for (int k = 0; k < 2; ++k) \
        acc[ai][bj][m][n] = __builtin_amdgcn_mfma_f32_16x16x32_bf16(Bt[n][k], At[m][k], acc[ai][bj][m][n], 0, 0, 0); __builtin_amdgcn_s_setprio(0); } while (0)
#define PG8_WAIT_V(n) asm volatile("s_waitcnt vmcnt(" #n ")" ::: "memory")
#define PG8_WAIT_L(n) asm volatile("s_waitcnt lgkmcnt(" #n ")" ::: "memory")
#define PG8_BAR __builtin_amdgcn_s_barrier()
#define PG8_SCHED __builtin_amdgcn_sched_barrier(0)
    Unit cur, nxt; int ui = 0;
    if (!S.next(0, cur)) return;
    f32x4 acc[2][2][4][2];
#pragma unroll
    for (int a = 0; a < 2; ++a)
#pragma unroll
        for (int b = 0; b < 2; ++b)
#pragma unroll
            for (int m = 0; m < 4; ++m)
#pragma unroll
                for (int n = 0; n < 2; ++n) acc[a][b][m][n] = (f32x4){0.f, 0.f, 0.f, 0.f};
    bf16x8 At[4][2], B0[2][2], B1[2][2];
    const char* cA = (const char*)g.A + (size_t)cur.pm * tstepA; const char* cB = (const char*)g.Bt + (size_t)cur.pn * tstep;
    S.a_ready(cur);
    if constexpr (SP2) {
        PG8_STAGE(PG8_SB(0, 0), cB, voffB); PG8_STAGE(PG8_SB(0, 1), cB + hstep, voffB); PG8_STAGE(PG8_SA(0, 0), cA, voffA); PG8_STAGE(PG8_SA(0, 1), cA + hstepA, voffA);
        if (wr == 1) PG8_BAR;
        PG8_WAIT_V(2); PG8_BAR;
        PG8_STAGE(PG8_SB(1, 0), cB + kstep, voffB); PG8_STAGE(PG8_SA(1, 0), cA + kstep, voffA); PG8_STAGE(PG8_SB(1, 1), cB + hstep + kstep, voffB);
        PG8_WAIT_V(6); PG8_BAR;
    } else {
        PG8_STAGE(PG8_SB(0, 0), cB, voffB); PG8_STAGE(PG8_SA(0, 0), cA, voffA); PG8_STAGE(PG8_SB(0, 1), cB + hstep, voffB); PG8_STAGE(PG8_SA(0, 1), cA + hstepA, voffA);
        if (wr == 1) PG8_BAR;
        PG8_WAIT_V(4); PG8_BAR;
        PG8_STAGE(PG8_SB(1, 0), cB + kstep, voffB); PG8_STAGE(PG8_SA(1, 0), cA + kstep, voffA); PG8_STAGE(PG8_SB(1, 1), cB + hstep + kstep, voffB);
        PG8_WAIT_V(6); PG8_BAR;
    }
    for (;;) {
        const bool has_next = S.next(ui + 1, nxt);
        const char* nA = has_next ? (const char*)g.A + (size_t)nxt.pm * tstepA : cA; const char* nB = has_next ? (const char*)g.Bt + (size_t)nxt.pn * tstep : cB;
        for (int t = 0; t < nt; t += 2) {
            const bool last = (t == nt - 2);
            const char* a1 = cA + (size_t)(t + 1) * kstep;
            const char* a2 = last ? nA : cA + (size_t)(t + 2) * kstep; const char* b2 = last ? nB : cB + (size_t)(t + 2) * kstep;
            const char* a3 = a2 + kstep; const char* b3 = b2 + kstep;
            if (last && has_next) S.a_ready(nxt);
            if constexpr (SP2) {
            PG8_LDB(B0, 0, 0); PG8_LDB(B1, 0, 1); PG8_SCHED; PG8_LDA(At, 0, 0); PG8_STAGE(PG8_SA(1, 1), a1 + hstepA, voffA);
            PG8_WAIT_V(8); PG8_WAIT_L(0); PG8_BAR; PG8_MMA(0, 0, At, B0); PG8_MMA(0, 1, At, B1); PG8_BAR; PG8_SCHED;
            PG8_LDA(At, 0, 1); PG8_STAGE(PG8_SB(0, 0), b2, voffB); PG8_STAGE(PG8_SB(0, 1), b2 + hstep, voffB); PG8_STAGE(PG8_SA(0, 0), a2, voffA);
            PG8_WAIT_V(8); PG8_WAIT_L(0); PG8_BAR; PG8_MMA(1, 0, At, B0); PG8_MMA(1, 1, At, B1); PG8_BAR; PG8_SCHED;
            PG8_LDB(B0, 1, 0); PG8_LDB(B1, 1, 1); PG8_SCHED; PG8_LDA(At, 1, 0); PG8_STAGE(PG8_SA(0, 1), a2 + hstepA, voffA);
            PG8_WAIT_V(8); PG8_WAIT_L(0); PG8_BAR; PG8_MMA(0, 0, At, B0); PG8_MMA(0, 1, At, B1); PG8_BAR; PG8_SCHED;
            PG8_LDA(At, 1, 1); PG8_STAGE(PG8_SB(1, 0), b3, voffB); PG8_STAGE(PG8_SB(1, 1), b3 + hstep, voffB); PG8_STAGE(PG8_SA(1, 0), a3, voffA);
            PG8_WAIT_V(8); PG8_WAIT_L(0); PG8_BAR; PG8_MMA(1, 0, At, B0); PG8_MMA(1, 1, At, B1); PG8_BAR; PG8_SCHED;
            } else {
            PG8_LDB(B0, 0, 0); PG8_SCHED; PG8_LDA(At, 0, 0); PG8_STAGE(PG8_SA(1, 1), a1 + hstepA, voffA);
            PG8_WAIT_L(8); PG8_BAR; PG8_WAIT_L(0); PG8_MMA(0, 0, At, B0); PG8_BAR; PG8_SCHED;
            PG8_LDB(B1, 0, 1); PG8_STAGE(PG8_SB(0, 0), b2, voffB);
            PG8_BAR; PG8_WAIT_L(0); PG8_MMA(0, 1, At, B1); PG8_BAR;
            PG8_LDA(At, 0, 1); PG8_STAGE(PG8_SA(0, 0), a2, voffA);
            PG8_BAR; PG8_WAIT_L(0); PG8_MMA(1, 0, At, B0); PG8_BAR; PG8_SCHED;
            PG8_STAGE(PG8_SB(0, 1), b2 + hstep, voffB);
            PG8_WAIT_V(6); PG8_BAR; PG8_MMA(1, 1, At, B1); PG8_BAR;
            PG8_LDB(B0, 1, 0); PG8_SCHED; PG8_LDA(At, 1, 0); PG8_STAGE(PG8_SA(0, 1), a2 + hstepA, voffA);
            PG8_WAIT_L(8); PG8_BAR; PG8_WAIT_L(0); PG8_MMA(0, 0, At, B0); PG8_BAR; PG8_SCHED;
            PG8_LDB(B1, 1, 1); PG8_STAGE(PG8_SB(1, 0), b3, voffB);
            PG8_BAR; PG8_WAIT_L(0); PG8_MMA(0, 1, At, B1); PG8_BAR;
            PG8_LDA(At, 1, 1); PG8_STAGE(PG8_SA(1, 0), a3, voffA);
            PG8_BAR; PG8_WAIT_L(0); PG8_MMA(1, 0, At, B0); PG8_BAR; PG8_SCHED;
            PG8_STAGE(PG8_SB(1, 1), b3 + hstep, voffB);
            PG8_WAIT_V(6); PG8_BAR; PG8_MMA(1, 1, At, B1); PG8_BAR;
            }
        }
        if constexpr (ALIGN_EPI) { if (wr == 0) PG8_BAR; }
        if constexpr (!Epi::AFTER_DRAIN) { E(acc, cur, wr, wc, fr, fq); S.done(cur); }
        if (!has_next) break;
#pragma unroll
        for (int a = 0; a < 2; ++a)
#pragma unroll
            for (int b = 0; b < 2; ++b)
#pragma unroll
                for (int m = 0; m < 4; ++m)
#pragma unroll
                    for (int n = 0; n < 2; ++n) acc[a][b][m][n] = (f32x4){0.f, 0.f, 0.f, 0.f};
        cur = nxt; cA = nA; cB = nB; ++ui;
        if constexpr (ALIGN_EPI) { if (wr == 1) PG8_BAR; }
    }
    PG8_WAIT_V(0);
    if constexpr (!ALIGN_EPI) { if (wr == 0) PG8_BAR; }
    PG8_BAR;
    if constexpr (Epi::AFTER_DRAIN) { E.fused(acc, cur, wr, wc, fr, fq, lds, wid, lane); S.done(cur); }
#undef PG8_SA
#undef PG8_SB
#undef PG8_STAGE
#undef PG8_LDA
#undef PG8_LDB
#undef PG8_MMA
#undef PG8_WAIT_V
#undef PG8_WAIT_L
#undef PG8_BAR
#undef PG8_SCHED
}
}
#define LAS __attribute__((address_space(3)))
#define XB_TMO      128
#define XB_XCNT(j)  (256  + 64 * (j))
#define XB_XSUB(j)  (1280 + 64 * (j))
#define XB_XGEN(j)  (2304 + 64 * (j))
#define XB_TOP      3328
#define XB_TOPGEN   3392
#define XCD_BAR_WORDS 3456
#define XB_SPIN_CAP (1u << 18)

__device__ __forceinline__ unsigned xb_ld(unsigned* p)              { return __hip_atomic_load(p, __ATOMIC_RELAXED, __HIP_MEMORY_SCOPE_AGENT); }
__device__ __forceinline__ unsigned xb_add(unsigned* p, unsigned v) { return __hip_atomic_fetch_add(p, v, __ATOMIC_RELAXED, __HIP_MEMORY_SCOPE_AGENT); }
__device__ __forceinline__ unsigned xb_xcc_id() { return (unsigned)__builtin_amdgcn_s_getreg((3 << 11) | 20) & 0xFu; }
#define XB_SPIN(cond, bar) do { unsigned _sp = 0; while (cond) { __builtin_amdgcn_s_sleep(1); \
    if ((++_sp & 255u) == 0u) { if (xb_ld(&(bar)[XB_TMO])) break; if (_sp > XB_SPIN_CAP) { atomicAdd(&(bar)[XB_TMO], 1u); break; } } } } while (0)

struct XcdBarrier {
    unsigned* bar; unsigned x;
    volatile LAS unsigned* st;
};

__device__ __forceinline__ XcdBarrier xcd_barrier_post(unsigned* bar, volatile LAS unsigned* st) {
    XcdBarrier b; b.bar = bar; b.x = xb_xcc_id(); b.st = st;
    if (threadIdx.x == 0) (void)xb_add(&bar[XB_XCNT(b.x)], 1u);
    return b;
}
__device__ __forceinline__ void xcd_barrier_complete(unsigned* bar, unsigned x, unsigned& nloc, unsigned& nx) {
    const unsigned G = gridDim.x * gridDim.y * gridDim.z;
    unsigned sum, cnt, mine, sp = 0u;
    for (;;) {
        sum = 0u; cnt = 0u; mine = 0u;
#pragma unroll
        for (unsigned j = 0; j < 16; ++j) { const unsigned c = xb_ld(&bar[XB_XCNT(j)]); sum += c; cnt += (c > 0u) ? 1u : 0u; mine = (j == x) ? c : mine; }
        if (sum == G) break;
        __builtin_amdgcn_s_sleep(1);
        if ((++sp & 255u) == 0u) { if (xb_ld(&bar[XB_TMO])) break; if (sp > XB_SPIN_CAP) { atomicAdd(&bar[XB_TMO], 1u); break; } }
    }
    nloc = mine > 0u ? mine : 1u; nx = cnt > 0u ? cnt : 1u;
}

__device__ __forceinline__ void xcd_barrier(const XcdBarrier& b) {
    asm volatile("s_waitcnt vmcnt(0)" ::: "memory");
    __syncthreads();
    if (threadIdx.x == 0) {
        unsigned* bar = b.bar;
        __builtin_amdgcn_s_waitcnt(0);
        unsigned nloc = b.st[0], nx = b.st[1];
        if (nloc == 0u) { xcd_barrier_complete(bar, b.x, nloc, nx); b.st[0] = nloc; b.st[1] = nx; }
        const unsigned old = xb_add(&bar[XB_XSUB(b.x)], 1u);
        const unsigned gen = old / nloc;
        if (old + 1u == (gen + 1u) * nloc) {
            __builtin_amdgcn_fence(__ATOMIC_RELEASE, "agent");
            asm volatile("s_waitcnt vmcnt(0)" ::: "memory");
            const unsigned og = xb_add(&bar[XB_TOP], 1u);
            const unsigned tg = og / nx;
            if (og + 1u == (tg + 1u) * nx) xb_add(&bar[XB_TOPGEN], 1u);
            else XB_SPIN(xb_ld(&bar[XB_TOPGEN]) == tg, bar);
            __builtin_amdgcn_fence(__ATOMIC_ACQUIRE, "agent");
            xb_add(&bar[XB_XGEN(b.x)], 1u);
            asm volatile("s_waitcnt vmcnt(0)" ::: "memory");
        } else {
            XB_SPIN(xb_ld(&bar[XB_XGEN(b.x)]) == gen, bar);
            __builtin_amdgcn_fence(__ATOMIC_ACQUIRE, "agent");
            asm volatile("s_waitcnt vmcnt(0)" ::: "memory");
        }
    }
    __syncthreads();
}


#ifndef FUSE_ACT
#define FUSE_ACT 1
#endif
#ifndef DN_STAGED
#define DN_STAGED 1
#endif
#ifndef DIAG_Y
#define DIAG_Y 0
#endif
#ifndef OLD_S5
#define OLD_S5 0
#endif
#if OLD_S5 == 3
#define OLD_S5_ULIM 8192
#else
#define OLD_S5_ULIM (4 * 32 * 64 + 32 * 32)
#endif
#define DI __device__ __forceinline__
typedef unsigned short bf16;
typedef float f32x4 __attribute__((ext_vector_type(4)));
typedef float f32x2 __attribute__((ext_vector_type(2)));
typedef short bf16x8 __attribute__((ext_vector_type(8)));
typedef unsigned u32x4 __attribute__((ext_vector_type(4)));
typedef unsigned u32x2 __attribute__((ext_vector_type(2)));
typedef __bf16 bf16x2_t __attribute__((ext_vector_type(2)));

DI unsigned pk2(float lo, float hi) { f32x2 v = {lo, hi}; bf16x2_t b = __builtin_convertvector(v, bf16x2_t); return __builtin_bit_cast(unsigned, b); }
DI bf16 f2b(float x) { return (bf16)(pk2(x, 0.f) & 0xffffu); }
DI float b2f(unsigned b) { return __uint_as_float(b << 16); }
DI float blo(unsigned w) { return __uint_as_float(w << 16); }
DI float bhi(unsigned w) { return __uint_as_float(w & 0xffff0000u); }
DI float wave_sum(float v) {
#pragma unroll
    for (int o = 1; o < 64; o <<= 1) v += __shfl_xor(v, o);
    return v;
}
DI float sigm(float x) { return __builtin_amdgcn_rcpf(1.f + __expf(-x)); }
DI float silu(float x) { return x * __builtin_amdgcn_rcpf(1.f + __expf(-x)); }
DI float gelu_tanh(float x) { const float z = 1.5957691216057308f * (x + 0.044715f * x * x * x); return x * __builtin_amdgcn_rcpf(1.f + __expf(-z)); }
#define MFMA16(a, b, c) __builtin_amdgcn_mfma_f32_16x16x32_bf16((a), (b), (c), 0, 0, 0)

constexpr int TP = 32768, TS = 512, T = TP + TS;
constexpr int DM = 1024, PW = 2560, NIN = 2816, DFF = 2816, UPW = 5632;
constexpr float EPS = 1e-6f;
constexpr int NCH = 2048 + 128;
constexpr int REC = 73728;
constexpr int R_WN = 0, R_QG = 16384, R_KDT = 32768, R_QK = 49152, R_U0 = 57344;
constexpr size_t O_Y = 0, O_PDC = (size_t)T * DM, O_PDS = O_PDC + 4 * 3 * 1536, O_PSR = O_PDS + 4 * 4 * 128 * 128, O_PSI = O_PSR + 4 * 32 * 64,
                 O_PFC = O_PSI + 4 * 32 * 64, O_SDC = O_PFC + 4 * 2 * 2816, O_SDS = O_SDC + 32 * 3 * 1536, O_SSR = O_SDS + (size_t)32 * 4 * 128 * 128,
                 O_SSI = O_SSR + 32 * 32 * 64, O_SFC = O_SSI + 32 * 32 * 64, O_END = O_SFC + 32 * 2 * 2816;
constexpr size_t MiB = 1u << 20;
constexpr size_t WS_SS2 = 0;
constexpr size_t WS_EG = 3 * MiB;
constexpr size_t WS_CTL = 5 * MiB + 512 * 1024;
constexpr size_t WS_BA = 4 * MiB;
constexpr size_t WS_WIN = 6 * MiB, WS_WGLU = 12 * MiB, WS_WOUT = 13 * MiB, WS_WUP = 15 * MiB, WS_WDOWN = 26 * MiB;
constexpr size_t WS_H = 32 * MiB;
constexpr size_t WS_P = 98 * MiB;
constexpr size_t WS_DNC = 262 * MiB;
constexpr size_t WS_Y5 = 416 * MiB, WS_GLU = 449 * MiB, WS_S5E = 482 * MiB, WS_END = 487 * MiB;
constexpr size_t WS_GH = 300 * MiB, WS_GT = 324 * MiB, WS_VH = 348 * MiB;
constexpr size_t WS_X2 = 416 * MiB;
constexpr size_t WS_UP = 98 * MiB;
static_assert(WS_UP + (size_t)T * UPW * 2 <= WS_END && WS_P + (size_t)T * PW * 2 <= WS_DNC && WS_DNC + (size_t)NCH * REC <= WS_Y5, "ws map");
constexpr int LDS_BYTES = 147456;

struct Args { const float* in[31]; float* out; unsigned char* ws; };

DI int colmap(int mode, int n) {
    if (mode == 0) return n;
    if (mode == 1) return n < 2048 ? n : (n < 2560 ? n + 8 : (n < 2568 ? n - 512 : -1));
    const int pn = n >> 8, bj = (n >> 7) & 1, j = n & 127;
    return bj * (mode == 2 ? 512 : 2816) + 128 * pn + j;
}
DI void transpose_item(const float* W, int K, int N, bf16* WT, float* scr, int kb, int nb, int lane, int mode, const float* rs) {
    const int k0 = 64 * kb, n0 = 32 * nb;
    const int sc = colmap(mode, n0 + (lane & 31));
    float tv[32];
#pragma unroll
    for (int i = 0; i < 32; ++i) { const int kk = 2 * i + (lane >> 5); tv[i] = 0.f; if (sc >= 0) tv[i] = W[(size_t)(k0 + kk) * N + sc]; }
#pragma unroll
    for (int i = 0; i < 32; ++i) { const int kk = 2 * i + (lane >> 5); float v = tv[i]; if (rs) v *= rs[k0 + kk]; scr[kk * 33 + (lane & 31)] = v; }
    asm volatile("s_waitcnt lgkmcnt(0)" ::: "memory");
    const int c = lane & 7;
#pragma unroll
    for (int j = 0; j < 4; ++j) { const int n = (lane >> 3) + 8 * j; const float* s = scr + (8 * c) * 33 + n;
        u32x4 o; o.x = pk2(s[0 * 33], s[1 * 33]); o.y = pk2(s[2 * 33], s[3 * 33]); o.z = pk2(s[4 * 33], s[5 * 33]); o.w = pk2(s[6 * 33], s[7 * 33]);
        *(u32x4*)(WT + (size_t)(n0 + n) * K + k0 + 8 * c) = o; }
    asm volatile("s_waitcnt lgkmcnt(0)" ::: "memory");
}
DI void phase0(const Args& a, unsigned char* lds, int gw, int NGW, int wave, int lane) {
    asm volatile("" : "+v"(lane));
    unsigned char* ws = a.ws;
    float* scr = (float*)(lds + wave * 16384);
    constexpr int I_IN = 16 * (NIN / 32), I_GLU = 8 * 32, I_OUT = 16 * 32, I_UP = 16 * (UPW / 32), I_DN = 44 * 32;
    constexpr int NIT = I_IN + I_GLU + I_OUT + I_UP + I_DN;
    for (int it = gw; it < NIT; it += NGW) {
        int r = it;
        if (r < I_IN) { transpose_item(a.in[8], 1024, 2568, (bf16*)(ws + WS_WIN), scr, r / (NIN / 32), r % (NIN / 32), lane, 1, nullptr); continue; } r -= I_IN;
        if (r < I_GLU) { transpose_item(a.in[21], 512, 1024, (bf16*)(ws + WS_WGLU), scr, r / 32, r % 32, lane, 2, nullptr); continue; } r -= I_GLU;
        if (r < I_OUT) { transpose_item(a.in[24], 1024, 1024, (bf16*)(ws + WS_WOUT), scr, r / 32, r % 32, lane, 0, nullptr); continue; } r -= I_OUT;
        if (r < I_UP) { transpose_item(a.in[26], 1024, 5632, (bf16*)(ws + WS_WUP), scr, r / (UPW / 32), r % (UPW / 32), lane, 3, a.in[25]); continue; } r -= I_UP;
        transpose_item(a.in[29], 2816, 1024, (bf16*)(ws + WS_WDOWN), scr, r / 32, r % 32, lane, 0, nullptr);
    }
    const float* g1 = a.in[7];
    f32x4 gv[4];
#pragma unroll
    for (int j = 0; j < 4; ++j) gv[j] = ((const f32x4*)g1)[lane + 64 * j];
    bf16* H = (bf16*)(ws + WS_H);
    for (int m0 = gw; m0 < T; m0 += 2 * NGW) {
        const int m1 = m0 + NGW < T ? m0 + NGW : m0;
        const f32x4* xr0 = (const f32x4*)(m0 < TP ? a.in[0] + (size_t)m0 * DM : a.in[1] + (size_t)(m0 - TP) * DM) + lane;
        const f32x4* xr1 = (const f32x4*)(m1 < TP ? a.in[0] + (size_t)m1 * DM : a.in[1] + (size_t)(m1 - TP) * DM) + lane;
        f32x4 v0[4], v1[4]; float s0 = 0.f, s1 = 0.f;
#pragma unroll
        for (int j = 0; j < 4; ++j) { v0[j] = xr0[64 * j]; v1[j] = xr1[64 * j]; }
#pragma unroll
        for (int j = 0; j < 4; ++j) { s0 += (v0[j].x * v0[j].x + v0[j].y * v0[j].y) + (v0[j].z * v0[j].z + v0[j].w * v0[j].w); s1 += (v1[j].x * v1[j].x + v1[j].y * v1[j].y) + (v1[j].z * v1[j].z + v1[j].w * v1[j].w); }
        const float r0 = rsqrtf(wave_sum(s0) * (1.f / DM) + EPS), r1 = rsqrtf(wave_sum(s1) * (1.f / DM) + EPS);
        u32x2* o0 = (u32x2*)(H + (size_t)m0 * DM) + lane; u32x2* o1 = (u32x2*)(H + (size_t)m1 * DM) + lane;
#pragma unroll
        for (int j = 0; j < 4; ++j) { u32x2 o; o.x = pk2(v0[j].x * r0 * gv[j].x, v0[j].y * r0 * gv[j].y); o.y = pk2(v0[j].z * r0 * gv[j].z, v0[j].w * r0 * gv[j].w); o0[64 * j] = o; }
        if (m1 != m0) {
#pragma unroll
            for (int j = 0; j < 4; ++j) { u32x2 o; o.x = pk2(v1[j].x * r1 * gv[j].x, v1[j].y * r1 * gv[j].y); o.y = pk2(v1[j].z * r1 * gv[j].z, v1[j].w * r1 * gv[j].w); o1[64 * j] = o; }
        }
    }
}

struct EpiP {
    static constexpr bool PERM = true, AFTER_DRAIN = false;
    bf16* P; float* BA;
    DI void operator()(const pg8::f32x4 (&acc)[2][2][4][2], const pg8::Unit& u, int wr, int wc, int fr, int fq) const {
        const int row0 = u.pm * 256 + wr * 64 + fr;
        if (u.pn < 10) {
            const int col0 = u.pn * 256 + wc * 32 + 8 * fq;
#pragma unroll
            for (int ai = 0; ai < 2; ++ai)
#pragma unroll
                for (int m = 0; m < 4; ++m) { bf16* rowp = P + (size_t)(row0 + ai * 128 + m * 16) * PW + col0;
#pragma unroll
                    for (int bj = 0; bj < 2; ++bj) { const pg8::f32x4 v0 = acc[ai][bj][m][0], v1 = acc[ai][bj][m][1];
                        u32x4 w; w.x = pk2(v0[0], v0[1]); w.y = pk2(v0[2], v0[3]); w.z = pk2(v1[0], v1[1]); w.w = pk2(v1[2], v1[3]);
                        *(u32x4*)(rowp + bj * 128) = w; } }
        } else if (wc == 0 && fq == 0) {
#pragma unroll
            for (int ai = 0; ai < 2; ++ai)
#pragma unroll
                for (int m = 0; m < 4; ++m) { float* bp = BA + (size_t)(row0 + ai * 128 + m * 16) * 8;
                    *(pg8::f32x4*)bp = acc[ai][0][m][0]; *(pg8::f32x4*)(bp + 4) = acc[ai][0][m][1]; }
        }
    }
};
struct EpiGlu {
    static constexpr bool PERM = true, AFTER_DRAIN = false;
    bf16* O; const float* gb;
    DI void operator()(const pg8::f32x4 (&acc)[2][2][4][2], const pg8::Unit& u, int wr, int wc, int fr, int fq) const {
        const int row0 = u.pm * 256 + wr * 64 + fr, col0 = u.pn * 128 + wc * 32 + 8 * fq;
        const pg8::f32x4 ba0 = *(const pg8::f32x4*)(gb + col0), ba1 = *(const pg8::f32x4*)(gb + col0 + 4), bg0 = *(const pg8::f32x4*)(gb + 512 + col0), bg1 = *(const pg8::f32x4*)(gb + 512 + col0 + 4);
#pragma unroll
        for (int ai = 0; ai < 2; ++ai)
#pragma unroll
            for (int m = 0; m < 4; ++m) {
                const pg8::f32x4 a0 = acc[ai][0][m][0] + ba0, a1 = acc[ai][0][m][1] + ba1, g0 = acc[ai][1][m][0] + bg0, g1 = acc[ai][1][m][1] + bg1;
                float o[8];
#pragma unroll
                for (int e = 0; e < 4; ++e) { o[e] = a0[e] * sigm(g0[e]); o[4 + e] = a1[e] * sigm(g1[e]); }
                u32x4 w; w.x = pk2(o[0], o[1]); w.y = pk2(o[2], o[3]); w.z = pk2(o[4], o[5]); w.w = pk2(o[6], o[7]);
                *(u32x4*)(O + (size_t)(row0 + ai * 128 + m * 16) * 512 + col0) = w;
            }
    }
};
struct EpiX1 {
    static constexpr bool PERM = false, AFTER_DRAIN = false;
    const float* xp; const float* xs; float* out; bf16* xb; float* ss2;
    DI void operator()(const pg8::f32x4 (&acc)[2][2][4][2], const pg8::Unit& u, int wr, int wc, int fr, int fq) const {
        const int row0 = u.pm * 256 + wr * 64 + fr, col0 = u.pn * 256 + wc * 32 + 4 * fq;
#pragma unroll
        for (int ai = 0; ai < 2; ++ai)
#pragma unroll
            for (int m = 0; m < 4; ++m) {
                const int row = row0 + ai * 128 + m * 16;
                const float* xr = (row < TP ? xp + (size_t)row * DM : xs + (size_t)(row - TP) * DM) + col0;
                float ss = 0.f;
#pragma unroll
                for (int bj = 0; bj < 2; ++bj)
#pragma unroll
                    for (int n = 0; n < 2; ++n) {
                        const pg8::f32x4 v = *(const pg8::f32x4*)(xr + bj * 128 + n * 16) + acc[ai][bj][m][n];
                        u32x2 w; w.x = pk2(v[0], v[1]); w.y = pk2(v[2], v[3]);
                        *(u32x2*)(xb + (size_t)row * DM + col0 + bj * 128 + n * 16) = w;
                        ss += (v[0] * v[0] + v[1] * v[1]) + (v[2] * v[2] + v[3] * v[3]);
                    }
                ss += __shfl_xor(ss, 16); ss += __shfl_xor(ss, 32);
                if (fq == 0) ss2[(size_t)row * 16 + u.pn * 4 + wc] = ss;
            }
    }
};
struct EpiUp {
    static constexpr bool PERM = true, AFTER_DRAIN = false;
    bf16* UP; const float* ss2;
    DI void operator()(const pg8::f32x4 (&acc)[2][2][4][2], const pg8::Unit& u, int wr, int wc, int fr, int fq) const {
        const int row0 = u.pm * 256 + wr * 64 + fr, col0 = u.pn * 128 + wc * 32 + 8 * fq;
#pragma unroll
        for (int ai = 0; ai < 2; ++ai)
#pragma unroll
            for (int m = 0; m < 4; ++m) {
                const int row = row0 + ai * 128 + m * 16;
                const pg8::f32x4* sp = (const pg8::f32x4*)(ss2 + (size_t)row * 16);
                const pg8::f32x4 s0 = sp[0], s1 = sp[1], s2 = sp[2], s3 = sp[3];
                const float tot = ((s0[0] + s0[1]) + (s0[2] + s0[3])) + ((s1[0] + s1[1]) + (s1[2] + s1[3])) + ((s2[0] + s2[1]) + (s2[2] + s2[3])) + ((s3[0] + s3[1]) + (s3[2] + s3[3]));
                const float r = rsqrtf(tot * (1.f / DM) + EPS);
                bf16* rowp = UP + (size_t)row * UPW + col0;
#pragma unroll
                for (int bj = 0; bj < 2; ++bj) { const pg8::f32x4 v0 = acc[ai][bj][m][0] * r, v1 = acc[ai][bj][m][1] * r;
                    u32x4 w; w.x = pk2(v0[0], v0[1]); w.y = pk2(v0[2], v0[3]); w.z = pk2(v1[0], v1[1]); w.w = pk2(v1[2], v1[3]);
                    *(u32x4*)(rowp + bj * DFF) = w; }
            }
    }
};
DI float dpp_shr1(float v) { return __int_as_float(__builtin_amdgcn_update_dpp(0, __float_as_int(v), 0x111, 0xf, 0xf, false)); }
DI float dpp_shr2(float v) { return __int_as_float(__builtin_amdgcn_update_dpp(0, __float_as_int(v), 0x112, 0xf, 0xf, false)); }
struct EpiUpAct {
    static constexpr bool PERM = true, AFTER_DRAIN = false;
    bf16* ACT; bf16* GH; bf16* GT; bf16* VH; const float* ss2; const float* fw; const float* fb;
    DI void operator()(const pg8::f32x4 (&acc)[2][2][4][2], const pg8::Unit& u, int wr, int wc, int fr, int fq) const {
        const int row0 = u.pm * 256 + wr * 64 + fr, col0 = u.pn * 128 + wc * 32 + 8 * fq;
        float w0[8], w1[8], w2[8], bb[8];
#pragma unroll
        for (int n = 0; n < 2; ++n) { const pg8::f32x4 a0 = *(const pg8::f32x4*)(fw + col0 + 4 * n), a1 = *(const pg8::f32x4*)(fw + DFF + col0 + 4 * n), a2 = *(const pg8::f32x4*)(fw + 2 * DFF + col0 + 4 * n), a3 = *(const pg8::f32x4*)(fb + col0 + 4 * n);
#pragma unroll
            for (int e = 0; e < 4; ++e) { w0[4 * n + e] = a0[e]; w1[4 * n + e] = a1[e]; w2[4 * n + e] = a2[e]; bb[4 * n + e] = a3[e]; } }
#pragma unroll
        for (int ai = 0; ai < 2; ++ai)
#pragma unroll
            for (int m = 0; m < 4; ++m) {
                const int row = row0 + ai * 128 + m * 16, grp = row >> 4;
                const pg8::f32x4* sp = (const pg8::f32x4*)(ss2 + (size_t)row * 16);
                const pg8::f32x4 s0 = sp[0], s1 = sp[1], s2 = sp[2], s3 = sp[3];
                const float tot = ((s0[0] + s0[1]) + (s0[2] + s0[3])) + ((s1[0] + s1[1]) + (s1[2] + s1[3])) + ((s2[0] + s2[1]) + (s2[2] + s2[3])) + ((s3[0] + s3[1]) + (s3[2] + s3[3]));
                const float r = rsqrtf(tot * (1.f / DM) + EPS);
                float gs[8], vv[8], o[8];
#pragma unroll
                for (int n = 0; n < 2; ++n)
#pragma unroll
                    for (int e = 0; e < 4; ++e) { gs[4 * n + e] = acc[ai][0][m][n][e] * r; vv[4 * n + e] = acc[ai][1][m][n][e] * r; }
#pragma unroll
                for (int e = 0; e < 8; ++e) { const float g1 = dpp_shr1(gs[e]), g2 = dpp_shr2(gs[e]); o[e] = silu(g2 * w0[e] + g1 * w1[e] + gs[e] * w2[e] + bb[e]) * vv[e]; }
                u32x4 wg; wg.x = pk2(gs[0], gs[1]); wg.y = pk2(gs[2], gs[3]); wg.z = pk2(gs[4], gs[5]); wg.w = pk2(gs[6], gs[7]);
                if (fr >= 2) { u32x4 w; w.x = pk2(o[0], o[1]); w.y = pk2(o[2], o[3]); w.z = pk2(o[4], o[5]); w.w = pk2(o[6], o[7]);
                    *(u32x4*)(ACT + (size_t)row * DFF + col0) = w; }
                else { u32x4 wv; wv.x = pk2(vv[0], vv[1]); wv.y = pk2(vv[2], vv[3]); wv.z = pk2(vv[4], vv[5]); wv.w = pk2(vv[6], vv[7]);
                    *(u32x4*)(GH + ((size_t)grp * 2 + fr) * DFF + col0) = wg; *(u32x4*)(VH + ((size_t)grp * 2 + fr) * DFF + col0) = wv; }
                if (fr >= 14) *(u32x4*)(GT + ((size_t)grp * 2 + (fr - 14)) * DFF + col0) = wg;
            }
    }
};
struct EpiX2 {
    static constexpr bool PERM = false, AFTER_DRAIN = false;
    float* out; const bf16* xb; bf16* x2;
    DI void operator()(const pg8::f32x4 (&acc)[2][2][4][2], const pg8::Unit& u, int wr, int wc, int fr, int fq) const {
        const int row0 = u.pm * 256 + wr * 64 + fr, col0 = u.pn * 256 + wc * 32 + 4 * fq;
#pragma unroll
        for (int ai = 0; ai < 2; ++ai)
#pragma unroll
            for (int m = 0; m < 4; ++m) {
                float* orow = out + (size_t)(row0 + ai * 128 + m * 16) * DM + col0;
#pragma unroll
                for (int bj = 0; bj < 2; ++bj)
#pragma unroll
                    for (int n = 0; n < 2; ++n) { const u32x2 xb2 = *(const u32x2*)(xb + (size_t)(row0 + ai * 128 + m * 16) * DM + col0 + bj * 128 + n * 16);
                        pg8::f32x4 v = acc[ai][bj][m][n]; v[0] += blo(xb2.x); v[1] += bhi(xb2.x); v[2] += blo(xb2.y); v[3] += bhi(xb2.y);
                        u32x2 w; w.x = pk2(v[0], v[1]); w.y = pk2(v[2], v[3]);
                        *(u32x2*)(x2 + (size_t)(row0 + ai * 128 + m * 16) * DM + col0 + bj * 128 + n * 16) = w; }
            }
    }
};

DI int kperm(int k) { return (k & ~31) | (((k >> 2) & 3) << 3) | (((k >> 4) & 1) << 2) | (k & 3); }
DI void conv_col(const bf16* pcol, float h0, float h1, float h2, const float* cw, int nrows, float* outp, float (&val)[64]) {
    const float w0 = cw[0], w1 = cw[1536], w2 = cw[2 * 1536], w3 = cw[3 * 1536];
    float x3 = h0, x2 = h1, x1 = h2;
#pragma unroll
    for (int r = 0; r < 64; ++r) {
        float x0 = 0.f;
        if (r < nrows) x0 = b2f(pcol[(size_t)r * PW]);
        const float c = x3 * w0 + x2 * w1 + x1 * w2 + x0 * w3;
        val[r] = r < nrows ? silu(c) : 0.f;
        if (outp && r >= nrows - 3 && r < nrows) outp[(r - (nrows - 3)) * 1536] = x0;
        x3 = x2; x2 = x1; x1 = x0;
    }
}
DI void dn_chunk_phase(const Args& a, unsigned char* lds, int tid, int it0, int it1, int its) {
    unsigned char* ws = a.ws;
    const bf16* P = (const bf16*)(ws + WS_P);
    const float* BA = (const float*)(ws + WS_BA);
    const float* cwt = a.in[9];
    constexpr float QSCALE = 0.08838834764831845f;
    for (int it = it0; it < it1; it += its) {
        int tl = tid; asm volatile("" : "+v"(tl));
        const int half = __builtin_amdgcn_readfirstlane(tl >> 8), t8 = tl & 255, hw = __builtin_amdgcn_readfirstlane((tl >> 6) & 3), lane = tl & 63, fr = lane & 15, fq = lane >> 4;
        unsigned char* L = lds + half * 53248;
        unsigned char* qb = L; unsigned char* kb = L + 17408;
        float* Am = (float*)(L + 34816);
        float* Gs = (float*)(L + 51200); float* Bs = Gs + 64; float* RQ = Gs + 128; float* RK = Gs + 192; float* EG = Gs + 256;
        const int unit = it * 2 + half;
        int row0, nrows, h, bidx; bool sample, first, lastc;
        if (unit < 2048) { const int b = unit >> 9, n = unit & 127; h = (unit >> 7) & 3; row0 = b * 8192 + n * 64; nrows = 64; sample = false; first = (n == 0); lastc = (n == 127); bidx = b; }
        else { const int su = unit - 2048; bidx = su >> 2; h = su & 3; row0 = TP + bidx * 16; nrows = 16; sample = true; first = false; lastc = true; }
        unsigned char* rec = ws + WS_DNC + (size_t)unit * REC;
        if (hw == 0) {
            float g = 0.f, be = 0.f;
            if (lane < nrows) {
                const float* bp = BA + (size_t)(row0 + lane) * 8;
                be = sigm(bp[h]);
                const float xx = bp[4 + h] + a.in[11][h];
                const float sp = xx > 20.f ? xx : log1pf(__expf(xx));
                g = -__expf(a.in[10][h]) * sp;
            }
#pragma unroll
            for (int o = 1; o < 64; o <<= 1) { const float v = __shfl_up(g, o); if (lane >= o) g += v; }
            Gs[lane] = g; Bs[lane] = be; EG[lane] = __expf(g);
            if (lane == 63) ((float*)(ws + WS_EG))[unit] = __expf(g);
        }
        float va[64];
        {
            const int c = t8 & 127;
            const int col = (t8 < 128 ? 0 : 512) + h * 128 + c;
            float h0 = 0.f, h1 = 0.f, h2 = 0.f;
            if (sample) { const float* cc = a.in[2] + (size_t)bidx * 3 * 1536 + col; h0 = cc[0]; h1 = cc[1536]; h2 = cc[2 * 1536]; }
            else if (!first) { const bf16* pp = P + (size_t)(row0 - 3) * PW + col; h0 = b2f(pp[0]); h1 = b2f(pp[PW]); h2 = b2f(pp[2 * PW]); }
            float* outp = lastc ? a.out + (sample ? O_SDC : O_PDC) + (size_t)bidx * 3 * 1536 + col : nullptr;
            conv_col(P + (size_t)row0 * PW + col, h0, h1, h2, cwt + col, nrows, outp, va);
            unsigned char* dst = (t8 < 128 ? qb : kb) + c * 2;
#pragma unroll
            for (int r = 0; r < 64; ++r) *(bf16*)(dst + r * 272) = f2b(va[r]);
        }
        __syncthreads();
        f32x4 kk[4], qk[4], qq;
        {
            bf16x8 ak[4], aq[4];
#pragma unroll
            for (int ks = 0; ks < 4; ++ks) { ak[ks] = *(const bf16x8*)(kb + (16 * hw + fr) * 272 + ks * 64 + fq * 16); aq[ks] = *(const bf16x8*)(qb + (16 * hw + fr) * 272 + ks * 64 + fq * 16); }
            qq = (f32x4){0.f, 0.f, 0.f, 0.f};
#pragma unroll
            for (int ks = 0; ks < 4; ++ks) qq = MFMA16(aq[ks], aq[ks], qq);
#pragma unroll
            for (int nt = 0; nt < 4; ++nt) {
                kk[nt] = (f32x4){0.f, 0.f, 0.f, 0.f}; qk[nt] = (f32x4){0.f, 0.f, 0.f, 0.f};
#pragma unroll
                for (int ks = 0; ks < 4; ++ks) { const bf16x8 bk = *(const bf16x8*)(kb + (16 * nt + fr) * 272 + ks * 64 + fq * 16);
                    kk[nt] = MFMA16(ak[ks], bk, kk[nt]); qk[nt] = MFMA16(aq[ks], bk, qk[nt]); }
            }
#pragma unroll
            for (int i = 0; i < 4; ++i) if (fr == 4 * fq + i) {
                float dk = 0.f;
#pragma unroll
                for (int nt = 0; nt < 4; ++nt) if (nt == hw) dk = kk[nt][i];
                RK[16 * hw + fr] = rsqrtf(dk + EPS); RQ[16 * hw + fr] = rsqrtf(qq[i] + EPS);
            }
        }
        __syncthreads();
        {
            bf16* QKr = (bf16*)(rec + R_QK);
#pragma unroll
            for (int i = 0; i < 4; ++i) {
                const int row = 16 * hw + 4 * fq + i;
                const float gr = Gs[row], br = Bs[row], rk = RK[row], rq = RQ[row];
#pragma unroll
                for (int nt = 0; nt < 4; ++nt) {
                    const int col = 16 * nt + fr;
                    const float d = col <= row ? gr - Gs[col] : 0.f;
                    const float e = __expf(d), rkc = RK[col];
                    Am[row * 64 + col] = col < row ? br * kk[nt][i] * rk * rkc * e : 0.f;
                    QKr[row * 64 + kperm(col)] = f2b(col <= row ? qk[nt][i] * rq * rkc * QSCALE * e : 0.f);
                }
            }
        }
        __syncthreads();
        if (t8 < 128) {
            bf16* Qg = (bf16*)(rec + R_QG) + kperm(t8);
#pragma unroll
            for (int r = 0; r < 64; ++r) Qg[r * 128] = f2b(va[r] * RQ[r] * QSCALE * EG[r]);
            {
                const int col = 1024 + h * 128 + t8;
                float h0 = 0.f, h1 = 0.f, h2 = 0.f;
                if (sample) { const float* cc = a.in[2] + (size_t)bidx * 3 * 1536 + col; h0 = cc[0]; h1 = cc[1536]; h2 = cc[2 * 1536]; }
                else if (!first) { const bf16* pp = P + (size_t)(row0 - 3) * PW + col; h0 = b2f(pp[0]); h1 = b2f(pp[PW]); h2 = b2f(pp[2 * PW]); }
                float* outp = lastc ? a.out + (sample ? O_SDC : O_PDC) + (size_t)bidx * 3 * 1536 + col : nullptr;
                conv_col(P + (size_t)row0 * PW + col, h0, h1, h2, cwt + col, nrows, outp, va);
            }
#pragma unroll
            for (int r = 0; r < 64; ++r) va[r] = va[r] * Bs[r];
        } else {
            const int c = t8 - 128;
            const float gl = Gs[63];
            unsigned w[32];
#pragma unroll
            for (int r = 0; r < 64; r += 2) w[kperm(r) >> 1] = pk2(va[r] * RK[r] * __expf(gl - Gs[r]), va[r + 1] * RK[r + 1] * __expf(gl - Gs[r + 1]));
            u32x4* dst = (u32x4*)(rec + R_KDT + c * 128);
#pragma unroll
            for (int j = 0; j < 8; ++j) dst[j] = (u32x4){w[4 * j], w[4 * j + 1], w[4 * j + 2], w[4 * j + 3]};
#pragma unroll
            for (int r = 0; r < 64; ++r) va[r] = va[r] * RK[r] * Bs[r] * EG[r];
        }
#if SOLVE_RL
        {
            float arow[64];
#pragma unroll
            for (int i = 1; i < 64; ++i) arow[i] = Am[i * 64 + lane];
#pragma unroll
            for (int i = 1; i < 64; ++i) {
                if (i < nrows) {
                    float acc0 = va[i], acc1 = 0.f;
#pragma unroll
                    for (int j = 0; j < i; ++j) { const float aij = __int_as_float(__builtin_amdgcn_readlane(__float_as_int(arow[i]), j)); if (j & 1) acc1 -= aij * va[j]; else acc0 -= aij * va[j]; }
                    va[i] = acc0 + acc1;
                }
            }
        }
#else
#pragma unroll
        for (int i = 1; i < 64; ++i) {
            float acc = va[i];
            const f32x4* Ar = (const f32x4*)(Am + i * 64);
#pragma unroll
            for (int j4 = 0; j4 < (i + 3) / 4; ++j4) {
                const f32x4 av = Ar[j4];
#pragma unroll
                for (int e = 0; e < 4; ++e) if (4 * j4 + e < i) acc -= av[e] * va[4 * j4 + e];
            }
            va[i] = acc;
        }
#endif
        if (t8 < 128) { bf16* U0 = (bf16*)(rec + R_U0) + t8;
#pragma unroll
            for (int r = 0; r < 64; ++r) U0[r * 128] = f2b(va[r]);
        } else { bf16* Wn = (bf16*)(rec + R_WN) + kperm(t8 - 128);
#pragma unroll
            for (int r = 0; r < 64; ++r) Wn[r * 128] = f2b(-va[r]);
        }
        __syncthreads();
    }
}

struct S5W { float lr[4], li[4]; bf16x8 bf[8]; };
DI void s5w_setup(const Args& a, int g, int fr, int fq, S5W& w) {
    const float dt = __expf(a.in[15][g]);
#pragma unroll
    for (int j = 0; j < 4; ++j) {
        const int p = 16 * j + fr;
        const float are = a.in[13][g * 64 + p], aim = a.in[14][g * 64 + p];
        const float mag = __expf(are * dt), ang = aim * dt;
        float sn, cs; sincosf(ang, &sn, &cs);
        const float lr = mag * cs, li = mag * sn;
        w.lr[j] = lr; w.li[j] = li;
        const float den = are * are + aim * aim;
        const float fre = ((lr - 1.f) * are + li * aim) / den, fim = (li * are - (lr - 1.f) * aim) / den;
        u32x4 wr = (u32x4){0u, 0u, 0u, 0u}, wi = (u32x4){0u, 0u, 0u, 0u};
        if (fq < 2) {
            const f32x4* br = (const f32x4*)(a.in[16] + (size_t)(g * 64 + p) * 16 + 8 * fq); const f32x4* bi = (const f32x4*)(a.in[17] + (size_t)(g * 64 + p) * 16 + 8 * fq);
            const f32x4 r0 = br[0], r1 = br[1], i0 = bi[0], i1 = bi[1];
            wr.x = pk2(fre * r0[0] - fim * i0[0], fre * r0[1] - fim * i0[1]); wr.y = pk2(fre * r0[2] - fim * i0[2], fre * r0[3] - fim * i0[3]);
            wr.z = pk2(fre * r1[0] - fim * i1[0], fre * r1[1] - fim * i1[1]); wr.w = pk2(fre * r1[2] - fim * i1[2], fre * r1[3] - fim * i1[3]);
            wi.x = pk2(fre * i0[0] + fim * r0[0], fre * i0[1] + fim * r0[1]); wi.y = pk2(fre * i0[2] + fim * r0[2], fre * i0[3] + fim * r0[3]);
            wi.z = pk2(fre * i1[0] + fim * r1[0], fre * i1[1] + fim * r1[1]); wi.w = pk2(fre * i1[2] + fim * r1[2], fre * i1[3] + fim * r1[3]);
        }
        w.bf[j] = __builtin_bit_cast(bf16x8, wr); w.bf[4 + j] = __builtin_bit_cast(bf16x8, wi);
    }
}
DI bf16x8 s5w_uload(const bf16* P, size_t row0, int SS, int ms, int g, int fr, int fq) {
    u32x4 v = (u32x4){0u, 0u, 0u, 0u};
    if (fq < 2) v = *(const u32x4*)(P + (row0 + (size_t)(fr >> 2) * SS + 4 * ms + (fr & 3)) * PW + 2048 + g * 16 + 8 * fq);
    return __builtin_bit_cast(bf16x8, v);
}
DI void s5w_step(const S5W& w, bf16x8 ua, float (&xr)[4], float (&xi)[4], unsigned (&xo)[4][4]) {
    f32x4 br[4], bi[4];
    const f32x4 z = (f32x4){0.f, 0.f, 0.f, 0.f};
#pragma unroll
    for (int j = 0; j < 4; ++j) { br[j] = MFMA16(ua, w.bf[j], z); bi[j] = MFMA16(ua, w.bf[4 + j], z); }
#pragma unroll
    for (int i = 0; i < 4; ++i)
#pragma unroll
        for (int j = 0; j < 4; ++j) {
            const float nr = w.lr[j] * xr[j] - w.li[j] * xi[j] + br[j][i], ni = w.lr[j] * xi[j] + w.li[j] * xr[j] + bi[j][i];
            xr[j] = nr; xi[j] = ni; xo[i][j] = pk2(nr, ni);
        }
#pragma unroll
    for (int j = 0; j < 8; ++j) asm volatile("" :: "v"(w.bf[j]));
    asm volatile("" :: "v"(ua));
}
DI void s5_pass1(const Args& a, int gw, int NGW, int lane) {
    asm volatile("" : "+v"(lane));
    const bf16* P = (const bf16*)(a.ws + WS_P);
    float* E = (float*)(a.ws + WS_S5E);
    const int fr = lane & 15, fq = lane >> 4;
    for (int unit = gw; unit < 4 * 32 * 16; unit += NGW) {
        const int sg = unit & 15, bg = unit >> 4, g = bg & 31, b = bg >> 5;
        S5W w; s5w_setup(a, g, fr, fq, w);
        float xr[4] = {0.f, 0.f, 0.f, 0.f}, xi[4] = {0.f, 0.f, 0.f, 0.f}; unsigned xo[4][4];
        const size_t row0 = (size_t)b * 8192 + sg * 512;
        bf16x8 ua = s5w_uload(P, row0, 128, 0, g, fr, fq);
        for (int ms = 0; ms < 32; ++ms) {
            const bf16x8 un = s5w_uload(P, row0, 128, ms + 1 < 32 ? ms + 1 : ms, g, fr, fq);
            s5w_step(w, ua, xr, xi, xo); ua = un;
        }
        float* e = E + ((size_t)bg * 64 + 4 * sg + fq) * 128;
#pragma unroll
        for (int j = 0; j < 4; ++j) { e[16 * j + fr] = xr[j]; e[64 + 16 * j + fr] = xi[j]; }
    }
}
DI void s5w_run(const Args& a, const S5W& w, const bf16x8 (&cf)[4], float Dg, unsigned char* xs, size_t row0, int SS, int nms, int g, int fr, int fq, float (&xr)[4], float (&xi)[4]) {
    const bf16* P = (const bf16*)(a.ws + WS_P);
    bf16* Y5 = (bf16*)(a.ws + WS_Y5);
    bf16x8 ua = s5w_uload(P, row0, SS, 0, g, fr, fq);
    for (int ms = 0; ms < nms; ++ms) {
        const bf16x8 un = s5w_uload(P, row0, SS, ms + 1 < nms ? ms + 1 : ms, g, fr, fq);
        float uu[4];
#pragma unroll
        for (int i = 0; i < 4; ++i) uu[i] = b2f(P[(row0 + (size_t)fq * SS + 4 * ms + i) * PW + 2048 + g * 16 + fr]);
        unsigned xo[4][4];
        s5w_step(w, ua, xr, xi, xo); ua = un;
#pragma unroll
        for (int i = 0; i < 4; ++i)
#pragma unroll
            for (int j = 0; j < 4; ++j) *(unsigned*)(xs + (4 * fq + i) * 272 + (16 * j + fr) * 4) = xo[i][j];
        asm volatile("s_waitcnt lgkmcnt(0)" ::: "memory");
        f32x4 y = (f32x4){0.f, 0.f, 0.f, 0.f};
        bf16x8 af[4];
#pragma unroll
        for (int ks = 0; ks < 4; ++ks) af[ks] = *(const bf16x8*)(xs + fr * 272 + ks * 64 + fq * 16);
        asm volatile("" ::: "memory");
#pragma unroll
        for (int ks = 0; ks < 4; ++ks) y = MFMA16(af[ks], cf[ks], y);
#if DIAG_Y
        {
            const float* cre = a.in[18] + (size_t)(g * 16 + fr) * 64; const float* cim = a.in[19] + (size_t)(g * 16 + fr) * 64;
#pragma unroll
            for (int i = 0; i < 4; ++i) { float acc = 0.f;
                for (int p = 0; p < 64; ++p) { const unsigned wv = *(const unsigned*)(xs + (4 * fq + i) * 272 + p * 4); acc += cre[p] * blo(wv) - cim[p] * bhi(wv); }
                y[i] = acc; }
        }
#endif
        asm volatile("" :: "v"(y));
#pragma unroll
        for (int ks = 0; ks < 4; ++ks) asm volatile("" :: "v"(af[ks]), "v"(cf[ks]));
#pragma unroll
        for (int i = 0; i < 4; ++i) {
            const size_t row = row0 + (size_t)fq * SS + 4 * ms + i;
            Y5[row * 512 + g * 16 + fr] = f2b(gelu_tanh(y[i] + Dg * uu[i]));
        }
    }
}
DI void s5_cfrag(const Args& a, int g, int fr, int fq, bf16x8 (&cf)[4]) {
#pragma unroll
    for (int ks = 0; ks < 4; ++ks) {
        const f32x4 cr = *(const f32x4*)(a.in[18] + (size_t)(g * 16 + fr) * 64 + 16 * ks + 4 * fq), ci = *(const f32x4*)(a.in[19] + (size_t)(g * 16 + fr) * 64 + 16 * ks + 4 * fq);
        u32x4 w; w.x = pk2(cr[0], -ci[0]); w.y = pk2(cr[1], -ci[1]); w.z = pk2(cr[2], -ci[2]); w.w = pk2(cr[3], -ci[3]);
        cf[ks] = __builtin_bit_cast(bf16x8, w);
    }
}
DI void s5_pass2_prompt(const Args& a, unsigned char* lds, int bg, int tid) {
    asm volatile("" : "+v"(tid));
    const int wave = __builtin_amdgcn_readfirstlane(tid >> 6), lane = tid & 63, fr = lane & 15, fq = lane >> 4;
    const int b = bg >> 5, g4 = (bg >> 2) & 7, part = bg & 3, g = 4 * g4 + (wave & 3);
    bg = b * 32 + g;
    unsigned char* xs = lds + wave * 4352;
    S5W w; s5w_setup(a, g, fr, fq, w);
    bf16x8 cf[4]; s5_cfrag(a, g, fr, fq, cf);
    const float Dg = a.in[20][g * 16 + fr];
    float pr[4], pi[4];
#pragma unroll
    for (int j = 0; j < 4; ++j) { pr[j] = w.lr[j]; pi[j] = w.li[j];
#pragma unroll
        for (int s = 0; s < 7; ++s) { const float nr = pr[j] * pr[j] - pi[j] * pi[j], ni = 2.f * pr[j] * pi[j]; pr[j] = nr; pi[j] = ni; } }
    const float* e = (const float*)(a.ws + WS_S5E) + (size_t)bg * 64 * 128;
    for (int uu = 0; uu < 2; ++uu) {
        const int sg = 4 * part + 2 * (wave >> 2) + uu, seg = 4 * sg + fq;
        float xr[4] = {0.f, 0.f, 0.f, 0.f}, xi[4] = {0.f, 0.f, 0.f, 0.f};
        for (int s = 0; s < 4 * sg + 3; ++s) {
            if (s < seg) {
#pragma unroll
                for (int j = 0; j < 4; ++j) { const float er = e[s * 128 + 16 * j + fr], ei = e[s * 128 + 64 + 16 * j + fr];
                    const float nr = pr[j] * xr[j] - pi[j] * xi[j] + er, ni = pr[j] * xi[j] + pi[j] * xr[j] + ei; xr[j] = nr; xi[j] = ni; }
            }
        }
        s5w_run(a, w, cf, Dg, xs, (size_t)b * 8192 + sg * 512, 128, 32, g, fr, fq, xr, xi);
        if (seg == 63) {
#pragma unroll
            for (int j = 0; j < 4; ++j) { a.out[O_PSR + (size_t)bg * 64 + 16 * j + fr] = xr[j]; a.out[O_PSI + (size_t)bg * 64 + 16 * j + fr] = xi[j]; }
        }
    }
}
DI void s5_pass2_sample(const Args& a, unsigned char* xs, int gw, int NGW, int lane) {
    asm volatile("" : "+v"(lane));
    const int fr = lane & 15, fq = lane >> 4;
    for (int unit = gw; unit < 256; unit += NGW) {
        const int g = unit & 31, q = unit >> 5, sb = 4 * q + fq;
        S5W w; s5w_setup(a, g, fr, fq, w);
        bf16x8 cf[4]; s5_cfrag(a, g, fr, fq, cf);
        const float Dg = a.in[20][g * 16 + fr];
        float xr[4], xi[4];
#pragma unroll
        for (int j = 0; j < 4; ++j) { xr[j] = a.in[4][(size_t)(sb * 32 + g) * 64 + 16 * j + fr]; xi[j] = a.in[5][(size_t)(sb * 32 + g) * 64 + 16 * j + fr]; }
        s5w_run(a, w, cf, Dg, xs, (size_t)TP + (size_t)q * 64, 16, 4, g, fr, fq, xr, xi);
#pragma unroll
        for (int j = 0; j < 4; ++j) { a.out[O_SSR + (size_t)(sb * 32 + g) * 64 + 16 * j + fr] = xr[j]; a.out[O_SSI + (size_t)(sb * 32 + g) * 64 + 16 * j + fr] = xi[j]; }
    }
}

struct S5Par { float lr, li; float bbr[16], bbi[16]; };
DI void s5_setup(const Args& a, int g, int p, S5Par& q) {
    const float are = a.in[13][g * 64 + p], aim = a.in[14][g * 64 + p], dt = __expf(a.in[15][g]);
    const float mag = __expf(are * dt), ang = aim * dt;
    float sn, cs; sincosf(ang, &sn, &cs);
    q.lr = mag * cs; q.li = mag * sn;
    const float den = are * are + aim * aim;
    const float fre = ((q.lr - 1.f) * are + q.li * aim) / den, fim = (q.li * are - (q.lr - 1.f) * aim) / den;
    const f32x4* br = (const f32x4*)(a.in[16] + (size_t)(g * 64 + p) * 16); const f32x4* bi = (const f32x4*)(a.in[17] + (size_t)(g * 64 + p) * 16);
#pragma unroll
    for (int j = 0; j < 4; ++j) { const f32x4 r = br[j], i = bi[j];
#pragma unroll
        for (int e = 0; e < 4; ++e) { q.bbr[4 * j + e] = fre * r[e] - fim * i[e]; q.bbi[4 * j + e] = fre * i[e] + fim * r[e]; } }
}
DI void s5_step4(const S5Par& q, float uv, float& xr, float& xi, unsigned (&xo)[4]) {
#pragma unroll
    for (int j = 0; j < 4; ++j) {
        float br = 0.f, bi = 0.f;
#pragma unroll
        for (int h = 0; h < 16; ++h) { const float uh = __int_as_float(__builtin_amdgcn_readlane(__float_as_int(uv), 16 * j + h)); br += q.bbr[h] * uh; bi += q.bbi[h] * uh; }
        const float nr = q.lr * xr - q.li * xi + br, ni = q.lr * xi + q.li * xr + bi;
        xr = nr; xi = ni; xo[j] = pk2(xr, xi);
    }
}
DI void old_s5_pass1(const Args& a, int gw, int NGW, int lane) {
    asm volatile("" : "+v"(lane));
    const bf16* P = (const bf16*)(a.ws + WS_P);
    float* E = (float*)(a.ws + WS_S5E);
    for (int unit = gw; unit < 4 * 32 * 64; unit += NGW) {
        const int seg = unit & 63, bg = unit >> 6, g = bg & 31, b = bg >> 5;
        S5Par q; s5_setup(a, g, lane, q);
        float xr = 0.f, xi = 0.f; unsigned xo[4];
        const bf16* up = P + (size_t)(b * 8192 + seg * 128 + (lane >> 4)) * PW + 2048 + g * 16 + (lane & 15);
#pragma unroll 2
        for (int t = 0; t < 128; t += 4) { const float uv = b2f(up[(size_t)t * PW]); s5_step4(q, uv, xr, xi, xo); }
        float* e = E + ((size_t)bg * 64 + seg) * 128;
        e[lane] = xr; e[64 + lane] = xi;
    }
}
DI void old_s5_pass2(const Args& a, unsigned char* xs  , int gw, int NGW, int lane) {
    asm volatile("" : "+v"(lane));
    const bf16* P = (const bf16*)(a.ws + WS_P);
    const float* E = (const float*)(a.ws + WS_S5E);
    bf16* Y5 = (bf16*)(a.ws + WS_Y5);
    const int fr = lane & 15, fq = lane >> 4;
    for (int unit = gw; unit < OLD_S5_ULIM; unit += NGW) {
        int g, row0, ntok, seg = 0, bg; bool sample;
        if (unit < 8192) { seg = unit & 63; bg = unit >> 6; g = bg & 31; row0 = (bg >> 5) * 8192 + seg * 128; ntok = 128; sample = false; }
        else { bg = unit - 8192; g = bg & 31; row0 = TP + (bg >> 5) * 16; ntok = 16; sample = true; }
        S5Par q; s5_setup(a, g, lane, q);
        float xr = 0.f, xi = 0.f;
        if (sample) { xr = a.in[4][(size_t)bg * 64 + lane]; xi = a.in[5][(size_t)bg * 64 + lane]; }
        else {
            float pr = q.lr, pi = q.li;
#pragma unroll
            for (int s = 0; s < 7; ++s) { const float nr = pr * pr - pi * pi, ni = 2.f * pr * pi; pr = nr; pi = ni; }
            const float* e = E + (size_t)bg * 64 * 128;
            for (int s = 0; s < seg; ++s) { const float er = e[s * 128 + lane], ei = e[s * 128 + 64 + lane]; const float nr = pr * xr - pi * xi + er, ni = pr * xi + pi * xr + ei; xr = nr; xi = ni; }
        }
        bf16x8 cf[4];
#pragma unroll
        for (int ks = 0; ks < 4; ++ks) {
            const f32x4 cr = *(const f32x4*)(a.in[18] + (size_t)(g * 16 + fr) * 64 + 16 * ks + 4 * fq), ci = *(const f32x4*)(a.in[19] + (size_t)(g * 16 + fr) * 64 + 16 * ks + 4 * fq);
            u32x4 w; w.x = pk2(cr[0], -ci[0]); w.y = pk2(cr[1], -ci[1]); w.z = pk2(cr[2], -ci[2]); w.w = pk2(cr[3], -ci[3]);
            cf[ks] = __builtin_bit_cast(bf16x8, w);
        }
        const float Dg = a.in[20][g * 16 + fr];
        const bf16* up = P + (size_t)(row0 + (lane >> 4)) * PW + 2048 + g * 16 + (lane & 15);
        for (int tb = 0; tb < ntok; tb += 16) {
#pragma unroll
            for (int j4 = 0; j4 < 4; ++j4) {
                const float uv = b2f(up[(size_t)(tb + 4 * j4) * PW]);
                unsigned xo[4]; s5_step4(q, uv, xr, xi, xo);
#pragma unroll
                for (int j = 0; j < 4; ++j) *(unsigned*)(xs + (4 * j4 + j) * 272 + lane * 4) = xo[j];
            }
            f32x4 y = (f32x4){0.f, 0.f, 0.f, 0.f};
#pragma unroll
            for (int ks = 0; ks < 4; ++ks) { const bf16x8 af = *(const bf16x8*)(xs + fr * 272 + ks * 64 + fq * 16); y = MFMA16(af, cf[ks], y); }
#pragma unroll
            for (int i = 0; i < 4; ++i) {
                const size_t row = (size_t)row0 + tb + 4 * fq + i;
                const float uu = b2f(P[row * PW + 2048 + g * 16 + fr]);
                Y5[row * 512 + g * 16 + fr] = f2b(gelu_tanh(y[i] + Dg * uu));
            }
        }
        if (sample) { a.out[O_SSR + (size_t)bg * 64 + lane] = xr; a.out[O_SSI + (size_t)bg * 64 + lane] = xi; }
        else if (seg == 63) { a.out[O_PSR + (size_t)bg * 64 + lane] = xr; a.out[O_PSI + (size_t)bg * 64 + lane] = xi; }
    }
}

DI void s5_pass2b(const Args& a, unsigned char* xs, int gw, int NGW, int lane) {
    asm volatile("" : "+v"(lane));
    const bf16* P = (const bf16*)(a.ws + WS_P);
    const float* E = (const float*)(a.ws + WS_S5E);
    bf16* Y5 = (bf16*)(a.ws + WS_Y5);
    const int fr = lane & 15, fq = lane >> 4;
    for (int unit = gw; unit < 4 * 32 * 64 + 32 * 32; unit += NGW) {
        int g, row0, ntok, seg = 0, bg; bool sample;
        if (unit < 8192) { seg = unit & 63; bg = unit >> 6; g = bg & 31; row0 = (bg >> 5) * 8192 + seg * 128; ntok = 128; sample = false; }
        else { bg = unit - 8192; g = bg & 31; row0 = TP + (bg >> 5) * 16; ntok = 16; sample = true; }
        S5Par q; s5_setup(a, g, lane, q);
        float xr = 0.f, xi = 0.f;
        if (sample) { xr = a.in[4][(size_t)bg * 64 + lane]; xi = a.in[5][(size_t)bg * 64 + lane]; }
        else {
            float pr = q.lr, pi = q.li;
#pragma unroll
            for (int s = 0; s < 7; ++s) { const float nr = pr * pr - pi * pi, ni = 2.f * pr * pi; pr = nr; pi = ni; }
            const float* e = E + (size_t)bg * 64 * 128;
            for (int s0 = 0; s0 < seg; s0 += 8) {
                float er[8], ei[8];
#pragma unroll
                for (int k = 0; k < 8; ++k) { const bool ok = s0 + k < seg; er[k] = ok ? e[(s0 + k) * 128 + lane] : 0.f; ei[k] = ok ? e[(s0 + k) * 128 + 64 + lane] : 0.f; }
#pragma unroll
                for (int k = 0; k < 8; ++k) if (s0 + k < seg) { const float nr = pr * xr - pi * xi + er[k], ni = pr * xi + pi * xr + ei[k]; xr = nr; xi = ni; }
            }
        }
        bf16x8 cf[4];
#pragma unroll
        for (int ks = 0; ks < 4; ++ks) {
            const f32x4 cr = *(const f32x4*)(a.in[18] + (size_t)(g * 16 + fr) * 64 + 16 * ks + 4 * fq), ci = *(const f32x4*)(a.in[19] + (size_t)(g * 16 + fr) * 64 + 16 * ks + 4 * fq);
            u32x4 w; w.x = pk2(cr[0], -ci[0]); w.y = pk2(cr[1], -ci[1]); w.z = pk2(cr[2], -ci[2]); w.w = pk2(cr[3], -ci[3]);
            cf[ks] = __builtin_bit_cast(bf16x8, w);
        }
        const float Dg = a.in[20][g * 16 + fr];
        S5W w; s5w_setup(a, g, fr, fq, w);
        unsigned char* bt = xs + 4352;
        for (int tb = 0; tb < ntok; tb += 16) {
            {
                u32x4 uv = (u32x4){0u, 0u, 0u, 0u};
                if (fq < 2) uv = *(const u32x4*)(P + (size_t)(row0 + tb + fr) * PW + 2048 + g * 16 + 8 * fq);
                const bf16x8 ua = __builtin_bit_cast(bf16x8, uv);
                const f32x4 z = (f32x4){0.f, 0.f, 0.f, 0.f};
#pragma unroll
                for (int j = 0; j < 4; ++j) {
                    const f32x4 br = MFMA16(ua, w.bf[j], z), bi = MFMA16(ua, w.bf[4 + j], z);
                    *(f32x4*)(bt + (16 * j + fr) * 80 + fq * 16) = br; *(f32x4*)(bt + (64 + 16 * j + fr) * 80 + fq * 16) = bi;
                }
            }
            asm volatile("s_waitcnt lgkmcnt(0)" ::: "memory");
            f32x4 bre[4], bim[4];
#pragma unroll
            for (int k = 0; k < 4; ++k) { bre[k] = *(const f32x4*)(bt + lane * 80 + k * 16); bim[k] = *(const f32x4*)(bt + (64 + lane) * 80 + k * 16); }
            asm volatile("s_waitcnt lgkmcnt(0)" ::: "memory");
#pragma unroll
            for (int t = 0; t < 16; ++t) {
                const float nr = q.lr * xr - q.li * xi + bre[t >> 2][t & 3], ni = q.lr * xi + q.li * xr + bim[t >> 2][t & 3];
                xr = nr; xi = ni;
                *(unsigned*)(xs + t * 272 + lane * 4) = pk2(nr, ni);
            }
            asm volatile("s_waitcnt lgkmcnt(0)" ::: "memory");
            f32x4 y = (f32x4){0.f, 0.f, 0.f, 0.f};
#pragma unroll
            for (int ks = 0; ks < 4; ++ks) { const bf16x8 af = *(const bf16x8*)(xs + fr * 272 + ks * 64 + fq * 16); y = MFMA16(af, cf[ks], y); }
#pragma unroll
            for (int i = 0; i < 4; ++i) {
                const size_t row = (size_t)row0 + tb + 4 * fq + i;
                const float uu = b2f(P[row * PW + 2048 + g * 16 + fr]);
                Y5[row * 512 + g * 16 + fr] = f2b(gelu_tanh(y[i] + Dg * uu));
            }
        }
        if (sample) { a.out[O_SSR + (size_t)bg * 64 + lane] = xr; a.out[O_SSI + (size_t)bg * 64 + lane] = xi; }
        else if (seg == 63) { a.out[O_PSR + (size_t)bg * 64 + lane] = xr; a.out[O_PSI + (size_t)bg * 64 + lane] = xi; }
    }
}

constexpr int DB_WN = 0, DB_QG = 17408, DB_KDT = 34816, DB_QK = 53248, DB_U0 = 62464;
constexpr int DBP_SIZE = DB_U0 + 64 * 80;
constexpr int DBS_SIZE = DB_U0 + 64 * 272;
template <int NC> struct DnRegs { u32x4 r[7]; u32x4 u[NC == 32 ? 1 : 2]; };
template <int NC> DI void dn_load(const unsigned char* rec, int tid, int c0, DnRegs<NC>& R) {
    const u32x4* g = (const u32x4*)rec;
    R.r[0] = g[tid]; R.r[1] = g[tid + 512]; R.r[2] = g[1024 + tid]; R.r[3] = g[1024 + tid + 512]; R.r[4] = g[2048 + tid]; R.r[5] = g[2048 + tid + 512]; R.r[6] = g[3072 + tid];
    if (NC == 32) { if (tid < 256) R.u[0] = *(const u32x4*)(rec + R_U0 + (tid >> 2) * 256 + c0 * 2 + (tid & 3) * 16); }
    else { R.u[0] = *(const u32x4*)(rec + R_U0 + tid * 16); R.u[1] = *(const u32x4*)(rec + R_U0 + (tid + 512) * 16); }
}
template <int NC> DI void dn_store(unsigned char* buf, int tid, const DnRegs<NC>& R) {
#pragma unroll
    for (int j = 0; j < 2; ++j) { const int q = tid + 512 * j;
        *(u32x4*)(buf + DB_WN + (q >> 4) * 272 + (q & 15) * 16) = R.r[j];
        *(u32x4*)(buf + DB_QG + (q >> 4) * 272 + (q & 15) * 16) = R.r[2 + j];
        *(u32x4*)(buf + DB_KDT + (q >> 3) * 144 + (q & 7) * 16) = R.r[4 + j]; }
    *(u32x4*)(buf + DB_QK + (tid >> 3) * 144 + (tid & 7) * 16) = R.r[6];
    if (NC == 32) { if (tid < 256) *(u32x4*)(buf + DB_U0 + (tid >> 2) * 80 + (tid & 3) * 16) = R.u[0]; }
    else {
#pragma unroll
        for (int j = 0; j < 2; ++j) { const int q = tid + 512 * j; *(u32x4*)(buf + DB_U0 + (q >> 4) * 272 + (q & 15) * 16) = R.u[j]; }
    }
}
DI bf16x8 pack8(const f32x4& lo, const f32x4& hi) { u32x4 w; w.x = pk2(lo[0], lo[1]); w.y = pk2(lo[2], lo[3]); w.z = pk2(hi[0], hi[1]); w.w = pk2(hi[2], hi[3]); return __builtin_bit_cast(bf16x8, w); }
template <int UPI> DI void dn_step(const unsigned char* buf, f32x4 (&S)[8], const unsigned char* u0, float eg, int fr, int fq, f32x4 (&o)[4]) {
    bf16x8 Sb[4];
#pragma unroll
    for (int ks = 0; ks < 4; ++ks) Sb[ks] = pack8(S[2 * ks], S[2 * ks + 1]);
    f32x4 u[4];
#pragma unroll
    for (int mt = 0; mt < 4; ++mt) {
#pragma unroll
        for (int i = 0; i < 4; ++i) u[mt][i] = b2f(*(const bf16*)(u0 + (16 * mt + 4 * fq + i) * UPI));
#pragma unroll
        for (int ks = 0; ks < 4; ++ks) u[mt] = MFMA16(*(const bf16x8*)(buf + DB_WN + (16 * mt + fr) * 272 + ks * 64 + fq * 16), Sb[ks], u[mt]);
    }
    bf16x8 ub[2];
#pragma unroll
    for (int k2 = 0; k2 < 2; ++k2) ub[k2] = pack8(u[2 * k2], u[2 * k2 + 1]);
#pragma unroll
    for (int mt = 0; mt < 4; ++mt) {
        o[mt] = (f32x4){0.f, 0.f, 0.f, 0.f};
#pragma unroll
        for (int ks = 0; ks < 4; ++ks) o[mt] = MFMA16(*(const bf16x8*)(buf + DB_QG + (16 * mt + fr) * 272 + ks * 64 + fq * 16), Sb[ks], o[mt]);
#pragma unroll
        for (int k2 = 0; k2 < 2; ++k2) o[mt] = MFMA16(*(const bf16x8*)(buf + DB_QK + (16 * mt + fr) * 144 + k2 * 64 + fq * 16), ub[k2], o[mt]);
    }
#pragma unroll
    for (int m8 = 0; m8 < 8; ++m8) {
        S[m8] = S[m8] * eg;
#pragma unroll
        for (int k2 = 0; k2 < 2; ++k2) S[m8] = MFMA16(*(const bf16x8*)(buf + DB_KDT + (16 * m8 + fr) * 144 + k2 * 64 + fq * 16), ub[k2], S[m8]);
    }
}
#if DN_STAGED == 2
#define DNP_SYNC() do { asm volatile("s_waitcnt lgkmcnt(0)" ::: "memory"); __builtin_amdgcn_sched_barrier(0); } while (0)
#else
#define DNP_SYNC() do { } while (0)
#endif
DI void dn_step_p(const unsigned char* buf, f32x4 (&S)[8], const unsigned char* u0, float eg, int fr, int fq, f32x4 (&o)[4]) {
    const unsigned char* aw = buf + DB_WN + fr * 272 + fq * 16;
    const unsigned char* aq = buf + DB_QG + fr * 272 + fq * 16;
    const unsigned char* ak = buf + DB_KDT + fr * 144 + fq * 16;
    const unsigned char* ac = buf + DB_QK + fr * 144 + fq * 16;
    bf16x8 f1[16], f2[16], Sb[4], ub[2];
    f32x4 u[4];
#pragma unroll
    for (int mt = 0; mt < 4; ++mt)
#pragma unroll
        for (int ks = 0; ks < 4; ++ks) f1[4 * mt + ks] = *(const bf16x8*)(aw + mt * 4352 + ks * 64);
#pragma unroll
    for (int mt = 0; mt < 4; ++mt)
#pragma unroll
        for (int i = 0; i < 4; ++i) u[mt][i] = b2f(*(const bf16*)(u0 + (16 * mt + 4 * fq + i) * 80));
#pragma unroll
    for (int ks = 0; ks < 4; ++ks) Sb[ks] = pack8(S[2 * ks], S[2 * ks + 1]);
    __builtin_amdgcn_sched_barrier(0);
#pragma unroll
    for (int mt = 0; mt < 4; ++mt)
#pragma unroll
        for (int ks = 0; ks < 4; ++ks) f2[4 * mt + ks] = *(const bf16x8*)(aq + mt * 4352 + ks * 64);
    DNP_SYNC();
#pragma unroll
    for (int ks = 0; ks < 4; ++ks)
#pragma unroll
        for (int mt = 0; mt < 4; ++mt) u[mt] = MFMA16(f1[4 * mt + ks], Sb[ks], u[mt]);
    __builtin_amdgcn_sched_barrier(0);
#pragma unroll
    for (int k2 = 0; k2 < 2; ++k2) ub[k2] = pack8(u[2 * k2], u[2 * k2 + 1]);
#pragma unroll
    for (int m8 = 0; m8 < 8; ++m8)
#pragma unroll
        for (int k2 = 0; k2 < 2; ++k2) f1[2 * m8 + k2] = *(const bf16x8*)(ak + m8 * 2304 + k2 * 64);
    DNP_SYNC();
#pragma unroll
    for (int mt = 0; mt < 4; ++mt) o[mt] = (f32x4){0.f, 0.f, 0.f, 0.f};
#pragma unroll
    for (int ks = 0; ks < 4; ++ks)
#pragma unroll
        for (int mt = 0; mt < 4; ++mt) o[mt] = MFMA16(f2[4 * mt + ks], Sb[ks], o[mt]);
    __builtin_amdgcn_sched_barrier(0);
#pragma unroll
    for (int mt = 0; mt < 4; ++mt)
#pragma unroll
        for (int k2 = 0; k2 < 2; ++k2) f2[2 * mt + k2] = *(const bf16x8*)(ac + mt * 2304 + k2 * 64);
    DNP_SYNC();
#pragma unroll
    for (int m8 = 0; m8 < 8; ++m8) S[m8] = S[m8] * eg;
#pragma unroll
    for (int k2 = 0; k2 < 2; ++k2)
#pragma unroll
        for (int m8 = 0; m8 < 8; ++m8) S[m8] = MFMA16(f1[2 * m8 + k2], ub[k2], S[m8]);
    __builtin_amdgcn_sched_barrier(0);
#pragma unroll
    for (int k2 = 0; k2 < 2; ++k2)
#pragma unroll
        for (int mt = 0; mt < 4; ++mt) o[mt] = MFMA16(f2[2 * mt + k2], ub[k2], o[mt]);
}
DI void dn_step_o(const unsigned char* buf, f32x4 (&S)[8], const unsigned char* u0, float eg, int fr, int fq, f32x4 (&o)[4]) {
    const unsigned char* aw = buf + DB_WN + fr * 272 + fq * 16;
    const unsigned char* aq = buf + DB_QG + fr * 272 + fq * 16;
    const unsigned char* ak = buf + DB_KDT + fr * 144 + fq * 16;
    const unsigned char* ac = buf + DB_QK + fr * 144 + fq * 16;
    bf16x8 f1[16], f2[16], Sb[4], ub[2];
    f32x4 u[4];
#pragma unroll
    for (int ks = 0; ks < 4; ++ks) Sb[ks] = pack8(S[2 * ks], S[2 * ks + 1]);
    __builtin_amdgcn_sched_barrier(0);
#pragma unroll
    for (int mt = 0; mt < 4; ++mt)
#pragma unroll
        for (int ks = 0; ks < 4; ++ks) f1[4 * mt + ks] = *(const bf16x8*)(aw + mt * 4352 + ks * 64);
#pragma unroll
    for (int mt = 0; mt < 4; ++mt)
#pragma unroll
        for (int i = 0; i < 4; ++i) u[mt][i] = b2f(*(const bf16*)(u0 + (16 * mt + 4 * fq + i) * 80));
#pragma unroll
    for (int mt = 0; mt < 4; ++mt)
#pragma unroll
        for (int ks = 0; ks < 4; ++ks) f2[4 * mt + ks] = *(const bf16x8*)(aq + mt * 4352 + ks * 64);
    __builtin_amdgcn_sched_barrier(0);
#pragma unroll
    for (int ks = 0; ks < 4; ++ks)
#pragma unroll
        for (int mt = 0; mt < 4; ++mt) u[mt] = MFMA16(f1[4 * mt + ks], Sb[ks], u[mt]);
    __builtin_amdgcn_sched_barrier(0);
#pragma unroll
    for (int k2 = 0; k2 < 2; ++k2) ub[k2] = pack8(u[2 * k2], u[2 * k2 + 1]);
    __builtin_amdgcn_sched_barrier(0);
#pragma unroll
    for (int m8 = 0; m8 < 8; ++m8)
#pragma unroll
        for (int k2 = 0; k2 < 2; ++k2) f1[2 * m8 + k2] = *(const bf16x8*)(ak + m8 * 2304 + k2 * 64);
#pragma unroll
    for (int mt = 0; mt < 4; ++mt) o[mt] = (f32x4){0.f, 0.f, 0.f, 0.f};
#pragma unroll
    for (int ks = 0; ks < 4; ++ks)
#pragma unroll
        for (int mt = 0; mt < 4; ++mt) o[mt] = MFMA16(f2[4 * mt + ks], Sb[ks], o[mt]);
    __builtin_amdgcn_sched_barrier(0);
    { float dmy = (o[0][0] + o[1][0]) + (o[2][0] + o[3][0]); asm volatile("" :: "v"(dmy)); }
    __builtin_amdgcn_sched_barrier(0);
#pragma unroll
    for (int mt = 0; mt < 4; ++mt)
#pragma unroll
        for (int k2 = 0; k2 < 2; ++k2) f2[2 * mt + k2] = *(const bf16x8*)(ac + mt * 2304 + k2 * 64);
#pragma unroll
    for (int m8 = 0; m8 < 8; ++m8) S[m8] = S[m8] * eg;
#pragma unroll
    for (int k2 = 0; k2 < 2; ++k2)
#pragma unroll
        for (int m8 = 0; m8 < 8; ++m8) S[m8] = MFMA16(f1[2 * m8 + k2], ub[k2], S[m8]);
    __builtin_amdgcn_sched_barrier(0);
#pragma unroll
    for (int k2 = 0; k2 < 2; ++k2)
#pragma unroll
        for (int mt = 0; mt < 4; ++mt) o[mt] = MFMA16(f2[2 * mt + k2], ub[k2], o[mt]);
}
DI void dn_piece(int q, int c0, unsigned& src, unsigned& dst) {
    if (q < 1024) { src = R_WN + q * 16; dst = DB_WN + (q >> 4) * 272 + (q & 15) * 16; }
    else if (q < 2048) { const int p = q - 1024; src = R_QG + p * 16; dst = DB_QG + (p >> 4) * 272 + (p & 15) * 16; }
    else if (q < 3072) { const int p = q - 2048; src = R_KDT + p * 16; dst = DB_KDT + (p >> 3) * 144 + (p & 7) * 16; }
    else if (q < 3584) { const int p = q - 3072; src = R_QK + p * 16; dst = DB_QK + (p >> 3) * 144 + (p & 7) * 16; }
    else { const int p = q - 3584; src = R_U0 + (p >> 2) * 256 + c0 * 2 + (p & 3) * 16; dst = DB_U0 + (p >> 2) * 80 + (p & 3) * 16; }
}
#define DN_LD(R, base) do { _Pragma("unroll") for (int k = 0; k < 10; ++k) { unsigned s_, d_; dn_piece(lt + 384 * k, c0, s_, d_); R[k] = *(const u32x4*)((base) + s_); } } while (0)
#define DN_WAIT(R, cnt) do { } while (0)
#define DN_ST(R, buf) do { _Pragma("unroll") for (int k = 0; k < 10; ++k) { unsigned s_, d_; dn_piece(lt + 384 * k, c0, s_, d_); *(u32x4*)((buf) + d_) = R[k]; } } while (0)
#define DN_BAR() do { asm volatile("s_waitcnt lgkmcnt(0)" ::: "memory"); __builtin_amdgcn_s_barrier(); asm volatile("" ::: "memory"); } while (0)
DI void dn_scan_prompt(const Args& a, unsigned char* lds, int tid) {
    asm volatile("" : "+v"(tid));
    const int wave = __builtin_amdgcn_readfirstlane(tid >> 6), lane = tid & 63, fr = lane & 15, fq = lane >> 4;
    const int bh = blockIdx.x >> 2, qt = blockIdx.x & 3, b = bh >> 2, h = bh & 3;
    const int c0 = qt * 32, v0 = c0 + (wave & 1) * 16;
    const unsigned char* recs = a.ws + WS_DNC + (size_t)bh * 128 * REC;
    const float* egs = (const float*)(a.ws + WS_EG) + bh * 128;
    bf16* ORAW = (bf16*)(a.ws + WS_H);
    const bool loader = wave >= 2;
    const int lt = tid - 128;
    f32x4 S[8];
#pragma unroll
    for (int m8 = 0; m8 < 8; ++m8) S[m8] = (f32x4){0.f, 0.f, 0.f, 0.f};
    float egA = egs[lane], egB = egs[64 + lane];
    asm volatile("s_waitcnt vmcnt(0)" : "+v"(egA), "+v"(egB) :: "memory");
    if (loader) {
        const int grp = wave >= 5 ? 1 : 0, lt2 = tid - 128 - grp * 192;
        u32x4 R[20];
        unsigned srcs[20], dsts[20];
        _Pragma("unroll") for (int k = 0; k < 20; ++k) dn_piece(lt2 + 192 * k, c0, srcs[k], dsts[k]);
#define DN_LD20(base) do { _Pragma("unroll") for (int k = 0; k < 20; ++k) R[k] = *(const u32x4*)((base) + srcs[k]); } while (0)
#define DN_ST20(buf) do { _Pragma("unroll") for (int k = 0; k < 20; ++k) *(u32x4*)((buf) + dsts[k]) = R[k]; } while (0)
        if (grp == 0) { DN_LD20(recs); DN_ST20(lds); DN_LD20(recs + 2 * (size_t)REC); }
        else { DN_LD20(recs + REC); }
        DN_BAR();
        for (int n = 0; n < 128; n += 2) {
            if (grp == 1) { DN_ST20(lds + DBP_SIZE); if (n + 3 < 128) DN_LD20(recs + (size_t)(n + 3) * REC); }
            DN_BAR();
            if (grp == 0 && n + 2 < 128) { DN_ST20(lds); if (n + 4 < 128) DN_LD20(recs + (size_t)(n + 4) * REC); }
            DN_BAR();
        }
#undef DN_LD20
#undef DN_ST20
    } else {
        DN_BAR();
        for (int n = 0; n < 128; ++n) {
            const float eg0 = __int_as_float(__builtin_amdgcn_readlane(__float_as_int(n < 64 ? egA : egB), n & 63));
            f32x4 o[4];
#if DN_STAGED == 3
            dn_step_o(lds + (n & 1) * DBP_SIZE, S, lds + (n & 1) * DBP_SIZE + DB_U0 + ((wave & 1) * 16 + fr) * 2, eg0, fr, fq, o);
#elif DN_STAGED
            dn_step_p(lds + (n & 1) * DBP_SIZE, S, lds + (n & 1) * DBP_SIZE + DB_U0 + ((wave & 1) * 16 + fr) * 2, eg0, fr, fq, o);
#else
            dn_step<80>(lds + (n & 1) * DBP_SIZE, S, lds + (n & 1) * DBP_SIZE + DB_U0 + ((wave & 1) * 16 + fr) * 2, eg0, fr, fq, o);
#endif
            bf16* op = ORAW + (size_t)(b * 8192 + n * 64) * 512 + h * 128 + v0 + fr;
#pragma unroll
            for (int mt = 0; mt < 4; ++mt)
#pragma unroll
                for (int i = 0; i < 4; ++i) op[(size_t)(16 * mt + 4 * fq + i) * 512] = f2b(o[mt][i]);
            DN_BAR();
        }
    }
    if (!loader) {
        float* so = a.out + O_PDS + (size_t)bh * 128 * 128 + v0 + fr;
#pragma unroll
        for (int m8 = 0; m8 < 8; ++m8)
#pragma unroll
            for (int i = 0; i < 4; ++i) so[(16 * m8 + 4 * fq + i) * 128] = S[m8][i];
    }
    __syncthreads();
}
DI void dn_scan_sample(const Args& a, unsigned char* lds, int tid, int su0, int su1, int sus) {
    asm volatile("" : "+v"(tid));
    const int wave = __builtin_amdgcn_readfirstlane(tid >> 6), lane = tid & 63, fr = lane & 15, fq = lane >> 4;
    const int v0 = wave * 16;
    bf16* ORAW = (bf16*)(a.ws + WS_H);
    for (int su = su0; su < su1; su += sus) {
        const int sb = su >> 2, h = su & 3;
        const unsigned char* rec = a.ws + WS_DNC + (size_t)(2048 + su) * REC;
        DnRegs<128> R; dn_load<128>(rec, tid, 0, R); dn_store<128>(lds, tid, R);
        __syncthreads();
        f32x4 S[8];
        const float* s0 = a.in[3] + (size_t)su * 128 * 128 + v0 + fr;
#pragma unroll
        for (int m8 = 0; m8 < 8; ++m8)
#pragma unroll
            for (int i = 0; i < 4; ++i) S[m8][i] = s0[(16 * m8 + 4 * fq + i) * 128];
        f32x4 o[4];
        dn_step<272>(lds, S, lds + DB_U0 + (v0 + fr) * 2, ((const float*)(a.ws + WS_EG))[2048 + su], fr, fq, o);
        bf16* op = ORAW + (size_t)(TP + sb * 16) * 512 + h * 128 + v0 + fr;
#pragma unroll
        for (int i = 0; i < 4; ++i) op[(size_t)(4 * fq + i) * 512] = f2b(o[0][i]);
        float* so = a.out + O_SDS + (size_t)su * 128 * 128 + v0 + fr;
#pragma unroll
        for (int m8 = 0; m8 < 8; ++m8)
#pragma unroll
            for (int i = 0; i < 4; ++i) so[(16 * m8 + 4 * fq + i) * 128] = S[m8][i];
        __syncthreads();
    }
}

DI void mix_phase(const Args& a, int gw, int NGW, int lane) {
    asm volatile("" : "+v"(lane));
    const bf16* ORAW = (const bf16*)(a.ws + WS_H);
    const bf16* P = (const bf16*)(a.ws + WS_P);
    const bf16* GLU = (const bf16*)(a.ws + WS_GLU);
    bf16* MIX = (bf16*)(a.ws + WS_DNC);
    const f32x2 dg = *(const f32x2*)(a.in[12] + 2 * lane);
    const f32x4 sg0 = *(const f32x4*)(a.in[23] + 8 * lane), sg1 = *(const f32x4*)(a.in[23] + 8 * lane + 4);
    constexpr int NR = 4;
    for (int row0 = gw; row0 < T; row0 += NR * NGW) {
        f32x2 ov[NR][4]; unsigned zz[NR][4]; u32x4 gv[NR]; float ssq[NR][5];
#pragma unroll
        for (int r = 0; r < NR; ++r) { const size_t row = row0 + r * NGW < T ? row0 + r * NGW : row0;
#pragma unroll
            for (int h = 0; h < 4; ++h) { { const unsigned ow = *(const unsigned*)(ORAW + row * 512 + h * 128 + 2 * lane); ov[r][h] = (f32x2){blo(ow), bhi(ow)}; } zz[r][h] = *(const unsigned*)(P + row * PW + 1536 + h * 128 + 2 * lane); }
            gv[r] = *(const u32x4*)(GLU + row * 512 + 8 * lane); }
#pragma unroll
        for (int r = 0; r < NR; ++r) {
#pragma unroll
            for (int h = 0; h < 4; ++h) ssq[r][h] = ov[r][h].x * ov[r][h].x + ov[r][h].y * ov[r][h].y;
            const float v[8] = {blo(gv[r].x), bhi(gv[r].x), blo(gv[r].y), bhi(gv[r].y), blo(gv[r].z), bhi(gv[r].z), blo(gv[r].w), bhi(gv[r].w)};
            float ss = 0.f;
#pragma unroll
            for (int e = 0; e < 8; ++e) ss += v[e] * v[e];
            ssq[r][4] = ss; }
#pragma unroll
        for (int o = 1; o < 64; o <<= 1)
#pragma unroll
            for (int r = 0; r < NR; ++r)
#pragma unroll
                for (int k = 0; k < 5; ++k) ssq[r][k] += __shfl_xor(ssq[r][k], o);
#pragma unroll
        for (int r = 0; r < NR; ++r) if (r == 0 || row0 + r * NGW < T) { const size_t row = row0 + r * NGW;
#pragma unroll
            for (int h = 0; h < 4; ++h) { const float rr = rsqrtf(ssq[r][h] * (1.f / 128.f) + EPS);
                *(unsigned*)(MIX + row * DM + h * 128 + 2 * lane) = pk2(ov[r][h].x * rr * dg.x * silu(blo(zz[r][h])), ov[r][h].y * rr * dg.y * silu(bhi(zz[r][h]))); }
            const float v[8] = {blo(gv[r].x), bhi(gv[r].x), blo(gv[r].y), bhi(gv[r].y), blo(gv[r].z), bhi(gv[r].z), blo(gv[r].w), bhi(gv[r].w)};
            const float r5 = rsqrtf(ssq[r][4] * (1.f / 512.f) + EPS);
            u32x4 w; w.x = pk2(v[0] * r5 * sg0[0], v[1] * r5 * sg0[1]); w.y = pk2(v[2] * r5 * sg0[2], v[3] * r5 * sg0[3]);
            w.z = pk2(v[4] * r5 * sg1[0], v[5] * r5 * sg1[1]); w.w = pk2(v[6] * r5 * sg1[2], v[7] * r5 * sg1[3]);
            *(u32x4*)(MIX + row * DM + 512 + 8 * lane) = w; }
    }
}

DI void act_phase(const Args& a, int gtid, int NT) {
    asm volatile("" : "+v"(gtid));
    bf16* UP = (bf16*)(a.ws + WS_UP);
    const float* fw = a.in[27]; const float* fb = a.in[28];
    constexpr int NCG = DFF / 8;
    for (int item = gtid; item < (T / 16) * NCG; item += NT) {
        const int cg8 = item % NCG, rb = item / NCG, col = cg8 * 8, row0 = rb * 16;
        float w0[8], w1[8], w2[8], bb[8], g2[8], g1[8];
#pragma unroll
        for (int e = 0; e < 8; ++e) { w0[e] = fw[col + e]; w1[e] = fw[DFF + col + e]; w2[e] = fw[2 * DFF + col + e]; bb[e] = fb[col + e]; g2[e] = 0.f; g1[e] = 0.f; }
        const bool sample = row0 >= TP;
        float* outp = nullptr;
        if (sample) { const int sb = (row0 - TP) >> 4; const float* cc = a.in[6] + (size_t)sb * 2 * DFF + col;
#pragma unroll
            for (int e = 0; e < 8; ++e) { g2[e] = cc[e]; g1[e] = cc[DFF + e]; }
            outp = a.out + O_SFC + (size_t)sb * 2 * DFF + col;
        } else {
            if ((rb & 511) != 0) {
                const u32x4 x2 = *(const u32x4*)(UP + (size_t)(row0 - 2) * UPW + col), x1 = *(const u32x4*)(UP + (size_t)(row0 - 1) * UPW + col);
                g2[0] = blo(x2.x); g2[1] = bhi(x2.x); g2[2] = blo(x2.y); g2[3] = bhi(x2.y); g2[4] = blo(x2.z); g2[5] = bhi(x2.z); g2[6] = blo(x2.w); g2[7] = bhi(x2.w);
                g1[0] = blo(x1.x); g1[1] = bhi(x1.x); g1[2] = blo(x1.y); g1[3] = bhi(x1.y); g1[4] = blo(x1.z); g1[5] = bhi(x1.z); g1[6] = blo(x1.w); g1[7] = bhi(x1.w);
            }
            if ((rb & 511) == 511) outp = a.out + O_PFC + (size_t)(rb >> 9) * 2 * DFF + col;
        }
#pragma unroll 4
        for (int r = 0; r < 16; ++r) {
            bf16* gp = UP + (size_t)(row0 + r) * UPW + col;
            const u32x4 xg = *(const u32x4*)gp, xv = *(const u32x4*)(gp + DFF);
            float g0[8] = {blo(xg.x), bhi(xg.x), blo(xg.y), bhi(xg.y), blo(xg.z), bhi(xg.z), blo(xg.w), bhi(xg.w)};
            float vv[8] = {blo(xv.x), bhi(xv.x), blo(xv.y), bhi(xv.y), blo(xv.z), bhi(xv.z), blo(xv.w), bhi(xv.w)};
            float o[8];
#pragma unroll
            for (int e = 0; e < 8; ++e) { o[e] = silu(g2[e] * w0[e] + g1[e] * w1[e] + g0[e] * w2[e] + bb[e]) * vv[e]; g2[e] = g1[e]; g1[e] = g0[e]; }
            u32x4 w; w.x = pk2(o[0], o[1]); w.y = pk2(o[2], o[3]); w.z = pk2(o[4], o[5]); w.w = pk2(o[6], o[7]);
            *(u32x4*)(gp + DFF) = w;
            if (outp && r >= 14) {
#pragma unroll
                for (int e = 0; e < 8; ++e) outp[(r - 14) * DFF + e] = g0[e];
            }
        }
    }
}

DI void act_fix_phase(const Args& a, int gtid, int NT) {
    asm volatile("" : "+v"(gtid));
    bf16* ACT = (bf16*)(a.ws + WS_UP);
    const bf16* GH = (const bf16*)(a.ws + WS_GH); const bf16* GT = (const bf16*)(a.ws + WS_GT); const bf16* VH = (const bf16*)(a.ws + WS_VH);
    const float* fw = a.in[27]; const float* fb = a.in[28];
    constexpr int NCG = DFF / 8;
    for (int item = gtid; item < (T / 16) * NCG; item += NT) {
        const int cg8 = item % NCG, grp = item / NCG, col = cg8 * 8;
        float w0[8], w1[8], w2[8], bb[8], g2[8], g1[8], h0[8], h1[8], v0[8], v1[8];
#pragma unroll
        for (int e = 0; e < 8; ++e) { w0[e] = fw[col + e]; w1[e] = fw[DFF + col + e]; w2[e] = fw[2 * DFF + col + e]; bb[e] = fb[col + e]; g2[e] = 0.f; g1[e] = 0.f; }
        const bool sample = grp >= TP / 16;
        if (sample) { const float* cc = a.in[6] + (size_t)(grp - TP / 16) * 2 * DFF + col;
#pragma unroll
            for (int e = 0; e < 8; ++e) { g2[e] = cc[e]; g1[e] = cc[DFF + e]; }
        } else if ((grp & 511) != 0) {
            const u32x4 x2 = *(const u32x4*)(GT + ((size_t)(grp - 1) * 2) * DFF + col), x1 = *(const u32x4*)(GT + ((size_t)(grp - 1) * 2 + 1) * DFF + col);
            g2[0] = blo(x2.x); g2[1] = bhi(x2.x); g2[2] = blo(x2.y); g2[3] = bhi(x2.y); g2[4] = blo(x2.z); g2[5] = bhi(x2.z); g2[6] = blo(x2.w); g2[7] = bhi(x2.w);
            g1[0] = blo(x1.x); g1[1] = bhi(x1.x); g1[2] = blo(x1.y); g1[3] = bhi(x1.y); g1[4] = blo(x1.z); g1[5] = bhi(x1.z); g1[6] = blo(x1.w); g1[7] = bhi(x1.w);
        }
        {
            const u32x4 xa = *(const u32x4*)(GH + ((size_t)grp * 2) * DFF + col), xb = *(const u32x4*)(GH + ((size_t)grp * 2 + 1) * DFF + col);
            const u32x4 ya = *(const u32x4*)(VH + ((size_t)grp * 2) * DFF + col), yb = *(const u32x4*)(VH + ((size_t)grp * 2 + 1) * DFF + col);
            h0[0] = blo(xa.x); h0[1] = bhi(xa.x); h0[2] = blo(xa.y); h0[3] = bhi(xa.y); h0[4] = blo(xa.z); h0[5] = bhi(xa.z); h0[6] = blo(xa.w); h0[7] = bhi(xa.w);
            h1[0] = blo(xb.x); h1[1] = bhi(xb.x); h1[2] = blo(xb.y); h1[3] = bhi(xb.y); h1[4] = blo(xb.z); h1[5] = bhi(xb.z); h1[6] = blo(xb.w); h1[7] = bhi(xb.w);
            v0[0] = blo(ya.x); v0[1] = bhi(ya.x); v0[2] = blo(ya.y); v0[3] = bhi(ya.y); v0[4] = blo(ya.z); v0[5] = bhi(ya.z); v0[6] = blo(ya.w); v0[7] = bhi(ya.w);
            v1[0] = blo(yb.x); v1[1] = bhi(yb.x); v1[2] = blo(yb.y); v1[3] = bhi(yb.y); v1[4] = blo(yb.z); v1[5] = bhi(yb.z); v1[6] = blo(yb.w); v1[7] = bhi(yb.w);
        }
        float o0[8], o1[8];
#pragma unroll
        for (int e = 0; e < 8; ++e) { o0[e] = silu(g2[e] * w0[e] + g1[e] * w1[e] + h0[e] * w2[e] + bb[e]) * v0[e]; o1[e] = silu(g1[e] * w0[e] + h0[e] * w1[e] + h1[e] * w2[e] + bb[e]) * v1[e]; }
        u32x4 wa, wb; wa.x = pk2(o0[0], o0[1]); wa.y = pk2(o0[2], o0[3]); wa.z = pk2(o0[4], o0[5]); wa.w = pk2(o0[6], o0[7]);
        wb.x = pk2(o1[0], o1[1]); wb.y = pk2(o1[2], o1[3]); wb.z = pk2(o1[4], o1[5]); wb.w = pk2(o1[6], o1[7]);
        *(u32x4*)(ACT + ((size_t)grp * 16) * DFF + col) = wa; *(u32x4*)(ACT + ((size_t)grp * 16 + 1) * DFF + col) = wb;
        float* outp = nullptr;
        if (sample) outp = a.out + O_SFC + (size_t)(grp - TP / 16) * 2 * DFF + col;
        else if ((grp & 511) == 511) outp = a.out + O_PFC + (size_t)(grp >> 9) * 2 * DFF + col;
        if (outp) {
            const u32x4 t0 = *(const u32x4*)(GT + ((size_t)grp * 2) * DFF + col), t1 = *(const u32x4*)(GT + ((size_t)grp * 2 + 1) * DFF + col);
            outp[0] = blo(t0.x); outp[1] = bhi(t0.x); outp[2] = blo(t0.y); outp[3] = bhi(t0.y); outp[4] = blo(t0.z); outp[5] = bhi(t0.z); outp[6] = blo(t0.w); outp[7] = bhi(t0.w);
            outp[DFF + 0] = blo(t1.x); outp[DFF + 1] = bhi(t1.x); outp[DFF + 2] = blo(t1.y); outp[DFF + 3] = bhi(t1.y); outp[DFF + 4] = blo(t1.z); outp[DFF + 5] = bhi(t1.z); outp[DFF + 6] = blo(t1.w); outp[DFF + 7] = bhi(t1.w);
        }
    }
}

DI void final_phase(const Args& a, int gw, int NGW, int lane) {
    asm volatile("" : "+v"(lane));
    f32x4 gv[4];
#pragma unroll
    for (int j = 0; j < 4; ++j) gv[j] = ((const f32x4*)a.in[30])[lane + 64 * j];
    const bf16* X2 = (const bf16*)(a.ws + WS_X2);
    for (int m0 = gw; m0 < T; m0 += 2 * NGW) {
        const int m1 = m0 + NGW < T ? m0 + NGW : m0;
        const u32x2* xr0 = (const u32x2*)(X2 + (size_t)m0 * DM) + lane; const u32x2* xr1 = (const u32x2*)(X2 + (size_t)m1 * DM) + lane;
        u32x2 b0[4], b1[4];
#pragma unroll
        for (int j = 0; j < 4; ++j) { b0[j] = xr0[64 * j]; b1[j] = xr1[64 * j]; }
        f32x4 v0[4], v1[4]; float s0 = 0.f, s1 = 0.f;
#pragma unroll
        for (int j = 0; j < 4; ++j) { v0[j] = (f32x4){blo(b0[j].x), bhi(b0[j].x), blo(b0[j].y), bhi(b0[j].y)}; v1[j] = (f32x4){blo(b1[j].x), bhi(b1[j].x), blo(b1[j].y), bhi(b1[j].y)};
            s0 += (v0[j].x * v0[j].x + v0[j].y * v0[j].y) + (v0[j].z * v0[j].z + v0[j].w * v0[j].w); s1 += (v1[j].x * v1[j].x + v1[j].y * v1[j].y) + (v1[j].z * v1[j].z + v1[j].w * v1[j].w); }
        const float r0 = rsqrtf(wave_sum(s0) * (1.f / DM) + EPS), r1 = rsqrtf(wave_sum(s1) * (1.f / DM) + EPS);
        f32x4* o0 = (f32x4*)(a.out + (size_t)m0 * DM) + lane; f32x4* o1 = (f32x4*)(a.out + (size_t)m1 * DM) + lane;
#pragma unroll
        for (int j = 0; j < 4; ++j) o0[64 * j] = v0[j] * r0 * gv[j];
        if (m1 != m0) {
#pragma unroll
            for (int j = 0; j < 4; ++j) o1[64 * j] = v1[j] * r1 * gv[j];
        }
    }
}

#ifndef PH_MASK
#define PH_MASK 0xffff
#endif
#ifndef SOLVE_RL
#define SOLVE_RL 1
#endif
#ifndef REP0
#define REP0 1
#endif
#ifndef REP1
#define REP1 1
#endif
#ifndef REP2A
#define REP2A 1
#endif
#ifndef REP2B
#define REP2B 1
#endif
#ifndef REP3A
#define REP3A 1
#endif
#ifndef REP3B
#define REP3B 1
#endif
#ifndef REP3C
#define REP3C 1
#endif
#ifndef PH_LO
#define PH_LO 0
#endif
#ifndef PH_HI
#define PH_HI 99
#endif
__global__ void __launch_bounds__(512, 2) fwd_kernel(Args a) {
    extern __shared__ __attribute__((aligned(16))) unsigned char lds[];
    cg::grid_group grid = cg::this_grid();
    const int tid = threadIdx.x, lane = tid & 63, wave = __builtin_amdgcn_readfirstlane(tid >> 6);
    const int G = gridDim.x, gw = blockIdx.x * 8 + wave, NGW = G * 8;
    unsigned char* ws = a.ws;
    PG8_LAS unsigned char* ldsg = (PG8_LAS unsigned char*)lds;
    volatile LAS unsigned* xbst = (volatile LAS unsigned*)(ldsg + (LDS_BYTES - 64));
    if (tid < 2) xbst[tid] = 0u;
    __syncthreads();
    const XcdBarrier xbar = xcd_barrier_post((unsigned*)(ws + WS_CTL), xbst);

    _Pragma("nounroll") for (int rep = 0; rep < REP0; ++rep) { phase0(a, lds, gw, NGW, wave, lane); __syncthreads(); }
    xcd_barrier(xbar);
    if (a.out == nullptr) grid.sync();
    _Pragma("nounroll") for (int rep = 0; rep < REP1; ++rep)
    { pg8::Gemm g{(const bf16*)(ws + WS_H), (const bf16*)(ws + WS_WIN), T, NIN, DM, DM}; pg8::StaticOrder S; S.init(T, NIN, G, (int)blockIdx.x);
      EpiP E{(bf16*)(ws + WS_P), (float*)(ws + WS_BA)};
      pg8::gemm_phase<EpiP, pg8::StaticOrder, true, true>(ldsg, g, S, E); }
    xcd_barrier(xbar);
    _Pragma("nounroll") for (int rep = 0; rep < REP2A; ++rep) dn_chunk_phase(a, lds, tid, (int)blockIdx.x, 1024, G);
#if OLD_S5 && OLD_S5 != 4 && OLD_S5 != 5
    old_s5_pass1(a, gw, NGW, lane);
#elif 0
#else
    _Pragma("nounroll") for (int rep = 0; rep < REP2B; ++rep) s5_pass1(a, gw, NGW, lane);
#endif
    xcd_barrier(xbar);
#if OLD_S5 == 3
    if (blockIdx.x < 64) dn_scan_prompt(a, lds, tid);
    else { if (blockIdx.x >= 192) { dn_scan_sample(a, lds, tid, (int)blockIdx.x - 192, 128, 64); s5_pass2_sample(a, lds + 81920 + wave * 4352, ((int)blockIdx.x - 192) * 8 + wave, 512, lane); __syncthreads(); }
           old_s5_pass2(a, lds + 81920 + wave * 4352, gw - 512, NGW - 512, lane); }
#elif OLD_S5 == 5
    if (blockIdx.x < 64) { _Pragma("nounroll") for (int rep = 0; rep < REP3A; ++rep) dn_scan_prompt(a, lds, tid); }
    else {
        if (blockIdx.x >= 192) {
            const int w = (int)blockIdx.x - 192;
            dn_chunk_phase(a, lds, tid, 1024 + w, 1025 + w, 1);
            __threadfence_block(); __syncthreads();
            dn_scan_sample(a, lds, tid, 2 * w, 2 * w + 2, 1);
        }
        _Pragma("nounroll") for (int rep = 0; rep < REP3B; ++rep) s5_pass2b(a, lds + wave * 14592, gw - 512, NGW - 512, lane);
    }
#elif OLD_S5 == 1 || OLD_S5 == 4
    if (blockIdx.x < 64) dn_scan_prompt(a, lds, tid);
    else { if (blockIdx.x >= 192) dn_scan_sample(a, lds, tid, (int)blockIdx.x - 192, 128, 64); old_s5_pass2(a, lds + 81920 + wave * 4352, gw - 512, NGW - 512, lane); }
#else
    if (blockIdx.x < 64) { _Pragma("nounroll") for (int rep = 0; rep < REP3A; ++rep) dn_scan_prompt(a, lds, tid); }
    else if (blockIdx.x < 192) { _Pragma("nounroll") for (int rep = 0; rep < REP3B; ++rep) s5_pass2_prompt(a, lds, (int)blockIdx.x - 64, tid); }
    else { _Pragma("nounroll") for (int rep = 0; rep < REP3C; ++rep) { dn_scan_sample(a, lds, tid, (int)blockIdx.x - 192, 128, 64); s5_pass2_sample(a, lds + 81920 + wave * 4352, ((int)blockIdx.x - 192) * 8 + wave, 512, lane); } }
#endif
    xcd_barrier(xbar);
#if PH_MASK & 512
    { pg8::Gemm g{(const bf16*)(ws + WS_Y5), (const bf16*)(ws + WS_WGLU), T, 1024, 512, 512}; pg8::StaticOrder S; S.init(T, 1024, G, (int)blockIdx.x);
      EpiGlu E{(bf16*)(ws + WS_GLU), a.in[22]};
      pg8::gemm_phase<EpiGlu, pg8::StaticOrder, true, true>(ldsg, g, S, E); }
#endif
    xcd_barrier(xbar);
#if PH_MASK & 32
    mix_phase(a, gw, NGW, lane);
#endif
    xcd_barrier(xbar);
#if PH_MASK & 1024
    { pg8::Gemm g{(const bf16*)(ws + WS_DNC), (const bf16*)(ws + WS_WOUT), T, DM, DM, DM}; pg8::StaticOrder S; S.init(T, DM, G, (int)blockIdx.x);
      EpiX1 E{a.in[0], a.in[1], a.out, (bf16*)(ws + WS_H), (float*)(ws + WS_SS2)};
      pg8::gemm_phase<EpiX1, pg8::StaticOrder, true, true>(ldsg, g, S, E); }
#endif
    xcd_barrier(xbar);
#if FUSE_ACT
    { pg8::Gemm g{(const bf16*)(ws + WS_H), (const bf16*)(ws + WS_WUP), T, UPW, DM, DM}; pg8::StaticOrder S; S.init(T, UPW, G, (int)blockIdx.x);
      EpiUpAct E{(bf16*)(ws + WS_UP), (bf16*)(ws + WS_GH), (bf16*)(ws + WS_GT), (bf16*)(ws + WS_VH), (const float*)(ws + WS_SS2), a.in[27], a.in[28]};
      pg8::gemm_phase<EpiUpAct, pg8::StaticOrder, true, true>(ldsg, g, S, E); }
    xcd_barrier(xbar);
    act_fix_phase(a, (int)blockIdx.x * 512 + tid, G * 512);
    xcd_barrier(xbar);
    { pg8::Gemm g{(const bf16*)(ws + WS_UP), (const bf16*)(ws + WS_WDOWN), T, DM, DFF, DFF}; pg8::StaticOrder S; S.init(T, DM, G, (int)blockIdx.x);
      EpiX2 E{a.out, (const bf16*)(ws + WS_H), (bf16*)(ws + WS_X2)};
      pg8::gemm_phase<EpiX2, pg8::StaticOrder, true, true>(ldsg, g, S, E); }
    xcd_barrier(xbar);
#else
#if PH_MASK & 2048
    { pg8::Gemm g{(const bf16*)(ws + WS_H), (const bf16*)(ws + WS_WUP), T, UPW, DM, DM}; pg8::StaticOrder S; S.init(T, UPW, G, (int)blockIdx.x);
      EpiUp E{(bf16*)(ws + WS_UP), (const float*)(ws + WS_SS2)};
      pg8::gemm_phase<EpiUp, pg8::StaticOrder, true, true>(ldsg, g, S, E); }
#endif
    xcd_barrier(xbar);
#if PH_MASK & 64
    act_phase(a, (int)blockIdx.x * 512 + tid, G * 512);
#endif
    xcd_barrier(xbar);
#if PH_MASK & 4096
    { pg8::Gemm g{(const bf16*)(ws + WS_UP) + DFF, (const bf16*)(ws + WS_WDOWN), T, DM, DFF, UPW}; pg8::StaticOrder S; S.init(T, DM, G, (int)blockIdx.x);
      EpiX2 E{a.out, (const bf16*)(ws + WS_H), (bf16*)(ws + WS_X2)};
      pg8::gemm_phase<EpiX2, pg8::StaticOrder, true, true>(ldsg, g, S, E); }
#endif
    xcd_barrier(xbar);
#endif
#if PH_MASK & 128
    final_phase(a, gw, NGW, lane);
#endif
}

extern "C" void kernel_launch(void* const* d_in, const int* in_sizes, int n_in, void* d_out, int out_size, void* d_ws, size_t ws_size, hipStream_t stream) {
    static int grid = 0;
    if (grid == 0) {
        if (n_in != 31 || (size_t)out_size != O_END || ws_size < WS_END) { fprintf(stderr, "kernel_launch: unexpected shapes n_in %d out %d ws %zu\n", n_in, out_size, ws_size); grid = -1; return; }
        int dev = 0, cus = 0, per_cu = 0;
        hipGetDevice(&dev);
        hipDeviceGetAttribute(&cus, hipDeviceAttributeMultiprocessorCount, dev);
        hipFuncSetAttribute((const void*)fwd_kernel, hipFuncAttributeMaxDynamicSharedMemorySize, LDS_BYTES);
        hipOccupancyMaxActiveBlocksPerMultiprocessor(&per_cu, (const void*)fwd_kernel, 512, LDS_BYTES);
        if (per_cu < 1) { fprintf(stderr, "kernel_launch: occupancy query says %d blocks per CU\n", per_cu); per_cu = 1; }
        grid = cus * 1;
        if (grid != 256) { fprintf(stderr, "kernel_launch: built for a 256-CU device, got %d\n", cus); grid = -1; return; }
        (void)hipGetLastError();
    }
    if (grid < 0) return;
    if (hipMemsetAsync((char*)d_ws + WS_CTL, 0, 16384, stream) != hipSuccess) { fprintf(stderr, "kernel_launch: memset of the barrier words failed\n"); return; }
    Args a{};
    for (int i = 0; i < 31; ++i) a.in[i] = (const float*)d_in[i];
    a.out = (float*)d_out; a.ws = (unsigned char*)d_ws;
    void* args[] = {&a};
    hipError_t e = hipLaunchCooperativeKernel((const void*)fwd_kernel, dim3(grid), dim3(512), args, LDS_BYTES, stream);
    if (e != hipSuccess) fprintf(stderr, "cooperative launch failed: %s (grid %d)\n", hipGetErrorString(e), grid);
}
```
